# Optimizing an MI355X kernel written in HIP

```python
import math
import jax, jax.numpy as jnp
from jax import lax
import numpy as np

D_MODEL = 1024
BATCH = 32
SEQ = 2048
DEPTH = 1

DA_HEADS = 8
DA_DK = 64
DA_DV = 2 * DA_DK
Q_BLOCK = 128
ML_HEADS = 4
ML_DK = 128
ML_DV = 256
ML_CHUNK = 128
CONV_K = 4
PEER_HEADS = 8
PEER_TOPK = 16
N_KEYS = 128
N_EXPERTS = N_KEYS * N_KEYS
PEER_DKEY = 128
PEER_CHUNK = 128

DA_QK_W = DA_HEADS * 2 * DA_DK
DA_V_W = DA_HEADS * DA_DV
ML_QK_W = ML_HEADS * ML_DK
ML_V_W = ML_HEADS * ML_DV
IN_SIZES = (DA_QK_W, DA_QK_W, DA_V_W, ML_QK_W, ML_QK_W, ML_V_W, ML_V_W,
            ML_HEADS, ML_HEADS, D_MODEL, D_MODEL)
IN_W = sum(IN_SIZES)

ALPHA = (2 * DEPTH) ** 0.25
BETA = (8 * DEPTH) ** -0.25
LN_EPS = 1e-5

kernel_name = "hybrid_diffattn_mlstm_peer_deepnorm_adaln"


def _split_cols(z, sizes):
    idx = np.cumsum(np.array(sizes))[:-1].tolist()
    return jnp.split(z, idx, axis=-1)


def _layer_norm(x):
    xf = x.astype(jnp.float32)
    mu = jnp.mean(xf, axis=-1, keepdims=True)
    var = jnp.mean(jnp.square(xf - mu), axis=-1, keepdims=True)
    return ((xf - mu) * lax.rsqrt(var + LN_EPS)).astype(x.dtype)


def _rms_norm(x, g):
    xf = x.astype(jnp.float32)
    y = xf * lax.rsqrt(jnp.mean(jnp.square(xf), axis=-1, keepdims=True) + LN_EPS)
    return y * g.astype(jnp.float32)


def _causal_depthwise_conv(x, w, b):
    C = x.shape[-1]
    y = lax.conv_general_dilated(x, w[:, None, :].astype(x.dtype), window_strides=(1,),
                                 padding=[(CONV_K - 1, 0)],
                                 dimension_numbers=('NWC', 'WIO', 'NWC'),
                                 feature_group_count=C)
    return y + b


def _diff_attention(q, k, v, lam, subln_g, lambda_init):
    dtype = v.dtype
    q = jnp.transpose(q, (0, 2, 3, 1, 4))
    k = jnp.transpose(k, (0, 2, 3, 1, 4))
    v = jnp.transpose(v, (0, 2, 1, 3)).astype(jnp.float32)
    S = q.shape[3]
    lamf = lam.astype(jnp.float32)
    lam_val = (jnp.exp(jnp.sum(lamf[0] * lamf[1])) - jnp.exp(jnp.sum(lamf[2] * lamf[3]))
               + lambda_init)
    scale = DA_DK ** -0.5
    outs = []
    for blk in range(S // Q_BLOCK):
        q0 = blk * Q_BLOCK
        kend = q0 + Q_BLOCK
        qb = q[:, :, :, q0:kend]
        kb = k[:, :, :, :kend]
        s = jnp.einsum('bhmqd,bhmkd->bhmqk', qb, kb).astype(jnp.float32) * scale
        mask = jnp.arange(kend)[None, :] <= (q0 + jnp.arange(Q_BLOCK))[:, None]
        p = jax.nn.softmax(jnp.where(mask, s, -jnp.inf), axis=-1)
        a = p[:, :, 0] - lam_val * p[:, :, 1]
        outs.append(jnp.einsum('bhqk,bhkd->bhqd', a, v[:, :, :kend]))
    o = jnp.concatenate(outs, axis=2)
    o = _rms_norm(o, subln_g) * (1.0 - lambda_init)
    B = o.shape[0]
    return jnp.transpose(o, (0, 2, 1, 3)).reshape(B, S, DA_HEADS * DA_DV).astype(dtype)


def _mlstm(q, k, v, i_pre, f_pre, norm_g):
    dtype = v.dtype
    B, S, H, _ = q.shape
    L = ML_CHUNK
    NC = S // L
    q = q.astype(jnp.float32)
    k = k.astype(jnp.float32) * (ML_DK ** -0.5)
    v = v.astype(jnp.float32)
    ig = i_pre.astype(jnp.float32)
    lf = jax.nn.log_sigmoid(f_pre.astype(jnp.float32))

    def to_chunks(t):
        return jnp.transpose(t.reshape(B, NC, L, H, t.shape[-1]), (1, 0, 3, 2, 4))

    def g_chunks(t):
        return jnp.transpose(t.reshape(B, NC, L, H), (1, 0, 3, 2))

    causal = jnp.tril(jnp.ones((L, L), dtype=bool))

    def step(carry, inp):
        C, n, m = carry
        qc, kc, vc, ic, fc = inp
        b = jnp.cumsum(fc, axis=-1)
        Dm = b[..., :, None] - b[..., None, :] + ic[..., None, :]
        Dm = jnp.where(causal, Dm, -jnp.inf)
        m_inter = b + m[..., None]
        m_t = jnp.maximum(m_inter, jnp.max(Dm, axis=-1))
        W = jnp.exp(Dm - m_t[..., None])
        P = W * jnp.einsum('bhtd,bhsd->bhts', qc, kc)
        inter = jnp.exp(m_inter - m_t)
        num = (jnp.einsum('bhts,bhsv->bhtv', P, vc)
               + inter[..., None] * jnp.einsum('bhvd,bhtd->bhtv', C, qc))
        nq = jnp.sum(P, axis=-1) + inter * jnp.einsum('bhd,bhtd->bht', n, qc)
        h = num / jnp.maximum(jnp.abs(nq), jnp.exp(-m_t))[..., None]
        m_new = m_t[..., -1]
        decay = jnp.exp(b[..., -1] + m - m_new)
        w_s = jnp.exp(b[..., -1:] - b + ic - m_new[..., None])
        C_new = decay[..., None, None] * C + jnp.einsum('bhsv,bhsd->bhvd', vc * w_s[..., None], kc)
        n_new = decay[..., None] * n + jnp.einsum('bhs,bhsd->bhd', w_s, kc)
        return (C_new, n_new, m_new), h

    init = (jnp.zeros((B, H, ML_DV, ML_DK), jnp.float32),
            jnp.zeros((B, H, ML_DK), jnp.float32),
            jnp.zeros((B, H), jnp.float32))
    _, hs = lax.scan(step, init, (to_chunks(q), to_chunks(k), to_chunks(v), g_chunks(ig), g_chunks(lf)))
    h = jnp.transpose(hs, (1, 0, 3, 2, 4)).reshape(B, S, H, ML_DV)
    h = _rms_norm(h, norm_g.reshape(H, ML_DV))
    return h.reshape(B, S, H * ML_DV).astype(dtype)


def _peer(h, w_q, sub_keys, u_tab, v_tab):
    B, S, D = h.shape
    T = B * S
    ht = h.reshape(T, D)
    q = (ht @ w_q).reshape(T, PEER_HEADS, 2, PEER_DKEY // 2)
    s = jnp.einsum('thpd,pnd->thpn', q, sub_keys).astype(jnp.float32)
    sv, si = lax.top_k(s, PEER_TOPK)
    cand = (sv[:, :, 0, :, None] + sv[:, :, 1, None, :]).reshape(T, PEER_HEADS, PEER_TOPK * PEER_TOPK)
    cv, ci = lax.top_k(cand, PEER_TOPK)
    i1 = jnp.take_along_axis(si[:, :, 0], ci // PEER_TOPK, axis=-1)
    i2 = jnp.take_along_axis(si[:, :, 1], ci % PEER_TOPK, axis=-1)
    eidx = i1 * N_KEYS + i2
    g = jax.nn.softmax(cv, axis=-1)
    nch = T // PEER_CHUNK

    def expert_block(args):
        hc, ec, gc = args
        uc = u_tab[ec]
        act = jax.nn.gelu(jnp.einsum('cd,chkd->chk', hc, uc), approximate=False)
        vc = v_tab[ec]
        return jnp.einsum('chk,chkd->cd', (gc * act).astype(hc.dtype), vc)

    out = lax.map(expert_block, (ht.reshape(nch, PEER_CHUNK, D),
                                 eidx.reshape(nch, PEER_CHUNK, PEER_HEADS, PEER_TOPK),
                                 g.reshape(nch, PEER_CHUNK, PEER_HEADS, PEER_TOPK)))
    return out.reshape(B, S, D)


def setup_inputs(seed: int = 0) -> dict:
    key = jax.random.key(seed)
    ks = jax.random.split(key, 26)
    f32 = jnp.float32
    nrm = lambda k, shape, s: jax.random.normal(k, shape, f32) * s
    gain = lambda k, shape: 1.0 + 0.02 * jax.random.normal(k, shape, f32)
    b_if = jnp.stack([0.1 * jax.random.normal(ks[4], (DEPTH, ML_HEADS), f32),
                      jnp.linspace(3.0, 6.0, ML_HEADS, dtype=f32)[None, :]
                      + 0.1 * jax.random.normal(ks[5], (DEPTH, ML_HEADS), f32)], axis=1)
    return {
        "x": nrm(ks[0], (BATCH, SEQ, D_MODEL), 1.0),
        "c": nrm(ks[1], (BATCH, D_MODEL), 1.0),
        "w_ada": nrm(ks[2], (DEPTH, D_MODEL, 6 * D_MODEL), 0.5 * D_MODEL ** -0.5),
        "b_ada": nrm(ks[3], (DEPTH, 6 * D_MODEL), 0.02),
        "w_in": nrm(ks[6], (DEPTH, D_MODEL, IN_W), D_MODEL ** -0.5),
        "b_if": b_if,
        "conv_w": nrm(ks[7], (DEPTH, CONV_K, 2 * ML_QK_W), CONV_K ** -0.5),
        "conv_b": nrm(ks[8], (DEPTH, 2 * ML_QK_W), 0.02),
        "da_lambda": nrm(ks[9], (DEPTH, 4, DA_DK), 0.1),
        "da_subln_g": gain(ks[10], (DEPTH, DA_DV)),
        "ml_norm_g": gain(ks[11], (DEPTH, ML_V_W)),
        "w_br_attn": nrm(ks[12], (DEPTH, DA_V_W, D_MODEL), BETA * DA_V_W ** -0.5),
        "w_br_mlstm": nrm(ks[13], (DEPTH, ML_V_W, D_MODEL), BETA * ML_V_W ** -0.5),
        "w_out": nrm(ks[14], (DEPTH, D_MODEL, D_MODEL), BETA * D_MODEL ** -0.5),
        "ln1_g": gain(ks[15], (DEPTH, D_MODEL)),
        "ln1_b": nrm(ks[16], (DEPTH, D_MODEL), 0.02),
        "peer_wq": nrm(ks[17], (DEPTH, D_MODEL, PEER_HEADS * PEER_DKEY), D_MODEL ** -0.5),
        "peer_keys": nrm(ks[18], (DEPTH, 2, N_KEYS, PEER_DKEY // 2), (PEER_DKEY // 2) ** -0.5),
        "peer_u": nrm(ks[19], (DEPTH, N_EXPERTS, D_MODEL), D_MODEL ** -0.5),
        "peer_v": nrm(ks[20], (DEPTH, N_EXPERTS, D_MODEL), BETA * PEER_HEADS ** -0.5),
        "ln2_g": gain(ks[21], (DEPTH, D_MODEL)),
        "ln2_b": nrm(ks[22], (DEPTH, D_MODEL), 0.02),
    }


def reference(x, c, w_ada, b_ada, w_in, b_if, conv_w, conv_b, da_lambda, da_subln_g,
              ml_norm_g, w_br_attn, w_br_mlstm, w_out, ln1_g, ln1_b, peer_wq, peer_keys,
              peer_u, peer_v, ln2_g, ln2_b):
    B, S, D = x.shape
    for l in range(DEPTH):
        mod = jax.nn.silu(c) @ w_ada[l] + b_ada[l]
        sh1, sc1, gt1, sh2, sc2, gt2 = jnp.split(mod[:, None, :], 6, axis=-1)

        h = _layer_norm(x) * (1.0 + sc1) + sh1
        z = h @ w_in[l]
        (da_q, da_k, da_v, ml_q, ml_k, ml_v, ml_o, ml_i, ml_f,
         g_attn, g_ml) = _split_cols(z, IN_SIZES)
        qk = jax.nn.silu(_causal_depthwise_conv(jnp.concatenate([ml_q, ml_k], axis=-1),
                                                conv_w[l], conv_b[l]))
        ml_q, ml_k = jnp.split(qk, 2, axis=-1)
        lambda_init = 0.8 - 0.6 * math.exp(-0.3 * l)
        ya = _diff_attention(da_q.reshape(B, S, DA_HEADS, 2, DA_DK),
                             da_k.reshape(B, S, DA_HEADS, 2, DA_DK),
                             da_v.reshape(B, S, DA_HEADS, DA_DV),
                             da_lambda[l], da_subln_g[l], lambda_init)
        ym = _mlstm(ml_q.reshape(B, S, ML_HEADS, ML_DK),
                    ml_k.reshape(B, S, ML_HEADS, ML_DK),
                    ml_v.reshape(B, S, ML_HEADS, ML_DV),
                    ml_i + b_if[l, 0], ml_f + b_if[l, 1], ml_norm_g[l])
        ym = ym * jax.nn.sigmoid(ml_o)
        y = (jax.nn.sigmoid(g_attn) * (ya @ w_br_attn[l])
             + jax.nn.sigmoid(g_ml) * (ym @ w_br_mlstm[l]))
        x = _layer_norm(ALPHA * x + gt1 * (y @ w_out[l])) * ln1_g[l] + ln1_b[l]

        h = _layer_norm(x) * (1.0 + sc2) + sh2
        yf = _peer(h, peer_wq[l], peer_keys[l], peer_u[l], peer_v[l])
        x = _layer_norm(ALPHA * x + gt2 * yf) * ln2_g[l] + ln2_b[l]
    return x
```

```cpp
#include <hip/hip_runtime.h>
#include <hip/hip_bf16.h>
#include <cstdio>
#include <cstdint>
#include <cmath>

#define LAS __attribute__((address_space(3)))
#define GAS __attribute__((address_space(1)))
typedef unsigned short bf16_t;
typedef short bf16x8 __attribute__((ext_vector_type(8)));
typedef short s16x4 __attribute__((ext_vector_type(4)));
typedef float f32x2 __attribute__((ext_vector_type(2)));
typedef float f32x4 __attribute__((ext_vector_type(4)));
typedef float f32x16 __attribute__((ext_vector_type(16)));
typedef unsigned u32x2 __attribute__((ext_vector_type(2)));
typedef unsigned u32x4 __attribute__((ext_vector_type(4)));
typedef __bf16 bf16x2_t __attribute__((ext_vector_type(2)));
#define DI __device__ __forceinline__

constexpr int BATCH = 32, SEQ = 2048, DM = 1024, TOK = BATCH * SEQ;
constexpr int NZ = 6144;
constexpr int ZC_Q = 0, ZC_K = 1024, ZC_V = 2048, ZC_MQ = 3072, ZC_MK = 3584, ZC_MV = 4096, ZC_MO = 5120;
constexpr int NGATE = 2048;
constexpr int NIN = 8192;
constexpr int IN_W = 8200;
constexpr int MODW = 6 * DM;
constexpr float LN_EPS = 1e-5f;
constexpr float ALPHA_RES = 1.189207115002721f;
constexpr float LAMBDA_INIT = 0.2f;
constexpr float QSCALE = 0.125f * 1.4426950408889634f;
constexpr int NEXP = 16384;

constexpr size_t MiB = 1u << 20;
constexpr size_t WS_CTL = 0, CTL_ZERO_BYTES = 2 * MiB;
constexpr size_t WS_MOD = 1 * MiB;
constexpr size_t WS_GIF = 3 * MiB;
constexpr size_t WS_WIN = 6 * MiB;
constexpr size_t WS_WA = 22 * MiB, WS_WM = 24 * MiB, WS_WOUT = 26 * MiB, WS_WQ = 28 * MiB;
constexpr size_t WS_U = 30 * MiB, WS_V = 62 * MiB;
constexpr size_t WS_H1 = 96 * MiB;
constexpr size_t WS_Z = 224 * MiB;
constexpr size_t WS_R = WS_Z, WS_X1 = WS_Z + 256 * MiB, WS_H2 = WS_Z + 512 * MiB, WS_QP = WS_Z + 640 * MiB;
constexpr size_t WS_END = 992 * MiB;
constexpr int CW_BAR = 4096;
constexpr int CW_QUEUE = 16384;

DI unsigned pk2(float lo, float hi) { f32x2 v = {lo, hi}; bf16x2_t b = __builtin_convertvector(v, bf16x2_t); return __builtin_bit_cast(unsigned, b); }
DI float bf_lo(unsigned u) { return __uint_as_float(u << 16); }
DI float bf_hi(unsigned u) { return __uint_as_float(u & 0xffff0000u); }
DI float bf2f(bf16_t h) { return __uint_as_float(((unsigned)h) << 16); }
DI float wave_sum(float v) {
#pragma unroll
    for (int o = 1; o < 64; o <<= 1) v += __shfl_xor(v, o);
    return v;
}
DI float sigmoidf_(float x) { return 1.0f / (1.0f + __expf(-x)); }
DI float siluf_(float x) { return x / (1.0f + __expf(-x)); }
DI int crow(int r, int hi) { return (r & 3) + 8 * (r >> 2) + 4 * hi; }
#define MFMA32(a, b, c) __builtin_amdgcn_mfma_f32_32x32x16_bf16((a), (b), (c), 0, 0, 0)
DI bf16x8 pack_step(const f32x16& x, int s) {
    u32x4 p;
    p[0] = pk2(x[8 * s + 0], x[8 * s + 1]); p[1] = pk2(x[8 * s + 2], x[8 * s + 3]); p[2] = pk2(x[8 * s + 4], x[8 * s + 5]); p[3] = pk2(x[8 * s + 6], x[8 * s + 7]);
    return __builtin_bit_cast(bf16x8, p);
}
DI unsigned off_b(unsigned row, unsigned ch) { return 256u * row + 16u * (ch ^ (((row & 3) << 2) | ((row >> 2) & 3))); }
DI unsigned row_read_addr(unsigned lane, unsigned rt, unsigned s) { return off_b(32 * rt + (lane & 31), 2 * s + (lane >> 5)); }
DI unsigned tr_read_addr(unsigned lane, unsigned c, unsigned ks, unsigned t) {
    const unsigned h = lane >> 5, blk = (lane >> 4) & 1, q = (lane & 15) >> 2, p = lane & 3;
    return off_b(16 * ks + 8 * h + 4 * t + q, 4 * c + 2 * blk + (p >> 1)) + 8 * (p & 1);
}
DI unsigned tr_base(unsigned lane, unsigned t) { const unsigned h = lane >> 5, blk = (lane >> 4) & 1, q = (lane & 15) >> 2, p = lane & 3, cl = 2 * blk + (p >> 1);
    return 256u * (8 * h + 4 * t + q) + 16u * (cl ^ (2 * h + t)) + 8u * (p & 1); }
#define OPAQUE(x) asm volatile("" : "+v"(x))
typedef short v4i16_t __attribute__((ext_vector_type(4)));
DI s16x4 tr_read(const LAS unsigned char* p) { return __builtin_bit_cast(s16x4, __builtin_amdgcn_ds_read_tr16_b64_v4i16((LAS v4i16_t*)p)); }
DI bf16x8 cat8(s16x4 lo, s16x4 hi) { return __builtin_shufflevector(lo, hi, 0, 1, 2, 3, 4, 5, 6, 7); }
namespace pg8 {
#define PG8_LAS __attribute__((address_space(3)))
typedef unsigned short bf16_t;
typedef short bf16x8 __attribute__((ext_vector_type(8)));
typedef float f32x4 __attribute__((ext_vector_type(4)));
typedef unsigned u32x4 __attribute__((ext_vector_type(4)));
constexpr int BM = 256, BK = 64, HALF = 128, HTB = HALF * BK * 2  , STAGE_BYTES = 8 * HTB, NXCD = 8, WGM = 8;

__host__ __device__ __forceinline__ int lds_byte(int r, int c) { const int st = (r >> 4) * 2 + (c >> 5), rr = r & 15, cc = c & 31, ob = rr * 64 + cc * 2; return st * 1024 + (ob ^ (((ob >> 9) & 1) << 5)); }
__host__ __device__ __forceinline__ void stage_rc(int b, int& R, int& C) { const int st = b / 1024, sb = b % 1024, swz = sb ^ (((sb >> 9) & 1) << 5); R = (st >> 1) * 16 + swz / 64; C = (st & 1) * 32 + (swz % 64) / 2; }
__host__ __device__ __forceinline__ int perm32(int rho) { const int n = rho >> 4, i = rho & 15; return 8 * (i >> 2) + 4 * n + (i & 3); }

struct Unit { int pm, pn; };
struct Gemm { const bf16_t* A; const bf16_t* Bt; int M, N, K, lda, ldb; };

struct StaticOrder {
    int nM, nN, nwg, G, c;
    __host__ __device__ void init(int M, int N, int G_, int c_) { nM = M / BM; nN = N / BM; nwg = nM * nN; G = G_; c = c_; }
    __host__ __device__ bool next(int i, Unit& u) const {
        const long L = (long)i * G + c; if (L >= nwg) return false;
        int wgid = (int)L; { const int q = nwg / NXCD, r = nwg % NXCD, xcd = wgid % NXCD, off = wgid / NXCD; wgid = (xcd < r ? xcd * (q + 1) : r * (q + 1) + (xcd - r) * q) + off; }
        const int nig = WGM * nN, gid = wgid / nig, fm = gid * WGM, gsz = (nM - fm) < WGM ? (nM - fm) : WGM;
        u.pm = fm + ((wgid % nig) % gsz); u.pn = (wgid % nig) / gsz; return true;
    }
    __device__ __forceinline__ void a_ready(const Unit&) const {}
    __device__ __forceinline__ void done(const Unit&) const {}
};

template <class Epi, class Sched, bool ALIGN_EPI = false, bool SP2 = false>
__device__ __forceinline__ void gemm_phase(PG8_LAS unsigned char* lds, const Gemm g, const Sched& S, const Epi& E) {
    const int tid = threadIdx.x, wid = __builtin_amdgcn_readfirstlane(tid >> 6), lane = tid & 63, wr = wid >> 2, wc = wid & 3, fr = lane & 15, fq = lane >> 4;
    const int K = g.K, nt = K / BK;
    unsigned voffA[2], voffB[2];
#pragma unroll
    for (int i = 0; i < 2; ++i) { int R, C; stage_rc(tid * 16 + i * 8192, R, C); const int Rb = Epi::PERM ? ((R & ~31) + perm32(R & 31)) : R;
        voffA[i] = (unsigned)(R * g.lda + C) * 2u; voffB[i] = (unsigned)(Rb * g.ldb + C) * 2u; }
    const size_t kstep = (size_t)(BK * 2);
    const size_t hstepA = (size_t)HALF * g.lda * 2, hstepB = (size_t)HALF * g.ldb * 2;
    const size_t tstepA = 2 * hstepA, tstepB = 2 * hstepB;
    const unsigned ldsw = (unsigned)wid * 1024u;
    const int aoff = lds_byte(wr * 64 + fr, fq * 8), boff = lds_byte(wc * 32 + fr, fq * 8);
#define PG8_SA(b, h) (((b) * 2 + (h)) * HTB)
#define PG8_SB(b, h) ((4 + (b) * 2 + (h)) * HTB)
#define PG8_STAGE(bufoff, gbase, voff) do { _Pragma("unroll") for (int _i = 0; _i < 2; ++_i) \
        __builtin_amdgcn_global_load_lds((const unsigned*)((const char*)(gbase) + (voff)[_i]), (PG8_LAS unsigned*)(lds + (bufoff) + ldsw + _i * 8192), 16, 0, 0); } while (0)
#define PG8_LDA(dst, b, h) do { _Pragma("unroll") for (int m = 0; m < 4; ++m) _Pragma("unroll") for (int k = 0; k < 2; ++k) dst[m][k] = *(const PG8_LAS bf16x8*)(lds + PG8_SA(b, h) + aoff + m * 2048 + k * 1024); } while (0)
#define PG8_LDB(dst, b, h) do { _Pragma("unroll") for (int n = 0; n < 2; ++n) _Pragma("unroll") for (int k = 0; k < 2; ++k) dst[n][k] = *(const PG8_LAS bf16x8*)(lds + PG8_SB(b, h) + boff + n * 2048 + k * 1024); } while (0)
#define PG8_MMA(ai, bj, At, Bt) do { __builtin_amdgcn_s_setprio(1); _Pragma("unroll") for (int m = 0; m < 4; ++m) _Pragma("unroll") for (int n = 0; n < 2; ++n) _Pragma("unroll") for (int k = 0; k < 2; ++k) \
        acc[ai][bj][m][n] = __builtin_amdgcn_mfma_f32_16x16x32_bf16(Bt[n][k], At[m][k], acc[ai][bj][m][n], 0, 0, 0); __builtin_amdgcn_s_setprio(0); } while (0)
#define PG8_WAIT_V(n) asm volatile("s_waitcnt vmcnt(" #n ")" ::: "memory")
#define PG8_WAIT_L(n) asm volatile("s_waitcnt lgkmcnt(" #n ")" ::: "memory")
#define PG8_BAR __builtin_amdgcn_s_barrier()
#define PG8_SCHED __builtin_amdgcn_sched_barrier(0)
    Unit cur, nxt; int ui = 0;
    if (!S.next(0, cur)) return;
    f32x4 acc[2][2][4][2];
#pragma unroll
    for (int a = 0; a < 2; ++a)
#pragma unroll
        for (int b = 0; b < 2; ++b)
#pragma unroll
            for (int m = 0; m < 4; ++m)
#pragma unroll
                for (int n = 0; n < 2; ++n) acc[a][b][m][n] = (f32x4){0.f, 0.f, 0.f, 0.f};
    bf16x8 At[4][2], B0[2][2], B1[2][2];
    const char* cA = (const char*)g.A + (size_t)cur.pm * tstepA; const char* cB = (const char*)g.Bt + (size_t)cur.pn * tstepB;
    S.a_ready(cur);
    if constexpr (SP2) {
        PG8_STAGE(PG8_SB(0, 0), cB, voffB); PG8_STAGE(PG8_SB(0, 1), cB + hstepB, voffB); PG8_STAGE(PG8_SA(0, 0), cA, voffA); PG8_STAGE(PG8_SA(0, 1), cA + hstepA, voffA);
        if (wr == 1) PG8_BAR;
        PG8_WAIT_V(2); PG8_BAR;
        PG8_STAGE(PG8_SB(1, 0), cB + kstep, voffB); PG8_STAGE(PG8_SA(1, 0), cA + kstep, voffA); PG8_STAGE(PG8_SB(1, 1), cB + hstepB + kstep, voffB);
        PG8_WAIT_V(6); PG8_BAR;
    } else {
        PG8_STAGE(PG8_SB(0, 0), cB, voffB); PG8_STAGE(PG8_SA(0, 0), cA, voffA); PG8_STAGE(PG8_SB(0, 1), cB + hstepB, voffB); PG8_STAGE(PG8_SA(0, 1), cA + hstepA, voffA);
        if (wr == 1) PG8_BAR;
        PG8_WAIT_V(4); PG8_BAR;
        PG8_STAGE(PG8_SB(1, 0), cB + kstep, voffB); PG8_STAGE(PG8_SA(1, 0), cA + kstep, voffA); PG8_STAGE(PG8_SB(1, 1), cB + hstepB + kstep, voffB);
        PG8_WAIT_V(6); PG8_BAR;
    }
    for (;;) {
        const bool has_next = S.next(ui + 1, nxt);
        const char* nA = has_next ? (const char*)g.A + (size_t)nxt.pm * tstepA : cA; const char* nB = has_next ? (const char*)g.Bt + (size_t)nxt.pn * tstepB : cB;
        for (int t = 0; t < nt; t += 2) {
            const bool last = (t == nt - 2);
            const char* a1 = cA + (size_t)(t + 1) * kstep;
            const char* a2 = last ? nA : cA + (size_t)(t + 2) * kstep; const char* b2 = last ? nB : cB + (size_t)(t + 2) * kstep;
            const char* a3 = a2 + kstep; const char* b3 = b2 + kstep;
            if (last && has_next) S.a_ready(nxt);
            if constexpr (SP2) {
            PG8_LDB(B0, 0, 0); PG8_LDB(B1, 0, 1); PG8_SCHED; PG8_LDA(At, 0, 0); PG8_STAGE(PG8_SA(1, 1), a1 + hstepA, voffA);
            PG8_WAIT_V(8); PG8_WAIT_L(0); PG8_BAR; PG8_MMA(0, 0, At, B0); PG8_MMA(0, 1, At, B1); PG8_BAR; PG8_SCHED;
            PG8_LDA(At, 0, 1); PG8_STAGE(PG8_SB(0, 0), b2, voffB); PG8_STAGE(PG8_SB(0, 1), b2 + hstepB, voffB); PG8_STAGE(PG8_SA(0, 0), a2, voffA);
            PG8_WAIT_V(8); PG8_WAIT_L(0); PG8_BAR; PG8_MMA(1, 0, At, B0); PG8_MMA(1, 1, At, B1); PG8_BAR; PG8_SCHED;
            PG8_LDB(B0, 1, 0); PG8_LDB(B1, 1, 1); PG8_SCHED; PG8_LDA(At, 1, 0); PG8_STAGE(PG8_SA(0, 1), a2 + hstepA, voffA);
            PG8_WAIT_V(8); PG8_WAIT_L(0); PG8_BAR; PG8_MMA(0, 0, At, B0); PG8_MMA(0, 1, At, B1); PG8_BAR; PG8_SCHED;
            PG8_LDA(At, 1, 1); PG8_STAGE(PG8_SB(1, 0), b3, voffB); PG8_STAGE(PG8_SB(1, 1), b3 + hstepB, voffB); PG8_STAGE(PG8_SA(1, 0), a3, voffA);
            PG8_WAIT_V(8); PG8_WAIT_L(0); PG8_BAR; PG8_MMA(1, 0, At, B0); PG8_MMA(1, 1, At, B1); PG8_BAR; PG8_SCHED;
            } else {
            PG8_LDB(B0, 0, 0); PG8_SCHED; PG8_LDA(At, 0, 0); PG8_STAGE(PG8_SA(1, 1), a1 + hstepA, voffA);
            PG8_WAIT_L(8); PG8_BAR; PG8_WAIT_L(0); PG8_MMA(0, 0, At, B0); PG8_BAR; PG8_SCHED;
            PG8_LDB(B1, 0, 1); PG8_STAGE(PG8_SB(0, 0), b2, voffB);
            PG8_BAR; PG8_WAIT_L(0); PG8_MMA(0, 1, At, B1); PG8_BAR;
            PG8_LDA(At, 0, 1); PG8_STAGE(PG8_SA(0, 0), a2, voffA);
            PG8_BAR; PG8_WAIT_L(0); PG8_MMA(1, 0, At, B0); PG8_BAR; PG8_SCHED;
            PG8_STAGE(PG8_SB(0, 1), b2 + hstepB, voffB);
            PG8_WAIT_V(6); PG8_BAR; PG8_MMA(1, 1, At, B1); PG8_BAR;
            PG8_LDB(B0, 1, 0); PG8_SCHED; PG8_LDA(At, 1, 0); PG8_STAGE(PG8_SA(0, 1), a2 + hstepA, voffA);
            PG8_WAIT_L(8); PG8_BAR; PG8_WAIT_L(0); PG8_MMA(0, 0, At, B0); PG8_BAR; PG8_SCHED;
            PG8_LDB(B1, 1, 1); PG8_STAGE(PG8_SB(1, 0), b3, voffB);
            PG8_BAR; PG8_WAIT_L(0); PG8_MMA(0, 1, At, B1); PG8_BAR;
            PG8_LDA(At, 1, 1); PG8_STAGE(PG8_SA(1, 0), a3, voffA);
            PG8_BAR; PG8_WAIT_L(0); PG8_MMA(1, 0, At, B0); PG8_BAR; PG8_SCHED;
            PG8_STAGE(PG8_SB(1, 1), b3 + hstepB, voffB);
            PG8_WAIT_V(6); PG8_BAR; PG8_MMA(1, 1, At, B1); PG8_BAR;
            }
        }
        if constexpr (ALIGN_EPI) { if (wr == 0) PG8_BAR; }
        if constexpr (!Epi::AFTER_DRAIN) { E(acc, cur, wr, wc, fr, fq); S.done(cur); }
        if (!has_next) break;
#pragma unroll
        for (int a = 0; a < 2; ++a)
#pragma unroll
            for (int b = 0; b < 2; ++b)
#pragma unroll
                for (int m = 0; m < 4; ++m)
#pragma unroll
                    for (int n = 0; n < 2; ++n) acc[a][b][m][n] = (f32x4){0.f, 0.f, 0.f, 0.f};
        cur = nxt; cA = nA; cB = nB; ++ui;
        if constexpr (ALIGN_EPI) { if (wr == 1) PG8_BAR; }
    }
    PG8_WAIT_V(0);
    if constexpr (!ALIGN_EPI) { if (wr == 0) PG8_BAR; }
    PG8_BAR;
    if constexpr (Epi::AFTER_DRAIN) { E.fused(acc, cur, wr, wc, fr, fq, lds, wid, lane); S.done(cur); }
#undef PG8_SA
#undef PG8_SB
#undef PG8_STAGE
#undef PG8_LDA
#undef PG8_LDB
#undef PG8_MMA
#undef PG8_WAIT_V
#undef PG8_WAIT_L
#undef PG8_BAR
#undef PG8_SCHED
}
}
namespace pg8 {
struct EpiZ {
    static constexpr bool PERM = true, AFTER_DRAIN = false;
    bf16_t* Z; bf16_t* G;
    __device__ __forceinline__ void operator()(const f32x4 (&acc)[2][2][4][2], const Unit& u, int wr, int wc, int fr, int fq) const {
        const int row0 = u.pm * BM + wr * 64 + fr, colt = u.pn * BM; const bool gate = colt >= NZ;
        bf16_t* base = gate ? G : Z; const int ld = gate ? NGATE : NZ; const int col0 = (gate ? colt - NZ : colt) + wc * 32 + 8 * fq;
#pragma unroll
        for (int ai = 0; ai < 2; ++ai)
#pragma unroll
            for (int m = 0; m < 4; ++m) { bf16_t* rowp = base + (size_t)(row0 + ai * HALF + m * 16) * ld + col0;
#pragma unroll
                for (int bj = 0; bj < 2; ++bj) { f32x4 v0 = acc[ai][bj][m][0], v1 = acc[ai][bj][m][1];
                    if (gate) {
#pragma unroll
                        for (int e = 0; e < 4; ++e) { v0[e] = sigmoidf_(v0[e]); v1[e] = sigmoidf_(v1[e]); } }
                    ::u32x4 w; w.x = pk2(v0[0], v0[1]); w.y = pk2(v0[2], v0[3]); w.z = pk2(v1[0], v1[1]); w.w = pk2(v1[2], v1[3]);
                    *(::u32x4*)(rowp + bj * HALF) = w; } }
    }
};
template <bool FIRST> struct EpiGate {
    static constexpr bool PERM = true, AFTER_DRAIN = false;
    const bf16_t* G; bf16_t* Y;
    __device__ __forceinline__ void operator()(const f32x4 (&acc)[2][2][4][2], const Unit& u, int wr, int wc, int fr, int fq) const {
        const int row0 = u.pm * BM + wr * 64 + fr, col0 = u.pn * BM + wc * 32 + 8 * fq;
#pragma unroll
        for (int ai = 0; ai < 2; ++ai)
#pragma unroll
            for (int m = 0; m < 4; ++m) { const size_t row = (size_t)(row0 + ai * HALF + m * 16);
#pragma unroll
                for (int bj = 0; bj < 2; ++bj) { const f32x4 v0 = acc[ai][bj][m][0], v1 = acc[ai][bj][m][1];
                    const ::u32x4 g = *(const ::u32x4*)(G + row * NGATE + col0 + bj * HALF);
                    float o[8] = { bf_lo(g.x) * v0[0], bf_hi(g.x) * v0[1], bf_lo(g.y) * v0[2], bf_hi(g.y) * v0[3], bf_lo(g.z) * v1[0], bf_hi(g.z) * v1[1], bf_lo(g.w) * v1[2], bf_hi(g.w) * v1[3] };
                    bf16_t* yp = Y + row * DM + col0 + bj * HALF;
                    if (!FIRST) { const ::u32x4 y = *(const ::u32x4*)yp;
                        o[0] += bf_lo(y.x); o[1] += bf_hi(y.x); o[2] += bf_lo(y.y); o[3] += bf_hi(y.y); o[4] += bf_lo(y.z); o[5] += bf_hi(y.z); o[6] += bf_lo(y.w); o[7] += bf_hi(y.w); }
                    ::u32x4 w; w.x = pk2(o[0], o[1]); w.y = pk2(o[2], o[3]); w.z = pk2(o[4], o[5]); w.w = pk2(o[6], o[7]);
                    *(::u32x4*)yp = w; } }
    }
};
struct EpiR {
    static constexpr bool PERM = true, AFTER_DRAIN = false;
    const float* X; const float* MOD; float* R;
    __device__ __forceinline__ void operator()(const f32x4 (&acc)[2][2][4][2], const Unit& u, int wr, int wc, int fr, int fq) const {
        const int row0 = u.pm * BM + wr * 64 + fr, col0 = u.pn * BM + wc * 32 + 8 * fq;
        const float* gt = MOD + (size_t)((u.pm * BM) / SEQ) * MODW + 2 * DM;
        f32x4 g[2][2];
#pragma unroll
        for (int bj = 0; bj < 2; ++bj) { g[bj][0] = *(const f32x4*)(gt + col0 + bj * HALF); g[bj][1] = *(const f32x4*)(gt + col0 + bj * HALF + 4); }
#pragma unroll
        for (int ai = 0; ai < 2; ++ai)
#pragma unroll
            for (int m = 0; m < 4; ++m) { const size_t off = (size_t)(row0 + ai * HALF + m * 16) * DM + col0;
#pragma unroll
                for (int bj = 0; bj < 2; ++bj) {
                    const f32x4 x0 = *(const f32x4*)(X + off + bj * HALF), x1 = *(const f32x4*)(X + off + bj * HALF + 4);
                    *(f32x4*)(R + off + bj * HALF) = x0 * ALPHA_RES + g[bj][0] * acc[ai][bj][m][0];
                    *(f32x4*)(R + off + bj * HALF + 4) = x1 * ALPHA_RES + g[bj][1] * acc[ai][bj][m][1]; } }
    }
};
struct EpiStore {
    static constexpr bool PERM = true, AFTER_DRAIN = false;
    bf16_t* O;
    __device__ __forceinline__ void operator()(const f32x4 (&acc)[2][2][4][2], const Unit& u, int wr, int wc, int fr, int fq) const {
        const int row0 = u.pm * BM + wr * 64 + fr, col0 = u.pn * BM + wc * 32 + 8 * fq;
#pragma unroll
        for (int ai = 0; ai < 2; ++ai)
#pragma unroll
            for (int m = 0; m < 4; ++m) { bf16_t* rowp = O + (size_t)(row0 + ai * HALF + m * 16) * DM + col0;
#pragma unroll
                for (int bj = 0; bj < 2; ++bj) { const f32x4 v0 = acc[ai][bj][m][0], v1 = acc[ai][bj][m][1];
                    ::u32x4 w; w.x = pk2(v0[0], v0[1]); w.y = pk2(v0[2], v0[3]); w.z = pk2(v1[0], v1[1]); w.w = pk2(v1[2], v1[3]);
                    *(::u32x4*)(rowp + bj * HALF) = w; } }
    }
};
}
namespace datt {
constexpr int KROW = 144;
constexpr int LDS_K = 0, LDS_V = 64 * KROW, LDS_ST = LDS_V + 64 * 256, STROW = 272, ST_WAVE = 32 * STROW, LDS_BYTES = LDS_ST + 8 * ST_WAVE;
DI unsigned vrow(unsigned key) { return (key & ~12u) | ((key & 4u) << 1) | ((key & 8u) >> 1); }

DI void attn_unit(LAS unsigned char* lds, bf16_t* Z, const float* lam, const float* subln_g, int b, int h, int qb) {
    const int tid = threadIdx.x, lane = tid & 63, r32 = lane & 31, hi = lane >> 5; const int wid = __builtin_amdgcn_readfirstlane(tid >> 6);
    const size_t rowbase = (size_t)b * SEQ;
    const int q_first = qb * 256 + wid * 32, q_me = q_first + r32;
    float lam_val;
    { const float p1 = lam[lane] * lam[64 + lane], p2 = lam[128 + lane] * lam[192 + lane]; lam_val = __expf(wave_sum(p1)) - __expf(wave_sum(p2)) + LAMBDA_INIT; }
    const int NT = 4 * (qb + 1);
    const int k_key = tid >> 3, k_ch = tid & 7;
    const int v_key0 = tid >> 4, v_ch = tid & 15;
    const unsigned tb0 = LDS_V + tr_base(lane, 0), tb1 = LDS_V + tr_base(lane, 1); unsigned q64 = ((lane & 15) >> 2) << 6;
    const unsigned kb = LDS_K + r32 * KROW + hi * 16;
#pragma unroll
    for (int m = 0; m < 2; ++m) {
        bf16x8 qf[4];
        { const bf16_t* qp = Z + (rowbase + q_me) * NZ + ZC_Q + h * 128 + m * 64 + 8 * hi;
#pragma unroll
          for (int s = 0; s < 4; ++s) qf[s] = *(const bf16x8*)(qp + 16 * s); }
        const bf16_t* ksrc = Z + (rowbase + k_key) * NZ + ZC_K + h * 128 + m * 64 + k_ch * 8;
        const bf16_t* vsrc = Z + (rowbase + v_key0) * NZ + ZC_V + h * 128 + v_ch * 8;
        f32x16 O[4];
#pragma unroll
        for (int c = 0; c < 4; ++c)
#pragma unroll
            for (int r = 0; r < 16; ++r) O[c][r] = 0.f;
        float mrun = -1e30f, lrun = 0.f;
        u32x4 pk_ = *(const u32x4*)ksrc, pv0 = *(const u32x4*)vsrc, pv1 = *(const u32x4*)(vsrc + (size_t)32 * NZ);
        for (int kt = 0; kt < NT; ++kt) {
            __syncthreads();
            *(LAS u32x4*)(lds + LDS_K + k_key * KROW + k_ch * 16) = pk_;
            *(LAS u32x4*)(lds + LDS_V + off_b(vrow(v_key0), v_ch)) = pv0;
            *(LAS u32x4*)(lds + LDS_V + off_b(vrow(v_key0 + 32), v_ch)) = pv1;
            __syncthreads();
            if (kt + 1 < NT) { const size_t o = (size_t)(kt + 1) * 64 * NZ; pk_ = *(const u32x4*)(ksrc + o); pv0 = *(const u32x4*)(vsrc + o); pv1 = *(const u32x4*)(vsrc + o + (size_t)32 * NZ); }
            if (kt * 64 > q_first + 31) continue;
            f32x16 p[2];
#pragma unroll
            for (int hf = 0; hf < 2; ++hf) {
#pragma unroll
                for (int r = 0; r < 16; ++r) p[hf][r] = 0.f;
#pragma unroll
                for (int s = 0; s < 4; ++s) { const bf16x8 a = *(const LAS bf16x8*)(lds + kb + 32 * hf * KROW + s * 32); p[hf] = MFMA32(a, qf[s], p[hf]); }
            }
            if (kt * 64 + 63 > q_first) {
#pragma unroll
                for (int hf = 0; hf < 2; ++hf)
#pragma unroll
                    for (int r = 0; r < 16; ++r) { const int key = kt * 64 + 32 * hf + crow(r, hi); if (key > q_me) p[hf][r] = -1e30f; }
            }
            float mx = p[0][0];
#pragma unroll
            for (int r = 1; r < 16; ++r) mx = fmaxf(mx, p[0][r]);
#pragma unroll
            for (int r = 0; r < 16; ++r) mx = fmaxf(mx, p[1][r]);
            mx = fmaxf(mx, __shfl_xor(mx, 32));
            const float mnew = fmaxf(mrun, mx), alpha = __builtin_amdgcn_exp2f(mrun - mnew); mrun = mnew;
            float ls = 0.f;
#pragma unroll
            for (int hf = 0; hf < 2; ++hf)
#pragma unroll
                for (int r = 0; r < 16; ++r) { const float e = __builtin_amdgcn_exp2f(p[hf][r] - mnew); p[hf][r] = e; ls += e; }
            lrun = lrun * alpha + ls;
#pragma unroll
            for (int c = 0; c < 4; ++c)
#pragma unroll
                for (int r = 0; r < 16; ++r) O[c][r] *= alpha;
            bf16x8 pf[4];
            pf[0] = pack_step(p[0], 0); pf[1] = pack_step(p[0], 1); pf[2] = pack_step(p[1], 0); pf[3] = pack_step(p[1], 1);
#pragma unroll
            for (int c = 0; c < 4; ++c) { OPAQUE(q64); const unsigned cx = (64u * c) ^ q64;
#pragma unroll
                for (int ks = 0; ks < 4; ++ks) {
                    const s16x4 lo = tr_read(lds + tb0 + cx + 4096 * ks), hi4 = tr_read(lds + tb1 + cx + 4096 * ks);
                    O[c] = MFMA32(cat8(lo, hi4), pf[ks], O[c]);
                } }
        }
        const float ltot = lrun + __shfl_xor(lrun, 32), inv = 1.0f / ltot;
        if (m == 0) {
            LAS unsigned char* stg = lds + LDS_ST + wid * ST_WAVE;
#pragma unroll
            for (int c = 0; c < 4; ++c)
#pragma unroll
                for (int g4 = 0; g4 < 4; ++g4) { const int dv0 = 32 * c + 8 * g4 + 4 * hi;
                    u32x2 w; w.x = pk2(O[c][4 * g4] * inv, O[c][4 * g4 + 1] * inv); w.y = pk2(O[c][4 * g4 + 2] * inv, O[c][4 * g4 + 3] * inv);
                    *(LAS u32x2*)(stg + r32 * STROW + dv0 * 2) = w; }
        } else {
            const float li = lam_val * inv;
            float ss = 0.f;
            LAS unsigned char* stg = lds + LDS_ST + wid * ST_WAVE;
#pragma unroll
            for (int c = 0; c < 4; ++c)
#pragma unroll
                for (int g4 = 0; g4 < 4; ++g4) { const int dv0 = 32 * c + 8 * g4 + 4 * hi; const u32x2 k2 = *(const LAS u32x2*)(stg + r32 * STROW + dv0 * 2);
                    O[c][4 * g4] = bf_lo(k2.x) - li * O[c][4 * g4]; O[c][4 * g4 + 1] = bf_hi(k2.x) - li * O[c][4 * g4 + 1]; O[c][4 * g4 + 2] = bf_lo(k2.y) - li * O[c][4 * g4 + 2]; O[c][4 * g4 + 3] = bf_hi(k2.y) - li * O[c][4 * g4 + 3];
                    ss += (O[c][4 * g4] * O[c][4 * g4] + O[c][4 * g4 + 1] * O[c][4 * g4 + 1]) + (O[c][4 * g4 + 2] * O[c][4 * g4 + 2] + O[c][4 * g4 + 3] * O[c][4 * g4 + 3]); }
            ss += __shfl_xor(ss, 32);
            const float rstd = rsqrtf(ss * (1.0f / 128.0f) + LN_EPS) * (1.0f - LAMBDA_INIT);
#pragma unroll
            for (int c = 0; c < 4; ++c)
#pragma unroll
                for (int g4 = 0; g4 < 4; ++g4) { const int dv0 = 32 * c + 8 * g4 + 4 * hi; const f32x4 gg = *(const f32x4*)(subln_g + dv0);
                    u32x2 w; w.x = pk2(O[c][4 * g4] * rstd * gg[0], O[c][4 * g4 + 1] * rstd * gg[1]); w.y = pk2(O[c][4 * g4 + 2] * rstd * gg[2], O[c][4 * g4 + 3] * rstd * gg[3]);
                    *(LAS u32x2*)(stg + r32 * STROW + dv0 * 2) = w; }
        }
    }
    LAS unsigned char* stg = lds + LDS_ST + wid * ST_WAVE;
    asm volatile("s_waitcnt lgkmcnt(0)" ::: "memory");
    bf16_t* obase = Z + (rowbase + q_first) * NZ + ZC_Q + h * 128;
#pragma unroll
    for (int i = 0; i < 8; ++i) { const int idx = lane + 64 * i, row = idx >> 4, ch = idx & 15;
        const u32x4 v = *(const LAS u32x4*)(stg + row * STROW + ch * 16); *(u32x4*)(obase + (size_t)row * NZ + ch * 8) = v; }
}
}
namespace mls {
constexpr int QI = 0, KI = 32768, VI = 65536, SC = 131072;
constexpr int F_IG = 0, F_LF = 128, F_A = 256, F_M = 384, F_INTER = 512, F_EMT = 640, F_W = 768, F_DEN = 896, F_N = 1024, F_MISC = 1152,
              F_NQ2P = 1280, F_NQ1P = 1792, F_NP = 2304, F_RSQ = 2816, F_END = 3840;
constexpr int LDS_BYTES = SC + F_END * 4;
static_assert(LDS_BYTES <= 147456, "mLSTM LDS");

DI float scan_add(float x, int lane) {
#pragma unroll
    for (int o = 1; o < 64; o <<= 1) { const float y = __shfl_up(x, o); if (lane >= o) x += y; }
    return x;
}
DI float scan_max(float x, int lane) {
#pragma unroll
    for (int o = 1; o < 64; o <<= 1) { const float y = __shfl_up(x, o); if (lane >= o) x = fmaxf(x, y); }
    return x;
}
DI float log_sigmoid(float x) { return fminf(x, 0.f) - __logf(1.0f + __expf(-fabsf(x))); }

DI void mlstm_unit(LAS unsigned char* lds, bf16_t* Z, const float* GIF, const float* conv_w, const float* conv_b, const float* norm_g, int b, int hd) {
    const int tid = threadIdx.x, lane = tid & 63; const int wid = __builtin_amdgcn_readfirstlane(tid >> 6);
    LAS float* sc = (LAS float*)(lds + SC);
#define MLS_LV unsigned L_ = lane; OPAQUE(L_); const unsigned r32 = L_ & 31, hi = L_ >> 5, rowb = 256u * r32, f16 = (((r32 & 3) << 2) | ((r32 >> 2) & 3)) << 4, q64 = ((L_ & 15) >> 2) << 6; (void)rowb; (void)f16; (void)q64; (void)hi
    f32x16 CT[4];
#pragma unroll
    for (int i = 0; i < 4; ++i)
#pragma unroll
        for (int r = 0; r < 16; ++r) CT[i][r] = 0.f;
    float m_prev = 0.f;
    if (tid < 128) sc[F_N + tid] = 0.f;
    const int img = wid >> 2, vc = wid & 3;
    const int st_i = wid >> 1, st_j0 = 2 * (wid & 1);

    for (int c = 0; c < 16; ++c) {
        const size_t t0 = (size_t)b * SEQ + (size_t)c * 128;
        __syncthreads();
        {
            int tq = tid; OPAQUE(tq);
            const int c_mat = tq >> 8, c_ch = tq & 15, c_rg = (tq >> 4) & 15;
            const int chan0 = c_mat * 512 + hd * 128 + c_ch * 8;
            const float kscale = c_mat ? 0.08838834764831845f : 1.0f;
            float cw[4][8], cb[8];
            { const float* cwp = conv_w + chan0; const float* cbp = conv_b + chan0; asm volatile("" : "+v"(cwp), "+v"(cbp));
#pragma unroll
              for (int j = 0; j < 4; ++j) { const f32x4 a = *(const f32x4*)(cwp + j * 1024), c4 = *(const f32x4*)(cwp + j * 1024 + 4);
                cw[j][0] = a[0]; cw[j][1] = a[1]; cw[j][2] = a[2]; cw[j][3] = a[3]; cw[j][4] = c4[0]; cw[j][5] = c4[1]; cw[j][6] = c4[2]; cw[j][7] = c4[3]; }
              const f32x4 a = *(const f32x4*)cbp, c4 = *(const f32x4*)(cbp + 4); cb[0] = a[0]; cb[1] = a[1]; cb[2] = a[2]; cb[3] = a[3]; cb[4] = c4[0]; cb[5] = c4[1]; cb[6] = c4[2]; cb[7] = c4[3]; }
            const bf16_t* src = Z + (t0 + c_rg * 8) * NZ + (c_mat ? ZC_MK : ZC_MQ) + hd * 128 + c_ch * 8;
            float win[3][8];
#pragma unroll
            for (int j = 0; j < 3; ++j) {
                const int lp = c * 128 + c_rg * 8 - 3 + j;
                u32x4 raw = {0u, 0u, 0u, 0u};
                if (lp >= 0) raw = *(const u32x4*)(src + (ptrdiff_t)(j - 3) * NZ);
                win[j][0] = bf_lo(raw.x); win[j][1] = bf_hi(raw.x); win[j][2] = bf_lo(raw.y); win[j][3] = bf_hi(raw.y); win[j][4] = bf_lo(raw.z); win[j][5] = bf_hi(raw.z); win[j][6] = bf_lo(raw.w); win[j][7] = bf_hi(raw.w);
            }
#pragma unroll 2
            for (int i = 0; i < 8; ++i) {
                const u32x4 raw = *(const u32x4*)(src + (size_t)i * NZ);
                float cur[8] = { bf_lo(raw.x), bf_hi(raw.x), bf_lo(raw.y), bf_hi(raw.y), bf_lo(raw.z), bf_hi(raw.z), bf_lo(raw.w), bf_hi(raw.w) };
                float o[8];
#pragma unroll
                for (int e = 0; e < 8; ++e) { const float y = cb[e] + cw[0][e] * win[0][e] + cw[1][e] * win[1][e] + cw[2][e] * win[2][e] + cw[3][e] * cur[e]; o[e] = siluf_(y) * kscale; }
#pragma unroll
                for (int e = 0; e < 8; ++e) { win[0][e] = win[1][e]; win[1][e] = win[2][e]; win[2][e] = cur[e]; }
                u32x4 w; w.x = pk2(o[0], o[1]); w.y = pk2(o[2], o[3]); w.z = pk2(o[4], o[5]); w.w = pk2(o[6], o[7]);
                *(LAS u32x4*)(lds + (c_mat ? KI : QI) + off_b(c_rg * 8 + i, c_ch)) = w;
            }
        }
        { int tq = tid; OPAQUE(tq);
#pragma unroll
        for (int i = 0; i < 8; ++i) { const int idx = tq + 512 * i, row = idx >> 5, ch32 = idx & 31;
            const u32x4 raw = *(const u32x4*)(Z + (t0 + row) * NZ + ZC_MV + hd * 256 + ch32 * 8);
            *(LAS u32x4*)(lds + VI + (ch32 >> 4) * 32768 + off_b(row, ch32 & 15)) = raw; } }
        if (tid < 128) { const float* g = GIF + (t0 + tid) * 8; sc[F_IG + tid] = g[hd]; sc[F_LF + tid] = log_sigmoid(g[4 + hd]);
            if (c > 0) sc[F_N + tid] = sc[F_MISC + 1] * sc[F_N + tid] + (sc[F_NP + tid] + sc[F_NP + 128 + tid]) + (sc[F_NP + 256 + tid] + sc[F_NP + 384 + tid]); }
        __syncthreads();
        if (wid == 0) {
            const float ig0 = sc[F_IG + 2 * lane], ig1 = sc[F_IG + 2 * lane + 1], lf0 = sc[F_LF + 2 * lane], lf1 = sc[F_LF + 2 * lane + 1];
            const float s2 = lf0 + lf1, incl = scan_add(s2, lane), excl = incl - s2;
            const float b0 = excl + lf0, b1 = incl, a0 = ig0 - b0, a1 = ig1 - b1;
            const float im = scan_max(fmaxf(a0, a1), lane); float em = __shfl_up(im, 1); if (lane == 0) em = -3.0e38f;
            const float cm0 = fmaxf(em, a0), cm1 = im;
            const float M0 = fmaxf(m_prev, cm0), M1 = fmaxf(m_prev, cm1);
            const float ML = __shfl(M1, 63), bL = __shfl(b1, 63);
            sc[F_A + 2 * lane] = a0; sc[F_A + 2 * lane + 1] = a1; sc[F_M + 2 * lane] = M0; sc[F_M + 2 * lane + 1] = M1;
            sc[F_INTER + 2 * lane] = __expf(m_prev - M0); sc[F_INTER + 2 * lane + 1] = __expf(m_prev - M1);
            sc[F_EMT + 2 * lane] = __expf(-(b0 + M0)); sc[F_EMT + 2 * lane + 1] = __expf(-(b1 + M1));
            sc[F_W + 2 * lane] = __expf(a0 - ML); sc[F_W + 2 * lane + 1] = __expf(a1 - ML);
            if (lane == 0) sc[F_MISC + 0] = __expf(m_prev - ML);
            m_prev = bL + ML;
        }
        f32x16 sT[2];
#pragma unroll
        for (int jj = 0; jj < 2; ++jj) {
#pragma unroll
            for (int r = 0; r < 16; ++r) sT[jj][r] = 0.f;
            const int j = st_j0 + jj;
            if (j <= st_i) { MLS_LV; const unsigned fh = (16u * hi) ^ f16;
#pragma unroll
                for (int ks = 0; ks < 8; ++ks) { const unsigned xo = rowb + ((32u * ks) ^ fh);
                    const bf16x8 a = *(const LAS bf16x8*)(lds + KI + 8192 * j + xo), q = *(const LAS bf16x8*)(lds + QI + 8192 * st_i + xo);
                    sT[jj] = MFMA32(a, q, sT[jj]); }
            }
        }
        __syncthreads();
        u32x2 pp[2][4];
        { MLS_LV; const int t = 32 * st_i + r32; const float Mt = sc[F_M + t]; const unsigned ab = SC + 4 * F_A + 128 * st_j0 + 16 * hi;
#pragma unroll
          for (int jj = 0; jj < 2; ++jj) { const int j = st_j0 + jj;
#pragma unroll
            for (int g4 = 0; g4 < 4; ++g4) { const int s0 = 32 * j + 8 * g4 + 4 * hi; float pv[4];
#pragma unroll
                for (int e = 0; e < 4; ++e) { const int s = s0 + e; pv[e] = (s <= t) ? __expf(*(const LAS float*)(lds + ab + 4 * (32 * jj + 8 * g4 + e)) - Mt) * sT[jj][4 * g4 + e] : 0.f; }
                pp[jj][g4].x = pk2(pv[0], pv[1]); pp[jj][g4].y = pk2(pv[2], pv[3]); } } }
        f32x16 acc[4];
#pragma unroll
        for (int ti = 0; ti < 4; ++ti)
#pragma unroll
            for (int r = 0; r < 16; ++r) acc[ti][r] = 0.f;
        if (c > 0) {
#pragma unroll
            for (int dt = 0; dt < 4; ++dt)
#pragma unroll
                for (int s2 = 0; s2 < 2; ++s2) { const bf16x8 bfr = pack_step(CT[dt], s2); MLS_LV;
                    const unsigned a0 = QI + rowb + 8 * hi + ((64u * dt + 32u * s2) ^ f16), a1 = QI + rowb + 8 * hi + ((64u * dt + 32u * s2 + 16u) ^ f16);
#pragma unroll
                    for (int ti = 0; ti < 4; ++ti) {
                        const s16x4 lo = *(const LAS s16x4*)(lds + a0 + 8192 * ti), hi4 = *(const LAS s16x4*)(lds + a1 + 8192 * ti);
                        acc[ti] = MFMA32(cat8(lo, hi4), bfr, acc[ti]); }
                    __builtin_amdgcn_sched_barrier(0); }
        }
        { int tq = tid; OPAQUE(tq); const int t = tq & 127, part = tq >> 7; float d = 0.f;
#pragma unroll
          for (int cc = 0; cc < 4; ++cc) { const int ch = 4 * part + cc; const u32x4 raw = *(const LAS u32x4*)(lds + QI + off_b(t, ch)); const LAS float* nn = sc + F_N + 8 * ch;
              d += bf_lo(raw.x) * nn[0] + bf_hi(raw.x) * nn[1] + bf_lo(raw.y) * nn[2] + bf_hi(raw.y) * nn[3] + bf_lo(raw.z) * nn[4] + bf_hi(raw.z) * nn[5] + bf_lo(raw.w) * nn[6] + bf_hi(raw.w) * nn[7]; }
          sc[F_NQ2P + part * 128 + t] = d; }
        __syncthreads();
        { MLS_LV; const unsigned ib = SC + 4 * F_INTER + 16 * hi;
#pragma unroll
          for (int ti = 0; ti < 4; ++ti)
#pragma unroll
            for (int r = 0; r < 16; ++r) acc[ti][r] *= *(const LAS float*)(lds + ib + 4 * (32 * ti + (r & 3) + 8 * (r >> 2))); }
        { MLS_LV;
#pragma unroll
          for (int jj = 0; jj < 2; ++jj) { const int j = st_j0 + jj;
#pragma unroll
            for (int g4 = 0; g4 < 4; ++g4) *(LAS u32x2*)(lds + QI + 8192 * st_i + rowb + 8 * hi + ((64u * j + 16u * g4) ^ f16)) = pp[jj][g4]; } }
        { int tq = tid; OPAQUE(tq);
#pragma unroll
        for (int i = 0; i < 4; ++i) { const int idx = tq + 512 * i, row = idx >> 4, ch = idx & 15; LAS u32x4* p = (LAS u32x4*)(lds + KI + off_b(row, ch)); const u32x4 raw = *p; const float w = sc[F_W + row];
            u32x4 o; o.x = pk2(bf_lo(raw.x) * w, bf_hi(raw.x) * w); o.y = pk2(bf_lo(raw.y) * w, bf_hi(raw.y) * w); o.z = pk2(bf_lo(raw.z) * w, bf_hi(raw.z) * w); o.w = pk2(bf_lo(raw.w) * w, bf_hi(raw.w) * w); *p = o; } }
        __syncthreads();
        { const float decay = sc[F_MISC + 0];
#pragma unroll
          for (int dt = 0; dt < 4; ++dt)
#pragma unroll
            for (int r = 0; r < 16; ++r) CT[dt][r] *= decay; }
#pragma unroll
        for (int ks = 0; ks < 8; ++ks) {
            MLS_LV;
            const unsigned tbv0 = VI + img * 32768 + tr_base(L_, 0) + ((64u * vc) ^ q64), tbv1 = VI + img * 32768 + tr_base(L_, 1) + ((64u * vc) ^ q64);
            const unsigned tbk0 = KI + tr_base(L_, 0), tbk1 = KI + tr_base(L_, 1);
            const bf16x8 bv = cat8(tr_read(lds + tbv0 + 4096 * ks), tr_read(lds + tbv1 + 4096 * ks));
            const unsigned xo = QI + rowb + ((32u * ks) ^ ((16u * hi) ^ f16));
#pragma unroll
            for (int ti = 0; ti < 4; ++ti) if (ks < 2 * (ti + 1)) { const bf16x8 a = *(const LAS bf16x8*)(lds + xo + 8192 * ti); acc[ti] = MFMA32(a, bv, acc[ti]); }
#pragma unroll
            for (int dt = 0; dt < 4; ++dt) { const unsigned cx = (64u * dt) ^ q64; const bf16x8 a = cat8(tr_read(lds + tbk0 + 4096 * ks + cx), tr_read(lds + tbk1 + 4096 * ks + cx)); CT[dt] = MFMA32(a, bv, CT[dt]); }
            __builtin_amdgcn_sched_barrier(0);
        }
        { int tq = tid; OPAQUE(tq); const int t = tq & 127, part = tq >> 7; float d = 0.f;
#pragma unroll
          for (int cc = 0; cc < 4; ++cc) { const u32x4 raw = *(const LAS u32x4*)(lds + QI + off_b(t, 4 * part + cc));
              d += (bf_lo(raw.x) + bf_hi(raw.x)) + (bf_lo(raw.y) + bf_hi(raw.y)) + (bf_lo(raw.z) + bf_hi(raw.z)) + (bf_lo(raw.w) + bf_hi(raw.w)); }
          sc[F_NQ1P + part * 128 + t] = d;
          float nn = 0.f;
          for (int s = 32 * part; s < 32 * part + 32; ++s) nn += bf2f(*(const LAS bf16_t*)(lds + KI + off_b(s, t >> 3) + (t & 7) * 2));
          sc[F_NP + part * 128 + t] = nn;
          if (tid == 0) sc[F_MISC + 1] = sc[F_MISC + 0]; }
        __syncthreads();
        if (tid < 128) { const float nq1 = (sc[F_NQ1P + tid] + sc[F_NQ1P + 128 + tid]) + (sc[F_NQ1P + 256 + tid] + sc[F_NQ1P + 384 + tid]);
            const float nq2 = (sc[F_NQ2P + tid] + sc[F_NQ2P + 128 + tid]) + (sc[F_NQ2P + 256 + tid] + sc[F_NQ2P + 384 + tid]);
            sc[F_DEN + tid] = 1.0f / fmaxf(fabsf(nq1 + sc[F_INTER + tid] * nq2), sc[F_EMT + tid]); }
        __syncthreads();
        { MLS_LV; const unsigned db = SC + 4 * F_DEN + 16 * hi, hb = VI + 2048 * hi + (32 * wid + r32) * 2, qb = SC + 4 * (F_RSQ + wid * 128) + 16 * hi;
#pragma unroll
          for (int ti = 0; ti < 4; ++ti)
#pragma unroll
            for (int r = 0; r < 16; ++r) { const int tt = 32 * ti + (r & 3) + 8 * (r >> 2); const float x = acc[ti][r] * *(const LAS float*)(lds + db + 4 * tt);
                *(LAS bf16_t*)(lds + hb + 512 * tt) = (bf16_t)(pk2(x, 0.f) & 0xffffu);
                float q = x * x; q += __shfl_xor(q, 1); q += __shfl_xor(q, 2); q += __shfl_xor(q, 4); q += __shfl_xor(q, 8); q += __shfl_xor(q, 16);
                if (r32 == 0) *(LAS float*)(lds + qb + 4 * tt) = q; } }
        __syncthreads();
        { int tq = tid; OPAQUE(tq);
#pragma unroll 2
        for (int i = 0; i < 8; ++i) { const int idx = tq + 512 * i, row = idx >> 5, ch = idx & 31;
            float ssq = 0.f;
#pragma unroll
            for (int w = 0; w < 8; ++w) ssq += sc[F_RSQ + w * 128 + row];
            const float rstd = rsqrtf(ssq * (1.0f / 256.0f) + LN_EPS);
            const u32x4 hraw = *(const LAS u32x4*)(lds + VI + row * 512 + ch * 16);
            bf16_t* gp = Z + (t0 + row) * NZ + hd * 256 + ch * 8;
            const u32x4 oraw = *(const u32x4*)(gp + ZC_MO);
            const f32x4 g0 = *(const f32x4*)(norm_g + hd * 256 + ch * 8), g1 = *(const f32x4*)(norm_g + hd * 256 + ch * 8 + 4);
            u32x4 o;
            o.x = pk2(bf_lo(hraw.x) * rstd * g0[0] * sigmoidf_(bf_lo(oraw.x)), bf_hi(hraw.x) * rstd * g0[1] * sigmoidf_(bf_hi(oraw.x)));
            o.y = pk2(bf_lo(hraw.y) * rstd * g0[2] * sigmoidf_(bf_lo(oraw.y)), bf_hi(hraw.y) * rstd * g0[3] * sigmoidf_(bf_hi(oraw.y)));
            o.z = pk2(bf_lo(hraw.z) * rstd * g1[0] * sigmoidf_(bf_lo(oraw.z)), bf_hi(hraw.z) * rstd * g1[1] * sigmoidf_(bf_hi(oraw.z)));
            o.w = pk2(bf_lo(hraw.w) * rstd * g1[2] * sigmoidf_(bf_lo(oraw.w)), bf_hi(hraw.w) * rstd * g1[3] * sigmoidf_(bf_hi(oraw.w)));
            *(u32x4*)(gp + ZC_MV) = o; } }
    }
    __syncthreads();
}
#undef MLS_LV
}
namespace peer {
constexpr int KROW = 144;
constexpr int L_KEYS = 0, L_SELE = 2 * 128 * KROW, L_SELG = L_SELE + 32 * 128 * 2, L_IDX = L_SELG + 32 * 128 * 4, LDS_BYTES = L_IDX + 512 * 32;
DI unsigned ordf(float f) { const unsigned u = __float_as_uint(f); return u ^ ((unsigned)((int)u >> 31) | 0x80000000u); }
DI float deord(unsigned k) { return __uint_as_float(k ^ ((~(unsigned)((int)k >> 31)) | 0x80000000u)); }
DI void ins16(unsigned (&L)[16], unsigned v) {
#pragma unroll
    for (int j = 0; j < 16; ++j) { const unsigned t = L[j] > v ? L[j] : v; v = L[j] > v ? v : L[j]; L[j] = t; }
}
DI float dot2bf(unsigned a, unsigned b, float c) { return __builtin_amdgcn_fdot2_f32_bf16(__builtin_bit_cast(bf16x2_t, a), __builtin_bit_cast(bf16x2_t, b), c, false); }
DI float gelu_erf(float x) { return 0.5f * x * (1.0f + erff(x * 0.7071067811865476f)); }

DI void stage_keys(LAS unsigned char* lds, const float* keys) {
    for (int i = threadIdx.x; i < 2 * 128 * 8; i += 512) { const int row = i >> 3, ch = i & 7; const float* s = keys + row * 64 + ch * 8;
        const f32x4 a = *(const f32x4*)s, b = *(const f32x4*)(s + 4);
        u32x4 w; w.x = pk2(a[0], a[1]); w.y = pk2(a[2], a[3]); w.z = pk2(b[0], b[1]); w.w = pk2(b[2], b[3]);
        *(LAS u32x4*)(lds + L_KEYS + row * KROW + ch * 16) = w; }
}

DI void select_tile(LAS unsigned char* lds, const bf16_t* QP, int tok0) {
    const int tid = threadIdx.x, lane = tid & 63, r32 = lane & 31, hi = lane >> 5; const int wid = __builtin_amdgcn_readfirstlane(tid >> 6);
    unsigned LA[16], LB[16];
#pragma unroll
    for (int p = 0; p < 2; ++p) {
        unsigned L[16];
#pragma unroll
        for (int i = 0; i < 16; ++i) L[i] = 0u;
        bf16x8 qf[4];
        { const bf16_t* qp = QP + (size_t)(tok0 + r32) * DM + wid * 128 + p * 64 + 8 * hi;
#pragma unroll
          for (int s = 0; s < 4; ++s) qf[s] = *(const bf16x8*)(qp + 16 * s); }
#pragma unroll
        for (int nt = 0; nt < 4; ++nt) {
            f32x16 acc;
#pragma unroll
            for (int r = 0; r < 16; ++r) acc[r] = 0.f;
#pragma unroll
            for (int s = 0; s < 4; ++s) { const bf16x8 a = *(const LAS bf16x8*)(lds + L_KEYS + (p * 128 + 32 * nt + r32) * KROW + (2 * s + hi) * 16); acc = MFMA32(a, qf[s], acc); }
#pragma unroll
            for (int r = 0; r < 16; ++r) ins16(L, (ordf(acc[r]) & ~0x7Fu) | (unsigned)(32 * nt + crow(r, hi)));
        }
        unsigned O[16];
#pragma unroll
        for (int i = 0; i < 16; ++i) O[i] = L[i];
#pragma unroll
        for (int i = 0; i < 16; ++i) ins16(L, (unsigned)__shfl_xor((int)O[i], 32));
#pragma unroll
        for (int i = 0; i < 16; ++i) { if (p == 0) LA[i] = L[i]; else LB[i] = L[i]; }
    }
    unsigned CL[16];
#pragma unroll
    for (int i = 0; i < 16; ++i) CL[i] = 0u;
#pragma unroll
    for (int i = 0; i < 16; ++i) {
        const float sa = deord(LA[i] & ~0x7Fu);
#pragma unroll
        for (int j = 0; j < 16; ++j) if ((i + 1) * (j + 1) <= 16) { const float sb = deord(LB[j] & ~0x7Fu); ins16(CL, (ordf(sa + sb) & ~0xFFu) | (unsigned)(i * 16 + j)); }
    }
    LAS unsigned char* itab = lds + L_IDX + tid * 32;
    { u32x4 wa, wb;
#pragma unroll
      for (int q = 0; q < 4; ++q) { wa[q] = (LA[4 * q] & 0x7Fu) | ((LA[4 * q + 1] & 0x7Fu) << 8) | ((LA[4 * q + 2] & 0x7Fu) << 16) | ((LA[4 * q + 3] & 0x7Fu) << 24);
                                    wb[q] = (LB[4 * q] & 0x7Fu) | ((LB[4 * q + 1] & 0x7Fu) << 8) | ((LB[4 * q + 2] & 0x7Fu) << 16) | ((LB[4 * q + 3] & 0x7Fu) << 24); }
      *(LAS u32x4*)itab = wa; *(LAS u32x4*)(itab + 16) = wb; }
    const float mx = deord(CL[0] & ~0xFFu);
    float ev[16], sum = 0.f;
#pragma unroll
    for (int k = 0; k < 16; ++k) { ev[k] = __expf(deord(CL[k] & ~0xFFu) - mx); sum += ev[k]; }
    const float inv = 1.0f / sum;
    LAS bf16_t* se = (LAS bf16_t*)(lds + L_SELE) + r32 * 128 + wid * 16;
    LAS float* sg = (LAS float*)(lds + L_SELG) + r32 * 128 + wid * 16;
#pragma unroll
    for (int k = 0; k < 16; ++k) if ((k >> 3) == hi) { const unsigned code = CL[k] & 0xFFu; const unsigned n1 = itab[code >> 4], n2 = itab[16 + (code & 15u)];
        se[k] = (bf16_t)(n1 * 128u + n2); sg[k] = ev[k] * inv; }
}

DI void eval_token(LAS unsigned char* lds, int tk, size_t tok, const bf16_t* H2, const bf16_t* U, const bf16_t* V, const float* X1, const float* MOD, const float* ln_g, const float* ln_b, float* OUT) {
    const int lane = threadIdx.x & 63;
    unsigned hp[8];
    { const u32x4 a = *(const u32x4*)(H2 + tok * DM + 16 * lane), b = *(const u32x4*)(H2 + tok * DM + 16 * lane + 8);
      hp[0] = a.x; hp[1] = a.y; hp[2] = a.z; hp[3] = a.w; hp[4] = b.x; hp[5] = b.y; hp[6] = b.z; hp[7] = b.w; }
    float yf[16];
#pragma unroll
    for (int i = 0; i < 16; ++i) yf[i] = 0.f;
    const LAS bf16_t* se = (const LAS bf16_t*)(lds + L_SELE) + tk * 128;
    const LAS float* sg = (const LAS float*)(lds + L_SELG) + tk * 128;
    for (int g = 0; g < 32; ++g) {
        u32x4 ur[4][2], vr[4][2]; float gk[4];
#pragma unroll
        for (int kk = 0; kk < 4; ++kk) { const unsigned e = (unsigned)__builtin_amdgcn_readfirstlane((int)se[4 * g + kk]); gk[kk] = sg[4 * g + kk];
            const bf16_t* up = U + (size_t)e * DM + 16 * lane; const bf16_t* vp = V + (size_t)e * DM + 16 * lane;
            ur[kk][0] = *(const u32x4*)up; ur[kk][1] = *(const u32x4*)(up + 8); vr[kk][0] = *(const u32x4*)vp; vr[kk][1] = *(const u32x4*)(vp + 8); }
#pragma unroll
        for (int kk = 0; kk < 4; ++kk) {
            float d0 = 0.f, d1 = 0.f;
            d0 = dot2bf(ur[kk][0].x, hp[0], d0); d1 = dot2bf(ur[kk][0].y, hp[1], d1); d0 = dot2bf(ur[kk][0].z, hp[2], d0); d1 = dot2bf(ur[kk][0].w, hp[3], d1);
            d0 = dot2bf(ur[kk][1].x, hp[4], d0); d1 = dot2bf(ur[kk][1].y, hp[5], d1); d0 = dot2bf(ur[kk][1].z, hp[6], d0); d1 = dot2bf(ur[kk][1].w, hp[7], d1);
            const float s = wave_sum(d0 + d1);
            const float coef = gk[kk] * gelu_erf(s);
            const unsigned cb = pk2(coef, 0.f), clo = cb & 0xffffu, chi = cb << 16;
            const unsigned vv[8] = { vr[kk][0].x, vr[kk][0].y, vr[kk][0].z, vr[kk][0].w, vr[kk][1].x, vr[kk][1].y, vr[kk][1].z, vr[kk][1].w };
#pragma unroll
            for (int i = 0; i < 8; ++i) { yf[2 * i] = dot2bf(vv[i], clo, yf[2 * i]); yf[2 * i + 1] = dot2bf(vv[i], chi, yf[2 * i + 1]); }
        }
    }
    const int b = (int)(tok / SEQ);
    const float* xr = X1 + tok * DM + 16 * lane; const float* gt = MOD + (size_t)b * MODW + 5 * DM + 16 * lane;
    float r[16]; float s1 = 0.f;
#pragma unroll
    for (int j = 0; j < 4; ++j) { const f32x4 x = *(const f32x4*)(xr + 4 * j), g4 = *(const f32x4*)(gt + 4 * j);
#pragma unroll
        for (int e = 0; e < 4; ++e) { r[4 * j + e] = ALPHA_RES * x[e] + g4[e] * yf[4 * j + e]; s1 += r[4 * j + e]; } }
    const float mean = wave_sum(s1) * (1.0f / DM); float s2 = 0.f;
#pragma unroll
    for (int i = 0; i < 16; ++i) { r[i] -= mean; s2 += r[i] * r[i]; }
    const float rstd = rsqrtf(wave_sum(s2) * (1.0f / DM) + LN_EPS);
    float* op = OUT + tok * DM + 16 * lane;
#pragma unroll
    for (int j = 0; j < 4; ++j) { const f32x4 g4 = *(const f32x4*)(ln_g + 16 * lane + 4 * j), b4 = *(const f32x4*)(ln_b + 16 * lane + 4 * j);
        f32x4 o; o[0] = r[4 * j] * rstd * g4[0] + b4[0]; o[1] = r[4 * j + 1] * rstd * g4[1] + b4[1]; o[2] = r[4 * j + 2] * rstd * g4[2] + b4[2]; o[3] = r[4 * j + 3] * rstd * g4[3] + b4[3];
        *(f32x4*)(op + 4 * j) = o; }
}
}
constexpr int NWAVES = 8;
#ifndef MK_N_LAUNCHES
#define MK_N_LAUNCHES 1
#endif
constexpr int N_PHASES = 10;
constexpr int RING_BYTES = 147456;
constexpr int MISC_OFF = RING_BYTES;
constexpr int LDS_BYTES = RING_BYTES + 4096;
static_assert(pg8::STAGE_BYTES <= RING_BYTES && datt::LDS_BYTES <= RING_BYTES && mls::LDS_BYTES <= RING_BYTES && peer::LDS_BYTES <= RING_BYTES, "LDS map");

typedef GAS unsigned gu32;
#define RLX_AGENT __ATOMIC_RELAXED, __HIP_MEMORY_SCOPE_AGENT
#define LDS_WAIT() asm volatile("s_waitcnt lgkmcnt(0)" ::: "memory")

#define XB_TMO      128
#define XB_XCNT(j)  (256  + 64 * (j))
#define XB_XSUB(j)  (1280 + 64 * (j))
#define XB_XGEN(j)  (2304 + 64 * (j))
#define XB_TOP      3328
#define XB_TOPGEN   3392
#define XCD_BAR_WORDS 3456
#define XB_SPIN_CAP (1u << 22)
DI unsigned xb_ld(unsigned* p)              { return __hip_atomic_load(p, __ATOMIC_RELAXED, __HIP_MEMORY_SCOPE_AGENT); }
DI unsigned xb_add(unsigned* p, unsigned v) { return __hip_atomic_fetch_add(p, v, __ATOMIC_RELAXED, __HIP_MEMORY_SCOPE_AGENT); }
DI unsigned xb_xcc_id() { return (unsigned)__builtin_amdgcn_s_getreg((3 << 11) | 20) & 0xFu; }
#define XB_SPIN(cond, bar) do { unsigned _sp = 0; while (cond) { __builtin_amdgcn_s_sleep(1); \
    if ((++_sp & 255u) == 0u) { if (xb_ld(&(bar)[XB_TMO])) break; if (_sp > XB_SPIN_CAP) { atomicAdd(&(bar)[XB_TMO], 1u); break; } } } } while (0)
struct XcdBarrier { unsigned* bar; unsigned x; volatile LAS unsigned* st; };
DI XcdBarrier xcd_barrier_post(unsigned* bar, volatile LAS unsigned* st) {
    XcdBarrier b; b.bar = bar; b.x = xb_xcc_id(); b.st = st;
    if (threadIdx.x == 0) (void)xb_add(&bar[XB_XCNT(b.x)], 1u);
    return b;
}
DI void xcd_barrier_complete(unsigned* bar, unsigned x, unsigned& nloc, unsigned& nx) {
    const unsigned G = gridDim.x * gridDim.y * gridDim.z;
    unsigned sum, cnt, mine, sp = 0u;
    for (;;) {
        sum = 0u; cnt = 0u; mine = 0u;
#pragma unroll
        for (unsigned j = 0; j < 16; ++j) { const unsigned c = xb_ld(&bar[XB_XCNT(j)]); sum += c; cnt += (c > 0u) ? 1u : 0u; mine = (j == x) ? c : mine; }
        if (sum == G) break;
        __builtin_amdgcn_s_sleep(1);
        if ((++sp & 255u) == 0u) { if (xb_ld(&bar[XB_TMO])) break; if (sp > XB_SPIN_CAP) { atomicAdd(&bar[XB_TMO], 1u); break; } }
    }
    nloc = mine > 0u ? mine : 1u; nx = cnt > 0u ? cnt : 1u;
}
DI void xcd_barrier(const XcdBarrier& b) {
    asm volatile("s_waitcnt vmcnt(0)" ::: "memory");
    __syncthreads();
    if (threadIdx.x == 0) {
        unsigned* bar = b.bar;
        __builtin_amdgcn_s_waitcnt(0);
        unsigned nloc = b.st[0], nx = b.st[1];
        if (nloc == 0u) { xcd_barrier_complete(bar, b.x, nloc, nx); b.st[0] = nloc; b.st[1] = nx; }
        const unsigned old = xb_add(&bar[XB_XSUB(b.x)], 1u);
        const unsigned gen = old / nloc;
        if (old + 1u == (gen + 1u) * nloc) {
            __builtin_amdgcn_fence(__ATOMIC_RELEASE, "agent");
            asm volatile("s_waitcnt vmcnt(0)" ::: "memory");
            const unsigned og = xb_add(&bar[XB_TOP], 1u);
            const unsigned tg = og / nx;
            if (og + 1u == (tg + 1u) * nx) xb_add(&bar[XB_TOPGEN], 1u);
            else XB_SPIN(xb_ld(&bar[XB_TOPGEN]) == tg, bar);
            __builtin_amdgcn_fence(__ATOMIC_ACQUIRE, "agent");
            xb_add(&bar[XB_XGEN(b.x)], 1u);
            asm volatile("s_waitcnt vmcnt(0)" ::: "memory");
        } else {
            XB_SPIN(xb_ld(&bar[XB_XGEN(b.x)]) == gen, bar);
            __builtin_amdgcn_fence(__ATOMIC_ACQUIRE, "agent");
            asm volatile("s_waitcnt vmcnt(0)" ::: "memory");
        }
    }
    __syncthreads();
}

DI void p0_transpose_item(const float* W, int ldw, int col0, bf16_t* WT, int K, int dst_row0, int kb, float scale, LAS float* scr, int lane) {
    const int k0 = 64 * kb;
#pragma unroll 8
    for (int i = 0; i < 32; ++i) { const int kk = 2 * i + (lane >> 5); scr[kk * 33 + (lane & 31)] = W[(size_t)(k0 + kk) * ldw + col0 + (lane & 31)] * scale; }
    LDS_WAIT(); asm volatile("" ::: "memory");
    const int c = lane & 7;
#pragma unroll
    for (int j = 0; j < 4; ++j) { const int n = (lane >> 3) + 8 * j; const LAS float* s = scr + (8 * c) * 33 + n;
        u32x4 o; o.x = pk2(s[0 * 33], s[1 * 33]); o.y = pk2(s[2 * 33], s[3 * 33]); o.z = pk2(s[4 * 33], s[5 * 33]); o.w = pk2(s[6 * 33], s[7 * 33]);
        *(u32x4*)(WT + (size_t)(dst_row0 + n) * K + k0 + 8 * c) = o; }
    LDS_WAIT(); asm volatile("" ::: "memory");
}

struct Args { const float* in[22]; float* out; unsigned char* ws; int ph_lo, ph_hi; };

__global__ void __launch_bounds__(NWAVES * 64, 2) mega_fwd(Args args) {
    extern __shared__ __attribute__((aligned(16))) unsigned char lds_raw[];
    LAS unsigned char* lds = (LAS unsigned char*)lds_raw;
    volatile LAS unsigned* MISC = (volatile LAS unsigned*)(lds + MISC_OFF);
    const int tid = threadIdx.x, lane = tid & 63, wave = __builtin_amdgcn_readfirstlane(tid >> 6);
    const int G = gridDim.x; const int bx = blockIdx.x; const int vcu = (G % 8 == 0) ? (bx % 8) * (G / 8) + bx / 8 : bx;
    const int gw = vcu * NWAVES + wave, NGW = G * NWAVES;
#define ws (args.ws)
#define ctl ((unsigned*)(ws + WS_CTL))
#define x_in (args.in[0])
#define cvec (args.in[1])
#define w_ada (args.in[2])
#define b_ada (args.in[3])
#define w_in (args.in[4])
#define b_if (args.in[5])
#define conv_w (args.in[6])
#define conv_b (args.in[7])
#define da_lambda (args.in[8])
#define da_subln_g (args.in[9])
#define ml_norm_g (args.in[10])
#define w_br_attn (args.in[11])
#define w_br_mlstm (args.in[12])
#define w_out (args.in[13])
#define ln1_g (args.in[14])
#define ln1_b (args.in[15])
#define peer_wq (args.in[16])
#define peer_keys (args.in[17])
#define peer_u (args.in[18])
#define peer_v (args.in[19])
#define ln2_g (args.in[20])
#define ln2_b (args.in[21])
#define MOD ((float*)(ws + WS_MOD))
#define GIF ((float*)(ws + WS_GIF))
#define WIN ((bf16_t*)(ws + WS_WIN))
#define WA ((bf16_t*)(ws + WS_WA))
#define WM ((bf16_t*)(ws + WS_WM))
#define WOUT ((bf16_t*)(ws + WS_WOUT))
#define WQ ((bf16_t*)(ws + WS_WQ))
#define UT ((bf16_t*)(ws + WS_U))
#define VT ((bf16_t*)(ws + WS_V))
#define H1 ((bf16_t*)(ws + WS_H1))
#define Z ((bf16_t*)(ws + WS_Z))
#define R ((float*)(ws + WS_R))
#define X1 ((float*)(ws + WS_X1))
#define H2 ((bf16_t*)(ws + WS_H2))
#define QP ((bf16_t*)(ws + WS_QP))
#define GATES ((bf16_t*)args.out)

    for (int u = tid; u < (LDS_BYTES - MISC_OFF) / 4; u += NWAVES * 64) MISC[u] = 0u;
    __syncthreads();
    XcdBarrier bar; bar.bar = ctl + CW_BAR; bar.x = 0; bar.st = nullptr;
    if (MK_N_LAUNCHES != N_PHASES) bar = xcd_barrier_post(ctl + CW_BAR, MISC + 8);
    const int lo = args.ph_lo, hi = args.ph_hi;
#ifndef PH_MASK
#define PH_MASK 0x3ff
#endif
#define IN(k) (((PH_MASK >> (k)) & 1) && lo <= (k) && (k) < hi)
#define SEAM(k) do { if (IN(k) && IN((k) + 1)) xcd_barrier(bar); } while (0)

    if (IN(0)) {
        for (int it = gw; it < 96 * 8; it += NGW) {
            const int cb = it % 96, ks = it / 96, col = 64 * cb + lane;
            float acc[32];
#pragma unroll
            for (int b = 0; b < 32; ++b) acc[b] = 0.f;
            for (int k = 128 * ks; k < 128 * ks + 128; ++k) { const float w = w_ada[(size_t)k * MODW + col];
#pragma unroll
                for (int b = 0; b < 32; ++b) acc[b] += siluf_(cvec[b * DM + k]) * w; }
            const float bias = (ks == 0) ? b_ada[col] : 0.f;
#pragma unroll
            for (int b = 0; b < 32; ++b) atomicAdd(MOD + b * MODW + col, acc[b] + bias);
        }
        LAS float* scr = (LAS float*)(lds + wave * 16384);
        for (int it = gw; it < 4096 + 4 * 512; it += NGW) {
            if (it < 4096) { const int kb = it / 256, nb = it % 256, n0 = 32 * nb; p0_transpose_item(w_in, IN_W, n0 < NZ ? n0 : n0 + 8, WIN, DM, n0, kb, n0 < 1024 ? QSCALE : 1.0f, scr, lane); }
            else { const int r = it - 4096, wsel = r / 512, q = r % 512, kb = q / 32, nb = q % 32;
                const float* src = wsel == 0 ? w_br_attn : wsel == 1 ? w_br_mlstm : wsel == 2 ? w_out : peer_wq; bf16_t* dst = wsel == 0 ? WA : wsel == 1 ? WM : wsel == 2 ? WOUT : WQ;
                p0_transpose_item(src, DM, 32 * nb, dst, DM, 32 * nb, kb, 1.0f, scr, lane); }
        }
        for (size_t i = (size_t)bx * 512 + tid; i < (size_t)2 * NEXP * DM / 8; i += (size_t)G * 512) {
            const size_t half = (size_t)NEXP * DM / 8; const bool second = i >= half; const size_t j = second ? i - half : i;
            const float* s = (second ? peer_v : peer_u) + j * 8; const f32x4 a = *(const f32x4*)s, b = *(const f32x4*)(s + 4);
            u32x4 w; w.x = pk2(a[0], a[1]); w.y = pk2(a[2], a[3]); w.z = pk2(b[0], b[1]); w.w = pk2(b[2], b[3]);
            *(u32x4*)((second ? VT : UT) + j * 8) = w;
        }
    }
    SEAM(0);
    if (IN(1)) {
        LAS float* wif = (LAS float*)lds;
        for (int i = tid; i < 8192; i += 512) { const int k = i >> 3, j = i & 7; wif[j * 1024 + k] = w_in[(size_t)k * IN_W + NZ + j]; }
        __syncthreads();
        for (int m = gw; m < TOK; m += NGW) {
            const int b = m / SEQ;
            const f32x4* xr = (const f32x4*)(x_in + (size_t)m * DM) + lane;
            f32x4 v[4]; float s = 0.f;
#pragma unroll
            for (int j = 0; j < 4; ++j) { v[j] = xr[64 * j]; s += (v[j].x + v[j].y) + (v[j].z + v[j].w); }
            const float mean = wave_sum(s) * (1.f / DM); float s2 = 0.f;
#pragma unroll
            for (int j = 0; j < 4; ++j) { v[j] = v[j] - mean; s2 += (v[j].x * v[j].x + v[j].y * v[j].y) + (v[j].z * v[j].z + v[j].w * v[j].w); }
            const float rstd = rsqrtf(wave_sum(s2) * (1.f / DM) + LN_EPS);
            const f32x4* sh = (const f32x4*)(MOD + (size_t)b * MODW) + lane; const f32x4* sc = (const f32x4*)(MOD + (size_t)b * MODW + DM) + lane;
            unsigned long long* o8 = (unsigned long long*)(H1 + (size_t)m * DM) + lane;
            float gp[8];
#pragma unroll
            for (int g = 0; g < 8; ++g) gp[g] = 0.f;
#pragma unroll
            for (int j = 0; j < 4; ++j) { const f32x4 hh = v[j] * rstd * (sc[64 * j] + 1.0f) + sh[64 * j];
                o8[64 * j] = (unsigned long long)pk2(hh.x, hh.y) | ((unsigned long long)pk2(hh.z, hh.w) << 32);
#pragma unroll
                for (int g = 0; g < 8; ++g) { const f32x4 w = *(const LAS f32x4*)(wif + g * 1024 + 4 * (lane + 64 * j)); gp[g] += (hh.x * w.x + hh.y * w.y) + (hh.z * w.z + hh.w * w.w); } }
#pragma unroll
            for (int g = 0; g < 8; ++g) gp[g] = wave_sum(gp[g]);
            if (lane == 0) {
#pragma unroll
                for (int g = 0; g < 8; ++g) GIF[(size_t)m * 8 + g] = gp[g] + b_if[g]; }
        }
    }
    SEAM(1);
    if (IN(2)) {
        pg8::Gemm g{H1, WIN, TOK, NIN, DM, DM, DM}; pg8::StaticOrder S; S.init(TOK, NIN, G, bx);
        pg8::EpiZ E{Z, GATES};
        pg8::gemm_phase<pg8::EpiZ, pg8::StaticOrder, true, true>(lds, g, S, E);
    }
    SEAM(2);
    if (IN(3)) {
        unsigned* qhead = ctl + CW_QUEUE;
        for (;;) {
            __syncthreads();
            if (tid == 0) MISC[0] = __hip_atomic_fetch_add(qhead, 1u, RLX_AGENT);
            __syncthreads();
            const int id = (int)MISC[0];
            if (id >= 128 + 2048) break;
#ifndef NO_MLS
            if (id < 128) mls::mlstm_unit(lds, Z, GIF, conv_w, conv_b, ml_norm_g, id >> 2, id & 3);
            else
#endif
#ifndef NO_ATT
            { const int idx = id - 128, qb = 7 - idx / 256, bh = idx % 256; datt::attn_unit(lds, Z, da_lambda, da_subln_g, bh >> 3, bh & 7, qb); }
#else
            {}
#endif
        }
    }
    SEAM(3);
    if (IN(4)) {
        pg8::Gemm g{Z + ZC_Q, WA, TOK, DM, DM, NZ, DM}; pg8::StaticOrder S; S.init(TOK, DM, G, bx);
        pg8::EpiGate<true> E{GATES, H1};
        pg8::gemm_phase<pg8::EpiGate<true>, pg8::StaticOrder, true, true>(lds, g, S, E);
    }
    SEAM(4);
    if (IN(5)) {
        pg8::Gemm g{Z + ZC_MV, WM, TOK, DM, DM, NZ, DM}; pg8::StaticOrder S; S.init(TOK, DM, G, bx);
        pg8::EpiGate<false> E{GATES + DM, H1};
        pg8::gemm_phase<pg8::EpiGate<false>, pg8::StaticOrder, true, true>(lds, g, S, E);
    }
    SEAM(5);
    if (IN(6)) {
        pg8::Gemm g{H1, WOUT, TOK, DM, DM, DM, DM}; pg8::StaticOrder S; S.init(TOK, DM, G, bx);
        pg8::EpiR E{x_in, MOD, R};
        pg8::gemm_phase<pg8::EpiR, pg8::StaticOrder, true, true>(lds, g, S, E);
    }
    SEAM(6);
    if (IN(7)) {
        for (int m = gw; m < TOK; m += NGW) {
            const int b = m / SEQ;
            const f32x4* rr = (const f32x4*)(R + (size_t)m * DM) + lane;
            f32x4 v[4]; float s = 0.f;
#pragma unroll
            for (int j = 0; j < 4; ++j) { v[j] = rr[64 * j]; s += (v[j].x + v[j].y) + (v[j].z + v[j].w); }
            float mean = wave_sum(s) * (1.f / DM); float s2 = 0.f;
#pragma unroll
            for (int j = 0; j < 4; ++j) { v[j] = v[j] - mean; s2 += (v[j].x * v[j].x + v[j].y * v[j].y) + (v[j].z * v[j].z + v[j].w * v[j].w); }
            float rstd = rsqrtf(wave_sum(s2) * (1.f / DM) + LN_EPS);
            f32x4* xo = (f32x4*)(X1 + (size_t)m * DM) + lane; s = 0.f;
#pragma unroll
            for (int j = 0; j < 4; ++j) { v[j] = v[j] * rstd * ((const f32x4*)ln1_g)[lane + 64 * j] + ((const f32x4*)ln1_b)[lane + 64 * j]; xo[64 * j] = v[j]; s += (v[j].x + v[j].y) + (v[j].z + v[j].w); }
            mean = wave_sum(s) * (1.f / DM); s2 = 0.f;
#pragma unroll
            for (int j = 0; j < 4; ++j) { v[j] = v[j] - mean; s2 += (v[j].x * v[j].x + v[j].y * v[j].y) + (v[j].z * v[j].z + v[j].w * v[j].w); }
            rstd = rsqrtf(wave_sum(s2) * (1.f / DM) + LN_EPS);
            const f32x4* sh = (const f32x4*)(MOD + (size_t)b * MODW + 3 * DM) + lane; const f32x4* sc = (const f32x4*)(MOD + (size_t)b * MODW + 4 * DM) + lane;
            unsigned long long* o8 = (unsigned long long*)(H2 + (size_t)m * DM) + lane;
#pragma unroll
            for (int j = 0; j < 4; ++j) { const f32x4 hh = v[j] * rstd * (sc[64 * j] + 1.0f) + sh[64 * j]; o8[64 * j] = (unsigned long long)pk2(hh.x, hh.y) | ((unsigned long long)pk2(hh.z, hh.w) << 32); }
        }
    }
    SEAM(7);
    if (IN(8)) {
        pg8::Gemm g{H2, WQ, TOK, DM, DM, DM, DM}; pg8::StaticOrder S; S.init(TOK, DM, G, bx);
        pg8::EpiStore E{QP};
        pg8::gemm_phase<pg8::EpiStore, pg8::StaticOrder, true, true>(lds, g, S, E);
    }
    SEAM(8);
    if (IN(9)) {
        peer::stage_keys(lds, peer_keys);
        for (int tile = bx; tile < TOK / 32; tile += G) {
            __syncthreads();
            peer::select_tile(lds, QP, tile * 32);
            __syncthreads();
#pragma unroll 1
            for (int j = 0; j < 4; ++j) peer::eval_token(lds, wave * 4 + j, (size_t)tile * 32 + wave * 4 + j, H2, UT, VT, X1, MOD, ln2_g, ln2_b, args.out);
        }
    }
#undef IN
#undef SEAM
#undef ws
#undef ctl
#undef x_in
#undef cvec
#undef w_ada
#undef b_ada
#undef w_in
#undef b_if
#undef conv_w
#undef conv_b
#undef da_lambda
#undef da_subln_g
#undef ml_norm_g
#undef w_br_attn
#undef w_br_mlstm
#undef w_out
#undef ln1_g
#undef ln1_b
#undef peer_wq
#undef peer_keys
#undef peer_u
#undef peer_v
#undef ln2_g
#undef ln2_b
#undef MOD
#undef GIF
#undef WIN
#undef WA
#undef WM
#undef WOUT
#undef WQ
#undef UT
#undef VT
#undef H1
#undef Z
#undef R
#undef X1
#undef H2
#undef QP
#undef GATES
}

extern "C" void kernel_launch(void* const* d_in, const int* in_sizes, int n_in, void* d_out, int out_size, void* d_ws, size_t ws_size, hipStream_t stream) {
    static int grid = 0;
    if (grid == 0) {
        if (n_in != 22 || in_sizes[0] != TOK * DM || out_size != TOK * DM || ws_size < WS_END) { fprintf(stderr, "kernel_launch: unexpected shapes (n_in %d, in0 %d, out %d, ws %zu; need ws >= %zu)\n", n_in, n_in > 0 ? in_sizes[0] : -1, out_size, ws_size, (size_t)WS_END); grid = -1; return; }
        int dev = 0, cus = 0, per_cu = 0;
        if (hipGetDevice(&dev) != hipSuccess || hipDeviceGetAttribute(&cus, hipDeviceAttributeMultiprocessorCount, dev) != hipSuccess) { fprintf(stderr, "kernel_launch: device query failed\n"); grid = -1; return; }
        if (hipFuncSetAttribute((const void*)mega_fwd, hipFuncAttributeMaxDynamicSharedMemorySize, LDS_BYTES) != hipSuccess) { fprintf(stderr, "kernel_launch: hipFuncSetAttribute failed\n"); grid = -1; return; }
        if (hipOccupancyMaxActiveBlocksPerMultiprocessor(&per_cu, (const void*)mega_fwd, NWAVES * 64, LDS_BYTES) != hipSuccess || per_cu < 1) fprintf(stderr, "kernel_launch: note: occupancy query reports %d workgroups per CU\n", per_cu);
        (void)hipGetLastError();
        grid = cus;
    }
    if (grid < 0) return;
    if (hipMemsetAsync((char*)d_ws + WS_CTL, 0, CTL_ZERO_BYTES, stream) != hipSuccess) { fprintf(stderr, "kernel_launch: memset failed\n"); return; }
    Args a{};
    for (int i = 0; i < 22; ++i) a.in[i] = (const float*)d_in[i];
    a.out = (float*)d_out; a.ws = (unsigned char*)d_ws;
    for (int li = 0; li < MK_N_LAUNCHES; ++li) {
        a.ph_lo = (MK_N_LAUNCHES == N_PHASES) ? li : 0; a.ph_hi = (MK_N_LAUNCHES == N_PHASES) ? li + 1 : N_PHASES;
        hipLaunchKernelGGL(mega_fwd, dim3(grid), dim3(NWAVES * 64), LDS_BYTES, stream, a);
        const hipError_t le = hipPeekAtLastError();
        if (le != hipSuccess) { fprintf(stderr, "kernel_launch: launch %d failed: %s\n", li, hipGetErrorName(le)); break; }
    }
}
```

```cpp
#include <hip/hip_runtime.h>
#include <hip/hip_bf16.h>
#include <cstdio>
#include <cstdint>
#include <cmath>

#define LAS __attribute__((address_space(3)))
#define GAS __attribute__((address_space(1)))
typedef unsigned short bf16_t;
typedef short bf16x8 __attribute__((ext_vector_type(8)));
typedef short s16x4 __attribute__((ext_vector_type(4)));
typedef float f32x2 __attribute__((ext_vector_type(2)));
typedef float f32x4 __attribute__((ext_vector_type(4)));
typedef float f32x16 __attribute__((ext_vector_type(16)));
typedef unsigned u32x2 __attribute__((ext_vector_type(2)));
typedef unsigned u32x4 __attribute__((ext_vector_type(4)));
typedef __bf16 bf16x2_t __attribute__((ext_vector_type(2)));
#define DI __device__ __forceinline__

constexpr int BATCH = 32, SEQ = 2048, DM = 1024, TOK = BATCH * SEQ;
constexpr int NZ = 6144;
constexpr int ZC_Q = 0, ZC_K = 1024, ZC_V = 2048, ZC_MQ = 3072, ZC_MK = 3584, ZC_MV = 4096, ZC_MO = 5120;
constexpr int NGATE = 2048;
constexpr int NIN = 8192;
constexpr int IN_W = 8200;
constexpr int MODW = 6 * DM;
constexpr float LN_EPS = 1e-5f;
constexpr float ALPHA_RES = 1.189207115002721f;
constexpr float LAMBDA_INIT = 0.2f;
constexpr float QSCALE = 0.125f * 1.4426950408889634f;
constexpr int NEXP = 16384;

constexpr size_t MiB = 1u << 20;
constexpr size_t WS_CTL = 0, CTL_ZERO_BYTES = 2 * MiB;
constexpr size_t WS_MOD = 1 * MiB;
constexpr size_t WS_GIF = 3 * MiB;
constexpr size_t WS_WIN = 6 * MiB;
constexpr size_t WS_WA = 22 * MiB, WS_WM = 24 * MiB, WS_WOUT = 26 * MiB, WS_WQ = 28 * MiB;
constexpr size_t WS_U = 30 * MiB, WS_V = 62 * MiB;
constexpr size_t WS_SU = 2 * MiB, WS_SV = 2 * MiB + 65536;
constexpr size_t WS_H1 = 96 * MiB;
constexpr size_t WS_Z = 224 * MiB;
constexpr size_t WS_R = WS_Z, WS_X1 = WS_Z + 256 * MiB, WS_H2 = WS_Z + 512 * MiB, WS_QP = WS_Z + 640 * MiB;
constexpr size_t WS_END = 992 * MiB;
constexpr int CW_BAR = 4096;
constexpr int CW_QUEUE = 16384;

DI unsigned pk2(float lo, float hi) { f32x2 v = {lo, hi}; bf16x2_t b = __builtin_convertvector(v, bf16x2_t); return __builtin_bit_cast(unsigned, b); }
DI float bf_lo(unsigned u) { return __uint_as_float(u << 16); }
DI float bf_hi(unsigned u) { return __uint_as_float(u & 0xffff0000u); }
DI float bf2f(bf16_t h) { return __uint_as_float(((unsigned)h) << 16); }
DI float wave_sum(float v) {
#pragma unroll
    for (int o = 1; o < 64; o <<= 1) v += __shfl_xor(v, o);
    return v;
}
DI float sigmoidf_(float x) { return 1.0f / (1.0f + __expf(-x)); }
DI float siluf_(float x) { return x / (1.0f + __expf(-x)); }
DI int crow(int r, int hi) { return (r & 3) + 8 * (r >> 2) + 4 * hi; }
#define MFMA32(a, b, c) __builtin_amdgcn_mfma_f32_32x32x16_bf16((a), (b), (c), 0, 0, 0)
DI bf16x8 pack_step(const f32x16& x, int s) {
    u32x4 p;
    p[0] = pk2(x[8 * s + 0], x[8 * s + 1]); p[1] = pk2(x[8 * s + 2], x[8 * s + 3]); p[2] = pk2(x[8 * s + 4], x[8 * s + 5]); p[3] = pk2(x[8 * s + 6], x[8 * s + 7]);
    return __builtin_bit_cast(bf16x8, p);
}
DI unsigned off_b(unsigned row, unsigned ch) { return 256u * row + 16u * (ch ^ (((row & 3) << 2) | ((row >> 2) & 3))); }
DI unsigned row_read_addr(unsigned lane, unsigned rt, unsigned s) { return off_b(32 * rt + (lane & 31), 2 * s + (lane >> 5)); }
DI unsigned tr_read_addr(unsigned lane, unsigned c, unsigned ks, unsigned t) {
    const unsigned h = lane >> 5, blk = (lane >> 4) & 1, q = (lane & 15) >> 2, p = lane & 3;
    return off_b(16 * ks + 8 * h + 4 * t + q, 4 * c + 2 * blk + (p >> 1)) + 8 * (p & 1);
}
DI unsigned tr_base(unsigned lane, unsigned t) { const unsigned h = lane >> 5, blk = (lane >> 4) & 1, q = (lane & 15) >> 2, p = lane & 3, cl = 2 * blk + (p >> 1);
    return 256u * (8 * h + 4 * t + q) + 16u * (cl ^ (2 * h + t)) + 8u * (p & 1); }
#define OPAQUE(x) asm volatile("" : "+v"(x))
typedef short v4i16_t __attribute__((ext_vector_type(4)));
DI s16x4 tr_read(const LAS unsigned char* p) { return __builtin_bit_cast(s16x4, __builtin_amdgcn_ds_read_tr16_b64_v4i16((LAS v4i16_t*)p)); }
DI bf16x8 cat8(s16x4 lo, s16x4 hi) { return __builtin_shufflevector(lo, hi, 0, 1, 2, 3, 4, 5, 6, 7); }
namespace pg8 {
#define PG8_LAS __attribute__((address_space(3)))
typedef unsigned short bf16_t;
typedef short bf16x8 __attribute__((ext_vector_type(8)));
typedef float f32x4 __attribute__((ext_vector_type(4)));
typedef unsigned u32x4 __attribute__((ext_vector_type(4)));
constexpr int BM = 256, BK = 64, HALF = 128, HTB = HALF * BK * 2  , STAGE_BYTES = 8 * HTB, NXCD = 8, WGM = 8;

__host__ __device__ __forceinline__ int lds_byte(int r, int c) { const int st = (r >> 4) * 2 + (c >> 5), rr = r & 15, cc = c & 31, ob = rr * 64 + cc * 2; return st * 1024 + (ob ^ (((ob >> 9) & 1) << 5)); }
__host__ __device__ __forceinline__ void stage_rc(int b, int& R, int& C) { const int st = b / 1024, sb = b % 1024, swz = sb ^ (((sb >> 9) & 1) << 5); R = (st >> 1) * 16 + swz / 64; C = (st & 1) * 32 + (swz % 64) / 2; }
__host__ __device__ __forceinline__ int perm32(int rho) { const int n = rho >> 4, i = rho & 15; return 8 * (i >> 2) + 4 * n + (i & 3); }

struct Unit { int pm, pn; };
struct Gemm { const bf16_t* A; const bf16_t* Bt; int M, N, K, lda, ldb; };

struct StaticOrder {
    int nM, nN, nwg, G, c;
    __host__ __device__ void init(int M, int N, int G_, int c_) { nM = M / BM; nN = N / BM; nwg = nM * nN; G = G_; c = c_; }
    __host__ __device__ bool next(int i, Unit& u) const {
        const long L = (long)i * G + c; if (L >= nwg) return false;
        int wgid = (int)L; { const int q = nwg / NXCD, r = nwg % NXCD, xcd = wgid % NXCD, off = wgid / NXCD; wgid = (xcd < r ? xcd * (q + 1) : r * (q + 1) + (xcd - r) * q) + off; }
        const int nig = WGM * nN, gid = wgid / nig, fm = gid * WGM, gsz = (nM - fm) < WGM ? (nM - fm) : WGM;
        u.pm = fm + ((wgid % nig) % gsz); u.pn = (wgid % nig) / gsz; return true;
    }
    __device__ __forceinline__ void a_ready(const Unit&) const {}
    __device__ __forceinline__ void done(const Unit&) const {}
};

template <class Epi, class Sched, bool ALIGN_EPI = false, bool SP2 = false>
__device__ __forceinline__ void gemm_phase(PG8_LAS unsigned char* lds, const Gemm g, const Sched& S, const Epi& E) {
    const int tid = threadIdx.x, wid = __builtin_amdgcn_readfirstlane(tid >> 6), lane = tid & 63, wr = wid >> 2, wc = wid & 3, fr = lane & 15, fq = lane >> 4;
    const int K = g.K, nt = K / BK;
    unsigned voffA[2], voffB[2];
#pragma unroll
    for (int i = 0; i < 2; ++i) { int R, C; stage_rc(tid * 16 + i * 8192, R, C); const int Rb = Epi::PERM ? ((R & ~31) + perm32(R & 31)) : R;
        voffA[i] = (unsigned)(R * g.lda + C) * 2u; voffB[i] = (unsigned)(Rb * g.ldb + C) * 2u; }
    const size_t kstep = (size_t)(BK * 2);
    const size_t hstepA = (size_t)HALF * g.lda * 2, hstepB = (size_t)HALF * g.ldb * 2;
    const size_t tstepA = 2 * hstepA, tstepB = 2 * hstepB;
    const unsigned ldsw = (unsigned)wid * 1024u;
    const int aoff = lds_byte(wr * 64 + fr, fq * 8), boff = lds_byte(wc * 32 + fr, fq * 8);
#define PG8_SA(b, h) (((b) * 2 + (h)) * HTB)
#define PG8_SB(b, h) ((4 + (b) * 2 + (h)) * HTB)
#define PG8_STAGE(bufoff, gbase, voff) do { _Pragma("unroll") for (int _i = 0; _i < 2; ++_i) \
        __builtin_amdgcn_global_load_lds((const unsigned*)((const char*)(gbase) + (voff)[_i]), (PG8_LAS unsigned*)(lds + (bufoff) + ldsw + _i * 8192), 16, 0, 0); } while (0)
#define PG8_LDA(dst, b, h) do { _Pragma("unroll") for (int m = 0; m < 4; ++m) _Pragma("unroll") for (int k = 0; k < 2; ++k) dst[m][k] = *(const PG8_LAS bf16x8*)(lds + PG8_SA(b, h) + aoff + m * 2048 + k * 1024); } while (0)
#define PG8_LDB(dst, b, h) do { _Pragma("unroll") for (int n = 0; n < 2; ++n) _Pragma("unroll") for (int k = 0; k < 2; ++k) dst[n][k] = *(const PG8_LAS bf16x8*)(lds + PG8_SB(b, h) + boff + n * 2048 + k * 1024); } while (0)
#define PG8_MMA(ai, bj, At, Bt) do { __builtin_amdgcn_s_setprio(1); _Pragma("unroll") for (int m = 0; m < 4; ++m) _Pragma("unroll") for (int n = 0; n < 2; ++n) _Pragma("unroll") for (int k = 0; k < 2; ++k) \
        acc[ai][bj][m][n] = __builtin_amdgcn_mfma_f32_16x16x32_bf16(Bt[n][k], At[m][k], acc[ai][bj][m][n], 0, 0, 0); __builtin_amdgcn_s_setprio(0); } while (0)
#define PG8_WAIT_V(n) asm volatile("s_waitcnt vmcnt(" #n ")" ::: "memory")
#define PG8_WAIT_L(n) asm volatile("s_waitcnt lgkmcnt(" #n ")" ::: "memory")
#define PG8_BAR __builtin_amdgcn_s_barrier()
#define PG8_SCHED __builtin_amdgcn_sched_barrier(0)
    Unit cur, nxt; int ui = 0;
    if (!S.next(0, cur)) return;
    f32x4 acc[2][2][4][2];
#pragma unroll
    for (int a = 0; a < 2; ++a)
#pragma unroll
        for (int b = 0; b < 2; ++b)
#pragma unroll
            for (int m = 0; m < 4; ++m)
#pragma unroll
                for (int n = 0; n < 2; ++n) acc[a][b][m][n] = (f32x4){0.f, 0.f, 0.f, 0.f};
    bf16x8 At[4][2], B0[2][2], B1[2][2];
    const char* cA = (const char*)g.A + (size_t)cur.pm * tstepA; const char* cB = (const char*)g.Bt + (size_t)cur.pn * tstepB;
    S.a_ready(cur);
    if constexpr (SP2) {
        PG8_STAGE(PG8_SB(0, 0), cB, voffB); PG8_STAGE(PG8_SB(0, 1), cB + hstepB, voffB); PG8_STAGE(PG8_SA(0, 0), cA, voffA); PG8_STAGE(PG8_SA(0, 1), cA + hstepA, voffA);
        if (wr == 1) PG8_BAR;
        PG8_WAIT_V(2); PG8_BAR;
        PG8_STAGE(PG8_SB(1, 0), cB + kstep, voffB); PG8_STAGE(PG8_SA(1, 0), cA + kstep, voffA); PG8_STAGE(PG8_SB(1, 1), cB + hstepB + kstep, voffB);
        PG8_WAIT_V(6); PG8_BAR;
    } else {
        PG8_STAGE(PG8_SB(0, 0), cB, voffB); PG8_STAGE(PG8_SA(0, 0), cA, voffA); PG8_STAGE(PG8_SB(0, 1), cB + hstepB, voffB); PG8_STAGE(PG8_SA(0, 1), cA + hstepA, voffA);
        if (wr == 1) PG8_BAR;
        PG8_WAIT_V(4); PG8_BAR;
        PG8_STAGE(PG8_SB(1, 0), cB + kstep, voffB); PG8_STAGE(PG8_SA(1, 0), cA + kstep, voffA); PG8_STAGE(PG8_SB(1, 1), cB + hstepB + kstep, voffB);
        PG8_WAIT_V(6); PG8_BAR;
    }
    for (;;) {
        const bool has_next = S.next(ui + 1, nxt);
        const char* nA = has_next ? (const char*)g.A + (size_t)nxt.pm * tstepA : cA; const char* nB = has_next ? (const char*)g.Bt + (size_t)nxt.pn * tstepB : cB;
        for (int t = 0; t < nt; t += 2) {
            const bool last = (t == nt - 2);
            const char* a1 = cA + (size_t)(t + 1) * kstep;
            const char* a2 = last ? nA : cA + (size_t)(t + 2) * kstep; const char* b2 = last ? nB : cB + (size_t)(t + 2) * kstep;
            const char* a3 = a2 + kstep; const char* b3 = b2 + kstep;
            if (last && has_next) S.a_ready(nxt);
            if constexpr (SP2) {
            PG8_LDB(B0, 0, 0); PG8_LDB(B1, 0, 1); PG8_SCHED; PG8_LDA(At, 0, 0); PG8_STAGE(PG8_SA(1, 1), a1 + hstepA, voffA);
            PG8_WAIT_V(8); PG8_WAIT_L(0); PG8_BAR; PG8_MMA(0, 0, At, B0); PG8_MMA(0, 1, At, B1); PG8_BAR; PG8_SCHED;
            PG8_LDA(At, 0, 1); PG8_STAGE(PG8_SB(0, 0), b2, voffB); PG8_STAGE(PG8_SB(0, 1), b2 + hstepB, voffB); PG8_STAGE(PG8_SA(0, 0), a2, voffA);
            PG8_WAIT_V(8); PG8_WAIT_L(0); PG8_BAR; PG8_MMA(1, 0, At, B0); PG8_MMA(1, 1, At, B1); PG8_BAR; PG8_SCHED;
            PG8_LDB(B0, 1, 0); PG8_LDB(B1, 1, 1); PG8_SCHED; PG8_LDA(At, 1, 0); PG8_STAGE(PG8_SA(0, 1), a2 + hstepA, voffA);
            PG8_WAIT_V(8); PG8_WAIT_L(0); PG8_BAR; PG8_MMA(0, 0, At, B0); PG8_MMA(0, 1, At, B1); PG8_BAR; PG8_SCHED;
            PG8_LDA(At, 1, 1); PG8_STAGE(PG8_SB(1, 0), b3, voffB); PG8_STAGE(PG8_SB(1, 1), b3 + hstepB, voffB); PG8_STAGE(PG8_SA(1, 0), a3, voffA);
            PG8_WAIT_V(8); PG8_WAIT_L(0); PG8_BAR; PG8_MMA(1, 0, At, B0); PG8_MMA(1, 1, At, B1); PG8_BAR; PG8_SCHED;
            } else {
            PG8_LDB(B0, 0, 0); PG8_SCHED; PG8_LDA(At, 0, 0); PG8_STAGE(PG8_SA(1, 1), a1 + hstepA, voffA);
            PG8_WAIT_L(8); PG8_BAR; PG8_WAIT_L(0); PG8_MMA(0, 0, At, B0); PG8_BAR; PG8_SCHED;
            PG8_LDB(B1, 0, 1); PG8_STAGE(PG8_SB(0, 0), b2, voffB);
            PG8_BAR; PG8_WAIT_L(0); PG8_MMA(0, 1, At, B1); PG8_BAR;
            PG8_LDA(At, 0, 1); PG8_STAGE(PG8_SA(0, 0), a2, voffA);
            PG8_BAR; PG8_WAIT_L(0); PG8_MMA(1, 0, At, B0); PG8_BAR; PG8_SCHED;
            PG8_STAGE(PG8_SB(0, 1), b2 + hstepB, voffB);
            PG8_WAIT_V(6); PG8_BAR; PG8_MMA(1, 1, At, B1); PG8_BAR;
            PG8_LDB(B0, 1, 0); PG8_SCHED; PG8_LDA(At, 1, 0); PG8_STAGE(PG8_SA(0, 1), a2 + hstepA, voffA);
            PG8_WAIT_L(8); PG8_BAR; PG8_WAIT_L(0); PG8_MMA(0, 0, At, B0); PG8_BAR; PG8_SCHED;
            PG8_LDB(B1, 1, 1); PG8_STAGE(PG8_SB(1, 0), b3, voffB);
            PG8_BAR; PG8_WAIT_L(0); PG8_MMA(0, 1, At, B1); PG8_BAR;
            PG8_LDA(At, 1, 1); PG8_STAGE(PG8_SA(1, 0), a3, voffA);
            PG8_BAR; PG8_WAIT_L(0); PG8_MMA(1, 0, At, B0); PG8_BAR; PG8_SCHED;
            PG8_STAGE(PG8_SB(1, 1), b3 + hstepB, voffB);
            PG8_WAIT_V(6); PG8_BAR; PG8_MMA(1, 1, At, B1); PG8_BAR;
            }
        }
        if constexpr (ALIGN_EPI) { if (wr == 0) PG8_BAR; }
        if constexpr (!Epi::AFTER_DRAIN) { E(acc, cur, wr, wc, fr, fq); S.done(cur); }
        if (!has_next) break;
#pragma unroll
        for (int a = 0; a < 2; ++a)
#pragma unroll
            for (int b = 0; b < 2; ++b)
#pragma unroll
                for (int m = 0; m < 4; ++m)
#pragma unroll
                    for (int n = 0; n < 2; ++n) acc[a][b][m][n] = (f32x4){0.f, 0.f, 0.f, 0.f};
        cur = nxt; cA = nA; cB = nB; ++ui;
        if constexpr (ALIGN_EPI) { if (wr == 1) PG8_BAR; }
    }
    PG8_WAIT_V(0);
    if constexpr (!ALIGN_EPI) { if (wr == 0) PG8_BAR; }
    PG8_BAR;
    if constexpr (Epi::AFTER_DRAIN) { E.fused(acc, cur, wr, wc, fr, fq, lds, wid, lane); S.done(cur); }
#undef PG8_SA
#undef PG8_SB
#undef PG8_STAGE
#undef PG8_LDA
#undef PG8_LDB
#undef PG8_MMA
#undef PG8_WAIT_V
#undef PG8_WAIT_L
#undef PG8_BAR
#undef PG8_SCHED
}
}
namespace pg8 {
struct EpiZ {
    static constexpr bool PERM = true, AFTER_DRAIN = false;
    bf16_t* Z; bf16_t* G;
    __device__ __forceinline__ void operator()(const f32x4 (&acc)[2][2][4][2], const Unit& u, int wr, int wc, int fr, int fq) const {
        const int row0 = u.pm * BM + wr * 64 + fr, colt = u.pn * BM; const bool gate = colt >= NZ;
        bf16_t* base = gate ? G : Z; const int ld = gate ? NGATE : NZ; const int col0 = (gate ? colt - NZ : colt) + wc * 32 + 8 * fq;
#pragma unroll
        for (int ai = 0; ai < 2; ++ai)
#pragma unroll
            for (int m = 0; m < 4; ++m) { bf16_t* rowp = base + (size_t)(row0 + ai * HALF + m * 16) * ld + col0;
#pragma unroll
                for (int bj = 0; bj < 2; ++bj) { f32x4 v0 = acc[ai][bj][m][0], v1 = acc[ai][bj][m][1];
                    if (gate) {
#pragma unroll
                        for (int e = 0; e < 4; ++e) { v0[e] = sigmoidf_(v0[e]); v1[e] = sigmoidf_(v1[e]); } }
                    ::u32x4 w; w.x = pk2(v0[0], v0[1]); w.y = pk2(v0[2], v0[3]); w.z = pk2(v1[0], v1[1]); w.w = pk2(v1[2], v1[3]);
                    *(::u32x4*)(rowp + bj * HALF) = w; } }
    }
};
template <bool FIRST> struct EpiGate {
    static constexpr bool PERM = true, AFTER_DRAIN = false;
    const bf16_t* G; bf16_t* Y;
    __device__ __forceinline__ void operator()(const f32x4 (&acc)[2][2][4][2], const Unit& u, int wr, int wc, int fr, int fq) const {
        const int row0 = u.pm * BM + wr * 64 + fr, col0 = u.pn * BM + wc * 32 + 8 * fq;
#pragma unroll
        for (int ai = 0; ai < 2; ++ai)
#pragma unroll
            for (int m = 0; m < 4; ++m) { const size_t row = (size_t)(row0 + ai * HALF + m * 16);
#pragma unroll
                for (int bj = 0; bj < 2; ++bj) { const f32x4 v0 = acc[ai][bj][m][0], v1 = acc[ai][bj][m][1];
                    const ::u32x4 g = *(const ::u32x4*)(G + row * NGATE + col0 + bj * HALF);
                    float o[8] = { bf_lo(g.x) * v0[0], bf_hi(g.x) * v0[1], bf_lo(g.y) * v0[2], bf_hi(g.y) * v0[3], bf_lo(g.z) * v1[0], bf_hi(g.z) * v1[1], bf_lo(g.w) * v1[2], bf_hi(g.w) * v1[3] };
                    bf16_t* yp = Y + row * DM + col0 + bj * HALF;
                    if (!FIRST) { const ::u32x4 y = *(const ::u32x4*)yp;
                        o[0] += bf_lo(y.x); o[1] += bf_hi(y.x); o[2] += bf_lo(y.y); o[3] += bf_hi(y.y); o[4] += bf_lo(y.z); o[5] += bf_hi(y.z); o[6] += bf_lo(y.w); o[7] += bf_hi(y.w); }
                    ::u32x4 w; w.x = pk2(o[0], o[1]); w.y = pk2(o[2], o[3]); w.z = pk2(o[4], o[5]); w.w = pk2(o[6], o[7]);
                    *(::u32x4*)yp = w; } }
    }
};
struct EpiR {
    static constexpr bool PERM = true, AFTER_DRAIN = false;
    const float* X; const float* MOD; float* R;
    __device__ __forceinline__ void operator()(const f32x4 (&acc)[2][2][4][2], const Unit& u, int wr, int wc, int fr, int fq) const {
        const int row0 = u.pm * BM + wr * 64 + fr, col0 = u.pn * BM + wc * 32 + 8 * fq;
        const float* gt = MOD + (size_t)((u.pm * BM) / SEQ) * MODW + 2 * DM;
        f32x4 g[2][2];
#pragma unroll
        for (int bj = 0; bj < 2; ++bj) { g[bj][0] = *(const f32x4*)(gt + col0 + bj * HALF); g[bj][1] = *(const f32x4*)(gt + col0 + bj * HALF + 4); }
#pragma unroll
        for (int ai = 0; ai < 2; ++ai)
#pragma unroll
            for (int m = 0; m < 4; ++m) { const size_t off = (size_t)(row0 + ai * HALF + m * 16) * DM + col0;
#pragma unroll
                for (int bj = 0; bj < 2; ++bj) {
                    const f32x4 x0 = *(const f32x4*)(X + off + bj * HALF), x1 = *(const f32x4*)(X + off + bj * HALF + 4);
                    *(f32x4*)(R + off + bj * HALF) = x0 * ALPHA_RES + g[bj][0] * acc[ai][bj][m][0];
                    *(f32x4*)(R + off + bj * HALF + 4) = x1 * ALPHA_RES + g[bj][1] * acc[ai][bj][m][1]; } }
    }
};
struct EpiStore {
    static constexpr bool PERM = true, AFTER_DRAIN = false;
    bf16_t* O;
    __device__ __forceinline__ void operator()(const f32x4 (&acc)[2][2][4][2], const Unit& u, int wr, int wc, int fr, int fq) const {
        const int row0 = u.pm * BM + wr * 64 + fr, col0 = u.pn * BM + wc * 32 + 8 * fq;
#pragma unroll
        for (int ai = 0; ai < 2; ++ai)
#pragma unroll
            for (int m = 0; m < 4; ++m) { bf16_t* rowp = O + (size_t)(row0 + ai * HALF + m * 16) * DM + col0;
#pragma unroll
                for (int bj = 0; bj < 2; ++bj) { const f32x4 v0 = acc[ai][bj][m][0], v1 = acc[ai][bj][m][1];
                    ::u32x4 w; w.x = pk2(v0[0], v0[1]); w.y = pk2(v0[2], v0[3]); w.z = pk2(v1[0], v1[1]); w.w = pk2(v1[2], v1[3]);
                    *(::u32x4*)(rowp + bj * HALF) = w; } }
    }
};
}
namespace datt {
constexpr int KROW = 144;
constexpr int LDS_K = 0, LDS_V = 64 * KROW, LDS_ST = LDS_V + 64 * 256, STROW = 272, ST_WAVE = 32 * STROW, LDS_BYTES = LDS_ST + 8 * ST_WAVE;
DI unsigned vrow(unsigned key) { return (key & ~12u) | ((key & 4u) << 1) | ((key & 8u) >> 1); }

DI void attn_unit(LAS unsigned char* lds, bf16_t* Z, const float* lam, const float* subln_g, int b, int h, int qb) {
    const int tid = threadIdx.x, lane = tid & 63, r32 = lane & 31, hi = lane >> 5; const int wid = __builtin_amdgcn_readfirstlane(tid >> 6);
    const size_t rowbase = (size_t)b * SEQ;
    const int q_first = qb * 256 + wid * 32, q_me = q_first + r32;
    float lam_val;
    { const float p1 = lam[lane] * lam[64 + lane], p2 = lam[128 + lane] * lam[192 + lane]; lam_val = __expf(wave_sum(p1)) - __expf(wave_sum(p2)) + LAMBDA_INIT; }
    const int NT = 4 * (qb + 1);
    const int k_key = tid >> 3, k_ch = tid & 7;
    const int v_key0 = tid >> 4, v_ch = tid & 15;
    const unsigned tb0 = LDS_V + tr_base(lane, 0), tb1 = LDS_V + tr_base(lane, 1); unsigned q64 = ((lane & 15) >> 2) << 6;
    const unsigned kb = LDS_K + r32 * KROW + hi * 16;
#pragma unroll
    for (int m = 0; m < 2; ++m) {
        bf16x8 qf[4];
        { const bf16_t* qp = Z + (rowbase + q_me) * NZ + ZC_Q + h * 128 + m * 64 + 8 * hi;
#pragma unroll
          for (int s = 0; s < 4; ++s) qf[s] = *(const bf16x8*)(qp + 16 * s); }
        const bf16_t* ksrc = Z + (rowbase + k_key) * NZ + ZC_K + h * 128 + m * 64 + k_ch * 8;
        const bf16_t* vsrc = Z + (rowbase + v_key0) * NZ + ZC_V + h * 128 + v_ch * 8;
        f32x16 O[4];
#pragma unroll
        for (int c = 0; c < 4; ++c)
#pragma unroll
            for (int r = 0; r < 16; ++r) O[c][r] = 0.f;
        float mrun = -1e30f, lrun = 0.f;
        u32x4 pk_ = *(const u32x4*)ksrc, pv0 = *(const u32x4*)vsrc, pv1 = *(const u32x4*)(vsrc + (size_t)32 * NZ);
        for (int kt = 0; kt < NT; ++kt) {
            __syncthreads();
            *(LAS u32x4*)(lds + LDS_K + k_key * KROW + k_ch * 16) = pk_;
            *(LAS u32x4*)(lds + LDS_V + off_b(vrow(v_key0), v_ch)) = pv0;
            *(LAS u32x4*)(lds + LDS_V + off_b(vrow(v_key0 + 32), v_ch)) = pv1;
            __syncthreads();
            if (kt + 1 < NT) { const size_t o = (size_t)(kt + 1) * 64 * NZ; pk_ = *(const u32x4*)(ksrc + o); pv0 = *(const u32x4*)(vsrc + o); pv1 = *(const u32x4*)(vsrc + o + (size_t)32 * NZ); }
            if (kt * 64 > q_first + 31) continue;
            f32x16 p[2];
#pragma unroll
            for (int hf = 0; hf < 2; ++hf) {
#pragma unroll
                for (int r = 0; r < 16; ++r) p[hf][r] = 0.f;
#pragma unroll
                for (int s = 0; s < 4; ++s) { const bf16x8 a = *(const LAS bf16x8*)(lds + kb + 32 * hf * KROW + s * 32); p[hf] = MFMA32(a, qf[s], p[hf]); }
            }
            if (kt * 64 + 63 > q_first) {
#pragma unroll
                for (int hf = 0; hf < 2; ++hf)
#pragma unroll
                    for (int r = 0; r < 16; ++r) { const int key = kt * 64 + 32 * hf + crow(r, hi); if (key > q_me) p[hf][r] = -1e30f; }
            }
            float mx = p[0][0];
#pragma unroll
            for (int r = 1; r < 16; ++r) mx = fmaxf(mx, p[0][r]);
#pragma unroll
            for (int r = 0; r < 16; ++r) mx = fmaxf(mx, p[1][r]);
            mx = fmaxf(mx, __shfl_xor(mx, 32));
            const float mnew = fmaxf(mrun, mx), alpha = __builtin_amdgcn_exp2f(mrun - mnew); mrun = mnew;
            float ls = 0.f;
#pragma unroll
            for (int hf = 0; hf < 2; ++hf)
#pragma unroll
                for (int r = 0; r < 16; ++r) { const float e = __builtin_amdgcn_exp2f(p[hf][r] - mnew); p[hf][r] = e; ls += e; }
            lrun = lrun * alpha + ls;
#pragma unroll
            for (int c = 0; c < 4; ++c)
#pragma unroll
                for (int r = 0; r < 16; ++r) O[c][r] *= alpha;
            bf16x8 pf[4];
            pf[0] = pack_step(p[0], 0); pf[1] = pack_step(p[0], 1); pf[2] = pack_step(p[1], 0); pf[3] = pack_step(p[1], 1);
#pragma unroll
            for (int c = 0; c < 4; ++c) { OPAQUE(q64); const unsigned cx = (64u * c) ^ q64;
#pragma unroll
                for (int ks = 0; ks < 4; ++ks) {
                    const s16x4 lo = tr_read(lds + tb0 + cx + 4096 * ks), hi4 = tr_read(lds + tb1 + cx + 4096 * ks);
                    O[c] = MFMA32(cat8(lo, hi4), pf[ks], O[c]);
                } }
        }
        const float ltot = lrun + __shfl_xor(lrun, 32), inv = 1.0f / ltot;
        if (m == 0) {
            LAS unsigned char* stg = lds + LDS_ST + wid * ST_WAVE;
#pragma unroll
            for (int c = 0; c < 4; ++c)
#pragma unroll
                for (int g4 = 0; g4 < 4; ++g4) { const int dv0 = 32 * c + 8 * g4 + 4 * hi;
                    u32x2 w; w.x = pk2(O[c][4 * g4] * inv, O[c][4 * g4 + 1] * inv); w.y = pk2(O[c][4 * g4 + 2] * inv, O[c][4 * g4 + 3] * inv);
                    *(LAS u32x2*)(stg + r32 * STROW + dv0 * 2) = w; }
        } else {
            const float li = lam_val * inv;
            float ss = 0.f;
            LAS unsigned char* stg = lds + LDS_ST + wid * ST_WAVE;
#pragma unroll
            for (int c = 0; c < 4; ++c)
#pragma unroll
                for (int g4 = 0; g4 < 4; ++g4) { const int dv0 = 32 * c + 8 * g4 + 4 * hi; const u32x2 k2 = *(const LAS u32x2*)(stg + r32 * STROW + dv0 * 2);
                    O[c][4 * g4] = bf_lo(k2.x) - li * O[c][4 * g4]; O[c][4 * g4 + 1] = bf_hi(k2.x) - li * O[c][4 * g4 + 1]; O[c][4 * g4 + 2] = bf_lo(k2.y) - li * O[c][4 * g4 + 2]; O[c][4 * g4 + 3] = bf_hi(k2.y) - li * O[c][4 * g4 + 3];
                    ss += (O[c][4 * g4] * O[c][4 * g4] + O[c][4 * g4 + 1] * O[c][4 * g4 + 1]) + (O[c][4 * g4 + 2] * O[c][4 * g4 + 2] + O[c][4 * g4 + 3] * O[c][4 * g4 + 3]); }
            ss += __shfl_xor(ss, 32);
            const float rstd = rsqrtf(ss * (1.0f / 128.0f) + LN_EPS) * (1.0f - LAMBDA_INIT);
#pragma unroll
            for (int c = 0; c < 4; ++c)
#pragma unroll
                for (int g4 = 0; g4 < 4; ++g4) { const int dv0 = 32 * c + 8 * g4 + 4 * hi; const f32x4 gg = *(const f32x4*)(subln_g + dv0);
                    u32x2 w; w.x = pk2(O[c][4 * g4] * rstd * gg[0], O[c][4 * g4 + 1] * rstd * gg[1]); w.y = pk2(O[c][4 * g4 + 2] * rstd * gg[2], O[c][4 * g4 + 3] * rstd * gg[3]);
                    *(LAS u32x2*)(stg + r32 * STROW + dv0 * 2) = w; }
        }
    }
    LAS unsigned char* stg = lds + LDS_ST + wid * ST_WAVE;
    asm volatile("s_waitcnt lgkmcnt(0)" ::: "memory");
    bf16_t* obase = Z + (rowbase + q_first) * NZ + ZC_Q + h * 128;
#pragma unroll
    for (int i = 0; i < 8; ++i) { const int idx = lane + 64 * i, row = idx >> 4, ch = idx & 15;
        const u32x4 v = *(const LAS u32x4*)(stg + row * STROW + ch * 16); *(u32x4*)(obase + (size_t)row * NZ + ch * 8) = v; }
}
}
namespace mls {
constexpr int QI = 0, KI = 32768, VI = 65536, SC = 131072;
constexpr int F_IG = 0, F_LF = 128, F_A = 256, F_M = 384, F_INTER = 512, F_EMT = 640, F_W = 768, F_DEN = 896, F_N = 1024, F_MISC = 1152,
              F_NQ2P = 1280, F_NQ1P = 1792, F_NP = 2304, F_RSQ = 2816, F_END = 3840;
constexpr int LDS_BYTES = SC + F_END * 4;
static_assert(LDS_BYTES <= 147456, "mLSTM LDS");

DI float scan_add(float x, int lane) {
#pragma unroll
    for (int o = 1; o < 64; o <<= 1) { const float y = __shfl_up(x, o); if (lane >= o) x += y; }
    return x;
}
DI float scan_max(float x, int lane) {
#pragma unroll
    for (int o = 1; o < 64; o <<= 1) { const float y = __shfl_up(x, o); if (lane >= o) x = fmaxf(x, y); }
    return x;
}
DI float log_sigmoid(float x) { return fminf(x, 0.f) - __logf(1.0f + __expf(-fabsf(x))); }

DI void mlstm_unit(LAS unsigned char* lds, bf16_t* Z, const float* GIF, const float* conv_w, const float* conv_b, const float* norm_g, int b, int hd) {
    const int tid = threadIdx.x, lane = tid & 63; const int wid = __builtin_amdgcn_readfirstlane(tid >> 6);
    LAS float* sc = (LAS float*)(lds + SC);
#define MLS_LV unsigned L_ = lane; OPAQUE(L_); const unsigned r32 = L_ & 31, hi = L_ >> 5, rowb = 256u * r32, f16 = (((r32 & 3) << 2) | ((r32 >> 2) & 3)) << 4, q64 = ((L_ & 15) >> 2) << 6; (void)rowb; (void)f16; (void)q64; (void)hi
    f32x16 CT[4];
#pragma unroll
    for (int i = 0; i < 4; ++i)
#pragma unroll
        for (int r = 0; r < 16; ++r) CT[i][r] = 0.f;
    float m_prev = 0.f;
    if (tid < 128) sc[F_N + tid] = 0.f;
    const int img = wid >> 2, vc = wid & 3;
    const int st_i = wid >> 1, st_j0 = 2 * (wid & 1);

    for (int c = 0; c < 16; ++c) {
        const size_t t0 = (size_t)b * SEQ + (size_t)c * 128;
        __syncthreads();
        {
            int tq = tid; OPAQUE(tq);
            const int c_mat = tq >> 8, c_ch = tq & 15, c_rg = (tq >> 4) & 15;
            const int chan0 = c_mat * 512 + hd * 128 + c_ch * 8;
            const float kscale = c_mat ? 0.08838834764831845f : 1.0f;
            float cw[4][8], cb[8];
            { const float* cwp = conv_w + chan0; const float* cbp = conv_b + chan0; asm volatile("" : "+v"(cwp), "+v"(cbp));
#pragma unroll
              for (int j = 0; j < 4; ++j) { const f32x4 a = *(const f32x4*)(cwp + j * 1024), c4 = *(const f32x4*)(cwp + j * 1024 + 4);
                cw[j][0] = a[0]; cw[j][1] = a[1]; cw[j][2] = a[2]; cw[j][3] = a[3]; cw[j][4] = c4[0]; cw[j][5] = c4[1]; cw[j][6] = c4[2]; cw[j][7] = c4[3]; }
              const f32x4 a = *(const f32x4*)cbp, c4 = *(const f32x4*)(cbp + 4); cb[0] = a[0]; cb[1] = a[1]; cb[2] = a[2]; cb[3] = a[3]; cb[4] = c4[0]; cb[5] = c4[1]; cb[6] = c4[2]; cb[7] = c4[3]; }
            const bf16_t* src = Z + (t0 + c_rg * 8) * NZ + (c_mat ? ZC_MK : ZC_MQ) + hd * 128 + c_ch * 8;
            float win[3][8];
#pragma unroll
            for (int j = 0; j < 3; ++j) {
                const int lp = c * 128 + c_rg * 8 - 3 + j;
                u32x4 raw = {0u, 0u, 0u, 0u};
                if (lp >= 0) raw = *(const u32x4*)(src + (ptrdiff_t)(j - 3) * NZ);
                win[j][0] = bf_lo(raw.x); win[j][1] = bf_hi(raw.x); win[j][2] = bf_lo(raw.y); win[j][3] = bf_hi(raw.y); win[j][4] = bf_lo(raw.z); win[j][5] = bf_hi(raw.z); win[j][6] = bf_lo(raw.w); win[j][7] = bf_hi(raw.w);
            }
#pragma unroll 2
            for (int i = 0; i < 8; ++i) {
                const u32x4 raw = *(const u32x4*)(src + (size_t)i * NZ);
                float cur[8] = { bf_lo(raw.x), bf_hi(raw.x), bf_lo(raw.y), bf_hi(raw.y), bf_lo(raw.z), bf_hi(raw.z), bf_lo(raw.w), bf_hi(raw.w) };
                float o[8];
#pragma unroll
                for (int e = 0; e < 8; ++e) { const float y = cb[e] + cw[0][e] * win[0][e] + cw[1][e] * win[1][e] + cw[2][e] * win[2][e] + cw[3][e] * cur[e]; o[e] = siluf_(y) * kscale; }
#pragma unroll
                for (int e = 0; e < 8; ++e) { win[0][e] = win[1][e]; win[1][e] = win[2][e]; win[2][e] = cur[e]; }
                u32x4 w; w.x = pk2(o[0], o[1]); w.y = pk2(o[2], o[3]); w.z = pk2(o[4], o[5]); w.w = pk2(o[6], o[7]);
                *(LAS u32x4*)(lds + (c_mat ? KI : QI) + off_b(c_rg * 8 + i, c_ch)) = w;
            }
        }
        { int tq = tid; OPAQUE(tq);
#pragma unroll
        for (int i = 0; i < 8; ++i) { const int idx = tq + 512 * i, row = idx >> 5, ch32 = idx & 31;
            const u32x4 raw = *(const u32x4*)(Z + (t0 + row) * NZ + ZC_MV + hd * 256 + ch32 * 8);
            *(LAS u32x4*)(lds + VI + (ch32 >> 4) * 32768 + off_b(row, ch32 & 15)) = raw; } }
        if (tid < 128) { const float* g = GIF + (t0 + tid) * 8; sc[F_IG + tid] = g[hd]; sc[F_LF + tid] = log_sigmoid(g[4 + hd]);
            if (c > 0) sc[F_N + tid] = sc[F_MISC + 1] * sc[F_N + tid] + (sc[F_NP + tid] + sc[F_NP + 128 + tid]) + (sc[F_NP + 256 + tid] + sc[F_NP + 384 + tid]); }
        __syncthreads();
        if (wid == 0) {
            const float ig0 = sc[F_IG + 2 * lane], ig1 = sc[F_IG + 2 * lane + 1], lf0 = sc[F_LF + 2 * lane], lf1 = sc[F_LF + 2 * lane + 1];
            const float s2 = lf0 + lf1, incl = scan_add(s2, lane), excl = incl - s2;
            const float b0 = excl + lf0, b1 = incl, a0 = ig0 - b0, a1 = ig1 - b1;
            const float im = scan_max(fmaxf(a0, a1), lane); float em = __shfl_up(im, 1); if (lane == 0) em = -3.0e38f;
            const float cm0 = fmaxf(em, a0), cm1 = im;
            const float M0 = fmaxf(m_prev, cm0), M1 = fmaxf(m_prev, cm1);
            const float ML = __shfl(M1, 63), bL = __shfl(b1, 63);
            sc[F_A + 2 * lane] = a0; sc[F_A + 2 * lane + 1] = a1; sc[F_M + 2 * lane] = M0; sc[F_M + 2 * lane + 1] = M1;
            sc[F_INTER + 2 * lane] = __expf(m_prev - M0); sc[F_INTER + 2 * lane + 1] = __expf(m_prev - M1);
            sc[F_EMT + 2 * lane] = __expf(-(b0 + M0)); sc[F_EMT + 2 * lane + 1] = __expf(-(b1 + M1));
            sc[F_W + 2 * lane] = __expf(a0 - ML); sc[F_W + 2 * lane + 1] = __expf(a1 - ML);
            if (lane == 0) sc[F_MISC + 0] = __expf(m_prev - ML);
            m_prev = bL + ML;
        }
        f32x16 sT[2];
#pragma unroll
        for (int jj = 0; jj < 2; ++jj) {
#pragma unroll
            for (int r = 0; r < 16; ++r) sT[jj][r] = 0.f;
            const int j = st_j0 + jj;
            if (j <= st_i) { MLS_LV; const unsigned fh = (16u * hi) ^ f16;
#pragma unroll
                for (int ks = 0; ks < 8; ++ks) { const unsigned xo = rowb + ((32u * ks) ^ fh);
                    const bf16x8 a = *(const LAS bf16x8*)(lds + KI + 8192 * j + xo), q = *(const LAS bf16x8*)(lds + QI + 8192 * st_i + xo);
                    sT[jj] = MFMA32(a, q, sT[jj]); }
            }
        }
        __syncthreads();
        u32x2 pp[2][4];
        { MLS_LV; const int t = 32 * st_i + r32; const float Mt = sc[F_M + t]; const unsigned ab = SC + 4 * F_A + 128 * st_j0 + 16 * hi;
#pragma unroll
          for (int jj = 0; jj < 2; ++jj) { const int j = st_j0 + jj;
#pragma unroll
            for (int g4 = 0; g4 < 4; ++g4) { const int s0 = 32 * j + 8 * g4 + 4 * hi; float pv[4];
#pragma unroll
                for (int e = 0; e < 4; ++e) { const int s = s0 + e; pv[e] = (s <= t) ? __expf(*(const LAS float*)(lds + ab + 4 * (32 * jj + 8 * g4 + e)) - Mt) * sT[jj][4 * g4 + e] : 0.f; }
                pp[jj][g4].x = pk2(pv[0], pv[1]); pp[jj][g4].y = pk2(pv[2], pv[3]); } } }
        f32x16 acc[4];
#pragma unroll
        for (int ti = 0; ti < 4; ++ti)
#pragma unroll
            for (int r = 0; r < 16; ++r) acc[ti][r] = 0.f;
        if (c > 0) {
#pragma unroll
            for (int dt = 0; dt < 4; ++dt)
#pragma unroll
                for (int s2 = 0; s2 < 2; ++s2) { const bf16x8 bfr = pack_step(CT[dt], s2); MLS_LV;
                    const unsigned a0 = QI + rowb + 8 * hi + ((64u * dt + 32u * s2) ^ f16), a1 = QI + rowb + 8 * hi + ((64u * dt + 32u * s2 + 16u) ^ f16);
#pragma unroll
                    for (int ti = 0; ti < 4; ++ti) {
                        const s16x4 lo = *(const LAS s16x4*)(lds + a0 + 8192 * ti), hi4 = *(const LAS s16x4*)(lds + a1 + 8192 * ti);
                        acc[ti] = MFMA32(cat8(lo, hi4), bfr, acc[ti]); }
                    __builtin_amdgcn_sched_barrier(0); }
        }
        { int tq = tid; OPAQUE(tq); const int t = tq & 127, part = tq >> 7; float d = 0.f;
#pragma unroll
          for (int cc = 0; cc < 4; ++cc) { const int ch = 4 * part + cc; const u32x4 raw = *(const LAS u32x4*)(lds + QI + off_b(t, ch)); const LAS float* nn = sc + F_N + 8 * ch;
              d += bf_lo(raw.x) * nn[0] + bf_hi(raw.x) * nn[1] + bf_lo(raw.y) * nn[2] + bf_hi(raw.y) * nn[3] + bf_lo(raw.z) * nn[4] + bf_hi(raw.z) * nn[5] + bf_lo(raw.w) * nn[6] + bf_hi(raw.w) * nn[7]; }
          sc[F_NQ2P + part * 128 + t] = d; }
        __syncthreads();
        { MLS_LV; const unsigned ib = SC + 4 * F_INTER + 16 * hi;
#pragma unroll
          for (int ti = 0; ti < 4; ++ti)
#pragma unroll
            for (int r = 0; r < 16; ++r) acc[ti][r] *= *(const LAS float*)(lds + ib + 4 * (32 * ti + (r & 3) + 8 * (r >> 2))); }
        { MLS_LV;
#pragma unroll
          for (int jj = 0; jj < 2; ++jj) { const int j = st_j0 + jj;
#pragma unroll
            for (int g4 = 0; g4 < 4; ++g4) *(LAS u32x2*)(lds + QI + 8192 * st_i + rowb + 8 * hi + ((64u * j + 16u * g4) ^ f16)) = pp[jj][g4]; } }
        { int tq = tid; OPAQUE(tq);
#pragma unroll
        for (int i = 0; i < 4; ++i) { const int idx = tq + 512 * i, row = idx >> 4, ch = idx & 15; LAS u32x4* p = (LAS u32x4*)(lds + KI + off_b(row, ch)); const u32x4 raw = *p; const float w = sc[F_W + row];
            u32x4 o; o.x = pk2(bf_lo(raw.x) * w, bf_hi(raw.x) * w); o.y = pk2(bf_lo(raw.y) * w, bf_hi(raw.y) * w); o.z = pk2(bf_lo(raw.z) * w, bf_hi(raw.z) * w); o.w = pk2(bf_lo(raw.w) * w, bf_hi(raw.w) * w); *p = o; } }
        __syncthreads();
        { const float decay = sc[F_MISC + 0];
#pragma unroll
          for (int dt = 0; dt < 4; ++dt)
#pragma unroll
            for (int r = 0; r < 16; ++r) CT[dt][r] *= decay; }
#pragma unroll
        for (int ks = 0; ks < 8; ++ks) {
            MLS_LV;
            const unsigned tbv0 = VI + img * 32768 + tr_base(L_, 0) + ((64u * vc) ^ q64), tbv1 = VI + img * 32768 + tr_base(L_, 1) + ((64u * vc) ^ q64);
            const unsigned tbk0 = KI + tr_base(L_, 0), tbk1 = KI + tr_base(L_, 1);
            const bf16x8 bv = cat8(tr_read(lds + tbv0 + 4096 * ks), tr_read(lds + tbv1 + 4096 * ks));
            const unsigned xo = QI + rowb + ((32u * ks) ^ ((16u * hi) ^ f16));
#pragma unroll
            for (int ti = 0; ti < 4; ++ti) if (ks < 2 * (ti + 1)) { const bf16x8 a = *(const LAS bf16x8*)(lds + xo + 8192 * ti); acc[ti] = MFMA32(a, bv, acc[ti]); }
#pragma unroll
            for (int dt = 0; dt < 4; ++dt) { const unsigned cx = (64u * dt) ^ q64; const bf16x8 a = cat8(tr_read(lds + tbk0 + 4096 * ks + cx), tr_read(lds + tbk1 + 4096 * ks + cx)); CT[dt] = MFMA32(a, bv, CT[dt]); }
            __builtin_amdgcn_sched_barrier(0);
        }
        { int tq = tid; OPAQUE(tq); const int t = tq & 127, part = tq >> 7; float d = 0.f;
#pragma unroll
          for (int cc = 0; cc < 4; ++cc) { const u32x4 raw = *(const LAS u32x4*)(lds + QI + off_b(t, 4 * part + cc));
              d += (bf_lo(raw.x) + bf_hi(raw.x)) + (bf_lo(raw.y) + bf_hi(raw.y)) + (bf_lo(raw.z) + bf_hi(raw.z)) + (bf_lo(raw.w) + bf_hi(raw.w)); }
          sc[F_NQ1P + part * 128 + t] = d;
          float nn = 0.f;
          for (int s = 32 * part; s < 32 * part + 32; ++s) nn += bf2f(*(const LAS bf16_t*)(lds + KI + off_b(s, t >> 3) + (t & 7) * 2));
          sc[F_NP + part * 128 + t] = nn;
          if (tid == 0) sc[F_MISC + 1] = sc[F_MISC + 0]; }
        __syncthreads();
        if (tid < 128) { const float nq1 = (sc[F_NQ1P + tid] + sc[F_NQ1P + 128 + tid]) + (sc[F_NQ1P + 256 + tid] + sc[F_NQ1P + 384 + tid]);
            const float nq2 = (sc[F_NQ2P + tid] + sc[F_NQ2P + 128 + tid]) + (sc[F_NQ2P + 256 + tid] + sc[F_NQ2P + 384 + tid]);
            sc[F_DEN + tid] = 1.0f / fmaxf(fabsf(nq1 + sc[F_INTER + tid] * nq2), sc[F_EMT + tid]); }
        __syncthreads();
        { MLS_LV; const unsigned db = SC + 4 * F_DEN + 16 * hi, hb = VI + 2048 * hi + (32 * wid + r32) * 2, qb = SC + 4 * (F_RSQ + wid * 128) + 16 * hi;
#pragma unroll
          for (int ti = 0; ti < 4; ++ti)
#pragma unroll
            for (int r = 0; r < 16; ++r) { const int tt = 32 * ti + (r & 3) + 8 * (r >> 2); const float x = acc[ti][r] * *(const LAS float*)(lds + db + 4 * tt);
                *(LAS bf16_t*)(lds + hb + 512 * tt) = (bf16_t)(pk2(x, 0.f) & 0xffffu);
                float q = x * x; q += __shfl_xor(q, 1); q += __shfl_xor(q, 2); q += __shfl_xor(q, 4); q += __shfl_xor(q, 8); q += __shfl_xor(q, 16);
                if (r32 == 0) *(LAS float*)(lds + qb + 4 * tt) = q; } }
        __syncthreads();
        { int tq = tid; OPAQUE(tq);
#pragma unroll 2
        for (int i = 0; i < 8; ++i) { const int idx = tq + 512 * i, row = idx >> 5, ch = idx & 31;
            float ssq = 0.f;
#pragma unroll
            for (int w = 0; w < 8; ++w) ssq += sc[F_RSQ + w * 128 + row];
            const float rstd = rsqrtf(ssq * (1.0f / 256.0f) + LN_EPS);
            const u32x4 hraw = *(const LAS u32x4*)(lds + VI + row * 512 + ch * 16);
            bf16_t* gp = Z + (t0 + row) * NZ + hd * 256 + ch * 8;
            const u32x4 oraw = *(const u32x4*)(gp + ZC_MO);
            const f32x4 g0 = *(const f32x4*)(norm_g + hd * 256 + ch * 8), g1 = *(const f32x4*)(norm_g + hd * 256 + ch * 8 + 4);
            u32x4 o;
            o.x = pk2(bf_lo(hraw.x) * rstd * g0[0] * sigmoidf_(bf_lo(oraw.x)), bf_hi(hraw.x) * rstd * g0[1] * sigmoidf_(bf_hi(oraw.x)));
            o.y = pk2(bf_lo(hraw.y) * rstd * g0[2] * sigmoidf_(bf_lo(oraw.y)), bf_hi(hraw.y) * rstd * g0[3] * sigmoidf_(bf_hi(oraw.y)));
            o.z = pk2(bf_lo(hraw.z) * rstd * g1[0] * sigmoidf_(bf_lo(oraw.z)), bf_hi(hraw.z) * rstd * g1[1] * sigmoidf_(bf_hi(oraw.z)));
            o.w = pk2(bf_lo(hraw.w) * rstd * g1[2] * sigmoidf_(bf_lo(oraw.w)), bf_hi(hraw.w) * rstd * g1[3] * sigmoidf_(bf_hi(oraw.w)));
            *(u32x4*)(gp + ZC_MV) = o; } }
    }
    __syncthreads();
}
#undef MLS_LV
}
namespace peer {
constexpr int KROW = 144;
constexpr int L_KEYS = 0, L_SELE = 2 * 128 * KROW, L_SELG = L_SELE + 32 * 128 * 2, L_IDX = L_SELG + 32 * 128 * 4, LDS_BYTES = L_IDX + 512 * 32;
DI unsigned ordf(float f) { const unsigned u = __float_as_uint(f); return u ^ ((unsigned)((int)u >> 31) | 0x80000000u); }
DI float deord(unsigned k) { return __uint_as_float(k ^ ((~(unsigned)((int)k >> 31)) | 0x80000000u)); }
DI void ins16(unsigned (&L)[16], unsigned v) {
#pragma unroll
    for (int j = 0; j < 16; ++j) { const unsigned t = L[j] > v ? L[j] : v; v = L[j] > v ? v : L[j]; L[j] = t; }
}
DI float gelu_erf(float x) { return 0.5f * x * (1.0f + erff(x * 0.7071067811865476f)); }

DI void stage_keys(LAS unsigned char* lds, const float* keys) {
    for (int i = threadIdx.x; i < 2 * 128 * 8; i += 512) { const int row = i >> 3, ch = i & 7; const float* s = keys + row * 64 + ch * 8;
        const f32x4 a = *(const f32x4*)s, b = *(const f32x4*)(s + 4);
        u32x4 w; w.x = pk2(a[0], a[1]); w.y = pk2(a[2], a[3]); w.z = pk2(b[0], b[1]); w.w = pk2(b[2], b[3]);
        *(LAS u32x4*)(lds + L_KEYS + row * KROW + ch * 16) = w; }
}

DI void select_tile(LAS unsigned char* lds, const bf16_t* QP, int tok0) {
    const int tid = threadIdx.x, lane = tid & 63, r32 = lane & 31, hi = lane >> 5; const int wid = __builtin_amdgcn_readfirstlane(tid >> 6);
    unsigned LA[16], LB[16];
#pragma unroll
    for (int p = 0; p < 2; ++p) {
        unsigned L[16];
#pragma unroll
        for (int i = 0; i < 16; ++i) L[i] = 0u;
        bf16x8 qf[4];
        { const bf16_t* qp = QP + (size_t)(tok0 + r32) * DM + wid * 128 + p * 64 + 8 * hi;
#pragma unroll
          for (int s = 0; s < 4; ++s) qf[s] = *(const bf16x8*)(qp + 16 * s); }
#pragma unroll
        for (int nt = 0; nt < 4; ++nt) {
            f32x16 acc;
#pragma unroll
            for (int r = 0; r < 16; ++r) acc[r] = 0.f;
#pragma unroll
            for (int s = 0; s < 4; ++s) { const bf16x8 a = *(const LAS bf16x8*)(lds + L_KEYS + (p * 128 + 32 * nt + r32) * KROW + (2 * s + hi) * 16); acc = MFMA32(a, qf[s], acc); }
#pragma unroll
            for (int r = 0; r < 16; ++r) ins16(L, (ordf(acc[r]) & ~0x7Fu) | (unsigned)(32 * nt + crow(r, hi)));
        }
        unsigned O[16];
#pragma unroll
        for (int i = 0; i < 16; ++i) O[i] = L[i];
#pragma unroll
        for (int i = 0; i < 16; ++i) ins16(L, (unsigned)__shfl_xor((int)O[i], 32));
#pragma unroll
        for (int i = 0; i < 16; ++i) { if (p == 0) LA[i] = L[i]; else LB[i] = L[i]; }
    }
    unsigned CL[16];
#pragma unroll
    for (int i = 0; i < 16; ++i) CL[i] = 0u;
#pragma unroll
    for (int i = 0; i < 16; ++i) {
        const float sa = deord(LA[i] & ~0x7Fu);
#pragma unroll
        for (int j = 0; j < 16; ++j) if ((i + 1) * (j + 1) <= 16) { const float sb = deord(LB[j] & ~0x7Fu); ins16(CL, (ordf(sa + sb) & ~0xFFu) | (unsigned)(i * 16 + j)); }
    }
    LAS unsigned char* itab = lds + L_IDX + tid * 32;
    { u32x4 wa, wb;
#pragma unroll
      for (int q = 0; q < 4; ++q) { wa[q] = (LA[4 * q] & 0x7Fu) | ((LA[4 * q + 1] & 0x7Fu) << 8) | ((LA[4 * q + 2] & 0x7Fu) << 16) | ((LA[4 * q + 3] & 0x7Fu) << 24);
                                    wb[q] = (LB[4 * q] & 0x7Fu) | ((LB[4 * q + 1] & 0x7Fu) << 8) | ((LB[4 * q + 2] & 0x7Fu) << 16) | ((LB[4 * q + 3] & 0x7Fu) << 24); }
      *(LAS u32x4*)itab = wa; *(LAS u32x4*)(itab + 16) = wb; }
    const float mx = deord(CL[0] & ~0xFFu);
    float ev[16], sum = 0.f;
#pragma unroll
    for (int k = 0; k < 16; ++k) { ev[k] = __expf(deord(CL[k] & ~0xFFu) - mx); sum += ev[k]; }
    const float inv = 1.0f / sum;
    LAS bf16_t* se = (LAS bf16_t*)(lds + L_SELE) + r32 * 128 + wid * 16;
    LAS float* sg = (LAS float*)(lds + L_SELG) + r32 * 128 + wid * 16;
#pragma unroll
    for (int k = 0; k < 16; ++k) if ((k >> 3) == hi) { const unsigned code = CL[k] & 0xFFu; const unsigned n1 = itab[code >> 4], n2 = itab[16 + (code & 15u)];
        se[k] = (bf16_t)(n1 * 128u + n2); sg[k] = ev[k] * inv; }
}

DI void eval_token(LAS unsigned char* lds, int tk, size_t tok, const bf16_t* H2, const unsigned char* U8, const unsigned char* V8, const float* SU, const float* SV,
                   const float* X1, const float* MOD, const float* ln_g, const float* ln_b, float* OUT) {
    const int lane = threadIdx.x & 63;
    int hq[4]; float sh;
    { const u32x4 a = *(const u32x4*)(H2 + tok * DM + 16 * lane), b = *(const u32x4*)(H2 + tok * DM + 16 * lane + 8);
      const float hv[16] = { bf_lo(a.x), bf_hi(a.x), bf_lo(a.y), bf_hi(a.y), bf_lo(a.z), bf_hi(a.z), bf_lo(a.w), bf_hi(a.w), bf_lo(b.x), bf_hi(b.x), bf_lo(b.y), bf_hi(b.y), bf_lo(b.z), bf_hi(b.z), bf_lo(b.w), bf_hi(b.w) };
      float amax = 0.f;
#pragma unroll
      for (int i = 0; i < 16; ++i) amax = fmaxf(amax, fabsf(hv[i]));
#pragma unroll
      for (int o = 1; o < 64; o <<= 1) amax = fmaxf(amax, __shfl_xor(amax, o));
      const float inv = amax > 0.f ? 127.0f / amax : 0.f; sh = amax * (1.0f / 127.0f);
#pragma unroll
      for (int j = 0; j < 4; ++j) { const int q0 = (int)rintf(hv[4 * j] * inv), q1 = (int)rintf(hv[4 * j + 1] * inv), q2 = (int)rintf(hv[4 * j + 2] * inv), q3 = (int)rintf(hv[4 * j + 3] * inv);
          hq[j] = (int)((unsigned)(q0 & 255) | ((unsigned)(q1 & 255) << 8) | ((unsigned)(q2 & 255) << 16) | ((unsigned)(q3 & 255) << 24)); } }
    float yf[16]; float csum = 0.f;
#pragma unroll
    for (int i = 0; i < 16; ++i) yf[i] = 0.f;
    const LAS bf16_t* se = (const LAS bf16_t*)(lds + L_SELE) + tk * 128;
    const LAS float* sg = (const LAS float*)(lds + L_SELG) + tk * 128;
    for (int g = 0; g < 32; ++g) {
        u32x4 ur[4], vr[4]; float gu[4], gv[4];
#pragma unroll
        for (int kk = 0; kk < 4; ++kk) { const unsigned e = (unsigned)__builtin_amdgcn_readfirstlane((int)se[4 * g + kk]); const float gk = sg[4 * g + kk];
            ur[kk] = *(const u32x4*)(U8 + (size_t)e * DM + 16 * lane); vr[kk] = *(const u32x4*)(V8 + (size_t)e * DM + 16 * lane);
            gu[kk] = SU[e] * sh; gv[kk] = gk * SV[e]; }
#pragma unroll
        for (int kk = 0; kk < 4; ++kk) {
            int d = __builtin_amdgcn_sdot4((int)ur[kk].x, hq[0], 0, false); d = __builtin_amdgcn_sdot4((int)ur[kk].y, hq[1], d, false);
            d = __builtin_amdgcn_sdot4((int)ur[kk].z, hq[2], d, false); d = __builtin_amdgcn_sdot4((int)ur[kk].w, hq[3], d, false);
            const float s = wave_sum((float)d) * gu[kk];
            const float coef = gv[kk] * gelu_erf(s); csum += coef;
#pragma unroll
            for (int i = 0; i < 4; ++i) { const unsigned u = vr[kk][i];
                yf[4 * i] += coef * (float)(u & 0xffu); yf[4 * i + 1] += coef * (float)((u >> 8) & 0xffu); yf[4 * i + 2] += coef * (float)((u >> 16) & 0xffu); yf[4 * i + 3] += coef * (float)(u >> 24); }
        }
    }
#pragma unroll
    for (int i = 0; i < 16; ++i) yf[i] -= 128.0f * csum;
    const int b = (int)(tok / SEQ);
    const float* xr = X1 + tok * DM + 16 * lane; const float* gt = MOD + (size_t)b * MODW + 5 * DM + 16 * lane;
    float r[16]; float s1 = 0.f;
#pragma unroll
    for (int j = 0; j < 4; ++j) { const f32x4 x = *(const f32x4*)(xr + 4 * j), g4 = *(const f32x4*)(gt + 4 * j);
#pragma unroll
        for (int e = 0; e < 4; ++e) { r[4 * j + e] = ALPHA_RES * x[e] + g4[e] * yf[4 * j + e]; s1 += r[4 * j + e]; } }
    const float mean = wave_sum(s1) * (1.0f / DM); float s2 = 0.f;
#pragma unroll
    for (int i = 0; i < 16; ++i) { r[i] -= mean; s2 += r[i] * r[i]; }
    const float rstd = rsqrtf(wave_sum(s2) * (1.0f / DM) + LN_EPS);
    float* op = OUT + tok * DM + 16 * lane;
#pragma unroll
    for (int j = 0; j < 4; ++j) { const f32x4 g4 = *(const f32x4*)(ln_g + 16 * lane + 4 * j), b4 = *(const f32x4*)(ln_b + 16 * lane + 4 * j);
        f32x4 o; o[0] = r[4 * j] * rstd * g4[0] + b4[0]; o[1] = r[4 * j + 1] * rstd * g4[1] + b4[1]; o[2] = r[4 * j + 2] * rstd * g4[2] + b4[2]; o[3] = r[4 * j + 3] * rstd * g4[3] + b4[3];
        *(f32x4*)(op + 4 * j) = o; }
}
}
constexpr int NWAVES = 8;
#ifndef MK_N_LAUNCHES
#define MK_N_LAUNCHES 1
#endif
constexpr int N_PHASES = 10;
constexpr int RING_BYTES = 147456;
constexpr int MISC_OFF = RING_BYTES;
constexpr int LDS_BYTES = RING_BYTES + 4096;
static_assert(pg8::STAGE_BYTES <= RING_BYTES && datt::LDS_BYTES <= RING_BYTES && mls::LDS_BYTES <= RING_BYTES && peer::LDS_BYTES <= RING_BYTES, "LDS map");

typedef GAS unsigned gu32;
#define RLX_AGENT __ATOMIC_RELAXED, __HIP_MEMORY_SCOPE_AGENT
#define LDS_WAIT() asm volatile("s_waitcnt lgkmcnt(0)" ::: "memory")

#define XB_TMO      128
#define XB_XCNT(j)  (256  + 64 * (j))
#define XB_XSUB(j)  (1280 + 64 * (j))
#define XB_XGEN(j)  (2304 + 64 * (j))
#define XB_TOP      3328
#define XB_TOPGEN   3392
#define XCD_BAR_WORDS 3456
#define XB_SPIN_CAP (1u << 22)
DI unsigned xb_ld(unsigned* p)              { return __hip_atomic_load(p, __ATOMIC_RELAXED, __HIP_MEMORY_SCOPE_AGENT); }
DI unsigned xb_add(unsigned* p, unsigned v) { return __hip_atomic_fetch_add(p, v, __ATOMIC_RELAXED, __HIP_MEMORY_SCOPE_AGENT); }
DI unsigned xb_xcc_id() { return (unsigned)__builtin_amdgcn_s_getreg((3 << 11) | 20) & 0xFu; }
#define XB_SPIN(cond, bar) do { unsigned _sp = 0; while (cond) { __builtin_amdgcn_s_sleep(1); \
    if ((++_sp & 255u) == 0u) { if (xb_ld(&(bar)[XB_TMO])) break; if (_sp > XB_SPIN_CAP) { atomicAdd(&(bar)[XB_TMO], 1u); break; } } } } while (0)
struct XcdBarrier { unsigned* bar; unsigned x; volatile LAS unsigned* st; };
DI XcdBarrier xcd_barrier_post(unsigned* bar, volatile LAS unsigned* st) {
    XcdBarrier b; b.bar = bar; b.x = xb_xcc_id(); b.st = st;
    if (threadIdx.x == 0) (void)xb_add(&bar[XB_XCNT(b.x)], 1u);
    return b;
}
DI void xcd_barrier_complete(unsigned* bar, unsigned x, unsigned& nloc, unsigned& nx) {
    const unsigned G = gridDim.x * gridDim.y * gridDim.z;
    unsigned sum, cnt, mine, sp = 0u;
    for (;;) {
        sum = 0u; cnt = 0u; mine = 0u;
#pragma unroll
        for (unsigned j = 0; j < 16; ++j) { const unsigned c = xb_ld(&bar[XB_XCNT(j)]); sum += c; cnt += (c > 0u) ? 1u : 0u; mine = (j == x) ? c : mine; }
        if (sum == G) break;
        __builtin_amdgcn_s_sleep(1);
        if ((++sp & 255u) == 0u) { if (xb_ld(&bar[XB_TMO])) break; if (sp > XB_SPIN_CAP) { atomicAdd(&bar[XB_TMO], 1u); break; } }
    }
    nloc = mine > 0u ? mine : 1u; nx = cnt > 0u ? cnt : 1u;
}
DI void xcd_barrier(const XcdBarrier& b) {
    asm volatile("s_waitcnt vmcnt(0)" ::: "memory");
    __syncthreads();
    if (threadIdx.x == 0) {
        unsigned* bar = b.bar;
        __builtin_amdgcn_s_waitcnt(0);
        unsigned nloc = b.st[0], nx = b.st[1];
        if (nloc == 0u) { xcd_barrier_complete(bar, b.x, nloc, nx); b.st[0] = nloc; b.st[1] = nx; }
        const unsigned old = xb_add(&bar[XB_XSUB(b.x)], 1u);
        const unsigned gen = old / nloc;
        if (old + 1u == (gen + 1u) * nloc) {
            __builtin_amdgcn_fence(__ATOMIC_RELEASE, "agent");
            asm volatile("s_waitcnt vmcnt(0)" ::: "memory");
            const unsigned og = xb_add(&bar[XB_TOP], 1u);
            const unsigned tg = og / nx;
            if (og + 1u == (tg + 1u) * nx) xb_add(&bar[XB_TOPGEN], 1u);
            else XB_SPIN(xb_ld(&bar[XB_TOPGEN]) == tg, bar);
            __builtin_amdgcn_fence(__ATOMIC_ACQUIRE, "agent");
            xb_add(&bar[XB_XGEN(b.x)], 1u);
            asm volatile("s_waitcnt vmcnt(0)" ::: "memory");
        } else {
            XB_SPIN(xb_ld(&bar[XB_XGEN(b.x)]) == gen, bar);
            __builtin_amdgcn_fence(__ATOMIC_ACQUIRE, "agent");
            asm volatile("s_waitcnt vmcnt(0)" ::: "memory");
        }
    }
    __syncthreads();
}

DI void p0_transpose_item(const float* W, int ldw, int col0, bf16_t* WT, int K, int dst_row0, int kb, float scale, LAS float* scr, int lane) {
    const int k0 = 64 * kb;
#pragma unroll 8
    for (int i = 0; i < 32; ++i) { const int kk = 2 * i + (lane >> 5); scr[kk * 33 + (lane & 31)] = W[(size_t)(k0 + kk) * ldw + col0 + (lane & 31)] * scale; }
    LDS_WAIT(); asm volatile("" ::: "memory");
    const int c = lane & 7;
#pragma unroll
    for (int j = 0; j < 4; ++j) { const int n = (lane >> 3) + 8 * j; const LAS float* s = scr + (8 * c) * 33 + n;
        u32x4 o; o.x = pk2(s[0 * 33], s[1 * 33]); o.y = pk2(s[2 * 33], s[3 * 33]); o.z = pk2(s[4 * 33], s[5 * 33]); o.w = pk2(s[6 * 33], s[7 * 33]);
        *(u32x4*)(WT + (size_t)(dst_row0 + n) * K + k0 + 8 * c) = o; }
    LDS_WAIT(); asm volatile("" ::: "memory");
}

struct Args { const float* in[22]; float* out; unsigned char* ws; int ph_lo, ph_hi; };

__global__ void __launch_bounds__(NWAVES * 64, 2) mega_fwd(Args args) {
    extern __shared__ __attribute__((aligned(16))) unsigned char lds_raw[];
    LAS unsigned char* lds = (LAS unsigned char*)lds_raw;
    volatile LAS unsigned* MISC = (volatile LAS unsigned*)(lds + MISC_OFF);
    const int tid = threadIdx.x, lane = tid & 63, wave = __builtin_amdgcn_readfirstlane(tid >> 6);
    const int G = gridDim.x; const int bx = blockIdx.x; const int vcu = (G % 8 == 0) ? (bx % 8) * (G / 8) + bx / 8 : bx;
    const int gw = vcu * NWAVES + wave, NGW = G * NWAVES;
#define ws (args.ws)
#define ctl ((unsigned*)(ws + WS_CTL))
#define x_in (args.in[0])
#define cvec (args.in[1])
#define w_ada (args.in[2])
#define b_ada (args.in[3])
#define w_in (args.in[4])
#define b_if (args.in[5])
#define conv_w (args.in[6])
#define conv_b (args.in[7])
#define da_lambda (args.in[8])
#define da_subln_g (args.in[9])
#define ml_norm_g (args.in[10])
#define w_br_attn (args.in[11])
#define w_br_mlstm (args.in[12])
#define w_out (args.in[13])
#define ln1_g (args.in[14])
#define ln1_b (args.in[15])
#define peer_wq (args.in[16])
#define peer_keys (args.in[17])
#define peer_u (args.in[18])
#define peer_v (args.in[19])
#define ln2_g (args.in[20])
#define ln2_b (args.in[21])
#define MOD ((float*)(ws + WS_MOD))
#define GIF ((float*)(ws + WS_GIF))
#define WIN ((bf16_t*)(ws + WS_WIN))
#define WA ((bf16_t*)(ws + WS_WA))
#define WM ((bf16_t*)(ws + WS_WM))
#define WOUT ((bf16_t*)(ws + WS_WOUT))
#define WQ ((bf16_t*)(ws + WS_WQ))
#define UT8 ((unsigned char*)(ws + WS_U))
#define VT8 ((unsigned char*)(ws + WS_V))
#define SUS ((float*)(ws + WS_SU))
#define SVS ((float*)(ws + WS_SV))
#define H1 ((bf16_t*)(ws + WS_H1))
#define Z ((bf16_t*)(ws + WS_Z))
#define R ((float*)(ws + WS_R))
#define X1 ((float*)(ws + WS_X1))
#define H2 ((bf16_t*)(ws + WS_H2))
#define QP ((bf16_t*)(ws + WS_QP))
#define GATES ((bf16_t*)args.out)

    for (int u = tid; u < (LDS_BYTES - MISC_OFF) / 4; u += NWAVES * 64) MISC[u] = 0u;
    __syncthreads();
    XcdBarrier bar; bar.bar = ctl + CW_BAR; bar.x = 0; bar.st = nullptr;
    if (MK_N_LAUNCHES != N_PHASES) bar = xcd_barrier_post(ctl + CW_BAR, MISC + 8);
    const int lo = args.ph_lo, hi = args.ph_hi;
#ifndef PH_MASK
#define PH_MASK 0x3ff
#endif
#define IN(k) (((PH_MASK >> (k)) & 1) && lo <= (k) && (k) < hi)
#define SEAM(k) do { if (IN(k) && IN((k) + 1)) xcd_barrier(bar); } while (0)

    if (IN(0)) {
        for (int it = gw; it < 96 * 8; it += NGW) {
            const int cb = it % 96, ks = it / 96, col = 64 * cb + lane;
            float acc[32];
#pragma unroll
            for (int b = 0; b < 32; ++b) acc[b] = 0.f;
            for (int k = 128 * ks; k < 128 * ks + 128; ++k) { const float w = w_ada[(size_t)k * MODW + col];
#pragma unroll
                for (int b = 0; b < 32; ++b) acc[b] += siluf_(cvec[b * DM + k]) * w; }
            const float bias = (ks == 0) ? b_ada[col] : 0.f;
#pragma unroll
            for (int b = 0; b < 32; ++b) atomicAdd(MOD + b * MODW + col, acc[b] + bias);
        }
        LAS float* scr = (LAS float*)(lds + wave * 16384);
        for (int it = gw; it < 4096 + 4 * 512; it += NGW) {
            if (it < 4096) { const int kb = it / 256, nb = it % 256, n0 = 32 * nb; p0_transpose_item(w_in, IN_W, n0 < NZ ? n0 : n0 + 8, WIN, DM, n0, kb, n0 < 1024 ? QSCALE : 1.0f, scr, lane); }
            else { const int r = it - 4096, wsel = r / 512, q = r % 512, kb = q / 32, nb = q % 32;
                const float* src = wsel == 0 ? w_br_attn : wsel == 1 ? w_br_mlstm : wsel == 2 ? w_out : peer_wq; bf16_t* dst = wsel == 0 ? WA : wsel == 1 ? WM : wsel == 2 ? WOUT : WQ;
                p0_transpose_item(src, DM, 32 * nb, dst, DM, 32 * nb, kb, 1.0f, scr, lane); }
        }
        for (int row = gw; row < 2 * NEXP; row += NGW) {
            const bool second = row >= NEXP; const int e = second ? row - NEXP : row;
            const float* s = (second ? peer_v : peer_u) + (size_t)e * DM + 16 * lane;
            f32x4 a[4]; float amax = 0.f;
#pragma unroll
            for (int j = 0; j < 4; ++j) { a[j] = *(const f32x4*)(s + 4 * j); amax = fmaxf(amax, fmaxf(fmaxf(fabsf(a[j].x), fabsf(a[j].y)), fmaxf(fabsf(a[j].z), fabsf(a[j].w)))); }
#pragma unroll
            for (int o = 1; o < 64; o <<= 1) amax = fmaxf(amax, __shfl_xor(amax, o));
            const float inv = amax > 0.f ? 127.0f / amax : 0.f; const int bias = second ? 128 : 0;
            u32x4 w;
#pragma unroll
            for (int j = 0; j < 4; ++j) { const int q0 = (int)rintf(a[j].x * inv) + bias, q1 = (int)rintf(a[j].y * inv) + bias, q2 = (int)rintf(a[j].z * inv) + bias, q3 = (int)rintf(a[j].w * inv) + bias;
                w[j] = (unsigned)(q0 & 255) | ((unsigned)(q1 & 255) << 8) | ((unsigned)(q2 & 255) << 16) | ((unsigned)(q3 & 255) << 24); }
            *(u32x4*)((second ? VT8 : UT8) + (size_t)e * DM + 16 * lane) = w;
            if (lane == 0) (second ? SVS : SUS)[e] = amax * (1.0f / 127.0f);
        }
    }
    SEAM(0);
    if (IN(1)) {
        LAS float* wif = (LAS float*)lds;
        for (int i = tid; i < 8192; i += 512) { const int k = i >> 3, j = i & 7; wif[j * 1024 + k] = w_in[(size_t)k * IN_W + NZ + j]; }
        __syncthreads();
        for (int m = gw; m < TOK; m += NGW) {
            const int b = m / SEQ;
            const f32x4* xr = (const f32x4*)(x_in + (size_t)m * DM) + lane;
            f32x4 v[4]; float s = 0.f;
#pragma unroll
            for (int j = 0; j < 4; ++j) { v[j] = xr[64 * j]; s += (v[j].x + v[j].y) + (v[j].z + v[j].w); }
            const float mean = wave_sum(s) * (1.f / DM); float s2 = 0.f;
#pragma unroll
            for (int j = 0; j < 4; ++j) { v[j] = v[j] - mean; s2 += (v[j].x * v[j].x + v[j].y * v[j].y) + (v[j].z * v[j].z + v[j].w * v[j].w); }
            const float rstd = rsqrtf(wave_sum(s2) * (1.f / DM) + LN_EPS);
            const f32x4* sh = (const f32x4*)(MOD + (size_t)b * MODW) + lane; const f32x4* sc = (const f32x4*)(MOD + (size_t)b * MODW + DM) + lane;
            unsigned long long* o8 = (unsigned long long*)(H1 + (size_t)m * DM) + lane;
            float gp[8];
#pragma unroll
            for (int g = 0; g < 8; ++g) gp[g] = 0.f;
#pragma unroll
            for (int j = 0; j < 4; ++j) { const f32x4 hh = v[j] * rstd * (sc[64 * j] + 1.0f) + sh[64 * j];
                o8[64 * j] = (unsigned long long)pk2(hh.x, hh.y) | ((unsigned long long)pk2(hh.z, hh.w) << 32);
#pragma unroll
                for (int g = 0; g < 8; ++g) { const f32x4 w = *(const LAS f32x4*)(wif + g * 1024 + 4 * (lane + 64 * j)); gp[g] += (hh.x * w.x + hh.y * w.y) + (hh.z * w.z + hh.w * w.w); } }
#pragma unroll
            for (int g = 0; g < 8; ++g) gp[g] = wave_sum(gp[g]);
            if (lane == 0) {
#pragma unroll
                for (int g = 0; g < 8; ++g) GIF[(size_t)m * 8 + g] = gp[g] + b_if[g]; }
        }
    }
    SEAM(1);
#ifndef REP2
#define REP2 1
#endif
    if (IN(2)) for (int rep2 = 0; rep2 < REP2; ++rep2) {
        pg8::Gemm g{H1, WIN, TOK, NIN, DM, DM, DM}; pg8::StaticOrder S; S.init(TOK, NIN, G, bx);
        pg8::EpiZ E{Z, GATES};
        pg8::gemm_phase<pg8::EpiZ, pg8::StaticOrder, true, true>(lds, g, S, E);
    }
    SEAM(2);
    if (IN(3)) {
        unsigned* qhead = ctl + CW_QUEUE;
        for (;;) {
            __syncthreads();
            if (tid == 0) MISC[0] = __hip_atomic_fetch_add(qhead, 1u, RLX_AGENT);
            __syncthreads();
            const int id = (int)MISC[0];
            if (id >= 128 + 2048) break;
#ifndef NO_MLS
            if (id < 128) mls::mlstm_unit(lds, Z, GIF, conv_w, conv_b, ml_norm_g, id >> 2, id & 3);
            else
#endif
#ifndef NO_ATT
            { const int idx = id - 128, qb = 7 - idx / 256, bh = idx % 256; datt::attn_unit(lds, Z, da_lambda, da_subln_g, bh >> 3, bh & 7, qb); }
#else
            {}
#endif
        }
    }
    SEAM(3);
    if (IN(4)) {
        pg8::Gemm g{Z + ZC_Q, WA, TOK, DM, DM, NZ, DM}; pg8::StaticOrder S; S.init(TOK, DM, G, bx);
        pg8::EpiGate<true> E{GATES, H1};
        pg8::gemm_phase<pg8::EpiGate<true>, pg8::StaticOrder, true, true>(lds, g, S, E);
    }
    SEAM(4);
    if (IN(5)) {
        pg8::Gemm g{Z + ZC_MV, WM, TOK, DM, DM, NZ, DM}; pg8::StaticOrder S; S.init(TOK, DM, G, bx);
        pg8::EpiGate<false> E{GATES + DM, H1};
        pg8::gemm_phase<pg8::EpiGate<false>, pg8::StaticOrder, true, true>(lds, g, S, E);
    }
    SEAM(5);
    if (IN(6)) {
        pg8::Gemm g{H1, WOUT, TOK, DM, DM, DM, DM}; pg8::StaticOrder S; S.init(TOK, DM, G, bx);
        pg8::EpiR E{x_in, MOD, R};
        pg8::gemm_phase<pg8::EpiR, pg8::StaticOrder, true, true>(lds, g, S, E);
    }
    SEAM(6);
    if (IN(7)) {
        for (int m = gw; m < TOK; m += NGW) {
            const int b = m / SEQ;
            const f32x4* rr = (const f32x4*)(R + (size_t)m * DM) + lane;
            f32x4 v[4]; float s = 0.f;
#pragma unroll
            for (int j = 0; j < 4; ++j) { v[j] = rr[64 * j]; s += (v[j].x + v[j].y) + (v[j].z + v[j].w); }
            float mean = wave_sum(s) * (1.f / DM); float s2 = 0.f;
#pragma unroll
            for (int j = 0; j < 4; ++j) { v[j] = v[j] - mean; s2 += (v[j].x * v[j].x + v[j].y * v[j].y) + (v[j].z * v[j].z + v[j].w * v[j].w); }
            float rstd = rsqrtf(wave_sum(s2) * (1.f / DM) + LN_EPS);
            f32x4* xo = (f32x4*)(X1 + (size_t)m * DM) + lane; s = 0.f;
#pragma unroll
            for (int j = 0; j < 4; ++j) { v[j] = v[j] * rstd * ((const f32x4*)ln1_g)[lane + 64 * j] + ((const f32x4*)ln1_b)[lane + 64 * j]; xo[64 * j] = v[j]; s += (v[j].x + v[j].y) + (v[j].z + v[j].w); }
            mean = wave_sum(s) * (1.f / DM); s2 = 0.f;
#pragma unroll
            for (int j = 0; j < 4; ++j) { v[j] = v[j] - mean; s2 += (v[j].x * v[j].x + v[j].y * v[j].y) + (v[j].z * v[j].z + v[j].w * v[j].w); }
            rstd = rsqrtf(wave_sum(s2) * (1.f / DM) + LN_EPS);
            const f32x4* sh = (const f32x4*)(MOD + (size_t)b * MODW + 3 * DM) + lane; const f32x4* sc = (const f32x4*)(MOD + (size_t)b * MODW + 4 * DM) + lane;
            unsigned long long* o8 = (unsigned long long*)(H2 + (size_t)m * DM) + lane;
#pragma unroll
            for (int j = 0; j < 4; ++j) { const f32x4 hh = v[j] * rstd * (sc[64 * j] + 1.0f) + sh[64 * j]; o8[64 * j] = (unsigned long long)pk2(hh.x, hh.y) | ((unsigned long long)pk2(hh.z, hh.w) << 32); }
        }
    }
    SEAM(7);
    if (IN(8)) {
        pg8::Gemm g{H2, WQ, TOK, DM, DM, DM, DM}; pg8::StaticOrder S; S.init(TOK, DM, G, bx);
        pg8::EpiStore E{QP};
        pg8::gemm_phase<pg8::EpiStore, pg8::StaticOrder, true, true>(lds, g, S, E);
    }
    SEAM(8);
#ifndef REP9
#define REP9 1
#endif
    if (IN(9)) for (int rep9 = 0; rep9 < REP9; ++rep9) {
        __syncthreads();
        peer::stage_keys(lds, peer_keys);
        for (int tile = bx; tile < TOK / 32; tile += G) {
            __syncthreads();
            peer::select_tile(lds, QP, tile * 32);
            __syncthreads();
#pragma unroll 1
            for (int j = 0; j < 4; ++j) peer::eval_token(lds, wave * 4 + j, (size_t)tile * 32 + wave * 4 + j, H2, UT8, VT8, SUS, SVS, X1, MOD, ln2_g, ln2_b, args.out);
        }
    }
#undef IN
#undef SEAM
#undef ws
#undef ctl
#undef x_in
#undef cvec
#undef w_ada
#undef b_ada
#undef w_in
#undef b_if
#undef conv_w
#undef conv_b
#undef da_lambda
#undef da_subln_g
#undef ml_norm_g
#undef w_br_attn
#undef w_br_mlstm
#undef w_out
#undef ln1_g
#undef ln1_b
#undef peer_wq
#undef peer_keys
#undef peer_u
#undef peer_v
#undef ln2_g
#undef ln2_b
#undef MOD
#undef GIF
#undef WIN
#undef WA
#undef WM
#undef WOUT
#undef WQ
#undef UT8
#undef VT8
#undef SUS
#undef SVS
#undef H1
#undef Z
#undef R
#undef X1
#undef H2
#undef QP
#undef GATES
}

extern "C" void kernel_launch(void* const* d_in, const int* in_sizes, int n_in, void* d_out, int out_size, void* d_ws, size_t ws_size, hipStream_t stream) {
    static int grid = 0;
    if (grid == 0) {
        if (n_in != 22 || in_sizes[0] != TOK * DM || out_size != TOK * DM || ws_size < WS_END) { fprintf(stderr, "kernel_launch: unexpected shapes (n_in %d, in0 %d, out %d, ws %zu; need ws >= %zu)\n", n_in, n_in > 0 ? in_sizes[0] : -1, out_size, ws_size, (size_t)WS_END); grid = -1; return; }
        int dev = 0, cus = 0, per_cu = 0;
        if (hipGetDevice(&dev) != hipSuccess || hipDeviceGetAttribute(&cus, hipDeviceAttributeMultiprocessorCount, dev) != hipSuccess) { fprintf(stderr, "kernel_launch: device query failed\n"); grid = -1; return; }
        if (hipFuncSetAttribute((const void*)mega_fwd, hipFuncAttributeMaxDynamicSharedMemorySize, LDS_BYTES) != hipSuccess) { fprintf(stderr, "kernel_launch: hipFuncSetAttribute failed\n"); grid = -1; return; }
        if (hipOccupancyMaxActiveBlocksPerMultiprocessor(&per_cu, (const void*)mega_fwd, NWAVES * 64, LDS_BYTES) != hipSuccess || per_cu < 1) fprintf(stderr, "kernel_launch: note: occupancy query reports %d workgroups per CU\n", per_cu);
        (void)hipGetLastError();
        grid = cus;
    }
    if (grid < 0) return;
    if (hipMemsetAsync((char*)d_ws + WS_CTL, 0, CTL_ZERO_BYTES, stream) != hipSuccess) { fprintf(stderr, "kernel_launch: memset failed\n"); return; }
    Args a{};
    for (int i = 0; i < 22; ++i) a.in[i] = (const float*)d_in[i];
    a.out = (float*)d_out; a.ws = (unsigned char*)d_ws;
    for (int li = 0; li < MK_N_LAUNCHES; ++li) {
        a.ph_lo = (MK_N_LAUNCHES == N_PHASES) ? li : 0; a.ph_hi = (MK_N_LAUNCHES == N_PHASES) ? li + 1 : N_PHASES;
        hipLaunchKernelGGL(mega_fwd, dim3(grid), dim3(NWAVES * 64), LDS_BYTES, stream, a);
        const hipError_t le = hipPeekAtLastError();
        if (le != hipSuccess) { fprintf(stderr, "kernel_launch: launch %d failed: %s\n", li, hipGetErrorName(le)); break; }
    }
}
```

```cpp
#include <hip/hip_runtime.h>
#include <hip/hip_bf16.h>
#include <cstdio>
#include <cstdint>
#include <cmath>

#define LAS __attribute__((address_space(3)))
#define GAS __attribute__((address_space(1)))
typedef unsigned short bf16_t;
typedef short bf16x8 __attribute__((ext_vector_type(8)));
typedef short s16x4 __attribute__((ext_vector_type(4)));
typedef float f32x2 __attribute__((ext_vector_type(2)));
typedef float f32x4 __attribute__((ext_vector_type(4)));
typedef float f32x16 __attribute__((ext_vector_type(16)));
typedef unsigned u32x2 __attribute__((ext_vector_type(2)));
typedef unsigned u32x4 __attribute__((ext_vector_type(4)));
typedef __bf16 bf16x2_t __attribute__((ext_vector_type(2)));
#define DI __device__ __forceinline__

constexpr int BATCH = 32, SEQ = 2048, DM = 1024, TOK = BATCH * SEQ;
constexpr int NZ = 6144;
constexpr int ZC_Q = 0, ZC_K = 1024, ZC_V = 2048, ZC_MQ = 3072, ZC_MK = 3584, ZC_MV = 4096, ZC_MO = 5120;
constexpr int NGATE = 2048;
constexpr int NIN = 8192;
constexpr int IN_W = 8200;
constexpr int MODW = 6 * DM;
constexpr float LN_EPS = 1e-5f;
constexpr float ALPHA_RES = 1.189207115002721f;
constexpr float LAMBDA_INIT = 0.2f;
constexpr float QSCALE = 0.125f * 1.4426950408889634f;
constexpr int NEXP = 16384;

constexpr size_t MiB = 1u << 20;
constexpr size_t WS_CTL = 0, CTL_ZERO_BYTES = 2 * MiB;
constexpr size_t WS_MOD = 1 * MiB;
constexpr size_t WS_GIF = 3 * MiB;
constexpr size_t WS_WIN = 6 * MiB;
constexpr size_t WS_WA = 22 * MiB, WS_WM = 24 * MiB, WS_WOUT = 26 * MiB, WS_WQ = 28 * MiB;
constexpr size_t WS_U = 30 * MiB, WS_V = 62 * MiB;
constexpr size_t WS_SU = 2 * MiB, WS_SV = 2 * MiB + 65536, WS_SH = 2 * MiB + 131072, WS_CS = 2 * MiB + 393216;
constexpr size_t WS_H2Q = 96 * MiB, WS_SELE = 160 * MiB, WS_SELG = 176 * MiB;
constexpr size_t WS_H1 = 96 * MiB;
constexpr size_t WS_Z = 224 * MiB;
constexpr size_t WS_R = WS_Z, WS_X1 = WS_Z + 256 * MiB, WS_H2 = WS_Z + 512 * MiB, WS_QP = WS_Z + 640 * MiB;
constexpr size_t WS_PART = WS_R, WS_COEF = WS_H2;
constexpr size_t WS_END = 992 * MiB;
constexpr int CW_BAR = 4096;
constexpr int CW_QUEUE = 16384;

DI unsigned pk2(float lo, float hi) { f32x2 v = {lo, hi}; bf16x2_t b = __builtin_convertvector(v, bf16x2_t); return __builtin_bit_cast(unsigned, b); }
DI float bf_lo(unsigned u) { return __uint_as_float(u << 16); }
DI float bf_hi(unsigned u) { return __uint_as_float(u & 0xffff0000u); }
DI float bf2f(bf16_t h) { return __uint_as_float(((unsigned)h) << 16); }
DI float wave_sum(float v) {
#pragma unroll
    for (int o = 1; o < 64; o <<= 1) v += __shfl_xor(v, o);
    return v;
}
DI float sigmoidf_(float x) { return 1.0f / (1.0f + __expf(-x)); }
DI float siluf_(float x) { return x / (1.0f + __expf(-x)); }
DI int crow(int r, int hi) { return (r & 3) + 8 * (r >> 2) + 4 * hi; }
#define MFMA32(a, b, c) __builtin_amdgcn_mfma_f32_32x32x16_bf16((a), (b), (c), 0, 0, 0)
DI bf16x8 pack_step(const f32x16& x, int s) {
    u32x4 p;
    p[0] = pk2(x[8 * s + 0], x[8 * s + 1]); p[1] = pk2(x[8 * s + 2], x[8 * s + 3]); p[2] = pk2(x[8 * s + 4], x[8 * s + 5]); p[3] = pk2(x[8 * s + 6], x[8 * s + 7]);
    return __builtin_bit_cast(bf16x8, p);
}
DI unsigned off_b(unsigned row, unsigned ch) { return 256u * row + 16u * (ch ^ (((row & 3) << 2) | ((row >> 2) & 3))); }
DI unsigned row_read_addr(unsigned lane, unsigned rt, unsigned s) { return off_b(32 * rt + (lane & 31), 2 * s + (lane >> 5)); }
DI unsigned tr_read_addr(unsigned lane, unsigned c, unsigned ks, unsigned t) {
    const unsigned h = lane >> 5, blk = (lane >> 4) & 1, q = (lane & 15) >> 2, p = lane & 3;
    return off_b(16 * ks + 8 * h + 4 * t + q, 4 * c + 2 * blk + (p >> 1)) + 8 * (p & 1);
}
DI unsigned tr_base(unsigned lane, unsigned t) { const unsigned h = lane >> 5, blk = (lane >> 4) & 1, q = (lane & 15) >> 2, p = lane & 3, cl = 2 * blk + (p >> 1);
    return 256u * (8 * h + 4 * t + q) + 16u * (cl ^ (2 * h + t)) + 8u * (p & 1); }
#define OPAQUE(x) asm volatile("" : "+v"(x))
typedef short v4i16_t __attribute__((ext_vector_type(4)));
DI s16x4 tr_read(const LAS unsigned char* p) { return __builtin_bit_cast(s16x4, __builtin_amdgcn_ds_read_tr16_b64_v4i16((LAS v4i16_t*)p)); }
DI bf16x8 cat8(s16x4 lo, s16x4 hi) { return __builtin_shufflevector(lo, hi, 0, 1, 2, 3, 4, 5, 6, 7); }
namespace pg8 {
#define PG8_LAS __attribute__((address_space(3)))
typedef unsigned short bf16_t;
typedef short bf16x8 __attribute__((ext_vector_type(8)));
typedef float f32x4 __attribute__((ext_vector_type(4)));
typedef unsigned u32x4 __attribute__((ext_vector_type(4)));
constexpr int BM = 256, BK = 64, HALF = 128, HTB = HALF * BK * 2  , STAGE_BYTES = 8 * HTB, NXCD = 8, WGM = 8;

__host__ __device__ __forceinline__ int lds_byte(int r, int c) { const int st = (r >> 4) * 2 + (c >> 5), rr = r & 15, cc = c & 31, ob = rr * 64 + cc * 2; return st * 1024 + (ob ^ (((ob >> 9) & 1) << 5)); }
__host__ __device__ __forceinline__ void stage_rc(int b, int& R, int& C) { const int st = b / 1024, sb = b % 1024, swz = sb ^ (((sb >> 9) & 1) << 5); R = (st >> 1) * 16 + swz / 64; C = (st & 1) * 32 + (swz % 64) / 2; }
__host__ __device__ __forceinline__ int perm32(int rho) { const int n = rho >> 4, i = rho & 15; return 8 * (i >> 2) + 4 * n + (i & 3); }

struct Unit { int pm, pn; };
struct Gemm { const bf16_t* A; const bf16_t* Bt; int M, N, K, lda, ldb; };

struct StaticOrder {
    int nM, nN, nwg, G, c;
    __host__ __device__ void init(int M, int N, int G_, int c_) { nM = M / BM; nN = N / BM; nwg = nM * nN; G = G_; c = c_; }
    __host__ __device__ bool next(int i, Unit& u) const {
        const long L = (long)i * G + c; if (L >= nwg) return false;
        int wgid = (int)L; { const int q = nwg / NXCD, r = nwg % NXCD, xcd = wgid % NXCD, off = wgid / NXCD; wgid = (xcd < r ? xcd * (q + 1) : r * (q + 1) + (xcd - r) * q) + off; }
        const int nig = WGM * nN, gid = wgid / nig, fm = gid * WGM, gsz = (nM - fm) < WGM ? (nM - fm) : WGM;
        u.pm = fm + ((wgid % nig) % gsz); u.pn = (wgid % nig) / gsz; return true;
    }
    __device__ __forceinline__ void a_ready(const Unit&) const {}
    __device__ __forceinline__ void done(const Unit&) const {}
};

template <class Epi, class Sched, bool ALIGN_EPI = false, bool SP2 = false>
__device__ __forceinline__ void gemm_phase(PG8_LAS unsigned char* lds, const Gemm g, const Sched& S, const Epi& E) {
    const int tid = threadIdx.x, wid = __builtin_amdgcn_readfirstlane(tid >> 6), lane = tid & 63, wr = wid >> 2, wc = wid & 3, fr = lane & 15, fq = lane >> 4;
    const int K = g.K, nt = K / BK;
    unsigned voffA[2], voffB[2];
#pragma unroll
    for (int i = 0; i < 2; ++i) { int R, C; stage_rc(tid * 16 + i * 8192, R, C); const int Rb = Epi::PERM ? ((R & ~31) + perm32(R & 31)) : R;
        voffA[i] = (unsigned)(R * g.lda + C) * 2u; voffB[i] = (unsigned)(Rb * g.ldb + C) * 2u; }
    const size_t kstep = (size_t)(BK * 2);
    const size_t hstepA = (size_t)HALF * g.lda * 2, hstepB = (size_t)HALF * g.ldb * 2;
    const size_t tstepA = 2 * hstepA, tstepB = 2 * hstepB;
    const unsigned ldsw = (unsigned)wid * 1024u;
    const int aoff = lds_byte(wr * 64 + fr, fq * 8), boff = lds_byte(wc * 32 + fr, fq * 8);
#define PG8_SA(b, h) (((b) * 2 + (h)) * HTB)
#define PG8_SB(b, h) ((4 + (b) * 2 + (h)) * HTB)
#define PG8_STAGE(bufoff, gbase, voff) do { _Pragma("unroll") for (int _i = 0; _i < 2; ++_i) \
        __builtin_amdgcn_global_load_lds((const unsigned*)((const char*)(gbase) + (voff)[_i]), (PG8_LAS unsigned*)(lds + (bufoff) + ldsw + _i * 8192), 16, 0, 0); } while (0)
#define PG8_LDA(dst, b, h) do { _Pragma("unroll") for (int m = 0; m < 4; ++m) _Pragma("unroll") for (int k = 0; k < 2; ++k) dst[m][k] = *(const PG8_LAS bf16x8*)(lds + PG8_SA(b, h) + aoff + m * 2048 + k * 1024); } while (0)
#define PG8_LDB(dst, b, h) do { _Pragma("unroll") for (int n = 0; n < 2; ++n) _Pragma("unroll") for (int k = 0; k < 2; ++k) dst[n][k] = *(const PG8_LAS bf16x8*)(lds + PG8_SB(b, h) + boff + n * 2048 + k * 1024); } while (0)
#define PG8_MMA(ai, bj, At, Bt) do { __builtin_amdgcn_s_setprio(1); _Pragma("unroll") for (int m = 0; m < 4; ++m) _Pragma("unroll") for (int n = 0; n < 2; ++n) _Pragma("unroll") for (int k = 0; k < 2; ++k) \
        acc[ai][bj][m][n] = __builtin_amdgcn_mfma_f32_16x16x32_bf16(Bt[n][k], At[m][k], acc[ai][bj][m][n], 0, 0, 0); __builtin_amdgcn_s_setprio(0); } while (0)
#define PG8_WAIT_V(n) asm volatile("s_waitcnt vmcnt(" #n ")" ::: "memory")
#define PG8_WAIT_L(n) asm volatile("s_waitcnt lgkmcnt(" #n ")" ::: "memory")
#define PG8_BAR __builtin_amdgcn_s_barrier()
#define PG8_SCHED __builtin_amdgcn_sched_barrier(0)
    Unit cur, nxt; int ui = 0;
    if (!S.next(0, cur)) return;
    f32x4 acc[2][2][4][2];
#pragma unroll
    for (int a = 0; a < 2; ++a)
#pragma unroll
        for (int b = 0; b < 2; ++b)
#pragma unroll
            for (int m = 0; m < 4; ++m)
#pragma unroll
                for (int n = 0; n < 2; ++n) acc[a][b][m][n] = (f32x4){0.f, 0.f, 0.f, 0.f};
    bf16x8 At[4][2], B0[2][2], B1[2][2];
    const char* cA = (const char*)g.A + (size_t)cur.pm * tstepA; const char* cB = (const char*)g.Bt + (size_t)cur.pn * tstepB;
    S.a_ready(cur);
    if constexpr (SP2) {
        PG8_STAGE(PG8_SB(0, 0), cB, voffB); PG8_STAGE(PG8_SB(0, 1), cB + hstepB, voffB); PG8_STAGE(PG8_SA(0, 0), cA, voffA); PG8_STAGE(PG8_SA(0, 1), cA + hstepA, voffA);
        if (wr == 1) PG8_BAR;
        PG8_WAIT_V(2); PG8_BAR;
        PG8_STAGE(PG8_SB(1, 0), cB + kstep, voffB); PG8_STAGE(PG8_SA(1, 0), cA + kstep, voffA); PG8_STAGE(PG8_SB(1, 1), cB + hstepB + kstep, voffB);
        PG8_WAIT_V(6); PG8_BAR;
    } else {
        PG8_STAGE(PG8_SB(0, 0), cB, voffB); PG8_STAGE(PG8_SA(0, 0), cA, voffA); PG8_STAGE(PG8_SB(0, 1), cB + hstepB, voffB); PG8_STAGE(PG8_SA(0, 1), cA + hstepA, voffA);
        if (wr == 1) PG8_BAR;
        PG8_WAIT_V(4); PG8_BAR;
        PG8_STAGE(PG8_SB(1, 0), cB + kstep, voffB); PG8_STAGE(PG8_SA(1, 0), cA + kstep, voffA); PG8_STAGE(PG8_SB(1, 1), cB + hstepB + kstep, voffB);
        PG8_WAIT_V(6); PG8_BAR;
    }
    for (;;) {
        const bool has_next = S.next(ui + 1, nxt);
        const char* nA = has_next ? (const char*)g.A + (size_t)nxt.pm * tstepA : cA; const char* nB = has_next ? (const char*)g.Bt + (size_t)nxt.pn * tstepB : cB;
        for (int t = 0; t < nt; t += 2) {
            const bool last = (t == nt - 2);
            const char* a1 = cA + (size_t)(t + 1) * kstep;
            const char* a2 = last ? nA : cA + (size_t)(t + 2) * kstep; const char* b2 = last ? nB : cB + (size_t)(t + 2) * kstep;
            const char* a3 = a2 + kstep; const char* b3 = b2 + kstep;
            if (last && has_next) S.a_ready(nxt);
            if constexpr (SP2) {
            PG8_LDB(B0, 0, 0); PG8_LDB(B1, 0, 1); PG8_SCHED; PG8_LDA(At, 0, 0); PG8_STAGE(PG8_SA(1, 1), a1 + hstepA, voffA);
            PG8_WAIT_V(8); PG8_WAIT_L(0); PG8_BAR; PG8_MMA(0, 0, At, B0); PG8_MMA(0, 1, At, B1); PG8_BAR; PG8_SCHED;
            PG8_LDA(At, 0, 1); PG8_STAGE(PG8_SB(0, 0), b2, voffB); PG8_STAGE(PG8_SB(0, 1), b2 + hstepB, voffB); PG8_STAGE(PG8_SA(0, 0), a2, voffA);
            PG8_WAIT_V(8); PG8_WAIT_L(0); PG8_BAR; PG8_MMA(1, 0, At, B0); PG8_MMA(1, 1, At, B1); PG8_BAR; PG8_SCHED;
            PG8_LDB(B0, 1, 0); PG8_LDB(B1, 1, 1); PG8_SCHED; PG8_LDA(At, 1, 0); PG8_STAGE(PG8_SA(0, 1), a2 + hstepA, voffA);
            PG8_WAIT_V(8); PG8_WAIT_L(0); PG8_BAR; PG8_MMA(0, 0, At, B0); PG8_MMA(0, 1, At, B1); PG8_BAR; PG8_SCHED;
            PG8_LDA(At, 1, 1); PG8_STAGE(PG8_SB(1, 0), b3, voffB); PG8_STAGE(PG8_SB(1, 1), b3 + hstepB, voffB); PG8_STAGE(PG8_SA(1, 0), a3, voffA);
            PG8_WAIT_V(8); PG8_WAIT_L(0); PG8_BAR; PG8_MMA(1, 0, At, B0); PG8_MMA(1, 1, At, B1); PG8_BAR; PG8_SCHED;
            } else {
            PG8_LDB(B0, 0, 0); PG8_SCHED; PG8_LDA(At, 0, 0); PG8_STAGE(PG8_SA(1, 1), a1 + hstepA, voffA);
            PG8_WAIT_L(8); PG8_BAR; PG8_WAIT_L(0); PG8_MMA(0, 0, At, B0); PG8_BAR; PG8_SCHED;
            PG8_LDB(B1, 0, 1); PG8_STAGE(PG8_SB(0, 0), b2, voffB);
            PG8_BAR; PG8_WAIT_L(0); PG8_MMA(0, 1, At, B1); PG8_BAR;
            PG8_LDA(At, 0, 1); PG8_STAGE(PG8_SA(0, 0), a2, voffA);
            PG8_BAR; PG8_WAIT_L(0); PG8_MMA(1, 0, At, B0); PG8_BAR; PG8_SCHED;
            PG8_STAGE(PG8_SB(0, 1), b2 + hstepB, voffB);
            PG8_WAIT_V(6); PG8_BAR; PG8_MMA(1, 1, At, B1); PG8_BAR;
            PG8_LDB(B0, 1, 0); PG8_SCHED; PG8_LDA(At, 1, 0); PG8_STAGE(PG8_SA(0, 1), a2 + hstepA, voffA);
            PG8_WAIT_L(8); PG8_BAR; PG8_WAIT_L(0); PG8_MMA(0, 0, At, B0); PG8_BAR; PG8_SCHED;
            PG8_LDB(B1, 1, 1); PG8_STAGE(PG8_SB(1, 0), b3, voffB);
            PG8_BAR; PG8_WAIT_L(0); PG8_MMA(0, 1, At, B1); PG8_BAR;
            PG8_LDA(At, 1, 1); PG8_STAGE(PG8_SA(1, 0), a3, voffA);
            PG8_BAR; PG8_WAIT_L(0); PG8_MMA(1, 0, At, B0); PG8_BAR; PG8_SCHED;
            PG8_STAGE(PG8_SB(1, 1), b3 + hstepB, voffB);
            PG8_WAIT_V(6); PG8_BAR; PG8_MMA(1, 1, At, B1); PG8_BAR;
            }
        }
        if constexpr (ALIGN_EPI) { if (wr == 0) PG8_BAR; }
        if constexpr (!Epi::AFTER_DRAIN) { E(acc, cur, wr, wc, fr, fq); S.done(cur); }
        if (!has_next) break;
#pragma unroll
        for (int a = 0; a < 2; ++a)
#pragma unroll
            for (int b = 0; b < 2; ++b)
#pragma unroll
                for (int m = 0; m < 4; ++m)
#pragma unroll
                    for (int n = 0; n < 2; ++n) acc[a][b][m][n] = (f32x4){0.f, 0.f, 0.f, 0.f};
        cur = nxt; cA = nA; cB = nB; ++ui;
        if constexpr (ALIGN_EPI) { if (wr == 1) PG8_BAR; }
    }
    PG8_WAIT_V(0);
    if constexpr (!ALIGN_EPI) { if (wr == 0) PG8_BAR; }
    PG8_BAR;
    if constexpr (Epi::AFTER_DRAIN) { E.fused(acc, cur, wr, wc, fr, fq, lds, wid, lane); S.done(cur); }
#undef PG8_SA
#undef PG8_SB
#undef PG8_STAGE
#undef PG8_LDA
#undef PG8_LDB
#undef PG8_MMA
#undef PG8_WAIT_V
#undef PG8_WAIT_L
#undef PG8_BAR
#undef PG8_SCHED
}
}
namespace pg8 {
struct EpiZ {
    static constexpr bool PERM = true, AFTER_DRAIN = false;
    bf16_t* Z; bf16_t* G;
    __device__ __forceinline__ void operator()(const f32x4 (&acc)[2][2][4][2], const Unit& u, int wr, int wc, int fr, int fq) const {
        const int row0 = u.pm * BM + wr * 64 + fr, colt = u.pn * BM; const bool gate = colt >= NZ;
        bf16_t* base = gate ? G : Z; const int ld = gate ? NGATE : NZ; const int col0 = (gate ? colt - NZ : colt) + wc * 32 + 8 * fq;
#pragma unroll
        for (int ai = 0; ai < 2; ++ai)
#pragma unroll
            for (int m = 0; m < 4; ++m) { bf16_t* rowp = base + (size_t)(row0 + ai * HALF + m * 16) * ld + col0;
#pragma unroll
                for (int bj = 0; bj < 2; ++bj) { f32x4 v0 = acc[ai][bj][m][0], v1 = acc[ai][bj][m][1];
                    if (gate) {
#pragma unroll
                        for (int e = 0; e < 4; ++e) { v0[e] = sigmoidf_(v0[e]); v1[e] = sigmoidf_(v1[e]); } }
                    ::u32x4 w; w.x = pk2(v0[0], v0[1]); w.y = pk2(v0[2], v0[3]); w.z = pk2(v1[0], v1[1]); w.w = pk2(v1[2], v1[3]);
                    *(::u32x4*)(rowp + bj * HALF) = w; } }
    }
};
template <bool FIRST> struct EpiGate {
    static constexpr bool PERM = true, AFTER_DRAIN = false;
    const bf16_t* G; bf16_t* Y;
    __device__ __forceinline__ void operator()(const f32x4 (&acc)[2][2][4][2], const Unit& u, int wr, int wc, int fr, int fq) const {
        const int row0 = u.pm * BM + wr * 64 + fr, col0 = u.pn * BM + wc * 32 + 8 * fq;
#pragma unroll
        for (int ai = 0; ai < 2; ++ai)
#pragma unroll
            for (int m = 0; m < 4; ++m) { const size_t row = (size_t)(row0 + ai * HALF + m * 16);
#pragma unroll
                for (int bj = 0; bj < 2; ++bj) { const f32x4 v0 = acc[ai][bj][m][0], v1 = acc[ai][bj][m][1];
                    const ::u32x4 g = *(const ::u32x4*)(G + row * NGATE + col0 + bj * HALF);
                    float o[8] = { bf_lo(g.x) * v0[0], bf_hi(g.x) * v0[1], bf_lo(g.y) * v0[2], bf_hi(g.y) * v0[3], bf_lo(g.z) * v1[0], bf_hi(g.z) * v1[1], bf_lo(g.w) * v1[2], bf_hi(g.w) * v1[3] };
                    bf16_t* yp = Y + row * DM + col0 + bj * HALF;
                    if (!FIRST) { const ::u32x4 y = *(const ::u32x4*)yp;
                        o[0] += bf_lo(y.x); o[1] += bf_hi(y.x); o[2] += bf_lo(y.y); o[3] += bf_hi(y.y); o[4] += bf_lo(y.z); o[5] += bf_hi(y.z); o[6] += bf_lo(y.w); o[7] += bf_hi(y.w); }
                    ::u32x4 w; w.x = pk2(o[0], o[1]); w.y = pk2(o[2], o[3]); w.z = pk2(o[4], o[5]); w.w = pk2(o[6], o[7]);
                    *(::u32x4*)yp = w; } }
    }
};
struct EpiR {
    static constexpr bool PERM = true, AFTER_DRAIN = false;
    const float* X; const float* MOD; float* R;
    __device__ __forceinline__ void operator()(const f32x4 (&acc)[2][2][4][2], const Unit& u, int wr, int wc, int fr, int fq) const {
        const int row0 = u.pm * BM + wr * 64 + fr, col0 = u.pn * BM + wc * 32 + 8 * fq;
        const float* gt = MOD + (size_t)((u.pm * BM) / SEQ) * MODW + 2 * DM;
        f32x4 g[2][2];
#pragma unroll
        for (int bj = 0; bj < 2; ++bj) { g[bj][0] = *(const f32x4*)(gt + col0 + bj * HALF); g[bj][1] = *(const f32x4*)(gt + col0 + bj * HALF + 4); }
#pragma unroll
        for (int ai = 0; ai < 2; ++ai)
#pragma unroll
            for (int m = 0; m < 4; ++m) { const size_t off = (size_t)(row0 + ai * HALF + m * 16) * DM + col0;
#pragma unroll
                for (int bj = 0; bj < 2; ++bj) {
                    const f32x4 x0 = *(const f32x4*)(X + off + bj * HALF), x1 = *(const f32x4*)(X + off + bj * HALF + 4);
                    *(f32x4*)(R + off + bj * HALF) = x0 * ALPHA_RES + g[bj][0] * acc[ai][bj][m][0];
                    *(f32x4*)(R + off + bj * HALF + 4) = x1 * ALPHA_RES + g[bj][1] * acc[ai][bj][m][1]; } }
    }
};
struct EpiStore {
    static constexpr bool PERM = true, AFTER_DRAIN = false;
    bf16_t* O;
    __device__ __forceinline__ void operator()(const f32x4 (&acc)[2][2][4][2], const Unit& u, int wr, int wc, int fr, int fq) const {
        const int row0 = u.pm * BM + wr * 64 + fr, col0 = u.pn * BM + wc * 32 + 8 * fq;
#pragma unroll
        for (int ai = 0; ai < 2; ++ai)
#pragma unroll
            for (int m = 0; m < 4; ++m) { bf16_t* rowp = O + (size_t)(row0 + ai * HALF + m * 16) * DM + col0;
#pragma unroll
                for (int bj = 0; bj < 2; ++bj) { const f32x4 v0 = acc[ai][bj][m][0], v1 = acc[ai][bj][m][1];
                    ::u32x4 w; w.x = pk2(v0[0], v0[1]); w.y = pk2(v0[2], v0[3]); w.z = pk2(v1[0], v1[1]); w.w = pk2(v1[2], v1[3]);
                    *(::u32x4*)(rowp + bj * HALF) = w; } }
    }
};
}
namespace datt {
constexpr int KROW = 144;
constexpr int LDS_K = 0, LDS_V = 64 * KROW, LDS_ST = LDS_V + 64 * 256, STROW = 272, ST_WAVE = 32 * STROW, LDS_BYTES = LDS_ST + 8 * ST_WAVE;
DI unsigned vrow(unsigned key) { return (key & ~12u) | ((key & 4u) << 1) | ((key & 8u) >> 1); }

DI void attn_unit(LAS unsigned char* lds, bf16_t* Z, const float* lam, const float* subln_g, int b, int h, int qb) {
    const int tid = threadIdx.x, lane = tid & 63, r32 = lane & 31, hi = lane >> 5; const int wid = __builtin_amdgcn_readfirstlane(tid >> 6);
    const size_t rowbase = (size_t)b * SEQ;
    const int q_first = qb * 256 + wid * 32, q_me = q_first + r32;
    float lam_val;
    { const float p1 = lam[lane] * lam[64 + lane], p2 = lam[128 + lane] * lam[192 + lane]; lam_val = __expf(wave_sum(p1)) - __expf(wave_sum(p2)) + LAMBDA_INIT; }
    const int NT = 4 * (qb + 1);
    const int k_key = tid >> 3, k_ch = tid & 7;
    const int v_key0 = tid >> 4, v_ch = tid & 15;
    const unsigned tb0 = LDS_V + tr_base(lane, 0), tb1 = LDS_V + tr_base(lane, 1); unsigned q64 = ((lane & 15) >> 2) << 6;
    const unsigned kb = LDS_K + r32 * KROW + hi * 16;
#pragma unroll
    for (int m = 0; m < 2; ++m) {
        bf16x8 qf[4];
        { const bf16_t* qp = Z + (rowbase + q_me) * NZ + ZC_Q + h * 128 + m * 64 + 8 * hi;
#pragma unroll
          for (int s = 0; s < 4; ++s) qf[s] = *(const bf16x8*)(qp + 16 * s); }
        const bf16_t* ksrc = Z + (rowbase + k_key) * NZ + ZC_K + h * 128 + m * 64 + k_ch * 8;
        const bf16_t* vsrc = Z + (rowbase + v_key0) * NZ + ZC_V + h * 128 + v_ch * 8;
        f32x16 O[4];
#pragma unroll
        for (int c = 0; c < 4; ++c)
#pragma unroll
            for (int r = 0; r < 16; ++r) O[c][r] = 0.f;
        float mrun = -1e30f, lrun = 0.f;
        u32x4 pk_ = *(const u32x4*)ksrc, pv0 = *(const u32x4*)vsrc, pv1 = *(const u32x4*)(vsrc + (size_t)32 * NZ);
        for (int kt = 0; kt < NT; ++kt) {
            __syncthreads();
            *(LAS u32x4*)(lds + LDS_K + k_key * KROW + k_ch * 16) = pk_;
            *(LAS u32x4*)(lds + LDS_V + off_b(vrow(v_key0), v_ch)) = pv0;
            *(LAS u32x4*)(lds + LDS_V + off_b(vrow(v_key0 + 32), v_ch)) = pv1;
            __syncthreads();
            if (kt + 1 < NT) { const size_t o = (size_t)(kt + 1) * 64 * NZ; pk_ = *(const u32x4*)(ksrc + o); pv0 = *(const u32x4*)(vsrc + o); pv1 = *(const u32x4*)(vsrc + o + (size_t)32 * NZ); }
            if (kt * 64 > q_first + 31) continue;
            f32x16 p[2];
#pragma unroll
            for (int hf = 0; hf < 2; ++hf) {
#pragma unroll
                for (int r = 0; r < 16; ++r) p[hf][r] = 0.f;
#pragma unroll
                for (int s = 0; s < 4; ++s) { const bf16x8 a = *(const LAS bf16x8*)(lds + kb + 32 * hf * KROW + s * 32); p[hf] = MFMA32(a, qf[s], p[hf]); }
            }
            if (kt * 64 + 63 > q_first) {
#pragma unroll
                for (int hf = 0; hf < 2; ++hf)
#pragma unroll
                    for (int r = 0; r < 16; ++r) { const int key = kt * 64 + 32 * hf + crow(r, hi); if (key > q_me) p[hf][r] = -1e30f; }
            }
            float mx = p[0][0];
#pragma unroll
            for (int r = 1; r < 16; ++r) mx = fmaxf(mx, p[0][r]);
#pragma unroll
            for (int r = 0; r < 16; ++r) mx = fmaxf(mx, p[1][r]);
            mx = fmaxf(mx, __shfl_xor(mx, 32));
            const float mnew = fmaxf(mrun, mx), alpha = __builtin_amdgcn_exp2f(mrun - mnew); mrun = mnew;
            float ls = 0.f;
#pragma unroll
            for (int hf = 0; hf < 2; ++hf)
#pragma unroll
                for (int r = 0; r < 16; ++r) { const float e = __builtin_amdgcn_exp2f(p[hf][r] - mnew); p[hf][r] = e; ls += e; }
            lrun = lrun * alpha + ls;
#pragma unroll
            for (int c = 0; c < 4; ++c)
#pragma unroll
                for (int r = 0; r < 16; ++r) O[c][r] *= alpha;
            bf16x8 pf[4];
            pf[0] = pack_step(p[0], 0); pf[1] = pack_step(p[0], 1); pf[2] = pack_step(p[1], 0); pf[3] = pack_step(p[1], 1);
#pragma unroll
            for (int c = 0; c < 4; ++c) { OPAQUE(q64); const unsigned cx = (64u * c) ^ q64;
#pragma unroll
                for (int ks = 0; ks < 4; ++ks) {
                    const s16x4 lo = tr_read(lds + tb0 + cx + 4096 * ks), hi4 = tr_read(lds + tb1 + cx + 4096 * ks);
                    O[c] = MFMA32(cat8(lo, hi4), pf[ks], O[c]);
                } }
        }
        const float ltot = lrun + __shfl_xor(lrun, 32), inv = 1.0f / ltot;
        if (m == 0) {
            LAS unsigned char* stg = lds + LDS_ST + wid * ST_WAVE;
#pragma unroll
            for (int c = 0; c < 4; ++c)
#pragma unroll
                for (int g4 = 0; g4 < 4; ++g4) { const int dv0 = 32 * c + 8 * g4 + 4 * hi;
                    u32x2 w; w.x = pk2(O[c][4 * g4] * inv, O[c][4 * g4 + 1] * inv); w.y = pk2(O[c][4 * g4 + 2] * inv, O[c][4 * g4 + 3] * inv);
                    *(LAS u32x2*)(stg + r32 * STROW + dv0 * 2) = w; }
        } else {
            const float li = lam_val * inv;
            float ss = 0.f;
            LAS unsigned char* stg = lds + LDS_ST + wid * ST_WAVE;
#pragma unroll
            for (int c = 0; c < 4; ++c)
#pragma unroll
                for (int g4 = 0; g4 < 4; ++g4) { const int dv0 = 32 * c + 8 * g4 + 4 * hi; const u32x2 k2 = *(const LAS u32x2*)(stg + r32 * STROW + dv0 * 2);
                    O[c][4 * g4] = bf_lo(k2.x) - li * O[c][4 * g4]; O[c][4 * g4 + 1] = bf_hi(k2.x) - li * O[c][4 * g4 + 1]; O[c][4 * g4 + 2] = bf_lo(k2.y) - li * O[c][4 * g4 + 2]; O[c][4 * g4 + 3] = bf_hi(k2.y) - li * O[c][4 * g4 + 3];
                    ss += (O[c][4 * g4] * O[c][4 * g4] + O[c][4 * g4 + 1] * O[c][4 * g4 + 1]) + (O[c][4 * g4 + 2] * O[c][4 * g4 + 2] + O[c][4 * g4 + 3] * O[c][4 * g4 + 3]); }
            ss += __shfl_xor(ss, 32);
            const float rstd = rsqrtf(ss * (1.0f / 128.0f) + LN_EPS) * (1.0f - LAMBDA_INIT);
#pragma unroll
            for (int c = 0; c < 4; ++c)
#pragma unroll
                for (int g4 = 0; g4 < 4; ++g4) { const int dv0 = 32 * c + 8 * g4 + 4 * hi; const f32x4 gg = *(const f32x4*)(subln_g + dv0);
                    u32x2 w; w.x = pk2(O[c][4 * g4] * rstd * gg[0], O[c][4 * g4 + 1] * rstd * gg[1]); w.y = pk2(O[c][4 * g4 + 2] * rstd * gg[2], O[c][4 * g4 + 3] * rstd * gg[3]);
                    *(LAS u32x2*)(stg + r32 * STROW + dv0 * 2) = w; }
        }
    }
    LAS unsigned char* stg = lds + LDS_ST + wid * ST_WAVE;
    asm volatile("s_waitcnt lgkmcnt(0)" ::: "memory");
    bf16_t* obase = Z + (rowbase + q_first) * NZ + ZC_Q + h * 128;
#pragma unroll
    for (int i = 0; i < 8; ++i) { const int idx = lane + 64 * i, row = idx >> 4, ch = idx & 15;
        const u32x4 v = *(const LAS u32x4*)(stg + row * STROW + ch * 16); *(u32x4*)(obase + (size_t)row * NZ + ch * 8) = v; }
}
}
namespace mls {
constexpr int QI = 0, KI = 32768, VI = 65536, SC = 131072;
constexpr int F_IG = 0, F_LF = 128, F_A = 256, F_M = 384, F_INTER = 512, F_EMT = 640, F_W = 768, F_DEN = 896, F_N = 1024, F_MISC = 1152,
              F_NQ2P = 1280, F_NQ1P = 1792, F_NP = 2304, F_RSQ = 2816, F_END = 3840;
constexpr int LDS_BYTES = SC + F_END * 4;
static_assert(LDS_BYTES <= 147456, "mLSTM LDS");

DI float scan_add(float x, int lane) {
#pragma unroll
    for (int o = 1; o < 64; o <<= 1) { const float y = __shfl_up(x, o); if (lane >= o) x += y; }
    return x;
}
DI float scan_max(float x, int lane) {
#pragma unroll
    for (int o = 1; o < 64; o <<= 1) { const float y = __shfl_up(x, o); if (lane >= o) x = fmaxf(x, y); }
    return x;
}
DI float log_sigmoid(float x) { return fminf(x, 0.f) - __logf(1.0f + __expf(-fabsf(x))); }

DI void mlstm_unit(LAS unsigned char* lds, bf16_t* Z, const float* GIF, const float* conv_w, const float* conv_b, const float* norm_g, int b, int hd) {
    const int tid = threadIdx.x, lane = tid & 63; const int wid = __builtin_amdgcn_readfirstlane(tid >> 6);
    LAS float* sc = (LAS float*)(lds + SC);
#define MLS_LV unsigned L_ = lane; OPAQUE(L_); const unsigned r32 = L_ & 31, hi = L_ >> 5, rowb = 256u * r32, f16 = (((r32 & 3) << 2) | ((r32 >> 2) & 3)) << 4, q64 = ((L_ & 15) >> 2) << 6; (void)rowb; (void)f16; (void)q64; (void)hi
    f32x16 CT[4];
#pragma unroll
    for (int i = 0; i < 4; ++i)
#pragma unroll
        for (int r = 0; r < 16; ++r) CT[i][r] = 0.f;
    float m_prev = 0.f;
    if (tid < 128) sc[F_N + tid] = 0.f;
    const int img = wid >> 2, vc = wid & 3;
    const int st_i = wid >> 1, st_j0 = 2 * (wid & 1);

    for (int c = 0; c < 16; ++c) {
        const size_t t0 = (size_t)b * SEQ + (size_t)c * 128;
        __syncthreads();
        {
            int tq = tid; OPAQUE(tq);
            const int c_mat = tq >> 8, c_ch = tq & 15, c_rg = (tq >> 4) & 15;
            const int chan0 = c_mat * 512 + hd * 128 + c_ch * 8;
            const float kscale = c_mat ? 0.08838834764831845f : 1.0f;
            float cw[4][8], cb[8];
            { const float* cwp = conv_w + chan0; const float* cbp = conv_b + chan0; asm volatile("" : "+v"(cwp), "+v"(cbp));
#pragma unroll
              for (int j = 0; j < 4; ++j) { const f32x4 a = *(const f32x4*)(cwp + j * 1024), c4 = *(const f32x4*)(cwp + j * 1024 + 4);
                cw[j][0] = a[0]; cw[j][1] = a[1]; cw[j][2] = a[2]; cw[j][3] = a[3]; cw[j][4] = c4[0]; cw[j][5] = c4[1]; cw[j][6] = c4[2]; cw[j][7] = c4[3]; }
              const f32x4 a = *(const f32x4*)cbp, c4 = *(const f32x4*)(cbp + 4); cb[0] = a[0]; cb[1] = a[1]; cb[2] = a[2]; cb[3] = a[3]; cb[4] = c4[0]; cb[5] = c4[1]; cb[6] = c4[2]; cb[7] = c4[3]; }
            const bf16_t* src = Z + (t0 + c_rg * 8) * NZ + (c_mat ? ZC_MK : ZC_MQ) + hd * 128 + c_ch * 8;
            float win[3][8];
#pragma unroll
            for (int j = 0; j < 3; ++j) {
                const int lp = c * 128 + c_rg * 8 - 3 + j;
                u32x4 raw = {0u, 0u, 0u, 0u};
                if (lp >= 0) raw = *(const u32x4*)(src + (ptrdiff_t)(j - 3) * NZ);
                win[j][0] = bf_lo(raw.x); win[j][1] = bf_hi(raw.x); win[j][2] = bf_lo(raw.y); win[j][3] = bf_hi(raw.y); win[j][4] = bf_lo(raw.z); win[j][5] = bf_hi(raw.z); win[j][6] = bf_lo(raw.w); win[j][7] = bf_hi(raw.w);
            }
#pragma unroll 2
            for (int i = 0; i < 8; ++i) {
                const u32x4 raw = *(const u32x4*)(src + (size_t)i * NZ);
                float cur[8] = { bf_lo(raw.x), bf_hi(raw.x), bf_lo(raw.y), bf_hi(raw.y), bf_lo(raw.z), bf_hi(raw.z), bf_lo(raw.w), bf_hi(raw.w) };
                float o[8];
#pragma unroll
                for (int e = 0; e < 8; ++e) { const float y = cb[e] + cw[0][e] * win[0][e] + cw[1][e] * win[1][e] + cw[2][e] * win[2][e] + cw[3][e] * cur[e]; o[e] = siluf_(y) * kscale; }
#pragma unroll
                for (int e = 0; e < 8; ++e) { win[0][e] = win[1][e]; win[1][e] = win[2][e]; win[2][e] = cur[e]; }
                u32x4 w; w.x = pk2(o[0], o[1]); w.y = pk2(o[2], o[3]); w.z = pk2(o[4], o[5]); w.w = pk2(o[6], o[7]);
                *(LAS u32x4*)(lds + (c_mat ? KI : QI) + off_b(c_rg * 8 + i, c_ch)) = w;
            }
        }
        { int tq = tid; OPAQUE(tq);
#pragma unroll
        for (int i = 0; i < 8; ++i) { const int idx = tq + 512 * i, row = idx >> 5, ch32 = idx & 31;
            const u32x4 raw = *(const u32x4*)(Z + (t0 + row) * NZ + ZC_MV + hd * 256 + ch32 * 8);
            *(LAS u32x4*)(lds + VI + (ch32 >> 4) * 32768 + off_b(row, ch32 & 15)) = raw; } }
        if (tid < 128) { const float* g = GIF + (t0 + tid) * 8; sc[F_IG + tid] = g[hd]; sc[F_LF + tid] = log_sigmoid(g[4 + hd]);
            if (c > 0) sc[F_N + tid] = sc[F_MISC + 1] * sc[F_N + tid] + (sc[F_NP + tid] + sc[F_NP + 128 + tid]) + (sc[F_NP + 256 + tid] + sc[F_NP + 384 + tid]); }
        __syncthreads();
        if (wid == 0) {
            const float ig0 = sc[F_IG + 2 * lane], ig1 = sc[F_IG + 2 * lane + 1], lf0 = sc[F_LF + 2 * lane], lf1 = sc[F_LF + 2 * lane + 1];
            const float s2 = lf0 + lf1, incl = scan_add(s2, lane), excl = incl - s2;
            const float b0 = excl + lf0, b1 = incl, a0 = ig0 - b0, a1 = ig1 - b1;
            const float im = scan_max(fmaxf(a0, a1), lane); float em = __shfl_up(im, 1); if (lane == 0) em = -3.0e38f;
            const float cm0 = fmaxf(em, a0), cm1 = im;
            const float M0 = fmaxf(m_prev, cm0), M1 = fmaxf(m_prev, cm1);
            const float ML = __shfl(M1, 63), bL = __shfl(b1, 63);
            sc[F_A + 2 * lane] = a0; sc[F_A + 2 * lane + 1] = a1; sc[F_M + 2 * lane] = M0; sc[F_M + 2 * lane + 1] = M1;
            sc[F_INTER + 2 * lane] = __expf(m_prev - M0); sc[F_INTER + 2 * lane + 1] = __expf(m_prev - M1);
            sc[F_EMT + 2 * lane] = __expf(-(b0 + M0)); sc[F_EMT + 2 * lane + 1] = __expf(-(b1 + M1));
            sc[F_W + 2 * lane] = __expf(a0 - ML); sc[F_W + 2 * lane + 1] = __expf(a1 - ML);
            if (lane == 0) sc[F_MISC + 0] = __expf(m_prev - ML);
            m_prev = bL + ML;
        }
        f32x16 sT[2];
#pragma unroll
        for (int jj = 0; jj < 2; ++jj) {
#pragma unroll
            for (int r = 0; r < 16; ++r) sT[jj][r] = 0.f;
            const int j = st_j0 + jj;
            if (j <= st_i) { MLS_LV; const unsigned fh = (16u * hi) ^ f16;
#pragma unroll
                for (int ks = 0; ks < 8; ++ks) { const unsigned xo = rowb + ((32u * ks) ^ fh);
                    const bf16x8 a = *(const LAS bf16x8*)(lds + KI + 8192 * j + xo), q = *(const LAS bf16x8*)(lds + QI + 8192 * st_i + xo);
                    sT[jj] = MFMA32(a, q, sT[jj]); }
            }
        }
        __syncthreads();
        u32x2 pp[2][4];
        { MLS_LV; const int t = 32 * st_i + r32; const float Mt = sc[F_M + t]; const unsigned ab = SC + 4 * F_A + 128 * st_j0 + 16 * hi;
#pragma unroll
          for (int jj = 0; jj < 2; ++jj) { const int j = st_j0 + jj;
#pragma unroll
            for (int g4 = 0; g4 < 4; ++g4) { const int s0 = 32 * j + 8 * g4 + 4 * hi; float pv[4];
#pragma unroll
                for (int e = 0; e < 4; ++e) { const int s = s0 + e; pv[e] = (s <= t) ? __expf(*(const LAS float*)(lds + ab + 4 * (32 * jj + 8 * g4 + e)) - Mt) * sT[jj][4 * g4 + e] : 0.f; }
                pp[jj][g4].x = pk2(pv[0], pv[1]); pp[jj][g4].y = pk2(pv[2], pv[3]); } } }
        f32x16 acc[4];
#pragma unroll
        for (int ti = 0; ti < 4; ++ti)
#pragma unroll
            for (int r = 0; r < 16; ++r) acc[ti][r] = 0.f;
        if (c > 0) {
#pragma unroll
            for (int dt = 0; dt < 4; ++dt)
#pragma unroll
                for (int s2 = 0; s2 < 2; ++s2) { const bf16x8 bfr = pack_step(CT[dt], s2); MLS_LV;
                    const unsigned a0 = QI + rowb + 8 * hi + ((64u * dt + 32u * s2) ^ f16), a1 = QI + rowb + 8 * hi + ((64u * dt + 32u * s2 + 16u) ^ f16);
#pragma unroll
                    for (int ti = 0; ti < 4; ++ti) {
                        const s16x4 lo = *(const LAS s16x4*)(lds + a0 + 8192 * ti), hi4 = *(const LAS s16x4*)(lds + a1 + 8192 * ti);
                        acc[ti] = MFMA32(cat8(lo, hi4), bfr, acc[ti]); }
                    __builtin_amdgcn_sched_barrier(0); }
        }
        { int tq = tid; OPAQUE(tq); const int t = tq & 127, part = tq >> 7; float d = 0.f;
#pragma unroll
          for (int cc = 0; cc < 4; ++cc) { const int ch = 4 * part + cc; const u32x4 raw = *(const LAS u32x4*)(lds + QI + off_b(t, ch)); const LAS float* nn = sc + F_N + 8 * ch;
              d += bf_lo(raw.x) * nn[0] + bf_hi(raw.x) * nn[1] + bf_lo(raw.y) * nn[2] + bf_hi(raw.y) * nn[3] + bf_lo(raw.z) * nn[4] + bf_hi(raw.z) * nn[5] + bf_lo(raw.w) * nn[6] + bf_hi(raw.w) * nn[7]; }
          sc[F_NQ2P + part * 128 + t] = d; }
        __syncthreads();
        { MLS_LV; const unsigned ib = SC + 4 * F_INTER + 16 * hi;
#pragma unroll
          for (int ti = 0; ti < 4; ++ti)
#pragma unroll
            for (int r = 0; r < 16; ++r) acc[ti][r] *= *(const LAS float*)(lds + ib + 4 * (32 * ti + (r & 3) + 8 * (r >> 2))); }
        { MLS_LV;
#pragma unroll
          for (int jj = 0; jj < 2; ++jj) { const int j = st_j0 + jj;
#pragma unroll
            for (int g4 = 0; g4 < 4; ++g4) *(LAS u32x2*)(lds + QI + 8192 * st_i + rowb + 8 * hi + ((64u * j + 16u * g4) ^ f16)) = pp[jj][g4]; } }
        { int tq = tid; OPAQUE(tq);
#pragma unroll
        for (int i = 0; i < 4; ++i) { const int idx = tq + 512 * i, row = idx >> 4, ch = idx & 15; LAS u32x4* p = (LAS u32x4*)(lds + KI + off_b(row, ch)); const u32x4 raw = *p; const float w = sc[F_W + row];
            u32x4 o; o.x = pk2(bf_lo(raw.x) * w, bf_hi(raw.x) * w); o.y = pk2(bf_lo(raw.y) * w, bf_hi(raw.y) * w); o.z = pk2(bf_lo(raw.z) * w, bf_hi(raw.z) * w); o.w = pk2(bf_lo(raw.w) * w, bf_hi(raw.w) * w); *p = o; } }
        __syncthreads();
        { const float decay = sc[F_MISC + 0];
#pragma unroll
          for (int dt = 0; dt < 4; ++dt)
#pragma unroll
            for (int r = 0; r < 16; ++r) CT[dt][r] *= decay; }
#pragma unroll
        for (int ks = 0; ks < 8; ++ks) {
            MLS_LV;
            const unsigned tbv0 = VI + img * 32768 + tr_base(L_, 0) + ((64u * vc) ^ q64), tbv1 = VI + img * 32768 + tr_base(L_, 1) + ((64u * vc) ^ q64);
            const unsigned tbk0 = KI + tr_base(L_, 0), tbk1 = KI + tr_base(L_, 1);
            const bf16x8 bv = cat8(tr_read(lds + tbv0 + 4096 * ks), tr_read(lds + tbv1 + 4096 * ks));
            const unsigned xo = QI + rowb + ((32u * ks) ^ ((16u * hi) ^ f16));
#pragma unroll
            for (int ti = 0; ti < 4; ++ti) if (ks < 2 * (ti + 1)) { const bf16x8 a = *(const LAS bf16x8*)(lds + xo + 8192 * ti); acc[ti] = MFMA32(a, bv, acc[ti]); }
#pragma unroll
            for (int dt = 0; dt < 4; ++dt) { const unsigned cx = (64u * dt) ^ q64; const bf16x8 a = cat8(tr_read(lds + tbk0 + 4096 * ks + cx), tr_read(lds + tbk1 + 4096 * ks + cx)); CT[dt] = MFMA32(a, bv, CT[dt]); }
            __builtin_amdgcn_sched_barrier(0);
        }
        { int tq = tid; OPAQUE(tq); const int t = tq & 127, part = tq >> 7; float d = 0.f;
#pragma unroll
          for (int cc = 0; cc < 4; ++cc) { const u32x4 raw = *(const LAS u32x4*)(lds + QI + off_b(t, 4 * part + cc));
              d += (bf_lo(raw.x) + bf_hi(raw.x)) + (bf_lo(raw.y) + bf_hi(raw.y)) + (bf_lo(raw.z) + bf_hi(raw.z)) + (bf_lo(raw.w) + bf_hi(raw.w)); }
          sc[F_NQ1P + part * 128 + t] = d;
          float nn = 0.f;
          for (int s = 32 * part; s < 32 * part + 32; ++s) nn += bf2f(*(const LAS bf16_t*)(lds + KI + off_b(s, t >> 3) + (t & 7) * 2));
          sc[F_NP + part * 128 + t] = nn;
          if (tid == 0) sc[F_MISC + 1] = sc[F_MISC + 0]; }
        __syncthreads();
        if (tid < 128) { const float nq1 = (sc[F_NQ1P + tid] + sc[F_NQ1P + 128 + tid]) + (sc[F_NQ1P + 256 + tid] + sc[F_NQ1P + 384 + tid]);
            const float nq2 = (sc[F_NQ2P + tid] + sc[F_NQ2P + 128 + tid]) + (sc[F_NQ2P + 256 + tid] + sc[F_NQ2P + 384 + tid]);
            sc[F_DEN + tid] = 1.0f / fmaxf(fabsf(nq1 + sc[F_INTER + tid] * nq2), sc[F_EMT + tid]); }
        __syncthreads();
        { MLS_LV; const unsigned db = SC + 4 * F_DEN + 16 * hi, hb = VI + 2048 * hi + (32 * wid + r32) * 2, qb = SC + 4 * (F_RSQ + wid * 128) + 16 * hi;
#pragma unroll
          for (int ti = 0; ti < 4; ++ti)
#pragma unroll
            for (int r = 0; r < 16; ++r) { const int tt = 32 * ti + (r & 3) + 8 * (r >> 2); const float x = acc[ti][r] * *(const LAS float*)(lds + db + 4 * tt);
                *(LAS bf16_t*)(lds + hb + 512 * tt) = (bf16_t)(pk2(x, 0.f) & 0xffffu);
                float q = x * x; q += __shfl_xor(q, 1); q += __shfl_xor(q, 2); q += __shfl_xor(q, 4); q += __shfl_xor(q, 8); q += __shfl_xor(q, 16);
                if (r32 == 0) *(LAS float*)(lds + qb + 4 * tt) = q; } }
        __syncthreads();
        { int tq = tid; OPAQUE(tq);
#pragma unroll 2
        for (int i = 0; i < 8; ++i) { const int idx = tq + 512 * i, row = idx >> 5, ch = idx & 31;
            float ssq = 0.f;
#pragma unroll
            for (int w = 0; w < 8; ++w) ssq += sc[F_RSQ + w * 128 + row];
            const float rstd = rsqrtf(ssq * (1.0f / 256.0f) + LN_EPS);
            const u32x4 hraw = *(const LAS u32x4*)(lds + VI + row * 512 + ch * 16);
            bf16_t* gp = Z + (t0 + row) * NZ + hd * 256 + ch * 8;
            const u32x4 oraw = *(const u32x4*)(gp + ZC_MO);
            const f32x4 g0 = *(const f32x4*)(norm_g + hd * 256 + ch * 8), g1 = *(const f32x4*)(norm_g + hd * 256 + ch * 8 + 4);
            u32x4 o;
            o.x = pk2(bf_lo(hraw.x) * rstd * g0[0] * sigmoidf_(bf_lo(oraw.x)), bf_hi(hraw.x) * rstd * g0[1] * sigmoidf_(bf_hi(oraw.x)));
            o.y = pk2(bf_lo(hraw.y) * rstd * g0[2] * sigmoidf_(bf_lo(oraw.y)), bf_hi(hraw.y) * rstd * g0[3] * sigmoidf_(bf_hi(oraw.y)));
            o.z = pk2(bf_lo(hraw.z) * rstd * g1[0] * sigmoidf_(bf_lo(oraw.z)), bf_hi(hraw.z) * rstd * g1[1] * sigmoidf_(bf_hi(oraw.z)));
            o.w = pk2(bf_lo(hraw.w) * rstd * g1[2] * sigmoidf_(bf_lo(oraw.w)), bf_hi(hraw.w) * rstd * g1[3] * sigmoidf_(bf_hi(oraw.w)));
            *(u32x4*)(gp + ZC_MV) = o; } }
    }
    __syncthreads();
}
#undef MLS_LV
}
namespace peer {
constexpr int KROW = 144;
constexpr int L_KEYS = 0, L_IDX = 2 * 128 * KROW, LDS_BYTES = L_IDX + 512 * 32;
DI unsigned ordf(float f) { const unsigned u = __float_as_uint(f); return u ^ ((unsigned)((int)u >> 31) | 0x80000000u); }
DI float deord(unsigned k) { return __uint_as_float(k ^ ((~(unsigned)((int)k >> 31)) | 0x80000000u)); }
DI void ins16(unsigned (&L)[16], unsigned v) {
#pragma unroll
    for (int j = 0; j < 16; ++j) { const unsigned t = L[j] > v ? L[j] : v; v = L[j] > v ? v : L[j]; L[j] = t; }
}
DI float gelu_erf(float x) { return 0.5f * x * (1.0f + erff(x * 0.7071067811865476f)); }

DI void stage_keys(LAS unsigned char* lds, const float* keys) {
    for (int i = threadIdx.x; i < 2 * 128 * 8; i += 512) { const int row = i >> 3, ch = i & 7; const float* s = keys + row * 64 + ch * 8;
        const f32x4 a = *(const f32x4*)s, b = *(const f32x4*)(s + 4);
        u32x4 w; w.x = pk2(a[0], a[1]); w.y = pk2(a[2], a[3]); w.z = pk2(b[0], b[1]); w.w = pk2(b[2], b[3]);
        *(LAS u32x4*)(lds + L_KEYS + row * KROW + ch * 16) = w; }
}

DI void select_tile(LAS unsigned char* lds, const bf16_t* QP, int tok0, bf16_t* SELE, float* SELG) {
    const int tid = threadIdx.x, lane = tid & 63, r32 = lane & 31, hi = lane >> 5; const int wid = __builtin_amdgcn_readfirstlane(tid >> 6);
    unsigned LA[16], LB[16];
#pragma unroll
    for (int p = 0; p < 2; ++p) {
        unsigned L[16];
#pragma unroll
        for (int i = 0; i < 16; ++i) L[i] = 0u;
        bf16x8 qf[4];
        { const bf16_t* qp = QP + (size_t)(tok0 + r32) * DM + wid * 128 + p * 64 + 8 * hi;
#pragma unroll
          for (int s = 0; s < 4; ++s) qf[s] = *(const bf16x8*)(qp + 16 * s); }
#pragma unroll
        for (int nt = 0; nt < 4; ++nt) {
            f32x16 acc;
#pragma unroll
            for (int r = 0; r < 16; ++r) acc[r] = 0.f;
#pragma unroll
            for (int s = 0; s < 4; ++s) { const bf16x8 a = *(const LAS bf16x8*)(lds + L_KEYS + (p * 128 + 32 * nt + r32) * KROW + (2 * s + hi) * 16); acc = MFMA32(a, qf[s], acc); }
#pragma unroll
            for (int r = 0; r < 16; ++r) ins16(L, (ordf(acc[r]) & ~0x7Fu) | (unsigned)(32 * nt + crow(r, hi)));
        }
        unsigned O[16];
#pragma unroll
        for (int i = 0; i < 16; ++i) O[i] = L[i];
#pragma unroll
        for (int i = 0; i < 16; ++i) ins16(L, (unsigned)__shfl_xor((int)O[i], 32));
#pragma unroll
        for (int i = 0; i < 16; ++i) { if (p == 0) LA[i] = L[i]; else LB[i] = L[i]; }
    }
    unsigned CL[16];
#pragma unroll
    for (int i = 0; i < 16; ++i) CL[i] = 0u;
#pragma unroll
    for (int i = 0; i < 16; ++i) {
        const float sa = deord(LA[i] & ~0x7Fu);
#pragma unroll
        for (int j = 0; j < 16; ++j) if ((i + 1) * (j + 1) <= 16) { const float sb = deord(LB[j] & ~0x7Fu); ins16(CL, (ordf(sa + sb) & ~0xFFu) | (unsigned)(i * 16 + j)); }
    }
    LAS unsigned char* itab = lds + L_IDX + tid * 32;
    { u32x4 wa, wb;
#pragma unroll
      for (int q = 0; q < 4; ++q) { wa[q] = (LA[4 * q] & 0x7Fu) | ((LA[4 * q + 1] & 0x7Fu) << 8) | ((LA[4 * q + 2] & 0x7Fu) << 16) | ((LA[4 * q + 3] & 0x7Fu) << 24);
                                    wb[q] = (LB[4 * q] & 0x7Fu) | ((LB[4 * q + 1] & 0x7Fu) << 8) | ((LB[4 * q + 2] & 0x7Fu) << 16) | ((LB[4 * q + 3] & 0x7Fu) << 24); }
      *(LAS u32x4*)itab = wa; *(LAS u32x4*)(itab + 16) = wb; }
    const float mx = deord(CL[0] & ~0xFFu);
    float ev[16], sum = 0.f;
#pragma unroll
    for (int k = 0; k < 16; ++k) { ev[k] = __expf(deord(CL[k] & ~0xFFu) - mx); sum += ev[k]; }
    const float inv = 1.0f / sum;
    bf16_t* se = SELE + (size_t)(tok0 + r32) * 128 + wid * 16;
    float* sg = SELG + (size_t)(tok0 + r32) * 128 + wid * 16;
#pragma unroll
    for (int k = 0; k < 16; ++k) if ((k >> 3) == hi) { const unsigned code = CL[k] & 0xFFu; const unsigned n1 = itab[code >> 4], n2 = itab[16 + (code & 15u)];
        se[k] = (bf16_t)(n1 * 128u + n2); sg[k] = ev[k] * inv; }
}

DI void u_phase_tile(LAS unsigned char* lds, int tile, int x, const bf16_t* SELE, const unsigned char* H2Q, const unsigned char* U8S, float* PART) {
    const int tid = threadIdx.x, lane = tid & 63, j = lane >> 3, c = lane & 7; const int wid = __builtin_amdgcn_readfirstlane(tid >> 6);
    *(LAS u32x4*)(lds + tid * 16) = *(const u32x4*)(SELE + (size_t)tile * 32 * 128 + tid * 8);
    __syncthreads();
    const unsigned char* Us = U8S + (size_t)x * NEXP * 128 + 16 * c;
#pragma unroll 1
    for (int jt = 0; jt < 4; ++jt) {
        const int tk = wid * 4 + jt; const size_t t = (size_t)tile * 32 + tk;
        const u32x4 hq = *(const u32x4*)(H2Q + t * DM + 128 * x + 16 * c);
        const LAS bf16_t* se = (const LAS bf16_t*)lds + tk * 128 + j;
        u32x4 ur[16];
#pragma unroll
        for (int g = 0; g < 16; ++g) { const unsigned e = se[8 * g]; ur[g] = *(const u32x4*)(Us + (size_t)e * 128); }
        float keep0 = 0.f, keep1 = 0.f;
#pragma unroll
        for (int g = 0; g < 16; ++g) {
            int d = __builtin_amdgcn_sdot4((int)ur[g].x, (int)hq.x, 0, false); d = __builtin_amdgcn_sdot4((int)ur[g].y, (int)hq.y, d, false);
            d = __builtin_amdgcn_sdot4((int)ur[g].z, (int)hq.z, d, false); d = __builtin_amdgcn_sdot4((int)ur[g].w, (int)hq.w, d, false);
            d += __shfl_xor(d, 1); d += __shfl_xor(d, 2); d += __shfl_xor(d, 4);
            if ((g & 7) == c) { if (g < 8) keep0 = (float)d; else keep1 = (float)d; }
        }
        float* pp = PART + t * 1024 + x * 128 + 8 * c + j;
        pp[0] = keep0; pp[64] = keep1;
    }
}
DI void red_token(size_t t, const float* PART, const bf16_t* SELE, const float* SELG, const float* SU, const float* SV, const float* SH, float* COEF, float* CS) {
    const int lane = threadIdx.x & 63; const float sh = SH[t]; float cs = 0.f;
#pragma unroll
    for (int h = 0; h < 2; ++h) { const int k = lane + 64 * h; float s = 0.f;
#pragma unroll
        for (int xx = 0; xx < 8; ++xx) s += PART[t * 1024 + xx * 128 + k];
        const unsigned e = SELE[t * 128 + k];
        const float cf = SELG[t * 128 + k] * gelu_erf(s * SU[e] * sh) * SV[e];
        COEF[t * 128 + k] = cf; cs += cf; }
    cs = wave_sum(cs);
    if (lane == 0) CS[t] = cs;
}
DI void v_phase_tile(LAS unsigned char* lds, int tile, int x, const bf16_t* SELE, const float* COEF, const float* CS, const unsigned char* V8S, float* YF) {
    const int tid = threadIdx.x, lane = tid & 63, j = lane >> 3, c = lane & 7; const int wid = __builtin_amdgcn_readfirstlane(tid >> 6);
    *(LAS u32x4*)(lds + tid * 16) = *(const u32x4*)(SELE + (size_t)tile * 32 * 128 + tid * 8);
    *(LAS u32x4*)(lds + 8192 + tid * 16) = *(const u32x4*)(COEF + (size_t)tile * 32 * 128 + tid * 4);
    *(LAS u32x4*)(lds + 16384 + tid * 16) = *(const u32x4*)(COEF + (size_t)tile * 32 * 128 + 2048 + tid * 4);
    __syncthreads();
    const unsigned char* Vs = V8S + (size_t)x * NEXP * 128 + 16 * c;
#pragma unroll 1
    for (int jt = 0; jt < 4; ++jt) {
        const int tk = wid * 4 + jt; const size_t t = (size_t)tile * 32 + tk;
        const LAS bf16_t* se = (const LAS bf16_t*)lds + tk * 128 + j;
        const LAS float* cf = (const LAS float*)(lds + 8192) + tk * 128 + j;
        u32x4 vr[16];
#pragma unroll
        for (int g = 0; g < 16; ++g) { const unsigned e = se[8 * g]; vr[g] = *(const u32x4*)(Vs + (size_t)e * 128); }
        float acc[16];
#pragma unroll
        for (int i = 0; i < 16; ++i) acc[i] = 0.f;
#pragma unroll
        for (int g = 0; g < 16; ++g) { const float co = cf[8 * g];
#pragma unroll
            for (int i = 0; i < 4; ++i) { const unsigned u = vr[g][i];
                acc[4 * i] += co * (float)(u & 0xffu); acc[4 * i + 1] += co * (float)((u >> 8) & 0xffu); acc[4 * i + 2] += co * (float)((u >> 16) & 0xffu); acc[4 * i + 3] += co * (float)(u >> 24); } }
#pragma unroll
        for (int i = 0; i < 16; ++i) { acc[i] += __shfl_xor(acc[i], 8); acc[i] += __shfl_xor(acc[i], 16); acc[i] += __shfl_xor(acc[i], 32); }
        if (j == 0) { const float off = 128.0f * CS[t]; float* yp = YF + t * DM + 128 * x + 16 * c;
#pragma unroll
            for (int i = 0; i < 4; ++i) { f32x4 o; o[0] = acc[4 * i] - off; o[1] = acc[4 * i + 1] - off; o[2] = acc[4 * i + 2] - off; o[3] = acc[4 * i + 3] - off; *(f32x4*)(yp + 4 * i) = o; } }
    }
}
DI void final_row(size_t m, const float* YF, const float* X1, const float* MOD, const float* ln_g, const float* ln_b, float* OUT) {
    const int lane = threadIdx.x & 63; const int b = (int)(m / SEQ);
    const f32x4* yr = (const f32x4*)(YF + m * DM) + lane; const f32x4* xr = (const f32x4*)(X1 + m * DM) + lane; const f32x4* gt = (const f32x4*)(MOD + (size_t)b * MODW + 5 * DM) + lane;
    f32x4 v[4]; float s = 0.f;
#pragma unroll
    for (int q = 0; q < 4; ++q) { v[q] = xr[64 * q] * ALPHA_RES + gt[64 * q] * yr[64 * q]; s += (v[q].x + v[q].y) + (v[q].z + v[q].w); }
    const float mean = wave_sum(s) * (1.f / DM); float s2 = 0.f;
#pragma unroll
    for (int q = 0; q < 4; ++q) { v[q] = v[q] - mean; s2 += (v[q].x * v[q].x + v[q].y * v[q].y) + (v[q].z * v[q].z + v[q].w * v[q].w); }
    const float rstd = rsqrtf(wave_sum(s2) * (1.f / DM) + LN_EPS);
    f32x4* op = (f32x4*)(OUT + m * DM) + lane;
#pragma unroll
    for (int q = 0; q < 4; ++q) op[64 * q] = v[q] * rstd * ((const f32x4*)ln_g)[lane + 64 * q] + ((const f32x4*)ln_b)[lane + 64 * q];
}
}
constexpr int NWAVES = 8;
#ifndef MK_N_LAUNCHES
#define MK_N_LAUNCHES 1
#endif
constexpr int N_PHASES = 14;
constexpr int RING_BYTES = 147456;
constexpr int MISC_OFF = RING_BYTES;
constexpr int LDS_BYTES = RING_BYTES + 4096;
static_assert(pg8::STAGE_BYTES <= RING_BYTES && datt::LDS_BYTES <= RING_BYTES && mls::LDS_BYTES <= RING_BYTES && peer::LDS_BYTES <= RING_BYTES, "LDS map");

typedef GAS unsigned gu32;
#define RLX_AGENT __ATOMIC_RELAXED, __HIP_MEMORY_SCOPE_AGENT
#define LDS_WAIT() asm volatile("s_waitcnt lgkmcnt(0)" ::: "memory")

#define XB_TMO      128
#define XB_XCNT(j)  (256  + 64 * (j))
#define XB_XSUB(j)  (1280 + 64 * (j))
#define XB_XGEN(j)  (2304 + 64 * (j))
#define XB_TOP      3328
#define XB_TOPGEN   3392
#define XCD_BAR_WORDS 3456
#define XB_SPIN_CAP (1u << 22)
DI unsigned xb_ld(unsigned* p)              { return __hip_atomic_load(p, __ATOMIC_RELAXED, __HIP_MEMORY_SCOPE_AGENT); }
DI unsigned xb_add(unsigned* p, unsigned v) { return __hip_atomic_fetch_add(p, v, __ATOMIC_RELAXED, __HIP_MEMORY_SCOPE_AGENT); }
DI unsigned xb_xcc_id() { return (unsigned)__builtin_amdgcn_s_getreg((3 << 11) | 20) & 0xFu; }
#define XB_SPIN(cond, bar) do { unsigned _sp = 0; while (cond) { __builtin_amdgcn_s_sleep(1); \
    if ((++_sp & 255u) == 0u) { if (xb_ld(&(bar)[XB_TMO])) break; if (_sp > XB_SPIN_CAP) { atomicAdd(&(bar)[XB_TMO], 1u); break; } } } } while (0)
struct XcdBarrier { unsigned* bar; unsigned x; volatile LAS unsigned* st; };
DI XcdBarrier xcd_barrier_post(unsigned* bar, volatile LAS unsigned* st) {
    XcdBarrier b; b.bar = bar; b.x = xb_xcc_id(); b.st = st;
    if (threadIdx.x == 0) st[2] = xb_add(&bar[XB_XCNT(b.x)], 1u);
    return b;
}
DI void xcd_barrier_complete(unsigned* bar, unsigned x, unsigned& nloc, unsigned& nx) {
    const unsigned G = gridDim.x * gridDim.y * gridDim.z;
    unsigned sum, cnt, mine, sp = 0u;
    for (;;) {
        sum = 0u; cnt = 0u; mine = 0u;
#pragma unroll
        for (unsigned j = 0; j < 16; ++j) { const unsigned c = xb_ld(&bar[XB_XCNT(j)]); sum += c; cnt += (c > 0u) ? 1u : 0u; mine = (j == x) ? c : mine; }
        if (sum == G) break;
        __builtin_amdgcn_s_sleep(1);
        if ((++sp & 255u) == 0u) { if (xb_ld(&bar[XB_TMO])) break; if (sp > XB_SPIN_CAP) { atomicAdd(&bar[XB_TMO], 1u); break; } }
    }
    nloc = mine > 0u ? mine : 1u; nx = cnt > 0u ? cnt : 1u;
}
DI void xcd_barrier(const XcdBarrier& b) {
    asm volatile("s_waitcnt vmcnt(0)" ::: "memory");
    __syncthreads();
    if (threadIdx.x == 0) {
        unsigned* bar = b.bar;
        __builtin_amdgcn_s_waitcnt(0);
        unsigned nloc = b.st[0], nx = b.st[1];
        if (nloc == 0u) { xcd_barrier_complete(bar, b.x, nloc, nx); b.st[0] = nloc; b.st[1] = nx; }
        const unsigned old = xb_add(&bar[XB_XSUB(b.x)], 1u);
        const unsigned gen = old / nloc;
        if (old + 1u == (gen + 1u) * nloc) {
            __builtin_amdgcn_fence(__ATOMIC_RELEASE, "agent");
            asm volatile("s_waitcnt vmcnt(0)" ::: "memory");
            const unsigned og = xb_add(&bar[XB_TOP], 1u);
            const unsigned tg = og / nx;
            if (og + 1u == (tg + 1u) * nx) xb_add(&bar[XB_TOPGEN], 1u);
            else XB_SPIN(xb_ld(&bar[XB_TOPGEN]) == tg, bar);
            __builtin_amdgcn_fence(__ATOMIC_ACQUIRE, "agent");
            xb_add(&bar[XB_XGEN(b.x)], 1u);
            asm volatile("s_waitcnt vmcnt(0)" ::: "memory");
        } else {
            XB_SPIN(xb_ld(&bar[XB_XGEN(b.x)]) == gen, bar);
            __builtin_amdgcn_fence(__ATOMIC_ACQUIRE, "agent");
            asm volatile("s_waitcnt vmcnt(0)" ::: "memory");
        }
    }
    __syncthreads();
}

DI void p0_transpose_item(const float* W, int ldw, int col0, bf16_t* WT, int K, int dst_row0, int kb, float scale, LAS float* scr, int lane) {
    const int k0 = 64 * kb;
#pragma unroll 8
    for (int i = 0; i < 32; ++i) { const int kk = 2 * i + (lane >> 5); scr[kk * 33 + (lane & 31)] = W[(size_t)(k0 + kk) * ldw + col0 + (lane & 31)] * scale; }
    LDS_WAIT(); asm volatile("" ::: "memory");
    const int c = lane & 7;
#pragma unroll
    for (int j = 0; j < 4; ++j) { const int n = (lane >> 3) + 8 * j; const LAS float* s = scr + (8 * c) * 33 + n;
        u32x4 o; o.x = pk2(s[0 * 33], s[1 * 33]); o.y = pk2(s[2 * 33], s[3 * 33]); o.z = pk2(s[4 * 33], s[5 * 33]); o.w = pk2(s[6 * 33], s[7 * 33]);
        *(u32x4*)(WT + (size_t)(dst_row0 + n) * K + k0 + 8 * c) = o; }
    LDS_WAIT(); asm volatile("" ::: "memory");
}

struct Args { const float* in[22]; float* out; unsigned char* ws; int ph_lo, ph_hi; };

__global__ void __launch_bounds__(NWAVES * 64, 2) mega_fwd(Args args) {
    extern __shared__ __attribute__((aligned(16))) unsigned char lds_raw[];
    LAS unsigned char* lds = (LAS unsigned char*)lds_raw;
    volatile LAS unsigned* MISC = (volatile LAS unsigned*)(lds + MISC_OFF);
    const int tid = threadIdx.x, lane = tid & 63, wave = __builtin_amdgcn_readfirstlane(tid >> 6);
    const int G = gridDim.x; const int bx = blockIdx.x; const int vcu = (G % 8 == 0) ? (bx % 8) * (G / 8) + bx / 8 : bx;
    const int gw = vcu * NWAVES + wave, NGW = G * NWAVES;
#define ws (args.ws)
#define ctl ((unsigned*)(ws + WS_CTL))
#define x_in (args.in[0])
#define cvec (args.in[1])
#define w_ada (args.in[2])
#define b_ada (args.in[3])
#define w_in (args.in[4])
#define b_if (args.in[5])
#define conv_w (args.in[6])
#define conv_b (args.in[7])
#define da_lambda (args.in[8])
#define da_subln_g (args.in[9])
#define ml_norm_g (args.in[10])
#define w_br_attn (args.in[11])
#define w_br_mlstm (args.in[12])
#define w_out (args.in[13])
#define ln1_g (args.in[14])
#define ln1_b (args.in[15])
#define peer_wq (args.in[16])
#define peer_keys (args.in[17])
#define peer_u (args.in[18])
#define peer_v (args.in[19])
#define ln2_g (args.in[20])
#define ln2_b (args.in[21])
#define MOD ((float*)(ws + WS_MOD))
#define GIF ((float*)(ws + WS_GIF))
#define WIN ((bf16_t*)(ws + WS_WIN))
#define WA ((bf16_t*)(ws + WS_WA))
#define WM ((bf16_t*)(ws + WS_WM))
#define WOUT ((bf16_t*)(ws + WS_WOUT))
#define WQ ((bf16_t*)(ws + WS_WQ))
#define UT8 ((unsigned char*)(ws + WS_U))
#define VT8 ((unsigned char*)(ws + WS_V))
#define SUS ((float*)(ws + WS_SU))
#define SVS ((float*)(ws + WS_SV))
#define SHS ((float*)(ws + WS_SH))
#define CSS ((float*)(ws + WS_CS))
#define H2Q ((unsigned char*)(ws + WS_H2Q))
#define SELE ((bf16_t*)(ws + WS_SELE))
#define SELG ((float*)(ws + WS_SELG))
#define PART ((float*)(ws + WS_PART))
#define COEF ((float*)(ws + WS_COEF))
#define H1 ((bf16_t*)(ws + WS_H1))
#define Z ((bf16_t*)(ws + WS_Z))
#define R ((float*)(ws + WS_R))
#define X1 ((float*)(ws + WS_X1))
#define H2 ((bf16_t*)(ws + WS_H2))
#define QP ((bf16_t*)(ws + WS_QP))
#define GATES ((bf16_t*)args.out)

    for (int u = tid; u < (LDS_BYTES - MISC_OFF) / 4; u += NWAVES * 64) MISC[u] = 0u;
    __syncthreads();
    XcdBarrier bar; bar.bar = ctl + CW_BAR; bar.x = 0; bar.st = nullptr;
    if (MK_N_LAUNCHES != N_PHASES) bar = xcd_barrier_post(ctl + CW_BAR, MISC + 8);
    const int lo = args.ph_lo, hi = args.ph_hi;
#ifndef PH_MASK
#define PH_MASK 0x3fff
#endif
#define IN(k) (((PH_MASK >> (k)) & 1) && lo <= (k) && (k) < hi)
#define SEAM(k) do { if (IN(k) && IN((k) + 1)) xcd_barrier(bar); } while (0)

    if (IN(0)) {
        for (int it = gw; it < 96 * 8; it += NGW) {
            const int cb = it % 96, ks = it / 96, col = 64 * cb + lane;
            float acc[32];
#pragma unroll
            for (int b = 0; b < 32; ++b) acc[b] = 0.f;
            for (int k = 128 * ks; k < 128 * ks + 128; ++k) { const float w = w_ada[(size_t)k * MODW + col];
#pragma unroll
                for (int b = 0; b < 32; ++b) acc[b] += siluf_(cvec[b * DM + k]) * w; }
            const float bias = (ks == 0) ? b_ada[col] : 0.f;
#pragma unroll
            for (int b = 0; b < 32; ++b) atomicAdd(MOD + b * MODW + col, acc[b] + bias);
        }
        LAS float* scr = (LAS float*)(lds + wave * 16384);
        for (int it = gw; it < 4096 + 4 * 512; it += NGW) {
            if (it < 4096) { const int kb = it / 256, nb = it % 256, n0 = 32 * nb; p0_transpose_item(w_in, IN_W, n0 < NZ ? n0 : n0 + 8, WIN, DM, n0, kb, n0 < 1024 ? QSCALE : 1.0f, scr, lane); }
            else { const int r = it - 4096, wsel = r / 512, q = r % 512, kb = q / 32, nb = q % 32;
                const float* src = wsel == 0 ? w_br_attn : wsel == 1 ? w_br_mlstm : wsel == 2 ? w_out : peer_wq; bf16_t* dst = wsel == 0 ? WA : wsel == 1 ? WM : wsel == 2 ? WOUT : WQ;
                p0_transpose_item(src, DM, 32 * nb, dst, DM, 32 * nb, kb, 1.0f, scr, lane); }
        }
        for (int row = gw; row < 2 * NEXP; row += NGW) {
            const bool second = row >= NEXP; const int e = second ? row - NEXP : row;
            const float* s = (second ? peer_v : peer_u) + (size_t)e * DM + 16 * lane;
            f32x4 a[4]; float amax = 0.f;
#pragma unroll
            for (int j = 0; j < 4; ++j) { a[j] = *(const f32x4*)(s + 4 * j); amax = fmaxf(amax, fmaxf(fmaxf(fabsf(a[j].x), fabsf(a[j].y)), fmaxf(fabsf(a[j].z), fabsf(a[j].w)))); }
#pragma unroll
            for (int o = 1; o < 64; o <<= 1) amax = fmaxf(amax, __shfl_xor(amax, o));
            const float inv = amax > 0.f ? 127.0f / amax : 0.f; const int bias = second ? 128 : 0;
            u32x4 w;
#pragma unroll
            for (int j = 0; j < 4; ++j) { const int q0 = (int)rintf(a[j].x * inv) + bias, q1 = (int)rintf(a[j].y * inv) + bias, q2 = (int)rintf(a[j].z * inv) + bias, q3 = (int)rintf(a[j].w * inv) + bias;
                w[j] = (unsigned)(q0 & 255) | ((unsigned)(q1 & 255) << 8) | ((unsigned)(q2 & 255) << 16) | ((unsigned)(q3 & 255) << 24); }
            *(u32x4*)((second ? VT8 : UT8) + (size_t)(lane >> 3) * NEXP * 128 + (size_t)e * 128 + (lane & 7) * 16) = w;
            if (lane == 0) (second ? SVS : SUS)[e] = amax * (1.0f / 127.0f);
        }
    }
    SEAM(0);
    if (IN(1)) {
        LAS float* wif = (LAS float*)lds;
        for (int i = tid; i < 8192; i += 512) { const int k = i >> 3, j = i & 7; wif[j * 1024 + k] = w_in[(size_t)k * IN_W + NZ + j]; }
        __syncthreads();
        for (int m = gw; m < TOK; m += NGW) {
            const int b = m / SEQ;
            const f32x4* xr = (const f32x4*)(x_in + (size_t)m * DM) + lane;
            f32x4 v[4]; float s = 0.f;
#pragma unroll
            for (int j = 0; j < 4; ++j) { v[j] = xr[64 * j]; s += (v[j].x + v[j].y) + (v[j].z + v[j].w); }
            const float mean = wave_sum(s) * (1.f / DM); float s2 = 0.f;
#pragma unroll
            for (int j = 0; j < 4; ++j) { v[j] = v[j] - mean; s2 += (v[j].x * v[j].x + v[j].y * v[j].y) + (v[j].z * v[j].z + v[j].w * v[j].w); }
            const float rstd = rsqrtf(wave_sum(s2) * (1.f / DM) + LN_EPS);
            const f32x4* sh = (const f32x4*)(MOD + (size_t)b * MODW) + lane; const f32x4* sc = (const f32x4*)(MOD + (size_t)b * MODW + DM) + lane;
            unsigned long long* o8 = (unsigned long long*)(H1 + (size_t)m * DM) + lane;
            float gp[8];
#pragma unroll
            for (int g = 0; g < 8; ++g) gp[g] = 0.f;
#pragma unroll
            for (int j = 0; j < 4; ++j) { const f32x4 hh = v[j] * rstd * (sc[64 * j] + 1.0f) + sh[64 * j];
                o8[64 * j] = (unsigned long long)pk2(hh.x, hh.y) | ((unsigned long long)pk2(hh.z, hh.w) << 32);
#pragma unroll
                for (int g = 0; g < 8; ++g) { const f32x4 w = *(const LAS f32x4*)(wif + g * 1024 + 4 * (lane + 64 * j)); gp[g] += (hh.x * w.x + hh.y * w.y) + (hh.z * w.z + hh.w * w.w); } }
#pragma unroll
            for (int g = 0; g < 8; ++g) gp[g] = wave_sum(gp[g]);
            if (lane == 0) {
#pragma unroll
                for (int g = 0; g < 8; ++g) GIF[(size_t)m * 8 + g] = gp[g] + b_if[g]; }
        }
    }
    SEAM(1);
#ifndef REP2
#define REP2 1
#endif
    if (IN(2)) for (int rep2 = 0; rep2 < REP2; ++rep2) {
        pg8::Gemm g{H1, WIN, TOK, NIN, DM, DM, DM}; pg8::StaticOrder S; S.init(TOK, NIN, G, bx);
        pg8::EpiZ E{Z, GATES};
        pg8::gemm_phase<pg8::EpiZ, pg8::StaticOrder, true, true>(lds, g, S, E);
    }
    SEAM(2);
    if (IN(3)) {
        unsigned* qhead = ctl + CW_QUEUE;
        for (;;) {
            __syncthreads();
            if (tid == 0) MISC[0] = __hip_atomic_fetch_add(qhead, 1u, RLX_AGENT);
            __syncthreads();
            const int id = (int)MISC[0];
            if (id >= 128 + 2048) break;
#ifndef NO_MLS
            if (id < 128) mls::mlstm_unit(lds, Z, GIF, conv_w, conv_b, ml_norm_g, id >> 2, id & 3);
            else
#endif
#ifndef NO_ATT
            { const int idx = id - 128, qb = 7 - idx / 256, bh = idx % 256; datt::attn_unit(lds, Z, da_lambda, da_subln_g, bh >> 3, bh & 7, qb); }
#else
            {}
#endif
        }
    }
    SEAM(3);
    if (IN(4)) {
        pg8::Gemm g{Z + ZC_Q, WA, TOK, DM, DM, NZ, DM}; pg8::StaticOrder S; S.init(TOK, DM, G, bx);
        pg8::EpiGate<true> E{GATES, H1};
        pg8::gemm_phase<pg8::EpiGate<true>, pg8::StaticOrder, true, true>(lds, g, S, E);
    }
    SEAM(4);
    if (IN(5)) {
        pg8::Gemm g{Z + ZC_MV, WM, TOK, DM, DM, NZ, DM}; pg8::StaticOrder S; S.init(TOK, DM, G, bx);
        pg8::EpiGate<false> E{GATES + DM, H1};
        pg8::gemm_phase<pg8::EpiGate<false>, pg8::StaticOrder, true, true>(lds, g, S, E);
    }
    SEAM(5);
    if (IN(6)) {
        pg8::Gemm g{H1, WOUT, TOK, DM, DM, DM, DM}; pg8::StaticOrder S; S.init(TOK, DM, G, bx);
        pg8::EpiR E{x_in, MOD, R};
        pg8::gemm_phase<pg8::EpiR, pg8::StaticOrder, true, true>(lds, g, S, E);
    }
    SEAM(6);
    if (IN(7)) {
        for (int m = gw; m < TOK; m += NGW) {
            const int b = m / SEQ;
            const f32x4* rr = (const f32x4*)(R + (size_t)m * DM) + lane;
            f32x4 v[4]; float s = 0.f;
#pragma unroll
            for (int j = 0; j < 4; ++j) { v[j] = rr[64 * j]; s += (v[j].x + v[j].y) + (v[j].z + v[j].w); }
            float mean = wave_sum(s) * (1.f / DM); float s2 = 0.f;
#pragma unroll
            for (int j = 0; j < 4; ++j) { v[j] = v[j] - mean; s2 += (v[j].x * v[j].x + v[j].y * v[j].y) + (v[j].z * v[j].z + v[j].w * v[j].w); }
            float rstd = rsqrtf(wave_sum(s2) * (1.f / DM) + LN_EPS);
            f32x4* xo = (f32x4*)(X1 + (size_t)m * DM) + lane; s = 0.f;
#pragma unroll
            for (int j = 0; j < 4; ++j) { v[j] = v[j] * rstd * ((const f32x4*)ln1_g)[lane + 64 * j] + ((const f32x4*)ln1_b)[lane + 64 * j]; xo[64 * j] = v[j]; s += (v[j].x + v[j].y) + (v[j].z + v[j].w); }
            mean = wave_sum(s) * (1.f / DM); s2 = 0.f;
#pragma unroll
            for (int j = 0; j < 4; ++j) { v[j] = v[j] - mean; s2 += (v[j].x * v[j].x + v[j].y * v[j].y) + (v[j].z * v[j].z + v[j].w * v[j].w); }
            rstd = rsqrtf(wave_sum(s2) * (1.f / DM) + LN_EPS);
            const f32x4* sh = (const f32x4*)(MOD + (size_t)b * MODW + 3 * DM) + lane; const f32x4* sc = (const f32x4*)(MOD + (size_t)b * MODW + 4 * DM) + lane;
            unsigned long long* o8 = (unsigned long long*)(H2 + (size_t)m * DM) + lane;
            float amax = 0.f;
#pragma unroll
            for (int j = 0; j < 4; ++j) { const f32x4 hh = v[j] * rstd * (sc[64 * j] + 1.0f) + sh[64 * j]; o8[64 * j] = (unsigned long long)pk2(hh.x, hh.y) | ((unsigned long long)pk2(hh.z, hh.w) << 32);
                v[j] = hh; amax = fmaxf(amax, fmaxf(fmaxf(fabsf(hh.x), fabsf(hh.y)), fmaxf(fabsf(hh.z), fabsf(hh.w)))); }
#pragma unroll
            for (int o = 1; o < 64; o <<= 1) amax = fmaxf(amax, __shfl_xor(amax, o));
            const float qinv = amax > 0.f ? 127.0f / amax : 0.f;
            unsigned* q4 = (unsigned*)(H2Q + (size_t)m * DM) + lane;
#pragma unroll
            for (int j = 0; j < 4; ++j) { const int q0 = (int)rintf(v[j].x * qinv), q1 = (int)rintf(v[j].y * qinv), q2 = (int)rintf(v[j].z * qinv), q3 = (int)rintf(v[j].w * qinv);
                q4[64 * j] = (unsigned)(q0 & 255) | ((unsigned)(q1 & 255) << 8) | ((unsigned)(q2 & 255) << 16) | ((unsigned)(q3 & 255) << 24); }
            if (lane == 0) SHS[m] = amax * (1.0f / 127.0f);
        }
    }
    SEAM(7);
    if (IN(8)) {
        pg8::Gemm g{H2, WQ, TOK, DM, DM, DM, DM}; pg8::StaticOrder S; S.init(TOK, DM, G, bx);
        pg8::EpiStore E{QP};
        pg8::gemm_phase<pg8::EpiStore, pg8::StaticOrder, true, true>(lds, g, S, E);
    }
    SEAM(8);
    if (IN(9)) {
        peer::stage_keys(lds, peer_keys);
        __syncthreads();
        for (int tile = bx; tile < TOK / 32; tile += G) peer::select_tile(lds, QP, tile * 32, SELE, SELG);
    }
    SEAM(9);
    int sx = bx % 8, sr = bx / 8, sn = (G - sx + 7) / 8;
    if (IN(10) || IN(12)) {
        __syncthreads();
        if (tid == 0) { bool phys = (MK_N_LAUNCHES != N_PHASES) && lo == 0 && hi > 10; unsigned mine = 0;
            if (phys) { for (unsigned j = 0; j < 16; ++j) { const unsigned c = xb_ld(&bar.bar[XB_XCNT(j)]); if (j < 8) { if (c == 0u) phys = false; if (j == bar.x) mine = c; } else if (c != 0u) phys = false; } }
            MISC[16] = phys ? bar.x : (unsigned)sx; MISC[17] = phys ? MISC[10] : (unsigned)sr; MISC[18] = phys ? mine : (unsigned)sn; }
        __syncthreads();
        sx = (int)MISC[16]; sr = (int)MISC[17]; sn = (int)MISC[18];
    }
    if (IN(10)) {
        for (int tile = sr; tile < TOK / 32; tile += sn) { __syncthreads(); peer::u_phase_tile(lds, tile, sx, SELE, H2Q, UT8, PART); }
    }
    SEAM(10);
    if (IN(11)) { for (int m = gw; m < TOK; m += NGW) peer::red_token((size_t)m, PART, SELE, SELG, SUS, SVS, SHS, COEF, CSS); }
    SEAM(11);
    if (IN(12)) {
        for (int tile = sr; tile < TOK / 32; tile += sn) { __syncthreads(); peer::v_phase_tile(lds, tile, sx, SELE, COEF, CSS, VT8, args.out); }
    }
    SEAM(12);
    if (IN(13)) { for (int m = gw; m < TOK; m += NGW) peer::final_row((size_t)m, args.out, X1, MOD, ln2_g, ln2_b, args.out); }
#undef IN
#undef SEAM
#undef ws
#undef ctl
#undef x_in
#undef cvec
#undef w_ada
#undef b_ada
#undef w_in
#undef b_if
#undef conv_w
#undef conv_b
#undef da_lambda
#undef da_subln_g
#undef ml_norm_g
#undef w_br_attn
#undef w_br_mlstm
#undef w_out
#undef ln1_g
#undef ln1_b
#undef peer_wq
#undef peer_keys
#undef peer_u
#undef peer_v
#undef ln2_g
#undef ln2_b
#undef MOD
#undef GIF
#undef WIN
#undef WA
#undef WM
#undef WOUT
#undef WQ
#undef UT8
#undef VT8
#undef SUS
#undef SVS
#undef SHS
#undef CSS
#undef H2Q
#undef SELE
#undef SELG
#undef PART
#undef COEF
#undef H1
#undef Z
#undef R
#undef X1
#undef H2
#undef QP
#undef GATES
}

extern "C" void kernel_launch(void* const* d_in, const int* in_sizes, int n_in, void* d_out, int out_size, void* d_ws, size_t ws_size, hipStream_t stream) {
    static int grid = 0;
    if (grid == 0) {
        if (n_in != 22 || in_sizes[0] != TOK * DM || out_size != TOK * DM || ws_size < WS_END) { fprintf(stderr, "kernel_launch: unexpected shapes (n_in %d, in0 %d, out %d, ws %zu; need ws >= %zu)\n", n_in, n_in > 0 ? in_sizes[0] : -1, out_size, ws_size, (size_t)WS_END); grid = -1; return; }
        int dev = 0, cus = 0, per_cu = 0;
        if (hipGetDevice(&dev) != hipSuccess || hipDeviceGetAttribute(&cus, hipDeviceAttributeMultiprocessorCount, dev) != hipSuccess) { fprintf(stderr, "kernel_launch: device query failed\n"); grid = -1; return; }
        if (hipFuncSetAttribute((const void*)mega_fwd, hipFuncAttributeMaxDynamicSharedMemorySize, LDS_BYTES) != hipSuccess) { fprintf(stderr, "kernel_launch: hipFuncSetAttribute failed\n"); grid = -1; return; }
        if (hipOccupancyMaxActiveBlocksPerMultiprocessor(&per_cu, (const void*)mega_fwd, NWAVES * 64, LDS_BYTES) != hipSuccess || per_cu < 1) fprintf(stderr, "kernel_launch: note: occupancy query reports %d workgroups per CU\n", per_cu);
        (void)hipGetLastError();
        grid = cus;
    }
    if (grid < 0) return;
    if (hipMemsetAsync((char*)d_ws + WS_CTL, 0, CTL_ZERO_BYTES, stream) != hipSuccess) { fprintf(stderr, "kernel_launch: memset failed\n"); return; }
    Args a{};
    for (int i = 0; i < 22; ++i) a.in[i] = (const float*)d_in[i];
    a.out = (float*)d_out; a.ws = (unsigned char*)d_ws;
    for (int li = 0; li < MK_N_LAUNCHES; ++li) {
        a.ph_lo = (MK_N_LAUNCHES == N_PHASES) ? li : 0; a.ph_hi = (MK_N_LAUNCHES == N_PHASES) ? li + 1 : N_PHASES;
        hipLaunchKernelGGL(mega_fwd, dim3(grid), dim3(NWAVES * 64), LDS_BYTES, stream, a);
        const hipError_t le = hipPeekAtLastError();
        if (le != hipSuccess) { fprintf(stderr, "kernel_launch: launch %d failed: %s\n", li, hipGetErrorName(le)); break; }
    }
}
```

```cpp
#include <hip/hip_runtime.h>
#include <hip/hip_bf16.h>
#include <cstdio>
#include <cstdint>
#include <cmath>

#define LAS __attribute__((address_space(3)))
#define GAS __attribute__((address_space(1)))
typedef unsigned short bf16_t;
typedef short bf16x8 __attribute__((ext_vector_type(8)));
typedef short s16x4 __attribute__((ext_vector_type(4)));
typedef float f32x2 __attribute__((ext_vector_type(2)));
typedef float f32x4 __attribute__((ext_vector_type(4)));
typedef float f32x16 __attribute__((ext_vector_type(16)));
typedef unsigned u32x2 __attribute__((ext_vector_type(2)));
typedef unsigned u32x4 __attribute__((ext_vector_type(4)));
typedef __bf16 bf16x2_t __attribute__((ext_vector_type(2)));
#define DI __device__ __forceinline__

constexpr int BATCH = 32, SEQ = 2048, DM = 1024, TOK = BATCH * SEQ;
constexpr int NZ = 6144;
constexpr int ZC_Q = 0, ZC_K = 1024, ZC_V = 2048, ZC_MQ = 3072, ZC_MK = 3584, ZC_MV = 4096, ZC_MO = 5120;
constexpr int NGATE = 2048;
constexpr int NIN = 8192;
constexpr int IN_W = 8200;
constexpr int MODW = 6 * DM;
constexpr float LN_EPS = 1e-5f;
constexpr float ALPHA_RES = 1.189207115002721f;
constexpr float LAMBDA_INIT = 0.2f;
constexpr float QSCALE = 0.125f * 1.4426950408889634f;
constexpr int NEXP = 16384;

constexpr size_t MiB = 1u << 20;
constexpr size_t WS_CTL = 0, CTL_ZERO_BYTES = 2 * MiB;
constexpr size_t WS_MOD = 1 * MiB;
constexpr size_t WS_GIF = 3 * MiB;
constexpr size_t WS_WIN = 6 * MiB;
constexpr size_t WS_WA = 22 * MiB, WS_WM = 24 * MiB, WS_WOUT = 26 * MiB, WS_WQ = 28 * MiB;
constexpr size_t WS_U = 30 * MiB, WS_V = 62 * MiB;
constexpr size_t WS_SU = 2 * MiB, WS_SV = 2 * MiB + 65536, WS_SH = 2 * MiB + 131072, WS_CS = 2 * MiB + 393216;
constexpr size_t WS_H2Q = 96 * MiB, WS_SELE = 160 * MiB, WS_SELG = 176 * MiB;
constexpr size_t WS_H1 = 96 * MiB;
constexpr size_t WS_Z = 224 * MiB;
constexpr size_t WS_R = WS_Z, WS_X1 = WS_Z + 256 * MiB, WS_H2 = WS_Z + 512 * MiB, WS_QP = WS_Z + 640 * MiB;
constexpr size_t WS_PART = WS_R, WS_COEF = WS_H2;
constexpr size_t WS_END = 992 * MiB;
constexpr int CW_BAR = 4096;
constexpr int CW_QUEUE = 16384;

DI unsigned pk2(float lo, float hi) { f32x2 v = {lo, hi}; bf16x2_t b = __builtin_convertvector(v, bf16x2_t); return __builtin_bit_cast(unsigned, b); }
DI float bf_lo(unsigned u) { return __uint_as_float(u << 16); }
DI float bf_hi(unsigned u) { return __uint_as_float(u & 0xffff0000u); }
DI float bf2f(bf16_t h) { return __uint_as_float(((unsigned)h) << 16); }
DI float wave_sum(float v) {
#pragma unroll
    for (int o = 1; o < 64; o <<= 1) v += __shfl_xor(v, o);
    return v;
}
DI float sigmoidf_(float x) { return 1.0f / (1.0f + __expf(-x)); }
DI float siluf_(float x) { return x / (1.0f + __expf(-x)); }
DI int crow(int r, int hi) { return (r & 3) + 8 * (r >> 2) + 4 * hi; }
#define MFMA32(a, b, c) __builtin_amdgcn_mfma_f32_32x32x16_bf16((a), (b), (c), 0, 0, 0)
DI bf16x8 pack_step(const f32x16& x, int s) {
    u32x4 p;
    p[0] = pk2(x[8 * s + 0], x[8 * s + 1]); p[1] = pk2(x[8 * s + 2], x[8 * s + 3]); p[2] = pk2(x[8 * s + 4], x[8 * s + 5]); p[3] = pk2(x[8 * s + 6], x[8 * s + 7]);
    return __builtin_bit_cast(bf16x8, p);
}
DI unsigned off_b(unsigned row, unsigned ch) { return 256u * row + 16u * (ch ^ (((row & 3) << 2) | ((row >> 2) & 3))); }
DI unsigned row_read_addr(unsigned lane, unsigned rt, unsigned s) { return off_b(32 * rt + (lane & 31), 2 * s + (lane >> 5)); }
DI unsigned tr_read_addr(unsigned lane, unsigned c, unsigned ks, unsigned t) {
    const unsigned h = lane >> 5, blk = (lane >> 4) & 1, q = (lane & 15) >> 2, p = lane & 3;
    return off_b(16 * ks + 8 * h + 4 * t + q, 4 * c + 2 * blk + (p >> 1)) + 8 * (p & 1);
}
DI unsigned tr_base(unsigned lane, unsigned t) { const unsigned h = lane >> 5, blk = (lane >> 4) & 1, q = (lane & 15) >> 2, p = lane & 3, cl = 2 * blk + (p >> 1);
    return 256u * (8 * h + 4 * t + q) + 16u * (cl ^ (2 * h + t)) + 8u * (p & 1); }
#define OPAQUE(x) asm volatile("" : "+v"(x))
#define OPAQUE(x) asm volatile("" : "+v"(x))
typedef short v4i16_t __attribute__((ext_vector_type(4)));
DI s16x4 tr_read(const LAS unsigned char* p) { return __builtin_bit_cast(s16x4, __builtin_amdgcn_ds_read_tr16_b64_v4i16((LAS v4i16_t*)p)); }
DI bf16x8 cat8(s16x4 lo, s16x4 hi) { return __builtin_shufflevector(lo, hi, 0, 1, 2, 3, 4, 5, 6, 7); }
namespace pg8 {
#define PG8_LAS __attribute__((address_space(3)))
typedef unsigned short bf16_t;
typedef short bf16x8 __attribute__((ext_vector_type(8)));
typedef float f32x4 __attribute__((ext_vector_type(4)));
typedef unsigned u32x4 __attribute__((ext_vector_type(4)));
constexpr int BM = 256, BK = 64, HALF = 128, HTB = HALF * BK * 2  , STAGE_BYTES = 8 * HTB, NXCD = 8, WGM = 8;

__host__ __device__ __forceinline__ int lds_byte(int r, int c) { const int st = (r >> 4) * 2 + (c >> 5), rr = r & 15, cc = c & 31, ob = rr * 64 + cc * 2; return st * 1024 + (ob ^ (((ob >> 9) & 1) << 5)); }
__host__ __device__ __forceinline__ void stage_rc(int b, int& R, int& C) { const int st = b / 1024, sb = b % 1024, swz = sb ^ (((sb >> 9) & 1) << 5); R = (st >> 1) * 16 + swz / 64; C = (st & 1) * 32 + (swz % 64) / 2; }
__host__ __device__ __forceinline__ int perm32(int rho) { const int n = rho >> 4, i = rho & 15; return 8 * (i >> 2) + 4 * n + (i & 3); }

struct Unit { int pm, pn; };
struct Gemm { const bf16_t* A; const bf16_t* Bt; int M, N, K, lda, ldb; };

struct StaticOrder {
    int nM, nN, nwg, G, c;
    __host__ __device__ void init(int M, int N, int G_, int c_) { nM = M / BM; nN = N / BM; nwg = nM * nN; G = G_; c = c_; }
    __host__ __device__ bool next(int i, Unit& u) const {
        const long L = (long)i * G + c; if (L >= nwg) return false;
        int wgid = (int)L; { const int q = nwg / NXCD, r = nwg % NXCD, xcd = wgid % NXCD, off = wgid / NXCD; wgid = (xcd < r ? xcd * (q + 1) : r * (q + 1) + (xcd - r) * q) + off; }
        const int nig = WGM * nN, gid = wgid / nig, fm = gid * WGM, gsz = (nM - fm) < WGM ? (nM - fm) : WGM;
        u.pm = fm + ((wgid % nig) % gsz); u.pn = (wgid % nig) / gsz; return true;
    }
    __device__ __forceinline__ void a_ready(const Unit&) const {}
    __device__ __forceinline__ void done(const Unit&) const {}
};

template <class Epi, class Sched, bool ALIGN_EPI = false, bool SP2 = false>
__device__ __forceinline__ void gemm_phase(PG8_LAS unsigned char* lds, const Gemm g, const Sched& S, const Epi& E) {
    const int tid = threadIdx.x, wid = __builtin_amdgcn_readfirstlane(tid >> 6), lane = tid & 63, wr = wid >> 2, wc = wid & 3, fr = lane & 15, fq = lane >> 4;
    const int K = g.K, nt = K / BK;
    unsigned voffA[2], voffB[2];
#pragma unroll
    for (int i = 0; i < 2; ++i) { int R, C; stage_rc(tid * 16 + i * 8192, R, C); const int Rb = Epi::PERM ? ((R & ~31) + perm32(R & 31)) : R;
        voffA[i] = (unsigned)(R * g.lda + C) * 2u; voffB[i] = (unsigned)(Rb * g.ldb + C) * 2u; }
    const size_t kstep = (size_t)(BK * 2);
    const size_t hstepA = (size_t)HALF * g.lda * 2, hstepB = (size_t)HALF * g.ldb * 2;
    const size_t tstepA = 2 * hstepA, tstepB = 2 * hstepB;
    const unsigned ldsw = (unsigned)wid * 1024u;
    const int aoff = lds_byte(wr * 64 + fr, fq * 8), boff = lds_byte(wc * 32 + fr, fq * 8);
#define PG8_SA(b, h) (((b) * 2 + (h)) * HTB)
#define PG8_SB(b, h) ((4 + (b) * 2 + (h)) * HTB)
#define PG8_STAGE(bufoff, gbase, voff) do { _Pragma("unroll") for (int _i = 0; _i < 2; ++_i) \
        __builtin_amdgcn_global_load_lds((const unsigned*)((const char*)(gbase) + (voff)[_i]), (PG8_LAS unsigned*)(lds + (bufoff) + ldsw + _i * 8192), 16, 0, 0); } while (0)
#define PG8_LDA(dst, b, h) do { _Pragma("unroll") for (int m = 0; m < 4; ++m) _Pragma("unroll") for (int k = 0; k < 2; ++k) dst[m][k] = *(const PG8_LAS bf16x8*)(lds + PG8_SA(b, h) + aoff + m * 2048 + k * 1024); } while (0)
#define PG8_LDB(dst, b, h) do { _Pragma("unroll") for (int n = 0; n < 2; ++n) _Pragma("unroll") for (int k = 0; k < 2; ++k) dst[n][k] = *(const PG8_LAS bf16x8*)(lds + PG8_SB(b, h) + boff + n * 2048 + k * 1024); } while (0)
#define PG8_MMA(ai, bj, At, Bt) do { __builtin_amdgcn_s_setprio(1); _Pragma("unroll") for (int m = 0; m < 4; ++m) _Pragma("unroll") for (int n = 0; n < 2; ++n) _Pragma("unroll") for (int k = 0; k < 2; ++k) \
        acc[ai][bj][m][n] = __builtin_amdgcn_mfma_f32_16x16x32_bf16(Bt[n][k], At[m][k], acc[ai][bj][m][n], 0, 0, 0); __builtin_amdgcn_s_setprio(0); } while (0)
#define PG8_WAIT_V(n) asm volatile("s_waitcnt vmcnt(" #n ")" ::: "memory")
#define PG8_WAIT_L(n) asm volatile("s_waitcnt lgkmcnt(" #n ")" ::: "memory")
#define PG8_BAR __builtin_amdgcn_s_barrier()
#define PG8_SCHED __builtin_amdgcn_sched_barrier(0)
    Unit cur, nxt; int ui = 0;
    if (!S.next(0, cur)) return;
    f32x4 acc[2][2][4][2];
#pragma unroll
    for (int a = 0; a < 2; ++a)
#pragma unroll
        for (int b = 0; b < 2; ++b)
#pragma unroll
            for (int m = 0; m < 4; ++m)
#pragma unroll
                for (int n = 0; n < 2; ++n) acc[a][b][m][n] = (f32x4){0.f, 0.f, 0.f, 0.f};
    bf16x8 At[4][2], B0[2][2], B1[2][2];
    const char* cA = (const char*)g.A + (size_t)cur.pm * tstepA; const char* cB = (const char*)g.Bt + (size_t)cur.pn * tstepB;
    S.a_ready(cur);
    if constexpr (SP2) {
        PG8_STAGE(PG8_SB(0, 0), cB, voffB); PG8_STAGE(PG8_SB(0, 1), cB + hstepB, voffB); PG8_STAGE(PG8_SA(0, 0), cA, voffA); PG8_STAGE(PG8_SA(0, 1), cA + hstepA, voffA);
        if (wr == 1) PG8_BAR;
        PG8_WAIT_V(2); PG8_BAR;
        PG8_STAGE(PG8_SB(1, 0), cB + kstep, voffB); PG8_STAGE(PG8_SA(1, 0), cA + kstep, voffA); PG8_STAGE(PG8_SB(1, 1), cB + hstepB + kstep, voffB);
        PG8_WAIT_V(6); PG8_BAR;
    } else {
        PG8_STAGE(PG8_SB(0, 0), cB, voffB); PG8_STAGE(PG8_SA(0, 0), cA, voffA); PG8_STAGE(PG8_SB(0, 1), cB + hstepB, voffB); PG8_STAGE(PG8_SA(0, 1), cA + hstepA, voffA);
        if (wr == 1) PG8_BAR;
        PG8_WAIT_V(4); PG8_BAR;
        PG8_STAGE(PG8_SB(1, 0), cB + kstep, voffB); PG8_STAGE(PG8_SA(1, 0), cA + kstep, voffA); PG8_STAGE(PG8_SB(1, 1), cB + hstepB + kstep, voffB);
        PG8_WAIT_V(6); PG8_BAR;
    }
    for (;;) {
        const bool has_next = S.next(ui + 1, nxt);
        const char* nA = has_next ? (const char*)g.A + (size_t)nxt.pm * tstepA : cA; const char* nB = has_next ? (const char*)g.Bt + (size_t)nxt.pn * tstepB : cB;
        for (int t = 0; t < nt; t += 2) {
            const bool last = (t == nt - 2);
            const char* a1 = cA + (size_t)(t + 1) * kstep;
            const char* a2 = last ? nA : cA + (size_t)(t + 2) * kstep; const char* b2 = last ? nB : cB + (size_t)(t + 2) * kstep;
            const char* a3 = a2 + kstep; const char* b3 = b2 + kstep;
            if (last && has_next) S.a_ready(nxt);
            if constexpr (SP2) {
            PG8_LDB(B0, 0, 0); PG8_LDB(B1, 0, 1); PG8_SCHED; PG8_LDA(At, 0, 0); PG8_STAGE(PG8_SA(1, 1), a1 + hstepA, voffA);
            PG8_WAIT_V(8); PG8_WAIT_L(0); PG8_BAR; PG8_MMA(0, 0, At, B0); PG8_MMA(0, 1, At, B1); PG8_BAR; PG8_SCHED;
            PG8_LDA(At, 0, 1); PG8_STAGE(PG8_SB(0, 0), b2, voffB); PG8_STAGE(PG8_SB(0, 1), b2 + hstepB, voffB); PG8_STAGE(PG8_SA(0, 0), a2, voffA);
            PG8_WAIT_V(8); PG8_WAIT_L(0); PG8_BAR; PG8_MMA(1, 0, At, B0); PG8_MMA(1, 1, At, B1); PG8_BAR; PG8_SCHED;
            PG8_LDB(B0, 1, 0); PG8_LDB(B1, 1, 1); PG8_SCHED; PG8_LDA(At, 1, 0); PG8_STAGE(PG8_SA(0, 1), a2 + hstepA, voffA);
            PG8_WAIT_V(8); PG8_WAIT_L(0); PG8_BAR; PG8_MMA(0, 0, At, B0); PG8_MMA(0, 1, At, B1); PG8_BAR; PG8_SCHED;
            PG8_LDA(At, 1, 1); PG8_STAGE(PG8_SB(1, 0), b3, voffB); PG8_STAGE(PG8_SB(1, 1), b3 + hstepB, voffB); PG8_STAGE(PG8_SA(1, 0), a3, voffA);
            PG8_WAIT_V(8); PG8_WAIT_L(0); PG8_BAR; PG8_MMA(1, 0, At, B0); PG8_MMA(1, 1, At, B1); PG8_BAR; PG8_SCHED;
            } else {
            PG8_LDB(B0, 0, 0); PG8_SCHED; PG8_LDA(At, 0, 0); PG8_STAGE(PG8_SA(1, 1), a1 + hstepA, voffA);
            PG8_WAIT_L(8); PG8_BAR; PG8_WAIT_L(0); PG8_MMA(0, 0, At, B0); PG8_BAR; PG8_SCHED;
            PG8_LDB(B1, 0, 1); PG8_STAGE(PG8_SB(0, 0), b2, voffB);
            PG8_BAR; PG8_WAIT_L(0); PG8_MMA(0, 1, At, B1); PG8_BAR;
            PG8_LDA(At, 0, 1); PG8_STAGE(PG8_SA(0, 0), a2, voffA);
            PG8_BAR; PG8_WAIT_L(0); PG8_MMA(1, 0, At, B0); PG8_BAR; PG8_SCHED;
            PG8_STAGE(PG8_SB(0, 1), b2 + hstepB, voffB);
            PG8_WAIT_V(6); PG8_BAR; PG8_MMA(1, 1, At, B1); PG8_BAR;
            PG8_LDB(B0, 1, 0); PG8_SCHED; PG8_LDA(At, 1, 0); PG8_STAGE(PG8_SA(0, 1), a2 + hstepA, voffA);
            PG8_WAIT_L(8); PG8_BAR; PG8_WAIT_L(0); PG8_MMA(0, 0, At, B0); PG8_BAR; PG8_SCHED;
            PG8_LDB(B1, 1, 1); PG8_STAGE(PG8_SB(1, 0), b3, voffB);
            PG8_BAR; PG8_WAIT_L(0); PG8_MMA(0, 1, At, B1); PG8_BAR;
            PG8_LDA(At, 1, 1); PG8_STAGE(PG8_SA(1, 0), a3, voffA);
            PG8_BAR; PG8_WAIT_L(0); PG8_MMA(1, 0, At, B0); PG8_BAR; PG8_SCHED;
            PG8_STAGE(PG8_SB(1, 1), b3 + hstepB, voffB);
            PG8_WAIT_V(6); PG8_BAR; PG8_MMA(1, 1, At, B1); PG8_BAR;
            }
        }
        if constexpr (ALIGN_EPI) { if (wr == 0) PG8_BAR; }
        if constexpr (!Epi::AFTER_DRAIN) { E(acc, cur, wr, wc, fr, fq); S.done(cur); }
        if (!has_next) break;
#pragma unroll
        for (int a = 0; a < 2; ++a)
#pragma unroll
            for (int b = 0; b < 2; ++b)
#pragma unroll
                for (int m = 0; m < 4; ++m)
#pragma unroll
                    for (int n = 0; n < 2; ++n) acc[a][b][m][n] = (f32x4){0.f, 0.f, 0.f, 0.f};
        cur = nxt; cA = nA; cB = nB; ++ui;
        if constexpr (ALIGN_EPI) { if (wr == 1) PG8_BAR; }
    }
    PG8_WAIT_V(0);
    if constexpr (!ALIGN_EPI) { if (wr == 0) PG8_BAR; }
    PG8_BAR;
    if constexpr (Epi::AFTER_DRAIN) { E.fused(acc, cur, wr, wc, fr, fq, lds, wid, lane); S.done(cur); }
#undef PG8_SA
#undef PG8_SB
#undef PG8_STAGE
#undef PG8_LDA
#undef PG8_LDB
#undef PG8_MMA
#undef PG8_WAIT_V
#undef PG8_WAIT_L
#undef PG8_BAR
#undef PG8_SCHED
}
}
namespace pg8 {
struct EpiZ {
    static constexpr bool PERM = true, AFTER_DRAIN = false;
    bf16_t* Z; bf16_t* G;
    __device__ __forceinline__ void operator()(const f32x4 (&acc)[2][2][4][2], const Unit& u, int wr, int wc, int fr, int fq) const {
        const int row0 = u.pm * BM + wr * 64 + fr, colt = u.pn * BM; const bool gate = colt >= NZ;
        bf16_t* base = gate ? G : Z; const int ld = gate ? NGATE : NZ; const int col0 = (gate ? colt - NZ : colt) + wc * 32 + 8 * fq;
#pragma unroll
        for (int ai = 0; ai < 2; ++ai)
#pragma unroll
            for (int m = 0; m < 4; ++m) { bf16_t* rowp = base + (size_t)(row0 + ai * HALF + m * 16) * ld + col0;
#pragma unroll
                for (int bj = 0; bj < 2; ++bj) { f32x4 v0 = acc[ai][bj][m][0], v1 = acc[ai][bj][m][1];
                    if (gate) {
#pragma unroll
                        for (int e = 0; e < 4; ++e) { v0[e] = sigmoidf_(v0[e]); v1[e] = sigmoidf_(v1[e]); } }
                    ::u32x4 w; w.x = pk2(v0[0], v0[1]); w.y = pk2(v0[2], v0[3]); w.z = pk2(v1[0], v1[1]); w.w = pk2(v1[2], v1[3]);
                    *(::u32x4*)(rowp + bj * HALF) = w; } }
    }
};
template <bool FIRST> struct EpiGate {
    static constexpr bool PERM = true, AFTER_DRAIN = false;
    const bf16_t* G; bf16_t* Y;
    __device__ __forceinline__ void operator()(const f32x4 (&acc)[2][2][4][2], const Unit& u, int wr, int wc, int fr, int fq) const {
        const int row0 = u.pm * BM + wr * 64 + fr, col0 = u.pn * BM + wc * 32 + 8 * fq;
#pragma unroll
        for (int ai = 0; ai < 2; ++ai)
#pragma unroll
            for (int m = 0; m < 4; ++m) { const size_t row = (size_t)(row0 + ai * HALF + m * 16);
#pragma unroll
                for (int bj = 0; bj < 2; ++bj) { const f32x4 v0 = acc[ai][bj][m][0], v1 = acc[ai][bj][m][1];
                    const ::u32x4 g = *(const ::u32x4*)(G + row * NGATE + col0 + bj * HALF);
                    float o[8] = { bf_lo(g.x) * v0[0], bf_hi(g.x) * v0[1], bf_lo(g.y) * v0[2], bf_hi(g.y) * v0[3], bf_lo(g.z) * v1[0], bf_hi(g.z) * v1[1], bf_lo(g.w) * v1[2], bf_hi(g.w) * v1[3] };
                    bf16_t* yp = Y + row * DM + col0 + bj * HALF;
                    if (!FIRST) { const ::u32x4 y = *(const ::u32x4*)yp;
                        o[0] += bf_lo(y.x); o[1] += bf_hi(y.x); o[2] += bf_lo(y.y); o[3] += bf_hi(y.y); o[4] += bf_lo(y.z); o[5] += bf_hi(y.z); o[6] += bf_lo(y.w); o[7] += bf_hi(y.w); }
                    ::u32x4 w; w.x = pk2(o[0], o[1]); w.y = pk2(o[2], o[3]); w.z = pk2(o[4], o[5]); w.w = pk2(o[6], o[7]);
                    *(::u32x4*)yp = w; } }
    }
};
struct EpiR {
    static constexpr bool PERM = true, AFTER_DRAIN = false;
    const float* X; const float* MOD; float* R;
    __device__ __forceinline__ void operator()(const f32x4 (&acc)[2][2][4][2], const Unit& u, int wr, int wc, int fr, int fq) const {
        const int row0 = u.pm * BM + wr * 64 + fr, col0 = u.pn * BM + wc * 32 + 8 * fq;
        const float* gt = MOD + (size_t)((u.pm * BM) / SEQ) * MODW + 2 * DM;
        f32x4 g[2][2];
#pragma unroll
        for (int bj = 0; bj < 2; ++bj) { g[bj][0] = *(const f32x4*)(gt + col0 + bj * HALF); g[bj][1] = *(const f32x4*)(gt + col0 + bj * HALF + 4); }
#pragma unroll
        for (int ai = 0; ai < 2; ++ai)
#pragma unroll
            for (int m = 0; m < 4; ++m) { const size_t off = (size_t)(row0 + ai * HALF + m * 16) * DM + col0;
#pragma unroll
                for (int bj = 0; bj < 2; ++bj) {
                    const f32x4 x0 = *(const f32x4*)(X + off + bj * HALF), x1 = *(const f32x4*)(X + off + bj * HALF + 4);
                    *(f32x4*)(R + off + bj * HALF) = x0 * ALPHA_RES + g[bj][0] * acc[ai][bj][m][0];
                    *(f32x4*)(R + off + bj * HALF + 4) = x1 * ALPHA_RES + g[bj][1] * acc[ai][bj][m][1]; } }
    }
};
struct EpiStore {
    static constexpr bool PERM = true, AFTER_DRAIN = false;
    bf16_t* O;
    __device__ __forceinline__ void operator()(const f32x4 (&acc)[2][2][4][2], const Unit& u, int wr, int wc, int fr, int fq) const {
        const int row0 = u.pm * BM + wr * 64 + fr, col0 = u.pn * BM + wc * 32 + 8 * fq;
#pragma unroll
        for (int ai = 0; ai < 2; ++ai)
#pragma unroll
            for (int m = 0; m < 4; ++m) { bf16_t* rowp = O + (size_t)(row0 + ai * HALF + m * 16) * DM + col0;
#pragma unroll
                for (int bj = 0; bj < 2; ++bj) { const f32x4 v0 = acc[ai][bj][m][0], v1 = acc[ai][bj][m][1];
                    ::u32x4 w; w.x = pk2(v0[0], v0[1]); w.y = pk2(v0[2], v0[3]); w.z = pk2(v1[0], v1[1]); w.w = pk2(v1[2], v1[3]);
                    *(::u32x4*)(rowp + bj * HALF) = w; } }
    }
};
}
namespace datt {
constexpr int KROW = 144;
constexpr int KBUF = 64 * KROW, VBUF = 64 * 256, LDS_K = 0, LDS_V = 2 * KBUF, LDS_ST = LDS_V + 2 * VBUF, STROW = 272, ST_WAVE = 32 * STROW, LDS_BYTES = LDS_ST + 8 * ST_WAVE;
DI unsigned vrow(unsigned key) { return (key & ~12u) | ((key & 4u) << 1) | ((key & 8u) >> 1); }

template <bool DRY> DI void attn_unit(LAS unsigned char* lds, bf16_t* Z, const float* lam, const float* subln_g, int b, int h, int qb) {
    int tid_o = threadIdx.x; OPAQUE(tid_o); const int tid = tid_o, lane = tid & 63, r32 = lane & 31, hi = lane >> 5; const int wid = __builtin_amdgcn_readfirstlane(tid >> 6);
    const size_t rowbase = (size_t)b * SEQ;
    const int q_first = qb * 256 + wid * 32, q_me = q_first + r32;
    float lam_val;
    { const float p1 = lam[lane] * lam[64 + lane], p2 = lam[128 + lane] * lam[192 + lane]; lam_val = __expf(wave_sum(p1)) - __expf(wave_sum(p2)) + LAMBDA_INIT; }
    const int NT = 4 * (qb + 1);
    const int k_key = tid >> 3, k_ch = tid & 7;
    const int v_key0 = tid >> 4, v_ch = tid & 15;
    const unsigned tb0 = LDS_V + tr_base(lane, 0), tb1 = LDS_V + tr_base(lane, 1); unsigned q64 = ((lane & 15) >> 2) << 6;
    const unsigned kb = LDS_K + r32 * KROW + hi * 16;
#pragma unroll
    for (int m = 0; m < 2; ++m) {
        bf16x8 qf[4];
        { const bf16_t* qp = Z + (rowbase + q_me) * NZ + ZC_Q + h * 128 + m * 64 + 8 * hi;
#pragma unroll
          for (int s = 0; s < 4; ++s) qf[s] = *(const bf16x8*)(qp + 16 * s); }
        const bf16_t* ksrc = Z + (rowbase + k_key) * NZ + ZC_K + h * 128 + m * 64 + k_ch * 8;
        const bf16_t* vsrc = Z + (rowbase + v_key0) * NZ + ZC_V + h * 128 + v_ch * 8;
        f32x16 O[4];
#pragma unroll
        for (int c = 0; c < 4; ++c)
#pragma unroll
            for (int r = 0; r < 16; ++r) O[c][r] = 0.f;
        float mrun = -1e30f, lrun = 0.f;
        u32x4 pk_ = *(const u32x4*)ksrc, pv0 = *(const u32x4*)vsrc, pv1 = *(const u32x4*)(vsrc + (size_t)32 * NZ);
        __syncthreads();
        *(LAS u32x4*)(lds + LDS_K + k_key * KROW + k_ch * 16) = pk_;
        *(LAS u32x4*)(lds + LDS_V + off_b(vrow(v_key0), v_ch)) = pv0;
        *(LAS u32x4*)(lds + LDS_V + off_b(vrow(v_key0 + 32), v_ch)) = pv1;
        { const size_t o = (size_t)64 * NZ; pk_ = *(const u32x4*)(ksrc + o); pv0 = *(const u32x4*)(vsrc + o); pv1 = *(const u32x4*)(vsrc + o + (size_t)32 * NZ); }
        __syncthreads();
        for (int kt = 0; kt < NT; ++kt) {
            const int cur = kt & 1, nxt = cur ^ 1;
            if (kt + 1 < NT) {
                *(LAS u32x4*)(lds + LDS_K + nxt * KBUF + k_key * KROW + k_ch * 16) = pk_;
                *(LAS u32x4*)(lds + LDS_V + nxt * VBUF + off_b(vrow(v_key0), v_ch)) = pv0;
                *(LAS u32x4*)(lds + LDS_V + nxt * VBUF + off_b(vrow(v_key0 + 32), v_ch)) = pv1;
                if (kt + 2 < NT) { const size_t o = (size_t)(kt + 2) * 64 * NZ; pk_ = *(const u32x4*)(ksrc + o); pv0 = *(const u32x4*)(vsrc + o); pv1 = *(const u32x4*)(vsrc + o + (size_t)32 * NZ); }
            }
            if (kt * 64 <= q_first + 31) {
            f32x16 p[2];
#pragma unroll
            for (int hf = 0; hf < 2; ++hf) {
#pragma unroll
                for (int r = 0; r < 16; ++r) p[hf][r] = 0.f;
#pragma unroll
                for (int s = 0; s < 4; ++s) { const bf16x8 a = *(const LAS bf16x8*)(lds + kb + cur * KBUF + 32 * hf * KROW + s * 32); p[hf] = MFMA32(a, qf[s], p[hf]); }
            }
            if (kt * 64 + 63 > q_first) {
#pragma unroll
                for (int hf = 0; hf < 2; ++hf)
#pragma unroll
                    for (int r = 0; r < 16; ++r) { const int key = kt * 64 + 32 * hf + crow(r, hi); if (key > q_me) p[hf][r] = -1e30f; }
            }
            float mx = p[0][0];
#pragma unroll
            for (int r = 1; r < 16; ++r) mx = fmaxf(mx, p[0][r]);
#pragma unroll
            for (int r = 0; r < 16; ++r) mx = fmaxf(mx, p[1][r]);
            mx = fmaxf(mx, __shfl_xor(mx, 32));
            const float mnew = fmaxf(mrun, mx), alpha = __builtin_amdgcn_exp2f(mrun - mnew); mrun = mnew;
            float ls = 0.f;
#pragma unroll
            for (int hf = 0; hf < 2; ++hf)
#pragma unroll
                for (int r = 0; r < 16; ++r) { const float e = __builtin_amdgcn_exp2f(p[hf][r] - mnew); p[hf][r] = e; ls += e; }
            lrun = lrun * alpha + ls;
#pragma unroll
            for (int c = 0; c < 4; ++c)
#pragma unroll
                for (int r = 0; r < 16; ++r) O[c][r] *= alpha;
            bf16x8 pf[4];
            pf[0] = pack_step(p[0], 0); pf[1] = pack_step(p[0], 1); pf[2] = pack_step(p[1], 0); pf[3] = pack_step(p[1], 1);
#pragma unroll
            for (int c = 0; c < 4; ++c) { OPAQUE(q64); const unsigned cx = (64u * c) ^ q64;
#pragma unroll
                for (int ks = 0; ks < 4; ++ks) {
                    const s16x4 lo = tr_read(lds + tb0 + cur * VBUF + cx + 4096 * ks), hi4 = tr_read(lds + tb1 + cur * VBUF + cx + 4096 * ks);
                    O[c] = MFMA32(cat8(lo, hi4), pf[ks], O[c]);
                } }
            }
            __syncthreads();
        }
        const float ltot = lrun + __shfl_xor(lrun, 32), inv = 1.0f / ltot;
        if (m == 0) {
            LAS unsigned char* stg = lds + LDS_ST + wid * ST_WAVE;
#pragma unroll
            for (int c = 0; c < 4; ++c)
#pragma unroll
                for (int g4 = 0; g4 < 4; ++g4) { const int dv0 = 32 * c + 8 * g4 + 4 * hi;
                    u32x2 w; w.x = pk2(O[c][4 * g4] * inv, O[c][4 * g4 + 1] * inv); w.y = pk2(O[c][4 * g4 + 2] * inv, O[c][4 * g4 + 3] * inv);
                    *(LAS u32x2*)(stg + r32 * STROW + dv0 * 2) = w; }
        } else {
            const float li = lam_val * inv;
            float ss = 0.f;
            LAS unsigned char* stg = lds + LDS_ST + wid * ST_WAVE;
#pragma unroll
            for (int c = 0; c < 4; ++c)
#pragma unroll
                for (int g4 = 0; g4 < 4; ++g4) { const int dv0 = 32 * c + 8 * g4 + 4 * hi; const u32x2 k2 = *(const LAS u32x2*)(stg + r32 * STROW + dv0 * 2);
                    O[c][4 * g4] = bf_lo(k2.x) - li * O[c][4 * g4]; O[c][4 * g4 + 1] = bf_hi(k2.x) - li * O[c][4 * g4 + 1]; O[c][4 * g4 + 2] = bf_lo(k2.y) - li * O[c][4 * g4 + 2]; O[c][4 * g4 + 3] = bf_hi(k2.y) - li * O[c][4 * g4 + 3];
                    ss += (O[c][4 * g4] * O[c][4 * g4] + O[c][4 * g4 + 1] * O[c][4 * g4 + 1]) + (O[c][4 * g4 + 2] * O[c][4 * g4 + 2] + O[c][4 * g4 + 3] * O[c][4 * g4 + 3]); }
            ss += __shfl_xor(ss, 32);
            const float rstd = rsqrtf(ss * (1.0f / 128.0f) + LN_EPS) * (1.0f - LAMBDA_INIT);
#pragma unroll
            for (int c = 0; c < 4; ++c)
#pragma unroll
                for (int g4 = 0; g4 < 4; ++g4) { const int dv0 = 32 * c + 8 * g4 + 4 * hi; const f32x4 gg = *(const f32x4*)(subln_g + dv0);
                    u32x2 w; w.x = pk2(O[c][4 * g4] * rstd * gg[0], O[c][4 * g4 + 1] * rstd * gg[1]); w.y = pk2(O[c][4 * g4 + 2] * rstd * gg[2], O[c][4 * g4 + 3] * rstd * gg[3]);
                    *(LAS u32x2*)(stg + r32 * STROW + dv0 * 2) = w; }
        }
    }
    LAS unsigned char* stg = lds + LDS_ST + wid * ST_WAVE;
    asm volatile("s_waitcnt lgkmcnt(0)" ::: "memory");
    bf16_t* obase = Z + (rowbase + q_first) * NZ + ZC_Q + h * 128;
#pragma unroll
    for (int i = 0; i < 8; ++i) { const int idx = lane + 64 * i, row = idx >> 4, ch = idx & 15;
        const u32x4 v = *(const LAS u32x4*)(stg + row * STROW + ch * 16); if (!DRY || v.x == 0x12345678u) *(u32x4*)(obase + (size_t)row * NZ + ch * 8) = v; }
}
}
namespace mls {
constexpr int QI = 0, KI = 32768, VI = 65536, SC = 131072;
constexpr int F_IG = 0, F_LF = 128, F_A = 256, F_M = 384, F_INTER = 512, F_EMT = 640, F_W = 768, F_DEN = 896, F_N = 1024, F_MISC = 1152,
              F_NQ2P = 1280, F_NQ1P = 1792, F_NP = 2304, F_RSQ = 2816, F_END = 3840;
constexpr int LDS_BYTES = SC + F_END * 4;
static_assert(LDS_BYTES <= 147456, "mLSTM LDS");

DI float scan_add(float x, int lane) {
#pragma unroll
    for (int o = 1; o < 64; o <<= 1) { const float y = __shfl_up(x, o); if (lane >= o) x += y; }
    return x;
}
DI float scan_max(float x, int lane) {
#pragma unroll
    for (int o = 1; o < 64; o <<= 1) { const float y = __shfl_up(x, o); if (lane >= o) x = fmaxf(x, y); }
    return x;
}
DI float log_sigmoid(float x) { return fminf(x, 0.f) - __logf(1.0f + __expf(-fabsf(x))); }

template <bool DRY> DI void mlstm_unit(LAS unsigned char* lds, bf16_t* Z, const float* GIF, const float* conv_w, const float* conv_b, const float* norm_g, int b, int hd) {
    int tid_o = threadIdx.x; OPAQUE(tid_o); const int tid = tid_o, lane = tid & 63; const int wid = __builtin_amdgcn_readfirstlane(tid >> 6);
    LAS float* sc = (LAS float*)(lds + SC);
#define MLS_LV unsigned L_ = lane; OPAQUE(L_); const unsigned r32 = L_ & 31, hi = L_ >> 5, rowb = 256u * r32, f16 = (((r32 & 3) << 2) | ((r32 >> 2) & 3)) << 4, q64 = ((L_ & 15) >> 2) << 6; (void)rowb; (void)f16; (void)q64; (void)hi
    f32x16 CT[4];
#pragma unroll
    for (int i = 0; i < 4; ++i)
#pragma unroll
        for (int r = 0; r < 16; ++r) CT[i][r] = 0.f;
    float m_prev = 0.f;
    if (tid < 128) sc[F_N + tid] = 0.f;
    const int img = wid >> 2, vc = wid & 3;
    const int st_i = wid >> 1, st_j0 = 2 * (wid & 1);

    u32x4 rawn[11]; float gin = 0.f, gfn = 0.f;
#define MLS_PREFETCH(CC) do { int tp = tid; OPAQUE(tp); const int p_mat = tp >> 8, p_ch = tp & 15, p_rg = (tp >> 4) & 15; const size_t tn = (size_t)b * SEQ + (size_t)(CC) * 128; \
        const bf16_t* srcn = Z + (tn + p_rg * 8) * NZ + (p_mat ? ZC_MK : ZC_MQ) + hd * 128 + p_ch * 8; \
        _Pragma("unroll") for (int j = 0; j < 11; ++j) { const int lp = (CC) * 128 + p_rg * 8 - 3 + j; rawn[j] = (u32x4){0u, 0u, 0u, 0u}; if (lp >= 0) rawn[j] = *(const u32x4*)(srcn + (ptrdiff_t)(j - 3) * NZ); } \
        if (tp < 128) { const float* gg = GIF + (tn + tp) * 8; gin = gg[hd]; gfn = gg[4 + hd]; } } while (0)
    MLS_PREFETCH(0);
    for (int c = 0; c < 16; ++c) {
        const size_t t0 = (size_t)b * SEQ + (size_t)c * 128;
        __syncthreads();
        u32x4 vn[8];
        { int tq = tid; OPAQUE(tq);
#pragma unroll
          for (int i = 0; i < 8; ++i) { const int idx = tq + 512 * i, row = idx >> 5, ch32 = idx & 31; vn[i] = *(const u32x4*)(Z + (t0 + row) * NZ + ZC_MV + hd * 256 + ch32 * 8); } }
        {
            int tq = tid; OPAQUE(tq);
            const int c_mat = tq >> 8, c_ch = tq & 15, c_rg = (tq >> 4) & 15;
            const int chan0 = c_mat * 512 + hd * 128 + c_ch * 8;
            const float kscale = c_mat ? 0.08838834764831845f : 1.0f;
            float cw[4][8], cb[8];
            { const float* cwp = conv_w + chan0; const float* cbp = conv_b + chan0; asm volatile("" : "+v"(cwp), "+v"(cbp));
#pragma unroll
              for (int j = 0; j < 4; ++j) { const f32x4 a = *(const f32x4*)(cwp + j * 1024), c4 = *(const f32x4*)(cwp + j * 1024 + 4);
                cw[j][0] = a[0]; cw[j][1] = a[1]; cw[j][2] = a[2]; cw[j][3] = a[3]; cw[j][4] = c4[0]; cw[j][5] = c4[1]; cw[j][6] = c4[2]; cw[j][7] = c4[3]; }
              const f32x4 a = *(const f32x4*)cbp, c4 = *(const f32x4*)(cbp + 4); cb[0] = a[0]; cb[1] = a[1]; cb[2] = a[2]; cb[3] = a[3]; cb[4] = c4[0]; cb[5] = c4[1]; cb[6] = c4[2]; cb[7] = c4[3]; }
            u32x4 raw[11];
#pragma unroll
            for (int j = 0; j < 11; ++j) raw[j] = rawn[j];
#pragma unroll
            for (int i = 0; i < 8; ++i) {
                float o[8];
#pragma unroll
                for (int e = 0; e < 8; ++e) { const int q = e >> 1; const bool hi_ = e & 1;
                    const float x0 = hi_ ? bf_hi(raw[i][q]) : bf_lo(raw[i][q]), x1 = hi_ ? bf_hi(raw[i + 1][q]) : bf_lo(raw[i + 1][q]), x2 = hi_ ? bf_hi(raw[i + 2][q]) : bf_lo(raw[i + 2][q]), x3 = hi_ ? bf_hi(raw[i + 3][q]) : bf_lo(raw[i + 3][q]);
                    const float y = cb[e] + cw[0][e] * x0 + cw[1][e] * x1 + cw[2][e] * x2 + cw[3][e] * x3; o[e] = siluf_(y) * kscale; }
                u32x4 w; w.x = pk2(o[0], o[1]); w.y = pk2(o[2], o[3]); w.z = pk2(o[4], o[5]); w.w = pk2(o[6], o[7]);
                *(LAS u32x4*)(lds + (c_mat ? KI : QI) + off_b(c_rg * 8 + i, c_ch)) = w;
            }
        }
        { int tq = tid; OPAQUE(tq);
#pragma unroll
        for (int i = 0; i < 8; ++i) { const int idx = tq + 512 * i, row = idx >> 5, ch32 = idx & 31;
            *(LAS u32x4*)(lds + VI + (ch32 >> 4) * 32768 + off_b(row, ch32 & 15)) = vn[i]; } }
        if (tid < 128) { sc[F_IG + tid] = gin; sc[F_LF + tid] = log_sigmoid(gfn);
            if (c > 0) sc[F_N + tid] = sc[F_MISC + 1] * sc[F_N + tid] + (sc[F_NP + tid] + sc[F_NP + 128 + tid]) + (sc[F_NP + 256 + tid] + sc[F_NP + 384 + tid]); }
        __syncthreads();
        if (wid == 0) {
            const float ig0 = sc[F_IG + 2 * lane], ig1 = sc[F_IG + 2 * lane + 1], lf0 = sc[F_LF + 2 * lane], lf1 = sc[F_LF + 2 * lane + 1];
            const float s2 = lf0 + lf1, incl = scan_add(s2, lane), excl = incl - s2;
            const float b0 = excl + lf0, b1 = incl, a0 = ig0 - b0, a1 = ig1 - b1;
            const float im = scan_max(fmaxf(a0, a1), lane); float em = __shfl_up(im, 1); if (lane == 0) em = -3.0e38f;
            const float cm0 = fmaxf(em, a0), cm1 = im;
            const float M0 = fmaxf(m_prev, cm0), M1 = fmaxf(m_prev, cm1);
            const float ML = __shfl(M1, 63), bL = __shfl(b1, 63);
            sc[F_A + 2 * lane] = a0; sc[F_A + 2 * lane + 1] = a1; sc[F_M + 2 * lane] = M0; sc[F_M + 2 * lane + 1] = M1;
            sc[F_INTER + 2 * lane] = __expf(m_prev - M0); sc[F_INTER + 2 * lane + 1] = __expf(m_prev - M1);
            sc[F_EMT + 2 * lane] = __expf(-(b0 + M0)); sc[F_EMT + 2 * lane + 1] = __expf(-(b1 + M1));
            sc[F_W + 2 * lane] = __expf(a0 - ML); sc[F_W + 2 * lane + 1] = __expf(a1 - ML);
            if (lane == 0) sc[F_MISC + 0] = __expf(m_prev - ML);
            m_prev = bL + ML;
        }
        f32x16 sT[2];
#pragma unroll
        for (int jj = 0; jj < 2; ++jj) {
#pragma unroll
            for (int r = 0; r < 16; ++r) sT[jj][r] = 0.f;
            const int j = st_j0 + jj;
            if (j <= st_i) { MLS_LV; const unsigned fh = (16u * hi) ^ f16;
#pragma unroll
                for (int ks = 0; ks < 8; ++ks) { const unsigned xo = rowb + ((32u * ks) ^ fh);
                    const bf16x8 a = *(const LAS bf16x8*)(lds + KI + 8192 * j + xo), q = *(const LAS bf16x8*)(lds + QI + 8192 * st_i + xo);
                    sT[jj] = MFMA32(a, q, sT[jj]); }
            }
        }
        __syncthreads();
        u32x2 pp[2][4];
        { MLS_LV; const int t = 32 * st_i + r32; const float Mt = sc[F_M + t]; const unsigned ab = SC + 4 * F_A + 128 * st_j0 + 16 * hi;
#pragma unroll
          for (int jj = 0; jj < 2; ++jj) { const int j = st_j0 + jj;
#pragma unroll
            for (int g4 = 0; g4 < 4; ++g4) { const int s0 = 32 * j + 8 * g4 + 4 * hi; float pv[4];
#pragma unroll
                for (int e = 0; e < 4; ++e) { const int s = s0 + e; pv[e] = (s <= t) ? __expf(*(const LAS float*)(lds + ab + 4 * (32 * jj + 8 * g4 + e)) - Mt) * sT[jj][4 * g4 + e] : 0.f; }
                pp[jj][g4].x = pk2(pv[0], pv[1]); pp[jj][g4].y = pk2(pv[2], pv[3]); } } }
        f32x16 acc[4];
#pragma unroll
        for (int ti = 0; ti < 4; ++ti)
#pragma unroll
            for (int r = 0; r < 16; ++r) acc[ti][r] = 0.f;
        if (c > 0) {
#pragma unroll
            for (int dt = 0; dt < 4; ++dt)
#pragma unroll
                for (int s2 = 0; s2 < 2; ++s2) { const bf16x8 bfr = pack_step(CT[dt], s2); MLS_LV;
                    const unsigned a0 = QI + rowb + 8 * hi + ((64u * dt + 32u * s2) ^ f16), a1 = QI + rowb + 8 * hi + ((64u * dt + 32u * s2 + 16u) ^ f16);
#pragma unroll
                    for (int ti = 0; ti < 4; ++ti) {
                        const s16x4 lo = *(const LAS s16x4*)(lds + a0 + 8192 * ti), hi4 = *(const LAS s16x4*)(lds + a1 + 8192 * ti);
                        acc[ti] = MFMA32(cat8(lo, hi4), bfr, acc[ti]); }
                    __builtin_amdgcn_sched_barrier(0); }
        }
        { int tq = tid; OPAQUE(tq); const int t = tq & 127, part = tq >> 7; float d = 0.f;
#pragma unroll
          for (int cc = 0; cc < 4; ++cc) { const int ch = 4 * part + cc; const u32x4 raw = *(const LAS u32x4*)(lds + QI + off_b(t, ch)); const LAS float* nn = sc + F_N + 8 * ch;
              d += bf_lo(raw.x) * nn[0] + bf_hi(raw.x) * nn[1] + bf_lo(raw.y) * nn[2] + bf_hi(raw.y) * nn[3] + bf_lo(raw.z) * nn[4] + bf_hi(raw.z) * nn[5] + bf_lo(raw.w) * nn[6] + bf_hi(raw.w) * nn[7]; }
          sc[F_NQ2P + part * 128 + t] = d; }
        __syncthreads();
        { MLS_LV; const unsigned ib = SC + 4 * F_INTER + 16 * hi;
#pragma unroll
          for (int ti = 0; ti < 4; ++ti)
#pragma unroll
            for (int r = 0; r < 16; ++r) acc[ti][r] *= *(const LAS float*)(lds + ib + 4 * (32 * ti + (r & 3) + 8 * (r >> 2))); }
        { MLS_LV;
#pragma unroll
          for (int jj = 0; jj < 2; ++jj) { const int j = st_j0 + jj;
#pragma unroll
            for (int g4 = 0; g4 < 4; ++g4) *(LAS u32x2*)(lds + QI + 8192 * st_i + rowb + 8 * hi + ((64u * j + 16u * g4) ^ f16)) = pp[jj][g4]; } }
        { int tq = tid; OPAQUE(tq);
#pragma unroll
        for (int i = 0; i < 4; ++i) { const int idx = tq + 512 * i, row = idx >> 4, ch = idx & 15; LAS u32x4* p = (LAS u32x4*)(lds + KI + off_b(row, ch)); const u32x4 raw = *p; const float w = sc[F_W + row];
            u32x4 o; o.x = pk2(bf_lo(raw.x) * w, bf_hi(raw.x) * w); o.y = pk2(bf_lo(raw.y) * w, bf_hi(raw.y) * w); o.z = pk2(bf_lo(raw.z) * w, bf_hi(raw.z) * w); o.w = pk2(bf_lo(raw.w) * w, bf_hi(raw.w) * w); *p = o; } }
        __syncthreads();
        { const float decay = sc[F_MISC + 0];
#pragma unroll
          for (int dt = 0; dt < 4; ++dt)
#pragma unroll
            for (int r = 0; r < 16; ++r) CT[dt][r] *= decay; }
#pragma unroll
        for (int ks = 0; ks < 8; ++ks) {
            MLS_LV;
            const unsigned tbv0 = VI + img * 32768 + tr_base(L_, 0) + ((64u * vc) ^ q64), tbv1 = VI + img * 32768 + tr_base(L_, 1) + ((64u * vc) ^ q64);
            const unsigned tbk0 = KI + tr_base(L_, 0), tbk1 = KI + tr_base(L_, 1);
            const bf16x8 bv = cat8(tr_read(lds + tbv0 + 4096 * ks), tr_read(lds + tbv1 + 4096 * ks));
            const unsigned xo = QI + rowb + ((32u * ks) ^ ((16u * hi) ^ f16));
#pragma unroll
            for (int ti = 0; ti < 4; ++ti) if (ks < 2 * (ti + 1)) { const bf16x8 a = *(const LAS bf16x8*)(lds + xo + 8192 * ti); acc[ti] = MFMA32(a, bv, acc[ti]); }
#pragma unroll
            for (int dt = 0; dt < 4; ++dt) { const unsigned cx = (64u * dt) ^ q64; const bf16x8 a = cat8(tr_read(lds + tbk0 + 4096 * ks + cx), tr_read(lds + tbk1 + 4096 * ks + cx)); CT[dt] = MFMA32(a, bv, CT[dt]); }
            __builtin_amdgcn_sched_barrier(0);
        }
        { int tq = tid; OPAQUE(tq); const int t = tq & 127, part = tq >> 7; float d = 0.f;
#pragma unroll
          for (int cc = 0; cc < 4; ++cc) { const u32x4 raw = *(const LAS u32x4*)(lds + QI + off_b(t, 4 * part + cc));
              d += (bf_lo(raw.x) + bf_hi(raw.x)) + (bf_lo(raw.y) + bf_hi(raw.y)) + (bf_lo(raw.z) + bf_hi(raw.z)) + (bf_lo(raw.w) + bf_hi(raw.w)); }
          sc[F_NQ1P + part * 128 + t] = d;
          float nn = 0.f;
          for (int s = 32 * part; s < 32 * part + 32; ++s) nn += bf2f(*(const LAS bf16_t*)(lds + KI + off_b(s, t >> 3) + (t & 7) * 2));
          sc[F_NP + part * 128 + t] = nn;
          if (tid == 0) sc[F_MISC + 1] = sc[F_MISC + 0]; }
        __syncthreads();
        if (tid < 128) { const float nq1 = (sc[F_NQ1P + tid] + sc[F_NQ1P + 128 + tid]) + (sc[F_NQ1P + 256 + tid] + sc[F_NQ1P + 384 + tid]);
            const float nq2 = (sc[F_NQ2P + tid] + sc[F_NQ2P + 128 + tid]) + (sc[F_NQ2P + 256 + tid] + sc[F_NQ2P + 384 + tid]);
            sc[F_DEN + tid] = 1.0f / fmaxf(fabsf(nq1 + sc[F_INTER + tid] * nq2), sc[F_EMT + tid]); }
        __syncthreads();
        u32x4 oraw[8];
        { int tq = tid; OPAQUE(tq);
#pragma unroll
          for (int i = 0; i < 8; ++i) { const int idx = tq + 512 * i, row = idx >> 5, ch = idx & 31; oraw[i] = *(const u32x4*)(Z + (t0 + row) * NZ + hd * 256 + ch * 8 + ZC_MO); } }
        { MLS_LV; const unsigned db = SC + 4 * F_DEN + 16 * hi, hb = VI + 2048 * hi + (32 * wid + r32) * 2;
#pragma unroll
          for (int ti = 0; ti < 4; ++ti)
#pragma unroll
            for (int r = 0; r < 16; ++r) { const int tt = 32 * ti + (r & 3) + 8 * (r >> 2); const float x = acc[ti][r] * *(const LAS float*)(lds + db + 4 * tt);
                *(LAS bf16_t*)(lds + hb + 512 * tt) = (bf16_t)(pk2(x, 0.f) & 0xffffu); } }
        __syncthreads();
        { const int cn = c + 1 < 16 ? c + 1 : 15; MLS_PREFETCH(cn); }
        { int tq = tid; OPAQUE(tq);
          const f32x4 g0 = *(const f32x4*)(norm_g + hd * 256 + (tq & 31) * 8), g1 = *(const f32x4*)(norm_g + hd * 256 + (tq & 31) * 8 + 4);
#pragma unroll
          for (int i = 0; i < 8; ++i) { const int idx = tq + 512 * i, row = idx >> 5, ch = idx & 31;
            const u32x4 hraw = *(const LAS u32x4*)(lds + VI + row * 512 + ch * 16);
            const float h0 = bf_lo(hraw.x), h1 = bf_hi(hraw.x), h2 = bf_lo(hraw.y), h3 = bf_hi(hraw.y), h4 = bf_lo(hraw.z), h5 = bf_hi(hraw.z), h6 = bf_lo(hraw.w), h7 = bf_hi(hraw.w);
            float ssq = (h0 * h0 + h1 * h1) + (h2 * h2 + h3 * h3) + (h4 * h4 + h5 * h5) + (h6 * h6 + h7 * h7);
            ssq += __shfl_xor(ssq, 1); ssq += __shfl_xor(ssq, 2); ssq += __shfl_xor(ssq, 4); ssq += __shfl_xor(ssq, 8); ssq += __shfl_xor(ssq, 16);
            const float rstd = rsqrtf(ssq * (1.0f / 256.0f) + LN_EPS);
            bf16_t* gp = Z + (t0 + row) * NZ + hd * 256 + ch * 8;
            u32x4 o;
            o.x = pk2(h0 * rstd * g0[0] * sigmoidf_(bf_lo(oraw[i].x)), h1 * rstd * g0[1] * sigmoidf_(bf_hi(oraw[i].x)));
            o.y = pk2(h2 * rstd * g0[2] * sigmoidf_(bf_lo(oraw[i].y)), h3 * rstd * g0[3] * sigmoidf_(bf_hi(oraw[i].y)));
            o.z = pk2(h4 * rstd * g1[0] * sigmoidf_(bf_lo(oraw[i].z)), h5 * rstd * g1[1] * sigmoidf_(bf_hi(oraw[i].z)));
            o.w = pk2(h6 * rstd * g1[2] * sigmoidf_(bf_lo(oraw[i].w)), h7 * rstd * g1[3] * sigmoidf_(bf_hi(oraw[i].w)));
            if (!DRY || o.x == 0x12345678u) *(u32x4*)(gp + ZC_MV) = o; } }
    }
    __syncthreads();
}
#undef MLS_LV
#undef MLS_PREFETCH
}
namespace peer {
constexpr int KROW = 144;
constexpr int L_KEYS = 0, L_IDX = 2 * 128 * KROW, LDS_BYTES = L_IDX + 512 * 32;
DI unsigned ordf(float f) { const unsigned u = __float_as_uint(f); return u ^ ((unsigned)((int)u >> 31) | 0x80000000u); }
DI float deord(unsigned k) { return __uint_as_float(k ^ ((~(unsigned)((int)k >> 31)) | 0x80000000u)); }
DI void ins16(unsigned (&L)[16], unsigned v) {
#pragma unroll
    for (int j = 0; j < 16; ++j) { const unsigned t = L[j] > v ? L[j] : v; v = L[j] > v ? v : L[j]; L[j] = t; }
}
DI float gelu_erf(float x) { return 0.5f * x * (1.0f + erff(x * 0.7071067811865476f)); }

DI void stage_keys(LAS unsigned char* lds, const float* keys) {
    for (int i = threadIdx.x; i < 2 * 128 * 8; i += 512) { const int row = i >> 3, ch = i & 7; const float* s = keys + row * 64 + ch * 8;
        const f32x4 a = *(const f32x4*)s, b = *(const f32x4*)(s + 4);
        u32x4 w; w.x = pk2(a[0], a[1]); w.y = pk2(a[2], a[3]); w.z = pk2(b[0], b[1]); w.w = pk2(b[2], b[3]);
        *(LAS u32x4*)(lds + L_KEYS + row * KROW + ch * 16) = w; }
}

DI void select_tile(LAS unsigned char* lds, const bf16_t* QP, int tok0, bf16_t* SELE, float* SELG) {
    int tid_o = threadIdx.x; OPAQUE(tid_o); const int tid = tid_o, lane = tid & 63, r32 = lane & 31, hi = lane >> 5; const int wid = __builtin_amdgcn_readfirstlane(tid >> 6);
    unsigned LA[16], LB[16];
#pragma unroll
    for (int p = 0; p < 2; ++p) {
        unsigned L[16];
#pragma unroll
        for (int i = 0; i < 16; ++i) L[i] = 0u;
        bf16x8 qf[4];
        { const bf16_t* qp = QP + (size_t)(tok0 + r32) * DM + wid * 128 + p * 64 + 8 * hi;
#pragma unroll
          for (int s = 0; s < 4; ++s) qf[s] = *(const bf16x8*)(qp + 16 * s); }
#pragma unroll
        for (int nt = 0; nt < 4; ++nt) {
            f32x16 acc;
#pragma unroll
            for (int r = 0; r < 16; ++r) acc[r] = 0.f;
#pragma unroll
            for (int s = 0; s < 4; ++s) { const bf16x8 a = *(const LAS bf16x8*)(lds + L_KEYS + (p * 128 + 32 * nt + r32) * KROW + (2 * s + hi) * 16); acc = MFMA32(a, qf[s], acc); }
#pragma unroll
            for (int r = 0; r < 16; ++r) ins16(L, (ordf(acc[r]) & ~0x7Fu) | (unsigned)(32 * nt + crow(r, hi)));
        }
        unsigned O[16];
#pragma unroll
        for (int i = 0; i < 16; ++i) O[i] = L[i];
#pragma unroll
        for (int i = 0; i < 16; ++i) ins16(L, (unsigned)__shfl_xor((int)O[i], 32));
#pragma unroll
        for (int i = 0; i < 16; ++i) { if (p == 0) LA[i] = L[i]; else LB[i] = L[i]; }
    }
    unsigned CL[16];
#pragma unroll
    for (int i = 0; i < 16; ++i) CL[i] = 0u;
#pragma unroll
    for (int i = 0; i < 16; ++i) {
        const float sa = deord(LA[i] & ~0x7Fu);
#pragma unroll
        for (int j = 0; j < 16; ++j) if ((i + 1) * (j + 1) <= 16) { const float sb = deord(LB[j] & ~0x7Fu); ins16(CL, (ordf(sa + sb) & ~0xFFu) | (unsigned)(i * 16 + j)); }
    }
    LAS unsigned char* itab = lds + L_IDX + tid * 32;
    { u32x4 wa, wb;
#pragma unroll
      for (int q = 0; q < 4; ++q) { wa[q] = (LA[4 * q] & 0x7Fu) | ((LA[4 * q + 1] & 0x7Fu) << 8) | ((LA[4 * q + 2] & 0x7Fu) << 16) | ((LA[4 * q + 3] & 0x7Fu) << 24);
                                    wb[q] = (LB[4 * q] & 0x7Fu) | ((LB[4 * q + 1] & 0x7Fu) << 8) | ((LB[4 * q + 2] & 0x7Fu) << 16) | ((LB[4 * q + 3] & 0x7Fu) << 24); }
      *(LAS u32x4*)itab = wa; *(LAS u32x4*)(itab + 16) = wb; }
    const float mx = deord(CL[0] & ~0xFFu);
    float ev[16], sum = 0.f;
#pragma unroll
    for (int k = 0; k < 16; ++k) { ev[k] = __expf(deord(CL[k] & ~0xFFu) - mx); sum += ev[k]; }
    const float inv = 1.0f / sum;
    bf16_t* se = SELE + (size_t)(tok0 + r32) * 128 + wid * 16;
    float* sg = SELG + (size_t)(tok0 + r32) * 128 + wid * 16;
#pragma unroll
    for (int k = 0; k < 16; ++k) if ((k >> 3) == hi) { const unsigned code = CL[k] & 0xFFu; const unsigned n1 = itab[code >> 4], n2 = itab[16 + (code & 15u)];
        se[k] = (bf16_t)(n1 * 128u + n2); sg[k] = ev[k] * inv; }
}

DI void u_phase_tile(LAS unsigned char* lds, int tile, int x, const bf16_t* SELE, const unsigned char* H2Q, const unsigned char* U8S, float* PART) {
    int tid_o = threadIdx.x; OPAQUE(tid_o); const int tid = tid_o, lane = tid & 63, j = lane >> 3, c = lane & 7; const int wid = __builtin_amdgcn_readfirstlane(tid >> 6);
    *(LAS u32x4*)(lds + tid * 16) = *(const u32x4*)(SELE + (size_t)tile * 32 * 128 + tid * 8);
    __syncthreads();
    const unsigned char* Us = U8S + (size_t)x * NEXP * 128 + 16 * c;
#pragma unroll 1
    for (int jt = 0; jt < 4; ++jt) {
        const int tk = wid * 4 + jt; const size_t t = (size_t)tile * 32 + tk;
        const u32x4 hq = *(const u32x4*)(H2Q + t * DM + 128 * x + 16 * c);
        const LAS bf16_t* se = (const LAS bf16_t*)lds + tk * 128 + j;
        u32x4 ur[16];
#pragma unroll
        for (int g = 0; g < 16; ++g) { const unsigned e = se[8 * g]; ur[g] = *(const u32x4*)(Us + (size_t)e * 128); }
        float keep0 = 0.f, keep1 = 0.f;
#pragma unroll
        for (int g = 0; g < 16; ++g) {
            int d = __builtin_amdgcn_sdot4((int)ur[g].x, (int)hq.x, 0, false); d = __builtin_amdgcn_sdot4((int)ur[g].y, (int)hq.y, d, false);
            d = __builtin_amdgcn_sdot4((int)ur[g].z, (int)hq.z, d, false); d = __builtin_amdgcn_sdot4((int)ur[g].w, (int)hq.w, d, false);
            d += __shfl_xor(d, 1); d += __shfl_xor(d, 2); d += __shfl_xor(d, 4);
            if ((g & 7) == c) { if (g < 8) keep0 = (float)d; else keep1 = (float)d; }
        }
        float* pp = PART + t * 1024 + x * 128 + 8 * c + j;
        pp[0] = keep0; pp[64] = keep1;
    }
}
DI void red_tokens4(size_t t0, const float* __restrict__ PART, const bf16_t* __restrict__ SELE, const float* __restrict__ SELG, const float* __restrict__ SU, const float* __restrict__ SV,
                    const float* __restrict__ SH, float* __restrict__ COEF, float* __restrict__ CS) {
    const int lane = threadIdx.x & 63;
    float s[4][2], g[4][2], su[4][2], sv[4][2], sh[4];
#pragma unroll
    for (int q = 0; q < 4; ++q) { const size_t t = t0 + q; sh[q] = SH[t];
#pragma unroll
        for (int h = 0; h < 2; ++h) { const int k = lane + 64 * h; const unsigned e = SELE[t * 128 + k]; g[q][h] = SELG[t * 128 + k]; su[q][h] = SU[e]; sv[q][h] = SV[e];
            float a = 0.f;
#pragma unroll
            for (int xx = 0; xx < 8; ++xx) a += PART[t * 1024 + xx * 128 + k];
            s[q][h] = a; } }
#pragma unroll
    for (int q = 0; q < 4; ++q) { const size_t t = t0 + q; float cs = 0.f;
#pragma unroll
        for (int h = 0; h < 2; ++h) { const float cf = g[q][h] * gelu_erf(s[q][h] * su[q][h] * sh[q]) * sv[q][h]; COEF[t * 128 + lane + 64 * h] = cf; cs += cf; }
        cs = wave_sum(cs);
        if (lane == 0) CS[t] = cs; }
}
DI void v_phase_tile(LAS unsigned char* lds, int tile, int x, const bf16_t* SELE, const float* COEF, const float* CS, const unsigned char* V8S, float* YF) {
    int tid_o = threadIdx.x; OPAQUE(tid_o); const int tid = tid_o, lane = tid & 63, j = lane >> 3, c = lane & 7; const int wid = __builtin_amdgcn_readfirstlane(tid >> 6);
    *(LAS u32x4*)(lds + tid * 16) = *(const u32x4*)(SELE + (size_t)tile * 32 * 128 + tid * 8);
    *(LAS u32x4*)(lds + 8192 + tid * 16) = *(const u32x4*)(COEF + (size_t)tile * 32 * 128 + tid * 4);
    *(LAS u32x4*)(lds + 16384 + tid * 16) = *(const u32x4*)(COEF + (size_t)tile * 32 * 128 + 2048 + tid * 4);
    __syncthreads();
    const unsigned char* Vs = V8S + (size_t)x * NEXP * 128 + 16 * c;
#pragma unroll 1
    for (int jt = 0; jt < 4; ++jt) {
        const int tk = wid * 4 + jt; const size_t t = (size_t)tile * 32 + tk;
        const LAS bf16_t* se = (const LAS bf16_t*)lds + tk * 128 + j;
        const LAS float* cf = (const LAS float*)(lds + 8192) + tk * 128 + j;
        u32x4 vr[16];
#pragma unroll
        for (int g = 0; g < 16; ++g) { const unsigned e = se[8 * g]; vr[g] = *(const u32x4*)(Vs + (size_t)e * 128); }
        float acc[16];
#pragma unroll
        for (int i = 0; i < 16; ++i) acc[i] = 0.f;
#pragma unroll
        for (int g = 0; g < 16; ++g) { const float co = cf[8 * g];
#pragma unroll
            for (int i = 0; i < 4; ++i) { const unsigned u = vr[g][i];
                acc[4 * i] += co * (float)(u & 0xffu); acc[4 * i + 1] += co * (float)((u >> 8) & 0xffu); acc[4 * i + 2] += co * (float)((u >> 16) & 0xffu); acc[4 * i + 3] += co * (float)(u >> 24); } }
#pragma unroll
        for (int i = 0; i < 16; ++i) { acc[i] += __shfl_xor(acc[i], 8); acc[i] += __shfl_xor(acc[i], 16); acc[i] += __shfl_xor(acc[i], 32); }
        if (j == 0) { const float off = 128.0f * CS[t]; float* yp = YF + t * DM + 128 * x + 16 * c;
#pragma unroll
            for (int i = 0; i < 4; ++i) { f32x4 o; o[0] = acc[4 * i] - off; o[1] = acc[4 * i + 1] - off; o[2] = acc[4 * i + 2] - off; o[3] = acc[4 * i + 3] - off; *(f32x4*)(yp + 4 * i) = o; } }
    }
}
DI void final_rows2(size_t m0, size_t m1, float* YFOUT, const float* __restrict__ X1, const float* __restrict__ MOD, const float* __restrict__ ln_g, const float* __restrict__ ln_b) {
    const int lane = threadIdx.x & 63;
    f32x4 v[2][4];
#pragma unroll
    for (int r = 0; r < 2; ++r) { const size_t m = r ? m1 : m0; const int b = (int)(m / SEQ);
        const f32x4* yr = (const f32x4*)(YFOUT + m * DM) + lane; const f32x4* xr = (const f32x4*)(X1 + m * DM) + lane; const f32x4* gt = (const f32x4*)(MOD + (size_t)b * MODW + 5 * DM) + lane;
#pragma unroll
        for (int q = 0; q < 4; ++q) v[r][q] = xr[64 * q] * ALPHA_RES + gt[64 * q] * yr[64 * q]; }
#pragma unroll
    for (int r = 0; r < 2; ++r) { const size_t m = r ? m1 : m0; float s = 0.f;
#pragma unroll
        for (int q = 0; q < 4; ++q) s += (v[r][q].x + v[r][q].y) + (v[r][q].z + v[r][q].w);
        const float mean = wave_sum(s) * (1.f / DM); float s2 = 0.f;
#pragma unroll
        for (int q = 0; q < 4; ++q) { v[r][q] = v[r][q] - mean; s2 += (v[r][q].x * v[r][q].x + v[r][q].y * v[r][q].y) + (v[r][q].z * v[r][q].z + v[r][q].w * v[r][q].w); }
        const float rstd = rsqrtf(wave_sum(s2) * (1.f / DM) + LN_EPS);
        f32x4* op = (f32x4*)(YFOUT + m * DM) + lane;
#pragma unroll
        for (int q = 0; q < 4; ++q) op[64 * q] = v[r][q] * rstd * ((const f32x4*)ln_g)[lane + 64 * q] + ((const f32x4*)ln_b)[lane + 64 * q]; }
}
}
constexpr int NWAVES = 8;
#ifndef MK_N_LAUNCHES
#define MK_N_LAUNCHES 1
#endif
constexpr int N_PHASES = 14;
constexpr int RING_BYTES = 147456;
constexpr int MISC_OFF = RING_BYTES;
constexpr int LDS_BYTES = RING_BYTES + 4096;
static_assert(pg8::STAGE_BYTES <= RING_BYTES && datt::LDS_BYTES <= RING_BYTES && mls::LDS_BYTES <= RING_BYTES && peer::LDS_BYTES <= RING_BYTES, "LDS map");

typedef GAS unsigned gu32;
#define RLX_AGENT __ATOMIC_RELAXED, __HIP_MEMORY_SCOPE_AGENT
#define LDS_WAIT() asm volatile("s_waitcnt lgkmcnt(0)" ::: "memory")

#define XB_TMO      128
#define XB_XCNT(j)  (256  + 64 * (j))
#define XB_XSUB(j)  (1280 + 64 * (j))
#define XB_XGEN(j)  (2304 + 64 * (j))
#define XB_TOP      3328
#define XB_TOPGEN   3392
#define XCD_BAR_WORDS 3456
#define XB_SPIN_CAP (1u << 22)
DI unsigned xb_ld(unsigned* p)              { return __hip_atomic_load(p, __ATOMIC_RELAXED, __HIP_MEMORY_SCOPE_AGENT); }
DI unsigned xb_add(unsigned* p, unsigned v) { return __hip_atomic_fetch_add(p, v, __ATOMIC_RELAXED, __HIP_MEMORY_SCOPE_AGENT); }
DI unsigned xb_xcc_id() { return (unsigned)__builtin_amdgcn_s_getreg((3 << 11) | 20) & 0xFu; }
#define XB_SPIN(cond, bar) do { unsigned _sp = 0; while (cond) { __builtin_amdgcn_s_sleep(1); \
    if ((++_sp & 255u) == 0u) { if (xb_ld(&(bar)[XB_TMO])) break; if (_sp > XB_SPIN_CAP) { atomicAdd(&(bar)[XB_TMO], 1u); break; } } } } while (0)
struct XcdBarrier { unsigned* bar; unsigned x; volatile LAS unsigned* st; };
DI XcdBarrier xcd_barrier_post(unsigned* bar, volatile LAS unsigned* st) {
    XcdBarrier b; b.bar = bar; b.x = xb_xcc_id(); b.st = st;
    if (threadIdx.x == 0) st[2] = xb_add(&bar[XB_XCNT(b.x)], 1u);
    return b;
}
DI void xcd_barrier_complete(unsigned* bar, unsigned x, unsigned& nloc, unsigned& nx) {
    const unsigned G = gridDim.x * gridDim.y * gridDim.z;
    unsigned sum, cnt, mine, sp = 0u;
    for (;;) {
        sum = 0u; cnt = 0u; mine = 0u;
#pragma unroll
        for (unsigned j = 0; j < 16; ++j) { const unsigned c = xb_ld(&bar[XB_XCNT(j)]); sum += c; cnt += (c > 0u) ? 1u : 0u; mine = (j == x) ? c : mine; }
        if (sum == G) break;
        __builtin_amdgcn_s_sleep(1);
        if ((++sp & 255u) == 0u) { if (xb_ld(&bar[XB_TMO])) break; if (sp > XB_SPIN_CAP) { atomicAdd(&bar[XB_TMO], 1u); break; } }
    }
    nloc = mine > 0u ? mine : 1u; nx = cnt > 0u ? cnt : 1u;
}
DI void xcd_barrier(const XcdBarrier& b) {
    asm volatile("s_waitcnt vmcnt(0)" ::: "memory");
    __syncthreads();
    if (threadIdx.x == 0) {
        unsigned* bar = b.bar;
        __builtin_amdgcn_s_waitcnt(0);
        unsigned nloc = b.st[0], nx = b.st[1];
        if (nloc == 0u) { xcd_barrier_complete(bar, b.x, nloc, nx); b.st[0] = nloc; b.st[1] = nx; }
        const unsigned old = xb_add(&bar[XB_XSUB(b.x)], 1u);
        const unsigned gen = old / nloc;
        if (old + 1u == (gen + 1u) * nloc) {
            __builtin_amdgcn_fence(__ATOMIC_RELEASE, "agent");
            asm volatile("s_waitcnt vmcnt(0)" ::: "memory");
            const unsigned og = xb_add(&bar[XB_TOP], 1u);
            const unsigned tg = og / nx;
            if (og + 1u == (tg + 1u) * nx) xb_add(&bar[XB_TOPGEN], 1u);
            else XB_SPIN(xb_ld(&bar[XB_TOPGEN]) == tg, bar);
            __builtin_amdgcn_fence(__ATOMIC_ACQUIRE, "agent");
            xb_add(&bar[XB_XGEN(b.x)], 1u);
            asm volatile("s_waitcnt vmcnt(0)" ::: "memory");
        } else {
            XB_SPIN(xb_ld(&bar[XB_XGEN(b.x)]) == gen, bar);
            __builtin_amdgcn_fence(__ATOMIC_ACQUIRE, "agent");
            asm volatile("s_waitcnt vmcnt(0)" ::: "memory");
        }
    }
    __syncthreads();
}

DI void p0_transpose_item(const float* W, int ldw, int col0, bf16_t* WT, int K, int dst_row0, int kb, float scale, LAS float* scr, int lane) {
    const int k0 = 64 * kb;
#pragma unroll 8
    for (int i = 0; i < 32; ++i) { const int kk = 2 * i + (lane >> 5); scr[kk * 33 + (lane & 31)] = W[(size_t)(k0 + kk) * ldw + col0 + (lane & 31)] * scale; }
    LDS_WAIT(); asm volatile("" ::: "memory");
    const int c = lane & 7;
#pragma unroll
    for (int j = 0; j < 4; ++j) { const int n = (lane >> 3) + 8 * j; const LAS float* s = scr + (8 * c) * 33 + n;
        u32x4 o; o.x = pk2(s[0 * 33], s[1 * 33]); o.y = pk2(s[2 * 33], s[3 * 33]); o.z = pk2(s[4 * 33], s[5 * 33]); o.w = pk2(s[6 * 33], s[7 * 33]);
        *(u32x4*)(WT + (size_t)(dst_row0 + n) * K + k0 + 8 * c) = o; }
    LDS_WAIT(); asm volatile("" ::: "memory");
}


DI void p1_rows2(int m0, int m1, int lane, const float* __restrict__ xin, const float* __restrict__ MODp, bf16_t* __restrict__ H1p, float* __restrict__ GIFp, const float* __restrict__ bif, const LAS float* wif) {
    f32x4 v[2][4], scv[2][4], shv[2][4];
#pragma unroll
    for (int r = 0; r < 2; ++r) { const int m = r ? m1 : m0; const int b = m / SEQ;
        const f32x4* xr = (const f32x4*)(xin + (size_t)m * DM) + lane; const f32x4* sh = (const f32x4*)(MODp + (size_t)b * MODW) + lane; const f32x4* sc = (const f32x4*)(MODp + (size_t)b * MODW + DM) + lane;
#pragma unroll
        for (int j = 0; j < 4; ++j) { v[r][j] = xr[64 * j]; scv[r][j] = sc[64 * j]; shv[r][j] = sh[64 * j]; } }
#pragma unroll
    for (int r = 0; r < 2; ++r) { const int m = r ? m1 : m0; float s = 0.f;
#pragma unroll
        for (int j = 0; j < 4; ++j) s += (v[r][j].x + v[r][j].y) + (v[r][j].z + v[r][j].w);
        const float mean = wave_sum(s) * (1.f / DM); float s2 = 0.f;
#pragma unroll
        for (int j = 0; j < 4; ++j) { v[r][j] = v[r][j] - mean; s2 += (v[r][j].x * v[r][j].x + v[r][j].y * v[r][j].y) + (v[r][j].z * v[r][j].z + v[r][j].w * v[r][j].w); }
        const float rstd = rsqrtf(wave_sum(s2) * (1.f / DM) + LN_EPS);
        unsigned long long* o8 = (unsigned long long*)(H1p + (size_t)m * DM) + lane;
        float gp[8];
#pragma unroll
        for (int g = 0; g < 8; ++g) gp[g] = 0.f;
        const LAS float* wl = wif + 4 * lane; asm volatile("" : "+v"(wl));
#pragma unroll
        for (int j = 0; j < 4; ++j) { const f32x4 hh = v[r][j] * rstd * (scv[r][j] + 1.0f) + shv[r][j];
            o8[64 * j] = (unsigned long long)pk2(hh.x, hh.y) | ((unsigned long long)pk2(hh.z, hh.w) << 32);
#pragma unroll
            for (int g = 0; g < 8; ++g) { const f32x4 w = *(const LAS f32x4*)(wl + g * 1024 + 256 * j); gp[g] += (hh.x * w.x + hh.y * w.y) + (hh.z * w.z + hh.w * w.w); } }
#pragma unroll
        for (int g = 0; g < 8; ++g) gp[g] = wave_sum(gp[g]);
        if (lane == 0) {
#pragma unroll
            for (int g = 0; g < 8; ++g) GIFp[(size_t)m * 8 + g] = gp[g] + bif[g]; } }
}
DI void p7_rows2(int m0, int m1, int lane, const float* __restrict__ Rp, const float* __restrict__ MODp, const float* __restrict__ g1, const float* __restrict__ b1,
                 float* __restrict__ X1p, bf16_t* __restrict__ H2p, unsigned char* __restrict__ H2Qp, float* __restrict__ SHp) {
    f32x4 v[2][4], scv[2][4], shv[2][4];
#pragma unroll
    for (int r = 0; r < 2; ++r) { const int m = r ? m1 : m0; const int b = m / SEQ;
        const f32x4* rr = (const f32x4*)(Rp + (size_t)m * DM) + lane; const f32x4* sh = (const f32x4*)(MODp + (size_t)b * MODW + 3 * DM) + lane; const f32x4* sc = (const f32x4*)(MODp + (size_t)b * MODW + 4 * DM) + lane;
#pragma unroll
        for (int j = 0; j < 4; ++j) { v[r][j] = rr[64 * j]; scv[r][j] = sc[64 * j]; shv[r][j] = sh[64 * j]; } }
#pragma unroll
    for (int r = 0; r < 2; ++r) { const int m = r ? m1 : m0; float s = 0.f;
#pragma unroll
        for (int j = 0; j < 4; ++j) s += (v[r][j].x + v[r][j].y) + (v[r][j].z + v[r][j].w);
        float mean = wave_sum(s) * (1.f / DM); float s2 = 0.f;
#pragma unroll
        for (int j = 0; j < 4; ++j) { v[r][j] = v[r][j] - mean; s2 += (v[r][j].x * v[r][j].x + v[r][j].y * v[r][j].y) + (v[r][j].z * v[r][j].z + v[r][j].w * v[r][j].w); }
        float rstd = rsqrtf(wave_sum(s2) * (1.f / DM) + LN_EPS);
        f32x4* xo = (f32x4*)(X1p + (size_t)m * DM) + lane; s = 0.f;
#pragma unroll
        for (int j = 0; j < 4; ++j) { v[r][j] = v[r][j] * rstd * ((const f32x4*)g1)[lane + 64 * j] + ((const f32x4*)b1)[lane + 64 * j]; xo[64 * j] = v[r][j]; s += (v[r][j].x + v[r][j].y) + (v[r][j].z + v[r][j].w); }
        mean = wave_sum(s) * (1.f / DM); s2 = 0.f;
#pragma unroll
        for (int j = 0; j < 4; ++j) { v[r][j] = v[r][j] - mean; s2 += (v[r][j].x * v[r][j].x + v[r][j].y * v[r][j].y) + (v[r][j].z * v[r][j].z + v[r][j].w * v[r][j].w); }
        rstd = rsqrtf(wave_sum(s2) * (1.f / DM) + LN_EPS);
        unsigned long long* o8 = (unsigned long long*)(H2p + (size_t)m * DM) + lane;
        float amax = 0.f;
#pragma unroll
        for (int j = 0; j < 4; ++j) { const f32x4 hh = v[r][j] * rstd * (scv[r][j] + 1.0f) + shv[r][j]; o8[64 * j] = (unsigned long long)pk2(hh.x, hh.y) | ((unsigned long long)pk2(hh.z, hh.w) << 32);
            v[r][j] = hh; amax = fmaxf(amax, fmaxf(fmaxf(fabsf(hh.x), fabsf(hh.y)), fmaxf(fabsf(hh.z), fabsf(hh.w)))); }
#pragma unroll
        for (int o = 1; o < 64; o <<= 1) amax = fmaxf(amax, __shfl_xor(amax, o));
        const float qinv = amax > 0.f ? 127.0f / amax : 0.f;
        unsigned* q4 = (unsigned*)(H2Qp + (size_t)m * DM) + lane;
#pragma unroll
        for (int j = 0; j < 4; ++j) { const int q0 = (int)rintf(v[r][j].x * qinv), q1 = (int)rintf(v[r][j].y * qinv), q2 = (int)rintf(v[r][j].z * qinv), q3 = (int)rintf(v[r][j].w * qinv);
            q4[64 * j] = (unsigned)(q0 & 255) | ((unsigned)(q1 & 255) << 8) | ((unsigned)(q2 & 255) << 16) | ((unsigned)(q3 & 255) << 24); }
        if (lane == 0) SHp[m] = amax * (1.0f / 127.0f); }
}

struct Args { const float* in[22]; float* out; unsigned char* ws; int ph_lo, ph_hi; };

__global__ void __launch_bounds__(NWAVES * 64, 2) mega_fwd(Args args) {
    extern __shared__ __attribute__((aligned(16))) unsigned char lds_raw[];
    LAS unsigned char* lds = (LAS unsigned char*)lds_raw;
    volatile LAS unsigned* MISC = (volatile LAS unsigned*)(lds + MISC_OFF);
    const int tid = threadIdx.x, lane = tid & 63, wave = __builtin_amdgcn_readfirstlane(tid >> 6);
    const int G = gridDim.x; const int bx = blockIdx.x; const int vcu = (G % 8 == 0) ? (bx % 8) * (G / 8) + bx / 8 : bx;
    const int gw = vcu * NWAVES + wave, NGW = G * NWAVES;
#define ws (args.ws)
#define ctl ((unsigned*)(ws + WS_CTL))
#define x_in (args.in[0])
#define cvec (args.in[1])
#define w_ada (args.in[2])
#define b_ada (args.in[3])
#define w_in (args.in[4])
#define b_if (args.in[5])
#define conv_w (args.in[6])
#define conv_b (args.in[7])
#define da_lambda (args.in[8])
#define da_subln_g (args.in[9])
#define ml_norm_g (args.in[10])
#define w_br_attn (args.in[11])
#define w_br_mlstm (args.in[12])
#define w_out (args.in[13])
#define ln1_g (args.in[14])
#define ln1_b (args.in[15])
#define peer_wq (args.in[16])
#define peer_keys (args.in[17])
#define peer_u (args.in[18])
#define peer_v (args.in[19])
#define ln2_g (args.in[20])
#define ln2_b (args.in[21])
#define MOD ((float*)(ws + WS_MOD))
#define GIF ((float*)(ws + WS_GIF))
#define WIN ((bf16_t*)(ws + WS_WIN))
#define WA ((bf16_t*)(ws + WS_WA))
#define WM ((bf16_t*)(ws + WS_WM))
#define WOUT ((bf16_t*)(ws + WS_WOUT))
#define WQ ((bf16_t*)(ws + WS_WQ))
#define UT8 ((unsigned char*)(ws + WS_U))
#define VT8 ((unsigned char*)(ws + WS_V))
#define SUS ((float*)(ws + WS_SU))
#define SVS ((float*)(ws + WS_SV))
#define SHS ((float*)(ws + WS_SH))
#define CSS ((float*)(ws + WS_CS))
#define H2Q ((unsigned char*)(ws + WS_H2Q))
#define SELE ((bf16_t*)(ws + WS_SELE))
#define SELG ((float*)(ws + WS_SELG))
#define PART ((float*)(ws + WS_PART))
#define COEF ((float*)(ws + WS_COEF))
#define H1 ((bf16_t*)(ws + WS_H1))
#define Z ((bf16_t*)(ws + WS_Z))
#define R ((float*)(ws + WS_R))
#define X1 ((float*)(ws + WS_X1))
#define H2 ((bf16_t*)(ws + WS_H2))
#define QP ((bf16_t*)(ws + WS_QP))
#define GATES ((bf16_t*)args.out)

    for (int u = tid; u < (LDS_BYTES - MISC_OFF) / 4; u += NWAVES * 64) MISC[u] = 0u;
    __syncthreads();
    XcdBarrier bar; bar.bar = ctl + CW_BAR; bar.x = 0; bar.st = nullptr;
    if (MK_N_LAUNCHES != N_PHASES) bar = xcd_barrier_post(ctl + CW_BAR, MISC + 8);
    const int lo = args.ph_lo, hi = args.ph_hi;
#ifndef PH_MASK
#define PH_MASK 0x3fff
#endif
#define IN(k) (((PH_MASK >> (k)) & 1) && lo <= (k) && (k) < hi)
#define SEAM(k) do { if (IN(k) && IN((k) + 1)) xcd_barrier(bar); } while (0)

    if (IN(0)) {
        for (int it = gw; it < 96 * 8; it += NGW) {
            const int cb = it % 96, ks = it / 96, col = 64 * cb + lane;
            float acc[32];
#pragma unroll
            for (int b = 0; b < 32; ++b) acc[b] = 0.f;
            for (int k = 128 * ks; k < 128 * ks + 128; ++k) { const float w = w_ada[(size_t)k * MODW + col];
#pragma unroll
                for (int b = 0; b < 32; ++b) acc[b] += siluf_(cvec[b * DM + k]) * w; }
            const float bias = (ks == 0) ? b_ada[col] : 0.f;
#pragma unroll
            for (int b = 0; b < 32; ++b) atomicAdd(MOD + b * MODW + col, acc[b] + bias);
        }
        LAS float* scr = (LAS float*)(lds + wave * 16384);
        for (int it = gw; it < 4096 + 4 * 512; it += NGW) {
            if (it < 4096) { const int kb = it / 256, nb = it % 256, n0 = 32 * nb; p0_transpose_item(w_in, IN_W, n0 < NZ ? n0 : n0 + 8, WIN, DM, n0, kb, n0 < 1024 ? QSCALE : 1.0f, scr, lane); }
            else { const int r = it - 4096, wsel = r / 512, q = r % 512, kb = q / 32, nb = q % 32;
                const float* src = wsel == 0 ? w_br_attn : wsel == 1 ? w_br_mlstm : wsel == 2 ? w_out : peer_wq; bf16_t* dst = wsel == 0 ? WA : wsel == 1 ? WM : wsel == 2 ? WOUT : WQ;
                p0_transpose_item(src, DM, 32 * nb, dst, DM, 32 * nb, kb, 1.0f, scr, lane); }
        }
        for (int row = gw; row < 2 * NEXP; row += NGW) {
            const bool second = row >= NEXP; const int e = second ? row - NEXP : row;
            const float* s = (second ? peer_v : peer_u) + (size_t)e * DM + 16 * lane;
            f32x4 a[4]; float amax = 0.f;
#pragma unroll
            for (int j = 0; j < 4; ++j) { a[j] = *(const f32x4*)(s + 4 * j); amax = fmaxf(amax, fmaxf(fmaxf(fabsf(a[j].x), fabsf(a[j].y)), fmaxf(fabsf(a[j].z), fabsf(a[j].w)))); }
#pragma unroll
            for (int o = 1; o < 64; o <<= 1) amax = fmaxf(amax, __shfl_xor(amax, o));
            const float inv = amax > 0.f ? 127.0f / amax : 0.f; const int bias = second ? 128 : 0;
            u32x4 w;
#pragma unroll
            for (int j = 0; j < 4; ++j) { const int q0 = (int)rintf(a[j].x * inv) + bias, q1 = (int)rintf(a[j].y * inv) + bias, q2 = (int)rintf(a[j].z * inv) + bias, q3 = (int)rintf(a[j].w * inv) + bias;
                w[j] = (unsigned)(q0 & 255) | ((unsigned)(q1 & 255) << 8) | ((unsigned)(q2 & 255) << 16) | ((unsigned)(q3 & 255) << 24); }
            *(u32x4*)((second ? VT8 : UT8) + (size_t)(lane >> 3) * NEXP * 128 + (size_t)e * 128 + (lane & 7) * 16) = w;
            if (lane == 0) (second ? SVS : SUS)[e] = amax * (1.0f / 127.0f);
        }
    }
    SEAM(0);
    if (IN(1)) {
        LAS float* wif = (LAS float*)lds;
        for (int i = tid; i < 8192; i += 512) { const int k = i >> 3, j = i & 7; wif[j * 1024 + k] = w_in[(size_t)k * IN_W + NZ + j]; }
        __syncthreads();
        for (int m = gw; m < TOK; m += 2 * NGW) p1_rows2(m, m + NGW, lane, x_in, MOD, H1, GIF, b_if, wif);
    }
    SEAM(1);
#ifndef DUP2
#define DUP2 0
#endif
#ifndef DUP23
#define DUP23 0
#endif
#define P2_BODY if (IN(2)) { pg8::Gemm g{H1, WIN, TOK, NIN, DM, DM, DM}; pg8::StaticOrder S; S.init(TOK, NIN, G, bx); pg8::EpiZ E{Z, GATES}; \
        pg8::gemm_phase<pg8::EpiZ, pg8::StaticOrder, true, true>(lds, g, S, E); }
#define P3_BODY(QOFF) if (IN(3)) { unsigned* qhead = ctl + CW_QUEUE + (QOFF); \
        for (;;) { __syncthreads(); if (tid == 0) MISC[0] = __hip_atomic_fetch_add(qhead, 1u, RLX_AGENT); __syncthreads(); \
            const int id = (int)MISC[0]; if (id >= 128 + 2048) break; \
            if (id < 128) mls::mlstm_unit<false>(lds, Z, GIF, conv_w, conv_b, ml_norm_g, id >> 2, id & 3); \
            else { const int idx = id - 128, qb = 7 - idx / 256, bh = idx % 256; datt::attn_unit<false>(lds, Z, da_lambda, da_subln_g, bh >> 3, bh & 7, qb); } } }
#define P3A_DRY(QOFF) if (IN(3)) { unsigned* qhead = ctl + CW_QUEUE + (QOFF); \
        for (;;) { __syncthreads(); if (tid == 0) MISC[0] = __hip_atomic_fetch_add(qhead, 1u, RLX_AGENT); __syncthreads(); \
            const int id = (int)MISC[0]; if (id >= 2048) break; \
            { const int idx = id, qb = 7 - idx / 256, bh = idx % 256; datt::attn_unit<true>(lds, Z, da_lambda, da_subln_g, bh >> 3, bh & 7, qb); } } }
#define P3M_DRY(QOFF) if (IN(3)) { unsigned* qhead = ctl + CW_QUEUE + (QOFF); \
        for (;;) { __syncthreads(); if (tid == 0) MISC[0] = __hip_atomic_fetch_add(qhead, 1u, RLX_AGENT); __syncthreads(); \
            const int id = (int)MISC[0]; if (id >= 128) break; \
            mls::mlstm_unit<true>(lds, Z, GIF, conv_w, conv_b, ml_norm_g, id >> 2, id & 3); } }
#ifndef DRY3A
#define DRY3A 0
#endif
#ifndef DRY3M
#define DRY3M 0
#endif
    P2_BODY
#if DUP2
    SEAM(2);
    P2_BODY
#endif
    SEAM(2);
#if DRY3A
    P3A_DRY(128)
    if (IN(3)) xcd_barrier(bar);
#endif
#if DRY3M
    P3M_DRY(192)
    if (IN(3)) xcd_barrier(bar);
#endif
    P3_BODY(0)
    SEAM(3);
#if DUP23
    P2_BODY
    SEAM(2);
    P3_BODY(64)
    SEAM(3);
#endif
    if (IN(4)) {
        pg8::Gemm g{Z + ZC_Q, WA, TOK, DM, DM, NZ, DM}; pg8::StaticOrder S; S.init(TOK, DM, G, bx);
        pg8::EpiGate<true> E{GATES, H1};
        pg8::gemm_phase<pg8::EpiGate<true>, pg8::StaticOrder, true, true>(lds, g, S, E);
    }
    SEAM(4);
    if (IN(5)) {
        pg8::Gemm g{Z + ZC_MV, WM, TOK, DM, DM, NZ, DM}; pg8::StaticOrder S; S.init(TOK, DM, G, bx);
        pg8::EpiGate<false> E{GATES + DM, H1};
        pg8::gemm_phase<pg8::EpiGate<false>, pg8::StaticOrder, true, true>(lds, g, S, E);
    }
    SEAM(5);
    if (IN(6)) {
        pg8::Gemm g{H1, WOUT, TOK, DM, DM, DM, DM}; pg8::StaticOrder S; S.init(TOK, DM, G, bx);
        pg8::EpiR E{x_in, MOD, R};
        pg8::gemm_phase<pg8::EpiR, pg8::StaticOrder, true, true>(lds, g, S, E);
    }
    SEAM(6);
    if (IN(7)) {
        for (int m = gw; m < TOK; m += 2 * NGW) p7_rows2(m, m + NGW, lane, R, MOD, ln1_g, ln1_b, X1, H2, H2Q, SHS);
    }
    SEAM(7);
    if (IN(8)) {
        pg8::Gemm g{H2, WQ, TOK, DM, DM, DM, DM}; pg8::StaticOrder S; S.init(TOK, DM, G, bx);
        pg8::EpiStore E{QP};
        pg8::gemm_phase<pg8::EpiStore, pg8::StaticOrder, true, true>(lds, g, S, E);
    }
    SEAM(8);
    if (IN(9)) {
        peer::stage_keys(lds, peer_keys);
        __syncthreads();
        for (int tile = bx; tile < TOK / 32; tile += G) peer::select_tile(lds, QP, tile * 32, SELE, SELG);
    }
    SEAM(9);
    int sx = bx % 8, sr = bx / 8, sn = (G - sx + 7) / 8;
    if (IN(10) || IN(12)) {
        __syncthreads();
        if (tid == 0) { bool phys = (MK_N_LAUNCHES != N_PHASES) && lo == 0 && hi > 10; unsigned mine = 0;
            if (phys) { for (unsigned j = 0; j < 16; ++j) { const unsigned c = xb_ld(&bar.bar[XB_XCNT(j)]); if (j < 8) { if (c == 0u) phys = false; if (j == bar.x) mine = c; } else if (c != 0u) phys = false; } }
            MISC[16] = phys ? bar.x : (unsigned)sx; MISC[17] = phys ? MISC[10] : (unsigned)sr; MISC[18] = phys ? mine : (unsigned)sn; }
        __syncthreads();
        sx = (int)MISC[16]; sr = (int)MISC[17]; sn = (int)MISC[18];
    }
    if (IN(10)) {
        for (int tile = sr; tile < TOK / 32; tile += sn) { __syncthreads(); peer::u_phase_tile(lds, tile, sx, SELE, H2Q, UT8, PART); }
    }
    SEAM(10);
    if (IN(11)) { for (int m = 4 * gw; m < TOK; m += 4 * NGW) peer::red_tokens4((size_t)m, PART, SELE, SELG, SUS, SVS, SHS, COEF, CSS); }
    SEAM(11);
    if (IN(12)) {
        for (int tile = sr; tile < TOK / 32; tile += sn) { __syncthreads(); peer::v_phase_tile(lds, tile, sx, SELE, COEF, CSS, VT8, args.out); }
    }
    SEAM(12);
    if (IN(13)) { for (int m = gw; m < TOK; m += 2 * NGW) peer::final_rows2((size_t)m, (size_t)m + NGW, args.out, X1, MOD, ln2_g, ln2_b); }
#undef IN
#undef SEAM
#undef ws
#undef ctl
#undef x_in
#undef cvec
#undef w_ada
#undef b_ada
#undef w_in
#undef b_if
#undef conv_w
#undef conv_b
#undef da_lambda
#undef da_subln_g
#undef ml_norm_g
#undef w_br_attn
#undef w_br_mlstm
#undef w_out
#undef ln1_g
#undef ln1_b
#undef peer_wq
#undef peer_keys
#undef peer_u
#undef peer_v
#undef ln2_g
#undef ln2_b
#undef MOD
#undef GIF
#undef WIN
#undef WA
#undef WM
#undef WOUT
#undef WQ
#undef UT8
#undef VT8
#undef SUS
#undef SVS
#undef SHS
#undef CSS
#undef H2Q
#undef SELE
#undef SELG
#undef PART
#undef COEF
#undef H1
#undef Z
#undef R
#undef X1
#undef H2
#undef QP
#undef GATES
}

extern "C" void kernel_launch(void* const* d_in, const int* in_sizes, int n_in, void* d_out, int out_size, void* d_ws, size_t ws_size, hipStream_t stream) {
    static int grid = 0;
    if (grid == 0) {
        if (n_in != 22 || in_sizes[0] != TOK * DM || out_size != TOK * DM || ws_size < WS_END) { fprintf(stderr, "kernel_launch: unexpected shapes (n_in %d, in0 %d, out %d, ws %zu; need ws >= %zu)\n", n_in, n_in > 0 ? in_sizes[0] : -1, out_size, ws_size, (size_t)WS_END); grid = -1; return; }
        int dev = 0, cus = 0, per_cu = 0;
        if (hipGetDevice(&dev) != hipSuccess || hipDeviceGetAttribute(&cus, hipDeviceAttributeMultiprocessorCount, dev) != hipSuccess) { fprintf(stderr, "kernel_launch: device query failed\n"); grid = -1; return; }
        if (hipFuncSetAttribute((const void*)mega_fwd, hipFuncAttributeMaxDynamicSharedMemorySize, LDS_BYTES) != hipSuccess) { fprintf(stderr, "kernel_launch: hipFuncSetAttribute failed\n"); grid = -1; return; }
        if (hipOccupancyMaxActiveBlocksPerMultiprocessor(&per_cu, (const void*)mega_fwd, NWAVES * 64, LDS_BYTES) != hipSuccess || per_cu < 1) fprintf(stderr, "kernel_launch: note: occupancy query reports %d workgroups per CU\n", per_cu);
        (void)hipGetLastError();
        grid = cus;
    }
    if (grid < 0) return;
    if (hipMemsetAsync((char*)d_ws + WS_CTL, 0, CTL_ZERO_BYTES, stream) != hipSuccess) { fprintf(stderr, "kernel_launch: memset failed\n"); return; }
    Args a{};
    for (int i = 0; i < 22; ++i) a.in[i] = (const float*)d_in[i];
    a.out = (float*)d_out; a.ws = (unsigned char*)d_ws;
    for (int li = 0; li < MK_N_LAUNCHES; ++li) {
        a.ph_lo = (MK_N_LAUNCHES == N_PHASES) ? li : 0; a.ph_hi = (MK_N_LAUNCHES == N_PHASES) ? li + 1 : N_PHASES;
        hipLaunchKernelGGL(mega_fwd, dim3(grid), dim3(NWAVES * 64), LDS_BYTES, stream, a);
        const hipError_t le = hipPeekAtLastError();
        if (le != hipSuccess) { fprintf(stderr, "kernel_launch: launch %d failed: %s\n", li, hipGetErrorName(le)); break; }
    }
}
```

```cpp
#include <hip/hip_runtime.h>
#include <hip/hip_bf16.h>
#include <cstdio>
#include <cstdint>
#include <cmath>

#define LAS __attribute__((address_space(3)))
#define GAS __attribute__((address_space(1)))
typedef unsigned short bf16_t;
typedef short bf16x8 __attribute__((ext_vector_type(8)));
typedef short s16x4 __attribute__((ext_vector_type(4)));
typedef float f32x2 __attribute__((ext_vector_type(2)));
typedef float f32x4 __attribute__((ext_vector_type(4)));
typedef float f32x16 __attribute__((ext_vector_type(16)));
typedef unsigned u32x2 __attribute__((ext_vector_type(2)));
typedef unsigned u32x4 __attribute__((ext_vector_type(4)));
typedef __bf16 bf16x2_t __attribute__((ext_vector_type(2)));
#define DI __device__ __forceinline__

constexpr int BATCH = 32, SEQ = 2048, DM = 1024, TOK = BATCH * SEQ;
constexpr int NZ = 6144;
constexpr int ZC_Q = 0, ZC_K = 1024, ZC_V = 2048, ZC_MQ = 3072, ZC_MK = 3584, ZC_MV = 4096, ZC_MO = 5120;
constexpr int NGATE = 2048;
constexpr int NIN = 8192;
constexpr int IN_W = 8200;
constexpr int MODW = 6 * DM;
constexpr float LN_EPS = 1e-5f;
constexpr float ALPHA_RES = 1.189207115002721f;
constexpr float LAMBDA_INIT = 0.2f;
constexpr float QSCALE = 0.125f * 1.4426950408889634f;
constexpr int NEXP = 16384;

constexpr size_t MiB = 1u << 20;
constexpr size_t WS_CTL = 0, CTL_ZERO_BYTES = 2 * MiB;
constexpr size_t WS_MOD = 1 * MiB;
constexpr size_t WS_GIF = 3 * MiB;
constexpr size_t WS_WIN = 6 * MiB;
constexpr size_t WS_WA = 22 * MiB, WS_WM = 24 * MiB, WS_WOUT = 26 * MiB, WS_WQ = 28 * MiB;
constexpr size_t WS_U = 30 * MiB, WS_V = 62 * MiB;
constexpr size_t WS_SU = 2 * MiB, WS_SV = 2 * MiB + 65536, WS_SH = 2 * MiB + 131072, WS_CS = 2 * MiB + 393216;
constexpr size_t WS_H2Q = 96 * MiB, WS_SELE = 160 * MiB, WS_SELG = 176 * MiB;
constexpr size_t WS_H1 = 96 * MiB;
constexpr size_t WS_Z = 224 * MiB;
constexpr size_t WS_R = WS_Z, WS_X1 = WS_Z + 256 * MiB, WS_H2 = WS_Z + 512 * MiB, WS_QP = WS_Z + 640 * MiB;
constexpr size_t WS_PART = WS_R, WS_COEF = WS_H2;
constexpr size_t WS_END = 992 * MiB;
constexpr int CW_BAR = 4096;
constexpr int CW_QUEUE = 16384;

DI unsigned pk2(float lo, float hi) { f32x2 v = {lo, hi}; bf16x2_t b = __builtin_convertvector(v, bf16x2_t); return __builtin_bit_cast(unsigned, b); }
DI float bf_lo(unsigned u) { return __uint_as_float(u << 16); }
DI float bf_hi(unsigned u) { return __uint_as_float(u & 0xffff0000u); }
DI float bf2f(bf16_t h) { return __uint_as_float(((unsigned)h) << 16); }
DI float wave_sum(float v) {
#pragma unroll
    for (int o = 1; o < 64; o <<= 1) v += __shfl_xor(v, o);
    return v;
}
DI float sigmoidf_(float x) { return 1.0f / (1.0f + __expf(-x)); }
DI float siluf_(float x) { return x / (1.0f + __expf(-x)); }
DI int crow(int r, int hi) { return (r & 3) + 8 * (r >> 2) + 4 * hi; }
#define MFMA32(a, b, c) __builtin_amdgcn_mfma_f32_32x32x16_bf16((a), (b), (c), 0, 0, 0)
DI bf16x8 pack_step(const f32x16& x, int s) {
    u32x4 p;
    p[0] = pk2(x[8 * s + 0], x[8 * s + 1]); p[1] = pk2(x[8 * s + 2], x[8 * s + 3]); p[2] = pk2(x[8 * s + 4], x[8 * s + 5]); p[3] = pk2(x[8 * s + 6], x[8 * s + 7]);
    return __builtin_bit_cast(bf16x8, p);
}
DI unsigned off_b(unsigned row, unsigned ch) { return 256u * row + 16u * (ch ^ (((row & 3) << 2) | ((row >> 2) & 3))); }
DI unsigned row_read_addr(unsigned lane, unsigned rt, unsigned s) { return off_b(32 * rt + (lane & 31), 2 * s + (lane >> 5)); }
DI unsigned tr_read_addr(unsigned lane, unsigned c, unsigned ks, unsigned t) {
    const unsigned h = lane >> 5, blk = (lane >> 4) & 1, q = (lane & 15) >> 2, p = lane & 3;
    return off_b(16 * ks + 8 * h + 4 * t + q, 4 * c + 2 * blk + (p >> 1)) + 8 * (p & 1);
}
DI unsigned tr_base(unsigned lane, unsigned t) { const unsigned h = lane >> 5, blk = (lane >> 4) & 1, q = (lane & 15) >> 2, p = lane & 3, cl = 2 * blk + (p >> 1);
    return 256u * (8 * h + 4 * t + q) + 16u * (cl ^ (2 * h + t)) + 8u * (p & 1); }
#define OPAQUE(x) asm volatile("" : "+v"(x))
#define OPAQUE(x) asm volatile("" : "+v"(x))
typedef short v4i16_t __attribute__((ext_vector_type(4)));
DI s16x4 tr_read(const LAS unsigned char* p) { return __builtin_bit_cast(s16x4, __builtin_amdgcn_ds_read_tr16_b64_v4i16((LAS v4i16_t*)p)); }
DI bf16x8 cat8(s16x4 lo, s16x4 hi) { return __builtin_shufflevector(lo, hi, 0, 1, 2, 3, 4, 5, 6, 7); }
namespace pg8 {
#define PG8_LAS __attribute__((address_space(3)))
typedef unsigned short bf16_t;
typedef short bf16x8 __attribute__((ext_vector_type(8)));
typedef float f32x4 __attribute__((ext_vector_type(4)));
typedef unsigned u32x4 __attribute__((ext_vector_type(4)));
constexpr int BM = 256, BK = 64, HALF = 128, HTB = HALF * BK * 2  , STAGE_BYTES = 8 * HTB, NXCD = 8, WGM = 8;

__host__ __device__ __forceinline__ int lds_byte(int r, int c) { const int st = (r >> 4) * 2 + (c >> 5), rr = r & 15, cc = c & 31, ob = rr * 64 + cc * 2; return st * 1024 + (ob ^ (((ob >> 9) & 1) << 5)); }
__host__ __device__ __forceinline__ void stage_rc(int b, int& R, int& C) { const int st = b / 1024, sb = b % 1024, swz = sb ^ (((sb >> 9) & 1) << 5); R = (st >> 1) * 16 + swz / 64; C = (st & 1) * 32 + (swz % 64) / 2; }
__host__ __device__ __forceinline__ int perm32(int rho) { const int n = rho >> 4, i = rho & 15; return 8 * (i >> 2) + 4 * n + (i & 3); }

struct Unit { int pm, pn; };
struct Gemm { const bf16_t* A; const bf16_t* Bt; int M, N, K, lda, ldb; };

struct StaticOrder {
    int nM, nN, nwg, G, c;
    __host__ __device__ void init(int M, int N, int G_, int c_) { nM = M / BM; nN = N / BM; nwg = nM * nN; G = G_; c = c_; }
    __host__ __device__ bool next(int i, Unit& u) const {
        const long L = (long)i * G + c; if (L >= nwg) return false;
        int wgid = (int)L; { const int q = nwg / NXCD, r = nwg % NXCD, xcd = wgid % NXCD, off = wgid / NXCD; wgid = (xcd < r ? xcd * (q + 1) : r * (q + 1) + (xcd - r) * q) + off; }
        const int nig = WGM * nN, gid = wgid / nig, fm = gid * WGM, gsz = (nM - fm) < WGM ? (nM - fm) : WGM;
        u.pm = fm + ((wgid % nig) % gsz); u.pn = (wgid % nig) / gsz; return true;
    }
    __device__ __forceinline__ void a_ready(const Unit&) const {}
    __device__ __forceinline__ void done(const Unit&) const {}
};

template <class Epi, class Sched, bool ALIGN_EPI = false, bool SP2 = false>
__device__ __forceinline__ void gemm_phase(PG8_LAS unsigned char* lds, const Gemm g, const Sched& S, const Epi& E) {
    const int tid = threadIdx.x, wid = __builtin_amdgcn_readfirstlane(tid >> 6), lane = tid & 63, wr = wid >> 2, wc = wid & 3, fr = lane & 15, fq = lane >> 4;
    const int K = g.K, nt = K / BK;
    unsigned voffA[2], voffB[2];
#pragma unroll
    for (int i = 0; i < 2; ++i) { int R, C; stage_rc(tid * 16 + i * 8192, R, C); const int Rb = Epi::PERM ? ((R & ~31) + perm32(R & 31)) : R;
        voffA[i] = (unsigned)(R * g.lda + C) * 2u; voffB[i] = (unsigned)(Rb * g.ldb + C) * 2u; }
    const size_t kstep = (size_t)(BK * 2);
    const size_t hstepA = (size_t)HALF * g.lda * 2, hstepB = (size_t)HALF * g.ldb * 2;
    const size_t tstepA = 2 * hstepA, tstepB = 2 * hstepB;
    const unsigned ldsw = (unsigned)wid * 1024u;
    const int aoff = lds_byte(wr * 64 + fr, fq * 8), boff = lds_byte(wc * 32 + fr, fq * 8);
#define PG8_SA(b, h) (((b) * 2 + (h)) * HTB)
#define PG8_SB(b, h) ((4 + (b) * 2 + (h)) * HTB)
#define PG8_STAGE(bufoff, gbase, voff) do { _Pragma("unroll") for (int _i = 0; _i < 2; ++_i) \
        __builtin_amdgcn_global_load_lds((const unsigned*)((const char*)(gbase) + (voff)[_i]), (PG8_LAS unsigned*)(lds + (bufoff) + ldsw + _i * 8192), 16, 0, 0); } while (0)
#define PG8_LDA(dst, b, h) do { _Pragma("unroll") for (int m = 0; m < 4; ++m) _Pragma("unroll") for (int k = 0; k < 2; ++k) dst[m][k] = *(const PG8_LAS bf16x8*)(lds + PG8_SA(b, h) + aoff + m * 2048 + k * 1024); } while (0)
#define PG8_LDB(dst, b, h) do { _Pragma("unroll") for (int n = 0; n < 2; ++n) _Pragma("unroll") for (int k = 0; k < 2; ++k) dst[n][k] = *(const PG8_LAS bf16x8*)(lds + PG8_SB(b, h) + boff + n * 2048 + k * 1024); } while (0)
#define PG8_MMA(ai, bj, At, Bt) do { __builtin_amdgcn_s_setprio(1); _Pragma("unroll") for (int m = 0; m < 4; ++m) _Pragma("unroll") for (int n = 0; n < 2; ++n) _Pragma("unroll") for (int k = 0; k < 2; ++k) \
        acc[ai][bj][m][n] = __builtin_amdgcn_mfma_f32_16x16x32_bf16(Bt[n][k], At[m][k], acc[ai][bj][m][n], 0, 0, 0); __builtin_amdgcn_s_setprio(0); } while (0)
#define PG8_WAIT_V(n) asm volatile("s_waitcnt vmcnt(" #n ")" ::: "memory")
#define PG8_WAIT_L(n) asm volatile("s_waitcnt lgkmcnt(" #n ")" ::: "memory")
#define PG8_BAR __builtin_amdgcn_s_barrier()
#define PG8_SCHED __builtin_amdgcn_sched_barrier(0)
    Unit cur, nxt; int ui = 0;
    if (!S.next(0, cur)) return;
    f32x4 acc[2][2][4][2];
#pragma unroll
    for (int a = 0; a < 2; ++a)
#pragma unroll
        for (int b = 0; b < 2; ++b)
#pragma unroll
            for (int m = 0; m < 4; ++m)
#pragma unroll
                for (int n = 0; n < 2; ++n) acc[a][b][m][n] = (f32x4){0.f, 0.f, 0.f, 0.f};
    bf16x8 At[4][2], B0[2][2], B1[2][2];
    const char* cA = (const char*)g.A + (size_t)cur.pm * tstepA; const char* cB = (const char*)g.Bt + (size_t)cur.pn * tstepB;
    S.a_ready(cur);
    if constexpr (SP2) {
        PG8_STAGE(PG8_SB(0, 0), cB, voffB); PG8_STAGE(PG8_SB(0, 1), cB + hstepB, voffB); PG8_STAGE(PG8_SA(0, 0), cA, voffA); PG8_STAGE(PG8_SA(0, 1), cA + hstepA, voffA);
        if (wr == 1) PG8_BAR;
        PG8_WAIT_V(2); PG8_BAR;
        PG8_STAGE(PG8_SB(1, 0), cB + kstep, voffB); PG8_STAGE(PG8_SA(1, 0), cA + kstep, voffA); PG8_STAGE(PG8_SB(1, 1), cB + hstepB + kstep, voffB);
        PG8_WAIT_V(6); PG8_BAR;
    } else {
        PG8_STAGE(PG8_SB(0, 0), cB, voffB); PG8_STAGE(PG8_SA(0, 0), cA, voffA); PG8_STAGE(PG8_SB(0, 1), cB + hstepB, voffB); PG8_STAGE(PG8_SA(0, 1), cA + hstepA, voffA);
        if (wr == 1) PG8_BAR;
        PG8_WAIT_V(4); PG8_BAR;
        PG8_STAGE(PG8_SB(1, 0), cB + kstep, voffB); PG8_STAGE(PG8_SA(1, 0), cA + kstep, voffA); PG8_STAGE(PG8_SB(1, 1), cB + hstepB + kstep, voffB);
        PG8_WAIT_V(6); PG8_BAR;
    }
    for (;;) {
        const bool has_next = S.next(ui + 1, nxt);
        const char* nA = has_next ? (const char*)g.A + (size_t)nxt.pm * tstepA : cA; const char* nB = has_next ? (const char*)g.Bt + (size_t)nxt.pn * tstepB : cB;
        for (int t = 0; t < nt; t += 2) {
            const bool last = (t == nt - 2);
            const char* a1 = cA + (size_t)(t + 1) * kstep;
            const char* a2 = last ? nA : cA + (size_t)(t + 2) * kstep; const char* b2 = last ? nB : cB + (size_t)(t + 2) * kstep;
            const char* a3 = a2 + kstep; const char* b3 = b2 + kstep;
            if (last && has_next) S.a_ready(nxt);
            if constexpr (SP2) {
            PG8_LDB(B0, 0, 0); PG8_LDB(B1, 0, 1); PG8_SCHED; PG8_LDA(At, 0, 0); PG8_STAGE(PG8_SA(1, 1), a1 + hstepA, voffA);
            PG8_WAIT_V(8); PG8_WAIT_L(0); PG8_BAR; PG8_MMA(0, 0, At, B0); PG8_MMA(0, 1, At, B1); PG8_BAR; PG8_SCHED;
            PG8_LDA(At, 0, 1); PG8_STAGE(PG8_SB(0, 0), b2, voffB); PG8_STAGE(PG8_SB(0, 1), b2 + hstepB, voffB); PG8_STAGE(PG8_SA(0, 0), a2, voffA);
            PG8_WAIT_V(8); PG8_WAIT_L(0); PG8_BAR; PG8_MMA(1, 0, At, B0); PG8_MMA(1, 1, At, B1); PG8_BAR; PG8_SCHED;
            PG8_LDB(B0, 1, 0); PG8_LDB(B1, 1, 1); PG8_SCHED; PG8_LDA(At, 1, 0); PG8_STAGE(PG8_SA(0, 1), a2 + hstepA, voffA);
            PG8_WAIT_V(8); PG8_WAIT_L(0); PG8_BAR; PG8_MMA(0, 0, At, B0); PG8_MMA(0, 1, At, B1); PG8_BAR; PG8_SCHED;
            PG8_LDA(At, 1, 1); PG8_STAGE(PG8_SB(1, 0), b3, voffB); PG8_STAGE(PG8_SB(1, 1), b3 + hstepB, voffB); PG8_STAGE(PG8_SA(1, 0), a3, voffA);
            PG8_WAIT_V(8); PG8_WAIT_L(0); PG8_BAR; PG8_MMA(1, 0, At, B0); PG8_MMA(1, 1, At, B1); PG8_BAR; PG8_SCHED;
            } else {
            PG8_LDB(B0, 0, 0); PG8_SCHED; PG8_LDA(At, 0, 0); PG8_STAGE(PG8_SA(1, 1), a1 + hstepA, voffA);
            PG8_WAIT_L(8); PG8_BAR; PG8_WAIT_L(0); PG8_MMA(0, 0, At, B0); PG8_BAR; PG8_SCHED;
            PG8_LDB(B1, 0, 1); PG8_STAGE(PG8_SB(0, 0), b2, voffB);
            PG8_BAR; PG8_WAIT_L(0); PG8_MMA(0, 1, At, B1); PG8_BAR;
            PG8_LDA(At, 0, 1); PG8_STAGE(PG8_SA(0, 0), a2, voffA);
            PG8_BAR; PG8_WAIT_L(0); PG8_MMA(1, 0, At, B0); PG8_BAR; PG8_SCHED;
            PG8_STAGE(PG8_SB(0, 1), b2 + hstepB, voffB);
            PG8_WAIT_V(6); PG8_BAR; PG8_MMA(1, 1, At, B1); PG8_BAR;
            PG8_LDB(B0, 1, 0); PG8_SCHED; PG8_LDA(At, 1, 0); PG8_STAGE(PG8_SA(0, 1), a2 + hstepA, voffA);
            PG8_WAIT_L(8); PG8_BAR; PG8_WAIT_L(0); PG8_MMA(0, 0, At, B0); PG8_BAR; PG8_SCHED;
            PG8_LDB(B1, 1, 1); PG8_STAGE(PG8_SB(1, 0), b3, voffB);
            PG8_BAR; PG8_WAIT_L(0); PG8_MMA(0, 1, At, B1); PG8_BAR;
            PG8_LDA(At, 1, 1); PG8_STAGE(PG8_SA(1, 0), a3, voffA);
            PG8_BAR; PG8_WAIT_L(0); PG8_MMA(1, 0, At, B0); PG8_BAR; PG8_SCHED;
            PG8_STAGE(PG8_SB(1, 1), b3 + hstepB, voffB);
            PG8_WAIT_V(6); PG8_BAR; PG8_MMA(1, 1, At, B1); PG8_BAR;
            }
        }
        if constexpr (ALIGN_EPI) { if (wr == 0) PG8_BAR; }
        if constexpr (!Epi::AFTER_DRAIN) { E(acc, cur, wr, wc, fr, fq); S.done(cur); }
        if (!has_next) break;
#pragma unroll
        for (int a = 0; a < 2; ++a)
#pragma unroll
            for (int b = 0; b < 2; ++b)
#pragma unroll
                for (int m = 0; m < 4; ++m)
#pragma unroll
                    for (int n = 0; n < 2; ++n) acc[a][b][m][n] = (f32x4){0.f, 0.f, 0.f, 0.f};
        cur = nxt; cA = nA; cB = nB; ++ui;
        if constexpr (ALIGN_EPI) { if (wr == 1) PG8_BAR; }
    }
    PG8_WAIT_V(0);
    if constexpr (!ALIGN_EPI) { if (wr == 0) PG8_BAR; }
    PG8_BAR;
    if constexpr (Epi::AFTER_DRAIN) { E.fused(acc, cur, wr, wc, fr, fq, lds, wid, lane); S.done(cur); }
#undef PG8_SA
#undef PG8_SB
#undef PG8_STAGE
#undef PG8_LDA
#undef PG8_LDB
#undef PG8_MMA
#undef PG8_WAIT_V
#undef PG8_WAIT_L
#undef PG8_BAR
#undef PG8_SCHED
}
}
namespace pg8 {
struct EpiZ {
    static constexpr bool PERM = true, AFTER_DRAIN = false;
    bf16_t* Z; bf16_t* G;
    __device__ __forceinline__ void operator()(const f32x4 (&acc)[2][2][4][2], const Unit& u, int wr, int wc, int fr, int fq) const {
        const int row0 = u.pm * BM + wr * 64 + fr, colt = u.pn * BM; const bool gate = colt >= NZ;
        bf16_t* base = gate ? G : Z; const int ld = gate ? NGATE : NZ; const int col0 = (gate ? colt - NZ : colt) + wc * 32 + 8 * fq;
#pragma unroll
        for (int ai = 0; ai < 2; ++ai)
#pragma unroll
            for (int m = 0; m < 4; ++m) { bf16_t* rowp = base + (size_t)(row0 + ai * HALF + m * 16) * ld + col0;
#pragma unroll
                for (int bj = 0; bj < 2; ++bj) { f32x4 v0 = acc[ai][bj][m][0], v1 = acc[ai][bj][m][1];
                    if (gate) {
#pragma unroll
                        for (int e = 0; e < 4; ++e) { v0[e] = sigmoidf_(v0[e]); v1[e] = sigmoidf_(v1[e]); } }
                    ::u32x4 w; w.x = pk2(v0[0], v0[1]); w.y = pk2(v0[2], v0[3]); w.z = pk2(v1[0], v1[1]); w.w = pk2(v1[2], v1[3]);
                    *(::u32x4*)(rowp + bj * HALF) = w; } }
    }
};
template <bool FIRST> struct EpiGate {
    static constexpr bool PERM = true, AFTER_DRAIN = false;
    const bf16_t* G; bf16_t* Y;
    __device__ __forceinline__ void operator()(const f32x4 (&acc)[2][2][4][2], const Unit& u, int wr, int wc, int fr, int fq) const {
        const int row0 = u.pm * BM + wr * 64 + fr, col0 = u.pn * BM + wc * 32 + 8 * fq;
#pragma unroll
        for (int ai = 0; ai < 2; ++ai)
#pragma unroll
            for (int m = 0; m < 4; ++m) { const size_t row = (size_t)(row0 + ai * HALF + m * 16);
#pragma unroll
                for (int bj = 0; bj < 2; ++bj) { const f32x4 v0 = acc[ai][bj][m][0], v1 = acc[ai][bj][m][1];
                    const ::u32x4 g = *(const ::u32x4*)(G + row * NGATE + col0 + bj * HALF);
                    float o[8] = { bf_lo(g.x) * v0[0], bf_hi(g.x) * v0[1], bf_lo(g.y) * v0[2], bf_hi(g.y) * v0[3], bf_lo(g.z) * v1[0], bf_hi(g.z) * v1[1], bf_lo(g.w) * v1[2], bf_hi(g.w) * v1[3] };
                    bf16_t* yp = Y + row * DM + col0 + bj * HALF;
                    if (!FIRST) { const ::u32x4 y = *(const ::u32x4*)yp;
                        o[0] += bf_lo(y.x); o[1] += bf_hi(y.x); o[2] += bf_lo(y.y); o[3] += bf_hi(y.y); o[4] += bf_lo(y.z); o[5] += bf_hi(y.z); o[6] += bf_lo(y.w); o[7] += bf_hi(y.w); }
                    ::u32x4 w; w.x = pk2(o[0], o[1]); w.y = pk2(o[2], o[3]); w.z = pk2(o[4], o[5]); w.w = pk2(o[6], o[7]);
                    *(::u32x4*)yp = w; } }
    }
};
struct EpiR {
    static constexpr bool PERM = true, AFTER_DRAIN = false;
    const float* X; const float* MOD; float* R;
    __device__ __forceinline__ void operator()(const f32x4 (&acc)[2][2][4][2], const Unit& u, int wr, int wc, int fr, int fq) const {
        const int row0 = u.pm * BM + wr * 64 + fr, col0 = u.pn * BM + wc * 32 + 8 * fq;
        const float* gt = MOD + (size_t)((u.pm * BM) / SEQ) * MODW + 2 * DM;
        f32x4 g[2][2];
#pragma unroll
        for (int bj = 0; bj < 2; ++bj) { g[bj][0] = *(const f32x4*)(gt + col0 + bj * HALF); g[bj][1] = *(const f32x4*)(gt + col0 + bj * HALF + 4); }
#pragma unroll
        for (int ai = 0; ai < 2; ++ai)
#pragma unroll
            for (int m = 0; m < 4; ++m) { const size_t off = (size_t)(row0 + ai * HALF + m * 16) * DM + col0;
#pragma unroll
                for (int bj = 0; bj < 2; ++bj) {
                    const f32x4 x0 = *(const f32x4*)(X + off + bj * HALF), x1 = *(const f32x4*)(X + off + bj * HALF + 4);
                    *(f32x4*)(R + off + bj * HALF) = x0 * ALPHA_RES + g[bj][0] * acc[ai][bj][m][0];
                    *(f32x4*)(R + off + bj * HALF + 4) = x1 * ALPHA_RES + g[bj][1] * acc[ai][bj][m][1]; } }
    }
};
struct EpiStore {
    static constexpr bool PERM = true, AFTER_DRAIN = false;
    bf16_t* O;
    __device__ __forceinline__ void operator()(const f32x4 (&acc)[2][2][4][2], const Unit& u, int wr, int wc, int fr, int fq) const {
        const int row0 = u.pm * BM + wr * 64 + fr, col0 = u.pn * BM + wc * 32 + 8 * fq;
#pragma unroll
        for (int ai = 0; ai < 2; ++ai)
#pragma unroll
            for (int m = 0; m < 4; ++m) { bf16_t* rowp = O + (size_t)(row0 + ai * HALF + m * 16) * DM + col0;
#pragma unroll
                for (int bj = 0; bj < 2; ++bj) { const f32x4 v0 = acc[ai][bj][m][0], v1 = acc[ai][bj][m][1];
                    ::u32x4 w; w.x = pk2(v0[0], v0[1]); w.y = pk2(v0[2], v0[3]); w.z = pk2(v1[0], v1[1]); w.w = pk2(v1[2], v1[3]);
                    *(::u32x4*)(rowp + bj * HALF) = w; } }
    }
};
}
namespace datt {
constexpr int KROW = 144;
constexpr int KBUF = 64 * KROW, VBUF = 64 * 256, LDS_K = 0, LDS_V = 2 * KBUF, LDS_ST = LDS_V + 2 * VBUF, STROW = 272, ST_WAVE = 32 * STROW, LDS_BYTES = LDS_ST + 8 * ST_WAVE;
DI unsigned vrow(unsigned key) { return (key & ~12u) | ((key & 4u) << 1) | ((key & 8u) >> 1); }

template <bool DRY> DI void attn_unit(LAS unsigned char* lds, bf16_t* Z, const float* lam, const float* subln_g, int b, int h, int qb) {
    int tid_o = threadIdx.x; OPAQUE(tid_o); const int tid = tid_o, lane = tid & 63, r32 = lane & 31, hi = lane >> 5; const int wid = __builtin_amdgcn_readfirstlane(tid >> 6);
    const size_t rowbase = (size_t)b * SEQ;
    const int q_first = qb * 256 + wid * 32, q_me = q_first + r32;
    float lam_val;
    { const float p1 = lam[lane] * lam[64 + lane], p2 = lam[128 + lane] * lam[192 + lane]; lam_val = __expf(wave_sum(p1)) - __expf(wave_sum(p2)) + LAMBDA_INIT; }
    const int NT = 4 * (qb + 1);
    const int k_key = tid >> 3, k_ch = tid & 7;
    const int v_key0 = tid >> 4, v_ch = tid & 15;
    const unsigned tb0 = LDS_V + tr_base(lane, 0), tb1 = LDS_V + tr_base(lane, 1); unsigned q64 = ((lane & 15) >> 2) << 6;
    const unsigned kb = LDS_K + r32 * KROW + hi * 16;
#pragma unroll
    for (int m = 0; m < 2; ++m) {
        bf16x8 qf[4];
        { const bf16_t* qp = Z + (rowbase + q_me) * NZ + ZC_Q + h * 128 + m * 64 + 8 * hi;
#pragma unroll
          for (int s = 0; s < 4; ++s) qf[s] = *(const bf16x8*)(qp + 16 * s); }
        const bf16_t* ksrc = Z + (rowbase + k_key) * NZ + ZC_K + h * 128 + m * 64 + k_ch * 8;
        const bf16_t* vsrc = Z + (rowbase + v_key0) * NZ + ZC_V + h * 128 + v_ch * 8;
        f32x16 O[4];
#pragma unroll
        for (int c = 0; c < 4; ++c)
#pragma unroll
            for (int r = 0; r < 16; ++r) O[c][r] = 0.f;
        float mrun = -1e30f, lrun = 0.f;
        u32x4 pk_ = *(const u32x4*)ksrc, pv0 = *(const u32x4*)vsrc, pv1 = *(const u32x4*)(vsrc + (size_t)32 * NZ);
        __syncthreads();
        *(LAS u32x4*)(lds + LDS_K + k_key * KROW + k_ch * 16) = pk_;
        *(LAS u32x4*)(lds + LDS_V + off_b(vrow(v_key0), v_ch)) = pv0;
        *(LAS u32x4*)(lds + LDS_V + off_b(vrow(v_key0 + 32), v_ch)) = pv1;
        { const size_t o = (size_t)64 * NZ; pk_ = *(const u32x4*)(ksrc + o); pv0 = *(const u32x4*)(vsrc + o); pv1 = *(const u32x4*)(vsrc + o + (size_t)32 * NZ); }
        __syncthreads();
        for (int kt = 0; kt < NT; ++kt) {
            const int cur = kt & 1, nxt = cur ^ 1;
            if (kt + 1 < NT) {
                *(LAS u32x4*)(lds + LDS_K + nxt * KBUF + k_key * KROW + k_ch * 16) = pk_;
                *(LAS u32x4*)(lds + LDS_V + nxt * VBUF + off_b(vrow(v_key0), v_ch)) = pv0;
                *(LAS u32x4*)(lds + LDS_V + nxt * VBUF + off_b(vrow(v_key0 + 32), v_ch)) = pv1;
                if (kt + 2 < NT) { const size_t o = (size_t)(kt + 2) * 64 * NZ; pk_ = *(const u32x4*)(ksrc + o); pv0 = *(const u32x4*)(vsrc + o); pv1 = *(const u32x4*)(vsrc + o + (size_t)32 * NZ); }
            }
            if (kt * 64 <= q_first + 31) {
            f32x16 p[2];
#pragma unroll
            for (int hf = 0; hf < 2; ++hf) {
#pragma unroll
                for (int r = 0; r < 16; ++r) p[hf][r] = 0.f;
#pragma unroll
                for (int s = 0; s < 4; ++s) { const bf16x8 a = *(const LAS bf16x8*)(lds + kb + cur * KBUF + 32 * hf * KROW + s * 32); p[hf] = MFMA32(a, qf[s], p[hf]); }
            }
            if (kt * 64 + 63 > q_first) {
#pragma unroll
                for (int hf = 0; hf < 2; ++hf)
#pragma unroll
                    for (int r = 0; r < 16; ++r) { const int key = kt * 64 + 32 * hf + crow(r, hi); if (key > q_me) p[hf][r] = -1e30f; }
            }
            float mx = p[0][0];
#pragma unroll
            for (int r = 1; r < 16; ++r) mx = fmaxf(mx, p[0][r]);
#pragma unroll
            for (int r = 0; r < 16; ++r) mx = fmaxf(mx, p[1][r]);
            mx = fmaxf(mx, __shfl_xor(mx, 32));
            const float mnew = fmaxf(mrun, mx), alpha = __builtin_amdgcn_exp2f(mrun - mnew); mrun = mnew;
            float ls = 0.f;
#pragma unroll
            for (int hf = 0; hf < 2; ++hf)
#pragma unroll
                for (int r = 0; r < 16; ++r) { const float e = __builtin_amdgcn_exp2f(p[hf][r] - mnew); p[hf][r] = e; ls += e; }
            lrun = lrun * alpha + ls;
#pragma unroll
            for (int c = 0; c < 4; ++c)
#pragma unroll
                for (int r = 0; r < 16; ++r) O[c][r] *= alpha;
            bf16x8 pf[4];
            pf[0] = pack_step(p[0], 0); pf[1] = pack_step(p[0], 1); pf[2] = pack_step(p[1], 0); pf[3] = pack_step(p[1], 1);
#pragma unroll
            for (int c = 0; c < 4; ++c) { OPAQUE(q64); const unsigned cx = (64u * c) ^ q64;
#pragma unroll
                for (int ks = 0; ks < 4; ++ks) {
                    const s16x4 lo = tr_read(lds + tb0 + cur * VBUF + cx + 4096 * ks), hi4 = tr_read(lds + tb1 + cur * VBUF + cx + 4096 * ks);
                    O[c] = MFMA32(cat8(lo, hi4), pf[ks], O[c]);
                } }
            }
            __syncthreads();
        }
        const float ltot = lrun + __shfl_xor(lrun, 32), inv = 1.0f / ltot;
        if (m == 0) {
            LAS unsigned char* stg = lds + LDS_ST + wid * ST_WAVE;
#pragma unroll
            for (int c = 0; c < 4; ++c)
#pragma unroll
                for (int g4 = 0; g4 < 4; ++g4) { const int dv0 = 32 * c + 8 * g4 + 4 * hi;
                    u32x2 w; w.x = pk2(O[c][4 * g4] * inv, O[c][4 * g4 + 1] * inv); w.y = pk2(O[c][4 * g4 + 2] * inv, O[c][4 * g4 + 3] * inv);
                    *(LAS u32x2*)(stg + r32 * STROW + dv0 * 2) = w; }
        } else {
            const float li = lam_val * inv;
            float ss = 0.f;
            LAS unsigned char* stg = lds + LDS_ST + wid * ST_WAVE;
#pragma unroll
            for (int c = 0; c < 4; ++c)
#pragma unroll
                for (int g4 = 0; g4 < 4; ++g4) { const int dv0 = 32 * c + 8 * g4 + 4 * hi; const u32x2 k2 = *(const LAS u32x2*)(stg + r32 * STROW + dv0 * 2);
                    O[c][4 * g4] = bf_lo(k2.x) - li * O[c][4 * g4]; O[c][4 * g4 + 1] = bf_hi(k2.x) - li * O[c][4 * g4 + 1]; O[c][4 * g4 + 2] = bf_lo(k2.y) - li * O[c][4 * g4 + 2]; O[c][4 * g4 + 3] = bf_hi(k2.y) - li * O[c][4 * g4 + 3];
                    ss += (O[c][4 * g4] * O[c][4 * g4] + O[c][4 * g4 + 1] * O[c][4 * g4 + 1]) + (O[c][4 * g4 + 2] * O[c][4 * g4 + 2] + O[c][4 * g4 + 3] * O[c][4 * g4 + 3]); }
            ss += __shfl_xor(ss, 32);
            const float rstd = rsqrtf(ss * (1.0f / 128.0f) + LN_EPS) * (1.0f - LAMBDA_INIT);
#pragma unroll
            for (int c = 0; c < 4; ++c)
#pragma unroll
                for (int g4 = 0; g4 < 4; ++g4) { const int dv0 = 32 * c + 8 * g4 + 4 * hi; const f32x4 gg = *(const f32x4*)(subln_g + dv0);
                    u32x2 w; w.x = pk2(O[c][4 * g4] * rstd * gg[0], O[c][4 * g4 + 1] * rstd * gg[1]); w.y = pk2(O[c][4 * g4 + 2] * rstd * gg[2], O[c][4 * g4 + 3] * rstd * gg[3]);
                    *(LAS u32x2*)(stg + r32 * STROW + dv0 * 2) = w; }
        }
    }
    LAS unsigned char* stg = lds + LDS_ST + wid * ST_WAVE;
    asm volatile("s_waitcnt lgkmcnt(0)" ::: "memory");
    bf16_t* obase = Z + (rowbase + q_first) * NZ + ZC_Q + h * 128;
#pragma unroll
    for (int i = 0; i < 8; ++i) { const int idx = lane + 64 * i, row = idx >> 4, ch = idx & 15;
        const u32x4 v = *(const LAS u32x4*)(stg + row * STROW + ch * 16); if (!DRY || v.x == 0x12345678u) *(u32x4*)(obase + (size_t)row * NZ + ch * 8) = v; }
}
}
namespace mls {
constexpr int QI = 0, KI = 32768, VI = 65536, SC = 131072;
constexpr int F_IG = 0, F_LF = 128, F_A = 256, F_M = 384, F_INTER = 512, F_EMT = 640, F_W = 768, F_DEN = 896, F_N = 1024, F_MISC = 1152,
              F_NQ2P = 1280, F_NQ1P = 1792, F_NP = 2304, F_RSQ = 2816, F_END = 3840;
constexpr int LDS_BYTES = SC + F_END * 4;
static_assert(LDS_BYTES <= 147456, "mLSTM LDS");

DI float scan_add(float x, int lane) {
#pragma unroll
    for (int o = 1; o < 64; o <<= 1) { const float y = __shfl_up(x, o); if (lane >= o) x += y; }
    return x;
}
DI float scan_max(float x, int lane) {
#pragma unroll
    for (int o = 1; o < 64; o <<= 1) { const float y = __shfl_up(x, o); if (lane >= o) x = fmaxf(x, y); }
    return x;
}
DI float log_sigmoid(float x) { return fminf(x, 0.f) - __logf(1.0f + __expf(-fabsf(x))); }

template <bool DRY> DI void mlstm_unit(LAS unsigned char* lds, bf16_t* Z, const float* GIF, const float* conv_w, const float* conv_b, const float* norm_g, int b, int hd) {
    int tid_o = threadIdx.x; OPAQUE(tid_o); const int tid = tid_o, lane = tid & 63; const int wid = __builtin_amdgcn_readfirstlane(tid >> 6);
    LAS float* sc = (LAS float*)(lds + SC);
#define MLS_LV unsigned L_ = lane; OPAQUE(L_); const unsigned r32 = L_ & 31, hi = L_ >> 5, rowb = 256u * r32, f16 = (((r32 & 3) << 2) | ((r32 >> 2) & 3)) << 4, q64 = ((L_ & 15) >> 2) << 6; (void)rowb; (void)f16; (void)q64; (void)hi
    f32x16 CT[4];
#pragma unroll
    for (int i = 0; i < 4; ++i)
#pragma unroll
        for (int r = 0; r < 16; ++r) CT[i][r] = 0.f;
    float m_prev = 0.f;
    if (tid < 128) sc[F_N + tid] = 0.f;
    const int img = wid >> 2, vc = wid & 3;
    const int st_i = wid >> 1, st_j0 = 2 * (wid & 1);

    u32x4 rawn[11]; float gin = 0.f, gfn = 0.f;
#define MLS_PREFETCH(CC) do { int tp = tid; OPAQUE(tp); const int p_mat = tp >> 8, p_ch = tp & 15, p_rg = (tp >> 4) & 15; const size_t tn = (size_t)b * SEQ + (size_t)(CC) * 128; \
        const bf16_t* srcn = Z + (tn + p_rg * 8) * NZ + (p_mat ? ZC_MK : ZC_MQ) + hd * 128 + p_ch * 8; \
        _Pragma("unroll") for (int j = 0; j < 11; ++j) { const int lp = (CC) * 128 + p_rg * 8 - 3 + j; rawn[j] = (u32x4){0u, 0u, 0u, 0u}; if (lp >= 0) rawn[j] = *(const u32x4*)(srcn + (ptrdiff_t)(j - 3) * NZ); } \
        if (tp < 128) { const float* gg = GIF + (tn + tp) * 8; gin = gg[hd]; gfn = gg[4 + hd]; } } while (0)
    MLS_PREFETCH(0);
    for (int c = 0; c < 16; ++c) {
        const size_t t0 = (size_t)b * SEQ + (size_t)c * 128;
        __syncthreads();
        u32x4 vn[8];
        { int tq = tid; OPAQUE(tq);
#pragma unroll
          for (int i = 0; i < 8; ++i) { const int idx = tq + 512 * i, row = idx >> 5, ch32 = idx & 31; vn[i] = *(const u32x4*)(Z + (t0 + row) * NZ + ZC_MV + hd * 256 + ch32 * 8); } }
        {
            int tq = tid; OPAQUE(tq);
            const int c_mat = tq >> 8, c_ch = tq & 15, c_rg = (tq >> 4) & 15;
            const int chan0 = c_mat * 512 + hd * 128 + c_ch * 8;
            const float kscale = c_mat ? 0.08838834764831845f : 1.0f;
            float cw[4][8], cb[8];
            { const float* cwp = conv_w + chan0; const float* cbp = conv_b + chan0; asm volatile("" : "+v"(cwp), "+v"(cbp));
#pragma unroll
              for (int j = 0; j < 4; ++j) { const f32x4 a = *(const f32x4*)(cwp + j * 1024), c4 = *(const f32x4*)(cwp + j * 1024 + 4);
                cw[j][0] = a[0]; cw[j][1] = a[1]; cw[j][2] = a[2]; cw[j][3] = a[3]; cw[j][4] = c4[0]; cw[j][5] = c4[1]; cw[j][6] = c4[2]; cw[j][7] = c4[3]; }
              const f32x4 a = *(const f32x4*)cbp, c4 = *(const f32x4*)(cbp + 4); cb[0] = a[0]; cb[1] = a[1]; cb[2] = a[2]; cb[3] = a[3]; cb[4] = c4[0]; cb[5] = c4[1]; cb[6] = c4[2]; cb[7] = c4[3]; }
            u32x4 raw[11];
#pragma unroll
            for (int j = 0; j < 11; ++j) raw[j] = rawn[j];
#pragma unroll
            for (int i = 0; i < 8; ++i) {
                float o[8];
#pragma unroll
                for (int e = 0; e < 8; ++e) { const int q = e >> 1; const bool hi_ = e & 1;
                    const float x0 = hi_ ? bf_hi(raw[i][q]) : bf_lo(raw[i][q]), x1 = hi_ ? bf_hi(raw[i + 1][q]) : bf_lo(raw[i + 1][q]), x2 = hi_ ? bf_hi(raw[i + 2][q]) : bf_lo(raw[i + 2][q]), x3 = hi_ ? bf_hi(raw[i + 3][q]) : bf_lo(raw[i + 3][q]);
                    const float y = cb[e] + cw[0][e] * x0 + cw[1][e] * x1 + cw[2][e] * x2 + cw[3][e] * x3; o[e] = siluf_(y) * kscale; }
                u32x4 w; w.x = pk2(o[0], o[1]); w.y = pk2(o[2], o[3]); w.z = pk2(o[4], o[5]); w.w = pk2(o[6], o[7]);
                *(LAS u32x4*)(lds + (c_mat ? KI : QI) + off_b(c_rg * 8 + i, c_ch)) = w;
            }
        }
        { int tq = tid; OPAQUE(tq);
#pragma unroll
        for (int i = 0; i < 8; ++i) { const int idx = tq + 512 * i, row = idx >> 5, ch32 = idx & 31;
            *(LAS u32x4*)(lds + VI + (ch32 >> 4) * 32768 + off_b(row, ch32 & 15)) = vn[i]; } }
        if (tid < 128) { sc[F_IG + tid] = gin; sc[F_LF + tid] = log_sigmoid(gfn);
            if (c > 0) sc[F_N + tid] = sc[F_MISC + 1] * sc[F_N + tid] + (sc[F_NP + tid] + sc[F_NP + 128 + tid]) + (sc[F_NP + 256 + tid] + sc[F_NP + 384 + tid]); }
        __syncthreads();
        if (wid == 0) {
            const float ig0 = sc[F_IG + 2 * lane], ig1 = sc[F_IG + 2 * lane + 1], lf0 = sc[F_LF + 2 * lane], lf1 = sc[F_LF + 2 * lane + 1];
            const float s2 = lf0 + lf1, incl = scan_add(s2, lane), excl = incl - s2;
            const float b0 = excl + lf0, b1 = incl, a0 = ig0 - b0, a1 = ig1 - b1;
            const float im = scan_max(fmaxf(a0, a1), lane); float em = __shfl_up(im, 1); if (lane == 0) em = -3.0e38f;
            const float cm0 = fmaxf(em, a0), cm1 = im;
            const float M0 = fmaxf(m_prev, cm0), M1 = fmaxf(m_prev, cm1);
            const float ML = __shfl(M1, 63), bL = __shfl(b1, 63);
            sc[F_A + 2 * lane] = a0; sc[F_A + 2 * lane + 1] = a1; sc[F_M + 2 * lane] = M0; sc[F_M + 2 * lane + 1] = M1;
            sc[F_INTER + 2 * lane] = __expf(m_prev - M0); sc[F_INTER + 2 * lane + 1] = __expf(m_prev - M1);
            sc[F_EMT + 2 * lane] = __expf(-(b0 + M0)); sc[F_EMT + 2 * lane + 1] = __expf(-(b1 + M1));
            sc[F_W + 2 * lane] = __expf(a0 - ML); sc[F_W + 2 * lane + 1] = __expf(a1 - ML);
            if (lane == 0) sc[F_MISC + 0] = __expf(m_prev - ML);
            m_prev = bL + ML;
        }
        f32x16 sT[2];
#pragma unroll
        for (int jj = 0; jj < 2; ++jj) {
#pragma unroll
            for (int r = 0; r < 16; ++r) sT[jj][r] = 0.f;
            const int j = st_j0 + jj;
            if (j <= st_i) { MLS_LV; const unsigned fh = (16u * hi) ^ f16;
#pragma unroll
                for (int ks = 0; ks < 8; ++ks) { const unsigned xo = rowb + ((32u * ks) ^ fh);
                    const bf16x8 a = *(const LAS bf16x8*)(lds + KI + 8192 * j + xo), q = *(const LAS bf16x8*)(lds + QI + 8192 * st_i + xo);
                    sT[jj] = MFMA32(a, q, sT[jj]); }
            }
        }
        __syncthreads();
        u32x2 pp[2][4];
        { MLS_LV; const int t = 32 * st_i + r32; const float Mt = sc[F_M + t]; const unsigned ab = SC + 4 * F_A + 128 * st_j0 + 16 * hi;
#pragma unroll
          for (int jj = 0; jj < 2; ++jj) { const int j = st_j0 + jj;
#pragma unroll
            for (int g4 = 0; g4 < 4; ++g4) { const int s0 = 32 * j + 8 * g4 + 4 * hi; float pv[4];
#pragma unroll
                for (int e = 0; e < 4; ++e) { const int s = s0 + e; pv[e] = (s <= t) ? __expf(*(const LAS float*)(lds + ab + 4 * (32 * jj + 8 * g4 + e)) - Mt) * sT[jj][4 * g4 + e] : 0.f; }
                pp[jj][g4].x = pk2(pv[0], pv[1]); pp[jj][g4].y = pk2(pv[2], pv[3]); } } }
        f32x16 acc[4];
#pragma unroll
        for (int ti = 0; ti < 4; ++ti)
#pragma unroll
            for (int r = 0; r < 16; ++r) acc[ti][r] = 0.f;
        if (c > 0) {
#pragma unroll
            for (int dt = 0; dt < 4; ++dt)
#pragma unroll
                for (int s2 = 0; s2 < 2; ++s2) { const bf16x8 bfr = pack_step(CT[dt], s2); MLS_LV;
                    const unsigned a0 = QI + rowb + 8 * hi + ((64u * dt + 32u * s2) ^ f16), a1 = QI + rowb + 8 * hi + ((64u * dt + 32u * s2 + 16u) ^ f16);
#pragma unroll
                    for (int ti = 0; ti < 4; ++ti) {
                        const s16x4 lo = *(const LAS s16x4*)(lds + a0 + 8192 * ti), hi4 = *(const LAS s16x4*)(lds + a1 + 8192 * ti);
                        acc[ti] = MFMA32(cat8(lo, hi4), bfr, acc[ti]); }
                    __builtin_amdgcn_sched_barrier(0); }
        }
        { int tq = tid; OPAQUE(tq); const int t = tq & 127, part = tq >> 7; float d = 0.f;
#pragma unroll
          for (int cc = 0; cc < 4; ++cc) { const int ch = 4 * part + cc; const u32x4 raw = *(const LAS u32x4*)(lds + QI + off_b(t, ch)); const LAS float* nn = sc + F_N + 8 * ch;
              d += bf_lo(raw.x) * nn[0] + bf_hi(raw.x) * nn[1] + bf_lo(raw.y) * nn[2] + bf_hi(raw.y) * nn[3] + bf_lo(raw.z) * nn[4] + bf_hi(raw.z) * nn[5] + bf_lo(raw.w) * nn[6] + bf_hi(raw.w) * nn[7]; }
          sc[F_NQ2P + part * 128 + t] = d; }
        __syncthreads();
        { MLS_LV; const unsigned ib = SC + 4 * F_INTER + 16 * hi;
#pragma unroll
          for (int ti = 0; ti < 4; ++ti)
#pragma unroll
            for (int r = 0; r < 16; ++r) acc[ti][r] *= *(const LAS float*)(lds + ib + 4 * (32 * ti + (r & 3) + 8 * (r >> 2))); }
        { MLS_LV;
#pragma unroll
          for (int jj = 0; jj < 2; ++jj) { const int j = st_j0 + jj;
#pragma unroll
            for (int g4 = 0; g4 < 4; ++g4) *(LAS u32x2*)(lds + QI + 8192 * st_i + rowb + 8 * hi + ((64u * j + 16u * g4) ^ f16)) = pp[jj][g4]; } }
        { int tq = tid; OPAQUE(tq);
#pragma unroll
        for (int i = 0; i < 4; ++i) { const int idx = tq + 512 * i, row = idx >> 4, ch = idx & 15; LAS u32x4* p = (LAS u32x4*)(lds + KI + off_b(row, ch)); const u32x4 raw = *p; const float w = sc[F_W + row];
            u32x4 o; o.x = pk2(bf_lo(raw.x) * w, bf_hi(raw.x) * w); o.y = pk2(bf_lo(raw.y) * w, bf_hi(raw.y) * w); o.z = pk2(bf_lo(raw.z) * w, bf_hi(raw.z) * w); o.w = pk2(bf_lo(raw.w) * w, bf_hi(raw.w) * w); *p = o; } }
        __syncthreads();
        { const float decay = sc[F_MISC + 0];
#pragma unroll
          for (int dt = 0; dt < 4; ++dt)
#pragma unroll
            for (int r = 0; r < 16; ++r) CT[dt][r] *= decay; }
#pragma unroll
        for (int ks = 0; ks < 8; ++ks) {
            MLS_LV;
            const unsigned tbv0 = VI + img * 32768 + tr_base(L_, 0) + ((64u * vc) ^ q64), tbv1 = VI + img * 32768 + tr_base(L_, 1) + ((64u * vc) ^ q64);
            const unsigned tbk0 = KI + tr_base(L_, 0), tbk1 = KI + tr_base(L_, 1);
            const bf16x8 bv = cat8(tr_read(lds + tbv0 + 4096 * ks), tr_read(lds + tbv1 + 4096 * ks));
            const unsigned xo = QI + rowb + ((32u * ks) ^ ((16u * hi) ^ f16));
#pragma unroll
            for (int ti = 0; ti < 4; ++ti) if (ks < 2 * (ti + 1)) { const bf16x8 a = *(const LAS bf16x8*)(lds + xo + 8192 * ti); acc[ti] = MFMA32(a, bv, acc[ti]); }
#pragma unroll
            for (int dt = 0; dt < 4; ++dt) { const unsigned cx = (64u * dt) ^ q64; const bf16x8 a = cat8(tr_read(lds + tbk0 + 4096 * ks + cx), tr_read(lds + tbk1 + 4096 * ks + cx)); CT[dt] = MFMA32(a, bv, CT[dt]); }
            __builtin_amdgcn_sched_barrier(0);
        }
        { int tq = tid; OPAQUE(tq); const int t = tq & 127, part = tq >> 7; float d = 0.f;
#pragma unroll
          for (int cc = 0; cc < 4; ++cc) { const u32x4 raw = *(const LAS u32x4*)(lds + QI + off_b(t, 4 * part + cc));
              d += (bf_lo(raw.x) + bf_hi(raw.x)) + (bf_lo(raw.y) + bf_hi(raw.y)) + (bf_lo(raw.z) + bf_hi(raw.z)) + (bf_lo(raw.w) + bf_hi(raw.w)); }
          sc[F_NQ1P + part * 128 + t] = d;
          float nn = 0.f;
          for (int s = 32 * part; s < 32 * part + 32; ++s) nn += bf2f(*(const LAS bf16_t*)(lds + KI + off_b(s, t >> 3) + (t & 7) * 2));
          sc[F_NP + part * 128 + t] = nn;
          if (tid == 0) sc[F_MISC + 1] = sc[F_MISC + 0]; }
        __syncthreads();
        if (tid < 128) { const float nq1 = (sc[F_NQ1P + tid] + sc[F_NQ1P + 128 + tid]) + (sc[F_NQ1P + 256 + tid] + sc[F_NQ1P + 384 + tid]);
            const float nq2 = (sc[F_NQ2P + tid] + sc[F_NQ2P + 128 + tid]) + (sc[F_NQ2P + 256 + tid] + sc[F_NQ2P + 384 + tid]);
            sc[F_DEN + tid] = 1.0f / fmaxf(fabsf(nq1 + sc[F_INTER + tid] * nq2), sc[F_EMT + tid]); }
        __syncthreads();
        u32x4 oraw[8];
        { int tq = tid; OPAQUE(tq);
#pragma unroll
          for (int i = 0; i < 8; ++i) { const int idx = tq + 512 * i, row = idx >> 5, ch = idx & 31; oraw[i] = *(const u32x4*)(Z + (t0 + row) * NZ + hd * 256 + ch * 8 + ZC_MO); } }
        { MLS_LV; const unsigned db = SC + 4 * F_DEN + 16 * hi, hb = VI + 2048 * hi + (32 * wid + r32) * 2;
#pragma unroll
          for (int ti = 0; ti < 4; ++ti)
#pragma unroll
            for (int r = 0; r < 16; ++r) { const int tt = 32 * ti + (r & 3) + 8 * (r >> 2); const float x = acc[ti][r] * *(const LAS float*)(lds + db + 4 * tt);
                *(LAS bf16_t*)(lds + hb + 512 * tt) = (bf16_t)(pk2(x, 0.f) & 0xffffu); } }
        __syncthreads();
        { const int cn = c + 1 < 16 ? c + 1 : 15; MLS_PREFETCH(cn); }
        { int tq = tid; OPAQUE(tq);
          const f32x4 g0 = *(const f32x4*)(norm_g + hd * 256 + (tq & 31) * 8), g1 = *(const f32x4*)(norm_g + hd * 256 + (tq & 31) * 8 + 4);
#pragma unroll
          for (int i = 0; i < 8; ++i) { const int idx = tq + 512 * i, row = idx >> 5, ch = idx & 31;
            const u32x4 hraw = *(const LAS u32x4*)(lds + VI + row * 512 + ch * 16);
            const float h0 = bf_lo(hraw.x), h1 = bf_hi(hraw.x), h2 = bf_lo(hraw.y), h3 = bf_hi(hraw.y), h4 = bf_lo(hraw.z), h5 = bf_hi(hraw.z), h6 = bf_lo(hraw.w), h7 = bf_hi(hraw.w);
            float ssq = (h0 * h0 + h1 * h1) + (h2 * h2 + h3 * h3) + (h4 * h4 + h5 * h5) + (h6 * h6 + h7 * h7);
            ssq += __shfl_xor(ssq, 1); ssq += __shfl_xor(ssq, 2); ssq += __shfl_xor(ssq, 4); ssq += __shfl_xor(ssq, 8); ssq += __shfl_xor(ssq, 16);
            const float rstd = rsqrtf(ssq * (1.0f / 256.0f) + LN_EPS);
            bf16_t* gp = Z + (t0 + row) * NZ + hd * 256 + ch * 8;
            u32x4 o;
            o.x = pk2(h0 * rstd * g0[0] * sigmoidf_(bf_lo(oraw[i].x)), h1 * rstd * g0[1] * sigmoidf_(bf_hi(oraw[i].x)));
            o.y = pk2(h2 * rstd * g0[2] * sigmoidf_(bf_lo(oraw[i].y)), h3 * rstd * g0[3] * sigmoidf_(bf_hi(oraw[i].y)));
            o.z = pk2(h4 * rstd * g1[0] * sigmoidf_(bf_lo(oraw[i].z)), h5 * rstd * g1[1] * sigmoidf_(bf_hi(oraw[i].z)));
            o.w = pk2(h6 * rstd * g1[2] * sigmoidf_(bf_lo(oraw[i].w)), h7 * rstd * g1[3] * sigmoidf_(bf_hi(oraw[i].w)));
            if (!DRY || o.x == 0x12345678u) *(u32x4*)(gp + ZC_MV) = o; } }
    }
    __syncthreads();
}
#undef MLS_LV
#undef MLS_PREFETCH
}
namespace peer {
constexpr int KROW = 144;
constexpr int L_KEYS = 0, L_IDX = 2 * 128 * KROW, LDS_BYTES = L_IDX + 512 * 32;
DI unsigned ordf(float f) { const unsigned u = __float_as_uint(f); return u ^ ((unsigned)((int)u >> 31) | 0x80000000u); }
DI float deord(unsigned k) { return __uint_as_float(k ^ ((~(unsigned)((int)k >> 31)) | 0x80000000u)); }
#define PEER_CE(a, b) do { const unsigned hi_ = (a) > (b) ? (a) : (b), lo_ = (a) > (b) ? (b) : (a); (a) = hi_; (b) = lo_; } while (0)
DI void sort16_desc(unsigned (&a)[16]) {
#pragma unroll
    for (int k = 2; k <= 16; k <<= 1)
#pragma unroll
        for (int j = k >> 1; j >= 1; j >>= 1)
#pragma unroll
            for (int i = 0; i < 16; ++i) { const int l = i ^ j; if (l > i) { if (k == 16 || (i & k) == 0) PEER_CE(a[i], a[l]); else PEER_CE(a[l], a[i]); } }
}
DI void merge16(unsigned (&a)[16], const unsigned (&b)[16]) {
#pragma unroll
    for (int i = 0; i < 16; ++i) a[i] = a[i] > b[15 - i] ? a[i] : b[15 - i];
#pragma unroll
    for (int j = 8; j >= 1; j >>= 1)
#pragma unroll
        for (int i = 0; i < 16; ++i) { const int l = i ^ j; if (l > i) PEER_CE(a[i], a[l]); }
}
DI float gelu_erf(float x) { return 0.5f * x * (1.0f + erff(x * 0.7071067811865476f)); }

DI void stage_keys(LAS unsigned char* lds, const float* keys) {
    for (int i = threadIdx.x; i < 2 * 128 * 8; i += 512) { const int row = i >> 3, ch = i & 7; const float* s = keys + row * 64 + ch * 8;
        const f32x4 a = *(const f32x4*)s, b = *(const f32x4*)(s + 4);
        u32x4 w; w.x = pk2(a[0], a[1]); w.y = pk2(a[2], a[3]); w.z = pk2(b[0], b[1]); w.w = pk2(b[2], b[3]);
        *(LAS u32x4*)(lds + L_KEYS + row * KROW + ch * 16) = w; }
}

DI void select_tile(LAS unsigned char* lds, const bf16_t* QP, int tok0, bf16_t* SELE, float* SELG) {
    int tid_o = threadIdx.x; OPAQUE(tid_o); const int tid = tid_o, lane = tid & 63, r32 = lane & 31, hi = lane >> 5; const int wid = __builtin_amdgcn_readfirstlane(tid >> 6);
    unsigned LA[16], LB[16];
#pragma unroll
    for (int p = 0; p < 2; ++p) {
        bf16x8 qf[4];
        { const bf16_t* qp = QP + (size_t)(tok0 + r32) * DM + wid * 128 + p * 64 + 8 * hi;
#pragma unroll
          for (int s = 0; s < 4; ++s) qf[s] = *(const bf16x8*)(qp + 16 * s); }
        unsigned L[16], M[16];
#pragma unroll
        for (int nt = 0; nt < 4; ++nt) {
            f32x16 acc;
#pragma unroll
            for (int r = 0; r < 16; ++r) acc[r] = 0.f;
#pragma unroll
            for (int s = 0; s < 4; ++s) { const bf16x8 a = *(const LAS bf16x8*)(lds + L_KEYS + (p * 128 + 32 * nt + r32) * KROW + (2 * s + hi) * 16); acc = MFMA32(a, qf[s], acc); }
            unsigned T[16];
#pragma unroll
            for (int r = 0; r < 16; ++r) T[r] = (ordf(acc[r]) & ~0x7Fu) | (unsigned)(32 * nt + crow(r, hi));
            sort16_desc(T);
            if (nt == 0) {
#pragma unroll
                for (int i = 0; i < 16; ++i) L[i] = T[i]; }
            else if (nt == 1) merge16(L, T);
            else if (nt == 2) {
#pragma unroll
                for (int i = 0; i < 16; ++i) M[i] = T[i]; }
            else { merge16(M, T); merge16(L, M); }
        }
        unsigned O[16];
#pragma unroll
        for (int i = 0; i < 16; ++i) O[i] = (unsigned)__shfl_xor((int)L[i], 32);
        merge16(L, O);
#pragma unroll
        for (int i = 0; i < 16; ++i) { if (p == 0) LA[i] = L[i]; else LB[i] = L[i]; }
    }
    unsigned CL[16], CM[16];
    {
        unsigned C4[4][16]; int n = 0;
#pragma unroll
        for (int g = 0; g < 4; ++g)
#pragma unroll
            for (int i = 0; i < 16; ++i) C4[g][i] = 0u;
#pragma unroll
        for (int i = 0; i < 16; ++i) {
            const float sa = deord(LA[i] & ~0x7Fu);
#pragma unroll
            for (int j = 0; j < 16; ++j) if ((i + 1) * (j + 1) <= 16) { const float sb = deord(LB[j] & ~0x7Fu); C4[n >> 4][n & 15] = (ordf(sa + sb) & ~0xFFu) | (unsigned)(i * 16 + j); ++n; }
        }
        sort16_desc(C4[0]); sort16_desc(C4[1]); sort16_desc(C4[2]); sort16_desc(C4[3]);
#pragma unroll
        for (int i = 0; i < 16; ++i) { CL[i] = C4[0][i]; CM[i] = C4[2][i]; }
        merge16(CL, C4[1]); merge16(CM, C4[3]); merge16(CL, CM);
    }
    LAS unsigned char* itab = lds + L_IDX + tid * 32;
    { u32x4 wa, wb;
#pragma unroll
      for (int q = 0; q < 4; ++q) { wa[q] = (LA[4 * q] & 0x7Fu) | ((LA[4 * q + 1] & 0x7Fu) << 8) | ((LA[4 * q + 2] & 0x7Fu) << 16) | ((LA[4 * q + 3] & 0x7Fu) << 24);
                                    wb[q] = (LB[4 * q] & 0x7Fu) | ((LB[4 * q + 1] & 0x7Fu) << 8) | ((LB[4 * q + 2] & 0x7Fu) << 16) | ((LB[4 * q + 3] & 0x7Fu) << 24); }
      *(LAS u32x4*)itab = wa; *(LAS u32x4*)(itab + 16) = wb; }
    const float mx = deord(CL[0] & ~0xFFu);
    float ev[16], sum = 0.f;
#pragma unroll
    for (int k = 0; k < 16; ++k) { ev[k] = __expf(deord(CL[k] & ~0xFFu) - mx); sum += ev[k]; }
    const float inv = 1.0f / sum;
    bf16_t* se = SELE + (size_t)(tok0 + r32) * 128 + wid * 16;
    float* sg = SELG + (size_t)(tok0 + r32) * 128 + wid * 16;
#pragma unroll
    for (int k = 0; k < 16; ++k) if ((k >> 3) == hi) { const unsigned code = CL[k] & 0xFFu; const unsigned n1 = itab[code >> 4], n2 = itab[16 + (code & 15u)];
        se[k] = (bf16_t)(n1 * 128u + n2); sg[k] = ev[k] * inv; }
}

DI void u_phase_tile(LAS unsigned char* lds, int tile, int x, const bf16_t* SELE, const unsigned char* H2Q, const unsigned char* U8S, float* PART) {
    int tid_o = threadIdx.x; OPAQUE(tid_o); const int tid = tid_o, lane = tid & 63, j = lane >> 3, c = lane & 7; const int wid = __builtin_amdgcn_readfirstlane(tid >> 6);
    *(LAS u32x4*)(lds + tid * 16) = *(const u32x4*)(SELE + (size_t)tile * 32 * 128 + tid * 8);
    __syncthreads();
    const unsigned char* Us = U8S + (size_t)x * NEXP * 128 + 16 * c;
#pragma unroll 1
    for (int jt = 0; jt < 4; ++jt) {
        const int tk = wid * 4 + jt; const size_t t = (size_t)tile * 32 + tk;
        const u32x4 hq = *(const u32x4*)(H2Q + t * DM + 128 * x + 16 * c);
        const LAS bf16_t* se = (const LAS bf16_t*)lds + tk * 128 + j;
        u32x4 ur[16];
#pragma unroll
        for (int g = 0; g < 16; ++g) { const unsigned e = se[8 * g]; ur[g] = *(const u32x4*)(Us + (size_t)e * 128); }
        float keep0 = 0.f, keep1 = 0.f;
#pragma unroll
        for (int g = 0; g < 16; ++g) {
            int d = __builtin_amdgcn_sdot4((int)ur[g].x, (int)hq.x, 0, false); d = __builtin_amdgcn_sdot4((int)ur[g].y, (int)hq.y, d, false);
            d = __builtin_amdgcn_sdot4((int)ur[g].z, (int)hq.z, d, false); d = __builtin_amdgcn_sdot4((int)ur[g].w, (int)hq.w, d, false);
            d += __shfl_xor(d, 1); d += __shfl_xor(d, 2); d += __shfl_xor(d, 4);
            if ((g & 7) == c) { if (g < 8) keep0 = (float)d; else keep1 = (float)d; }
        }
        float* pp = PART + t * 1024 + x * 128 + 8 * c + j;
        pp[0] = keep0; pp[64] = keep1;
    }
}
DI void red_tokens4(size_t t0, const float* __restrict__ PART, const bf16_t* __restrict__ SELE, const float* __restrict__ SELG, const float* __restrict__ SU, const float* __restrict__ SV,
                    const float* __restrict__ SH, signed char* __restrict__ COEFQ, float* __restrict__ CS) {
    const int lane = threadIdx.x & 63;
    float s[4][2], g[4][2], su[4][2], sv[4][2], sh[4];
#pragma unroll
    for (int q = 0; q < 4; ++q) { const size_t t = t0 + q; sh[q] = SH[t];
#pragma unroll
        for (int h = 0; h < 2; ++h) { const int k = lane + 64 * h; const unsigned e = SELE[t * 128 + k]; g[q][h] = SELG[t * 128 + k]; su[q][h] = SU[e]; sv[q][h] = SV[e];
            float a = 0.f;
#pragma unroll
            for (int xx = 0; xx < 8; ++xx) a += PART[t * 1024 + xx * 128 + k];
            s[q][h] = a; } }
#pragma unroll
    for (int q = 0; q < 4; ++q) { const size_t t = t0 + q;
        const float c0 = g[q][0] * gelu_erf(s[q][0] * su[q][0] * sh[q]) * sv[q][0], c1 = g[q][1] * gelu_erf(s[q][1] * su[q][1] * sh[q]) * sv[q][1];
        float cm = fmaxf(fabsf(c0), fabsf(c1));
#pragma unroll
        for (int o = 1; o < 64; o <<= 1) cm = fmaxf(cm, __shfl_xor(cm, o));
        const float inv = cm > 0.f ? 127.0f / cm : 0.f;
        signed char* cq = COEFQ + t * 128 + (lane & 7) * 16 + (lane >> 3);
        cq[0] = (signed char)(int)rintf(c0 * inv); cq[8] = (signed char)(int)rintf(c1 * inv);
        if (lane == 0) CS[t] = cm * (1.0f / 127.0f); }
}
DI unsigned bperm(unsigned hi, unsigned lo, unsigned sel) { return __builtin_amdgcn_perm(hi, lo, sel); }
DI void v_phase_tile(LAS unsigned char* lds, int tile, int x, const bf16_t* SELE, const signed char* COEFQ, const float* CS, const unsigned char* V8S, float* YF) {
    int tid_o = threadIdx.x; OPAQUE(tid_o); const int tid = tid_o, lane = tid & 63, j = lane >> 3, c = lane & 7; const int wid = __builtin_amdgcn_readfirstlane(tid >> 6);
    *(LAS u32x4*)(lds + tid * 16) = *(const u32x4*)(SELE + (size_t)tile * 32 * 128 + tid * 8);
    if (tid < 256) *(LAS u32x4*)(lds + 8192 + tid * 16) = *(const u32x4*)(COEFQ + (size_t)tile * 32 * 128 + tid * 16);
    __syncthreads();
    const unsigned char* Vs = V8S + (size_t)x * NEXP * 128 + 16 * c;
#pragma unroll 1
    for (int jt = 0; jt < 4; ++jt) {
        const int tk = wid * 4 + jt; const size_t t = (size_t)tile * 32 + tk;
        const LAS bf16_t* se = (const LAS bf16_t*)lds + tk * 128 + j;
        const LAS unsigned* cqp = (const LAS unsigned*)(lds + 8192 + tk * 128 + j * 16);
        u32x4 vr[16];
#pragma unroll
        for (int g = 0; g < 16; ++g) { const unsigned e = se[8 * g]; vr[g] = *(const u32x4*)(Vs + (size_t)e * 128); }
        int acc[16];
#pragma unroll
        for (int i = 0; i < 16; ++i) acc[i] = 0;
#pragma unroll
        for (int qd = 0; qd < 4; ++qd) { const int cp = (int)cqp[qd];
#pragma unroll
            for (int i = 0; i < 4; ++i) { const unsigned w0 = vr[4 * qd][i], w1 = vr[4 * qd + 1][i], w2 = vr[4 * qd + 2][i], w3 = vr[4 * qd + 3][i];
                const unsigned t0 = bperm(w1, w0, 0x05010400u), t1 = bperm(w1, w0, 0x07030602u), t2 = bperm(w3, w2, 0x05010400u), t3 = bperm(w3, w2, 0x07030602u);
                acc[4 * i] = __builtin_amdgcn_sdot4((int)bperm(t2, t0, 0x05040100u), cp, acc[4 * i], false);
                acc[4 * i + 1] = __builtin_amdgcn_sdot4((int)bperm(t2, t0, 0x07060302u), cp, acc[4 * i + 1], false);
                acc[4 * i + 2] = __builtin_amdgcn_sdot4((int)bperm(t3, t1, 0x05040100u), cp, acc[4 * i + 2], false);
                acc[4 * i + 3] = __builtin_amdgcn_sdot4((int)bperm(t3, t1, 0x07060302u), cp, acc[4 * i + 3], false); } }
#pragma unroll
        for (int i = 0; i < 16; ++i) { acc[i] += __shfl_xor(acc[i], 8); acc[i] += __shfl_xor(acc[i], 16); acc[i] += __shfl_xor(acc[i], 32); }
        if (j == 0) { const float sc = CS[t]; float* yp = YF + t * DM + 128 * x + 16 * c;
#pragma unroll
            for (int i = 0; i < 4; ++i) { f32x4 o; o[0] = (float)acc[4 * i] * sc; o[1] = (float)acc[4 * i + 1] * sc; o[2] = (float)acc[4 * i + 2] * sc; o[3] = (float)acc[4 * i + 3] * sc; *(f32x4*)(yp + 4 * i) = o; } }
    }
}
DI void final_rows2(size_t m0, size_t m1, float* YFOUT, const float* __restrict__ X1, const float* __restrict__ MOD, const float* __restrict__ ln_g, const float* __restrict__ ln_b) {
    const int lane = threadIdx.x & 63;
    f32x4 v[2][4];
#pragma unroll
    for (int r = 0; r < 2; ++r) { const size_t m = r ? m1 : m0; const int b = (int)(m / SEQ);
        const f32x4* yr = (const f32x4*)(YFOUT + m * DM) + lane; const f32x4* xr = (const f32x4*)(X1 + m * DM) + lane; const f32x4* gt = (const f32x4*)(MOD + (size_t)b * MODW + 5 * DM) + lane;
#pragma unroll
        for (int q = 0; q < 4; ++q) v[r][q] = xr[64 * q] * ALPHA_RES + gt[64 * q] * yr[64 * q]; }
#pragma unroll
    for (int r = 0; r < 2; ++r) { const size_t m = r ? m1 : m0; float s = 0.f;
#pragma unroll
        for (int q = 0; q < 4; ++q) s += (v[r][q].x + v[r][q].y) + (v[r][q].z + v[r][q].w);
        const float mean = wave_sum(s) * (1.f / DM); float s2 = 0.f;
#pragma unroll
        for (int q = 0; q < 4; ++q) { v[r][q] = v[r][q] - mean; s2 += (v[r][q].x * v[r][q].x + v[r][q].y * v[r][q].y) + (v[r][q].z * v[r][q].z + v[r][q].w * v[r][q].w); }
        const float rstd = rsqrtf(wave_sum(s2) * (1.f / DM) + LN_EPS);
        f32x4* op = (f32x4*)(YFOUT + m * DM) + lane;
#pragma unroll
        for (int q = 0; q < 4; ++q) op[64 * q] = v[r][q] * rstd * ((const f32x4*)ln_g)[lane + 64 * q] + ((const f32x4*)ln_b)[lane + 64 * q]; }
}
}
constexpr int NWAVES = 8;
#ifndef MK_N_LAUNCHES
#define MK_N_LAUNCHES 1
#endif
constexpr int N_PHASES = 14;
constexpr int RING_BYTES = 147456;
constexpr int MISC_OFF = RING_BYTES;
constexpr int LDS_BYTES = RING_BYTES + 4096;
static_assert(pg8::STAGE_BYTES <= RING_BYTES && datt::LDS_BYTES <= RING_BYTES && mls::LDS_BYTES <= RING_BYTES && peer::LDS_BYTES <= RING_BYTES, "LDS map");

typedef GAS unsigned gu32;
#define RLX_AGENT __ATOMIC_RELAXED, __HIP_MEMORY_SCOPE_AGENT
#define LDS_WAIT() asm volatile("s_waitcnt lgkmcnt(0)" ::: "memory")

#define XB_TMO      128
#define XB_XCNT(j)  (256  + 64 * (j))
#define XB_XSUB(j)  (1280 + 64 * (j))
#define XB_XGEN(j)  (2304 + 64 * (j))
#define XB_TOP      3328
#define XB_TOPGEN   3392
#define XCD_BAR_WORDS 3456
#define XB_SPIN_CAP (1u << 22)
DI unsigned xb_ld(unsigned* p)              { return __hip_atomic_load(p, __ATOMIC_RELAXED, __HIP_MEMORY_SCOPE_AGENT); }
DI unsigned xb_add(unsigned* p, unsigned v) { return __hip_atomic_fetch_add(p, v, __ATOMIC_RELAXED, __HIP_MEMORY_SCOPE_AGENT); }
DI unsigned xb_xcc_id() { return (unsigned)__builtin_amdgcn_s_getreg((3 << 11) | 20) & 0xFu; }
#define XB_SPIN(cond, bar) do { unsigned _sp = 0; while (cond) { __builtin_amdgcn_s_sleep(1); \
    if ((++_sp & 255u) == 0u) { if (xb_ld(&(bar)[XB_TMO])) break; if (_sp > XB_SPIN_CAP) { atomicAdd(&(bar)[XB_TMO], 1u); break; } } } } while (0)
struct XcdBarrier { unsigned* bar; unsigned x; volatile LAS unsigned* st; };
DI XcdBarrier xcd_barrier_post(unsigned* bar, volatile LAS unsigned* st) {
    XcdBarrier b; b.bar = bar; b.x = xb_xcc_id(); b.st = st;
    if (threadIdx.x == 0) st[2] = xb_add(&bar[XB_XCNT(b.x)], 1u);
    return b;
}
DI void xcd_barrier_complete(unsigned* bar, unsigned x, unsigned& nloc, unsigned& nx) {
    const unsigned G = gridDim.x * gridDim.y * gridDim.z;
    unsigned sum, cnt, mine, sp = 0u;
    for (;;) {
        sum = 0u; cnt = 0u; mine = 0u;
#pragma unroll
        for (unsigned j = 0; j < 16; ++j) { const unsigned c = xb_ld(&bar[XB_XCNT(j)]); sum += c; cnt += (c > 0u) ? 1u : 0u; mine = (j == x) ? c : mine; }
        if (sum == G) break;
        __builtin_amdgcn_s_sleep(1);
        if ((++sp & 255u) == 0u) { if (xb_ld(&bar[XB_TMO])) break; if (sp > XB_SPIN_CAP) { atomicAdd(&bar[XB_TMO], 1u); break; } }
    }
    nloc = mine > 0u ? mine : 1u; nx = cnt > 0u ? cnt : 1u;
}
DI void xcd_barrier(const XcdBarrier& b) {
    asm volatile("s_waitcnt vmcnt(0)" ::: "memory");
    __syncthreads();
    if (threadIdx.x == 0) {
        unsigned* bar = b.bar;
        __builtin_amdgcn_s_waitcnt(0);
        unsigned nloc = b.st[0], nx = b.st[1];
        if (nloc == 0u) { xcd_barrier_complete(bar, b.x, nloc, nx); b.st[0] = nloc; b.st[1] = nx; }
        const unsigned old = xb_add(&bar[XB_XSUB(b.x)], 1u);
        const unsigned gen = old / nloc;
        if (old + 1u == (gen + 1u) * nloc) {
            __builtin_amdgcn_fence(__ATOMIC_RELEASE, "agent");
            asm volatile("s_waitcnt vmcnt(0)" ::: "memory");
            const unsigned og = xb_add(&bar[XB_TOP], 1u);
            const unsigned tg = og / nx;
            if (og + 1u == (tg + 1u) * nx) xb_add(&bar[XB_TOPGEN], 1u);
            else XB_SPIN(xb_ld(&bar[XB_TOPGEN]) == tg, bar);
            __builtin_amdgcn_fence(__ATOMIC_ACQUIRE, "agent");
            xb_add(&bar[XB_XGEN(b.x)], 1u);
            asm volatile("s_waitcnt vmcnt(0)" ::: "memory");
        } else {
            XB_SPIN(xb_ld(&bar[XB_XGEN(b.x)]) == gen, bar);
            __builtin_amdgcn_fence(__ATOMIC_ACQUIRE, "agent");
            asm volatile("s_waitcnt vmcnt(0)" ::: "memory");
        }
    }
    __syncthreads();
}

DI void p0_transpose_item(const float* W, int ldw, int col0, bf16_t* WT, int K, int dst_row0, int kb, float scale, LAS float* scr, int lane) {
    const int k0 = 64 * kb;
#pragma unroll 8
    for (int i = 0; i < 32; ++i) { const int kk = 2 * i + (lane >> 5); scr[kk * 33 + (lane & 31)] = W[(size_t)(k0 + kk) * ldw + col0 + (lane & 31)] * scale; }
    LDS_WAIT(); asm volatile("" ::: "memory");
    const int c = lane & 7;
#pragma unroll
    for (int j = 0; j < 4; ++j) { const int n = (lane >> 3) + 8 * j; const LAS float* s = scr + (8 * c) * 33 + n;
        u32x4 o; o.x = pk2(s[0 * 33], s[1 * 33]); o.y = pk2(s[2 * 33], s[3 * 33]); o.z = pk2(s[4 * 33], s[5 * 33]); o.w = pk2(s[6 * 33], s[7 * 33]);
        *(u32x4*)(WT + (size_t)(dst_row0 + n) * K + k0 + 8 * c) = o; }
    LDS_WAIT(); asm volatile("" ::: "memory");
}


DI void p1_rows2(int m0, int m1, int lane, const float* __restrict__ xin, const float* __restrict__ MODp, bf16_t* __restrict__ H1p, float* __restrict__ GIFp, const float* __restrict__ bif, const LAS float* wif) {
    f32x4 v[2][4], scv[2][4], shv[2][4];
#pragma unroll
    for (int r = 0; r < 2; ++r) { const int m = r ? m1 : m0; const int b = m / SEQ;
        const f32x4* xr = (const f32x4*)(xin + (size_t)m * DM) + lane; const f32x4* sh = (const f32x4*)(MODp + (size_t)b * MODW) + lane; const f32x4* sc = (const f32x4*)(MODp + (size_t)b * MODW + DM) + lane;
#pragma unroll
        for (int j = 0; j < 4; ++j) { v[r][j] = xr[64 * j]; scv[r][j] = sc[64 * j]; shv[r][j] = sh[64 * j]; } }
#pragma unroll
    for (int r = 0; r < 2; ++r) { const int m = r ? m1 : m0; float s = 0.f;
#pragma unroll
        for (int j = 0; j < 4; ++j) s += (v[r][j].x + v[r][j].y) + (v[r][j].z + v[r][j].w);
        const float mean = wave_sum(s) * (1.f / DM); float s2 = 0.f;
#pragma unroll
        for (int j = 0; j < 4; ++j) { v[r][j] = v[r][j] - mean; s2 += (v[r][j].x * v[r][j].x + v[r][j].y * v[r][j].y) + (v[r][j].z * v[r][j].z + v[r][j].w * v[r][j].w); }
        const float rstd = rsqrtf(wave_sum(s2) * (1.f / DM) + LN_EPS);
        unsigned long long* o8 = (unsigned long long*)(H1p + (size_t)m * DM) + lane;
        float gp[8];
#pragma unroll
        for (int g = 0; g < 8; ++g) gp[g] = 0.f;
        const LAS float* wl = wif + 4 * lane; asm volatile("" : "+v"(wl));
#pragma unroll
        for (int j = 0; j < 4; ++j) { const f32x4 hh = v[r][j] * rstd * (scv[r][j] + 1.0f) + shv[r][j];
            o8[64 * j] = (unsigned long long)pk2(hh.x, hh.y) | ((unsigned long long)pk2(hh.z, hh.w) << 32);
#pragma unroll
            for (int g = 0; g < 8; ++g) { const f32x4 w = *(const LAS f32x4*)(wl + g * 1024 + 256 * j); gp[g] += (hh.x * w.x + hh.y * w.y) + (hh.z * w.z + hh.w * w.w); } }
#pragma unroll
        for (int g = 0; g < 8; ++g) gp[g] = wave_sum(gp[g]);
        if (lane == 0) {
#pragma unroll
            for (int g = 0; g < 8; ++g) GIFp[(size_t)m * 8 + g] = gp[g] + bif[g]; } }
}
DI void p7_rows2(int m0, int m1, int lane, const float* __restrict__ Rp, const float* __restrict__ MODp, const float* __restrict__ g1, const float* __restrict__ b1,
                 float* __restrict__ X1p, bf16_t* __restrict__ H2p, unsigned char* __restrict__ H2Qp, float* __restrict__ SHp) {
    f32x4 v[2][4], scv[2][4], shv[2][4];
#pragma unroll
    for (int r = 0; r < 2; ++r) { const int m = r ? m1 : m0; const int b = m / SEQ;
        const f32x4* rr = (const f32x4*)(Rp + (size_t)m * DM) + lane; const f32x4* sh = (const f32x4*)(MODp + (size_t)b * MODW + 3 * DM) + lane; const f32x4* sc = (const f32x4*)(MODp + (size_t)b * MODW + 4 * DM) + lane;
#pragma unroll
        for (int j = 0; j < 4; ++j) { v[r][j] = rr[64 * j]; scv[r][j] = sc[64 * j]; shv[r][j] = sh[64 * j]; } }
#pragma unroll
    for (int r = 0; r < 2; ++r) { const int m = r ? m1 : m0; float s = 0.f;
#pragma unroll
        for (int j = 0; j < 4; ++j) s += (v[r][j].x + v[r][j].y) + (v[r][j].z + v[r][j].w);
        float mean = wave_sum(s) * (1.f / DM); float s2 = 0.f;
#pragma unroll
        for (int j = 0; j < 4; ++j) { v[r][j] = v[r][j] - mean; s2 += (v[r][j].x * v[r][j].x + v[r][j].y * v[r][j].y) + (v[r][j].z * v[r][j].z + v[r][j].w * v[r][j].w); }
        float rstd = rsqrtf(wave_sum(s2) * (1.f / DM) + LN_EPS);
        f32x4* xo = (f32x4*)(X1p + (size_t)m * DM) + lane; s = 0.f;
#pragma unroll
        for (int j = 0; j < 4; ++j) { v[r][j] = v[r][j] * rstd * ((const f32x4*)g1)[lane + 64 * j] + ((const f32x4*)b1)[lane + 64 * j]; xo[64 * j] = v[r][j]; s += (v[r][j].x + v[r][j].y) + (v[r][j].z + v[r][j].w); }
        mean = wave_sum(s) * (1.f / DM); s2 = 0.f;
#pragma unroll
        for (int j = 0; j < 4; ++j) { v[r][j] = v[r][j] - mean; s2 += (v[r][j].x * v[r][j].x + v[r][j].y * v[r][j].y) + (v[r][j].z * v[r][j].z + v[r][j].w * v[r][j].w); }
        rstd = rsqrtf(wave_sum(s2) * (1.f / DM) + LN_EPS);
        unsigned long long* o8 = (unsigned long long*)(H2p + (size_t)m * DM) + lane;
        float amax = 0.f;
#pragma unroll
        for (int j = 0; j < 4; ++j) { const f32x4 hh = v[r][j] * rstd * (scv[r][j] + 1.0f) + shv[r][j]; o8[64 * j] = (unsigned long long)pk2(hh.x, hh.y) | ((unsigned long long)pk2(hh.z, hh.w) << 32);
            v[r][j] = hh; amax = fmaxf(amax, fmaxf(fmaxf(fabsf(hh.x), fabsf(hh.y)), fmaxf(fabsf(hh.z), fabsf(hh.w)))); }
#pragma unroll
        for (int o = 1; o < 64; o <<= 1) amax = fmaxf(amax, __shfl_xor(amax, o));
        const float qinv = amax > 0.f ? 127.0f / amax : 0.f;
        unsigned* q4 = (unsigned*)(H2Qp + (size_t)m * DM) + lane;
#pragma unroll
        for (int j = 0; j < 4; ++j) { const int q0 = (int)rintf(v[r][j].x * qinv), q1 = (int)rintf(v[r][j].y * qinv), q2 = (int)rintf(v[r][j].z * qinv), q3 = (int)rintf(v[r][j].w * qinv);
            q4[64 * j] = (unsigned)(q0 & 255) | ((unsigned)(q1 & 255) << 8) | ((unsigned)(q2 & 255) << 16) | ((unsigned)(q3 & 255) << 24); }
        if (lane == 0) SHp[m] = amax * (1.0f / 127.0f); }
}

struct Args { const float* in[22]; float* out; unsigned char* ws; int ph_lo, ph_hi; };

__global__ void __launch_bounds__(NWAVES * 64, 2) mega_fwd(Args args) {
    extern __shared__ __attribute__((aligned(16))) unsigned char lds_raw[];
    LAS unsigned char* lds = (LAS unsigned char*)lds_raw;
    volatile LAS unsigned* MISC = (volatile LAS unsigned*)(lds + MISC_OFF);
    const int tid = threadIdx.x, lane = tid & 63, wave = __builtin_amdgcn_readfirstlane(tid >> 6);
    const int G = gridDim.x; const int bx = blockIdx.x; const int vcu = (G % 8 == 0) ? (bx % 8) * (G / 8) + bx / 8 : bx;
    const int gw = vcu * NWAVES + wave, NGW = G * NWAVES;
#define ws (args.ws)
#define ctl ((unsigned*)(ws + WS_CTL))
#define x_in (args.in[0])
#define cvec (args.in[1])
#define w_ada (args.in[2])
#define b_ada (args.in[3])
#define w_in (args.in[4])
#define b_if (args.in[5])
#define conv_w (args.in[6])
#define conv_b (args.in[7])
#define da_lambda (args.in[8])
#define da_subln_g (args.in[9])
#define ml_norm_g (args.in[10])
#define w_br_attn (args.in[11])
#define w_br_mlstm (args.in[12])
#define w_out (args.in[13])
#define ln1_g (args.in[14])
#define ln1_b (args.in[15])
#define peer_wq (args.in[16])
#define peer_keys (args.in[17])
#define peer_u (args.in[18])
#define peer_v (args.in[19])
#define ln2_g (args.in[20])
#define ln2_b (args.in[21])
#define MOD ((float*)(ws + WS_MOD))
#define GIF ((float*)(ws + WS_GIF))
#define WIN ((bf16_t*)(ws + WS_WIN))
#define WA ((bf16_t*)(ws + WS_WA))
#define WM ((bf16_t*)(ws + WS_WM))
#define WOUT ((bf16_t*)(ws + WS_WOUT))
#define WQ ((bf16_t*)(ws + WS_WQ))
#define UT8 ((unsigned char*)(ws + WS_U))
#define VT8 ((unsigned char*)(ws + WS_V))
#define SUS ((float*)(ws + WS_SU))
#define SVS ((float*)(ws + WS_SV))
#define SHS ((float*)(ws + WS_SH))
#define CSS ((float*)(ws + WS_CS))
#define H2Q ((unsigned char*)(ws + WS_H2Q))
#define SELE ((bf16_t*)(ws + WS_SELE))
#define SELG ((float*)(ws + WS_SELG))
#define PART ((float*)(ws + WS_PART))
#define COEF ((signed char*)(ws + WS_COEF))
#define H1 ((bf16_t*)(ws + WS_H1))
#define Z ((bf16_t*)(ws + WS_Z))
#define R ((float*)(ws + WS_R))
#define X1 ((float*)(ws + WS_X1))
#define H2 ((bf16_t*)(ws + WS_H2))
#define QP ((bf16_t*)(ws + WS_QP))
#define GATES ((bf16_t*)args.out)

    for (int u = tid; u < (LDS_BYTES - MISC_OFF) / 4; u += NWAVES * 64) MISC[u] = 0u;
    __syncthreads();
    XcdBarrier bar; bar.bar = ctl + CW_BAR; bar.x = 0; bar.st = nullptr;
    if (MK_N_LAUNCHES != N_PHASES) bar = xcd_barrier_post(ctl + CW_BAR, MISC + 8);
    const int lo = args.ph_lo, hi = args.ph_hi;
#ifndef PH_MASK
#define PH_MASK 0x3fff
#endif
#define IN(k) (((PH_MASK >> (k)) & 1) && lo <= (k) && (k) < hi)
#define SEAM(k) do { if (IN(k) && IN((k) + 1)) xcd_barrier(bar); } while (0)

    if (IN(0)) {
        for (int it = gw; it < 96 * 8; it += NGW) {
            const int cb = it % 96, ks = it / 96, col = 64 * cb + lane;
            float acc[32];
#pragma unroll
            for (int b = 0; b < 32; ++b) acc[b] = 0.f;
            for (int k = 128 * ks; k < 128 * ks + 128; ++k) { const float w = w_ada[(size_t)k * MODW + col];
#pragma unroll
                for (int b = 0; b < 32; ++b) acc[b] += siluf_(cvec[b * DM + k]) * w; }
            const float bias = (ks == 0) ? b_ada[col] : 0.f;
#pragma unroll
            for (int b = 0; b < 32; ++b) atomicAdd(MOD + b * MODW + col, acc[b] + bias);
        }
        LAS float* scr = (LAS float*)(lds + wave * 16384);
        for (int it = gw; it < 4096 + 4 * 512; it += NGW) {
            if (it < 4096) { const int kb = it / 256, nb = it % 256, n0 = 32 * nb; p0_transpose_item(w_in, IN_W, n0 < NZ ? n0 : n0 + 8, WIN, DM, n0, kb, n0 < 1024 ? QSCALE : 1.0f, scr, lane); }
            else { const int r = it - 4096, wsel = r / 512, q = r % 512, kb = q / 32, nb = q % 32;
                const float* src = wsel == 0 ? w_br_attn : wsel == 1 ? w_br_mlstm : wsel == 2 ? w_out : peer_wq; bf16_t* dst = wsel == 0 ? WA : wsel == 1 ? WM : wsel == 2 ? WOUT : WQ;
                p0_transpose_item(src, DM, 32 * nb, dst, DM, 32 * nb, kb, 1.0f, scr, lane); }
        }
        for (int row = gw; row < 2 * NEXP; row += NGW) {
            const bool second = row >= NEXP; const int e = second ? row - NEXP : row;
            const float* s = (second ? peer_v : peer_u) + (size_t)e * DM + 16 * lane;
            f32x4 a[4]; float amax = 0.f;
#pragma unroll
            for (int j = 0; j < 4; ++j) { a[j] = *(const f32x4*)(s + 4 * j); amax = fmaxf(amax, fmaxf(fmaxf(fabsf(a[j].x), fabsf(a[j].y)), fmaxf(fabsf(a[j].z), fabsf(a[j].w)))); }
#pragma unroll
            for (int o = 1; o < 64; o <<= 1) amax = fmaxf(amax, __shfl_xor(amax, o));
            const float inv = amax > 0.f ? 127.0f / amax : 0.f; const int bias = 0;
            u32x4 w;
#pragma unroll
            for (int j = 0; j < 4; ++j) { const int q0 = (int)rintf(a[j].x * inv) + bias, q1 = (int)rintf(a[j].y * inv) + bias, q2 = (int)rintf(a[j].z * inv) + bias, q3 = (int)rintf(a[j].w * inv) + bias;
                w[j] = (unsigned)(q0 & 255) | ((unsigned)(q1 & 255) << 8) | ((unsigned)(q2 & 255) << 16) | ((unsigned)(q3 & 255) << 24); }
            *(u32x4*)((second ? VT8 : UT8) + (size_t)(lane >> 3) * NEXP * 128 + (size_t)e * 128 + (lane & 7) * 16) = w;
            if (lane == 0) (second ? SVS : SUS)[e] = amax * (1.0f / 127.0f);
        }
    }
    SEAM(0);
    if (IN(1)) {
        LAS float* wif = (LAS float*)lds;
        for (int i = tid; i < 8192; i += 512) { const int k = i >> 3, j = i & 7; wif[j * 1024 + k] = w_in[(size_t)k * IN_W + NZ + j]; }
        __syncthreads();
        for (int m = gw; m < TOK; m += 2 * NGW) p1_rows2(m, m + NGW, lane, x_in, MOD, H1, GIF, b_if, wif);
    }
    SEAM(1);
#ifndef DUP2
#define DUP2 0
#endif
#ifndef DUP23
#define DUP23 0
#endif
#define P2_BODY if (IN(2)) { pg8::Gemm g{H1, WIN, TOK, NIN, DM, DM, DM}; pg8::StaticOrder S; S.init(TOK, NIN, G, bx); pg8::EpiZ E{Z, GATES}; \
        pg8::gemm_phase<pg8::EpiZ, pg8::StaticOrder, true, true>(lds, g, S, E); }
#define P3_BODY(QOFF) if (IN(3)) { unsigned* qhead = ctl + CW_QUEUE + (QOFF); \
        for (;;) { __syncthreads(); if (tid == 0) MISC[0] = __hip_atomic_fetch_add(qhead, 1u, RLX_AGENT); __syncthreads(); \
            const int id = (int)MISC[0]; if (id >= 128 + 2048) break; \
            if (id < 128) mls::mlstm_unit<false>(lds, Z, GIF, conv_w, conv_b, ml_norm_g, id >> 2, id & 3); \
            else { const int idx = id - 128, qb = 7 - idx / 256, bh = idx % 256; datt::attn_unit<false>(lds, Z, da_lambda, da_subln_g, bh >> 3, bh & 7, qb); } } }
#define P3A_DRY(QOFF) if (IN(3)) { unsigned* qhead = ctl + CW_QUEUE + (QOFF); \
        for (;;) { __syncthreads(); if (tid == 0) MISC[0] = __hip_atomic_fetch_add(qhead, 1u, RLX_AGENT); __syncthreads(); \
            const int id = (int)MISC[0]; if (id >= 2048) break; \
            { const int idx = id, qb = 7 - idx / 256, bh = idx % 256; datt::attn_unit<true>(lds, Z, da_lambda, da_subln_g, bh >> 3, bh & 7, qb); } } }
#define P3M_DRY(QOFF) if (IN(3)) { unsigned* qhead = ctl + CW_QUEUE + (QOFF); \
        for (;;) { __syncthreads(); if (tid == 0) MISC[0] = __hip_atomic_fetch_add(qhead, 1u, RLX_AGENT); __syncthreads(); \
            const int id = (int)MISC[0]; if (id >= 128) break; \
            mls::mlstm_unit<true>(lds, Z, GIF, conv_w, conv_b, ml_norm_g, id >> 2, id & 3); } }
#ifndef DRY3A
#define DRY3A 0
#endif
#ifndef DRY3M
#define DRY3M 0
#endif
    P2_BODY
#if DUP2
    SEAM(2);
    P2_BODY
#endif
    SEAM(2);
#if DRY3A
    P3A_DRY(128)
    if (IN(3)) xcd_barrier(bar);
#endif
#if DRY3M
    P3M_DRY(192)
    if (IN(3)) xcd_barrier(bar);
#endif
    P3_BODY(0)
    SEAM(3);
#if DUP23
    P2_BODY
    SEAM(2);
    P3_BODY(64)
    SEAM(3);
#endif
    if (IN(4)) {
        pg8::Gemm g{Z + ZC_Q, WA, TOK, DM, DM, NZ, DM}; pg8::StaticOrder S; S.init(TOK, DM, G, bx);
        pg8::EpiGate<true> E{GATES, H1};
        pg8::gemm_phase<pg8::EpiGate<true>, pg8::StaticOrder, true, true>(lds, g, S, E);
    }
    SEAM(4);
    if (IN(5)) {
        pg8::Gemm g{Z + ZC_MV, WM, TOK, DM, DM, NZ, DM}; pg8::StaticOrder S; S.init(TOK, DM, G, bx);
        pg8::EpiGate<false> E{GATES + DM, H1};
        pg8::gemm_phase<pg8::EpiGate<false>, pg8::StaticOrder, true, true>(lds, g, S, E);
    }
    SEAM(5);
    if (IN(6)) {
        pg8::Gemm g{H1, WOUT, TOK, DM, DM, DM, DM}; pg8::StaticOrder S; S.init(TOK, DM, G, bx);
        pg8::EpiR E{x_in, MOD, R};
        pg8::gemm_phase<pg8::EpiR, pg8::StaticOrder, true, true>(lds, g, S, E);
    }
    SEAM(6);
    if (IN(7)) {
        for (int m = gw; m < TOK; m += 2 * NGW) p7_rows2(m, m + NGW, lane, R, MOD, ln1_g, ln1_b, X1, H2, H2Q, SHS);
    }
    SEAM(7);
    if (IN(8)) {
        pg8::Gemm g{H2, WQ, TOK, DM, DM, DM, DM}; pg8::StaticOrder S; S.init(TOK, DM, G, bx);
        pg8::EpiStore E{QP};
        pg8::gemm_phase<pg8::EpiStore, pg8::StaticOrder, true, true>(lds, g, S, E);
    }
    SEAM(8);
    if (IN(9)) {
        peer::stage_keys(lds, peer_keys);
        __syncthreads();
        for (int tile = bx; tile < TOK / 32; tile += G) peer::select_tile(lds, QP, tile * 32, SELE, SELG);
    }
    SEAM(9);
    int sx = bx % 8, sr = bx / 8, sn = (G - sx + 7) / 8;
    if (IN(10) || IN(12)) {
        __syncthreads();
        if (tid == 0) { bool phys = (MK_N_LAUNCHES != N_PHASES) && lo == 0 && hi > 10; unsigned mine = 0;
            if (phys) { for (unsigned j = 0; j < 16; ++j) { const unsigned c = xb_ld(&bar.bar[XB_XCNT(j)]); if (j < 8) { if (c == 0u) phys = false; if (j == bar.x) mine = c; } else if (c != 0u) phys = false; } }
            MISC[16] = phys ? bar.x : (unsigned)sx; MISC[17] = phys ? MISC[10] : (unsigned)sr; MISC[18] = phys ? mine : (unsigned)sn; }
        __syncthreads();
        sx = (int)MISC[16]; sr = (int)MISC[17]; sn = (int)MISC[18];
    }
    if (IN(10)) {
        for (int tile = sr; tile < TOK / 32; tile += sn) { __syncthreads(); peer::u_phase_tile(lds, tile, sx, SELE, H2Q, UT8, PART); }
    }
    SEAM(10);
    if (IN(11)) { for (int m = 4 * gw; m < TOK; m += 4 * NGW) peer::red_tokens4((size_t)m, PART, SELE, SELG, SUS, SVS, SHS, COEF, CSS); }
    SEAM(11);
    if (IN(12)) {
        for (int tile = sr; tile < TOK / 32; tile += sn) { __syncthreads(); peer::v_phase_tile(lds, tile, sx, SELE, COEF, CSS, VT8, args.out); }
    }
    SEAM(12);
    if (IN(13)) { for (int m = gw; m < TOK; m += 2 * NGW) peer::final_rows2((size_t)m, (size_t)m + NGW, args.out, X1, MOD, ln2_g, ln2_b); }
#undef IN
#undef SEAM
#undef ws
#undef ctl
#undef x_in
#undef cvec
#undef w_ada
#undef b_ada
#undef w_in
#undef b_if
#undef conv_w
#undef conv_b
#undef da_lambda
#undef da_subln_g
#undef ml_norm_g
#undef w_br_attn
#undef w_br_mlstm
#undef w_out
#undef ln1_g
#undef ln1_b
#undef peer_wq
#undef peer_keys
#undef peer_u
#undef peer_v
#undef ln2_g
#undef ln2_b
#undef MOD
#undef GIF
#undef WIN
#undef WA
#undef WM
#undef WOUT
#undef WQ
#undef UT8
#undef VT8
#undef SUS
#undef SVS
#undef SHS
#undef CSS
#undef H2Q
#undef SELE
#undef SELG
#undef PART
#undef COEF
#undef H1
#undef Z
#undef R
#undef X1
#undef H2
#undef QP
#undef GATES
}

extern "C" void kernel_launch(void* const* d_in, const int* in_sizes, int n_in, void* d_out, int out_size, void* d_ws, size_t ws_size, hipStream_t stream) {
    static int grid = 0;
    if (grid == 0) {
        if (n_in != 22 || in_sizes[0] != TOK * DM || out_size != TOK * DM || ws_size < WS_END) { fprintf(stderr, "kernel_launch: unexpected shapes (n_in %d, in0 %d, out %d, ws %zu; need ws >= %zu)\n", n_in, n_in > 0 ? in_sizes[0] : -1, out_size, ws_size, (size_t)WS_END); grid = -1; return; }
        int dev = 0, cus = 0, per_cu = 0;
        if (hipGetDevice(&dev) != hipSuccess || hipDeviceGetAttribute(&cus, hipDeviceAttributeMultiprocessorCount, dev) != hipSuccess) { fprintf(stderr, "kernel_launch: device query failed\n"); grid = -1; return; }
        if (hipFuncSetAttribute((const void*)mega_fwd, hipFuncAttributeMaxDynamicSharedMemorySize, LDS_BYTES) != hipSuccess) { fprintf(stderr, "kernel_launch: hipFuncSetAttribute failed\n"); grid = -1; return; }
        if (hipOccupancyMaxActiveBlocksPerMultiprocessor(&per_cu, (const void*)mega_fwd, NWAVES * 64, LDS_BYTES) != hipSuccess || per_cu < 1) fprintf(stderr, "kernel_launch: note: occupancy query reports %d workgroups per CU\n", per_cu);
        (void)hipGetLastError();
        grid = cus;
    }
    if (grid < 0) return;
    if (hipMemsetAsync((char*)d_ws + WS_CTL, 0, CTL_ZERO_BYTES, stream) != hipSuccess) { fprintf(stderr, "kernel_launch: memset failed\n"); return; }
    Args a{};
    for (int i = 0; i < 22; ++i) a.in[i] = (const float*)d_in[i];
    a.out = (float*)d_out; a.ws = (unsigned char*)d_ws;
    for (int li = 0; li < MK_N_LAUNCHES; ++li) {
        a.ph_lo = (MK_N_LAUNCHES == N_PHASES) ? li : 0; a.ph_hi = (MK_N_LAUNCHES == N_PHASES) ? li + 1 : N_PHASES;
        hipLaunchKernelGGL(mega_fwd, dim3(grid), dim3(NWAVES * 64), LDS_BYTES, stream, a);
        const hipError_t le = hipPeekAtLastError();
        if (le != hipSuccess) { fprintf(stderr, "kernel_launch: launch %d failed: %s\n", li, hipGetErrorName(le)); break; }
    }
}
```

```cpp
#include <hip/hip_runtime.h>
#include <hip/hip_bf16.h>
#include <cstdio>
#include <cstdint>
#include <cmath>

#define LAS __attribute__((address_space(3)))
#define GAS __attribute__((address_space(1)))
typedef unsigned short bf16_t;
typedef short bf16x8 __attribute__((ext_vector_type(8)));
typedef short s16x4 __attribute__((ext_vector_type(4)));
typedef float f32x2 __attribute__((ext_vector_type(2)));
typedef float f32x4 __attribute__((ext_vector_type(4)));
typedef float f32x16 __attribute__((ext_vector_type(16)));
typedef unsigned u32x2 __attribute__((ext_vector_type(2)));
typedef unsigned u32x4 __attribute__((ext_vector_type(4)));
typedef __bf16 bf16x2_t __attribute__((ext_vector_type(2)));
#define DI __device__ __forceinline__

constexpr int BATCH = 32, SEQ = 2048, DM = 1024, TOK = BATCH * SEQ;
constexpr int NZ = 6144;
constexpr int ZC_Q = 0, ZC_K = 1024, ZC_V = 2048, ZC_MQ = 3072, ZC_MK = 3584, ZC_MV = 4096, ZC_MO = 5120;
constexpr int NGATE = 2048;
constexpr int NIN = 8192;
constexpr int IN_W = 8200;
constexpr int MODW = 6 * DM;
constexpr float LN_EPS = 1e-5f;
constexpr float ALPHA_RES = 1.189207115002721f;
constexpr float LAMBDA_INIT = 0.2f;
constexpr float QSCALE = 0.125f * 1.4426950408889634f;
constexpr int NEXP = 16384;

constexpr size_t MiB = 1u << 20;
constexpr size_t WS_CTL = 0, CTL_ZERO_BYTES = 2 * MiB;
constexpr size_t WS_MOD = 1 * MiB;
constexpr size_t WS_GIF = 3 * MiB;
constexpr size_t WS_WIN = 6 * MiB;
constexpr size_t WS_WA = 22 * MiB, WS_WM = 24 * MiB, WS_WOUT = 26 * MiB, WS_WQ = 28 * MiB;
constexpr size_t WS_U = 30 * MiB, WS_V = 62 * MiB;
constexpr size_t WS_SU = 2 * MiB, WS_SV = 2 * MiB + 65536, WS_SH = 2 * MiB + 131072, WS_CS = 2 * MiB + 393216;
constexpr size_t WS_H2Q = 96 * MiB, WS_SELE = 160 * MiB, WS_SELG = 176 * MiB;
constexpr size_t WS_H1 = 96 * MiB;
constexpr size_t WS_Z = 224 * MiB;
constexpr size_t WS_R = WS_Z, WS_X1 = WS_Z + 256 * MiB, WS_H2 = WS_Z + 512 * MiB, WS_QP = WS_Z + 640 * MiB;
constexpr size_t WS_PART = WS_R, WS_COEF = WS_H2;
constexpr size_t WS_END = 992 * MiB;
constexpr int CW_BAR = 4096;
constexpr int CW_QUEUE = 16384;

DI unsigned pk2(float lo, float hi) { f32x2 v = {lo, hi}; bf16x2_t b = __builtin_convertvector(v, bf16x2_t); return __builtin_bit_cast(unsigned, b); }
DI float bf_lo(unsigned u) { return __uint_as_float(u << 16); }
DI float bf_hi(unsigned u) { return __uint_as_float(u & 0xffff0000u); }
DI float bf2f(bf16_t h) { return __uint_as_float(((unsigned)h) << 16); }
DI float wave_sum(float v) {
#pragma unroll
    for (int o = 1; o < 64; o <<= 1) v += __shfl_xor(v, o);
    return v;
}
DI float sigmoidf_(float x) { return 1.0f / (1.0f + __expf(-x)); }
DI float siluf_(float x) { return x / (1.0f + __expf(-x)); }
DI int crow(int r, int hi) { return (r & 3) + 8 * (r >> 2) + 4 * hi; }
#define MFMA32(a, b, c) __builtin_amdgcn_mfma_f32_32x32x16_bf16((a), (b), (c), 0, 0, 0)
DI bf16x8 pack_step(const f32x16& x, int s) {
    u32x4 p;
    p[0] = pk2(x[8 * s + 0], x[8 * s + 1]); p[1] = pk2(x[8 * s + 2], x[8 * s + 3]); p[2] = pk2(x[8 * s + 4], x[8 * s + 5]); p[3] = pk2(x[8 * s + 6], x[8 * s + 7]);
    return __builtin_bit_cast(bf16x8, p);
}
DI unsigned off_b(unsigned row, unsigned ch) { return 256u * row + 16u * (ch ^ (((row & 3) << 2) | ((row >> 2) & 3))); }
DI unsigned row_read_addr(unsigned lane, unsigned rt, unsigned s) { return off_b(32 * rt + (lane & 31), 2 * s + (lane >> 5)); }
DI unsigned tr_read_addr(unsigned lane, unsigned c, unsigned ks, unsigned t) {
    const unsigned h = lane >> 5, blk = (lane >> 4) & 1, q = (lane & 15) >> 2, p = lane & 3;
    return off_b(16 * ks + 8 * h + 4 * t + q, 4 * c + 2 * blk + (p >> 1)) + 8 * (p & 1);
}
DI unsigned tr_base(unsigned lane, unsigned t) { const unsigned h = lane >> 5, blk = (lane >> 4) & 1, q = (lane & 15) >> 2, p = lane & 3, cl = 2 * blk + (p >> 1);
    return 256u * (8 * h + 4 * t + q) + 16u * (cl ^ (2 * h + t)) + 8u * (p & 1); }
#define OPAQUE(x) asm volatile("" : "+v"(x))
#define OPAQUE(x) asm volatile("" : "+v"(x))
typedef short v4i16_t __attribute__((ext_vector_type(4)));
DI s16x4 tr_read(const LAS unsigned char* p) { return __builtin_bit_cast(s16x4, __builtin_amdgcn_ds_read_tr16_b64_v4i16((LAS v4i16_t*)p)); }
DI bf16x8 cat8(s16x4 lo, s16x4 hi) { return __builtin_shufflevector(lo, hi, 0, 1, 2, 3, 4, 5, 6, 7); }
namespace pg8 {
#define PG8_LAS __attribute__((address_space(3)))
typedef unsigned short bf16_t;
typedef short bf16x8 __attribute__((ext_vector_type(8)));
typedef float f32x4 __attribute__((ext_vector_type(4)));
typedef unsigned u32x4 __attribute__((ext_vector_type(4)));
constexpr int BM = 256, BK = 64, HALF = 128, HTB = HALF * BK * 2  , STAGE_BYTES = 8 * HTB, NXCD = 8, WGM = 8;

__host__ __device__ __forceinline__ int lds_byte(int r, int c) { const int st = (r >> 4) * 2 + (c >> 5), rr = r & 15, cc = c & 31, ob = rr * 64 + cc * 2; return st * 1024 + (ob ^ (((ob >> 9) & 1) << 5)); }
__host__ __device__ __forceinline__ void stage_rc(int b, int& R, int& C) { const int st = b / 1024, sb = b % 1024, swz = sb ^ (((sb >> 9) & 1) << 5); R = (st >> 1) * 16 + swz / 64; C = (st & 1) * 32 + (swz % 64) / 2; }
__host__ __device__ __forceinline__ int perm32(int rho) { const int n = rho >> 4, i = rho & 15; return 8 * (i >> 2) + 4 * n + (i & 3); }

struct Unit { int pm, pn; };
struct Gemm { const bf16_t* A; const bf16_t* Bt; int M, N, K, lda, ldb; };

struct StaticOrder {
    int nM, nN, nwg, G, c;
    __host__ __device__ void init(int M, int N, int G_, int c_) { nM = M / BM; nN = N / BM; nwg = nM * nN; G = G_; c = c_; }
    __host__ __device__ bool next(int i, Unit& u) const {
        const long L = (long)i * G + c; if (L >= nwg) return false;
        int wgid = (int)L; { const int q = nwg / NXCD, r = nwg % NXCD, xcd = wgid % NXCD, off = wgid / NXCD; wgid = (xcd < r ? xcd * (q + 1) : r * (q + 1) + (xcd - r) * q) + off; }
        const int nig = WGM * nN, gid = wgid / nig, fm = gid * WGM, gsz = (nM - fm) < WGM ? (nM - fm) : WGM;
        u.pm = fm + ((wgid % nig) % gsz); u.pn = (wgid % nig) / gsz; return true;
    }
    __device__ __forceinline__ void a_ready(const Unit&) const {}
    __device__ __forceinline__ void done(const Unit&) const {}
};

template <class Epi, class Sched, bool ALIGN_EPI = false, bool SP2 = false>
__device__ __forceinline__ void gemm_phase(PG8_LAS unsigned char* lds, const Gemm g, const Sched& S, const Epi& E) {
    const int tid = threadIdx.x, wid = __builtin_amdgcn_readfirstlane(tid >> 6), lane = tid & 63, wr = wid >> 2, wc = wid & 3, fr = lane & 15, fq = lane >> 4;
    const int K = g.K, nt = K / BK;
    unsigned voffA[2], voffB[2];
#pragma unroll
    for (int i = 0; i < 2; ++i) { int R, C; stage_rc(tid * 16 + i * 8192, R, C); const int Rb = Epi::PERM ? ((R & ~31) + perm32(R & 31)) : R;
        voffA[i] = (unsigned)(R * g.lda + C) * 2u; voffB[i] = (unsigned)(Rb * g.ldb + C) * 2u; }
    const size_t kstep = (size_t)(BK * 2);
    const size_t hstepA = (size_t)HALF * g.lda * 2, hstepB = (size_t)HALF * g.ldb * 2;
    const size_t tstepA = 2 * hstepA, tstepB = 2 * hstepB;
    const unsigned ldsw = (unsigned)wid * 1024u;
    const int aoff = lds_byte(wr * 64 + fr, fq * 8), boff = lds_byte(wc * 32 + fr, fq * 8);
#define PG8_SA(b, h) (((b) * 2 + (h)) * HTB)
#define PG8_SB(b, h) ((4 + (b) * 2 + (h)) * HTB)
#define PG8_STAGE(bufoff, gbase, voff) do { _Pragma("unroll") for (int _i = 0; _i < 2; ++_i) \
        __builtin_amdgcn_global_load_lds((const unsigned*)((const char*)(gbase) + (voff)[_i]), (PG8_LAS unsigned*)(lds + (bufoff) + ldsw + _i * 8192), 16, 0, 0); } while (0)
#define PG8_LDA(dst, b, h) do { _Pragma("unroll") for (int m = 0; m < 4; ++m) _Pragma("unroll") for (int k = 0; k < 2; ++k) dst[m][k] = *(const PG8_LAS bf16x8*)(lds + PG8_SA(b, h) + aoff + m * 2048 + k * 1024); } while (0)
#define PG8_LDB(dst, b, h) do { _Pragma("unroll") for (int n = 0; n < 2; ++n) _Pragma("unroll") for (int k = 0; k < 2; ++k) dst[n][k] = *(const PG8_LAS bf16x8*)(lds + PG8_SB(b, h) + boff + n * 2048 + k * 1024); } while (0)
#define PG8_MMA(ai, bj, At, Bt) do { __builtin_amdgcn_s_setprio(1); _Pragma("unroll") for (int m = 0; m < 4; ++m) _Pragma("unroll") for (int n = 0; n < 2; ++n) _Pragma("unroll") for (int k = 0; k < 2; ++k) \
        acc[ai][bj][m][n] = __builtin_amdgcn_mfma_f32_16x16x32_bf16(Bt[n][k], At[m][k], acc[ai][bj][m][n], 0, 0, 0); __builtin_amdgcn_s_setprio(0); } while (0)
#define PG8_WAIT_V(n) asm volatile("s_waitcnt vmcnt(" #n ")" ::: "memory")
#define PG8_WAIT_L(n) asm volatile("s_waitcnt lgkmcnt(" #n ")" ::: "memory")
#define PG8_BAR __builtin_amdgcn_s_barrier()
#define PG8_SCHED __builtin_amdgcn_sched_barrier(0)
    Unit cur, nxt; int ui = 0;
    if (!S.next(0, cur)) return;
    f32x4 acc[2][2][4][2];
#pragma unroll
    for (int a = 0; a < 2; ++a)
#pragma unroll
        for (int b = 0; b < 2; ++b)
#pragma unroll
            for (int m = 0; m < 4; ++m)
#pragma unroll
                for (int n = 0; n < 2; ++n) acc[a][b][m][n] = (f32x4){0.f, 0.f, 0.f, 0.f};
    bf16x8 At[4][2], B0[2][2], B1[2][2];
    const char* cA = (const char*)g.A + (size_t)cur.pm * tstepA; const char* cB = (const char*)g.Bt + (size_t)cur.pn * tstepB;
    S.a_ready(cur);
    if constexpr (SP2) {
        PG8_STAGE(PG8_SB(0, 0), cB, voffB); PG8_STAGE(PG8_SB(0, 1), cB + hstepB, voffB); PG8_STAGE(PG8_SA(0, 0), cA, voffA); PG8_STAGE(PG8_SA(0, 1), cA + hstepA, voffA);
        if (wr == 1) PG8_BAR;
        PG8_WAIT_V(2); PG8_BAR;
        PG8_STAGE(PG8_SB(1, 0), cB + kstep, voffB); PG8_STAGE(PG8_SA(1, 0), cA + kstep, voffA); PG8_STAGE(PG8_SB(1, 1), cB + hstepB + kstep, voffB);
        PG8_WAIT_V(6); PG8_BAR;
    } else {
        PG8_STAGE(PG8_SB(0, 0), cB, voffB); PG8_STAGE(PG8_SA(0, 0), cA, voffA); PG8_STAGE(PG8_SB(0, 1), cB + hstepB, voffB); PG8_STAGE(PG8_SA(0, 1), cA + hstepA, voffA);
        if (wr == 1) PG8_BAR;
        PG8_WAIT_V(4); PG8_BAR;
        PG8_STAGE(PG8_SB(1, 0), cB + kstep, voffB); PG8_STAGE(PG8_SA(1, 0), cA + kstep, voffA); PG8_STAGE(PG8_SB(1, 1), cB + hstepB + kstep, voffB);
        PG8_WAIT_V(6); PG8_BAR;
    }
    for (;;) {
        const bool has_next = S.next(ui + 1, nxt);
        const char* nA = has_next ? (const char*)g.A + (size_t)nxt.pm * tstepA : cA; const char* nB = has_next ? (const char*)g.Bt + (size_t)nxt.pn * tstepB : cB;
        for (int t = 0; t < nt; t += 2) {
            const bool last = (t == nt - 2);
            const char* a1 = cA + (size_t)(t + 1) * kstep;
            const char* a2 = last ? nA : cA + (size_t)(t + 2) * kstep; const char* b2 = last ? nB : cB + (size_t)(t + 2) * kstep;
            const char* a3 = a2 + kstep; const char* b3 = b2 + kstep;
            if (last && has_next) S.a_ready(nxt);
            if constexpr (SP2) {
            PG8_LDB(B0, 0, 0); PG8_LDB(B1, 0, 1); PG8_SCHED; PG8_LDA(At, 0, 0); PG8_STAGE(PG8_SA(1, 1), a1 + hstepA, voffA);
            PG8_WAIT_V(8); PG8_WAIT_L(0); PG8_BAR; PG8_MMA(0, 0, At, B0); PG8_MMA(0, 1, At, B1); PG8_BAR; PG8_SCHED;
            PG8_LDA(At, 0, 1); PG8_STAGE(PG8_SB(0, 0), b2, voffB); PG8_STAGE(PG8_SB(0, 1), b2 + hstepB, voffB); PG8_STAGE(PG8_SA(0, 0), a2, voffA);
            PG8_WAIT_V(8); PG8_WAIT_L(0); PG8_BAR; PG8_MMA(1, 0, At, B0); PG8_MMA(1, 1, At, B1); PG8_BAR; PG8_SCHED;
            PG8_LDB(B0, 1, 0); PG8_LDB(B1, 1, 1); PG8_SCHED; PG8_LDA(At, 1, 0); PG8_STAGE(PG8_SA(0, 1), a2 + hstepA, voffA);
            PG8_WAIT_V(8); PG8_WAIT_L(0); PG8_BAR; PG8_MMA(0, 0, At, B0); PG8_MMA(0, 1, At, B1); PG8_BAR; PG8_SCHED;
            PG8_LDA(At, 1, 1); PG8_STAGE(PG8_SB(1, 0), b3, voffB); PG8_STAGE(PG8_SB(1, 1), b3 + hstepB, voffB); PG8_STAGE(PG8_SA(1, 0), a3, voffA);
            PG8_WAIT_V(8); PG8_WAIT_L(0); PG8_BAR; PG8_MMA(1, 0, At, B0); PG8_MMA(1, 1, At, B1); PG8_BAR; PG8_SCHED;
            } else {
            PG8_LDB(B0, 0, 0); PG8_SCHED; PG8_LDA(At, 0, 0); PG8_STAGE(PG8_SA(1, 1), a1 + hstepA, voffA);
            PG8_WAIT_L(8); PG8_BAR; PG8_WAIT_L(0); PG8_MMA(0, 0, At, B0); PG8_BAR; PG8_SCHED;
            PG8_LDB(B1, 0, 1); PG8_STAGE(PG8_SB(0, 0), b2, voffB);
            PG8_BAR; PG8_WAIT_L(0); PG8_MMA(0, 1, At, B1); PG8_BAR;
            PG8_LDA(At, 0, 1); PG8_STAGE(PG8_SA(0, 0), a2, voffA);
            PG8_BAR; PG8_WAIT_L(0); PG8_MMA(1, 0, At, B0); PG8_BAR; PG8_SCHED;
            PG8_STAGE(PG8_SB(0, 1), b2 + hstepB, voffB);
            PG8_WAIT_V(6); PG8_BAR; PG8_MMA(1, 1, At, B1); PG8_BAR;
            PG8_LDB(B0, 1, 0); PG8_SCHED; PG8_LDA(At, 1, 0); PG8_STAGE(PG8_SA(0, 1), a2 + hstepA, voffA);
            PG8_WAIT_L(8); PG8_BAR; PG8_WAIT_L(0); PG8_MMA(0, 0, At, B0); PG8_BAR; PG8_SCHED;
            PG8_LDB(B1, 1, 1); PG8_STAGE(PG8_SB(1, 0), b3, voffB);
            PG8_BAR; PG8_WAIT_L(0); PG8_MMA(0, 1, At, B1); PG8_BAR;
            PG8_LDA(At, 1, 1); PG8_STAGE(PG8_SA(1, 0), a3, voffA);
            PG8_BAR; PG8_WAIT_L(0); PG8_MMA(1, 0, At, B0); PG8_BAR; PG8_SCHED;
            PG8_STAGE(PG8_SB(1, 1), b3 + hstepB, voffB);
            PG8_WAIT_V(6); PG8_BAR; PG8_MMA(1, 1, At, B1); PG8_BAR;
            }
        }
        if constexpr (ALIGN_EPI) { if (wr == 0) PG8_BAR; }
        if constexpr (!Epi::AFTER_DRAIN) { E(acc, cur, wr, wc, fr, fq); S.done(cur); }
        if (!has_next) break;
#pragma unroll
        for (int a = 0; a < 2; ++a)
#pragma unroll
            for (int b = 0; b < 2; ++b)
#pragma unroll
                for (int m = 0; m < 4; ++m)
#pragma unroll
                    for (int n = 0; n < 2; ++n) acc[a][b][m][n] = (f32x4){0.f, 0.f, 0.f, 0.f};
        cur = nxt; cA = nA; cB = nB; ++ui;
        if constexpr (ALIGN_EPI) { if (wr == 1) PG8_BAR; }
    }
    PG8_WAIT_V(0);
    if constexpr (!ALIGN_EPI) { if (wr == 0) PG8_BAR; }
    PG8_BAR;
    if constexpr (Epi::AFTER_DRAIN) { E.fused(acc, cur, wr, wc, fr, fq, lds, wid, lane); S.done(cur); }
#undef PG8_SA
#undef PG8_SB
#undef PG8_STAGE
#undef PG8_LDA
#undef PG8_LDB
#undef PG8_MMA
#undef PG8_WAIT_V
#undef PG8_WAIT_L
#undef PG8_BAR
#undef PG8_SCHED
}
}
namespace pg8 {
struct EpiZ {
    static constexpr bool PERM = true, AFTER_DRAIN = false;
    bf16_t* Z; bf16_t* G;
    __device__ __forceinline__ void operator()(const f32x4 (&acc)[2][2][4][2], const Unit& u, int wr, int wc, int fr, int fq) const {
        const int row0 = u.pm * BM + wr * 64 + fr, colt = u.pn * BM; const bool gate = colt >= NZ;
        bf16_t* base = gate ? G : Z; const int ld = gate ? NGATE : NZ; const int col0 = (gate ? colt - NZ : colt) + wc * 32 + 8 * fq;
#pragma unroll
        for (int ai = 0; ai < 2; ++ai)
#pragma unroll
            for (int m = 0; m < 4; ++m) { bf16_t* rowp = base + (size_t)(row0 + ai * HALF + m * 16) * ld + col0;
#pragma unroll
                for (int bj = 0; bj < 2; ++bj) { f32x4 v0 = acc[ai][bj][m][0], v1 = acc[ai][bj][m][1];
                    if (gate) {
#pragma unroll
                        for (int e = 0; e < 4; ++e) { v0[e] = sigmoidf_(v0[e]); v1[e] = sigmoidf_(v1[e]); } }
                    ::u32x4 w; w.x = pk2(v0[0], v0[1]); w.y = pk2(v0[2], v0[3]); w.z = pk2(v1[0], v1[1]); w.w = pk2(v1[2], v1[3]);
                    *(::u32x4*)(rowp + bj * HALF) = w; } }
    }
};
template <bool FIRST> struct EpiGate {
    static constexpr bool PERM = true, AFTER_DRAIN = false;
    const bf16_t* G; bf16_t* Y;
    __device__ __forceinline__ void operator()(const f32x4 (&acc)[2][2][4][2], const Unit& u, int wr, int wc, int fr, int fq) const {
        const int row0 = u.pm * BM + wr * 64 + fr, col0 = u.pn * BM + wc * 32 + 8 * fq;
#pragma unroll
        for (int ai = 0; ai < 2; ++ai)
#pragma unroll
            for (int m = 0; m < 4; ++m) { const size_t row = (size_t)(row0 + ai * HALF + m * 16);
#pragma unroll
                for (int bj = 0; bj < 2; ++bj) { const f32x4 v0 = acc[ai][bj][m][0], v1 = acc[ai][bj][m][1];
                    const ::u32x4 g = *(const ::u32x4*)(G + row * NGATE + col0 + bj * HALF);
                    float o[8] = { bf_lo(g.x) * v0[0], bf_hi(g.x) * v0[1], bf_lo(g.y) * v0[2], bf_hi(g.y) * v0[3], bf_lo(g.z) * v1[0], bf_hi(g.z) * v1[1], bf_lo(g.w) * v1[2], bf_hi(g.w) * v1[3] };
                    bf16_t* yp = Y + row * DM + col0 + bj * HALF;
                    if (!FIRST) { const ::u32x4 y = *(const ::u32x4*)yp;
                        o[0] += bf_lo(y.x); o[1] += bf_hi(y.x); o[2] += bf_lo(y.y); o[3] += bf_hi(y.y); o[4] += bf_lo(y.z); o[5] += bf_hi(y.z); o[6] += bf_lo(y.w); o[7] += bf_hi(y.w); }
                    ::u32x4 w; w.x = pk2(o[0], o[1]); w.y = pk2(o[2], o[3]); w.z = pk2(o[4], o[5]); w.w = pk2(o[6], o[7]);
                    *(::u32x4*)yp = w; } }
    }
};
struct EpiR {
    static constexpr bool PERM = true, AFTER_DRAIN = false;
    const float* X; const float* MOD; float* R;
    __device__ __forceinline__ void operator()(const f32x4 (&acc)[2][2][4][2], const Unit& u, int wr, int wc, int fr, int fq) const {
        const int row0 = u.pm * BM + wr * 64 + fr, col0 = u.pn * BM + wc * 32 + 8 * fq;
        const float* gt = MOD + (size_t)((u.pm * BM) / SEQ) * MODW + 2 * DM;
        f32x4 g[2][2];
#pragma unroll
        for (int bj = 0; bj < 2; ++bj) { g[bj][0] = *(const f32x4*)(gt + col0 + bj * HALF); g[bj][1] = *(const f32x4*)(gt + col0 + bj * HALF + 4); }
#pragma unroll
        for (int ai = 0; ai < 2; ++ai)
#pragma unroll
            for (int m = 0; m < 4; ++m) { const size_t off = (size_t)(row0 + ai * HALF + m * 16) * DM + col0;
#pragma unroll
                for (int bj = 0; bj < 2; ++bj) {
                    const f32x4 x0 = *(const f32x4*)(X + off + bj * HALF), x1 = *(const f32x4*)(X + off + bj * HALF + 4);
                    *(f32x4*)(R + off + bj * HALF) = x0 * ALPHA_RES + g[bj][0] * acc[ai][bj][m][0];
                    *(f32x4*)(R + off + bj * HALF + 4) = x1 * ALPHA_RES + g[bj][1] * acc[ai][bj][m][1]; } }
    }
};
struct EpiStore {
    static constexpr bool PERM = true, AFTER_DRAIN = false;
    bf16_t* O;
    __device__ __forceinline__ void operator()(const f32x4 (&acc)[2][2][4][2], const Unit& u, int wr, int wc, int fr, int fq) const {
        const int row0 = u.pm * BM + wr * 64 + fr, col0 = u.pn * BM + wc * 32 + 8 * fq;
#pragma unroll
        for (int ai = 0; ai < 2; ++ai)
#pragma unroll
            for (int m = 0; m < 4; ++m) { bf16_t* rowp = O + (size_t)(row0 + ai * HALF + m * 16) * DM + col0;
#pragma unroll
                for (int bj = 0; bj < 2; ++bj) { const f32x4 v0 = acc[ai][bj][m][0], v1 = acc[ai][bj][m][1];
                    ::u32x4 w; w.x = pk2(v0[0], v0[1]); w.y = pk2(v0[2], v0[3]); w.z = pk2(v1[0], v1[1]); w.w = pk2(v1[2], v1[3]);
                    *(::u32x4*)(rowp + bj * HALF) = w; } }
    }
};
}
namespace datt {
constexpr int KROW = 144;
constexpr int KBUF = 64 * KROW, VBUF = 64 * 256, LDS_K = 0, LDS_V = 2 * KBUF, LDS_ST = LDS_V + 2 * VBUF, STROW = 272, ST_WAVE = 32 * STROW, LDS_BYTES = LDS_ST + 8 * ST_WAVE;
DI unsigned vrow(unsigned key) { return (key & ~12u) | ((key & 4u) << 1) | ((key & 8u) >> 1); }

template <bool DRY> DI void attn_unit(LAS unsigned char* lds, bf16_t* Z, const float* lam, const float* subln_g, int b, int h, int qb) {
    int tid_o = threadIdx.x; OPAQUE(tid_o); const int tid = tid_o, lane = tid & 63, r32 = lane & 31, hi = lane >> 5; const int wid = __builtin_amdgcn_readfirstlane(tid >> 6);
    const size_t rowbase = (size_t)b * SEQ;
    const int q_first = qb * 256 + wid * 32, q_me = q_first + r32;
    float lam_val;
    { const float p1 = lam[lane] * lam[64 + lane], p2 = lam[128 + lane] * lam[192 + lane]; lam_val = __expf(wave_sum(p1)) - __expf(wave_sum(p2)) + LAMBDA_INIT; }
    const int NT = 4 * (qb + 1);
    const int k_key = tid >> 3, k_ch = tid & 7;
    const int v_key0 = tid >> 4, v_ch = tid & 15;
    const unsigned tb0 = LDS_V + tr_base(lane, 0), tb1 = LDS_V + tr_base(lane, 1); unsigned q64 = ((lane & 15) >> 2) << 6;
    const unsigned kb = LDS_K + r32 * KROW + hi * 16;
#pragma unroll
    for (int m = 0; m < 2; ++m) {
        bf16x8 qf[4];
        { const bf16_t* qp = Z + (rowbase + q_me) * NZ + ZC_Q + h * 128 + m * 64 + 8 * hi;
#pragma unroll
          for (int s = 0; s < 4; ++s) qf[s] = *(const bf16x8*)(qp + 16 * s); }
        const bf16_t* ksrc = Z + (rowbase + k_key) * NZ + ZC_K + h * 128 + m * 64 + k_ch * 8;
        const bf16_t* vsrc = Z + (rowbase + v_key0) * NZ + ZC_V + h * 128 + v_ch * 8;
        f32x16 O[4];
#pragma unroll
        for (int c = 0; c < 4; ++c)
#pragma unroll
            for (int r = 0; r < 16; ++r) O[c][r] = 0.f;
        float mrun = -1e30f, lrun = 0.f;
        u32x4 pk_ = *(const u32x4*)ksrc, pv0 = *(const u32x4*)vsrc, pv1 = *(const u32x4*)(vsrc + (size_t)32 * NZ);
        __syncthreads();
        *(LAS u32x4*)(lds + LDS_K + k_key * KROW + k_ch * 16) = pk_;
        *(LAS u32x4*)(lds + LDS_V + off_b(vrow(v_key0), v_ch)) = pv0;
        *(LAS u32x4*)(lds + LDS_V + off_b(vrow(v_key0 + 32), v_ch)) = pv1;
        { const size_t o = (size_t)64 * NZ; pk_ = *(const u32x4*)(ksrc + o); pv0 = *(const u32x4*)(vsrc + o); pv1 = *(const u32x4*)(vsrc + o + (size_t)32 * NZ); }
        __syncthreads();
        for (int kt = 0; kt < NT; ++kt) {
            const int cur = kt & 1, nxt = cur ^ 1;
            if (kt + 1 < NT) {
                *(LAS u32x4*)(lds + LDS_K + nxt * KBUF + k_key * KROW + k_ch * 16) = pk_;
                *(LAS u32x4*)(lds + LDS_V + nxt * VBUF + off_b(vrow(v_key0), v_ch)) = pv0;
                *(LAS u32x4*)(lds + LDS_V + nxt * VBUF + off_b(vrow(v_key0 + 32), v_ch)) = pv1;
                if (kt + 2 < NT) { const size_t o = (size_t)(kt + 2) * 64 * NZ; pk_ = *(const u32x4*)(ksrc + o); pv0 = *(const u32x4*)(vsrc + o); pv1 = *(const u32x4*)(vsrc + o + (size_t)32 * NZ); }
            }
            if (kt * 64 <= q_first + 31) {
            f32x16 p[2];
#pragma unroll
            for (int hf = 0; hf < 2; ++hf) {
#pragma unroll
                for (int r = 0; r < 16; ++r) p[hf][r] = 0.f;
#pragma unroll
                for (int s = 0; s < 4; ++s) { const bf16x8 a = *(const LAS bf16x8*)(lds + kb + cur * KBUF + 32 * hf * KROW + s * 32); p[hf] = MFMA32(a, qf[s], p[hf]); }
            }
            if (kt * 64 + 63 > q_first) {
#pragma unroll
                for (int hf = 0; hf < 2; ++hf)
#pragma unroll
                    for (int r = 0; r < 16; ++r) { const int key = kt * 64 + 32 * hf + crow(r, hi); if (key > q_me) p[hf][r] = -1e30f; }
            }
            float mx = p[0][0];
#pragma unroll
            for (int r = 1; r < 16; ++r) mx = fmaxf(mx, p[0][r]);
#pragma unroll
            for (int r = 0; r < 16; ++r) mx = fmaxf(mx, p[1][r]);
            mx = fmaxf(mx, __shfl_xor(mx, 32));
            const float mnew = fmaxf(mrun, mx), alpha = __builtin_amdgcn_exp2f(mrun - mnew); mrun = mnew;
            float ls = 0.f;
#pragma unroll
            for (int hf = 0; hf < 2; ++hf)
#pragma unroll
                for (int r = 0; r < 16; ++r) { const float e = __builtin_amdgcn_exp2f(p[hf][r] - mnew); p[hf][r] = e; ls += e; }
            lrun = lrun * alpha + ls;
#pragma unroll
            for (int c = 0; c < 4; ++c)
#pragma unroll
                for (int r = 0; r < 16; ++r) O[c][r] *= alpha;
            bf16x8 pf[4];
            pf[0] = pack_step(p[0], 0); pf[1] = pack_step(p[0], 1); pf[2] = pack_step(p[1], 0); pf[3] = pack_step(p[1], 1);
#pragma unroll
            for (int c = 0; c < 4; ++c) { OPAQUE(q64); const unsigned cx = (64u * c) ^ q64;
#pragma unroll
                for (int ks = 0; ks < 4; ++ks) {
                    const s16x4 lo = tr_read(lds + tb0 + cur * VBUF + cx + 4096 * ks), hi4 = tr_read(lds + tb1 + cur * VBUF + cx + 4096 * ks);
                    O[c] = MFMA32(cat8(lo, hi4), pf[ks], O[c]);
                } }
            }
            __syncthreads();
        }
        const float ltot = lrun + __shfl_xor(lrun, 32), inv = 1.0f / ltot;
        if (m == 0) {
            LAS unsigned char* stg = lds + LDS_ST + wid * ST_WAVE;
#pragma unroll
            for (int c = 0; c < 4; ++c)
#pragma unroll
                for (int g4 = 0; g4 < 4; ++g4) { const int dv0 = 32 * c + 8 * g4 + 4 * hi;
                    u32x2 w; w.x = pk2(O[c][4 * g4] * inv, O[c][4 * g4 + 1] * inv); w.y = pk2(O[c][4 * g4 + 2] * inv, O[c][4 * g4 + 3] * inv);
                    *(LAS u32x2*)(stg + r32 * STROW + dv0 * 2) = w; }
        } else {
            const float li = lam_val * inv;
            float ss = 0.f;
            LAS unsigned char* stg = lds + LDS_ST + wid * ST_WAVE;
#pragma unroll
            for (int c = 0; c < 4; ++c)
#pragma unroll
                for (int g4 = 0; g4 < 4; ++g4) { const int dv0 = 32 * c + 8 * g4 + 4 * hi; const u32x2 k2 = *(const LAS u32x2*)(stg + r32 * STROW + dv0 * 2);
                    O[c][4 * g4] = bf_lo(k2.x) - li * O[c][4 * g4]; O[c][4 * g4 + 1] = bf_hi(k2.x) - li * O[c][4 * g4 + 1]; O[c][4 * g4 + 2] = bf_lo(k2.y) - li * O[c][4 * g4 + 2]; O[c][4 * g4 + 3] = bf_hi(k2.y) - li * O[c][4 * g4 + 3];
                    ss += (O[c][4 * g4] * O[c][4 * g4] + O[c][4 * g4 + 1] * O[c][4 * g4 + 1]) + (O[c][4 * g4 + 2] * O[c][4 * g4 + 2] + O[c][4 * g4 + 3] * O[c][4 * g4 + 3]); }
            ss += __shfl_xor(ss, 32);
            const float rstd = rsqrtf(ss * (1.0f / 128.0f) + LN_EPS) * (1.0f - LAMBDA_INIT);
#pragma unroll
            for (int c = 0; c < 4; ++c)
#pragma unroll
                for (int g4 = 0; g4 < 4; ++g4) { const int dv0 = 32 * c + 8 * g4 + 4 * hi; const f32x4 gg = *(const f32x4*)(subln_g + dv0);
                    u32x2 w; w.x = pk2(O[c][4 * g4] * rstd * gg[0], O[c][4 * g4 + 1] * rstd * gg[1]); w.y = pk2(O[c][4 * g4 + 2] * rstd * gg[2], O[c][4 * g4 + 3] * rstd * gg[3]);
                    *(LAS u32x2*)(stg + r32 * STROW + dv0 * 2) = w; }
        }
    }
    LAS unsigned char* stg = lds + LDS_ST + wid * ST_WAVE;
    asm volatile("s_waitcnt lgkmcnt(0)" ::: "memory");
    bf16_t* obase = Z + (rowbase + q_first) * NZ + ZC_Q + h * 128;
#pragma unroll
    for (int i = 0; i < 8; ++i) { const int idx = lane + 64 * i, row = idx >> 4, ch = idx & 15;
        const u32x4 v = *(const LAS u32x4*)(stg + row * STROW + ch * 16); if (!DRY || v.x == 0x12345678u) *(u32x4*)(obase + (size_t)row * NZ + ch * 8) = v; }
}
}
namespace mls {
constexpr int QI = 0, KI = 32768, VI = 65536, SC = 131072;
constexpr int F_IG = 0, F_LF = 128, F_A = 256, F_M = 384, F_INTER = 512, F_EMT = 640, F_W = 768, F_DEN = 896, F_N = 1024, F_MISC = 1152,
              F_NQ2P = 1280, F_NQ1P = 1792, F_NP = 2304, F_RSQ = 2816, F_END = 3840;
constexpr int LDS_BYTES = SC + F_END * 4;
static_assert(LDS_BYTES <= 147456, "mLSTM LDS");

DI float scan_add(float x, int lane) {
#pragma unroll
    for (int o = 1; o < 64; o <<= 1) { const float y = __shfl_up(x, o); if (lane >= o) x += y; }
    return x;
}
DI float scan_max(float x, int lane) {
#pragma unroll
    for (int o = 1; o < 64; o <<= 1) { const float y = __shfl_up(x, o); if (lane >= o) x = fmaxf(x, y); }
    return x;
}
DI float log_sigmoid(float x) { return fminf(x, 0.f) - __logf(1.0f + __expf(-fabsf(x))); }

template <bool DRY> DI void mlstm_unit(LAS unsigned char* lds, bf16_t* Z, const float* GIF, const float* conv_w, const float* conv_b, const float* norm_g, int b, int hd) {
    int tid_o = threadIdx.x; OPAQUE(tid_o); const int tid = tid_o, lane = tid & 63; const int wid = __builtin_amdgcn_readfirstlane(tid >> 6);
    LAS float* sc = (LAS float*)(lds + SC);
#define MLS_LV unsigned L_ = lane; OPAQUE(L_); const unsigned r32 = L_ & 31, hi = L_ >> 5, rowb = 256u * r32, f16 = (((r32 & 3) << 2) | ((r32 >> 2) & 3)) << 4, q64 = ((L_ & 15) >> 2) << 6; (void)rowb; (void)f16; (void)q64; (void)hi
    f32x16 CT[4];
#pragma unroll
    for (int i = 0; i < 4; ++i)
#pragma unroll
        for (int r = 0; r < 16; ++r) CT[i][r] = 0.f;
    float m_prev = 0.f;
    if (tid < 128) sc[F_N + tid] = 0.f;
    const int img = wid >> 2, vc = wid & 3;
    const int st_i = wid >> 1, st_j0 = 2 * (wid & 1);

    u32x4 rawn[11]; float gin = 0.f, gfn = 0.f;
#define MLS_PREFETCH(CC) do { int tp = tid; OPAQUE(tp); const int p_mat = tp >> 8, p_ch = tp & 15, p_rg = (tp >> 4) & 15; const size_t tn = (size_t)b * SEQ + (size_t)(CC) * 128; \
        const bf16_t* srcn = Z + (tn + p_rg * 8) * NZ + (p_mat ? ZC_MK : ZC_MQ) + hd * 128 + p_ch * 8; \
        _Pragma("unroll") for (int j = 0; j < 11; ++j) { const int lp = (CC) * 128 + p_rg * 8 - 3 + j; rawn[j] = (u32x4){0u, 0u, 0u, 0u}; if (lp >= 0) rawn[j] = *(const u32x4*)(srcn + (ptrdiff_t)(j - 3) * NZ); } \
        if (tp < 128) { const float* gg = GIF + (tn + tp) * 8; gin = gg[hd]; gfn = gg[4 + hd]; } } while (0)
    MLS_PREFETCH(0);
    for (int c = 0; c < 16; ++c) {
        const size_t t0 = (size_t)b * SEQ + (size_t)c * 128;
        __syncthreads();
        u32x4 vn[8];
        { int tq = tid; OPAQUE(tq);
#pragma unroll
          for (int i = 0; i < 8; ++i) { const int idx = tq + 512 * i, row = idx >> 5, ch32 = idx & 31; vn[i] = *(const u32x4*)(Z + (t0 + row) * NZ + ZC_MV + hd * 256 + ch32 * 8); } }
        {
            int tq = tid; OPAQUE(tq);
            const int c_mat = tq >> 8, c_ch = tq & 15, c_rg = (tq >> 4) & 15;
            const int chan0 = c_mat * 512 + hd * 128 + c_ch * 8;
            const float kscale = c_mat ? 0.08838834764831845f : 1.0f;
            float cw[4][8], cb[8];
            { const float* cwp = conv_w + chan0; const float* cbp = conv_b + chan0; asm volatile("" : "+v"(cwp), "+v"(cbp));
#pragma unroll
              for (int j = 0; j < 4; ++j) { const f32x4 a = *(const f32x4*)(cwp + j * 1024), c4 = *(const f32x4*)(cwp + j * 1024 + 4);
                cw[j][0] = a[0]; cw[j][1] = a[1]; cw[j][2] = a[2]; cw[j][3] = a[3]; cw[j][4] = c4[0]; cw[j][5] = c4[1]; cw[j][6] = c4[2]; cw[j][7] = c4[3]; }
              const f32x4 a = *(const f32x4*)cbp, c4 = *(const f32x4*)(cbp + 4); cb[0] = a[0]; cb[1] = a[1]; cb[2] = a[2]; cb[3] = a[3]; cb[4] = c4[0]; cb[5] = c4[1]; cb[6] = c4[2]; cb[7] = c4[3]; }
            u32x4 raw[11];
#pragma unroll
            for (int j = 0; j < 11; ++j) raw[j] = rawn[j];
#pragma unroll
            for (int i = 0; i < 8; ++i) {
                float o[8];
#pragma unroll
                for (int e = 0; e < 8; ++e) { const int q = e >> 1; const bool hi_ = e & 1;
                    const float x0 = hi_ ? bf_hi(raw[i][q]) : bf_lo(raw[i][q]), x1 = hi_ ? bf_hi(raw[i + 1][q]) : bf_lo(raw[i + 1][q]), x2 = hi_ ? bf_hi(raw[i + 2][q]) : bf_lo(raw[i + 2][q]), x3 = hi_ ? bf_hi(raw[i + 3][q]) : bf_lo(raw[i + 3][q]);
                    const float y = cb[e] + cw[0][e] * x0 + cw[1][e] * x1 + cw[2][e] * x2 + cw[3][e] * x3; o[e] = siluf_(y) * kscale; }
                u32x4 w; w.x = pk2(o[0], o[1]); w.y = pk2(o[2], o[3]); w.z = pk2(o[4], o[5]); w.w = pk2(o[6], o[7]);
                *(LAS u32x4*)(lds + (c_mat ? KI : QI) + off_b(c_rg * 8 + i, c_ch)) = w;
            }
        }
        { int tq = tid; OPAQUE(tq);
#pragma unroll
        for (int i = 0; i < 8; ++i) { const int idx = tq + 512 * i, row = idx >> 5, ch32 = idx & 31;
            *(LAS u32x4*)(lds + VI + (ch32 >> 4) * 32768 + off_b(row, ch32 & 15)) = vn[i]; } }
        if (tid < 128) { sc[F_IG + tid] = gin; sc[F_LF + tid] = log_sigmoid(gfn);
            if (c > 0) sc[F_N + tid] = sc[F_MISC + 1] * sc[F_N + tid] + (sc[F_NP + tid] + sc[F_NP + 128 + tid]) + (sc[F_NP + 256 + tid] + sc[F_NP + 384 + tid]); }
        __syncthreads();
        if (wid == 0) {
            const float ig0 = sc[F_IG + 2 * lane], ig1 = sc[F_IG + 2 * lane + 1], lf0 = sc[F_LF + 2 * lane], lf1 = sc[F_LF + 2 * lane + 1];
            const float s2 = lf0 + lf1, incl = scan_add(s2, lane), excl = incl - s2;
            const float b0 = excl + lf0, b1 = incl, a0 = ig0 - b0, a1 = ig1 - b1;
            const float im = scan_max(fmaxf(a0, a1), lane); float em = __shfl_up(im, 1); if (lane == 0) em = -3.0e38f;
            const float cm0 = fmaxf(em, a0), cm1 = im;
            const float M0 = fmaxf(m_prev, cm0), M1 = fmaxf(m_prev, cm1);
            const float ML = __shfl(M1, 63), bL = __shfl(b1, 63);
            sc[F_A + 2 * lane] = a0; sc[F_A + 2 * lane + 1] = a1; sc[F_M + 2 * lane] = M0; sc[F_M + 2 * lane + 1] = M1;
            sc[F_INTER + 2 * lane] = __expf(m_prev - M0); sc[F_INTER + 2 * lane + 1] = __expf(m_prev - M1);
            sc[F_EMT + 2 * lane] = __expf(-(b0 + M0)); sc[F_EMT + 2 * lane + 1] = __expf(-(b1 + M1));
            sc[F_W + 2 * lane] = __expf(a0 - ML); sc[F_W + 2 * lane + 1] = __expf(a1 - ML);
            if (lane == 0) sc[F_MISC + 0] = __expf(m_prev - ML);
            m_prev = bL + ML;
        }
        f32x16 sT[2];
#pragma unroll
        for (int jj = 0; jj < 2; ++jj) {
#pragma unroll
            for (int r = 0; r < 16; ++r) sT[jj][r] = 0.f;
            const int j = st_j0 + jj;
            if (j <= st_i) { MLS_LV; const unsigned fh = (16u * hi) ^ f16;
#pragma unroll
                for (int ks = 0; ks < 8; ++ks) { const unsigned xo = rowb + ((32u * ks) ^ fh);
                    const bf16x8 a = *(const LAS bf16x8*)(lds + KI + 8192 * j + xo), q = *(const LAS bf16x8*)(lds + QI + 8192 * st_i + xo);
                    sT[jj] = MFMA32(a, q, sT[jj]); }
            }
        }
        __syncthreads();
        u32x2 pp[2][4];
        { MLS_LV; const int t = 32 * st_i + r32; const float Mt = sc[F_M + t]; const unsigned ab = SC + 4 * F_A + 128 * st_j0 + 16 * hi;
#pragma unroll
          for (int jj = 0; jj < 2; ++jj) { const int j = st_j0 + jj;
#pragma unroll
            for (int g4 = 0; g4 < 4; ++g4) { const int s0 = 32 * j + 8 * g4 + 4 * hi; float pv[4];
#pragma unroll
                for (int e = 0; e < 4; ++e) { const int s = s0 + e; pv[e] = (s <= t) ? __expf(*(const LAS float*)(lds + ab + 4 * (32 * jj + 8 * g4 + e)) - Mt) * sT[jj][4 * g4 + e] : 0.f; }
                pp[jj][g4].x = pk2(pv[0], pv[1]); pp[jj][g4].y = pk2(pv[2], pv[3]); } } }
        f32x16 acc[4];
#pragma unroll
        for (int ti = 0; ti < 4; ++ti)
#pragma unroll
            for (int r = 0; r < 16; ++r) acc[ti][r] = 0.f;
        if (c > 0) {
#pragma unroll
            for (int dt = 0; dt < 4; ++dt)
#pragma unroll
                for (int s2 = 0; s2 < 2; ++s2) { const bf16x8 bfr = pack_step(CT[dt], s2); MLS_LV;
                    const unsigned a0 = QI + rowb + 8 * hi + ((64u * dt + 32u * s2) ^ f16), a1 = QI + rowb + 8 * hi + ((64u * dt + 32u * s2 + 16u) ^ f16);
#pragma unroll
                    for (int ti = 0; ti < 4; ++ti) {
                        const s16x4 lo = *(const LAS s16x4*)(lds + a0 + 8192 * ti), hi4 = *(const LAS s16x4*)(lds + a1 + 8192 * ti);
                        acc[ti] = MFMA32(cat8(lo, hi4), bfr, acc[ti]); }
                    __builtin_amdgcn_sched_barrier(0); }
        }
        { int tq = tid; OPAQUE(tq); const int t = tq & 127, part = tq >> 7; float d = 0.f;
#pragma unroll
          for (int cc = 0; cc < 4; ++cc) { const int ch = 4 * part + cc; const u32x4 raw = *(const LAS u32x4*)(lds + QI + off_b(t, ch)); const LAS float* nn = sc + F_N + 8 * ch;
              d += bf_lo(raw.x) * nn[0] + bf_hi(raw.x) * nn[1] + bf_lo(raw.y) * nn[2] + bf_hi(raw.y) * nn[3] + bf_lo(raw.z) * nn[4] + bf_hi(raw.z) * nn[5] + bf_lo(raw.w) * nn[6] + bf_hi(raw.w) * nn[7]; }
          sc[F_NQ2P + part * 128 + t] = d; }
        __syncthreads();
        { MLS_LV; const unsigned ib = SC + 4 * F_INTER + 16 * hi;
#pragma unroll
          for (int ti = 0; ti < 4; ++ti)
#pragma unroll
            for (int r = 0; r < 16; ++r) acc[ti][r] *= *(const LAS float*)(lds + ib + 4 * (32 * ti + (r & 3) + 8 * (r >> 2))); }
        { MLS_LV;
#pragma unroll
          for (int jj = 0; jj < 2; ++jj) { const int j = st_j0 + jj;
#pragma unroll
            for (int g4 = 0; g4 < 4; ++g4) *(LAS u32x2*)(lds + QI + 8192 * st_i + rowb + 8 * hi + ((64u * j + 16u * g4) ^ f16)) = pp[jj][g4]; } }
        { int tq = tid; OPAQUE(tq);
#pragma unroll
        for (int i = 0; i < 4; ++i) { const int idx = tq + 512 * i, row = idx >> 4, ch = idx & 15; LAS u32x4* p = (LAS u32x4*)(lds + KI + off_b(row, ch)); const u32x4 raw = *p; const float w = sc[F_W + row];
            u32x4 o; o.x = pk2(bf_lo(raw.x) * w, bf_hi(raw.x) * w); o.y = pk2(bf_lo(raw.y) * w, bf_hi(raw.y) * w); o.z = pk2(bf_lo(raw.z) * w, bf_hi(raw.z) * w); o.w = pk2(bf_lo(raw.w) * w, bf_hi(raw.w) * w); *p = o; } }
        __syncthreads();
        { const float decay = sc[F_MISC + 0];
#pragma unroll
          for (int dt = 0; dt < 4; ++dt)
#pragma unroll
            for (int r = 0; r < 16; ++r) CT[dt][r] *= decay; }
#pragma unroll
        for (int ks = 0; ks < 8; ++ks) {
            MLS_LV;
            const unsigned tbv0 = VI + img * 32768 + tr_base(L_, 0) + ((64u * vc) ^ q64), tbv1 = VI + img * 32768 + tr_base(L_, 1) + ((64u * vc) ^ q64);
            const unsigned tbk0 = KI + tr_base(L_, 0), tbk1 = KI + tr_base(L_, 1);
            const bf16x8 bv = cat8(tr_read(lds + tbv0 + 4096 * ks), tr_read(lds + tbv1 + 4096 * ks));
            const unsigned xo = QI + rowb + ((32u * ks) ^ ((16u * hi) ^ f16));
#pragma unroll
            for (int ti = 0; ti < 4; ++ti) if (ks < 2 * (ti + 1)) { const bf16x8 a = *(const LAS bf16x8*)(lds + xo + 8192 * ti); acc[ti] = MFMA32(a, bv, acc[ti]); }
#pragma unroll
            for (int dt = 0; dt < 4; ++dt) { const unsigned cx = (64u * dt) ^ q64; const bf16x8 a = cat8(tr_read(lds + tbk0 + 4096 * ks + cx), tr_read(lds + tbk1 + 4096 * ks + cx)); CT[dt] = MFMA32(a, bv, CT[dt]); }
            __builtin_amdgcn_sched_barrier(0);
        }
        { int tq = tid; OPAQUE(tq); const int t = tq & 127, part = tq >> 7; float d = 0.f;
#pragma unroll
          for (int cc = 0; cc < 4; ++cc) { const u32x4 raw = *(const LAS u32x4*)(lds + QI + off_b(t, 4 * part + cc));
              d += (bf_lo(raw.x) + bf_hi(raw.x)) + (bf_lo(raw.y) + bf_hi(raw.y)) + (bf_lo(raw.z) + bf_hi(raw.z)) + (bf_lo(raw.w) + bf_hi(raw.w)); }
          sc[F_NQ1P + part * 128 + t] = d;
          float nn = 0.f;
          for (int s = 32 * part; s < 32 * part + 32; ++s) nn += bf2f(*(const LAS bf16_t*)(lds + KI + off_b(s, t >> 3) + (t & 7) * 2));
          sc[F_NP + part * 128 + t] = nn;
          if (tid == 0) sc[F_MISC + 1] = sc[F_MISC + 0]; }
        __syncthreads();
        if (tid < 128) { const float nq1 = (sc[F_NQ1P + tid] + sc[F_NQ1P + 128 + tid]) + (sc[F_NQ1P + 256 + tid] + sc[F_NQ1P + 384 + tid]);
            const float nq2 = (sc[F_NQ2P + tid] + sc[F_NQ2P + 128 + tid]) + (sc[F_NQ2P + 256 + tid] + sc[F_NQ2P + 384 + tid]);
            sc[F_DEN + tid] = 1.0f / fmaxf(fabsf(nq1 + sc[F_INTER + tid] * nq2), sc[F_EMT + tid]); }
        __syncthreads();
        u32x4 oraw[8];
        { int tq = tid; OPAQUE(tq);
#pragma unroll
          for (int i = 0; i < 8; ++i) { const int idx = tq + 512 * i, row = idx >> 5, ch = idx & 31; oraw[i] = *(const u32x4*)(Z + (t0 + row) * NZ + hd * 256 + ch * 8 + ZC_MO); } }
        { MLS_LV; const unsigned db = SC + 4 * F_DEN + 16 * hi, hb = VI + 2048 * hi + (32 * wid + r32) * 2;
#pragma unroll
          for (int ti = 0; ti < 4; ++ti)
#pragma unroll
            for (int r = 0; r < 16; ++r) { const int tt = 32 * ti + (r & 3) + 8 * (r >> 2); const float x = acc[ti][r] * *(const LAS float*)(lds + db + 4 * tt);
                *(LAS bf16_t*)(lds + hb + 512 * tt) = (bf16_t)(pk2(x, 0.f) & 0xffffu); } }
        __syncthreads();
        { const int cn = c + 1 < 16 ? c + 1 : 15; MLS_PREFETCH(cn); }
        { int tq = tid; OPAQUE(tq);
          const f32x4 g0 = *(const f32x4*)(norm_g + hd * 256 + (tq & 31) * 8), g1 = *(const f32x4*)(norm_g + hd * 256 + (tq & 31) * 8 + 4);
#pragma unroll
          for (int i = 0; i < 8; ++i) { const int idx = tq + 512 * i, row = idx >> 5, ch = idx & 31;
            const u32x4 hraw = *(const LAS u32x4*)(lds + VI + row * 512 + ch * 16);
            const float h0 = bf_lo(hraw.x), h1 = bf_hi(hraw.x), h2 = bf_lo(hraw.y), h3 = bf_hi(hraw.y), h4 = bf_lo(hraw.z), h5 = bf_hi(hraw.z), h6 = bf_lo(hraw.w), h7 = bf_hi(hraw.w);
            float ssq = (h0 * h0 + h1 * h1) + (h2 * h2 + h3 * h3) + (h4 * h4 + h5 * h5) + (h6 * h6 + h7 * h7);
            ssq += __shfl_xor(ssq, 1); ssq += __shfl_xor(ssq, 2); ssq += __shfl_xor(ssq, 4); ssq += __shfl_xor(ssq, 8); ssq += __shfl_xor(ssq, 16);
            const float rstd = rsqrtf(ssq * (1.0f / 256.0f) + LN_EPS);
            bf16_t* gp = Z + (t0 + row) * NZ + hd * 256 + ch * 8;
            u32x4 o;
            o.x = pk2(h0 * rstd * g0[0] * sigmoidf_(bf_lo(oraw[i].x)), h1 * rstd * g0[1] * sigmoidf_(bf_hi(oraw[i].x)));
            o.y = pk2(h2 * rstd * g0[2] * sigmoidf_(bf_lo(oraw[i].y)), h3 * rstd * g0[3] * sigmoidf_(bf_hi(oraw[i].y)));
            o.z = pk2(h4 * rstd * g1[0] * sigmoidf_(bf_lo(oraw[i].z)), h5 * rstd * g1[1] * sigmoidf_(bf_hi(oraw[i].z)));
            o.w = pk2(h6 * rstd * g1[2] * sigmoidf_(bf_lo(oraw[i].w)), h7 * rstd * g1[3] * sigmoidf_(bf_hi(oraw[i].w)));
            if (!DRY || o.x == 0x12345678u) *(u32x4*)(gp + ZC_MV) = o; } }
    }
    __syncthreads();
}
#undef MLS_LV
#undef MLS_PREFETCH
}
namespace peer {
constexpr int KROW = 144;
constexpr int L_KEYS = 0, L_IDX = 2 * 128 * KROW, LDS_BYTES = L_IDX + 512 * 32;
DI unsigned ordf(float f) { const unsigned u = __float_as_uint(f); return u ^ ((unsigned)((int)u >> 31) | 0x80000000u); }
DI float deord(unsigned k) { return __uint_as_float(k ^ ((~(unsigned)((int)k >> 31)) | 0x80000000u)); }
#define PEER_CE(a, b) do { const unsigned hi_ = (a) > (b) ? (a) : (b), lo_ = (a) > (b) ? (b) : (a); (a) = hi_; (b) = lo_; } while (0)
DI void sort16_desc(unsigned (&a)[16]) {
#pragma unroll
    for (int k = 2; k <= 16; k <<= 1)
#pragma unroll
        for (int j = k >> 1; j >= 1; j >>= 1)
#pragma unroll
            for (int i = 0; i < 16; ++i) { const int l = i ^ j; if (l > i) { if (k == 16 || (i & k) == 0) PEER_CE(a[i], a[l]); else PEER_CE(a[l], a[i]); } }
}
DI void merge16(unsigned (&a)[16], const unsigned (&b)[16]) {
#pragma unroll
    for (int i = 0; i < 16; ++i) a[i] = a[i] > b[15 - i] ? a[i] : b[15 - i];
#pragma unroll
    for (int j = 8; j >= 1; j >>= 1)
#pragma unroll
        for (int i = 0; i < 16; ++i) { const int l = i ^ j; if (l > i) PEER_CE(a[i], a[l]); }
}
DI float gelu_erf(float x) { return 0.5f * x * (1.0f + erff(x * 0.7071067811865476f)); }

DI void stage_keys(LAS unsigned char* lds, const float* keys) {
    for (int i = threadIdx.x; i < 2 * 128 * 8; i += 512) { const int row = i >> 3, ch = i & 7; const float* s = keys + row * 64 + ch * 8;
        const f32x4 a = *(const f32x4*)s, b = *(const f32x4*)(s + 4);
        u32x4 w; w.x = pk2(a[0], a[1]); w.y = pk2(a[2], a[3]); w.z = pk2(b[0], b[1]); w.w = pk2(b[2], b[3]);
        *(LAS u32x4*)(lds + L_KEYS + row * KROW + ch * 16) = w; }
}

DI void select_tile(LAS unsigned char* lds, const bf16_t* QP, int tok0, bf16_t* SELE, float* SELG) {
    int tid_o = threadIdx.x; OPAQUE(tid_o); const int tid = tid_o, lane = tid & 63, r32 = lane & 31, hi = lane >> 5; const int wid = __builtin_amdgcn_readfirstlane(tid >> 6);
    unsigned LA[16], LB[16];
#pragma unroll
    for (int p = 0; p < 2; ++p) {
        bf16x8 qf[4];
        { const bf16_t* qp = QP + (size_t)(tok0 + r32) * DM + wid * 128 + p * 64 + 8 * hi;
#pragma unroll
          for (int s = 0; s < 4; ++s) qf[s] = *(const bf16x8*)(qp + 16 * s); }
        unsigned L[16], M[16];
#pragma unroll
        for (int nt = 0; nt < 4; ++nt) {
            f32x16 acc;
#pragma unroll
            for (int r = 0; r < 16; ++r) acc[r] = 0.f;
#pragma unroll
            for (int s = 0; s < 4; ++s) { const bf16x8 a = *(const LAS bf16x8*)(lds + L_KEYS + (p * 128 + 32 * nt + r32) * KROW + (2 * s + hi) * 16); acc = MFMA32(a, qf[s], acc); }
            unsigned T[16];
#pragma unroll
            for (int r = 0; r < 16; ++r) T[r] = (ordf(acc[r]) & ~0x7Fu) | (unsigned)(32 * nt + crow(r, hi));
            sort16_desc(T);
            if (nt == 0) {
#pragma unroll
                for (int i = 0; i < 16; ++i) L[i] = T[i]; }
            else if (nt == 1) merge16(L, T);
            else if (nt == 2) {
#pragma unroll
                for (int i = 0; i < 16; ++i) M[i] = T[i]; }
            else { merge16(M, T); merge16(L, M); }
        }
        unsigned O[16];
#pragma unroll
        for (int i = 0; i < 16; ++i) O[i] = (unsigned)__shfl_xor((int)L[i], 32);
        merge16(L, O);
#pragma unroll
        for (int i = 0; i < 16; ++i) { if (p == 0) LA[i] = L[i]; else LB[i] = L[i]; }
    }
    unsigned CL[16], CM[16];
    {
        unsigned C4[4][16]; int n = 0;
#pragma unroll
        for (int g = 0; g < 4; ++g)
#pragma unroll
            for (int i = 0; i < 16; ++i) C4[g][i] = 0u;
#pragma unroll
        for (int i = 0; i < 16; ++i) {
            const float sa = deord(LA[i] & ~0x7Fu);
#pragma unroll
            for (int j = 0; j < 16; ++j) if ((i + 1) * (j + 1) <= 16) { const float sb = deord(LB[j] & ~0x7Fu); C4[n >> 4][n & 15] = (ordf(sa + sb) & ~0xFFu) | (unsigned)(i * 16 + j); ++n; }
        }
        sort16_desc(C4[0]); sort16_desc(C4[1]); sort16_desc(C4[2]); sort16_desc(C4[3]);
#pragma unroll
        for (int i = 0; i < 16; ++i) { CL[i] = C4[0][i]; CM[i] = C4[2][i]; }
        merge16(CL, C4[1]); merge16(CM, C4[3]); merge16(CL, CM);
    }
    LAS unsigned char* itab = lds + L_IDX + tid * 32;
    { u32x4 wa, wb;
#pragma unroll
      for (int q = 0; q < 4; ++q) { wa[q] = (LA[4 * q] & 0x7Fu) | ((LA[4 * q + 1] & 0x7Fu) << 8) | ((LA[4 * q + 2] & 0x7Fu) << 16) | ((LA[4 * q + 3] & 0x7Fu) << 24);
                                    wb[q] = (LB[4 * q] & 0x7Fu) | ((LB[4 * q + 1] & 0x7Fu) << 8) | ((LB[4 * q + 2] & 0x7Fu) << 16) | ((LB[4 * q + 3] & 0x7Fu) << 24); }
      *(LAS u32x4*)itab = wa; *(LAS u32x4*)(itab + 16) = wb; }
    const float mx = deord(CL[0] & ~0xFFu);
    float ev[16], sum = 0.f;
#pragma unroll
    for (int k = 0; k < 16; ++k) { ev[k] = __expf(deord(CL[k] & ~0xFFu) - mx); sum += ev[k]; }
    const float inv = 1.0f / sum;
    bf16_t* se = SELE + (size_t)(tok0 + r32) * 128 + wid * 16;
    float* sg = SELG + (size_t)(tok0 + r32) * 128 + wid * 16;
#pragma unroll
    for (int k = 0; k < 16; ++k) if ((k >> 3) == hi) { const unsigned code = CL[k] & 0xFFu; const unsigned n1 = itab[code >> 4], n2 = itab[16 + (code & 15u)];
        se[k] = (bf16_t)(n1 * 128u + n2); sg[k] = ev[k] * inv; }
}

DI void u_phase_tile(LAS unsigned char* lds, int tile, int x, const bf16_t* SELE, const unsigned char* H2Q, const unsigned char* U8S, float* PART) {
    int tid_o = threadIdx.x; OPAQUE(tid_o); const int tid = tid_o, lane = tid & 63, j = lane >> 3, c = lane & 7; const int wid = __builtin_amdgcn_readfirstlane(tid >> 6);
    *(LAS u32x4*)(lds + tid * 16) = *(const u32x4*)(SELE + (size_t)tile * 32 * 128 + tid * 8);
    __syncthreads();
    const unsigned char* Us = U8S + (size_t)x * NEXP * 128 + 16 * c;
#pragma unroll 1
    for (int jt = 0; jt < 4; ++jt) {
        const int tk = wid * 4 + jt; const size_t t = (size_t)tile * 32 + tk;
        const u32x4 hq = *(const u32x4*)(H2Q + t * DM + 128 * x + 16 * c);
        const LAS bf16_t* se = (const LAS bf16_t*)lds + tk * 128 + j;
        u32x4 ur[16];
#pragma unroll
        for (int g = 0; g < 16; ++g) { const unsigned e = se[8 * g]; ur[g] = *(const u32x4*)(Us + (size_t)e * 128); }
        float keep0 = 0.f, keep1 = 0.f;
#pragma unroll
        for (int g = 0; g < 16; ++g) {
            int d = __builtin_amdgcn_sdot4((int)ur[g].x, (int)hq.x, 0, false); d = __builtin_amdgcn_sdot4((int)ur[g].y, (int)hq.y, d, false);
            d = __builtin_amdgcn_sdot4((int)ur[g].z, (int)hq.z, d, false); d = __builtin_amdgcn_sdot4((int)ur[g].w, (int)hq.w, d, false);
            d += __shfl_xor(d, 1); d += __shfl_xor(d, 2); d += __shfl_xor(d, 4);
            if ((g & 7) == c) { if (g < 8) keep0 = (float)d; else keep1 = (float)d; }
        }
        float* pp = PART + t * 1024 + x * 128 + 8 * c + j;
        pp[0] = keep0; pp[64] = keep1;
    }
}
DI void red_tokens4(size_t t0, const float* __restrict__ PART, const bf16_t* __restrict__ SELE, const float* __restrict__ SELG, const float* __restrict__ SU, const float* __restrict__ SV,
                    const float* __restrict__ SH, signed char* __restrict__ COEFQ, float* __restrict__ CS) {
    const int lane = threadIdx.x & 63;
    float s[4][2], g[4][2], su[4][2], sv[4][2], sh[4];
#pragma unroll
    for (int q = 0; q < 4; ++q) { const size_t t = t0 + q; sh[q] = SH[t];
#pragma unroll
        for (int h = 0; h < 2; ++h) { const int k = lane + 64 * h; const unsigned e = SELE[t * 128 + k]; g[q][h] = SELG[t * 128 + k]; su[q][h] = SU[e]; sv[q][h] = SV[e];
            float a = 0.f;
#pragma unroll
            for (int xx = 0; xx < 8; ++xx) a += PART[t * 1024 + xx * 128 + k];
            s[q][h] = a; } }
#pragma unroll
    for (int q = 0; q < 4; ++q) { const size_t t = t0 + q;
        const float c0 = g[q][0] * gelu_erf(s[q][0] * su[q][0] * sh[q]) * sv[q][0], c1 = g[q][1] * gelu_erf(s[q][1] * su[q][1] * sh[q]) * sv[q][1];
        float cm = fmaxf(fabsf(c0), fabsf(c1));
#pragma unroll
        for (int o = 1; o < 64; o <<= 1) cm = fmaxf(cm, __shfl_xor(cm, o));
        const float inv = cm > 0.f ? 127.0f / cm : 0.f;
        signed char* cq = COEFQ + t * 128 + (lane & 7) * 16 + (lane >> 3);
        cq[0] = (signed char)(int)rintf(c0 * inv); cq[8] = (signed char)(int)rintf(c1 * inv);
        if (lane == 0) CS[t] = cm * (1.0f / 127.0f); }
}
DI unsigned bperm(unsigned hi, unsigned lo, unsigned sel) { return __builtin_amdgcn_perm(hi, lo, sel); }
DI void v_phase_tile(LAS unsigned char* lds, int tile, int x, const bf16_t* SELE, const signed char* COEFQ, const float* CS, const unsigned char* V8S, float* YF) {
    int tid_o = threadIdx.x; OPAQUE(tid_o); const int tid = tid_o, lane = tid & 63, j = lane >> 3, c = lane & 7; const int wid = __builtin_amdgcn_readfirstlane(tid >> 6);
    *(LAS u32x4*)(lds + tid * 16) = *(const u32x4*)(SELE + (size_t)tile * 32 * 128 + tid * 8);
    if (tid < 256) *(LAS u32x4*)(lds + 8192 + tid * 16) = *(const u32x4*)(COEFQ + (size_t)tile * 32 * 128 + tid * 16);
    __syncthreads();
    const unsigned char* Vs = V8S + (size_t)x * NEXP * 128 + 16 * c;
#pragma unroll 1
    for (int jt = 0; jt < 4; ++jt) {
        const int tk = wid * 4 + jt; const size_t t = (size_t)tile * 32 + tk;
        const LAS bf16_t* se = (const LAS bf16_t*)lds + tk * 128 + j;
        const LAS unsigned* cqp = (const LAS unsigned*)(lds + 8192 + tk * 128 + j * 16);
        u32x4 vr[16];
#pragma unroll
        for (int g = 0; g < 16; ++g) { const unsigned e = se[8 * g]; vr[g] = *(const u32x4*)(Vs + (size_t)e * 128); }
        int acc[16];
#pragma unroll
        for (int i = 0; i < 16; ++i) acc[i] = 0;
#pragma unroll
        for (int qd = 0; qd < 4; ++qd) { const int cp = (int)cqp[qd];
#pragma unroll
            for (int i = 0; i < 4; ++i) { const unsigned w0 = vr[4 * qd][i], w1 = vr[4 * qd + 1][i], w2 = vr[4 * qd + 2][i], w3 = vr[4 * qd + 3][i];
                const unsigned t0 = bperm(w1, w0, 0x05010400u), t1 = bperm(w1, w0, 0x07030602u), t2 = bperm(w3, w2, 0x05010400u), t3 = bperm(w3, w2, 0x07030602u);
                acc[4 * i] = __builtin_amdgcn_sdot4((int)bperm(t2, t0, 0x05040100u), cp, acc[4 * i], false);
                acc[4 * i + 1] = __builtin_amdgcn_sdot4((int)bperm(t2, t0, 0x07060302u), cp, acc[4 * i + 1], false);
                acc[4 * i + 2] = __builtin_amdgcn_sdot4((int)bperm(t3, t1, 0x05040100u), cp, acc[4 * i + 2], false);
                acc[4 * i + 3] = __builtin_amdgcn_sdot4((int)bperm(t3, t1, 0x07060302u), cp, acc[4 * i + 3], false); } }
#pragma unroll
        for (int i = 0; i < 16; ++i) { acc[i] += __shfl_xor(acc[i], 8); acc[i] += __shfl_xor(acc[i], 16); acc[i] += __shfl_xor(acc[i], 32); }
        if (j == 0) { const float sc = CS[t]; float* yp = YF + t * DM + 128 * x + 16 * c;
#pragma unroll
            for (int i = 0; i < 4; ++i) { f32x4 o; o[0] = (float)acc[4 * i] * sc; o[1] = (float)acc[4 * i + 1] * sc; o[2] = (float)acc[4 * i + 2] * sc; o[3] = (float)acc[4 * i + 3] * sc; *(f32x4*)(yp + 4 * i) = o; } }
    }
}
DI void final_rows2(size_t m0, size_t m1, float* YFOUT, const float* __restrict__ X1, const float* __restrict__ MOD, const float* __restrict__ ln_g, const float* __restrict__ ln_b) {
    const int lane = threadIdx.x & 63;
    f32x4 v[2][4];
#pragma unroll
    for (int r = 0; r < 2; ++r) { const size_t m = r ? m1 : m0; const int b = (int)(m / SEQ);
        const f32x4* yr = (const f32x4*)(YFOUT + m * DM) + lane; const f32x4* xr = (const f32x4*)(X1 + m * DM) + lane; const f32x4* gt = (const f32x4*)(MOD + (size_t)b * MODW + 5 * DM) + lane;
#pragma unroll
        for (int q = 0; q < 4; ++q) v[r][q] = xr[64 * q] * ALPHA_RES + gt[64 * q] * yr[64 * q]; }
#pragma unroll
    for (int r = 0; r < 2; ++r) { const size_t m = r ? m1 : m0; float s = 0.f;
#pragma unroll
        for (int q = 0; q < 4; ++q) s += (v[r][q].x + v[r][q].y) + (v[r][q].z + v[r][q].w);
        const float mean = wave_sum(s) * (1.f / DM); float s2 = 0.f;
#pragma unroll
        for (int q = 0; q < 4; ++q) { v[r][q] = v[r][q] - mean; s2 += (v[r][q].x * v[r][q].x + v[r][q].y * v[r][q].y) + (v[r][q].z * v[r][q].z + v[r][q].w * v[r][q].w); }
        const float rstd = rsqrtf(wave_sum(s2) * (1.f / DM) + LN_EPS);
        f32x4* op = (f32x4*)(YFOUT + m * DM) + lane;
#pragma unroll
        for (int q = 0; q < 4; ++q) op[64 * q] = v[r][q] * rstd * ((const f32x4*)ln_g)[lane + 64 * q] + ((const f32x4*)ln_b)[lane + 64 * q]; }
}
}
constexpr int NWAVES = 8;
#ifndef MK_N_LAUNCHES
#define MK_N_LAUNCHES 1
#endif
constexpr int N_PHASES = 14;
constexpr int RING_BYTES = 147456;
constexpr int MISC_OFF = RING_BYTES;
constexpr int LDS_BYTES = RING_BYTES + 4096;
static_assert(pg8::STAGE_BYTES <= RING_BYTES && datt::LDS_BYTES <= RING_BYTES && mls::LDS_BYTES <= RING_BYTES && peer::LDS_BYTES <= RING_BYTES, "LDS map");

typedef GAS unsigned gu32;
#define RLX_AGENT __ATOMIC_RELAXED, __HIP_MEMORY_SCOPE_AGENT
#define LDS_WAIT() asm volatile("s_waitcnt lgkmcnt(0)" ::: "memory")

#define XB_TMO      128
#define XB_XCNT(j)  (256  + 64 * (j))
#define XB_XSUB(j)  (1280 + 64 * (j))
#define XB_XGEN(j)  (2304 + 64 * (j))
#define XB_TOP      3328
#define XB_TOPGEN   3392
#define XCD_BAR_WORDS 3456
#define XB_SPIN_CAP (1u << 22)
DI unsigned xb_ld(unsigned* p)              { return __hip_atomic_load(p, __ATOMIC_RELAXED, __HIP_MEMORY_SCOPE_AGENT); }
DI unsigned xb_add(unsigned* p, unsigned v) { return __hip_atomic_fetch_add(p, v, __ATOMIC_RELAXED, __HIP_MEMORY_SCOPE_AGENT); }
DI unsigned xb_xcc_id() { return (unsigned)__builtin_amdgcn_s_getreg((3 << 11) | 20) & 0xFu; }
#define XB_SPIN(cond, bar) do { unsigned _sp = 0; while (cond) { __builtin_amdgcn_s_sleep(1); \
    if ((++_sp & 255u) == 0u) { if (xb_ld(&(bar)[XB_TMO])) break; if (_sp > XB_SPIN_CAP) { atomicAdd(&(bar)[XB_TMO], 1u); break; } } } } while (0)
struct XcdBarrier { unsigned* bar; unsigned x; volatile LAS unsigned* st; };
DI XcdBarrier xcd_barrier_post(unsigned* bar, volatile LAS unsigned* st) {
    XcdBarrier b; b.bar = bar; b.x = xb_xcc_id(); b.st = st;
    if (threadIdx.x == 0) st[2] = xb_add(&bar[XB_XCNT(b.x)], 1u);
    return b;
}
DI void xcd_barrier_complete(unsigned* bar, unsigned x, unsigned& nloc, unsigned& nx) {
    const unsigned G = gridDim.x * gridDim.y * gridDim.z;
    unsigned sum, cnt, mine, sp = 0u;
    for (;;) {
        sum = 0u; cnt = 0u; mine = 0u;
#pragma unroll
        for (unsigned j = 0; j < 16; ++j) { const unsigned c = xb_ld(&bar[XB_XCNT(j)]); sum += c; cnt += (c > 0u) ? 1u : 0u; mine = (j == x) ? c : mine; }
        if (sum == G) break;
        __builtin_amdgcn_s_sleep(1);
        if ((++sp & 255u) == 0u) { if (xb_ld(&bar[XB_TMO])) break; if (sp > XB_SPIN_CAP) { atomicAdd(&bar[XB_TMO], 1u); break; } }
    }
    nloc = mine > 0u ? mine : 1u; nx = cnt > 0u ? cnt : 1u;
}
DI void xcd_barrier(const XcdBarrier& b) {
    asm volatile("s_waitcnt vmcnt(0)" ::: "memory");
    __syncthreads();
    if (threadIdx.x == 0) {
        unsigned* bar = b.bar;
        __builtin_amdgcn_s_waitcnt(0);
        unsigned nloc = b.st[0], nx = b.st[1];
        if (nloc == 0u) { xcd_barrier_complete(bar, b.x, nloc, nx); b.st[0] = nloc; b.st[1] = nx; }
        const unsigned old = xb_add(&bar[XB_XSUB(b.x)], 1u);
        const unsigned gen = old / nloc;
        if (old + 1u == (gen + 1u) * nloc) {
            __builtin_amdgcn_fence(__ATOMIC_RELEASE, "agent");
            asm volatile("s_waitcnt vmcnt(0)" ::: "memory");
            const unsigned og = xb_add(&bar[XB_TOP], 1u);
            const unsigned tg = og / nx;
            if (og + 1u == (tg + 1u) * nx) xb_add(&bar[XB_TOPGEN], 1u);
            else XB_SPIN(xb_ld(&bar[XB_TOPGEN]) == tg, bar);
            __builtin_amdgcn_fence(__ATOMIC_ACQUIRE, "agent");
            xb_add(&bar[XB_XGEN(b.x)], 1u);
            asm volatile("s_waitcnt vmcnt(0)" ::: "memory");
        } else {
            XB_SPIN(xb_ld(&bar[XB_XGEN(b.x)]) == gen, bar);
            __builtin_amdgcn_fence(__ATOMIC_ACQUIRE, "agent");
            asm volatile("s_waitcnt vmcnt(0)" ::: "memory");
        }
    }
    __syncthreads();
}

DI void p0_transpose_item(const float* W, int ldw, int col0, bf16_t* WT, int K, int dst_row0, int kb, float scale, LAS float* scr, int lane) {
    const int k0 = 64 * kb;
#pragma unroll 8
    for (int i = 0; i < 32; ++i) { const int kk = 2 * i + (lane >> 5); scr[kk * 33 + (lane & 31)] = W[(size_t)(k0 + kk) * ldw + col0 + (lane & 31)] * scale; }
    LDS_WAIT(); asm volatile("" ::: "memory");
    const int c = lane & 7;
#pragma unroll
    for (int j = 0; j < 4; ++j) { const int n = (lane >> 3) + 8 * j; const LAS float* s = scr + (8 * c) * 33 + n;
        u32x4 o; o.x = pk2(s[0 * 33], s[1 * 33]); o.y = pk2(s[2 * 33], s[3 * 33]); o.z = pk2(s[4 * 33], s[5 * 33]); o.w = pk2(s[6 * 33], s[7 * 33]);
        *(u32x4*)(WT + (size_t)(dst_row0 + n) * K + k0 + 8 * c) = o; }
    LDS_WAIT(); asm volatile("" ::: "memory");
}


DI void p1_rows2(int m0, int m1, int lane, const float* __restrict__ xin, const float* __restrict__ MODp, bf16_t* __restrict__ H1p, float* __restrict__ GIFp, const float* __restrict__ bif, const LAS float* wif) {
    f32x4 v[2][4], scv[2][4], shv[2][4];
#pragma unroll
    for (int r = 0; r < 2; ++r) { const int m = r ? m1 : m0; const int b = m / SEQ;
        const f32x4* xr = (const f32x4*)(xin + (size_t)m * DM) + lane; const f32x4* sh = (const f32x4*)(MODp + (size_t)b * MODW) + lane; const f32x4* sc = (const f32x4*)(MODp + (size_t)b * MODW + DM) + lane;
#pragma unroll
        for (int j = 0; j < 4; ++j) { v[r][j] = xr[64 * j]; scv[r][j] = sc[64 * j]; shv[r][j] = sh[64 * j]; } }
#pragma unroll
    for (int r = 0; r < 2; ++r) { const int m = r ? m1 : m0; float s = 0.f;
#pragma unroll
        for (int j = 0; j < 4; ++j) s += (v[r][j].x + v[r][j].y) + (v[r][j].z + v[r][j].w);
        const float mean = wave_sum(s) * (1.f / DM); float s2 = 0.f;
#pragma unroll
        for (int j = 0; j < 4; ++j) { v[r][j] = v[r][j] - mean; s2 += (v[r][j].x * v[r][j].x + v[r][j].y * v[r][j].y) + (v[r][j].z * v[r][j].z + v[r][j].w * v[r][j].w); }
        const float rstd = rsqrtf(wave_sum(s2) * (1.f / DM) + LN_EPS);
        unsigned long long* o8 = (unsigned long long*)(H1p + (size_t)m * DM) + lane;
        float gp[8];
#pragma unroll
        for (int g = 0; g < 8; ++g) gp[g] = 0.f;
        const LAS float* wl = wif + 4 * lane; asm volatile("" : "+v"(wl));
#pragma unroll
        for (int j = 0; j < 4; ++j) { const f32x4 hh = v[r][j] * rstd * (scv[r][j] + 1.0f) + shv[r][j];
            o8[64 * j] = (unsigned long long)pk2(hh.x, hh.y) | ((unsigned long long)pk2(hh.z, hh.w) << 32);
#pragma unroll
            for (int g = 0; g < 8; ++g) { const f32x4 w = *(const LAS f32x4*)(wl + g * 1024 + 256 * j); gp[g] += (hh.x * w.x + hh.y * w.y) + (hh.z * w.z + hh.w * w.w); } }
#pragma unroll
        for (int g = 0; g < 8; ++g) gp[g] = wave_sum(gp[g]);
        if (lane == 0) {
#pragma unroll
            for (int g = 0; g < 8; ++g) GIFp[(size_t)m * 8 + g] = gp[g] + bif[g]; } }
}
DI void p7_rows2(int m0, int m1, int lane, const float* __restrict__ Rp, const float* __restrict__ MODp, const float* __restrict__ g1, const float* __restrict__ b1,
                 float* __restrict__ X1p, bf16_t* __restrict__ H2p, unsigned char* __restrict__ H2Qp, float* __restrict__ SHp) {
    f32x4 v[2][4], scv[2][4], shv[2][4];
#pragma unroll
    for (int r = 0; r < 2; ++r) { const int m = r ? m1 : m0; const int b = m / SEQ;
        const f32x4* rr = (const f32x4*)(Rp + (size_t)m * DM) + lane; const f32x4* sh = (const f32x4*)(MODp + (size_t)b * MODW + 3 * DM) + lane; const f32x4* sc = (const f32x4*)(MODp + (size_t)b * MODW + 4 * DM) + lane;
#pragma unroll
        for (int j = 0; j < 4; ++j) { v[r][j] = rr[64 * j]; scv[r][j] = sc[64 * j]; shv[r][j] = sh[64 * j]; } }
#pragma unroll
    for (int r = 0; r < 2; ++r) { const int m = r ? m1 : m0; float s = 0.f;
#pragma unroll
        for (int j = 0; j < 4; ++j) s += (v[r][j].x + v[r][j].y) + (v[r][j].z + v[r][j].w);
        float mean = wave_sum(s) * (1.f / DM); float s2 = 0.f;
#pragma unroll
        for (int j = 0; j < 4; ++j) { v[r][j] = v[r][j] - mean; s2 += (v[r][j].x * v[r][j].x + v[r][j].y * v[r][j].y) + (v[r][j].z * v[r][j].z + v[r][j].w * v[r][j].w); }
        float rstd = rsqrtf(wave_sum(s2) * (1.f / DM) + LN_EPS);
        f32x4* xo = (f32x4*)(X1p + (size_t)m * DM) + lane; s = 0.f;
#pragma unroll
        for (int j = 0; j < 4; ++j) { v[r][j] = v[r][j] * rstd * ((const f32x4*)g1)[lane + 64 * j] + ((const f32x4*)b1)[lane + 64 * j]; xo[64 * j] = v[r][j]; s += (v[r][j].x + v[r][j].y) + (v[r][j].z + v[r][j].w); }
        mean = wave_sum(s) * (1.f / DM); s2 = 0.f;
#pragma unroll
        for (int j = 0; j < 4; ++j) { v[r][j] = v[r][j] - mean; s2 += (v[r][j].x * v[r][j].x + v[r][j].y * v[r][j].y) + (v[r][j].z * v[r][j].z + v[r][j].w * v[r][j].w); }
        rstd = rsqrtf(wave_sum(s2) * (1.f / DM) + LN_EPS);
        unsigned long long* o8 = (unsigned long long*)(H2p + (size_t)m * DM) + lane;
        float amax = 0.f;
#pragma unroll
        for (int j = 0; j < 4; ++j) { const f32x4 hh = v[r][j] * rstd * (scv[r][j] + 1.0f) + shv[r][j]; o8[64 * j] = (unsigned long long)pk2(hh.x, hh.y) | ((unsigned long long)pk2(hh.z, hh.w) << 32);
            v[r][j] = hh; amax = fmaxf(amax, fmaxf(fmaxf(fabsf(hh.x), fabsf(hh.y)), fmaxf(fabsf(hh.z), fabsf(hh.w)))); }
#pragma unroll
        for (int o = 1; o < 64; o <<= 1) amax = fmaxf(amax, __shfl_xor(amax, o));
        const float qinv = amax > 0.f ? 127.0f / amax : 0.f;
        unsigned* q4 = (unsigned*)(H2Qp + (size_t)m * DM) + lane;
#pragma unroll
        for (int j = 0; j < 4; ++j) { const int q0 = (int)rintf(v[r][j].x * qinv), q1 = (int)rintf(v[r][j].y * qinv), q2 = (int)rintf(v[r][j].z * qinv), q3 = (int)rintf(v[r][j].w * qinv);
            q4[64 * j] = (unsigned)(q0 & 255) | ((unsigned)(q1 & 255) << 8) | ((unsigned)(q2 & 255) << 16) | ((unsigned)(q3 & 255) << 24); }
        if (lane == 0) SHp[m] = amax * (1.0f / 127.0f); }
}

struct Args { const float* in[22]; float* out; unsigned char* ws; int ph_lo, ph_hi; };

__global__ void __launch_bounds__(NWAVES * 64, 2) mega_fwd(Args args) {
    extern __shared__ __attribute__((aligned(16))) unsigned char lds_raw[];
    LAS unsigned char* lds = (LAS unsigned char*)lds_raw;
    volatile LAS unsigned* MISC = (volatile LAS unsigned*)(lds + MISC_OFF);
    const int tid = threadIdx.x, lane = tid & 63, wave = __builtin_amdgcn_readfirstlane(tid >> 6);
    const int G = gridDim.x; const int bx = blockIdx.x; const int vcu = (G % 8 == 0) ? (bx % 8) * (G / 8) + bx / 8 : bx;
    const int gw = vcu * NWAVES + wave, NGW = G * NWAVES;
#define ws (args.ws)
#define ctl ((unsigned*)(ws + WS_CTL))
#define x_in (args.in[0])
#define cvec (args.in[1])
#define w_ada (args.in[2])
#define b_ada (args.in[3])
#define w_in (args.in[4])
#define b_if (args.in[5])
#define conv_w (args.in[6])
#define conv_b (args.in[7])
#define da_lambda (args.in[8])
#define da_subln_g (args.in[9])
#define ml_norm_g (args.in[10])
#define w_br_attn (args.in[11])
#define w_br_mlstm (args.in[12])
#define w_out (args.in[13])
#define ln1_g (args.in[14])
#define ln1_b (args.in[15])
#define peer_wq (args.in[16])
#define peer_keys (args.in[17])
#define peer_u (args.in[18])
#define peer_v (args.in[19])
#define ln2_g (args.in[20])
#define ln2_b (args.in[21])
#define MOD ((float*)(ws + WS_MOD))
#define GIF ((float*)(ws + WS_GIF))
#define WIN ((bf16_t*)(ws + WS_WIN))
#define WA ((bf16_t*)(ws + WS_WA))
#define WM ((bf16_t*)(ws + WS_WM))
#define WOUT ((bf16_t*)(ws + WS_WOUT))
#define WQ ((bf16_t*)(ws + WS_WQ))
#define UT8 ((unsigned char*)(ws + WS_U))
#define VT8 ((unsigned char*)(ws + WS_V))
#define SUS ((float*)(ws + WS_SU))
#define SVS ((float*)(ws + WS_SV))
#define SHS ((float*)(ws + WS_SH))
#define CSS ((float*)(ws + WS_CS))
#define H2Q ((unsigned char*)(ws + WS_H2Q))
#define SELE ((bf16_t*)(ws + WS_SELE))
#define SELG ((float*)(ws + WS_SELG))
#define PART ((float*)(ws + WS_PART))
#define COEF ((signed char*)(ws + WS_COEF))
#define H1 ((bf16_t*)(ws + WS_H1))
#define Z ((bf16_t*)(ws + WS_Z))
#define R ((float*)(ws + WS_R))
#define X1 ((float*)(ws + WS_X1))
#define H2 ((bf16_t*)(ws + WS_H2))
#define QP ((bf16_t*)(ws + WS_QP))
#define GATES ((bf16_t*)args.out)

    for (int u = tid; u < (LDS_BYTES - MISC_OFF) / 4; u += NWAVES * 64) MISC[u] = 0u;
    __syncthreads();
    XcdBarrier bar; bar.bar = ctl + CW_BAR; bar.x = 0; bar.st = nullptr;
    if (MK_N_LAUNCHES != N_PHASES) bar = xcd_barrier_post(ctl + CW_BAR, MISC + 8);
    const int lo = args.ph_lo, hi = args.ph_hi;
#ifndef PH_MASK
#define PH_MASK 0x3fff
#endif
#define IN(k) (((PH_MASK >> (k)) & 1) && lo <= (k) && (k) < hi)
#define SEAM(k) do { if (IN(k) && IN((k) + 1)) xcd_barrier(bar); } while (0)

    if (IN(0)) {
        if (vcu * NWAVES < 96 * 8) {
            LAS float* sl = (LAS float*)lds;
            for (int i = tid; i < 32 * DM; i += NWAVES * 64) sl[i] = siluf_(cvec[i]);
            __syncthreads();
            for (int it = gw; it < 96 * 8; it += NGW) {
                const int cb = it % 96, ks = it / 96, col = 64 * cb + lane;
                float acc[32];
#pragma unroll
                for (int b = 0; b < 32; ++b) acc[b] = 0.f;
#pragma unroll 4
                for (int k = 128 * ks; k < 128 * ks + 128; ++k) { const float w = w_ada[(size_t)k * MODW + col];
#pragma unroll
                    for (int b = 0; b < 32; ++b) acc[b] += sl[b * DM + k] * w; }
                const float bias = (ks == 0) ? b_ada[col] : 0.f;
#pragma unroll
                for (int b = 0; b < 32; ++b) atomicAdd(MOD + b * MODW + col, acc[b] + bias);
            }
            __syncthreads();
        }
        LAS float* scr = (LAS float*)(lds + wave * 16384);
        for (int it = gw; it < 4096 + 4 * 512; it += NGW) {
            if (it < 4096) { const int kb = it / 256, nb = it % 256, n0 = 32 * nb; p0_transpose_item(w_in, IN_W, n0 < NZ ? n0 : n0 + 8, WIN, DM, n0, kb, n0 < 1024 ? QSCALE : 1.0f, scr, lane); }
            else { const int r = it - 4096, wsel = r / 512, q = r % 512, kb = q / 32, nb = q % 32;
                const float* src = wsel == 0 ? w_br_attn : wsel == 1 ? w_br_mlstm : wsel == 2 ? w_out : peer_wq; bf16_t* dst = wsel == 0 ? WA : wsel == 1 ? WM : wsel == 2 ? WOUT : WQ;
                p0_transpose_item(src, DM, 32 * nb, dst, DM, 32 * nb, kb, 1.0f, scr, lane); }
        }
        for (int row0 = 4 * gw; row0 < 2 * NEXP; row0 += 4 * NGW) {
            f32x4 a[4][4];
#pragma unroll
            for (int r = 0; r < 4; ++r) { const int row = row0 + r; const bool second = row >= NEXP; const int e = second ? row - NEXP : row;
                const float* s = (second ? peer_v : peer_u) + (size_t)e * DM + 16 * lane;
#pragma unroll
                for (int j = 0; j < 4; ++j) a[r][j] = *(const f32x4*)(s + 4 * j); }
#pragma unroll
            for (int r = 0; r < 4; ++r) { const int row = row0 + r; const bool second = row >= NEXP; const int e = second ? row - NEXP : row;
                float amax = 0.f;
#pragma unroll
                for (int j = 0; j < 4; ++j) amax = fmaxf(amax, fmaxf(fmaxf(fabsf(a[r][j].x), fabsf(a[r][j].y)), fmaxf(fabsf(a[r][j].z), fabsf(a[r][j].w))));
#pragma unroll
                for (int o = 1; o < 64; o <<= 1) amax = fmaxf(amax, __shfl_xor(amax, o));
                const float inv = amax > 0.f ? 127.0f / amax : 0.f;
                u32x4 w;
#pragma unroll
                for (int j = 0; j < 4; ++j) { const int q0 = (int)rintf(a[r][j].x * inv), q1 = (int)rintf(a[r][j].y * inv), q2 = (int)rintf(a[r][j].z * inv), q3 = (int)rintf(a[r][j].w * inv);
                    w[j] = (unsigned)(q0 & 255) | ((unsigned)(q1 & 255) << 8) | ((unsigned)(q2 & 255) << 16) | ((unsigned)(q3 & 255) << 24); }
                *(u32x4*)((second ? VT8 : UT8) + (size_t)(lane >> 3) * NEXP * 128 + (size_t)e * 128 + (lane & 7) * 16) = w;
                if (lane == 0) (second ? SVS : SUS)[e] = amax * (1.0f / 127.0f); }
        }
    }
    SEAM(0);
    if (IN(1)) {
        LAS float* wif = (LAS float*)lds;
        for (int i = tid; i < 8192; i += 512) { const int k = i >> 3, j = i & 7; wif[j * 1024 + k] = w_in[(size_t)k * IN_W + NZ + j]; }
        __syncthreads();
        for (int m = gw; m < TOK; m += 2 * NGW) p1_rows2(m, m + NGW, lane, x_in, MOD, H1, GIF, b_if, wif);
    }
#if DUP1
    xcd_barrier(bar);
    if (IN(1)) {
        LAS float* wif = (LAS float*)lds;
        for (int i = tid; i < 8192; i += 512) { const int k = i >> 3, j = i & 7; wif[j * 1024 + k] = w_in[(size_t)k * IN_W + NZ + j]; }
        __syncthreads();
        for (int m = gw; m < TOK; m += 2 * NGW) p1_rows2(m, m + NGW, lane, x_in, MOD, H1, GIF, b_if, wif);
    }
#endif
    SEAM(1);
#ifndef DUP4
#define DUP4 0
#endif
#ifndef DUP6
#define DUP6 0
#endif
#ifndef DUP7
#define DUP7 0
#endif
#ifndef DUP8
#define DUP8 0
#endif
#ifndef DUP1
#define DUP1 0
#endif
#ifndef DUP2
#define DUP2 0
#endif
#ifndef DUP23
#define DUP23 0
#endif
#define P2_BODY if (IN(2)) { pg8::Gemm g{H1, WIN, TOK, NIN, DM, DM, DM}; pg8::StaticOrder S; S.init(TOK, NIN, G, bx); pg8::EpiZ E{Z, GATES}; \
        pg8::gemm_phase<pg8::EpiZ, pg8::StaticOrder, true, true>(lds, g, S, E); }
#define P3_BODY(QOFF) if (IN(3)) { unsigned* qhead = ctl + CW_QUEUE + (QOFF); \
        for (;;) { __syncthreads(); if (tid == 0) MISC[0] = __hip_atomic_fetch_add(qhead, 1u, RLX_AGENT); __syncthreads(); \
            const int id = (int)MISC[0]; if (id >= 128 + 2048) break; \
            if (id < 128) mls::mlstm_unit<false>(lds, Z, GIF, conv_w, conv_b, ml_norm_g, id >> 2, id & 3); \
            else { const int idx = id - 128, qb = 7 - idx / 256, bh = idx % 256; datt::attn_unit<false>(lds, Z, da_lambda, da_subln_g, bh >> 3, bh & 7, qb); } } }
#define P3A_DRY(QOFF) if (IN(3)) { unsigned* qhead = ctl + CW_QUEUE + (QOFF); \
        for (;;) { __syncthreads(); if (tid == 0) MISC[0] = __hip_atomic_fetch_add(qhead, 1u, RLX_AGENT); __syncthreads(); \
            const int id = (int)MISC[0]; if (id >= 2048) break; \
            { const int idx = id, qb = 7 - idx / 256, bh = idx % 256; datt::attn_unit<true>(lds, Z, da_lambda, da_subln_g, bh >> 3, bh & 7, qb); } } }
#define P3M_DRY(QOFF) if (IN(3)) { unsigned* qhead = ctl + CW_QUEUE + (QOFF); \
        for (;;) { __syncthreads(); if (tid == 0) MISC[0] = __hip_atomic_fetch_add(qhead, 1u, RLX_AGENT); __syncthreads(); \
            const int id = (int)MISC[0]; if (id >= 128) break; \
            mls::mlstm_unit<true>(lds, Z, GIF, conv_w, conv_b, ml_norm_g, id >> 2, id & 3); } }
#ifndef DRY3A
#define DRY3A 0
#endif
#ifndef DRY3M
#define DRY3M 0
#endif
    P2_BODY
#if DUP2
    SEAM(2);
    P2_BODY
#endif
    SEAM(2);
#if DRY3A
    P3A_DRY(128)
    if (IN(3)) xcd_barrier(bar);
#endif
#if DRY3M
    P3M_DRY(192)
    if (IN(3)) xcd_barrier(bar);
#endif
    P3_BODY(0)
    SEAM(3);
#if DUP23
    P2_BODY
    SEAM(2);
    P3_BODY(64)
    SEAM(3);
#endif
    if (IN(4)) {
        pg8::Gemm g{Z + ZC_Q, WA, TOK, DM, DM, NZ, DM}; pg8::StaticOrder S; S.init(TOK, DM, G, bx);
        pg8::EpiGate<true> E{GATES, H1};
        pg8::gemm_phase<pg8::EpiGate<true>, pg8::StaticOrder, true, true>(lds, g, S, E);
    }
#if DUP4
    xcd_barrier(bar);
    if (IN(4)) {
        pg8::Gemm g{Z + ZC_Q, WA, TOK, DM, DM, NZ, DM}; pg8::StaticOrder S; S.init(TOK, DM, G, bx);
        pg8::EpiGate<true> E{GATES, H1};
        pg8::gemm_phase<pg8::EpiGate<true>, pg8::StaticOrder, true, true>(lds, g, S, E);
    }
#endif
    SEAM(4);
    if (IN(5)) {
        pg8::Gemm g{Z + ZC_MV, WM, TOK, DM, DM, NZ, DM}; pg8::StaticOrder S; S.init(TOK, DM, G, bx);
        pg8::EpiGate<false> E{GATES + DM, H1};
        pg8::gemm_phase<pg8::EpiGate<false>, pg8::StaticOrder, true, true>(lds, g, S, E);
    }
    SEAM(5);
    if (IN(6)) {
        pg8::Gemm g{H1, WOUT, TOK, DM, DM, DM, DM}; pg8::StaticOrder S; S.init(TOK, DM, G, bx);
        pg8::EpiR E{x_in, MOD, R};
        pg8::gemm_phase<pg8::EpiR, pg8::StaticOrder, true, true>(lds, g, S, E);
    }
#if DUP6
    xcd_barrier(bar);
    if (IN(6)) {
        pg8::Gemm g{H1, WOUT, TOK, DM, DM, DM, DM}; pg8::StaticOrder S; S.init(TOK, DM, G, bx);
        pg8::EpiR E{x_in, MOD, R};
        pg8::gemm_phase<pg8::EpiR, pg8::StaticOrder, true, true>(lds, g, S, E);
    }
#endif
    SEAM(6);
    if (IN(7)) {
        for (int m = gw; m < TOK; m += 2 * NGW) p7_rows2(m, m + NGW, lane, R, MOD, ln1_g, ln1_b, X1, H2, H2Q, SHS);
    }
#if DUP7
    xcd_barrier(bar);
    if (IN(7)) {
        for (int m = gw; m < TOK; m += 2 * NGW) p7_rows2(m, m + NGW, lane, R, MOD, ln1_g, ln1_b, X1, H2, H2Q, SHS);
    }
#endif
    SEAM(7);
    if (IN(8)) {
        pg8::Gemm g{H2, WQ, TOK, DM, DM, DM, DM}; pg8::StaticOrder S; S.init(TOK, DM, G, bx);
        pg8::EpiStore E{QP};
        pg8::gemm_phase<pg8::EpiStore, pg8::StaticOrder, true, true>(lds, g, S, E);
    }
#if DUP8
    xcd_barrier(bar);
    if (IN(8)) {
        pg8::Gemm g{H2, WQ, TOK, DM, DM, DM, DM}; pg8::StaticOrder S; S.init(TOK, DM, G, bx);
        pg8::EpiStore E{QP};
        pg8::gemm_phase<pg8::EpiStore, pg8::StaticOrder, true, true>(lds, g, S, E);
    }
#endif
    SEAM(8);
#ifndef XBAR
#define XBAR 0
#endif
#if XBAR
    for (int xb = 0; xb < XBAR; ++xb) xcd_barrier(bar);
#endif
    if (IN(9)) {
        peer::stage_keys(lds, peer_keys);
        __syncthreads();
        for (int tile = bx; tile < TOK / 32; tile += G) peer::select_tile(lds, QP, tile * 32, SELE, SELG);
    }
    SEAM(9);
    int sx = bx % 8, sr = bx / 8, sn = (G - sx + 7) / 8;
    if (IN(10) || IN(12)) {
        __syncthreads();
        if (tid == 0) { bool phys = (MK_N_LAUNCHES != N_PHASES) && lo == 0 && hi > 10; unsigned mine = 0;
            if (phys) { for (unsigned j = 0; j < 16; ++j) { const unsigned c = xb_ld(&bar.bar[XB_XCNT(j)]); if (j < 8) { if (c == 0u) phys = false; if (j == bar.x) mine = c; } else if (c != 0u) phys = false; } }
            MISC[16] = phys ? bar.x : (unsigned)sx; MISC[17] = phys ? MISC[10] : (unsigned)sr; MISC[18] = phys ? mine : (unsigned)sn; }
        __syncthreads();
        sx = (int)MISC[16]; sr = (int)MISC[17]; sn = (int)MISC[18];
    }
    if (IN(10)) {
        for (int tile = sr; tile < TOK / 32; tile += sn) { __syncthreads(); peer::u_phase_tile(lds, tile, sx, SELE, H2Q, UT8, PART); }
    }
    SEAM(10);
    if (IN(11)) { for (int m = 4 * gw; m < TOK; m += 4 * NGW) peer::red_tokens4((size_t)m, PART, SELE, SELG, SUS, SVS, SHS, COEF, CSS); }
    SEAM(11);
    if (IN(12)) {
        for (int tile = sr; tile < TOK / 32; tile += sn) { __syncthreads(); peer::v_phase_tile(lds, tile, sx, SELE, COEF, CSS, VT8, args.out); }
    }
    SEAM(12);
    if (IN(13)) { for (int m = gw; m < TOK; m += 2 * NGW) peer::final_rows2((size_t)m, (size_t)m + NGW, args.out, X1, MOD, ln2_g, ln2_b); }
#undef IN
#undef SEAM
#undef ws
#undef ctl
#undef x_in
#undef cvec
#undef w_ada
#undef b_ada
#undef w_in
#undef b_if
#undef conv_w
#undef conv_b
#undef da_lambda
#undef da_subln_g
#undef ml_norm_g
#undef w_br_attn
#undef w_br_mlstm
#undef w_out
#undef ln1_g
#undef ln1_b
#undef peer_wq
#undef peer_keys
#undef peer_u
#undef peer_v
#undef ln2_g
#undef ln2_b
#undef MOD
#undef GIF
#undef WIN
#undef WA
#undef WM
#undef WOUT
#undef WQ
#undef UT8
#undef VT8
#undef SUS
#undef SVS
#undef SHS
#undef CSS
#undef H2Q
#undef SELE
#undef SELG
#undef PART
#undef COEF
#undef H1
#undef Z
#undef R
#undef X1
#undef H2
#undef QP
#undef GATES
}

extern "C" void kernel_launch(void* const* d_in, const int* in_sizes, int n_in, void* d_out, int out_size, void* d_ws, size_t ws_size, hipStream_t stream) {
    static int grid = 0;
    if (grid == 0) {
        if (n_in != 22 || in_sizes[0] != TOK * DM || out_size != TOK * DM || ws_size < WS_END) { fprintf(stderr, "kernel_launch: unexpected shapes (n_in %d, in0 %d, out %d, ws %zu; need ws >= %zu)\n", n_in, n_in > 0 ? in_sizes[0] : -1, out_size, ws_size, (size_t)WS_END); grid = -1; return; }
        int dev = 0, cus = 0, per_cu = 0;
        if (hipGetDevice(&dev) != hipSuccess || hipDeviceGetAttribute(&cus, hipDeviceAttributeMultiprocessorCount, dev) != hipSuccess) { fprintf(stderr, "kernel_launch: device query failed\n"); grid = -1; return; }
        if (hipFuncSetAttribute((const void*)mega_fwd, hipFuncAttributeMaxDynamicSharedMemorySize, LDS_BYTES) != hipSuccess) { fprintf(stderr, "kernel_launch: hipFuncSetAttribute failed\n"); grid = -1; return; }
        if (hipOccupancyMaxActiveBlocksPerMultiprocessor(&per_cu, (const void*)mega_fwd, NWAVES * 64, LDS_BYTES) != hipSuccess || per_cu < 1) fprintf(stderr, "kernel_launch: note: occupancy query reports %d workgroups per CU\n", per_cu);
        (void)hipGetLastError();
        grid = cus;
    }
    if (grid < 0) return;
    if (hipMemsetAsync((char*)d_ws + WS_CTL, 0, CTL_ZERO_BYTES, stream) != hipSuccess) { fprintf(stderr, "kernel_launch: memset failed\n"); return; }
    Args a{};
    for (int i = 0; i < 22; ++i) a.in[i] = (const float*)d_in[i];
    a.out = (float*)d_out; a.ws = (unsigned char*)d_ws;
    for (int li = 0; li < MK_N_LAUNCHES; ++li) {
        a.ph_lo = (MK_N_LAUNCHES == N_PHASES) ? li : 0; a.ph_hi = (MK_N_LAUNCHES == N_PHASES) ? li + 1 : N_PHASES;
        hipLaunchKernelGGL(mega_fwd, dim3(grid), dim3(NWAVES * 64), LDS_BYTES, stream, a);
        const hipError_t le = hipPeekAtLastError();
        if (le != hipSuccess) { fprintf(stderr, "kernel_launch: launch %d failed: %s\n", li, hipGetErrorName(le)); break; }
    }
}
```

```cpp
#include <hip/hip_runtime.h>
#include <hip/hip_bf16.h>
#include <cstdio>
#include <cstdint>
#include <cmath>

#define LAS __attribute__((address_space(3)))
#define GAS __attribute__((address_space(1)))
typedef unsigned short bf16_t;
typedef short bf16x8 __attribute__((ext_vector_type(8)));
typedef short s16x4 __attribute__((ext_vector_type(4)));
typedef float f32x2 __attribute__((ext_vector_type(2)));
typedef float f32x4 __attribute__((ext_vector_type(4)));
typedef float f32x16 __attribute__((ext_vector_type(16)));
typedef unsigned u32x2 __attribute__((ext_vector_type(2)));
typedef unsigned u32x4 __attribute__((ext_vector_type(4)));
typedef __bf16 bf16x2_t __attribute__((ext_vector_type(2)));
#define DI __device__ __forceinline__

constexpr int BATCH = 32, SEQ = 2048, DM = 1024, TOK = BATCH * SEQ;
constexpr int NZ = 6144;
constexpr int ZC_Q = 0, ZC_K = 1024, ZC_V = 2048, ZC_MQ = 3072, ZC_MK = 3584, ZC_MV = 4096, ZC_MO = 5120;
constexpr int NGATE = 2048;
constexpr int NIN = 8192;
constexpr int IN_W = 8200;
constexpr int MODW = 6 * DM;
constexpr float LN_EPS = 1e-5f;
constexpr float ALPHA_RES = 1.189207115002721f;
constexpr float LAMBDA_INIT = 0.2f;
constexpr float QSCALE = 0.125f * 1.4426950408889634f;
constexpr int NEXP = 16384;

constexpr size_t MiB = 1u << 20;
constexpr size_t WS_CTL = 0, CTL_ZERO_BYTES = 2 * MiB;
constexpr size_t WS_MOD = 1 * MiB;
constexpr size_t WS_GIF = 3 * MiB;
constexpr size_t WS_WIN = 6 * MiB;
constexpr size_t WS_WA = 22 * MiB, WS_WM = 24 * MiB, WS_WOUT = 26 * MiB, WS_WQ = 28 * MiB;
constexpr size_t WS_U = 30 * MiB, WS_V = 62 * MiB;
constexpr size_t WS_SU = 2 * MiB, WS_SV = 2 * MiB + 65536, WS_SH = 2 * MiB + 131072, WS_CS = 2 * MiB + 393216;
constexpr size_t WS_H2Q = 96 * MiB, WS_SELE = 160 * MiB, WS_SELG = 176 * MiB;
constexpr size_t WS_H1 = 96 * MiB;
constexpr size_t WS_Z = 224 * MiB;
constexpr size_t WS_R = WS_Z, WS_X1 = WS_Z + 256 * MiB, WS_H2 = WS_Z + 512 * MiB, WS_QP = WS_Z + 640 * MiB;
constexpr size_t WS_PART = WS_R, WS_COEF = WS_H2;
constexpr size_t WS_END = 992 * MiB;
constexpr int CW_BAR = 4096;
constexpr int CW_QUEUE = 16384;

DI unsigned pk2(float lo, float hi) { f32x2 v = {lo, hi}; bf16x2_t b = __builtin_convertvector(v, bf16x2_t); return __builtin_bit_cast(unsigned, b); }
DI float bf_lo(unsigned u) { return __uint_as_float(u << 16); }
DI float bf_hi(unsigned u) { return __uint_as_float(u & 0xffff0000u); }
DI float bf2f(bf16_t h) { return __uint_as_float(((unsigned)h) << 16); }
DI float wave_sum(float v) {
#pragma unroll
    for (int o = 1; o < 64; o <<= 1) v += __shfl_xor(v, o);
    return v;
}
DI float sigmoidf_(float x) { return 1.0f / (1.0f + __expf(-x)); }
DI float siluf_(float x) { return x / (1.0f + __expf(-x)); }
DI int crow(int r, int hi) { return (r & 3) + 8 * (r >> 2) + 4 * hi; }
#define MFMA32(a, b, c) __builtin_amdgcn_mfma_f32_32x32x16_bf16((a), (b), (c), 0, 0, 0)
DI bf16x8 pack_step(const f32x16& x, int s) {
    u32x4 p;
    p[0] = pk2(x[8 * s + 0], x[8 * s + 1]); p[1] = pk2(x[8 * s + 2], x[8 * s + 3]); p[2] = pk2(x[8 * s + 4], x[8 * s + 5]); p[3] = pk2(x[8 * s + 6], x[8 * s + 7]);
    return __builtin_bit_cast(bf16x8, p);
}
DI unsigned off_b(unsigned row, unsigned ch) { return 256u * row + 16u * (ch ^ (((row & 3) << 2) | ((row >> 2) & 3))); }
DI unsigned row_read_addr(unsigned lane, unsigned rt, unsigned s) { return off_b(32 * rt + (lane & 31), 2 * s + (lane >> 5)); }
DI unsigned tr_read_addr(unsigned lane, unsigned c, unsigned ks, unsigned t) {
    const unsigned h = lane >> 5, blk = (lane >> 4) & 1, q = (lane & 15) >> 2, p = lane & 3;
    return off_b(16 * ks + 8 * h + 4 * t + q, 4 * c + 2 * blk + (p >> 1)) + 8 * (p & 1);
}
DI unsigned tr_base(unsigned lane, unsigned t) { const unsigned h = lane >> 5, blk = (lane >> 4) & 1, q = (lane & 15) >> 2, p = lane & 3, cl = 2 * blk + (p >> 1);
    return 256u * (8 * h + 4 * t + q) + 16u * (cl ^ (2 * h + t)) + 8u * (p & 1); }
#define OPAQUE(x) asm volatile("" : "+v"(x))
#define OPAQUE(x) asm volatile("" : "+v"(x))
typedef short v4i16_t __attribute__((ext_vector_type(4)));
DI s16x4 tr_read(const LAS unsigned char* p) { return __builtin_bit_cast(s16x4, __builtin_amdgcn_ds_read_tr16_b64_v4i16((LAS v4i16_t*)p)); }
DI bf16x8 cat8(s16x4 lo, s16x4 hi) { return __builtin_shufflevector(lo, hi, 0, 1, 2, 3, 4, 5, 6, 7); }
namespace pg8 {
#define PG8_LAS __attribute__((address_space(3)))
typedef unsigned short bf16_t;
typedef short bf16x8 __attribute__((ext_vector_type(8)));
typedef float f32x4 __attribute__((ext_vector_type(4)));
typedef unsigned u32x4 __attribute__((ext_vector_type(4)));
constexpr int BM = 256, BK = 64, HALF = 128, HTB = HALF * BK * 2  , STAGE_BYTES = 8 * HTB, NXCD = 8, WGM = 8;

__host__ __device__ __forceinline__ int lds_byte(int r, int c) { const int st = (r >> 4) * 2 + (c >> 5), rr = r & 15, cc = c & 31, ob = rr * 64 + cc * 2; return st * 1024 + (ob ^ (((ob >> 9) & 1) << 5)); }
__host__ __device__ __forceinline__ void stage_rc(int b, int& R, int& C) { const int st = b / 1024, sb = b % 1024, swz = sb ^ (((sb >> 9) & 1) << 5); R = (st >> 1) * 16 + swz / 64; C = (st & 1) * 32 + (swz % 64) / 2; }
__host__ __device__ __forceinline__ int perm32(int rho) { const int n = rho >> 4, i = rho & 15; return 8 * (i >> 2) + 4 * n + (i & 3); }

struct Unit { int pm, pn, ph; };
struct Gemm { const bf16_t* A; const bf16_t* Bt; int M, N, K, lda, ldb; long jA, jB; };

struct StaticOrder {
    int nM, nN, nwg, G, c;
    __host__ __device__ void init(int M, int N, int G_, int c_) { nM = M / BM; nN = N / BM; nwg = nM * nN; G = G_; c = c_; }
    __host__ __device__ bool next(int i, Unit& u) const {
        const long L = (long)i * G + c; if (L >= nwg) return false;
        int wgid = (int)L; { const int q = nwg / NXCD, r = nwg % NXCD, xcd = wgid % NXCD, off = wgid / NXCD; wgid = (xcd < r ? xcd * (q + 1) : r * (q + 1) + (xcd - r) * q) + off; }
        const int nig = WGM * nN, gid = wgid / nig, fm = gid * WGM, gsz = (nM - fm) < WGM ? (nM - fm) : WGM;
        u.pm = fm + ((wgid % nig) % gsz); u.pn = (wgid % nig) / gsz; u.ph = 0; return true;
    }
    __device__ __forceinline__ void a_ready(const Unit&) const {}
    __device__ __forceinline__ void done(const Unit&) const {}
};
struct StaticOrder2 {
    StaticOrder base;
    __host__ __device__ void init(int M, int N, int G_, int c_) { base.init(M, N, G_, c_); }
    __host__ __device__ bool next(int i, Unit& u) const { if (!base.next(i >> 1, u)) return false; u.ph = i & 1; return true; }
    __device__ __forceinline__ void a_ready(const Unit&) const {}
    __device__ __forceinline__ void done(const Unit&) const {}
};
template <class Epi, class Sched, bool ALIGN_EPI = false, bool SP2 = false>
__device__ __forceinline__ void gemm_phase(PG8_LAS unsigned char* lds, const Gemm g, const Sched& S, const Epi& E) {
    const int tid = threadIdx.x, wid = __builtin_amdgcn_readfirstlane(tid >> 6), lane = tid & 63, wr = wid >> 2, wc = wid & 3, fr = lane & 15, fq = lane >> 4;
    const int K = g.K, nt = K / BK;
    unsigned voffA[2], voffB[2];
#pragma unroll
    for (int i = 0; i < 2; ++i) { int R, C; stage_rc(tid * 16 + i * 8192, R, C); const int Rb = Epi::PERM ? ((R & ~31) + perm32(R & 31)) : R;
        voffA[i] = (unsigned)(R * g.lda + C) * 2u; voffB[i] = (unsigned)(Rb * g.ldb + C) * 2u; }
    const size_t kstep = (size_t)(BK * 2);
    const size_t hstepA = (size_t)HALF * g.lda * 2, hstepB = (size_t)HALF * g.ldb * 2;
    const size_t tstepA = 2 * hstepA, tstepB = 2 * hstepB;
    const unsigned ldsw = (unsigned)wid * 1024u;
    const int aoff = lds_byte(wr * 64 + fr, fq * 8), boff = lds_byte(wc * 32 + fr, fq * 8);
#define PG8_SA(b, h) (((b) * 2 + (h)) * HTB)
#define PG8_SB(b, h) ((4 + (b) * 2 + (h)) * HTB)
#define PG8_STAGE(bufoff, gbase, voff) do { _Pragma("unroll") for (int _i = 0; _i < 2; ++_i) \
        __builtin_amdgcn_global_load_lds((const unsigned*)((const char*)(gbase) + (voff)[_i]), (PG8_LAS unsigned*)(lds + (bufoff) + ldsw + _i * 8192), 16, 0, 0); } while (0)
#define PG8_LDA(dst, b, h) do { _Pragma("unroll") for (int m = 0; m < 4; ++m) _Pragma("unroll") for (int k = 0; k < 2; ++k) dst[m][k] = *(const PG8_LAS bf16x8*)(lds + PG8_SA(b, h) + aoff + m * 2048 + k * 1024); } while (0)
#define PG8_LDB(dst, b, h) do { _Pragma("unroll") for (int n = 0; n < 2; ++n) _Pragma("unroll") for (int k = 0; k < 2; ++k) dst[n][k] = *(const PG8_LAS bf16x8*)(lds + PG8_SB(b, h) + boff + n * 2048 + k * 1024); } while (0)
#define PG8_MMA(ai, bj, At, Bt) do { __builtin_amdgcn_s_setprio(1); _Pragma("unroll") for (int m = 0; m < 4; ++m) _Pragma("unroll") for (int n = 0; n < 2; ++n) _Pragma("unroll") for (int k = 0; k < 2; ++k) \
        acc[ai][bj][m][n] = __builtin_amdgcn_mfma_f32_16x16x32_bf16(Bt[n][k], At[m][k], acc[ai][bj][m][n], 0, 0, 0); __builtin_amdgcn_s_setprio(0); } while (0)
#define PG8_WAIT_V(n) asm volatile("s_waitcnt vmcnt(" #n ")" ::: "memory")
#define PG8_WAIT_L(n) asm volatile("s_waitcnt lgkmcnt(" #n ")" ::: "memory")
#define PG8_BAR __builtin_amdgcn_s_barrier()
#define PG8_SCHED __builtin_amdgcn_sched_barrier(0)
    Unit cur, nxt; int ui = 0;
    if (!S.next(0, cur)) return;
    f32x4 acc[2][2][4][2];
#pragma unroll
    for (int a = 0; a < 2; ++a)
#pragma unroll
        for (int b = 0; b < 2; ++b)
#pragma unroll
            for (int m = 0; m < 4; ++m)
#pragma unroll
                for (int n = 0; n < 2; ++n) acc[a][b][m][n] = (f32x4){0.f, 0.f, 0.f, 0.f};
    bf16x8 At[4][2], B0[2][2], B1[2][2];
    const char* cA = (const char*)g.A + (size_t)cur.pm * tstepA + cur.ph * g.jA; const char* cB = (const char*)g.Bt + (size_t)cur.pn * tstepB + cur.ph * g.jB;
    S.a_ready(cur);
    if constexpr (SP2) {
        PG8_STAGE(PG8_SB(0, 0), cB, voffB); PG8_STAGE(PG8_SB(0, 1), cB + hstepB, voffB); PG8_STAGE(PG8_SA(0, 0), cA, voffA); PG8_STAGE(PG8_SA(0, 1), cA + hstepA, voffA);
        if (wr == 1) PG8_BAR;
        PG8_WAIT_V(2); PG8_BAR;
        PG8_STAGE(PG8_SB(1, 0), cB + kstep, voffB); PG8_STAGE(PG8_SA(1, 0), cA + kstep, voffA); PG8_STAGE(PG8_SB(1, 1), cB + hstepB + kstep, voffB);
        PG8_WAIT_V(6); PG8_BAR;
    } else {
        PG8_STAGE(PG8_SB(0, 0), cB, voffB); PG8_STAGE(PG8_SA(0, 0), cA, voffA); PG8_STAGE(PG8_SB(0, 1), cB + hstepB, voffB); PG8_STAGE(PG8_SA(0, 1), cA + hstepA, voffA);
        if (wr == 1) PG8_BAR;
        PG8_WAIT_V(4); PG8_BAR;
        PG8_STAGE(PG8_SB(1, 0), cB + kstep, voffB); PG8_STAGE(PG8_SA(1, 0), cA + kstep, voffA); PG8_STAGE(PG8_SB(1, 1), cB + hstepB + kstep, voffB);
        PG8_WAIT_V(6); PG8_BAR;
    }
    for (;;) {
        const bool has_next = S.next(ui + 1, nxt);
        const char* nA = has_next ? (const char*)g.A + (size_t)nxt.pm * tstepA + nxt.ph * g.jA : cA; const char* nB = has_next ? (const char*)g.Bt + (size_t)nxt.pn * tstepB + nxt.ph * g.jB : cB;
        for (int t = 0; t < nt; t += 2) {
            const bool last = (t == nt - 2);
            const char* a1 = cA + (size_t)(t + 1) * kstep;
            const char* a2 = last ? nA : cA + (size_t)(t + 2) * kstep; const char* b2 = last ? nB : cB + (size_t)(t + 2) * kstep;
            const char* a3 = a2 + kstep; const char* b3 = b2 + kstep;
            if (last && has_next) S.a_ready(nxt);
            if constexpr (SP2) {
            PG8_LDB(B0, 0, 0); PG8_LDB(B1, 0, 1); PG8_SCHED; PG8_LDA(At, 0, 0); PG8_STAGE(PG8_SA(1, 1), a1 + hstepA, voffA);
            PG8_WAIT_V(8); PG8_WAIT_L(0); PG8_BAR; PG8_MMA(0, 0, At, B0); PG8_MMA(0, 1, At, B1); PG8_BAR; PG8_SCHED;
            PG8_LDA(At, 0, 1); PG8_STAGE(PG8_SB(0, 0), b2, voffB); PG8_STAGE(PG8_SB(0, 1), b2 + hstepB, voffB); PG8_STAGE(PG8_SA(0, 0), a2, voffA);
            PG8_WAIT_V(8); PG8_WAIT_L(0); PG8_BAR; PG8_MMA(1, 0, At, B0); PG8_MMA(1, 1, At, B1); PG8_BAR; PG8_SCHED;
            PG8_LDB(B0, 1, 0); PG8_LDB(B1, 1, 1); PG8_SCHED; PG8_LDA(At, 1, 0); PG8_STAGE(PG8_SA(0, 1), a2 + hstepA, voffA);
            PG8_WAIT_V(8); PG8_WAIT_L(0); PG8_BAR; PG8_MMA(0, 0, At, B0); PG8_MMA(0, 1, At, B1); PG8_BAR; PG8_SCHED;
            PG8_LDA(At, 1, 1); PG8_STAGE(PG8_SB(1, 0), b3, voffB); PG8_STAGE(PG8_SB(1, 1), b3 + hstepB, voffB); PG8_STAGE(PG8_SA(1, 0), a3, voffA);
            PG8_WAIT_V(8); PG8_WAIT_L(0); PG8_BAR; PG8_MMA(1, 0, At, B0); PG8_MMA(1, 1, At, B1); PG8_BAR; PG8_SCHED;
            } else {
            PG8_LDB(B0, 0, 0); PG8_SCHED; PG8_LDA(At, 0, 0); PG8_STAGE(PG8_SA(1, 1), a1 + hstepA, voffA);
            PG8_WAIT_L(8); PG8_BAR; PG8_WAIT_L(0); PG8_MMA(0, 0, At, B0); PG8_BAR; PG8_SCHED;
            PG8_LDB(B1, 0, 1); PG8_STAGE(PG8_SB(0, 0), b2, voffB);
            PG8_BAR; PG8_WAIT_L(0); PG8_MMA(0, 1, At, B1); PG8_BAR;
            PG8_LDA(At, 0, 1); PG8_STAGE(PG8_SA(0, 0), a2, voffA);
            PG8_BAR; PG8_WAIT_L(0); PG8_MMA(1, 0, At, B0); PG8_BAR; PG8_SCHED;
            PG8_STAGE(PG8_SB(0, 1), b2 + hstepB, voffB);
            PG8_WAIT_V(6); PG8_BAR; PG8_MMA(1, 1, At, B1); PG8_BAR;
            PG8_LDB(B0, 1, 0); PG8_SCHED; PG8_LDA(At, 1, 0); PG8_STAGE(PG8_SA(0, 1), a2 + hstepA, voffA);
            PG8_WAIT_L(8); PG8_BAR; PG8_WAIT_L(0); PG8_MMA(0, 0, At, B0); PG8_BAR; PG8_SCHED;
            PG8_LDB(B1, 1, 1); PG8_STAGE(PG8_SB(1, 0), b3, voffB);
            PG8_BAR; PG8_WAIT_L(0); PG8_MMA(0, 1, At, B1); PG8_BAR;
            PG8_LDA(At, 1, 1); PG8_STAGE(PG8_SA(1, 0), a3, voffA);
            PG8_BAR; PG8_WAIT_L(0); PG8_MMA(1, 0, At, B0); PG8_BAR; PG8_SCHED;
            PG8_STAGE(PG8_SB(1, 1), b3 + hstepB, voffB);
            PG8_WAIT_V(6); PG8_BAR; PG8_MMA(1, 1, At, B1); PG8_BAR;
            }
        }
        if constexpr (ALIGN_EPI) { if (wr == 0) PG8_BAR; }
        bool keep_acc = false;
        if constexpr (Epi::HAS_MID) { keep_acc = (cur.ph == 0) && has_next; }
        if constexpr (!Epi::AFTER_DRAIN) { if constexpr (Epi::HAS_MID) { if (keep_acc) E.mid(acc, cur, wr, wc, fr, fq); else E(acc, cur, wr, wc, fr, fq); } else E(acc, cur, wr, wc, fr, fq); S.done(cur); }
        if (!has_next) break;
        if (!keep_acc)
#pragma unroll
        for (int a = 0; a < 2; ++a)
#pragma unroll
            for (int b = 0; b < 2; ++b)
#pragma unroll
                for (int m = 0; m < 4; ++m)
#pragma unroll
                    for (int n = 0; n < 2; ++n) acc[a][b][m][n] = (f32x4){0.f, 0.f, 0.f, 0.f};
        cur = nxt; cA = nA; cB = nB; ++ui;
        if constexpr (ALIGN_EPI) { if (wr == 1) PG8_BAR; }
    }
    PG8_WAIT_V(0);
    if constexpr (!ALIGN_EPI) { if (wr == 0) PG8_BAR; }
    PG8_BAR;
    if constexpr (Epi::AFTER_DRAIN) { E.fused(acc, cur, wr, wc, fr, fq, lds, wid, lane); S.done(cur); }
#undef PG8_SA
#undef PG8_SB
#undef PG8_STAGE
#undef PG8_LDA
#undef PG8_LDB
#undef PG8_MMA
#undef PG8_WAIT_V
#undef PG8_WAIT_L
#undef PG8_BAR
#undef PG8_SCHED
}
}
namespace pg8 {
struct EpiZ {
    static constexpr bool PERM = true, AFTER_DRAIN = false, HAS_MID = false;
    bf16_t* Z; bf16_t* G;
    __device__ __forceinline__ void operator()(const f32x4 (&acc)[2][2][4][2], const Unit& u, int wr, int wc, int fr, int fq) const {
        const int row0 = u.pm * BM + wr * 64 + fr, colt = u.pn * BM; const bool gate = colt >= NZ;
        bf16_t* base = gate ? G : Z; const int ld = gate ? NGATE : NZ; const int col0 = (gate ? colt - NZ : colt) + wc * 32 + 8 * fq;
#pragma unroll
        for (int ai = 0; ai < 2; ++ai)
#pragma unroll
            for (int m = 0; m < 4; ++m) { bf16_t* rowp = base + (size_t)(row0 + ai * HALF + m * 16) * ld + col0;
#pragma unroll
                for (int bj = 0; bj < 2; ++bj) { f32x4 v0 = acc[ai][bj][m][0], v1 = acc[ai][bj][m][1];
                    if (gate) {
#pragma unroll
                        for (int e = 0; e < 4; ++e) { v0[e] = sigmoidf_(v0[e]); v1[e] = sigmoidf_(v1[e]); } }
                    ::u32x4 w; w.x = pk2(v0[0], v0[1]); w.y = pk2(v0[2], v0[3]); w.z = pk2(v1[0], v1[1]); w.w = pk2(v1[2], v1[3]);
                    *(::u32x4*)(rowp + bj * HALF) = w; } }
    }
};
template <bool FIRST> struct EpiGate {
    static constexpr bool PERM = true, AFTER_DRAIN = false, HAS_MID = false;
    const bf16_t* G; bf16_t* Y;
    __device__ __forceinline__ void operator()(const f32x4 (&acc)[2][2][4][2], const Unit& u, int wr, int wc, int fr, int fq) const {
        const int row0 = u.pm * BM + wr * 64 + fr, col0 = u.pn * BM + wc * 32 + 8 * fq;
#pragma unroll
        for (int ai = 0; ai < 2; ++ai)
#pragma unroll
            for (int m = 0; m < 4; ++m) { const size_t row = (size_t)(row0 + ai * HALF + m * 16);
#pragma unroll
                for (int bj = 0; bj < 2; ++bj) { const f32x4 v0 = acc[ai][bj][m][0], v1 = acc[ai][bj][m][1];
                    const ::u32x4 g = *(const ::u32x4*)(G + row * NGATE + col0 + bj * HALF);
                    float o[8] = { bf_lo(g.x) * v0[0], bf_hi(g.x) * v0[1], bf_lo(g.y) * v0[2], bf_hi(g.y) * v0[3], bf_lo(g.z) * v1[0], bf_hi(g.z) * v1[1], bf_lo(g.w) * v1[2], bf_hi(g.w) * v1[3] };
                    bf16_t* yp = Y + row * DM + col0 + bj * HALF;
                    if (!FIRST) { const ::u32x4 y = *(const ::u32x4*)yp;
                        o[0] += bf_lo(y.x); o[1] += bf_hi(y.x); o[2] += bf_lo(y.y); o[3] += bf_hi(y.y); o[4] += bf_lo(y.z); o[5] += bf_hi(y.z); o[6] += bf_lo(y.w); o[7] += bf_hi(y.w); }
                    ::u32x4 w; w.x = pk2(o[0], o[1]); w.y = pk2(o[2], o[3]); w.z = pk2(o[4], o[5]); w.w = pk2(o[6], o[7]);
                    *(::u32x4*)yp = w; } }
    }
};
struct EpiR {
    static constexpr bool PERM = true, AFTER_DRAIN = false, HAS_MID = false;
    const float* X; const float* MOD; float* R;
    __device__ __forceinline__ void operator()(const f32x4 (&acc)[2][2][4][2], const Unit& u, int wr, int wc, int fr, int fq) const {
        const int row0 = u.pm * BM + wr * 64 + fr, col0 = u.pn * BM + wc * 32 + 8 * fq;
        const float* gt = MOD + (size_t)((u.pm * BM) / SEQ) * MODW + 2 * DM;
        f32x4 g[2][2];
#pragma unroll
        for (int bj = 0; bj < 2; ++bj) { g[bj][0] = *(const f32x4*)(gt + col0 + bj * HALF); g[bj][1] = *(const f32x4*)(gt + col0 + bj * HALF + 4); }
#pragma unroll
        for (int ai = 0; ai < 2; ++ai)
#pragma unroll
            for (int m = 0; m < 4; ++m) { const size_t off = (size_t)(row0 + ai * HALF + m * 16) * DM + col0;
#pragma unroll
                for (int bj = 0; bj < 2; ++bj) {
                    const f32x4 x0 = *(const f32x4*)(X + off + bj * HALF), x1 = *(const f32x4*)(X + off + bj * HALF + 4);
                    *(f32x4*)(R + off + bj * HALF) = x0 * ALPHA_RES + g[bj][0] * acc[ai][bj][m][0];
                    *(f32x4*)(R + off + bj * HALF + 4) = x1 * ALPHA_RES + g[bj][1] * acc[ai][bj][m][1]; } }
    }
};
struct EpiStore {
    static constexpr bool PERM = true, AFTER_DRAIN = false, HAS_MID = false;
    bf16_t* O;
    __device__ __forceinline__ void operator()(const f32x4 (&acc)[2][2][4][2], const Unit& u, int wr, int wc, int fr, int fq) const {
        const int row0 = u.pm * BM + wr * 64 + fr, col0 = u.pn * BM + wc * 32 + 8 * fq;
#pragma unroll
        for (int ai = 0; ai < 2; ++ai)
#pragma unroll
            for (int m = 0; m < 4; ++m) { bf16_t* rowp = O + (size_t)(row0 + ai * HALF + m * 16) * DM + col0;
#pragma unroll
                for (int bj = 0; bj < 2; ++bj) { const f32x4 v0 = acc[ai][bj][m][0], v1 = acc[ai][bj][m][1];
                    ::u32x4 w; w.x = pk2(v0[0], v0[1]); w.y = pk2(v0[2], v0[3]); w.z = pk2(v1[0], v1[1]); w.w = pk2(v1[2], v1[3]);
                    *(::u32x4*)(rowp + bj * HALF) = w; } }
    }
};
struct EpiGate2 {
    static constexpr bool PERM = true, AFTER_DRAIN = false, HAS_MID = true;
    const bf16_t* G; bf16_t* Y;
    __device__ __forceinline__ void mid(f32x4 (&acc)[2][2][4][2], const Unit& u, int wr, int wc, int fr, int fq) const {
        const int row0 = u.pm * BM + wr * 64 + fr, col0 = u.pn * BM + wc * 32 + 8 * fq;
#pragma unroll
        for (int ai = 0; ai < 2; ++ai)
#pragma unroll
            for (int m = 0; m < 4; ++m) { const size_t row = (size_t)(row0 + ai * HALF + m * 16);
#pragma unroll
                for (int bj = 0; bj < 2; ++bj) {
                    const ::u32x4 ga = *(const ::u32x4*)(G + row * NGATE + col0 + bj * HALF), gm = *(const ::u32x4*)(G + row * NGATE + DM + col0 + bj * HALF);
                    f32x4& v0 = acc[ai][bj][m][0]; f32x4& v1 = acc[ai][bj][m][1];
#define PG8_RAT(a, b) ((a) * __builtin_amdgcn_rcpf(b))
                    v0[0] *= PG8_RAT(bf_lo(ga.x), bf_lo(gm.x)); v0[1] *= PG8_RAT(bf_hi(ga.x), bf_hi(gm.x)); v0[2] *= PG8_RAT(bf_lo(ga.y), bf_lo(gm.y)); v0[3] *= PG8_RAT(bf_hi(ga.y), bf_hi(gm.y));
                    v1[0] *= PG8_RAT(bf_lo(ga.z), bf_lo(gm.z)); v1[1] *= PG8_RAT(bf_hi(ga.z), bf_hi(gm.z)); v1[2] *= PG8_RAT(bf_lo(ga.w), bf_lo(gm.w)); v1[3] *= PG8_RAT(bf_hi(ga.w), bf_hi(gm.w)); }
#undef PG8_RAT
                __builtin_amdgcn_sched_barrier(0); }
    }
    __device__ __forceinline__ void operator()(const f32x4 (&acc)[2][2][4][2], const Unit& u, int wr, int wc, int fr, int fq) const {
        const int row0 = u.pm * BM + wr * 64 + fr, col0 = u.pn * BM + wc * 32 + 8 * fq;
#pragma unroll
        for (int ai = 0; ai < 2; ++ai)
#pragma unroll
            for (int m = 0; m < 4; ++m) { const size_t row = (size_t)(row0 + ai * HALF + m * 16);
#pragma unroll
                for (int bj = 0; bj < 2; ++bj) { const f32x4 v0 = acc[ai][bj][m][0], v1 = acc[ai][bj][m][1];
                    const ::u32x4 g = *(const ::u32x4*)(G + row * NGATE + DM + col0 + bj * HALF);
                    ::u32x4 w; w.x = pk2(bf_lo(g.x) * v0[0], bf_hi(g.x) * v0[1]); w.y = pk2(bf_lo(g.y) * v0[2], bf_hi(g.y) * v0[3]); w.z = pk2(bf_lo(g.z) * v1[0], bf_hi(g.z) * v1[1]); w.w = pk2(bf_lo(g.w) * v1[2], bf_hi(g.w) * v1[3]);
                    *(::u32x4*)(Y + row * DM + col0 + bj * HALF) = w; } }
    }
};
}
namespace datt {
constexpr int KROW = 144;
constexpr int KBUF = 64 * KROW, VBUF = 64 * 256, LDS_K = 0, LDS_V = 2 * KBUF, LDS_ST = LDS_V + 2 * VBUF, STROW = 272, ST_WAVE = 32 * STROW, LDS_BYTES = LDS_ST + 8 * ST_WAVE;
DI unsigned vrow(unsigned key) { return (key & ~12u) | ((key & 4u) << 1) | ((key & 8u) >> 1); }

template <bool DRY> DI void attn_unit(LAS unsigned char* lds, bf16_t* Z, const float* lam, const float* subln_g, int b, int h, int qb) {
    int tid_o = threadIdx.x; OPAQUE(tid_o); const int tid = tid_o, lane = tid & 63, r32 = lane & 31, hi = lane >> 5; const int wid = __builtin_amdgcn_readfirstlane(tid >> 6);
    const size_t rowbase = (size_t)b * SEQ;
    const int q_first = qb * 256 + wid * 32, q_me = q_first + r32;
    float lam_val;
    { const float p1 = lam[lane] * lam[64 + lane], p2 = lam[128 + lane] * lam[192 + lane]; lam_val = __expf(wave_sum(p1)) - __expf(wave_sum(p2)) + LAMBDA_INIT; }
    const int NT = 4 * (qb + 1);
    const int k_key = tid >> 3, k_ch = tid & 7;
    const int v_key0 = tid >> 4, v_ch = tid & 15;
    const unsigned tb0 = LDS_V + tr_base(lane, 0), tb1 = LDS_V + tr_base(lane, 1); unsigned q64 = ((lane & 15) >> 2) << 6;
    const unsigned kb = LDS_K + r32 * KROW + hi * 16;
#pragma unroll
    for (int m = 0; m < 2; ++m) {
        bf16x8 qf[4];
        { const bf16_t* qp = Z + (rowbase + q_me) * NZ + ZC_Q + h * 128 + m * 64 + 8 * hi;
#pragma unroll
          for (int s = 0; s < 4; ++s) qf[s] = *(const bf16x8*)(qp + 16 * s); }
        const bf16_t* ksrc = Z + (rowbase + k_key) * NZ + ZC_K + h * 128 + m * 64 + k_ch * 8;
        const bf16_t* vsrc = Z + (rowbase + v_key0) * NZ + ZC_V + h * 128 + v_ch * 8;
        f32x16 O[4];
#pragma unroll
        for (int c = 0; c < 4; ++c)
#pragma unroll
            for (int r = 0; r < 16; ++r) O[c][r] = 0.f;
        float mrun = -1e30f, lrun = 0.f;
        u32x4 pk_ = *(const u32x4*)ksrc, pv0 = *(const u32x4*)vsrc, pv1 = *(const u32x4*)(vsrc + (size_t)32 * NZ);
        __syncthreads();
        *(LAS u32x4*)(lds + LDS_K + k_key * KROW + k_ch * 16) = pk_;
        *(LAS u32x4*)(lds + LDS_V + off_b(vrow(v_key0), v_ch)) = pv0;
        *(LAS u32x4*)(lds + LDS_V + off_b(vrow(v_key0 + 32), v_ch)) = pv1;
        { const size_t o = (size_t)64 * NZ; pk_ = *(const u32x4*)(ksrc + o); pv0 = *(const u32x4*)(vsrc + o); pv1 = *(const u32x4*)(vsrc + o + (size_t)32 * NZ); }
        __syncthreads();
        for (int kt = 0; kt < NT; ++kt) {
            const int cur = kt & 1, nxt = cur ^ 1;
            if (kt + 1 < NT) {
                *(LAS u32x4*)(lds + LDS_K + nxt * KBUF + k_key * KROW + k_ch * 16) = pk_;
                *(LAS u32x4*)(lds + LDS_V + nxt * VBUF + off_b(vrow(v_key0), v_ch)) = pv0;
                *(LAS u32x4*)(lds + LDS_V + nxt * VBUF + off_b(vrow(v_key0 + 32), v_ch)) = pv1;
                if (kt + 2 < NT) { const size_t o = (size_t)(kt + 2) * 64 * NZ; pk_ = *(const u32x4*)(ksrc + o); pv0 = *(const u32x4*)(vsrc + o); pv1 = *(const u32x4*)(vsrc + o + (size_t)32 * NZ); }
            }
            if (kt * 64 <= q_first + 31) {
            f32x16 p[2];
#pragma unroll
            for (int hf = 0; hf < 2; ++hf) {
#pragma unroll
                for (int r = 0; r < 16; ++r) p[hf][r] = 0.f;
#pragma unroll
                for (int s = 0; s < 4; ++s) { const bf16x8 a = *(const LAS bf16x8*)(lds + kb + cur * KBUF + 32 * hf * KROW + s * 32); p[hf] = MFMA32(a, qf[s], p[hf]); }
            }
            if (kt * 64 + 63 > q_first) {
#pragma unroll
                for (int hf = 0; hf < 2; ++hf)
#pragma unroll
                    for (int r = 0; r < 16; ++r) { const int key = kt * 64 + 32 * hf + crow(r, hi); if (key > q_me) p[hf][r] = -1e30f; }
            }
            float mx = p[0][0];
#pragma unroll
            for (int r = 1; r < 16; ++r) mx = fmaxf(mx, p[0][r]);
#pragma unroll
            for (int r = 0; r < 16; ++r) mx = fmaxf(mx, p[1][r]);
            mx = fmaxf(mx, __shfl_xor(mx, 32));
            const float mnew = fmaxf(mrun, mx), alpha = __builtin_amdgcn_exp2f(mrun - mnew); mrun = mnew;
            float ls = 0.f;
#pragma unroll
            for (int hf = 0; hf < 2; ++hf)
#pragma unroll
                for (int r = 0; r < 16; ++r) { const float e = __builtin_amdgcn_exp2f(p[hf][r] - mnew); p[hf][r] = e; ls += e; }
            lrun = lrun * alpha + ls;
#pragma unroll
            for (int c = 0; c < 4; ++c)
#pragma unroll
                for (int r = 0; r < 16; ++r) O[c][r] *= alpha;
            bf16x8 pf[4];
            pf[0] = pack_step(p[0], 0); pf[1] = pack_step(p[0], 1); pf[2] = pack_step(p[1], 0); pf[3] = pack_step(p[1], 1);
#pragma unroll
            for (int c = 0; c < 4; ++c) { OPAQUE(q64); const unsigned cx = (64u * c) ^ q64;
#pragma unroll
                for (int ks = 0; ks < 4; ++ks) {
                    const s16x4 lo = tr_read(lds + tb0 + cur * VBUF + cx + 4096 * ks), hi4 = tr_read(lds + tb1 + cur * VBUF + cx + 4096 * ks);
                    O[c] = MFMA32(cat8(lo, hi4), pf[ks], O[c]);
                } }
            }
            __syncthreads();
        }
        const float ltot = lrun + __shfl_xor(lrun, 32), inv = 1.0f / ltot;
        if (m == 0) {
            LAS unsigned char* stg = lds + LDS_ST + wid * ST_WAVE;
#pragma unroll
            for (int c = 0; c < 4; ++c)
#pragma unroll
                for (int g4 = 0; g4 < 4; ++g4) { const int dv0 = 32 * c + 8 * g4 + 4 * hi;
                    u32x2 w; w.x = pk2(O[c][4 * g4] * inv, O[c][4 * g4 + 1] * inv); w.y = pk2(O[c][4 * g4 + 2] * inv, O[c][4 * g4 + 3] * inv);
                    *(LAS u32x2*)(stg + r32 * STROW + dv0 * 2) = w; }
        } else {
            const float li = lam_val * inv;
            float ss = 0.f;
            LAS unsigned char* stg = lds + LDS_ST + wid * ST_WAVE;
#pragma unroll
            for (int c = 0; c < 4; ++c)
#pragma unroll
                for (int g4 = 0; g4 < 4; ++g4) { const int dv0 = 32 * c + 8 * g4 + 4 * hi; const u32x2 k2 = *(const LAS u32x2*)(stg + r32 * STROW + dv0 * 2);
                    O[c][4 * g4] = bf_lo(k2.x) - li * O[c][4 * g4]; O[c][4 * g4 + 1] = bf_hi(k2.x) - li * O[c][4 * g4 + 1]; O[c][4 * g4 + 2] = bf_lo(k2.y) - li * O[c][4 * g4 + 2]; O[c][4 * g4 + 3] = bf_hi(k2.y) - li * O[c][4 * g4 + 3];
                    ss += (O[c][4 * g4] * O[c][4 * g4] + O[c][4 * g4 + 1] * O[c][4 * g4 + 1]) + (O[c][4 * g4 + 2] * O[c][4 * g4 + 2] + O[c][4 * g4 + 3] * O[c][4 * g4 + 3]); }
            ss += __shfl_xor(ss, 32);
            const float rstd = rsqrtf(ss * (1.0f / 128.0f) + LN_EPS) * (1.0f - LAMBDA_INIT);
#pragma unroll
            for (int c = 0; c < 4; ++c)
#pragma unroll
                for (int g4 = 0; g4 < 4; ++g4) { const int dv0 = 32 * c + 8 * g4 + 4 * hi; const f32x4 gg = *(const f32x4*)(subln_g + dv0);
                    u32x2 w; w.x = pk2(O[c][4 * g4] * rstd * gg[0], O[c][4 * g4 + 1] * rstd * gg[1]); w.y = pk2(O[c][4 * g4 + 2] * rstd * gg[2], O[c][4 * g4 + 3] * rstd * gg[3]);
                    *(LAS u32x2*)(stg + r32 * STROW + dv0 * 2) = w; }
        }
    }
    LAS unsigned char* stg = lds + LDS_ST + wid * ST_WAVE;
    asm volatile("s_waitcnt lgkmcnt(0)" ::: "memory");
    bf16_t* obase = Z + (rowbase + q_first) * NZ + ZC_Q + h * 128;
#pragma unroll
    for (int i = 0; i < 8; ++i) { const int idx = lane + 64 * i, row = idx >> 4, ch = idx & 15;
        const u32x4 v = *(const LAS u32x4*)(stg + row * STROW + ch * 16); if (!DRY || v.x == 0x12345678u) *(u32x4*)(obase + (size_t)row * NZ + ch * 8) = v; }
}
}
namespace mls {
constexpr int QI = 0, KI = 32768, VI = 65536, SC = 131072;
constexpr int F_IG = 0, F_LF = 128, F_A = 256, F_M = 384, F_INTER = 512, F_EMT = 640, F_W = 768, F_DEN = 896, F_N = 1024, F_MISC = 1152,
              F_NQ2P = 1280, F_NQ1P = 1792, F_NP = 2304, F_RSQ = 2816, F_END = 3840;
constexpr int LDS_BYTES = SC + F_END * 4;
static_assert(LDS_BYTES <= 147456, "mLSTM LDS");

DI float scan_add(float x, int lane) {
#pragma unroll
    for (int o = 1; o < 64; o <<= 1) { const float y = __shfl_up(x, o); if (lane >= o) x += y; }
    return x;
}
DI float scan_max(float x, int lane) {
#pragma unroll
    for (int o = 1; o < 64; o <<= 1) { const float y = __shfl_up(x, o); if (lane >= o) x = fmaxf(x, y); }
    return x;
}
DI float log_sigmoid(float x) { return fminf(x, 0.f) - __logf(1.0f + __expf(-fabsf(x))); }

template <bool DRY> DI void mlstm_unit(LAS unsigned char* lds, bf16_t* Z, const float* GIF, const float* conv_w, const float* conv_b, const float* norm_g, int b, int hd) {
    int tid_o = threadIdx.x; OPAQUE(tid_o); const int tid = tid_o, lane = tid & 63; const int wid = __builtin_amdgcn_readfirstlane(tid >> 6);
    LAS float* sc = (LAS float*)(lds + SC);
#define MLS_LV unsigned L_ = lane; OPAQUE(L_); const unsigned r32 = L_ & 31, hi = L_ >> 5, rowb = 256u * r32, f16 = (((r32 & 3) << 2) | ((r32 >> 2) & 3)) << 4, q64 = ((L_ & 15) >> 2) << 6; (void)rowb; (void)f16; (void)q64; (void)hi
    f32x16 CT[4];
#pragma unroll
    for (int i = 0; i < 4; ++i)
#pragma unroll
        for (int r = 0; r < 16; ++r) CT[i][r] = 0.f;
    float m_prev = 0.f;
    if (tid < 128) sc[F_N + tid] = 0.f;
    const int img = wid >> 2, vc = wid & 3;
    const int st_i = wid >> 1, st_j0 = 2 * (wid & 1);

    u32x4 rawn[11]; float gin = 0.f, gfn = 0.f;
#define MLS_PREFETCH(CC) do { int tp = tid; OPAQUE(tp); const int p_mat = tp >> 8, p_ch = tp & 15, p_rg = (tp >> 4) & 15; const size_t tn = (size_t)b * SEQ + (size_t)(CC) * 128; \
        const bf16_t* srcn = Z + (tn + p_rg * 8) * NZ + (p_mat ? ZC_MK : ZC_MQ) + hd * 128 + p_ch * 8; \
        _Pragma("unroll") for (int j = 0; j < 11; ++j) { const int lp = (CC) * 128 + p_rg * 8 - 3 + j; rawn[j] = (u32x4){0u, 0u, 0u, 0u}; if (lp >= 0) rawn[j] = *(const u32x4*)(srcn + (ptrdiff_t)(j - 3) * NZ); } \
        if (tp < 128) { const float* gg = GIF + (tn + tp) * 8; gin = gg[hd]; gfn = gg[4 + hd]; } } while (0)
    MLS_PREFETCH(0);
    for (int c = 0; c < 16; ++c) {
        const size_t t0 = (size_t)b * SEQ + (size_t)c * 128;
        __syncthreads();
        u32x4 vn[8];
        { int tq = tid; OPAQUE(tq);
#pragma unroll
          for (int i = 0; i < 8; ++i) { const int idx = tq + 512 * i, row = idx >> 5, ch32 = idx & 31; vn[i] = *(const u32x4*)(Z + (t0 + row) * NZ + ZC_MV + hd * 256 + ch32 * 8); } }
        {
            int tq = tid; OPAQUE(tq);
            const int c_mat = tq >> 8, c_ch = tq & 15, c_rg = (tq >> 4) & 15;
            const int chan0 = c_mat * 512 + hd * 128 + c_ch * 8;
            const float kscale = c_mat ? 0.08838834764831845f : 1.0f;
            float cw[4][8], cb[8];
            { const float* cwp = conv_w + chan0; const float* cbp = conv_b + chan0; asm volatile("" : "+v"(cwp), "+v"(cbp));
#pragma unroll
              for (int j = 0; j < 4; ++j) { const f32x4 a = *(const f32x4*)(cwp + j * 1024), c4 = *(const f32x4*)(cwp + j * 1024 + 4);
                cw[j][0] = a[0]; cw[j][1] = a[1]; cw[j][2] = a[2]; cw[j][3] = a[3]; cw[j][4] = c4[0]; cw[j][5] = c4[1]; cw[j][6] = c4[2]; cw[j][7] = c4[3]; }
              const f32x4 a = *(const f32x4*)cbp, c4 = *(const f32x4*)(cbp + 4); cb[0] = a[0]; cb[1] = a[1]; cb[2] = a[2]; cb[3] = a[3]; cb[4] = c4[0]; cb[5] = c4[1]; cb[6] = c4[2]; cb[7] = c4[3]; }
            u32x4 raw[11];
#pragma unroll
            for (int j = 0; j < 11; ++j) raw[j] = rawn[j];
#pragma unroll
            for (int i = 0; i < 8; ++i) {
                float o[8];
#pragma unroll
                for (int e = 0; e < 8; ++e) { const int q = e >> 1; const bool hi_ = e & 1;
                    const float x0 = hi_ ? bf_hi(raw[i][q]) : bf_lo(raw[i][q]), x1 = hi_ ? bf_hi(raw[i + 1][q]) : bf_lo(raw[i + 1][q]), x2 = hi_ ? bf_hi(raw[i + 2][q]) : bf_lo(raw[i + 2][q]), x3 = hi_ ? bf_hi(raw[i + 3][q]) : bf_lo(raw[i + 3][q]);
                    const float y = cb[e] + cw[0][e] * x0 + cw[1][e] * x1 + cw[2][e] * x2 + cw[3][e] * x3; o[e] = siluf_(y) * kscale; }
                u32x4 w; w.x = pk2(o[0], o[1]); w.y = pk2(o[2], o[3]); w.z = pk2(o[4], o[5]); w.w = pk2(o[6], o[7]);
                *(LAS u32x4*)(lds + (c_mat ? KI : QI) + off_b(c_rg * 8 + i, c_ch)) = w;
            }
        }
        { int tq = tid; OPAQUE(tq);
#pragma unroll
        for (int i = 0; i < 8; ++i) { const int idx = tq + 512 * i, row = idx >> 5, ch32 = idx & 31;
            *(LAS u32x4*)(lds + VI + (ch32 >> 4) * 32768 + off_b(row, ch32 & 15)) = vn[i]; } }
        if (tid < 128) { sc[F_IG + tid] = gin; sc[F_LF + tid] = log_sigmoid(gfn);
            if (c > 0) sc[F_N + tid] = sc[F_MISC + 1] * sc[F_N + tid] + (sc[F_NP + tid] + sc[F_NP + 128 + tid]) + (sc[F_NP + 256 + tid] + sc[F_NP + 384 + tid]); }
        __syncthreads();
        if (wid == 0) {
            const float ig0 = sc[F_IG + 2 * lane], ig1 = sc[F_IG + 2 * lane + 1], lf0 = sc[F_LF + 2 * lane], lf1 = sc[F_LF + 2 * lane + 1];
            const float s2 = lf0 + lf1, incl = scan_add(s2, lane), excl = incl - s2;
            const float b0 = excl + lf0, b1 = incl, a0 = ig0 - b0, a1 = ig1 - b1;
            const float im = scan_max(fmaxf(a0, a1), lane); float em = __shfl_up(im, 1); if (lane == 0) em = -3.0e38f;
            const float cm0 = fmaxf(em, a0), cm1 = im;
            const float M0 = fmaxf(m_prev, cm0), M1 = fmaxf(m_prev, cm1);
            const float ML = __shfl(M1, 63), bL = __shfl(b1, 63);
            sc[F_A + 2 * lane] = a0; sc[F_A + 2 * lane + 1] = a1; sc[F_M + 2 * lane] = M0; sc[F_M + 2 * lane + 1] = M1;
            sc[F_INTER + 2 * lane] = __expf(m_prev - M0); sc[F_INTER + 2 * lane + 1] = __expf(m_prev - M1);
            sc[F_EMT + 2 * lane] = __expf(-(b0 + M0)); sc[F_EMT + 2 * lane + 1] = __expf(-(b1 + M1));
            sc[F_W + 2 * lane] = __expf(a0 - ML); sc[F_W + 2 * lane + 1] = __expf(a1 - ML);
            if (lane == 0) sc[F_MISC + 0] = __expf(m_prev - ML);
            m_prev = bL + ML;
        }
        f32x16 sT[2];
#pragma unroll
        for (int jj = 0; jj < 2; ++jj) {
#pragma unroll
            for (int r = 0; r < 16; ++r) sT[jj][r] = 0.f;
            const int j = st_j0 + jj;
            if (j <= st_i) { MLS_LV; const unsigned fh = (16u * hi) ^ f16;
#pragma unroll
                for (int ks = 0; ks < 8; ++ks) { const unsigned xo = rowb + ((32u * ks) ^ fh);
                    const bf16x8 a = *(const LAS bf16x8*)(lds + KI + 8192 * j + xo), q = *(const LAS bf16x8*)(lds + QI + 8192 * st_i + xo);
                    sT[jj] = MFMA32(a, q, sT[jj]); }
            }
        }
        __syncthreads();
        u32x2 pp[2][4];
        { MLS_LV; const int t = 32 * st_i + r32; const float Mt = sc[F_M + t]; const unsigned ab = SC + 4 * F_A + 128 * st_j0 + 16 * hi;
#pragma unroll
          for (int jj = 0; jj < 2; ++jj) { const int j = st_j0 + jj;
#pragma unroll
            for (int g4 = 0; g4 < 4; ++g4) { const int s0 = 32 * j + 8 * g4 + 4 * hi; float pv[4];
#pragma unroll
                for (int e = 0; e < 4; ++e) { const int s = s0 + e; pv[e] = (s <= t) ? __expf(*(const LAS float*)(lds + ab + 4 * (32 * jj + 8 * g4 + e)) - Mt) * sT[jj][4 * g4 + e] : 0.f; }
                pp[jj][g4].x = pk2(pv[0], pv[1]); pp[jj][g4].y = pk2(pv[2], pv[3]); } } }
        f32x16 acc[4];
#pragma unroll
        for (int ti = 0; ti < 4; ++ti)
#pragma unroll
            for (int r = 0; r < 16; ++r) acc[ti][r] = 0.f;
        if (c > 0) {
#pragma unroll
            for (int dt = 0; dt < 4; ++dt)
#pragma unroll
                for (int s2 = 0; s2 < 2; ++s2) { const bf16x8 bfr = pack_step(CT[dt], s2); MLS_LV;
                    const unsigned a0 = QI + rowb + 8 * hi + ((64u * dt + 32u * s2) ^ f16), a1 = QI + rowb + 8 * hi + ((64u * dt + 32u * s2 + 16u) ^ f16);
#pragma unroll
                    for (int ti = 0; ti < 4; ++ti) {
                        const s16x4 lo = *(const LAS s16x4*)(lds + a0 + 8192 * ti), hi4 = *(const LAS s16x4*)(lds + a1 + 8192 * ti);
                        acc[ti] = MFMA32(cat8(lo, hi4), bfr, acc[ti]); }
                    __builtin_amdgcn_sched_barrier(0); }
        }
        { int tq = tid; OPAQUE(tq); const int t = tq & 127, part = tq >> 7; float d = 0.f;
#pragma unroll
          for (int cc = 0; cc < 4; ++cc) { const int ch = 4 * part + cc; const u32x4 raw = *(const LAS u32x4*)(lds + QI + off_b(t, ch)); const LAS float* nn = sc + F_N + 8 * ch;
              d += bf_lo(raw.x) * nn[0] + bf_hi(raw.x) * nn[1] + bf_lo(raw.y) * nn[2] + bf_hi(raw.y) * nn[3] + bf_lo(raw.z) * nn[4] + bf_hi(raw.z) * nn[5] + bf_lo(raw.w) * nn[6] + bf_hi(raw.w) * nn[7]; }
          sc[F_NQ2P + part * 128 + t] = d; }
        __syncthreads();
        { MLS_LV; const unsigned ib = SC + 4 * F_INTER + 16 * hi;
#pragma unroll
          for (int ti = 0; ti < 4; ++ti)
#pragma unroll
            for (int r = 0; r < 16; ++r) acc[ti][r] *= *(const LAS float*)(lds + ib + 4 * (32 * ti + (r & 3) + 8 * (r >> 2))); }
        { MLS_LV;
#pragma unroll
          for (int jj = 0; jj < 2; ++jj) { const int j = st_j0 + jj;
#pragma unroll
            for (int g4 = 0; g4 < 4; ++g4) *(LAS u32x2*)(lds + QI + 8192 * st_i + rowb + 8 * hi + ((64u * j + 16u * g4) ^ f16)) = pp[jj][g4]; } }
        { int tq = tid; OPAQUE(tq);
#pragma unroll
        for (int i = 0; i < 4; ++i) { const int idx = tq + 512 * i, row = idx >> 4, ch = idx & 15; LAS u32x4* p = (LAS u32x4*)(lds + KI + off_b(row, ch)); const u32x4 raw = *p; const float w = sc[F_W + row];
            u32x4 o; o.x = pk2(bf_lo(raw.x) * w, bf_hi(raw.x) * w); o.y = pk2(bf_lo(raw.y) * w, bf_hi(raw.y) * w); o.z = pk2(bf_lo(raw.z) * w, bf_hi(raw.z) * w); o.w = pk2(bf_lo(raw.w) * w, bf_hi(raw.w) * w); *p = o; } }
        __syncthreads();
        { const float decay = sc[F_MISC + 0];
#pragma unroll
          for (int dt = 0; dt < 4; ++dt)
#pragma unroll
            for (int r = 0; r < 16; ++r) CT[dt][r] *= decay; }
#pragma unroll
        for (int ks = 0; ks < 8; ++ks) {
            MLS_LV;
            const unsigned tbv0 = VI + img * 32768 + tr_base(L_, 0) + ((64u * vc) ^ q64), tbv1 = VI + img * 32768 + tr_base(L_, 1) + ((64u * vc) ^ q64);
            const unsigned tbk0 = KI + tr_base(L_, 0), tbk1 = KI + tr_base(L_, 1);
            const bf16x8 bv = cat8(tr_read(lds + tbv0 + 4096 * ks), tr_read(lds + tbv1 + 4096 * ks));
            const unsigned xo = QI + rowb + ((32u * ks) ^ ((16u * hi) ^ f16));
#pragma unroll
            for (int ti = 0; ti < 4; ++ti) if (ks < 2 * (ti + 1)) { const bf16x8 a = *(const LAS bf16x8*)(lds + xo + 8192 * ti); acc[ti] = MFMA32(a, bv, acc[ti]); }
#pragma unroll
            for (int dt = 0; dt < 4; ++dt) { const unsigned cx = (64u * dt) ^ q64; const bf16x8 a = cat8(tr_read(lds + tbk0 + 4096 * ks + cx), tr_read(lds + tbk1 + 4096 * ks + cx)); CT[dt] = MFMA32(a, bv, CT[dt]); }
            __builtin_amdgcn_sched_barrier(0);
        }
        { int tq = tid; OPAQUE(tq); const int t = tq & 127, part = tq >> 7; float d = 0.f;
#pragma unroll
          for (int cc = 0; cc < 4; ++cc) { const u32x4 raw = *(const LAS u32x4*)(lds + QI + off_b(t, 4 * part + cc));
              d += (bf_lo(raw.x) + bf_hi(raw.x)) + (bf_lo(raw.y) + bf_hi(raw.y)) + (bf_lo(raw.z) + bf_hi(raw.z)) + (bf_lo(raw.w) + bf_hi(raw.w)); }
          sc[F_NQ1P + part * 128 + t] = d;
          float nn = 0.f;
          for (int s = 32 * part; s < 32 * part + 32; ++s) nn += bf2f(*(const LAS bf16_t*)(lds + KI + off_b(s, t >> 3) + (t & 7) * 2));
          sc[F_NP + part * 128 + t] = nn;
          if (tid == 0) sc[F_MISC + 1] = sc[F_MISC + 0]; }
        __syncthreads();
        if (tid < 128) { const float nq1 = (sc[F_NQ1P + tid] + sc[F_NQ1P + 128 + tid]) + (sc[F_NQ1P + 256 + tid] + sc[F_NQ1P + 384 + tid]);
            const float nq2 = (sc[F_NQ2P + tid] + sc[F_NQ2P + 128 + tid]) + (sc[F_NQ2P + 256 + tid] + sc[F_NQ2P + 384 + tid]);
            sc[F_DEN + tid] = 1.0f / fmaxf(fabsf(nq1 + sc[F_INTER + tid] * nq2), sc[F_EMT + tid]); }
        __syncthreads();
        u32x4 oraw[8];
        { int tq = tid; OPAQUE(tq);
#pragma unroll
          for (int i = 0; i < 8; ++i) { const int idx = tq + 512 * i, row = idx >> 5, ch = idx & 31; oraw[i] = *(const u32x4*)(Z + (t0 + row) * NZ + hd * 256 + ch * 8 + ZC_MO); } }
        { MLS_LV; const unsigned db = SC + 4 * F_DEN + 16 * hi, hb = VI + 2048 * hi + (32 * wid + r32) * 2;
#pragma unroll
          for (int ti = 0; ti < 4; ++ti)
#pragma unroll
            for (int r = 0; r < 16; ++r) { const int tt = 32 * ti + (r & 3) + 8 * (r >> 2); const float x = acc[ti][r] * *(const LAS float*)(lds + db + 4 * tt);
                *(LAS bf16_t*)(lds + hb + 512 * tt) = (bf16_t)(pk2(x, 0.f) & 0xffffu); } }
        __syncthreads();
        { const int cn = c + 1 < 16 ? c + 1 : 15; MLS_PREFETCH(cn); }
        { int tq = tid; OPAQUE(tq);
          const f32x4 g0 = *(const f32x4*)(norm_g + hd * 256 + (tq & 31) * 8), g1 = *(const f32x4*)(norm_g + hd * 256 + (tq & 31) * 8 + 4);
#pragma unroll
          for (int i = 0; i < 8; ++i) { const int idx = tq + 512 * i, row = idx >> 5, ch = idx & 31;
            const u32x4 hraw = *(const LAS u32x4*)(lds + VI + row * 512 + ch * 16);
            const float h0 = bf_lo(hraw.x), h1 = bf_hi(hraw.x), h2 = bf_lo(hraw.y), h3 = bf_hi(hraw.y), h4 = bf_lo(hraw.z), h5 = bf_hi(hraw.z), h6 = bf_lo(hraw.w), h7 = bf_hi(hraw.w);
            float ssq = (h0 * h0 + h1 * h1) + (h2 * h2 + h3 * h3) + (h4 * h4 + h5 * h5) + (h6 * h6 + h7 * h7);
            ssq += __shfl_xor(ssq, 1); ssq += __shfl_xor(ssq, 2); ssq += __shfl_xor(ssq, 4); ssq += __shfl_xor(ssq, 8); ssq += __shfl_xor(ssq, 16);
            const float rstd = rsqrtf(ssq * (1.0f / 256.0f) + LN_EPS);
            bf16_t* gp = Z + (t0 + row) * NZ + hd * 256 + ch * 8;
            u32x4 o;
            o.x = pk2(h0 * rstd * g0[0] * sigmoidf_(bf_lo(oraw[i].x)), h1 * rstd * g0[1] * sigmoidf_(bf_hi(oraw[i].x)));
            o.y = pk2(h2 * rstd * g0[2] * sigmoidf_(bf_lo(oraw[i].y)), h3 * rstd * g0[3] * sigmoidf_(bf_hi(oraw[i].y)));
            o.z = pk2(h4 * rstd * g1[0] * sigmoidf_(bf_lo(oraw[i].z)), h5 * rstd * g1[1] * sigmoidf_(bf_hi(oraw[i].z)));
            o.w = pk2(h6 * rstd * g1[2] * sigmoidf_(bf_lo(oraw[i].w)), h7 * rstd * g1[3] * sigmoidf_(bf_hi(oraw[i].w)));
            if (!DRY || o.x == 0x12345678u) *(u32x4*)(gp + ZC_MV) = o; } }
    }
    __syncthreads();
}
#undef MLS_LV
#undef MLS_PREFETCH
}
namespace peer {
constexpr int KROW = 144;
constexpr int L_KEYS = 0, L_IDX = 2 * 128 * KROW, LDS_BYTES = L_IDX + 512 * 32;
DI unsigned ordf(float f) { const unsigned u = __float_as_uint(f); return u ^ ((unsigned)((int)u >> 31) | 0x80000000u); }
DI float deord(unsigned k) { return __uint_as_float(k ^ ((~(unsigned)((int)k >> 31)) | 0x80000000u)); }
#define PEER_CE(a, b) do { const unsigned hi_ = (a) > (b) ? (a) : (b), lo_ = (a) > (b) ? (b) : (a); (a) = hi_; (b) = lo_; } while (0)
DI void sort16_desc(unsigned (&a)[16]) {
#pragma unroll
    for (int k = 2; k <= 16; k <<= 1)
#pragma unroll
        for (int j = k >> 1; j >= 1; j >>= 1)
#pragma unroll
            for (int i = 0; i < 16; ++i) { const int l = i ^ j; if (l > i) { if (k == 16 || (i & k) == 0) PEER_CE(a[i], a[l]); else PEER_CE(a[l], a[i]); } }
}
DI void merge16(unsigned (&a)[16], const unsigned (&b)[16]) {
#pragma unroll
    for (int i = 0; i < 16; ++i) a[i] = a[i] > b[15 - i] ? a[i] : b[15 - i];
#pragma unroll
    for (int j = 8; j >= 1; j >>= 1)
#pragma unroll
        for (int i = 0; i < 16; ++i) { const int l = i ^ j; if (l > i) PEER_CE(a[i], a[l]); }
}
DI float gelu_erf(float x) { return 0.5f * x * (1.0f + erff(x * 0.7071067811865476f)); }

DI void stage_keys(LAS unsigned char* lds, const float* keys) {
    for (int i = threadIdx.x; i < 2 * 128 * 8; i += 512) { const int row = i >> 3, ch = i & 7; const float* s = keys + row * 64 + ch * 8;
        const f32x4 a = *(const f32x4*)s, b = *(const f32x4*)(s + 4);
        u32x4 w; w.x = pk2(a[0], a[1]); w.y = pk2(a[2], a[3]); w.z = pk2(b[0], b[1]); w.w = pk2(b[2], b[3]);
        *(LAS u32x4*)(lds + L_KEYS + row * KROW + ch * 16) = w; }
}

DI void select_tile(LAS unsigned char* lds, const bf16_t* QP, int tok0, bf16_t* SELE, float* SELG) {
    int tid_o = threadIdx.x; OPAQUE(tid_o); const int tid = tid_o, lane = tid & 63, r32 = lane & 31, hi = lane >> 5; const int wid = __builtin_amdgcn_readfirstlane(tid >> 6);
    unsigned LA[16], LB[16];
#pragma unroll
    for (int p = 0; p < 2; ++p) {
        bf16x8 qf[4];
        { const bf16_t* qp = QP + (size_t)(tok0 + r32) * DM + wid * 128 + p * 64 + 8 * hi;
#pragma unroll
          for (int s = 0; s < 4; ++s) qf[s] = *(const bf16x8*)(qp + 16 * s); }
        unsigned L[16], M[16];
#pragma unroll
        for (int nt = 0; nt < 4; ++nt) {
            f32x16 acc;
#pragma unroll
            for (int r = 0; r < 16; ++r) acc[r] = 0.f;
#pragma unroll
            for (int s = 0; s < 4; ++s) { const bf16x8 a = *(const LAS bf16x8*)(lds + L_KEYS + (p * 128 + 32 * nt + r32) * KROW + (2 * s + hi) * 16); acc = MFMA32(a, qf[s], acc); }
            unsigned T[16];
#pragma unroll
            for (int r = 0; r < 16; ++r) T[r] = (ordf(acc[r]) & ~0x7Fu) | (unsigned)(32 * nt + crow(r, hi));
            sort16_desc(T);
            if (nt == 0) {
#pragma unroll
                for (int i = 0; i < 16; ++i) L[i] = T[i]; }
            else if (nt == 1) merge16(L, T);
            else if (nt == 2) {
#pragma unroll
                for (int i = 0; i < 16; ++i) M[i] = T[i]; }
            else { merge16(M, T); merge16(L, M); }
        }
        unsigned O[16];
#pragma unroll
        for (int i = 0; i < 16; ++i) O[i] = (unsigned)__shfl_xor((int)L[i], 32);
        merge16(L, O);
#pragma unroll
        for (int i = 0; i < 16; ++i) { if (p == 0) LA[i] = L[i]; else LB[i] = L[i]; }
    }
    unsigned CL[16], CM[16];
    {
        unsigned C4[4][16]; int n = 0;
#pragma unroll
        for (int g = 0; g < 4; ++g)
#pragma unroll
            for (int i = 0; i < 16; ++i) C4[g][i] = 0u;
#pragma unroll
        for (int i = 0; i < 16; ++i) {
            const float sa = deord(LA[i] & ~0x7Fu);
#pragma unroll
            for (int j = 0; j < 16; ++j) if ((i + 1) * (j + 1) <= 16) { const float sb = deord(LB[j] & ~0x7Fu); C4[n >> 4][n & 15] = (ordf(sa + sb) & ~0xFFu) | (unsigned)(i * 16 + j); ++n; }
        }
        sort16_desc(C4[0]); sort16_desc(C4[1]); sort16_desc(C4[2]); sort16_desc(C4[3]);
#pragma unroll
        for (int i = 0; i < 16; ++i) { CL[i] = C4[0][i]; CM[i] = C4[2][i]; }
        merge16(CL, C4[1]); merge16(CM, C4[3]); merge16(CL, CM);
    }
    LAS unsigned char* itab = lds + L_IDX + tid * 32;
    { u32x4 wa, wb;
#pragma unroll
      for (int q = 0; q < 4; ++q) { wa[q] = (LA[4 * q] & 0x7Fu) | ((LA[4 * q + 1] & 0x7Fu) << 8) | ((LA[4 * q + 2] & 0x7Fu) << 16) | ((LA[4 * q + 3] & 0x7Fu) << 24);
                                    wb[q] = (LB[4 * q] & 0x7Fu) | ((LB[4 * q + 1] & 0x7Fu) << 8) | ((LB[4 * q + 2] & 0x7Fu) << 16) | ((LB[4 * q + 3] & 0x7Fu) << 24); }
      *(LAS u32x4*)itab = wa; *(LAS u32x4*)(itab + 16) = wb; }
    const float mx = deord(CL[0] & ~0xFFu);
    float ev[16], sum = 0.f;
#pragma unroll
    for (int k = 0; k < 16; ++k) { ev[k] = __expf(deord(CL[k] & ~0xFFu) - mx); sum += ev[k]; }
    const float inv = 1.0f / sum;
    bf16_t* se = SELE + (size_t)(tok0 + r32) * 128 + wid * 16;
    float* sg = SELG + (size_t)(tok0 + r32) * 128 + wid * 16;
#pragma unroll
    for (int k = 0; k < 16; ++k) if ((k >> 3) == hi) { const unsigned code = CL[k] & 0xFFu; const unsigned n1 = itab[code >> 4], n2 = itab[16 + (code & 15u)];
        se[k] = (bf16_t)(n1 * 128u + n2); sg[k] = ev[k] * inv; }
}

DI void u_phase_tile(LAS unsigned char* lds, int tile, int x, const bf16_t* SELE, const unsigned char* H2Q, const unsigned char* U8S, float* PART) {
    int tid_o = threadIdx.x; OPAQUE(tid_o); const int tid = tid_o, lane = tid & 63, j = lane >> 3, c = lane & 7; const int wid = __builtin_amdgcn_readfirstlane(tid >> 6);
    *(LAS u32x4*)(lds + tid * 16) = *(const u32x4*)(SELE + (size_t)tile * 32 * 128 + tid * 8);
    __syncthreads();
    const unsigned char* Us = U8S + (size_t)x * NEXP * 128 + 16 * c;
#pragma unroll 1
    for (int jt = 0; jt < 4; ++jt) {
        const int tk = wid * 4 + jt; const size_t t = (size_t)tile * 32 + tk;
        const u32x4 hq = *(const u32x4*)(H2Q + t * DM + 128 * x + 16 * c);
        const LAS bf16_t* se = (const LAS bf16_t*)lds + tk * 128 + j;
        u32x4 ur[16];
#pragma unroll
        for (int g = 0; g < 16; ++g) { const unsigned e = se[8 * g]; ur[g] = *(const u32x4*)(Us + (size_t)e * 128); }
        float keep0 = 0.f, keep1 = 0.f;
#pragma unroll
        for (int g = 0; g < 16; ++g) {
            int d = __builtin_amdgcn_sdot4((int)ur[g].x, (int)hq.x, 0, false); d = __builtin_amdgcn_sdot4((int)ur[g].y, (int)hq.y, d, false);
            d = __builtin_amdgcn_sdot4((int)ur[g].z, (int)hq.z, d, false); d = __builtin_amdgcn_sdot4((int)ur[g].w, (int)hq.w, d, false);
            d += __shfl_xor(d, 1); d += __shfl_xor(d, 2); d += __shfl_xor(d, 4);
            if ((g & 7) == c) { if (g < 8) keep0 = (float)d; else keep1 = (float)d; }
        }
        float* pp = PART + t * 1024 + x * 128 + 8 * c + j;
        pp[0] = keep0; pp[64] = keep1;
    }
}
DI void red_tokens4(size_t t0, const float* __restrict__ PART, const bf16_t* __restrict__ SELE, const float* __restrict__ SELG, const float* __restrict__ SU, const float* __restrict__ SV,
                    const float* __restrict__ SH, signed char* __restrict__ COEFQ, float* __restrict__ CS) {
    const int lane = threadIdx.x & 63;
    float s[4][2], g[4][2], su[4][2], sv[4][2], sh[4];
#pragma unroll
    for (int q = 0; q < 4; ++q) { const size_t t = t0 + q; sh[q] = SH[t];
#pragma unroll
        for (int h = 0; h < 2; ++h) { const int k = lane + 64 * h; const unsigned e = SELE[t * 128 + k]; g[q][h] = SELG[t * 128 + k]; su[q][h] = SU[e]; sv[q][h] = SV[e];
            float a = 0.f;
#pragma unroll
            for (int xx = 0; xx < 8; ++xx) a += PART[t * 1024 + xx * 128 + k];
            s[q][h] = a; } }
#pragma unroll
    for (int q = 0; q < 4; ++q) { const size_t t = t0 + q;
        const float c0 = g[q][0] * gelu_erf(s[q][0] * su[q][0] * sh[q]) * sv[q][0], c1 = g[q][1] * gelu_erf(s[q][1] * su[q][1] * sh[q]) * sv[q][1];
        float cm = fmaxf(fabsf(c0), fabsf(c1));
#pragma unroll
        for (int o = 1; o < 64; o <<= 1) cm = fmaxf(cm, __shfl_xor(cm, o));
        const float inv = cm > 0.f ? 127.0f / cm : 0.f;
        signed char* cq = COEFQ + t * 128 + (lane & 7) * 16 + (lane >> 3);
        cq[0] = (signed char)(int)rintf(c0 * inv); cq[8] = (signed char)(int)rintf(c1 * inv);
        if (lane == 0) CS[t] = cm * (1.0f / 127.0f); }
}
DI unsigned bperm(unsigned hi, unsigned lo, unsigned sel) { return __builtin_amdgcn_perm(hi, lo, sel); }
DI void v_phase_tile(LAS unsigned char* lds, int tile, int x, const bf16_t* SELE, const signed char* COEFQ, const float* CS, const unsigned char* V8S, float* YF) {
    int tid_o = threadIdx.x; OPAQUE(tid_o); const int tid = tid_o, lane = tid & 63, j = lane >> 3, c = lane & 7; const int wid = __builtin_amdgcn_readfirstlane(tid >> 6);
    *(LAS u32x4*)(lds + tid * 16) = *(const u32x4*)(SELE + (size_t)tile * 32 * 128 + tid * 8);
    if (tid < 256) *(LAS u32x4*)(lds + 8192 + tid * 16) = *(const u32x4*)(COEFQ + (size_t)tile * 32 * 128 + tid * 16);
    __syncthreads();
    const unsigned char* Vs = V8S + (size_t)x * NEXP * 128 + 16 * c;
#pragma unroll 1
    for (int jt = 0; jt < 4; ++jt) {
        const int tk = wid * 4 + jt; const size_t t = (size_t)tile * 32 + tk;
        const LAS bf16_t* se = (const LAS bf16_t*)lds + tk * 128 + j;
        const LAS unsigned* cqp = (const LAS unsigned*)(lds + 8192 + tk * 128 + j * 16);
        u32x4 vr[16];
#pragma unroll
        for (int g = 0; g < 16; ++g) { const unsigned e = se[8 * g]; vr[g] = *(const u32x4*)(Vs + (size_t)e * 128); }
        int acc[16];
#pragma unroll
        for (int i = 0; i < 16; ++i) acc[i] = 0;
#pragma unroll
        for (int qd = 0; qd < 4; ++qd) { const int cp = (int)cqp[qd];
#pragma unroll
            for (int i = 0; i < 4; ++i) { const unsigned w0 = vr[4 * qd][i], w1 = vr[4 * qd + 1][i], w2 = vr[4 * qd + 2][i], w3 = vr[4 * qd + 3][i];
                const unsigned t0 = bperm(w1, w0, 0x05010400u), t1 = bperm(w1, w0, 0x07030602u), t2 = bperm(w3, w2, 0x05010400u), t3 = bperm(w3, w2, 0x07030602u);
                acc[4 * i] = __builtin_amdgcn_sdot4((int)bperm(t2, t0, 0x05040100u), cp, acc[4 * i], false);
                acc[4 * i + 1] = __builtin_amdgcn_sdot4((int)bperm(t2, t0, 0x07060302u), cp, acc[4 * i + 1], false);
                acc[4 * i + 2] = __builtin_amdgcn_sdot4((int)bperm(t3, t1, 0x05040100u), cp, acc[4 * i + 2], false);
                acc[4 * i + 3] = __builtin_amdgcn_sdot4((int)bperm(t3, t1, 0x07060302u), cp, acc[4 * i + 3], false); } }
#pragma unroll
        for (int i = 0; i < 16; ++i) { acc[i] += __shfl_xor(acc[i], 8); acc[i] += __shfl_xor(acc[i], 16); acc[i] += __shfl_xor(acc[i], 32); }
        if (j == 0) { const float sc = CS[t]; float* yp = YF + t * DM + 128 * x + 16 * c;
#pragma unroll
            for (int i = 0; i < 4; ++i) { f32x4 o; o[0] = (float)acc[4 * i] * sc; o[1] = (float)acc[4 * i + 1] * sc; o[2] = (float)acc[4 * i + 2] * sc; o[3] = (float)acc[4 * i + 3] * sc; *(f32x4*)(yp + 4 * i) = o; } }
    }
}
DI void final_rows2(size_t m0, size_t m1, float* YFOUT, const float* __restrict__ X1, const float* __restrict__ MOD, const float* __restrict__ ln_g, const float* __restrict__ ln_b) {
    const int lane = threadIdx.x & 63;
    f32x4 v[2][4];
#pragma unroll
    for (int r = 0; r < 2; ++r) { const size_t m = r ? m1 : m0; const int b = (int)(m / SEQ);
        const f32x4* yr = (const f32x4*)(YFOUT + m * DM) + lane; const f32x4* xr = (const f32x4*)(X1 + m * DM) + lane; const f32x4* gt = (const f32x4*)(MOD + (size_t)b * MODW + 5 * DM) + lane;
#pragma unroll
        for (int q = 0; q < 4; ++q) v[r][q] = xr[64 * q] * ALPHA_RES + gt[64 * q] * yr[64 * q]; }
#pragma unroll
    for (int r = 0; r < 2; ++r) { const size_t m = r ? m1 : m0; float s = 0.f;
#pragma unroll
        for (int q = 0; q < 4; ++q) s += (v[r][q].x + v[r][q].y) + (v[r][q].z + v[r][q].w);
        const float mean = wave_sum(s) * (1.f / DM); float s2 = 0.f;
#pragma unroll
        for (int q = 0; q < 4; ++q) { v[r][q] = v[r][q] - mean; s2 += (v[r][q].x * v[r][q].x + v[r][q].y * v[r][q].y) + (v[r][q].z * v[r][q].z + v[r][q].w * v[r][q].w); }
        const float rstd = rsqrtf(wave_sum(s2) * (1.f / DM) + LN_EPS);
        f32x4* op = (f32x4*)(YFOUT + m * DM) + lane;
#pragma unroll
        for (int q = 0; q < 4; ++q) op[64 * q] = v[r][q] * rstd * ((const f32x4*)ln_g)[lane + 64 * q] + ((const f32x4*)ln_b)[lane + 64 * q]; }
}
}
constexpr int NWAVES = 8;
#ifndef MK_N_LAUNCHES
#define MK_N_LAUNCHES 1
#endif
constexpr int N_PHASES = 14;
constexpr int RING_BYTES = 147456;
constexpr int MISC_OFF = RING_BYTES;
constexpr int LDS_BYTES = RING_BYTES + 4096;
static_assert(pg8::STAGE_BYTES <= RING_BYTES && datt::LDS_BYTES <= RING_BYTES && mls::LDS_BYTES <= RING_BYTES && peer::LDS_BYTES <= RING_BYTES, "LDS map");

typedef GAS unsigned gu32;
#define RLX_AGENT __ATOMIC_RELAXED, __HIP_MEMORY_SCOPE_AGENT
#define LDS_WAIT() asm volatile("s_waitcnt lgkmcnt(0)" ::: "memory")

#define XB_TMO      128
#define XB_XCNT(j)  (256  + 64 * (j))
#define XB_XSUB(j)  (1280 + 64 * (j))
#define XB_XGEN(j)  (2304 + 64 * (j))
#define XB_TOP      3328
#define XB_TOPGEN   3392
#define XCD_BAR_WORDS 3456
#define XB_SPIN_CAP (1u << 22)
DI unsigned xb_ld(unsigned* p)              { return __hip_atomic_load(p, __ATOMIC_RELAXED, __HIP_MEMORY_SCOPE_AGENT); }
DI unsigned xb_add(unsigned* p, unsigned v) { return __hip_atomic_fetch_add(p, v, __ATOMIC_RELAXED, __HIP_MEMORY_SCOPE_AGENT); }
DI unsigned xb_xcc_id() { return (unsigned)__builtin_amdgcn_s_getreg((3 << 11) | 20) & 0xFu; }
#define XB_SPIN(cond, bar) do { unsigned _sp = 0; while (cond) { __builtin_amdgcn_s_sleep(1); \
    if ((++_sp & 255u) == 0u) { if (xb_ld(&(bar)[XB_TMO])) break; if (_sp > XB_SPIN_CAP) { atomicAdd(&(bar)[XB_TMO], 1u); break; } } } } while (0)
struct XcdBarrier { unsigned* bar; unsigned x; volatile LAS unsigned* st; };
DI XcdBarrier xcd_barrier_post(unsigned* bar, volatile LAS unsigned* st) {
    XcdBarrier b; b.bar = bar; b.x = xb_xcc_id(); b.st = st;
    if (threadIdx.x == 0) st[2] = xb_add(&bar[XB_XCNT(b.x)], 1u);
    return b;
}
DI void xcd_barrier_complete(unsigned* bar, unsigned x, unsigned& nloc, unsigned& nx) {
    const unsigned G = gridDim.x * gridDim.y * gridDim.z;
    unsigned sum, cnt, mine, sp = 0u;
    for (;;) {
        sum = 0u; cnt = 0u; mine = 0u;
#pragma unroll
        for (unsigned j = 0; j < 16; ++j) { const unsigned c = xb_ld(&bar[XB_XCNT(j)]); sum += c; cnt += (c > 0u) ? 1u : 0u; mine = (j == x) ? c : mine; }
        if (sum == G) break;
        __builtin_amdgcn_s_sleep(1);
        if ((++sp & 255u) == 0u) { if (xb_ld(&bar[XB_TMO])) break; if (sp > XB_SPIN_CAP) { atomicAdd(&bar[XB_TMO], 1u); break; } }
    }
    nloc = mine > 0u ? mine : 1u; nx = cnt > 0u ? cnt : 1u;
}
DI void xcd_barrier(const XcdBarrier& b) {
    asm volatile("s_waitcnt vmcnt(0)" ::: "memory");
    __syncthreads();
    if (threadIdx.x == 0) {
        unsigned* bar = b.bar;
        __builtin_amdgcn_s_waitcnt(0);
        unsigned nloc = b.st[0], nx = b.st[1];
        if (nloc == 0u) { xcd_barrier_complete(bar, b.x, nloc, nx); b.st[0] = nloc; b.st[1] = nx; }
        const unsigned old = xb_add(&bar[XB_XSUB(b.x)], 1u);
        const unsigned gen = old / nloc;
        if (old + 1u == (gen + 1u) * nloc) {
            __builtin_amdgcn_fence(__ATOMIC_RELEASE, "agent");
            asm volatile("s_waitcnt vmcnt(0)" ::: "memory");
            const unsigned og = xb_add(&bar[XB_TOP], 1u);
            const unsigned tg = og / nx;
            if (og + 1u == (tg + 1u) * nx) xb_add(&bar[XB_TOPGEN], 1u);
            else XB_SPIN(xb_ld(&bar[XB_TOPGEN]) == tg, bar);
            __builtin_amdgcn_fence(__ATOMIC_ACQUIRE, "agent");
            xb_add(&bar[XB_XGEN(b.x)], 1u);
            asm volatile("s_waitcnt vmcnt(0)" ::: "memory");
        } else {
            XB_SPIN(xb_ld(&bar[XB_XGEN(b.x)]) == gen, bar);
            __builtin_amdgcn_fence(__ATOMIC_ACQUIRE, "agent");
            asm volatile("s_waitcnt vmcnt(0)" ::: "memory");
        }
    }
    __syncthreads();
}

#ifndef FLATBAR
#define FLATBAR 0
#endif
DI void flat_barrier(unsigned* cnt, unsigned& epoch) {
    asm volatile("s_waitcnt vmcnt(0)" ::: "memory");
    __syncthreads();
    if (threadIdx.x == 0) {
        __builtin_amdgcn_fence(__ATOMIC_RELEASE, "agent");
        asm volatile("s_waitcnt vmcnt(0)" ::: "memory");
        const unsigned target = (epoch + 1u) * gridDim.x;
        xb_add(cnt, 1u);
        unsigned sp = 0;
        while (xb_ld(cnt) < target) { __builtin_amdgcn_s_sleep(1); if (++sp > (1u << 24)) break; }
        __builtin_amdgcn_fence(__ATOMIC_ACQUIRE, "agent");
        asm volatile("s_waitcnt vmcnt(0)" ::: "memory");
    }
    ++epoch;
    __syncthreads();
}
DI void p0_transpose_item(const float* W, int ldw, int col0, bf16_t* WT, int K, int dst_row0, int kb, float scale, LAS float* scr, int lane) {
    const int k0 = 64 * kb;
#pragma unroll 8
    for (int i = 0; i < 32; ++i) { const int kk = 2 * i + (lane >> 5); scr[kk * 33 + (lane & 31)] = W[(size_t)(k0 + kk) * ldw + col0 + (lane & 31)] * scale; }
    LDS_WAIT(); asm volatile("" ::: "memory");
    const int c = lane & 7;
#pragma unroll
    for (int j = 0; j < 4; ++j) { const int n = (lane >> 3) + 8 * j; const LAS float* s = scr + (8 * c) * 33 + n;
        u32x4 o; o.x = pk2(s[0 * 33], s[1 * 33]); o.y = pk2(s[2 * 33], s[3 * 33]); o.z = pk2(s[4 * 33], s[5 * 33]); o.w = pk2(s[6 * 33], s[7 * 33]);
        *(u32x4*)(WT + (size_t)(dst_row0 + n) * K + k0 + 8 * c) = o; }
    LDS_WAIT(); asm volatile("" ::: "memory");
}


DI void p1_rows2(int m0, int m1, int lane, const float* __restrict__ xin, const float* __restrict__ MODp, bf16_t* __restrict__ H1p, float* __restrict__ GIFp, const float* __restrict__ bif, const LAS float* wif) {
    f32x4 v[2][4], scv[2][4], shv[2][4];
#pragma unroll
    for (int r = 0; r < 2; ++r) { const int m = r ? m1 : m0; const int b = m / SEQ;
        const f32x4* xr = (const f32x4*)(xin + (size_t)m * DM) + lane; const f32x4* sh = (const f32x4*)(MODp + (size_t)b * MODW) + lane; const f32x4* sc = (const f32x4*)(MODp + (size_t)b * MODW + DM) + lane;
#pragma unroll
        for (int j = 0; j < 4; ++j) { v[r][j] = xr[64 * j]; scv[r][j] = sc[64 * j]; shv[r][j] = sh[64 * j]; } }
#pragma unroll
    for (int r = 0; r < 2; ++r) { const int m = r ? m1 : m0; float s = 0.f;
#pragma unroll
        for (int j = 0; j < 4; ++j) s += (v[r][j].x + v[r][j].y) + (v[r][j].z + v[r][j].w);
        const float mean = wave_sum(s) * (1.f / DM); float s2 = 0.f;
#pragma unroll
        for (int j = 0; j < 4; ++j) { v[r][j] = v[r][j] - mean; s2 += (v[r][j].x * v[r][j].x + v[r][j].y * v[r][j].y) + (v[r][j].z * v[r][j].z + v[r][j].w * v[r][j].w); }
        const float rstd = rsqrtf(wave_sum(s2) * (1.f / DM) + LN_EPS);
        unsigned long long* o8 = (unsigned long long*)(H1p + (size_t)m * DM) + lane;
        float gp[8];
#pragma unroll
        for (int g = 0; g < 8; ++g) gp[g] = 0.f;
        const LAS float* wl = wif + 4 * lane; asm volatile("" : "+v"(wl));
#pragma unroll
        for (int j = 0; j < 4; ++j) { const f32x4 hh = v[r][j] * rstd * (scv[r][j] + 1.0f) + shv[r][j];
            o8[64 * j] = (unsigned long long)pk2(hh.x, hh.y) | ((unsigned long long)pk2(hh.z, hh.w) << 32);
#pragma unroll
            for (int g = 0; g < 8; ++g) { const f32x4 w = *(const LAS f32x4*)(wl + g * 1024 + 256 * j); gp[g] += (hh.x * w.x + hh.y * w.y) + (hh.z * w.z + hh.w * w.w); } }
#pragma unroll
        for (int g = 0; g < 8; ++g) gp[g] = wave_sum(gp[g]);
        if (lane == 0) {
#pragma unroll
            for (int g = 0; g < 8; ++g) GIFp[(size_t)m * 8 + g] = gp[g] + bif[g]; } }
}
DI void p7_rows2(int m0, int m1, int lane, const float* __restrict__ Rp, const float* __restrict__ MODp, const float* __restrict__ g1, const float* __restrict__ b1,
                 float* __restrict__ X1p, bf16_t* __restrict__ H2p, unsigned char* __restrict__ H2Qp, float* __restrict__ SHp) {
    f32x4 v[2][4], scv[2][4], shv[2][4];
#pragma unroll
    for (int r = 0; r < 2; ++r) { const int m = r ? m1 : m0; const int b = m / SEQ;
        const f32x4* rr = (const f32x4*)(Rp + (size_t)m * DM) + lane; const f32x4* sh = (const f32x4*)(MODp + (size_t)b * MODW + 3 * DM) + lane; const f32x4* sc = (const f32x4*)(MODp + (size_t)b * MODW + 4 * DM) + lane;
#pragma unroll
        for (int j = 0; j < 4; ++j) { v[r][j] = rr[64 * j]; scv[r][j] = sc[64 * j]; shv[r][j] = sh[64 * j]; } }
#pragma unroll
    for (int r = 0; r < 2; ++r) { const int m = r ? m1 : m0; float s = 0.f;
#pragma unroll
        for (int j = 0; j < 4; ++j) s += (v[r][j].x + v[r][j].y) + (v[r][j].z + v[r][j].w);
        float mean = wave_sum(s) * (1.f / DM); float s2 = 0.f;
#pragma unroll
        for (int j = 0; j < 4; ++j) { v[r][j] = v[r][j] - mean; s2 += (v[r][j].x * v[r][j].x + v[r][j].y * v[r][j].y) + (v[r][j].z * v[r][j].z + v[r][j].w * v[r][j].w); }
        float rstd = rsqrtf(wave_sum(s2) * (1.f / DM) + LN_EPS);
        f32x4* xo = (f32x4*)(X1p + (size_t)m * DM) + lane; s = 0.f;
#pragma unroll
        for (int j = 0; j < 4; ++j) { v[r][j] = v[r][j] * rstd * ((const f32x4*)g1)[lane + 64 * j] + ((const f32x4*)b1)[lane + 64 * j]; xo[64 * j] = v[r][j]; s += (v[r][j].x + v[r][j].y) + (v[r][j].z + v[r][j].w); }
        mean = wave_sum(s) * (1.f / DM); s2 = 0.f;
#pragma unroll
        for (int j = 0; j < 4; ++j) { v[r][j] = v[r][j] - mean; s2 += (v[r][j].x * v[r][j].x + v[r][j].y * v[r][j].y) + (v[r][j].z * v[r][j].z + v[r][j].w * v[r][j].w); }
        rstd = rsqrtf(wave_sum(s2) * (1.f / DM) + LN_EPS);
        unsigned long long* o8 = (unsigned long long*)(H2p + (size_t)m * DM) + lane;
        float amax = 0.f;
#pragma unroll
        for (int j = 0; j < 4; ++j) { const f32x4 hh = v[r][j] * rstd * (scv[r][j] + 1.0f) + shv[r][j]; o8[64 * j] = (unsigned long long)pk2(hh.x, hh.y) | ((unsigned long long)pk2(hh.z, hh.w) << 32);
            v[r][j] = hh; amax = fmaxf(amax, fmaxf(fmaxf(fabsf(hh.x), fabsf(hh.y)), fmaxf(fabsf(hh.z), fabsf(hh.w)))); }
#pragma unroll
        for (int o = 1; o < 64; o <<= 1) amax = fmaxf(amax, __shfl_xor(amax, o));
        const float qinv = amax > 0.f ? 127.0f / amax : 0.f;
        unsigned* q4 = (unsigned*)(H2Qp + (size_t)m * DM) + lane;
#pragma unroll
        for (int j = 0; j < 4; ++j) { const int q0 = (int)rintf(v[r][j].x * qinv), q1 = (int)rintf(v[r][j].y * qinv), q2 = (int)rintf(v[r][j].z * qinv), q3 = (int)rintf(v[r][j].w * qinv);
            q4[64 * j] = (unsigned)(q0 & 255) | ((unsigned)(q1 & 255) << 8) | ((unsigned)(q2 & 255) << 16) | ((unsigned)(q3 & 255) << 24); }
        if (lane == 0) SHp[m] = amax * (1.0f / 127.0f); }
}

struct Args { const float* in[22]; float* out; unsigned char* ws; int ph_lo, ph_hi; };

__global__ void __launch_bounds__(NWAVES * 64, 2) mega_fwd(Args args) {
    extern __shared__ __attribute__((aligned(16))) unsigned char lds_raw[];
    LAS unsigned char* lds = (LAS unsigned char*)lds_raw;
    volatile LAS unsigned* MISC = (volatile LAS unsigned*)(lds + MISC_OFF);
    const int tid = threadIdx.x, lane = tid & 63, wave = __builtin_amdgcn_readfirstlane(tid >> 6);
    const int G = gridDim.x; const int bx = blockIdx.x; const int vcu = (G % 8 == 0) ? (bx % 8) * (G / 8) + bx / 8 : bx;
    const int gw = vcu * NWAVES + wave, NGW = G * NWAVES;
#define ws (args.ws)
#define ctl ((unsigned*)(ws + WS_CTL))
#define x_in (args.in[0])
#define cvec (args.in[1])
#define w_ada (args.in[2])
#define b_ada (args.in[3])
#define w_in (args.in[4])
#define b_if (args.in[5])
#define conv_w (args.in[6])
#define conv_b (args.in[7])
#define da_lambda (args.in[8])
#define da_subln_g (args.in[9])
#define ml_norm_g (args.in[10])
#define w_br_attn (args.in[11])
#define w_br_mlstm (args.in[12])
#define w_out (args.in[13])
#define ln1_g (args.in[14])
#define ln1_b (args.in[15])
#define peer_wq (args.in[16])
#define peer_keys (args.in[17])
#define peer_u (args.in[18])
#define peer_v (args.in[19])
#define ln2_g (args.in[20])
#define ln2_b (args.in[21])
#define MOD ((float*)(ws + WS_MOD))
#define GIF ((float*)(ws + WS_GIF))
#define WIN ((bf16_t*)(ws + WS_WIN))
#define WA ((bf16_t*)(ws + WS_WA))
#define WM ((bf16_t*)(ws + WS_WM))
#define WOUT ((bf16_t*)(ws + WS_WOUT))
#define WQ ((bf16_t*)(ws + WS_WQ))
#define UT8 ((unsigned char*)(ws + WS_U))
#define VT8 ((unsigned char*)(ws + WS_V))
#define SUS ((float*)(ws + WS_SU))
#define SVS ((float*)(ws + WS_SV))
#define SHS ((float*)(ws + WS_SH))
#define CSS ((float*)(ws + WS_CS))
#define H2Q ((unsigned char*)(ws + WS_H2Q))
#define SELE ((bf16_t*)(ws + WS_SELE))
#define SELG ((float*)(ws + WS_SELG))
#define PART ((float*)(ws + WS_PART))
#define COEF ((signed char*)(ws + WS_COEF))
#define H1 ((bf16_t*)(ws + WS_H1))
#define Z ((bf16_t*)(ws + WS_Z))
#define R ((float*)(ws + WS_R))
#define X1 ((float*)(ws + WS_X1))
#define H2 ((bf16_t*)(ws + WS_H2))
#define QP ((bf16_t*)(ws + WS_QP))
#define GATES ((bf16_t*)args.out)

    for (int u = tid; u < (LDS_BYTES - MISC_OFF) / 4; u += NWAVES * 64) MISC[u] = 0u;
    __syncthreads();
    XcdBarrier bar; bar.bar = ctl + CW_BAR; bar.x = 0; bar.st = nullptr;
    if (MK_N_LAUNCHES != N_PHASES) bar = xcd_barrier_post(ctl + CW_BAR, MISC + 8);
    const int lo = args.ph_lo, hi = args.ph_hi;
#ifndef PH_MASK
#define PH_MASK 0x3fff
#endif
#define IN(k) (((PH_MASK >> (k)) & 1) && lo <= (k) && (k) < hi)
    unsigned fepoch = 0; unsigned* fcnt = ctl + CW_QUEUE + 1024;
#if FLATBAR
#define GBAR() flat_barrier(fcnt, fepoch)
#else
#define GBAR() xcd_barrier(bar)
#endif
#define SEAM(k) do { if (IN(k) && IN((k) + 1)) GBAR(); } while (0)

    if (IN(0)) {
        if (vcu * NWAVES < 96 * 8) {
            LAS float* sl = (LAS float*)lds;
            for (int i = tid; i < 32 * DM; i += NWAVES * 64) sl[i] = siluf_(cvec[i]);
            __syncthreads();
            for (int it = gw; it < 96 * 8; it += NGW) {
                const int cb = it % 96, ks = it / 96, col = 64 * cb + lane;
                float acc[32];
#pragma unroll
                for (int b = 0; b < 32; ++b) acc[b] = 0.f;
#pragma unroll 4
                for (int k = 128 * ks; k < 128 * ks + 128; ++k) { const float w = w_ada[(size_t)k * MODW + col];
#pragma unroll
                    for (int b = 0; b < 32; ++b) acc[b] += sl[b * DM + k] * w; }
                const float bias = (ks == 0) ? b_ada[col] : 0.f;
#pragma unroll
                for (int b = 0; b < 32; ++b) atomicAdd(MOD + b * MODW + col, acc[b] + bias);
            }
            __syncthreads();
        }
        LAS float* scr = (LAS float*)(lds + wave * 16384);
        for (int it = gw; it < 4096 + 4 * 512; it += NGW) {
            if (it < 4096) { const int kb = it / 256, nb = it % 256, n0 = 32 * nb; p0_transpose_item(w_in, IN_W, n0 < NZ ? n0 : n0 + 8, WIN, DM, n0, kb, n0 < 1024 ? QSCALE : 1.0f, scr, lane); }
            else { const int r = it - 4096, wsel = r / 512, q = r % 512, kb = q / 32, nb = q % 32;
                const float* src = wsel == 0 ? w_br_attn : wsel == 1 ? w_br_mlstm : wsel == 2 ? w_out : peer_wq; bf16_t* dst = wsel == 0 ? WA : wsel == 1 ? WM : wsel == 2 ? WOUT : WQ;
                p0_transpose_item(src, DM, 32 * nb, dst, DM, 32 * nb, kb, 1.0f, scr, lane); }
        }
        for (int row0 = 4 * gw; row0 < 2 * NEXP; row0 += 4 * NGW) {
            f32x4 a[4][4];
#pragma unroll
            for (int r = 0; r < 4; ++r) { const int row = row0 + r; const bool second = row >= NEXP; const int e = second ? row - NEXP : row;
                const float* s = (second ? peer_v : peer_u) + (size_t)e * DM + 16 * lane;
#pragma unroll
                for (int j = 0; j < 4; ++j) a[r][j] = *(const f32x4*)(s + 4 * j); }
#pragma unroll
            for (int r = 0; r < 4; ++r) { const int row = row0 + r; const bool second = row >= NEXP; const int e = second ? row - NEXP : row;
                float amax = 0.f;
#pragma unroll
                for (int j = 0; j < 4; ++j) amax = fmaxf(amax, fmaxf(fmaxf(fabsf(a[r][j].x), fabsf(a[r][j].y)), fmaxf(fabsf(a[r][j].z), fabsf(a[r][j].w))));
#pragma unroll
                for (int o = 1; o < 64; o <<= 1) amax = fmaxf(amax, __shfl_xor(amax, o));
                const float inv = amax > 0.f ? 127.0f / amax : 0.f;
                u32x4 w;
#pragma unroll
                for (int j = 0; j < 4; ++j) { const int q0 = (int)rintf(a[r][j].x * inv), q1 = (int)rintf(a[r][j].y * inv), q2 = (int)rintf(a[r][j].z * inv), q3 = (int)rintf(a[r][j].w * inv);
                    w[j] = (unsigned)(q0 & 255) | ((unsigned)(q1 & 255) << 8) | ((unsigned)(q2 & 255) << 16) | ((unsigned)(q3 & 255) << 24); }
                *(u32x4*)((second ? VT8 : UT8) + (size_t)(lane >> 3) * NEXP * 128 + (size_t)e * 128 + (lane & 7) * 16) = w;
                if (lane == 0) (second ? SVS : SUS)[e] = amax * (1.0f / 127.0f); }
        }
    }
    SEAM(0);
    if (IN(1)) {
        LAS float* wif = (LAS float*)lds;
        for (int i = tid; i < 8192; i += 512) { const int k = i >> 3, j = i & 7; wif[j * 1024 + k] = w_in[(size_t)k * IN_W + NZ + j]; }
        __syncthreads();
        for (int m = gw; m < TOK; m += 2 * NGW) p1_rows2(m, m + NGW, lane, x_in, MOD, H1, GIF, b_if, wif);
    }
#if DUP1
    GBAR();
    if (IN(1)) {
        LAS float* wif = (LAS float*)lds;
        for (int i = tid; i < 8192; i += 512) { const int k = i >> 3, j = i & 7; wif[j * 1024 + k] = w_in[(size_t)k * IN_W + NZ + j]; }
        __syncthreads();
        for (int m = gw; m < TOK; m += 2 * NGW) p1_rows2(m, m + NGW, lane, x_in, MOD, H1, GIF, b_if, wif);
    }
#endif
    SEAM(1);
#ifndef DUP4
#define DUP4 0
#endif
#ifndef DUP6
#define DUP6 0
#endif
#ifndef DUP7
#define DUP7 0
#endif
#ifndef DUP8
#define DUP8 0
#endif
#ifndef DUP1
#define DUP1 0
#endif
#ifndef DUP2
#define DUP2 0
#endif
#ifndef DUP23
#define DUP23 0
#endif
#define P2_BODY if (IN(2)) { pg8::Gemm g{H1, WIN, TOK, NIN, DM, DM, DM}; pg8::StaticOrder S; S.init(TOK, NIN, G, bx); pg8::EpiZ E{Z, GATES}; \
        pg8::gemm_phase<pg8::EpiZ, pg8::StaticOrder, true, true>(lds, g, S, E); }
#define P3_BODY(QOFF) if (IN(3)) { unsigned* qhead = ctl + CW_QUEUE + (QOFF); \
        for (;;) { __syncthreads(); if (tid == 0) MISC[0] = __hip_atomic_fetch_add(qhead, 1u, RLX_AGENT); __syncthreads(); \
            const int id = (int)MISC[0]; if (id >= 128 + 2048) break; \
            if (id < 128) mls::mlstm_unit<false>(lds, Z, GIF, conv_w, conv_b, ml_norm_g, id >> 2, id & 3); \
            else { const int idx = id - 128, qb = 7 - idx / 256, bh = idx % 256; datt::attn_unit<false>(lds, Z, da_lambda, da_subln_g, bh >> 3, bh & 7, qb); } } }
#define P3A_DRY(QOFF) if (IN(3)) { unsigned* qhead = ctl + CW_QUEUE + (QOFF); \
        for (;;) { __syncthreads(); if (tid == 0) MISC[0] = __hip_atomic_fetch_add(qhead, 1u, RLX_AGENT); __syncthreads(); \
            const int id = (int)MISC[0]; if (id >= 2048) break; \
            { const int idx = id, qb = 7 - idx / 256, bh = idx % 256; datt::attn_unit<true>(lds, Z, da_lambda, da_subln_g, bh >> 3, bh & 7, qb); } } }
#define P3M_DRY(QOFF) if (IN(3)) { unsigned* qhead = ctl + CW_QUEUE + (QOFF); \
        for (;;) { __syncthreads(); if (tid == 0) MISC[0] = __hip_atomic_fetch_add(qhead, 1u, RLX_AGENT); __syncthreads(); \
            const int id = (int)MISC[0]; if (id >= 128) break; \
            mls::mlstm_unit<true>(lds, Z, GIF, conv_w, conv_b, ml_norm_g, id >> 2, id & 3); } }
#ifndef DRY3A
#define DRY3A 0
#endif
#ifndef DRY3M
#define DRY3M 0
#endif
    P2_BODY
#if DUP2
    SEAM(2);
    P2_BODY
#endif
    SEAM(2);
#if DRY3A
    P3A_DRY(128)
    if (IN(3)) GBAR();
#endif
#if DRY3M
    P3M_DRY(192)
    if (IN(3)) GBAR();
#endif
    P3_BODY(0)
    SEAM(3);
#if DUP23
    P2_BODY
    SEAM(2);
    P3_BODY(64)
    SEAM(3);
#endif
    if (IN(4)) {
        pg8::Gemm g{Z + ZC_Q, WA, TOK, DM, DM, NZ, DM, (long)(ZC_MV - ZC_Q) * 2, (long)(WS_WM - WS_WA)}; pg8::StaticOrder2 S; S.init(TOK, DM, G, bx);
        pg8::EpiGate2 E{GATES, H1};
        pg8::gemm_phase<pg8::EpiGate2, pg8::StaticOrder2, true, true>(lds, g, S, E);
    }
    SEAM(4);
    if (IN(6)) {
        pg8::Gemm g{H1, WOUT, TOK, DM, DM, DM, DM}; pg8::StaticOrder S; S.init(TOK, DM, G, bx);
        pg8::EpiR E{x_in, MOD, R};
        pg8::gemm_phase<pg8::EpiR, pg8::StaticOrder, true, true>(lds, g, S, E);
    }
#if DUP6
    GBAR();
    if (IN(6)) {
        pg8::Gemm g{H1, WOUT, TOK, DM, DM, DM, DM}; pg8::StaticOrder S; S.init(TOK, DM, G, bx);
        pg8::EpiR E{x_in, MOD, R};
        pg8::gemm_phase<pg8::EpiR, pg8::StaticOrder, true, true>(lds, g, S, E);
    }
#endif
    SEAM(6);
    if (IN(7)) {
        for (int m = gw; m < TOK; m += 2 * NGW) p7_rows2(m, m + NGW, lane, R, MOD, ln1_g, ln1_b, X1, H2, H2Q, SHS);
    }
#if DUP7
    GBAR();
    if (IN(7)) {
        for (int m = gw; m < TOK; m += 2 * NGW) p7_rows2(m, m + NGW, lane, R, MOD, ln1_g, ln1_b, X1, H2, H2Q, SHS);
    }
#endif
    SEAM(7);
    if (IN(8)) {
        pg8::Gemm g{H2, WQ, TOK, DM, DM, DM, DM}; pg8::StaticOrder S; S.init(TOK, DM, G, bx);
        pg8::EpiStore E{QP};
        pg8::gemm_phase<pg8::EpiStore, pg8::StaticOrder, true, true>(lds, g, S, E);
    }
#if DUP8
    GBAR();
    if (IN(8)) {
        pg8::Gemm g{H2, WQ, TOK, DM, DM, DM, DM}; pg8::StaticOrder S; S.init(TOK, DM, G, bx);
        pg8::EpiStore E{QP};
        pg8::gemm_phase<pg8::EpiStore, pg8::StaticOrder, true, true>(lds, g, S, E);
    }
#endif
    SEAM(8);
#ifndef XBAR
#define XBAR 0
#endif
#if XBAR
    for (int xb = 0; xb < XBAR; ++xb) GBAR();
#endif
    if (IN(9)) {
        peer::stage_keys(lds, peer_keys);
        __syncthreads();
        for (int tile = bx; tile < TOK / 32; tile += G) peer::select_tile(lds, QP, tile * 32, SELE, SELG);
    }
    SEAM(9);
    int sx = bx % 8, sr = bx / 8, sn = (G - sx + 7) / 8;
    if (IN(10) || IN(12)) {
        __syncthreads();
        if (tid == 0) { bool phys = (MK_N_LAUNCHES != N_PHASES) && lo == 0 && hi > 10; unsigned mine = 0;
            if (phys) { for (unsigned j = 0; j < 16; ++j) { const unsigned c = xb_ld(&bar.bar[XB_XCNT(j)]); if (j < 8) { if (c == 0u) phys = false; if (j == bar.x) mine = c; } else if (c != 0u) phys = false; } }
            MISC[16] = phys ? bar.x : (unsigned)sx; MISC[17] = phys ? MISC[10] : (unsigned)sr; MISC[18] = phys ? mine : (unsigned)sn; }
        __syncthreads();
        sx = (int)MISC[16]; sr = (int)MISC[17]; sn = (int)MISC[18];
    }
    if (IN(10)) {
        for (int tile = sr; tile < TOK / 32; tile += sn) { __syncthreads(); peer::u_phase_tile(lds, tile, sx, SELE, H2Q, UT8, PART); }
    }
    SEAM(10);
    if (IN(11)) { for (int m = 4 * gw; m < TOK; m += 4 * NGW) peer::red_tokens4((size_t)m, PART, SELE, SELG, SUS, SVS, SHS, COEF, CSS); }
    SEAM(11);
    if (IN(12)) {
        for (int tile = sr; tile < TOK / 32; tile += sn) { __syncthreads(); peer::v_phase_tile(lds, tile, sx, SELE, COEF, CSS, VT8, args.out); }
    }
    SEAM(12);
    if (IN(13)) { for (int m = gw; m < TOK; m += 2 * NGW) peer::final_rows2((size_t)m, (size_t)m + NGW, args.out, X1, MOD, ln2_g, ln2_b); }
#undef IN
#undef SEAM
#undef ws
#undef ctl
#undef x_in
#undef cvec
#undef w_ada
#undef b_ada
#undef w_in
#undef b_if
#undef conv_w
#undef conv_b
#undef da_lambda
#undef da_subln_g
#undef ml_norm_g
#undef w_br_attn
#undef w_br_mlstm
#undef w_out
#undef ln1_g
#undef ln1_b
#undef peer_wq
#undef peer_keys
#undef peer_u
#undef peer_v
#undef ln2_g
#undef ln2_b
#undef MOD
#undef GIF
#undef WIN
#undef WA
#undef WM
#undef WOUT
#undef WQ
#undef UT8
#undef VT8
#undef SUS
#undef SVS
#undef SHS
#undef CSS
#undef H2Q
#undef SELE
#undef SELG
#undef PART
#undef COEF
#undef H1
#undef Z
#undef R
#undef X1
#undef H2
#undef QP
#undef GATES
}

extern "C" void kernel_launch(void* const* d_in, const int* in_sizes, int n_in, void* d_out, int out_size, void* d_ws, size_t ws_size, hipStream_t stream) {
    static int grid = 0;
    if (grid == 0) {
        if (n_in != 22 || in_sizes[0] != TOK * DM || out_size != TOK * DM || ws_size < WS_END) { fprintf(stderr, "kernel_launch: unexpected shapes (n_in %d, in0 %d, out %d, ws %zu; need ws >= %zu)\n", n_in, n_in > 0 ? in_sizes[0] : -1, out_size, ws_size, (size_t)WS_END); grid = -1; return; }
        int dev = 0, cus = 0, per_cu = 0;
        if (hipGetDevice(&dev) != hipSuccess || hipDeviceGetAttribute(&cus, hipDeviceAttributeMultiprocessorCount, dev) != hipSuccess) { fprintf(stderr, "kernel_launch: device query failed\n"); grid = -1; return; }
        if (hipFuncSetAttribute((const void*)mega_fwd, hipFuncAttributeMaxDynamicSharedMemorySize, LDS_BYTES) != hipSuccess) { fprintf(stderr, "kernel_launch: hipFuncSetAttribute failed\n"); grid = -1; return; }
        if (hipOccupancyMaxActiveBlocksPerMultiprocessor(&per_cu, (const void*)mega_fwd, NWAVES * 64, LDS_BYTES) != hipSuccess || per_cu < 1) fprintf(stderr, "kernel_launch: note: occupancy query reports %d workgroups per CU\n", per_cu);
        (void)hipGetLastError();
        grid = cus;
    }
    if (grid < 0) return;
    if (hipMemsetAsync((char*)d_ws + WS_CTL, 0, CTL_ZERO_BYTES, stream) != hipSuccess) { fprintf(stderr, "kernel_launch: memset failed\n"); return; }
    Args a{};
    for (int i = 0; i < 22; ++i) a.in[i] = (const float*)d_in[i];
    a.out = (float*)d_out; a.ws = (unsigned char*)d_ws;
    for (int li = 0; li < MK_N_LAUNCHES; ++li) {
        a.ph_lo = (MK_N_LAUNCHES == N_PHASES) ? li : 0; a.ph_hi = (MK_N_LAUNCHES == N_PHASES) ? li + 1 : N_PHASES;
        hipLaunchKernelGGL(mega_fwd, dim3(grid), dim3(NWAVES * 64), LDS_BYTES, stream, a);
        const hipError_t le = hipPeekAtLastError();
        if (le != hipSuccess) { fprintf(stderr, "kernel_launch: launch %d failed: %s\n", li, hipGetErrorName(le)); break; }
    }
}
```

```cpp
#include <hip/hip_runtime.h>
#include <hip/hip_bf16.h>
#include <cstdio>
#include <cstdint>
#include <cmath>

#define LAS __attribute__((address_space(3)))
#define GAS __attribute__((address_space(1)))
typedef unsigned short bf16_t;
typedef short bf16x8 __attribute__((ext_vector_type(8)));
typedef short s16x4 __attribute__((ext_vector_type(4)));
typedef float f32x2 __attribute__((ext_vector_type(2)));
typedef float f32x4 __attribute__((ext_vector_type(4)));
typedef float f32x16 __attribute__((ext_vector_type(16)));
typedef unsigned u32x2 __attribute__((ext_vector_type(2)));
typedef unsigned u32x4 __attribute__((ext_vector_type(4)));
typedef __bf16 bf16x2_t __attribute__((ext_vector_type(2)));
#define DI __device__ __forceinline__

constexpr int BATCH = 32, SEQ = 2048, DM = 1024, TOK = BATCH * SEQ;
constexpr int NZ = 6144;
constexpr int ZC_Q = 0, ZC_K = 1024, ZC_V = 2048, ZC_MQ = 3072, ZC_MK = 3584, ZC_MV = 4096, ZC_MO = 5120;
constexpr int NGATE = 2048;
constexpr int NIN = 8192;
constexpr int IN_W = 8200;
constexpr int MODW = 6 * DM;
constexpr float LN_EPS = 1e-5f;
constexpr float ALPHA_RES = 1.189207115002721f;
constexpr float LAMBDA_INIT = 0.2f;
constexpr float QSCALE = 0.125f * 1.4426950408889634f;
constexpr int NEXP = 16384;

constexpr size_t MiB = 1u << 20;
constexpr size_t WS_CTL = 0, CTL_ZERO_BYTES = 2 * MiB;
constexpr size_t WS_MOD = 1 * MiB;
constexpr size_t WS_GIF = 3 * MiB;
constexpr size_t WS_WIN = 6 * MiB;
constexpr size_t WS_WA = 22 * MiB, WS_WM = 24 * MiB, WS_WOUT = 26 * MiB, WS_WQ = 28 * MiB;
constexpr size_t WS_U = 30 * MiB, WS_V = 62 * MiB;
constexpr size_t WS_SU = 2 * MiB, WS_SV = 2 * MiB + 65536, WS_SH = 2 * MiB + 131072, WS_CS = 2 * MiB + 393216;
constexpr size_t WS_H2Q = 352 * MiB, WS_SELE = 416 * MiB, WS_SELG = 432 * MiB;
constexpr size_t WS_H1 = 96 * MiB;
constexpr size_t WS_Z = 224 * MiB;
constexpr size_t WS_R = WS_Z, WS_X1 = WS_Z + 256 * MiB, WS_H2 = WS_Z + 512 * MiB, WS_QP = WS_Z + 640 * MiB;
constexpr size_t WS_PART = WS_X1, WS_COEF = WS_H2, WS_YF = WS_QP;
constexpr size_t WS_PART_UNUSED = 0, WS_COEF_UNUSED = 0;
constexpr size_t WS_END = 992 * MiB;
constexpr int CW_BAR = 4096;
constexpr int CW_QUEUE = 16384;

DI unsigned pk2(float lo, float hi) { f32x2 v = {lo, hi}; bf16x2_t b = __builtin_convertvector(v, bf16x2_t); return __builtin_bit_cast(unsigned, b); }
DI float bf_lo(unsigned u) { return __uint_as_float(u << 16); }
DI float bf_hi(unsigned u) { return __uint_as_float(u & 0xffff0000u); }
DI float bf2f(bf16_t h) { return __uint_as_float(((unsigned)h) << 16); }
template <int CTRL> DI float dppf(float v) { return __builtin_bit_cast(float, __builtin_amdgcn_update_dpp(0, __builtin_bit_cast(int, v), CTRL, 0xF, 0xF, true)); }
DI float row_sum16(float v) { v += dppf<0xB1>(v); v += dppf<0x4E>(v); v += dppf<0x141>(v); v += dppf<0x140>(v); return v; }
DI float row_max16(float v) { v = fmaxf(v, dppf<0xB1>(v)); v = fmaxf(v, dppf<0x4E>(v)); v = fmaxf(v, dppf<0x141>(v)); v = fmaxf(v, dppf<0x140>(v)); return v; }
template <int CTRL> DI int dppi(int v) { return __builtin_amdgcn_update_dpp(0, v, CTRL, 0xF, 0xF, true); }
DI float sum32x(float v) { auto rr = __builtin_amdgcn_permlane32_swap(__builtin_bit_cast(unsigned, v), __builtin_bit_cast(unsigned, v), false, false); return __builtin_bit_cast(float, (unsigned)rr[0]) + __builtin_bit_cast(float, (unsigned)rr[1]); }
DI float max32x(float v) { auto rr = __builtin_amdgcn_permlane32_swap(__builtin_bit_cast(unsigned, v), __builtin_bit_cast(unsigned, v), false, false); return fmaxf(__builtin_bit_cast(float, (unsigned)rr[0]), __builtin_bit_cast(float, (unsigned)rr[1])); }
DI int isum32x(int v) { auto rr = __builtin_amdgcn_permlane32_swap((unsigned)v, (unsigned)v, false, false); return (int)rr[0] + (int)rr[1]; }
DI unsigned partner32(unsigned v, int hi) { auto rr = __builtin_amdgcn_permlane32_swap(v, v, false, false); return hi ? (unsigned)rr[0] : (unsigned)rr[1]; }
DI float rdlane(float v, int l) { return __builtin_bit_cast(float, __builtin_amdgcn_readlane(__builtin_bit_cast(int, v), l)); }
DI float wave_sum(float v) { v = row_sum16(v); return (rdlane(v, 0) + rdlane(v, 16)) + (rdlane(v, 32) + rdlane(v, 48)); }
DI float wave_max(float v) { v = row_max16(v); return fmaxf(fmaxf(rdlane(v, 0), rdlane(v, 16)), fmaxf(rdlane(v, 32), rdlane(v, 48))); }
DI float half_sum32(float v) { v = row_sum16(v); return v + __builtin_bit_cast(float, __builtin_amdgcn_ds_swizzle(__builtin_bit_cast(int, v), 0x401F)); }
DI float sigmoidf_(float x) { return __builtin_amdgcn_rcpf(1.0f + __builtin_amdgcn_exp2f(x * -1.4426950408889634f)); }
DI float siluf_(float x) { return x * __builtin_amdgcn_rcpf(1.0f + __builtin_amdgcn_exp2f(x * -1.4426950408889634f)); }
DI int crow(int r, int hi) { return (r & 3) + 8 * (r >> 2) + 4 * hi; }
#define MFMA32(a, b, c) __builtin_amdgcn_mfma_f32_32x32x16_bf16((a), (b), (c), 0, 0, 0)
DI bf16x8 pack_step(const f32x16& x, int s) {
    u32x4 p;
    p[0] = pk2(x[8 * s + 0], x[8 * s + 1]); p[1] = pk2(x[8 * s + 2], x[8 * s + 3]); p[2] = pk2(x[8 * s + 4], x[8 * s + 5]); p[3] = pk2(x[8 * s + 6], x[8 * s + 7]);
    return __builtin_bit_cast(bf16x8, p);
}
DI unsigned off_b(unsigned row, unsigned ch) { return 256u * row + 16u * (ch ^ (((row & 3) << 2) | ((row >> 2) & 3))); }
DI unsigned row_read_addr(unsigned lane, unsigned rt, unsigned s) { return off_b(32 * rt + (lane & 31), 2 * s + (lane >> 5)); }
DI unsigned tr_read_addr(unsigned lane, unsigned c, unsigned ks, unsigned t) {
    const unsigned h = lane >> 5, blk = (lane >> 4) & 1, q = (lane & 15) >> 2, p = lane & 3;
    return off_b(16 * ks + 8 * h + 4 * t + q, 4 * c + 2 * blk + (p >> 1)) + 8 * (p & 1);
}
DI unsigned tr_base(unsigned lane, unsigned t) { const unsigned h = lane >> 5, blk = (lane >> 4) & 1, q = (lane & 15) >> 2, p = lane & 3, cl = 2 * blk + (p >> 1);
    return 256u * (8 * h + 4 * t + q) + 16u * (cl ^ (2 * h + t)) + 8u * (p & 1); }
#define OPAQUE(x) asm volatile("" : "+v"(x))
#define OPAQUE(x) asm volatile("" : "+v"(x))
typedef short v4i16_t __attribute__((ext_vector_type(4)));
DI s16x4 tr_read(const LAS unsigned char* p) { return __builtin_bit_cast(s16x4, __builtin_amdgcn_ds_read_tr16_b64_v4i16((LAS v4i16_t*)p)); }
DI bf16x8 cat8(s16x4 lo, s16x4 hi) { return __builtin_shufflevector(lo, hi, 0, 1, 2, 3, 4, 5, 6, 7); }
namespace pg8 {
#define PG8_LAS __attribute__((address_space(3)))
typedef unsigned short bf16_t;
typedef short bf16x8 __attribute__((ext_vector_type(8)));
typedef float f32x4 __attribute__((ext_vector_type(4)));
typedef unsigned u32x4 __attribute__((ext_vector_type(4)));
constexpr int BM = 256, BK = 64, HALF = 128, HTB = HALF * BK * 2  , STAGE_BYTES = 8 * HTB, NXCD = 8, WGM = 8;

__host__ __device__ __forceinline__ int lds_byte(int r, int c) { const int st = (r >> 4) * 2 + (c >> 5), rr = r & 15, cc = c & 31, ob = rr * 64 + cc * 2; return st * 1024 + (ob ^ (((ob >> 9) & 1) << 5)); }
__host__ __device__ __forceinline__ void stage_rc(int b, int& R, int& C) { const int st = b / 1024, sb = b % 1024, swz = sb ^ (((sb >> 9) & 1) << 5); R = (st >> 1) * 16 + swz / 64; C = (st & 1) * 32 + (swz % 64) / 2; }
__host__ __device__ __forceinline__ int perm32(int rho) { const int n = rho >> 4, i = rho & 15; return 8 * (i >> 2) + 4 * n + (i & 3); }

struct Unit { int pm, pn, ph; };
struct Gemm { const bf16_t* A; const bf16_t* Bt; int M, N, K, lda, ldb; long jA, jB; };

struct StaticOrder {
    int nM, nN, nwg, G, c;
    __host__ __device__ void init(int M, int N, int G_, int c_) { nM = M / BM; nN = N / BM; nwg = nM * nN; G = G_; c = c_; }
    __host__ __device__ bool next(int i, Unit& u) const {
        const long L = (long)i * G + c; if (L >= nwg) return false;
        int wgid = (int)L; { const int q = nwg / NXCD, r = nwg % NXCD, xcd = wgid % NXCD, off = wgid / NXCD; wgid = (xcd < r ? xcd * (q + 1) : r * (q + 1) + (xcd - r) * q) + off; }
        const int nig = WGM * nN, gid = wgid / nig, fm = gid * WGM, gsz = (nM - fm) < WGM ? (nM - fm) : WGM;
        u.pm = fm + ((wgid % nig) % gsz); u.pn = (wgid % nig) / gsz; u.ph = 0; return true;
    }
    __device__ __forceinline__ void a_ready(const Unit&) const {}
    __device__ __forceinline__ void done(const Unit&) const {}
};
struct RowsOrder {
    int nM, nN, G, c;
    __host__ __device__ void init(int M, int N, int G_, int c_) { nM = M / BM; nN = N / BM; G = G_; c = c_; }
    __host__ __device__ bool next(int i, Unit& u) const { const int pm = c + (i / nN) * G; if (pm >= nM) return false; u.pm = pm; u.pn = i % nN; u.ph = 0; return true; }
    __device__ __forceinline__ void a_ready(const Unit&) const {}
    __device__ __forceinline__ void done(const Unit&) const {}
};
struct RowsOrder2 {
    RowsOrder base;
    __host__ __device__ void init(int M, int N, int G_, int c_) { base.init(M, N, G_, c_); }
    __host__ __device__ bool next(int i, Unit& u) const { if (!base.next(i >> 1, u)) return false; u.ph = i & 1; return true; }
    __device__ __forceinline__ void a_ready(const Unit&) const {}
    __device__ __forceinline__ void done(const Unit&) const {}
};
struct StaticOrder2 {
    StaticOrder base;
    __host__ __device__ void init(int M, int N, int G_, int c_) { base.init(M, N, G_, c_); }
    __host__ __device__ bool next(int i, Unit& u) const { if (!base.next(i >> 1, u)) return false; u.ph = i & 1; return true; }
    __device__ __forceinline__ void a_ready(const Unit&) const {}
    __device__ __forceinline__ void done(const Unit&) const {}
};
template <class Epi, class Sched, bool ALIGN_EPI = false, bool SP2 = false>
__device__ __forceinline__ void gemm_phase(PG8_LAS unsigned char* lds, const Gemm g, const Sched& S, const Epi& E) {
    const int tid = threadIdx.x, wid = __builtin_amdgcn_readfirstlane(tid >> 6), lane = tid & 63, wr = wid >> 2, wc = wid & 3, fr = lane & 15, fq = lane >> 4;
    const int K = g.K, nt = K / BK;
    unsigned voffA[2], voffB[2];
#pragma unroll
    for (int i = 0; i < 2; ++i) { int R, C; stage_rc(tid * 16 + i * 8192, R, C); const int Rb = Epi::PERM ? ((R & ~31) + perm32(R & 31)) : R;
        voffA[i] = (unsigned)(R * g.lda + C) * 2u; voffB[i] = (unsigned)(Rb * g.ldb + C) * 2u; }
    const size_t kstep = (size_t)(BK * 2);
    const size_t hstepA = (size_t)HALF * g.lda * 2, hstepB = (size_t)HALF * g.ldb * 2;
    const size_t tstepA = 2 * hstepA, tstepB = 2 * hstepB;
    const unsigned ldsw = (unsigned)wid * 1024u;
    const int aoff = lds_byte(wr * 64 + fr, fq * 8), boff = lds_byte(wc * 32 + fr, fq * 8);
#define PG8_SA(b, h) (((b) * 2 + (h)) * HTB)
#define PG8_SB(b, h) ((4 + (b) * 2 + (h)) * HTB)
#define PG8_STAGE(bufoff, gbase, voff) do { _Pragma("unroll") for (int _i = 0; _i < 2; ++_i) \
        __builtin_amdgcn_global_load_lds((const unsigned*)((const char*)(gbase) + (voff)[_i]), (PG8_LAS unsigned*)(lds + (bufoff) + ldsw + _i * 8192), 16, 0, 0); } while (0)
#define PG8_LDA(dst, b, h) do { _Pragma("unroll") for (int m = 0; m < 4; ++m) _Pragma("unroll") for (int k = 0; k < 2; ++k) dst[m][k] = *(const PG8_LAS bf16x8*)(lds + PG8_SA(b, h) + aoff + m * 2048 + k * 1024); } while (0)
#define PG8_LDB(dst, b, h) do { _Pragma("unroll") for (int n = 0; n < 2; ++n) _Pragma("unroll") for (int k = 0; k < 2; ++k) dst[n][k] = *(const PG8_LAS bf16x8*)(lds + PG8_SB(b, h) + boff + n * 2048 + k * 1024); } while (0)
#define PG8_MMA(ai, bj, At, Bt) do { __builtin_amdgcn_s_setprio(1); _Pragma("unroll") for (int m = 0; m < 4; ++m) _Pragma("unroll") for (int n = 0; n < 2; ++n) _Pragma("unroll") for (int k = 0; k < 2; ++k) \
        acc[ai][bj][m][n] = __builtin_amdgcn_mfma_f32_16x16x32_bf16(Bt[n][k], At[m][k], acc[ai][bj][m][n], 0, 0, 0); __builtin_amdgcn_s_setprio(0); } while (0)
#define PG8_WAIT_V(n) asm volatile("s_waitcnt vmcnt(" #n ")" ::: "memory")
#define PG8_WAIT_L(n) asm volatile("s_waitcnt lgkmcnt(" #n ")" ::: "memory")
#define PG8_BAR __builtin_amdgcn_s_barrier()
#define PG8_SCHED __builtin_amdgcn_sched_barrier(0)
    Unit cur, nxt; int ui = 0;
    if (!S.next(0, cur)) return;
    f32x4 acc[2][2][4][2];
#pragma unroll
    for (int a = 0; a < 2; ++a)
#pragma unroll
        for (int b = 0; b < 2; ++b)
#pragma unroll
            for (int m = 0; m < 4; ++m)
#pragma unroll
                for (int n = 0; n < 2; ++n) acc[a][b][m][n] = (f32x4){0.f, 0.f, 0.f, 0.f};
    bf16x8 At[4][2], B0[2][2], B1[2][2];
    const char* cA = (const char*)g.A + (size_t)cur.pm * tstepA + cur.ph * g.jA; const char* cB = (const char*)g.Bt + (size_t)cur.pn * tstepB + cur.ph * g.jB;
    S.a_ready(cur);
    if constexpr (SP2) {
        PG8_STAGE(PG8_SB(0, 0), cB, voffB); PG8_STAGE(PG8_SB(0, 1), cB + hstepB, voffB); PG8_STAGE(PG8_SA(0, 0), cA, voffA); PG8_STAGE(PG8_SA(0, 1), cA + hstepA, voffA);
        if (wr == 1) PG8_BAR;
        PG8_WAIT_V(2); PG8_BAR;
        PG8_STAGE(PG8_SB(1, 0), cB + kstep, voffB); PG8_STAGE(PG8_SA(1, 0), cA + kstep, voffA); PG8_STAGE(PG8_SB(1, 1), cB + hstepB + kstep, voffB);
        PG8_WAIT_V(6); PG8_BAR;
    } else {
        PG8_STAGE(PG8_SB(0, 0), cB, voffB); PG8_STAGE(PG8_SA(0, 0), cA, voffA); PG8_STAGE(PG8_SB(0, 1), cB + hstepB, voffB); PG8_STAGE(PG8_SA(0, 1), cA + hstepA, voffA);
        if (wr == 1) PG8_BAR;
        PG8_WAIT_V(4); PG8_BAR;
        PG8_STAGE(PG8_SB(1, 0), cB + kstep, voffB); PG8_STAGE(PG8_SA(1, 0), cA + kstep, voffA); PG8_STAGE(PG8_SB(1, 1), cB + hstepB + kstep, voffB);
        PG8_WAIT_V(6); PG8_BAR;
    }
    for (;;) {
        const bool has_next = S.next(ui + 1, nxt);
        const char* nA = has_next ? (const char*)g.A + (size_t)nxt.pm * tstepA + nxt.ph * g.jA : cA; const char* nB = has_next ? (const char*)g.Bt + (size_t)nxt.pn * tstepB + nxt.ph * g.jB : cB;
        for (int t = 0; t < nt; t += 2) {
            const bool last = (t == nt - 2);
            const char* a1 = cA + (size_t)(t + 1) * kstep;
            const char* a2 = last ? nA : cA + (size_t)(t + 2) * kstep; const char* b2 = last ? nB : cB + (size_t)(t + 2) * kstep;
            const char* a3 = a2 + kstep; const char* b3 = b2 + kstep;
            if (last && has_next) S.a_ready(nxt);
            if constexpr (SP2) {
            PG8_LDB(B0, 0, 0); PG8_LDB(B1, 0, 1); PG8_SCHED; PG8_LDA(At, 0, 0); PG8_STAGE(PG8_SA(1, 1), a1 + hstepA, voffA);
            PG8_WAIT_V(8); PG8_WAIT_L(0); PG8_BAR; PG8_MMA(0, 0, At, B0); PG8_MMA(0, 1, At, B1); PG8_BAR; PG8_SCHED;
            PG8_LDA(At, 0, 1); PG8_STAGE(PG8_SB(0, 0), b2, voffB); PG8_STAGE(PG8_SB(0, 1), b2 + hstepB, voffB); PG8_STAGE(PG8_SA(0, 0), a2, voffA);
            PG8_WAIT_V(8); PG8_WAIT_L(0); PG8_BAR; PG8_MMA(1, 0, At, B0); PG8_MMA(1, 1, At, B1); PG8_BAR; PG8_SCHED;
            PG8_LDB(B0, 1, 0); PG8_LDB(B1, 1, 1); PG8_SCHED; PG8_LDA(At, 1, 0); PG8_STAGE(PG8_SA(0, 1), a2 + hstepA, voffA);
            PG8_WAIT_V(8); PG8_WAIT_L(0); PG8_BAR; PG8_MMA(0, 0, At, B0); PG8_MMA(0, 1, At, B1); PG8_BAR; PG8_SCHED;
            PG8_LDA(At, 1, 1); PG8_STAGE(PG8_SB(1, 0), b3, voffB); PG8_STAGE(PG8_SB(1, 1), b3 + hstepB, voffB); PG8_STAGE(PG8_SA(1, 0), a3, voffA);
            PG8_WAIT_V(8); PG8_WAIT_L(0); PG8_BAR; PG8_MMA(1, 0, At, B0); PG8_MMA(1, 1, At, B1); PG8_BAR; PG8_SCHED;
            } else {
            PG8_LDB(B0, 0, 0); PG8_SCHED; PG8_LDA(At, 0, 0); PG8_STAGE(PG8_SA(1, 1), a1 + hstepA, voffA);
            PG8_WAIT_L(8); PG8_BAR; PG8_WAIT_L(0); PG8_MMA(0, 0, At, B0); PG8_BAR; PG8_SCHED;
            PG8_LDB(B1, 0, 1); PG8_STAGE(PG8_SB(0, 0), b2, voffB);
            PG8_BAR; PG8_WAIT_L(0); PG8_MMA(0, 1, At, B1); PG8_BAR;
            PG8_LDA(At, 0, 1); PG8_STAGE(PG8_SA(0, 0), a2, voffA);
            PG8_BAR; PG8_WAIT_L(0); PG8_MMA(1, 0, At, B0); PG8_BAR; PG8_SCHED;
            PG8_STAGE(PG8_SB(0, 1), b2 + hstepB, voffB);
            PG8_WAIT_V(6); PG8_BAR; PG8_MMA(1, 1, At, B1); PG8_BAR;
            PG8_LDB(B0, 1, 0); PG8_SCHED; PG8_LDA(At, 1, 0); PG8_STAGE(PG8_SA(0, 1), a2 + hstepA, voffA);
            PG8_WAIT_L(8); PG8_BAR; PG8_WAIT_L(0); PG8_MMA(0, 0, At, B0); PG8_BAR; PG8_SCHED;
            PG8_LDB(B1, 1, 1); PG8_STAGE(PG8_SB(1, 0), b3, voffB);
            PG8_BAR; PG8_WAIT_L(0); PG8_MMA(0, 1, At, B1); PG8_BAR;
            PG8_LDA(At, 1, 1); PG8_STAGE(PG8_SA(1, 0), a3, voffA);
            PG8_BAR; PG8_WAIT_L(0); PG8_MMA(1, 0, At, B0); PG8_BAR; PG8_SCHED;
            PG8_STAGE(PG8_SB(1, 1), b3 + hstepB, voffB);
            PG8_WAIT_V(6); PG8_BAR; PG8_MMA(1, 1, At, B1); PG8_BAR;
            }
        }
        if constexpr (ALIGN_EPI) { if (wr == 0) PG8_BAR; }
        bool keep_acc = false;
        if constexpr (Epi::HAS_MID) { keep_acc = (cur.ph == 0) && has_next; }
        if constexpr (!Epi::AFTER_DRAIN) { if constexpr (Epi::HAS_MID) { if (keep_acc) E.mid(acc, cur, wr, wc, fr, fq); else E(acc, cur, wr, wc, fr, fq); } else E(acc, cur, wr, wc, fr, fq); S.done(cur); }
        if (!has_next) break;
        if (!keep_acc)
#pragma unroll
        for (int a = 0; a < 2; ++a)
#pragma unroll
            for (int b = 0; b < 2; ++b)
#pragma unroll
                for (int m = 0; m < 4; ++m)
#pragma unroll
                    for (int n = 0; n < 2; ++n) acc[a][b][m][n] = (f32x4){0.f, 0.f, 0.f, 0.f};
        cur = nxt; cA = nA; cB = nB; ++ui;
        if constexpr (ALIGN_EPI) { if (wr == 1) PG8_BAR; }
    }
    PG8_WAIT_V(0);
    if constexpr (!ALIGN_EPI) { if (wr == 0) PG8_BAR; }
    PG8_BAR;
    if constexpr (Epi::AFTER_DRAIN) { E.fused(acc, cur, wr, wc, fr, fq, lds, wid, lane); S.done(cur); }
#undef PG8_SA
#undef PG8_SB
#undef PG8_STAGE
#undef PG8_LDA
#undef PG8_LDB
#undef PG8_MMA
#undef PG8_WAIT_V
#undef PG8_WAIT_L
#undef PG8_BAR
#undef PG8_SCHED
}
}
namespace pg8 {
struct EpiZ {
    static constexpr bool PERM = true, AFTER_DRAIN = false, HAS_MID = false;
    bf16_t* Z; bf16_t* G;
    __device__ __forceinline__ void operator()(const f32x4 (&acc)[2][2][4][2], const Unit& u, int wr, int wc, int fr, int fq) const {
        const int row0 = u.pm * BM + wr * 64 + fr, colt = u.pn * BM; const bool gate = colt >= NZ;
        bf16_t* base = gate ? G : Z; const int ld = gate ? NGATE : NZ; const int col0 = (gate ? colt - NZ : colt) + wc * 32 + 8 * fq;
#pragma unroll
        for (int ai = 0; ai < 2; ++ai)
#pragma unroll
            for (int m = 0; m < 4; ++m) { bf16_t* rowp = base + (size_t)(row0 + ai * HALF + m * 16) * ld + col0;
#pragma unroll
                for (int bj = 0; bj < 2; ++bj) { f32x4 v0 = acc[ai][bj][m][0], v1 = acc[ai][bj][m][1];
                    if (gate) {
#pragma unroll
                        for (int e = 0; e < 4; ++e) { v0[e] = sigmoidf_(v0[e]); v1[e] = sigmoidf_(v1[e]); } }
                    ::u32x4 w; w.x = pk2(v0[0], v0[1]); w.y = pk2(v0[2], v0[3]); w.z = pk2(v1[0], v1[1]); w.w = pk2(v1[2], v1[3]);
                    *(::u32x4*)(rowp + bj * HALF) = w; } }
    }
};
template <bool FIRST> struct EpiGate {
    static constexpr bool PERM = true, AFTER_DRAIN = false, HAS_MID = false;
    const bf16_t* G; bf16_t* Y;
    __device__ __forceinline__ void operator()(const f32x4 (&acc)[2][2][4][2], const Unit& u, int wr, int wc, int fr, int fq) const {
        const int row0 = u.pm * BM + wr * 64 + fr, col0 = u.pn * BM + wc * 32 + 8 * fq;
#pragma unroll
        for (int ai = 0; ai < 2; ++ai)
#pragma unroll
            for (int m = 0; m < 4; ++m) { const size_t row = (size_t)(row0 + ai * HALF + m * 16);
#pragma unroll
                for (int bj = 0; bj < 2; ++bj) { const f32x4 v0 = acc[ai][bj][m][0], v1 = acc[ai][bj][m][1];
                    const ::u32x4 g = *(const ::u32x4*)(G + row * NGATE + col0 + bj * HALF);
                    float o[8] = { bf_lo(g.x) * v0[0], bf_hi(g.x) * v0[1], bf_lo(g.y) * v0[2], bf_hi(g.y) * v0[3], bf_lo(g.z) * v1[0], bf_hi(g.z) * v1[1], bf_lo(g.w) * v1[2], bf_hi(g.w) * v1[3] };
                    bf16_t* yp = Y + row * DM + col0 + bj * HALF;
                    if (!FIRST) { const ::u32x4 y = *(const ::u32x4*)yp;
                        o[0] += bf_lo(y.x); o[1] += bf_hi(y.x); o[2] += bf_lo(y.y); o[3] += bf_hi(y.y); o[4] += bf_lo(y.z); o[5] += bf_hi(y.z); o[6] += bf_lo(y.w); o[7] += bf_hi(y.w); }
                    ::u32x4 w; w.x = pk2(o[0], o[1]); w.y = pk2(o[2], o[3]); w.z = pk2(o[4], o[5]); w.w = pk2(o[6], o[7]);
                    *(::u32x4*)yp = w; } }
    }
};
struct EpiR {
    static constexpr bool PERM = true, AFTER_DRAIN = false, HAS_MID = false;
    const float* X; const float* MOD; bf16_t* R;
    __device__ __forceinline__ void operator()(const f32x4 (&acc)[2][2][4][2], const Unit& u, int wr, int wc, int fr, int fq) const {
        const int row0 = u.pm * BM + wr * 64 + fr, col0 = u.pn * BM + wc * 32 + 8 * fq;
        const float* gt = MOD + (size_t)((u.pm * BM) / SEQ) * MODW + 2 * DM;
        f32x4 g[2][2];
#pragma unroll
        for (int bj = 0; bj < 2; ++bj) { g[bj][0] = *(const f32x4*)(gt + col0 + bj * HALF); g[bj][1] = *(const f32x4*)(gt + col0 + bj * HALF + 4); }
#pragma unroll
        for (int ai = 0; ai < 2; ++ai) {
            f32x4 xv[4][2][2];
#pragma unroll
            for (int m = 0; m < 4; ++m) { const size_t off = (size_t)(row0 + ai * HALF + m * 16) * DM + col0;
#pragma unroll
                for (int bj = 0; bj < 2; ++bj) { xv[m][bj][0] = *(const f32x4*)(X + off + bj * HALF); xv[m][bj][1] = *(const f32x4*)(X + off + bj * HALF + 4); } }
            __builtin_amdgcn_sched_barrier(0);
#pragma unroll
            for (int m = 0; m < 4; ++m) { const size_t off = (size_t)(row0 + ai * HALF + m * 16) * DM + col0;
#pragma unroll
                for (int bj = 0; bj < 2; ++bj) {
                    const f32x4 r0 = xv[m][bj][0] * ALPHA_RES + g[bj][0] * acc[ai][bj][m][0], r1 = xv[m][bj][1] * ALPHA_RES + g[bj][1] * acc[ai][bj][m][1];
                    ::u32x4 w; w.x = pk2(r0[0], r0[1]); w.y = pk2(r0[2], r0[3]); w.z = pk2(r1[0], r1[1]); w.w = pk2(r1[2], r1[3]);
                    *(::u32x4*)(R + off + bj * HALF) = w; } }
            __builtin_amdgcn_sched_barrier(0);
        }
    }
};
struct EpiStore {
    static constexpr bool PERM = true, AFTER_DRAIN = false, HAS_MID = false;
    bf16_t* O;
    __device__ __forceinline__ void operator()(const f32x4 (&acc)[2][2][4][2], const Unit& u, int wr, int wc, int fr, int fq) const {
        const int row0 = u.pm * BM + wr * 64 + fr, col0 = u.pn * BM + wc * 32 + 8 * fq;
#pragma unroll
        for (int ai = 0; ai < 2; ++ai)
#pragma unroll
            for (int m = 0; m < 4; ++m) { bf16_t* rowp = O + (size_t)(row0 + ai * HALF + m * 16) * DM + col0;
#pragma unroll
                for (int bj = 0; bj < 2; ++bj) { const f32x4 v0 = acc[ai][bj][m][0], v1 = acc[ai][bj][m][1];
                    ::u32x4 w; w.x = pk2(v0[0], v0[1]); w.y = pk2(v0[2], v0[3]); w.z = pk2(v1[0], v1[1]); w.w = pk2(v1[2], v1[3]);
                    *(::u32x4*)(rowp + bj * HALF) = w; } }
    }
};
struct EpiGate2 {
    static constexpr bool PERM = true, AFTER_DRAIN = false, HAS_MID = true;
    const bf16_t* G; bf16_t* Y;
    __device__ __forceinline__ void mid(f32x4 (&acc)[2][2][4][2], const Unit& u, int wr, int wc, int fr, int fq) const {
        const int row0 = u.pm * BM + wr * 64 + fr, col0 = u.pn * BM + wc * 32 + 8 * fq;
#pragma unroll
        for (int ai = 0; ai < 2; ++ai)
#pragma unroll
            for (int m = 0; m < 4; ++m) { const size_t row = (size_t)(row0 + ai * HALF + m * 16);
#pragma unroll
                for (int bj = 0; bj < 2; ++bj) {
                    const ::u32x4 ga = *(const ::u32x4*)(G + row * NGATE + col0 + bj * HALF), gm = *(const ::u32x4*)(G + row * NGATE + DM + col0 + bj * HALF);
                    f32x4& v0 = acc[ai][bj][m][0]; f32x4& v1 = acc[ai][bj][m][1];
#define PG8_RAT(a, b) ((a) * __builtin_amdgcn_rcpf(b))
                    v0[0] *= PG8_RAT(bf_lo(ga.x), bf_lo(gm.x)); v0[1] *= PG8_RAT(bf_hi(ga.x), bf_hi(gm.x)); v0[2] *= PG8_RAT(bf_lo(ga.y), bf_lo(gm.y)); v0[3] *= PG8_RAT(bf_hi(ga.y), bf_hi(gm.y));
                    v1[0] *= PG8_RAT(bf_lo(ga.z), bf_lo(gm.z)); v1[1] *= PG8_RAT(bf_hi(ga.z), bf_hi(gm.z)); v1[2] *= PG8_RAT(bf_lo(ga.w), bf_lo(gm.w)); v1[3] *= PG8_RAT(bf_hi(ga.w), bf_hi(gm.w)); }
#undef PG8_RAT
                if (m == 3) __builtin_amdgcn_sched_barrier(0); }
    }
    __device__ __forceinline__ void operator()(const f32x4 (&acc)[2][2][4][2], const Unit& u, int wr, int wc, int fr, int fq) const {
        const int row0 = u.pm * BM + wr * 64 + fr, col0 = u.pn * BM + wc * 32 + 8 * fq;
        ::u32x4 gg[2][4][2];
#pragma unroll
        for (int ai = 0; ai < 2; ++ai)
#pragma unroll
            for (int m = 0; m < 4; ++m) { const size_t row = (size_t)(row0 + ai * HALF + m * 16);
#pragma unroll
                for (int bj = 0; bj < 2; ++bj) gg[ai][m][bj] = *(const ::u32x4*)(G + row * NGATE + DM + col0 + bj * HALF); }
        __builtin_amdgcn_sched_barrier(0);
#pragma unroll
        for (int ai = 0; ai < 2; ++ai)
#pragma unroll
            for (int m = 0; m < 4; ++m) { const size_t row = (size_t)(row0 + ai * HALF + m * 16);
#pragma unroll
                for (int bj = 0; bj < 2; ++bj) { const f32x4 v0 = acc[ai][bj][m][0], v1 = acc[ai][bj][m][1]; const ::u32x4 g = gg[ai][m][bj];
                    ::u32x4 w; w.x = pk2(bf_lo(g.x) * v0[0], bf_hi(g.x) * v0[1]); w.y = pk2(bf_lo(g.y) * v0[2], bf_hi(g.y) * v0[3]); w.z = pk2(bf_lo(g.z) * v1[0], bf_hi(g.z) * v1[1]); w.w = pk2(bf_lo(g.w) * v1[2], bf_hi(g.w) * v1[3]);
                    *(::u32x4*)(Y + row * DM + col0 + bj * HALF) = w; } }
    }
};
}
namespace datt {
constexpr int KROW = 144;
constexpr int KBUF = 64 * KROW, VBUF = 64 * 256, LDS_K = 0, LDS_V = 2 * KBUF, LDS_ST = LDS_V + 2 * VBUF, STROW = 272, ST_WAVE = 32 * STROW, LDS_BYTES = LDS_ST + 8 * ST_WAVE;
DI unsigned vrow(unsigned key) { return (key & ~12u) | ((key & 4u) << 1) | ((key & 8u) >> 1); }

template <bool DRY> DI void attn_unit(LAS unsigned char* lds, bf16_t* Z, const float* lam, const float* subln_g, int b, int h, int qb) {
    int tid_o = threadIdx.x; OPAQUE(tid_o); const int tid = tid_o, lane = tid & 63, r32 = lane & 31, hi = lane >> 5; const int wid = __builtin_amdgcn_readfirstlane(tid >> 6);
    const size_t rowbase = (size_t)b * SEQ;
    const int q_first = qb * 256 + wid * 32, q_me = q_first + r32;
    float lam_val;
    { const float p1 = lam[lane] * lam[64 + lane], p2 = lam[128 + lane] * lam[192 + lane]; lam_val = __expf(wave_sum(p1)) - __expf(wave_sum(p2)) + LAMBDA_INIT; }
    const int NT = 4 * (qb + 1);
    const int k_key = tid >> 3, k_ch = tid & 7;
    const int v_key0 = tid >> 4, v_ch = tid & 15;
    const unsigned tb0 = LDS_V + tr_base(lane, 0), tb1 = LDS_V + tr_base(lane, 1); unsigned q64 = ((lane & 15) >> 2) << 6;
    const unsigned kb = LDS_K + r32 * KROW + hi * 16;
    u32x4 pk_, pv0, pv1;
#pragma unroll
    for (int m = 0; m < 2; ++m) {
        bf16x8 qf[4];
        { const bf16_t* qp = Z + (rowbase + q_me) * NZ + ZC_Q + h * 128 + m * 64 + 8 * hi;
#pragma unroll
          for (int s = 0; s < 4; ++s) qf[s] = *(const bf16x8*)(qp + 16 * s); }
        const bf16_t* ksrc = Z + (rowbase + k_key) * NZ + ZC_K + h * 128 + m * 64 + k_ch * 8;
        const bf16_t* vsrc = Z + (rowbase + v_key0) * NZ + ZC_V + h * 128 + v_ch * 8;
        f32x16 O[4];
#pragma unroll
        for (int c = 0; c < 4; ++c)
#pragma unroll
            for (int r = 0; r < 16; ++r) O[c][r] = 0.f;
        float mrun = -1e30f, lrun = 0.f;
        if (m == 0) { pk_ = *(const u32x4*)ksrc; pv0 = *(const u32x4*)vsrc; pv1 = *(const u32x4*)(vsrc + (size_t)32 * NZ); }
        __syncthreads();
        *(LAS u32x4*)(lds + LDS_K + k_key * KROW + k_ch * 16) = pk_;
        *(LAS u32x4*)(lds + LDS_V + off_b(vrow(v_key0), v_ch)) = pv0;
        *(LAS u32x4*)(lds + LDS_V + off_b(vrow(v_key0 + 32), v_ch)) = pv1;
        { const size_t o = (size_t)64 * NZ; pk_ = *(const u32x4*)(ksrc + o); pv0 = *(const u32x4*)(vsrc + o); pv1 = *(const u32x4*)(vsrc + o + (size_t)32 * NZ); }
        __syncthreads();
        for (int kt = 0; kt < NT; ++kt) {
            const int cur = kt & 1, nxt = cur ^ 1;
            if (kt * 64 <= q_first + 31) {
            f32x16 p[2];
            bf16x8 ka[8];
#pragma unroll
            for (int i = 0; i < 8; ++i) ka[i] = *(const LAS bf16x8*)(lds + kb + cur * KBUF + 32 * (i >> 2) * KROW + (i & 3) * 32);
            __builtin_amdgcn_sched_barrier(0);
#pragma unroll
            for (int hf = 0; hf < 2; ++hf) {
#pragma unroll
                for (int r = 0; r < 16; ++r) p[hf][r] = 0.f;
#pragma unroll
                for (int s = 0; s < 4; ++s) p[hf] = MFMA32(ka[4 * hf + s], qf[s], p[hf]);
            }
            OPAQUE(q64);
            const unsigned vb0 = tb0 + cur * VBUF, vb1 = tb1 + cur * VBUF;
            s16x4 vlo[2][4], vhi[2][4];
#pragma unroll
            for (int ks = 0; ks < 4; ++ks) { vlo[0][ks] = tr_read(lds + vb0 + q64 + 4096 * ks); vhi[0][ks] = tr_read(lds + vb1 + q64 + 4096 * ks); }
            __builtin_amdgcn_sched_barrier(0);
            if (kt * 64 + 63 > q_first) {
#pragma unroll
                for (int hf = 0; hf < 2; ++hf)
#pragma unroll
                    for (int r = 0; r < 16; ++r) { const int key = kt * 64 + 32 * hf + crow(r, hi); if (key > q_me) p[hf][r] = -1e30f; }
            }
            float mx = p[0][0];
#pragma unroll
            for (int r = 1; r < 16; ++r) mx = fmaxf(mx, p[0][r]);
#pragma unroll
            for (int r = 0; r < 16; ++r) mx = fmaxf(mx, p[1][r]);
            mx = max32x(mx);
            if (__builtin_amdgcn_ballot_w64(mx > mrun + 8.0f) != 0) {
                const float mnew = fmaxf(mrun, mx), alpha = __builtin_amdgcn_exp2f(mrun - mnew); mrun = mnew; lrun *= alpha;
#pragma unroll
                for (int c = 0; c < 4; ++c)
#pragma unroll
                    for (int r = 0; r < 16; ++r) O[c][r] *= alpha;
            }
            float ls = 0.f;
#pragma unroll
            for (int hf = 0; hf < 2; ++hf)
#pragma unroll
                for (int r = 0; r < 16; ++r) { const float e = __builtin_amdgcn_exp2f(p[hf][r] - mrun); p[hf][r] = e; ls += e; }
            lrun += ls;
            bf16x8 pf[4];
            pf[0] = pack_step(p[0], 0); pf[1] = pack_step(p[0], 1); pf[2] = pack_step(p[1], 0); pf[3] = pack_step(p[1], 1);
#pragma unroll
            for (int c = 0; c < 4; ++c) {
                if (c < 3) { const unsigned cx = (64u * (c + 1)) ^ q64;
#pragma unroll
                    for (int ks = 0; ks < 4; ++ks) { vlo[(c + 1) & 1][ks] = tr_read(lds + vb0 + cx + 4096 * ks); vhi[(c + 1) & 1][ks] = tr_read(lds + vb1 + cx + 4096 * ks); } }
                __builtin_amdgcn_sched_barrier(0);
#pragma unroll
                for (int ks = 0; ks < 4; ++ks) O[c] = MFMA32(cat8(vlo[c & 1][ks], vhi[c & 1][ks]), pf[ks], O[c]);
                __builtin_amdgcn_sched_barrier(0);
            }
            }
            if (kt + 1 < NT) {
                *(LAS u32x4*)(lds + LDS_K + nxt * KBUF + k_key * KROW + k_ch * 16) = pk_;
                *(LAS u32x4*)(lds + LDS_V + nxt * VBUF + off_b(vrow(v_key0), v_ch)) = pv0;
                *(LAS u32x4*)(lds + LDS_V + nxt * VBUF + off_b(vrow(v_key0 + 32), v_ch)) = pv1;
                if (kt + 2 < NT) { const size_t o = (size_t)(kt + 2) * 64 * NZ; pk_ = *(const u32x4*)(ksrc + o); pv0 = *(const u32x4*)(vsrc + o); pv1 = *(const u32x4*)(vsrc + o + (size_t)32 * NZ); }
                else if (m == 0) { pk_ = *(const u32x4*)(ksrc + 64); pv0 = *(const u32x4*)vsrc; pv1 = *(const u32x4*)(vsrc + (size_t)32 * NZ); }
            }
            __syncthreads();
        }
        const float ltot = sum32x(lrun), inv = 1.0f / ltot;
        if (m == 0) {
            LAS unsigned char* stg = lds + LDS_ST + wid * ST_WAVE;
#pragma unroll
            for (int c = 0; c < 4; ++c)
#pragma unroll
                for (int g4 = 0; g4 < 4; ++g4) { const int dv0 = 32 * c + 8 * g4 + 4 * hi;
                    u32x2 w; w.x = pk2(O[c][4 * g4] * inv, O[c][4 * g4 + 1] * inv); w.y = pk2(O[c][4 * g4 + 2] * inv, O[c][4 * g4 + 3] * inv);
                    *(LAS u32x2*)(stg + r32 * STROW + dv0 * 2) = w; }
        } else {
            const float li = lam_val * inv;
            float ss = 0.f;
            LAS unsigned char* stg = lds + LDS_ST + wid * ST_WAVE;
#pragma unroll
            for (int c = 0; c < 4; ++c)
#pragma unroll
                for (int g4 = 0; g4 < 4; ++g4) { const int dv0 = 32 * c + 8 * g4 + 4 * hi; const u32x2 k2 = *(const LAS u32x2*)(stg + r32 * STROW + dv0 * 2);
                    O[c][4 * g4] = bf_lo(k2.x) - li * O[c][4 * g4]; O[c][4 * g4 + 1] = bf_hi(k2.x) - li * O[c][4 * g4 + 1]; O[c][4 * g4 + 2] = bf_lo(k2.y) - li * O[c][4 * g4 + 2]; O[c][4 * g4 + 3] = bf_hi(k2.y) - li * O[c][4 * g4 + 3];
                    ss += (O[c][4 * g4] * O[c][4 * g4] + O[c][4 * g4 + 1] * O[c][4 * g4 + 1]) + (O[c][4 * g4 + 2] * O[c][4 * g4 + 2] + O[c][4 * g4 + 3] * O[c][4 * g4 + 3]); }
            ss = sum32x(ss);
            const float rstd = rsqrtf(ss * (1.0f / 128.0f) + LN_EPS) * (1.0f - LAMBDA_INIT);
#pragma unroll
            for (int c = 0; c < 4; ++c)
#pragma unroll
                for (int g4 = 0; g4 < 4; ++g4) { const int dv0 = 32 * c + 8 * g4 + 4 * hi; const f32x4 gg = *(const f32x4*)(subln_g + dv0);
                    u32x2 w; w.x = pk2(O[c][4 * g4] * rstd * gg[0], O[c][4 * g4 + 1] * rstd * gg[1]); w.y = pk2(O[c][4 * g4 + 2] * rstd * gg[2], O[c][4 * g4 + 3] * rstd * gg[3]);
                    *(LAS u32x2*)(stg + r32 * STROW + dv0 * 2) = w; }
        }
    }
    LAS unsigned char* stg = lds + LDS_ST + wid * ST_WAVE;
    asm volatile("s_waitcnt lgkmcnt(0)" ::: "memory");
    bf16_t* obase = Z + (rowbase + q_first) * NZ + ZC_Q + h * 128;
#pragma unroll
    for (int i = 0; i < 8; ++i) { const int idx = lane + 64 * i, row = idx >> 4, ch = idx & 15;
        const u32x4 v = *(const LAS u32x4*)(stg + row * STROW + ch * 16); if (!DRY || v.x == 0x12345678u) *(u32x4*)(obase + (size_t)row * NZ + ch * 8) = v; }
}
}
namespace mls {
constexpr int QI = 0, KI = 32768, VI = 65536, SC = 131072;
constexpr int F_IG = 0, F_LF = 128, F_A = 256, F_M = 384, F_INTER = 512, F_EMT = 640, F_W = 768, F_DEN = 896, F_N = 1024, F_MISC = 1152,
              F_NQ2P = 1280, F_NQ1P = 1792, F_NP = 2304, F_RSQ = 2816, F_END = 3840;
constexpr int LDS_BYTES = SC + F_END * 4;
static_assert(LDS_BYTES <= 147456, "mLSTM LDS");

template <int CTRL> DI float dpp_keep(float old, float v) { return __builtin_bit_cast(float, __builtin_amdgcn_update_dpp(__builtin_bit_cast(int, old), __builtin_bit_cast(int, v), CTRL, 0xF, 0xF, false)); }
DI float scan_add(float x, int lane) {
    x += dpp_keep<0x111>(0.f, x); x += dpp_keep<0x112>(0.f, x); x += dpp_keep<0x114>(0.f, x); x += dpp_keep<0x118>(0.f, x);
    const float t0 = rdlane(x, 15), t1 = rdlane(x, 31), t2 = rdlane(x, 47); const int r = lane >> 4;
    return x + ((r >= 1 ? t0 : 0.f) + (r >= 2 ? t1 : 0.f) + (r >= 3 ? t2 : 0.f));
}
DI float scan_max(float x, int lane) {
    const float ninf = -3.0e38f;
    x = fmaxf(x, dpp_keep<0x111>(ninf, x)); x = fmaxf(x, dpp_keep<0x112>(ninf, x)); x = fmaxf(x, dpp_keep<0x114>(ninf, x)); x = fmaxf(x, dpp_keep<0x118>(ninf, x));
    const float t0 = rdlane(x, 15), t1 = rdlane(x, 31), t2 = rdlane(x, 47); const int r = lane >> 4;
    return fmaxf(x, fmaxf(fmaxf(r >= 1 ? t0 : ninf, r >= 2 ? t1 : ninf), r >= 3 ? t2 : ninf));
}
DI float log_sigmoid(float x) { return fminf(x, 0.f) - __logf(1.0f + __expf(-fabsf(x))); }

template <bool DRY, int ABL = 0> DI void mlstm_unit(LAS unsigned char* lds, bf16_t* Z, const float* GIF, const float* conv_w, const float* conv_b, const float* norm_g, int b, int hd) {
    int tid_o = threadIdx.x; OPAQUE(tid_o); const int tid = tid_o, lane = tid & 63; const int wid = __builtin_amdgcn_readfirstlane(tid >> 6);
    LAS float* sc = (LAS float*)(lds + SC);
#define MLS_LV unsigned L_ = lane; OPAQUE(L_); const unsigned r32 = L_ & 31, hi = L_ >> 5, rowb = 256u * r32, f16 = (((r32 & 3) << 2) | ((r32 >> 2) & 3)) << 4, q64 = ((L_ & 15) >> 2) << 6; (void)rowb; (void)f16; (void)q64; (void)hi
    f32x16 CT[4];
#pragma unroll
    for (int i = 0; i < 4; ++i)
#pragma unroll
        for (int r = 0; r < 16; ++r) CT[i][r] = 0.f;
    float m_prev = 0.f;
    if (tid < 128) sc[F_N + tid] = 0.f;
    const int img = wid >> 2, vc = wid & 3;
    const int st_i = wid >> 1, st_j0 = 2 * (wid & 1);

    u32x4 rawn[11]; float gin = 0.f, gfn = 0.f;
#define MLS_PREFETCH(CC) do { int tp = tid; OPAQUE(tp); const int p_mat = tp >> 8, p_ch = tp & 15, p_rg = (tp >> 4) & 15; const size_t tn = (size_t)b * SEQ + (size_t)(CC) * 128; \
        const bf16_t* srcn = Z + (tn + p_rg * 8) * NZ + (p_mat ? ZC_MK : ZC_MQ) + hd * 128 + p_ch * 8; \
        _Pragma("unroll") for (int j = 0; j < 11; ++j) { const int lp = (CC) * 128 + p_rg * 8 - 3 + j; rawn[j] = (u32x4){0u, 0u, 0u, 0u}; if (lp >= 0) rawn[j] = *(const u32x4*)(srcn + (ptrdiff_t)(j - 3) * NZ); } \
        if (tp < 128) { const float* gg = GIF + (tn + tp) * 8; gin = gg[hd]; gfn = gg[4 + hd]; } } while (0)
    MLS_PREFETCH(0);
    for (int c = 0; c < 16; ++c) {
        const size_t t0 = (size_t)b * SEQ + (size_t)c * 128;
        __syncthreads();
        u32x4 vn[8];
        { int tq = tid; OPAQUE(tq);
#pragma unroll
          for (int i = 0; i < 8; ++i) { const int idx = tq + 512 * i, row = idx >> 5, ch32 = idx & 31; vn[i] = *(const u32x4*)(Z + (t0 + row) * NZ + ZC_MV + hd * 256 + ch32 * 8); } }
        {
            int tq = tid; OPAQUE(tq);
            const int c_mat = tq >> 8, c_ch = tq & 15, c_rg = (tq >> 4) & 15;
            const int chan0 = c_mat * 512 + hd * 128 + c_ch * 8;
            const float kscale = c_mat ? 0.08838834764831845f : 1.0f;
            float cw[4][8], cb[8];
            { const GAS float* cwp = (const GAS float*)(conv_w + chan0); const GAS float* cbp = (const GAS float*)(conv_b + chan0); asm volatile("" : "+v"(cwp), "+v"(cbp));
#pragma unroll
              for (int j = 0; j < 4; ++j) { const f32x4 a = *(const GAS f32x4*)(cwp + j * 1024), c4 = *(const GAS f32x4*)(cwp + j * 1024 + 4);
                cw[j][0] = a[0]; cw[j][1] = a[1]; cw[j][2] = a[2]; cw[j][3] = a[3]; cw[j][4] = c4[0]; cw[j][5] = c4[1]; cw[j][6] = c4[2]; cw[j][7] = c4[3]; }
              const f32x4 a = *(const GAS f32x4*)cbp, c4 = *(const GAS f32x4*)(cbp + 4); cb[0] = a[0]; cb[1] = a[1]; cb[2] = a[2]; cb[3] = a[3]; cb[4] = c4[0]; cb[5] = c4[1]; cb[6] = c4[2]; cb[7] = c4[3]; }
            u32x4 raw[11];
#pragma unroll
            for (int j = 0; j < 11; ++j) raw[j] = rawn[j];
#pragma unroll
            for (int i = 0; i < 8; ++i) {
                float o[8];
#pragma unroll
                for (int e = 0; e < 8; ++e) { const int q = e >> 1; const bool hi_ = e & 1;
                    const float x0 = hi_ ? bf_hi(raw[i][q]) : bf_lo(raw[i][q]), x1 = hi_ ? bf_hi(raw[i + 1][q]) : bf_lo(raw[i + 1][q]), x2 = hi_ ? bf_hi(raw[i + 2][q]) : bf_lo(raw[i + 2][q]), x3 = hi_ ? bf_hi(raw[i + 3][q]) : bf_lo(raw[i + 3][q]);
                    const float y = cb[e] + cw[0][e] * x0 + cw[1][e] * x1 + cw[2][e] * x2 + cw[3][e] * x3; o[e] = (ABL & 1) ? y : siluf_(y) * kscale; }
                u32x4 w; w.x = pk2(o[0], o[1]); w.y = pk2(o[2], o[3]); w.z = pk2(o[4], o[5]); w.w = pk2(o[6], o[7]);
                *(LAS u32x4*)(lds + (c_mat ? KI : QI) + off_b(c_rg * 8 + i, c_ch)) = w;
            }
        }
        { int tq = tid; OPAQUE(tq);
#pragma unroll
        for (int i = 0; i < 8; ++i) { const int idx = tq + 512 * i, row = idx >> 5, ch32 = idx & 31;
            *(LAS u32x4*)(lds + VI + (ch32 >> 4) * 32768 + off_b(row, ch32 & 15)) = vn[i]; } }
        if (tid < 128) { sc[F_IG + tid] = gin; sc[F_LF + tid] = log_sigmoid(gfn);
            if (c > 0) sc[F_N + tid] = sc[F_MISC + 1] * sc[F_N + tid] + (sc[F_NP + tid] + sc[F_NP + 128 + tid]) + (sc[F_NP + 256 + tid] + sc[F_NP + 384 + tid]); }
        __syncthreads();
        if (wid == 0 && !(ABL & 8)) {
            const float ig0 = sc[F_IG + 2 * lane], ig1 = sc[F_IG + 2 * lane + 1], lf0 = sc[F_LF + 2 * lane], lf1 = sc[F_LF + 2 * lane + 1];
            const float s2 = lf0 + lf1, incl = scan_add(s2, lane), excl = incl - s2;
            const float b0 = excl + lf0, b1 = incl, a0 = ig0 - b0, a1 = ig1 - b1;
            const float im = scan_max(fmaxf(a0, a1), lane); const float em = dpp_keep<0x138>(-3.0e38f, im);
            const float cm0 = fmaxf(em, a0), cm1 = im;
            const float M0 = fmaxf(m_prev, cm0), M1 = fmaxf(m_prev, cm1);
            const float ML = rdlane(M1, 63), bL = rdlane(b1, 63);
            sc[F_A + 2 * lane] = a0; sc[F_A + 2 * lane + 1] = a1; sc[F_M + 2 * lane] = M0; sc[F_M + 2 * lane + 1] = M1;
            sc[F_INTER + 2 * lane] = __expf(m_prev - M0); sc[F_INTER + 2 * lane + 1] = __expf(m_prev - M1);
            sc[F_EMT + 2 * lane] = __expf(-(b0 + M0)); sc[F_EMT + 2 * lane + 1] = __expf(-(b1 + M1));
            sc[F_W + 2 * lane] = __expf(a0 - ML); sc[F_W + 2 * lane + 1] = __expf(a1 - ML);
            if (lane == 0) sc[F_MISC + 0] = __expf(m_prev - ML);
            m_prev = bL + ML;
        }
        f32x16 sT[2];
#pragma unroll
        for (int jj = 0; jj < 2; ++jj) {
#pragma unroll
            for (int r = 0; r < 16; ++r) sT[jj][r] = 0.f;
            const int j = st_j0 + jj;
            if (j <= st_i) { MLS_LV; const unsigned fh = (16u * hi) ^ f16;
                bf16x8 af[8], qq[8];
#pragma unroll
                for (int ks = 0; ks < 8; ++ks) { const unsigned xo = rowb + ((32u * ks) ^ fh);
                    af[ks] = *(const LAS bf16x8*)(lds + KI + 8192 * j + xo); qq[ks] = *(const LAS bf16x8*)(lds + QI + 8192 * st_i + xo); }
                __builtin_amdgcn_sched_barrier(0);
#pragma unroll
                for (int ks = 0; ks < 8; ++ks) sT[jj] = MFMA32(af[ks], qq[ks], sT[jj]);
                __builtin_amdgcn_sched_barrier(0);
            }
        }
        __syncthreads();
        u32x2 pp[2][4];
        { MLS_LV; const int t = 32 * st_i + r32; const float Mt = sc[F_M + t]; const unsigned ab = SC + 4 * F_A + 128 * st_j0 + 16 * hi;
#pragma unroll
          for (int jj = 0; jj < 2; ++jj) { const int j = st_j0 + jj;
#pragma unroll
            for (int g4 = 0; g4 < 4; ++g4) { const int s0 = 32 * j + 8 * g4 + 4 * hi; float pv[4];
#pragma unroll
                for (int e = 0; e < 4; ++e) { const int s = s0 + e; pv[e] = (s <= t) ? __expf(*(const LAS float*)(lds + ab + 4 * (32 * jj + 8 * g4 + e)) - Mt) * sT[jj][4 * g4 + e] : 0.f; }
                pp[jj][g4].x = pk2(pv[0], pv[1]); pp[jj][g4].y = pk2(pv[2], pv[3]); } } }
        f32x16 acc[4];
#pragma unroll
        for (int ti = 0; ti < 4; ++ti)
#pragma unroll
            for (int r = 0; r < 16; ++r) acc[ti][r] = 0.f;
        if (c > 0) {
#pragma unroll
            for (int dt = 0; dt < 4; ++dt)
#pragma unroll
                for (int s2 = 0; s2 < 2; ++s2) { const bf16x8 bfr = pack_step(CT[dt], s2); MLS_LV;
                    const unsigned a0 = QI + rowb + 8 * hi + ((64u * dt + 32u * s2) ^ f16), a1 = QI + rowb + 8 * hi + ((64u * dt + 32u * s2 + 16u) ^ f16);
                    s16x4 lo[4], hi4[4];
#pragma unroll
                    for (int ti = 0; ti < 4; ++ti) { lo[ti] = *(const LAS s16x4*)(lds + a0 + 8192 * ti); hi4[ti] = *(const LAS s16x4*)(lds + a1 + 8192 * ti); }
                    __builtin_amdgcn_sched_barrier(0);
#pragma unroll
                    for (int ti = 0; ti < 4; ++ti) acc[ti] = MFMA32(cat8(lo[ti], hi4[ti]), bfr, acc[ti]);
                    __builtin_amdgcn_sched_barrier(0); }
        }
        { int tq = tid; OPAQUE(tq); const int t = tq & 127, part = tq >> 7; float d = 0.f;
#pragma unroll
          for (int cc = 0; cc < 4; ++cc) { const int ch = 4 * part + cc; const u32x4 raw = *(const LAS u32x4*)(lds + QI + off_b(t, ch)); const LAS float* nn = sc + F_N + 8 * ch;
              d += bf_lo(raw.x) * nn[0] + bf_hi(raw.x) * nn[1] + bf_lo(raw.y) * nn[2] + bf_hi(raw.y) * nn[3] + bf_lo(raw.z) * nn[4] + bf_hi(raw.z) * nn[5] + bf_lo(raw.w) * nn[6] + bf_hi(raw.w) * nn[7]; }
          sc[F_NQ2P + part * 128 + t] = d; }
        __syncthreads();
        { MLS_LV; const unsigned ib = SC + 4 * F_INTER + 16 * hi;
#pragma unroll
          for (int ti = 0; ti < 4; ++ti)
#pragma unroll
            for (int r = 0; r < 16; ++r) acc[ti][r] *= *(const LAS float*)(lds + ib + 4 * (32 * ti + (r & 3) + 8 * (r >> 2))); }
        { MLS_LV;
#pragma unroll
          for (int jj = 0; jj < 2; ++jj) { const int j = st_j0 + jj;
#pragma unroll
            for (int g4 = 0; g4 < 4; ++g4) *(LAS u32x2*)(lds + QI + 8192 * st_i + rowb + 8 * hi + ((64u * j + 16u * g4) ^ f16)) = pp[jj][g4]; } }
        { int tq = tid; OPAQUE(tq);
#pragma unroll
        for (int i = 0; i < 4; ++i) { const int idx = tq + 512 * i, row = idx >> 4, ch = idx & 15; LAS u32x4* p = (LAS u32x4*)(lds + KI + off_b(row, ch)); const u32x4 raw = *p; const float w = sc[F_W + row];
            u32x4 o; o.x = pk2(bf_lo(raw.x) * w, bf_hi(raw.x) * w); o.y = pk2(bf_lo(raw.y) * w, bf_hi(raw.y) * w); o.z = pk2(bf_lo(raw.z) * w, bf_hi(raw.z) * w); o.w = pk2(bf_lo(raw.w) * w, bf_hi(raw.w) * w); *p = o; } }
        __syncthreads();
        { const float decay = sc[F_MISC + 0];
#pragma unroll
          for (int dt = 0; dt < 4; ++dt)
#pragma unroll
            for (int r = 0; r < 16; ++r) CT[dt][r] *= decay; }
#pragma unroll
        for (int ks = 0; ks < 8; ++ks) {
            MLS_LV;
            const unsigned tbv0 = VI + img * 32768 + tr_base(L_, 0) + ((64u * vc) ^ q64), tbv1 = VI + img * 32768 + tr_base(L_, 1) + ((64u * vc) ^ q64);
            const unsigned tbk0 = KI + tr_base(L_, 0), tbk1 = KI + tr_base(L_, 1);
            const bf16x8 bv = cat8(tr_read(lds + tbv0 + 4096 * ks), tr_read(lds + tbv1 + 4096 * ks));
            const unsigned xo = QI + rowb + ((32u * ks) ^ ((16u * hi) ^ f16));
            bf16x8 pa[4]; s16x4 klo[4], khi[4];
#pragma unroll
            for (int ti = 0; ti < 4; ++ti) if (ks < 2 * (ti + 1)) pa[ti] = *(const LAS bf16x8*)(lds + xo + 8192 * ti);
#pragma unroll
            for (int dt = 0; dt < 4; ++dt) { const unsigned cx = (64u * dt) ^ q64; klo[dt] = tr_read(lds + tbk0 + 4096 * ks + cx); khi[dt] = tr_read(lds + tbk1 + 4096 * ks + cx); }
            __builtin_amdgcn_sched_barrier(0);
#pragma unroll
            for (int ti = 0; ti < 4; ++ti) if (ks < 2 * (ti + 1)) acc[ti] = MFMA32(pa[ti], bv, acc[ti]);
#pragma unroll
            for (int dt = 0; dt < 4; ++dt) CT[dt] = MFMA32(cat8(klo[dt], khi[dt]), bv, CT[dt]);
            __builtin_amdgcn_sched_barrier(0);
        }
        { int tq = tid; OPAQUE(tq); const int t = tq & 127, part = tq >> 7; float d = 0.f;
#pragma unroll
          for (int cc = 0; cc < 4; ++cc) { const u32x4 raw = *(const LAS u32x4*)(lds + QI + off_b(t, 4 * part + cc));
              d += (bf_lo(raw.x) + bf_hi(raw.x)) + (bf_lo(raw.y) + bf_hi(raw.y)) + (bf_lo(raw.z) + bf_hi(raw.z)) + (bf_lo(raw.w) + bf_hi(raw.w)); }
          sc[F_NQ1P + part * 128 + t] = d;
          float nn = 0.f;
          if (!(ABL & 16)) for (int s = 32 * part; s < 32 * part + 32; ++s) nn += bf2f(*(const LAS bf16_t*)(lds + KI + off_b(s, t >> 3) + (t & 7) * 2));
          sc[F_NP + part * 128 + t] = nn;
          if (tid == 0) sc[F_MISC + 1] = sc[F_MISC + 0]; }
        __syncthreads();
        if (tid < 128) { const float nq1 = (sc[F_NQ1P + tid] + sc[F_NQ1P + 128 + tid]) + (sc[F_NQ1P + 256 + tid] + sc[F_NQ1P + 384 + tid]);
            const float nq2 = (sc[F_NQ2P + tid] + sc[F_NQ2P + 128 + tid]) + (sc[F_NQ2P + 256 + tid] + sc[F_NQ2P + 384 + tid]);
            sc[F_DEN + tid] = 1.0f / fmaxf(fabsf(nq1 + sc[F_INTER + tid] * nq2), sc[F_EMT + tid]); }
        __syncthreads();
        u32x4 oraw[8];
        { int tq = tid; OPAQUE(tq);
#pragma unroll
          for (int i = 0; i < 8; ++i) { const int idx = tq + 512 * i, row = idx >> 5, ch = idx & 31; oraw[i] = *(const u32x4*)(Z + (t0 + row) * NZ + hd * 256 + ch * 8 + ZC_MO); } }
        { MLS_LV; const unsigned db = SC + 4 * F_DEN + 16 * hi, hb = VI + 2048 * hi + (32 * wid + r32) * 2;
#pragma unroll
          for (int ti = 0; ti < 4; ++ti)
#pragma unroll
            for (int r = 0; r < 16; ++r) { const int tt = 32 * ti + (r & 3) + 8 * (r >> 2); const float x = acc[ti][r] * *(const LAS float*)(lds + db + 4 * tt);
                *(LAS bf16_t*)(lds + hb + 512 * tt) = (bf16_t)(pk2(x, 0.f) & 0xffffu); } }
        __syncthreads();
        { const int cn = c + 1 < 16 ? c + 1 : 15; MLS_PREFETCH(cn); }
        if (!(ABL & 2))
        { int tq = tid; OPAQUE(tq);
          const f32x4 g0 = *(const f32x4*)(norm_g + hd * 256 + (tq & 31) * 8), g1 = *(const f32x4*)(norm_g + hd * 256 + (tq & 31) * 8 + 4);
#pragma unroll
          for (int i = 0; i < 8; ++i) { const int idx = tq + 512 * i, row = idx >> 5, ch = idx & 31;
            const u32x4 hraw = *(const LAS u32x4*)(lds + VI + row * 512 + ch * 16);
            const float h0 = bf_lo(hraw.x), h1 = bf_hi(hraw.x), h2 = bf_lo(hraw.y), h3 = bf_hi(hraw.y), h4 = bf_lo(hraw.z), h5 = bf_hi(hraw.z), h6 = bf_lo(hraw.w), h7 = bf_hi(hraw.w);
            float ssq = (h0 * h0 + h1 * h1) + (h2 * h2 + h3 * h3) + (h4 * h4 + h5 * h5) + (h6 * h6 + h7 * h7);
            ssq = half_sum32(ssq);
            const float rstd = rsqrtf(ssq * (1.0f / 256.0f) + LN_EPS);
            bf16_t* gp = Z + (t0 + row) * NZ + hd * 256 + ch * 8;
            u32x4 o;
            o.x = pk2(h0 * rstd * g0[0] * sigmoidf_(bf_lo(oraw[i].x)), h1 * rstd * g0[1] * sigmoidf_(bf_hi(oraw[i].x)));
            o.y = pk2(h2 * rstd * g0[2] * sigmoidf_(bf_lo(oraw[i].y)), h3 * rstd * g0[3] * sigmoidf_(bf_hi(oraw[i].y)));
            o.z = pk2(h4 * rstd * g1[0] * sigmoidf_(bf_lo(oraw[i].z)), h5 * rstd * g1[1] * sigmoidf_(bf_hi(oraw[i].z)));
            o.w = pk2(h6 * rstd * g1[2] * sigmoidf_(bf_lo(oraw[i].w)), h7 * rstd * g1[3] * sigmoidf_(bf_hi(oraw[i].w)));
            if (!DRY || o.x == 0x12345678u) *(u32x4*)(gp + ZC_MV) = o; } }
    }
    __syncthreads();
}
#undef MLS_LV
#undef MLS_PREFETCH
}
namespace peer {
constexpr int KROW = 144;
constexpr int L_KEYS = 0, L_IDX = 2 * 128 * KROW, LDS_BYTES = L_IDX + 512 * 32;
DI unsigned ordf(float f) { const unsigned u = __float_as_uint(f); return u ^ ((unsigned)((int)u >> 31) | 0x80000000u); }
DI float deord(unsigned k) { return __uint_as_float(k ^ ((~(unsigned)((int)k >> 31)) | 0x80000000u)); }
#define PEER_CE(a, b) do { const unsigned hi_ = (a) > (b) ? (a) : (b), lo_ = (a) > (b) ? (b) : (a); (a) = hi_; (b) = lo_; } while (0)
DI void sort16_desc(unsigned (&a)[16]) {
    PEER_CE(a[0], a[13]); PEER_CE(a[1], a[12]); PEER_CE(a[2], a[15]); PEER_CE(a[3], a[14]); PEER_CE(a[4], a[8]); PEER_CE(a[5], a[6]); PEER_CE(a[7], a[11]); PEER_CE(a[9], a[10]);
    PEER_CE(a[0], a[5]); PEER_CE(a[1], a[7]); PEER_CE(a[2], a[9]); PEER_CE(a[3], a[4]); PEER_CE(a[6], a[13]); PEER_CE(a[8], a[14]); PEER_CE(a[10], a[15]); PEER_CE(a[11], a[12]);
    PEER_CE(a[0], a[1]); PEER_CE(a[2], a[3]); PEER_CE(a[4], a[5]); PEER_CE(a[6], a[8]); PEER_CE(a[7], a[9]); PEER_CE(a[10], a[11]); PEER_CE(a[12], a[13]); PEER_CE(a[14], a[15]);
    PEER_CE(a[0], a[2]); PEER_CE(a[1], a[3]); PEER_CE(a[4], a[10]); PEER_CE(a[5], a[11]); PEER_CE(a[6], a[7]); PEER_CE(a[8], a[9]); PEER_CE(a[12], a[14]); PEER_CE(a[13], a[15]);
    PEER_CE(a[1], a[2]); PEER_CE(a[3], a[12]); PEER_CE(a[4], a[6]); PEER_CE(a[5], a[7]); PEER_CE(a[8], a[10]); PEER_CE(a[9], a[11]); PEER_CE(a[13], a[14]);
    PEER_CE(a[1], a[4]); PEER_CE(a[2], a[6]); PEER_CE(a[5], a[8]); PEER_CE(a[7], a[10]); PEER_CE(a[9], a[13]); PEER_CE(a[11], a[14]);
    PEER_CE(a[2], a[4]); PEER_CE(a[3], a[6]); PEER_CE(a[9], a[12]); PEER_CE(a[11], a[13]);
    PEER_CE(a[3], a[5]); PEER_CE(a[6], a[8]); PEER_CE(a[7], a[9]); PEER_CE(a[10], a[12]);
    PEER_CE(a[3], a[4]); PEER_CE(a[5], a[6]); PEER_CE(a[7], a[8]); PEER_CE(a[9], a[10]); PEER_CE(a[11], a[12]);
    PEER_CE(a[6], a[7]); PEER_CE(a[8], a[9]);
}
DI void merge16(unsigned (&a)[16], const unsigned (&b)[16]) {
#pragma unroll
    for (int i = 0; i < 16; ++i) a[i] = a[i] > b[15 - i] ? a[i] : b[15 - i];
#pragma unroll
    for (int j = 8; j >= 1; j >>= 1)
#pragma unroll
        for (int i = 0; i < 16; ++i) { const int l = i ^ j; if (l > i) PEER_CE(a[i], a[l]); }
}
DI float gelu_erf(float x) { return 0.5f * x * (1.0f + erff(x * 0.7071067811865476f)); }

DI void stage_keys(LAS unsigned char* lds, const float* keys) {
    for (int i = threadIdx.x; i < 2 * 128 * 8; i += 512) { const int row = i >> 3, ch = i & 7; const float* s = keys + row * 64 + ch * 8;
        const f32x4 a = *(const f32x4*)s, b = *(const f32x4*)(s + 4);
        u32x4 w; w.x = pk2(a[0], a[1]); w.y = pk2(a[2], a[3]); w.z = pk2(b[0], b[1]); w.w = pk2(b[2], b[3]);
        *(LAS u32x4*)(lds + L_KEYS + row * KROW + ch * 16) = w; }
}

DI void select_phase(LAS unsigned char* lds, const bf16_t* QP, int tile0, int tstep, int tile_end, bf16_t* SELE, float* SELG) {
    int tid_o = threadIdx.x; OPAQUE(tid_o); const int tid = tid_o, lane = tid & 63, r32 = lane & 31, hi = lane >> 5; const int wid = __builtin_amdgcn_readfirstlane(tid >> 6);
    bf16x8 qn[2][4];
#define SEL_QLOAD(TILE) do { const bf16_t* qp_ = QP + ((size_t)(TILE) * 32 + r32) * DM + wid * 128 + 8 * hi; \
        _Pragma("unroll") for (int p_ = 0; p_ < 2; ++p_) _Pragma("unroll") for (int s_ = 0; s_ < 4; ++s_) qn[p_][s_] = *(const bf16x8*)(qp_ + p_ * 64 + 16 * s_); } while (0)
    if (tile0 < tile_end) SEL_QLOAD(tile0);
    for (int tile = tile0; tile < tile_end; tile += tstep) {
    const int tok0 = tile * 32;
    unsigned LA[16], LB[16];
    bf16x8 qc[2][4];
#pragma unroll
    for (int p = 0; p < 2; ++p)
#pragma unroll
        for (int s = 0; s < 4; ++s) qc[p][s] = qn[p][s];
    { const int tn = tile + tstep < tile_end ? tile + tstep : tile; SEL_QLOAD(tn); }
#pragma unroll
    for (int p = 0; p < 2; ++p) {
        bf16x8 qf[4];
#pragma unroll
        for (int s = 0; s < 4; ++s) qf[s] = qc[p][s];
        unsigned L[16], M[16];
#pragma unroll
        for (int nt = 0; nt < 4; ++nt) {
            f32x16 acc;
#pragma unroll
            for (int r = 0; r < 16; ++r) acc[r] = 0.f;
#pragma unroll
            for (int s = 0; s < 4; ++s) { const bf16x8 a = *(const LAS bf16x8*)(lds + L_KEYS + (p * 128 + 32 * nt + r32) * KROW + (2 * s + hi) * 16); acc = MFMA32(a, qf[s], acc); }
            unsigned T[16];
#pragma unroll
            for (int r = 0; r < 16; ++r) T[r] = (ordf(acc[r]) & ~0x7Fu) | (unsigned)(32 * nt + crow(r, hi));
            sort16_desc(T);
            if (nt == 0) {
#pragma unroll
                for (int i = 0; i < 16; ++i) L[i] = T[i]; }
            else if (nt == 1) merge16(L, T);
            else if (nt == 2) {
#pragma unroll
                for (int i = 0; i < 16; ++i) M[i] = T[i]; }
            else { merge16(M, T); merge16(L, M); }
        }
        unsigned O[16];
#pragma unroll
        for (int i = 0; i < 16; ++i) O[i] = partner32(L[i], hi);
        merge16(L, O);
#pragma unroll
        for (int i = 0; i < 16; ++i) { if (p == 0) LA[i] = L[i]; else LB[i] = L[i]; }
    }
    unsigned CL[16];
    {
        float sa[16], sb[16];
#pragma unroll
        for (int i = 0; i < 16; ++i) { sa[i] = deord(LA[i] & ~0x7Fu); sb[i] = deord(LB[i] & ~0x7Fu); }
        unsigned G0[16], G1[16];
#define SEL_PUT(k, v) do { if ((k) < 16) G0[(k) & 15] = (v); else G1[(k) & 15] = (v); } while (0)
#define SEL_CAND2(k, iA, jA, iB, jB) SEL_PUT(k, (ordf((hi ? sa[iB] : sa[iA]) + (hi ? sb[jB] : sb[jA])) & ~0xFFu) | (unsigned)(hi ? (iB) * 16 + (jB) : (iA) * 16 + (jA)))
#define SEL_CAND1(k, iA, jA) SEL_PUT(k, hi ? 0u : ((ordf(sa[iA] + sb[jA]) & ~0xFFu) | (unsigned)((iA) * 16 + (jA))))
        SEL_CAND2(0, 0, 0, 3, 3);
        SEL_CAND2(1, 0, 1, 4, 0);
        SEL_CAND2(2, 0, 2, 4, 1);
        SEL_CAND2(3, 0, 3, 4, 2);
        SEL_CAND2(4, 0, 4, 5, 0);
        SEL_CAND2(5, 0, 5, 5, 1);
        SEL_CAND2(6, 0, 6, 6, 0);
        SEL_CAND2(7, 0, 7, 6, 1);
        SEL_CAND2(8, 0, 8, 7, 0);
        SEL_CAND2(9, 0, 9, 7, 1);
        SEL_CAND2(10, 0, 10, 8, 0);
        SEL_CAND2(11, 0, 11, 9, 0);
        SEL_CAND2(12, 0, 12, 10, 0);
        SEL_CAND2(13, 0, 13, 11, 0);
        SEL_CAND2(14, 0, 14, 12, 0);
        SEL_CAND2(15, 0, 15, 13, 0);
        SEL_CAND2(16, 1, 0, 14, 0);
        SEL_CAND2(17, 1, 1, 15, 0);
        SEL_CAND1(18, 1, 2);
        SEL_CAND1(19, 1, 3);
        SEL_CAND1(20, 1, 4);
        SEL_CAND1(21, 1, 5);
        SEL_CAND1(22, 1, 6);
        SEL_CAND1(23, 1, 7);
        SEL_CAND1(24, 2, 0);
        SEL_CAND1(25, 2, 1);
        SEL_CAND1(26, 2, 2);
        SEL_CAND1(27, 2, 3);
        SEL_CAND1(28, 2, 4);
        SEL_CAND1(29, 3, 0);
        SEL_CAND1(30, 3, 1);
        SEL_CAND1(31, 3, 2);
#undef SEL_PUT
#undef SEL_CAND2
#undef SEL_CAND1
        sort16_desc(G0); sort16_desc(G1); merge16(G0, G1);
        unsigned O[16];
#pragma unroll
        for (int i = 0; i < 16; ++i) O[i] = partner32(G0[i], hi);
        merge16(G0, O);
#pragma unroll
        for (int i = 0; i < 16; ++i) CL[i] = G0[i];
    }
    LAS unsigned char* itab = lds + L_IDX + tid * 32;
    { u32x4 wa, wb;
#pragma unroll
      for (int q = 0; q < 4; ++q) { wa[q] = (LA[4 * q] & 0x7Fu) | ((LA[4 * q + 1] & 0x7Fu) << 8) | ((LA[4 * q + 2] & 0x7Fu) << 16) | ((LA[4 * q + 3] & 0x7Fu) << 24);
                                    wb[q] = (LB[4 * q] & 0x7Fu) | ((LB[4 * q + 1] & 0x7Fu) << 8) | ((LB[4 * q + 2] & 0x7Fu) << 16) | ((LB[4 * q + 3] & 0x7Fu) << 24); }
      *(LAS u32x4*)itab = wa; *(LAS u32x4*)(itab + 16) = wb; }
    const float mx = deord(CL[0] & ~0xFFu);
    float ev[16], sum = 0.f;
#pragma unroll
    for (int k = 0; k < 16; ++k) { ev[k] = __expf(deord(CL[k] & ~0xFFu) - mx); sum += ev[k]; }
    const float inv = 1.0f / sum;
    bf16_t* se = SELE + (size_t)(tok0 + r32) * 128 + wid * 16;
    float* sg = SELG + (size_t)(tok0 + r32) * 128 + wid * 16;
#pragma unroll
    for (int k = 0; k < 16; ++k) if ((k >> 3) == hi) { const unsigned code = CL[k] & 0xFFu; const unsigned n1 = itab[code >> 4], n2 = itab[16 + (code & 15u)];
        se[k] = (bf16_t)(n1 * 128u + n2); sg[k] = ev[k] * inv; }
    }
#undef SEL_QLOAD
}

DI void u_phase(LAS unsigned char* lds, int tile0, int tstep, int s, const bf16_t* SELE, const unsigned char* H2Q, const unsigned char* U4S, bf16_t* PART) {
    int tid_o = threadIdx.x; OPAQUE(tid_o); const int tid = tid_o, lane = tid & 63, j = lane >> 3, c = lane & 7; const int wid = __builtin_amdgcn_readfirstlane(tid >> 6);
    if (tile0 >= TOK / 32) return;
    LAS unsigned char* wl = lds + wid * 4096;
    const unsigned char* Us = U4S + (size_t)s * NEXP * 128; const unsigned c16 = 16u * c;
    u32x4 sreg;
#define UP_STAGE_LOAD(TILE) do { sreg = *(const u32x4*)(SELE + (size_t)(TILE) * 32 * 128 + (wid * 64 + lane) * 8); } while (0)
#define UP_STAGE_STORE(BUF) do { *(LAS u32x4*)(wl + (BUF) * 2048 + lane * 16) = sreg; } while (0)
#define UP_GATHER(UR, H0, H1, BUF, JT, TILE) do { const LAS bf16_t* se_ = (const LAS bf16_t*)(wl + (BUF) * 2048) + (JT) * 128 + j; const size_t t_ = (size_t)(TILE) * 32 + wid * 4 + (JT); \
        { const unsigned char* hrow_ = H2Q + t_ * DM + 128 * s; H0 = *(const u32x4*)(hrow_ + c16); H1 = *(const u32x4*)(hrow_ + 512 + c16); }       \
        _Pragma("unroll") for (int g = 0; g < 16; ++g) { const unsigned e_ = se_[8 * g]; UR[g] = *(const u32x4*)(Us + ((e_ << 7) + c16)); } } while (0)
#define UP_COMPUTE(UR, H0, H1, JT, TILE) do { \
        int d[16]; \
        _Pragma("unroll") for (int g = 0; g < 16; ++g) { int da = 0, db = 0; \
            _Pragma("unroll") for (int i = 0; i < 4; ++i) { da = __builtin_amdgcn_sdot8((int)UR[g][i], (int)H0[i], da, false); db = __builtin_amdgcn_sdot8((int)UR[g][i], (int)H1[i], db, false); } \
            d[g] = 16 * da + db; if ((g & 3) == 3) __builtin_amdgcn_sched_barrier(0); } \
          \
        int r1[8], r2[4], r3[2]; \
        _Pragma("unroll") for (int i = 0; i < 8; ++i) { const int keep = c2 ? d[i + 8] : d[i], send = c2 ? d[i] : d[i + 8]; r1[i] = keep + dppi<0x141>(send); } \
        _Pragma("unroll") for (int i = 0; i < 4; ++i) { const int keep = c1 ? r1[i + 4] : r1[i], send = c1 ? r1[i] : r1[i + 4]; r2[i] = keep + dppi<0x4E>(send); } \
        _Pragma("unroll") for (int i = 0; i < 2; ++i) { const int keep = c0 ? r2[i + 2] : r2[i], send = c0 ? r2[i] : r2[i + 2]; r3[i] = keep + dppi<0xB1>(send); } \
        bf16_t* pp = PART + ((size_t)(TILE) * 32 + wid * 4 + (JT)) * 512 + s * 128 + 16 * c + j;            \
        pp[0] = (bf16_t)(pk2((float)r3[0], 0.f) & 0xffffu); pp[8] = (bf16_t)(pk2((float)r3[1], 0.f) & 0xffffu); } while (0)
    u32x4 urA[16], urB[16], hA0, hA1, hB0, hB1; const int c2 = c >> 2, c1 = (c >> 1) & 1, c0 = c & 1;
    UP_STAGE_LOAD(tile0); UP_STAGE_STORE(0);
    UP_GATHER(urA, hA0, hA1, 0, 0, tile0);
    int buf = 0;
#pragma unroll 1
    for (int tile = tile0; tile < TOK / 32; tile += tstep) {
        const int tnext = tile + tstep < TOK / 32 ? tile + tstep : tile;
        UP_STAGE_LOAD(tnext);
        UP_GATHER(urB, hB0, hB1, buf, 1, tile); UP_COMPUTE(urA, hA0, hA1, 0, tile);
        UP_GATHER(urA, hA0, hA1, buf, 2, tile); UP_COMPUTE(urB, hB0, hB1, 1, tile);
        UP_GATHER(urB, hB0, hB1, buf, 3, tile); UP_COMPUTE(urA, hA0, hA1, 2, tile);
        UP_STAGE_STORE(buf ^ 1);
        UP_GATHER(urA, hA0, hA1, buf ^ 1, 0, tnext);
        UP_COMPUTE(urB, hB0, hB1, 3, tile);
        buf ^= 1;
    }
#undef UP_STAGE_LOAD
#undef UP_STAGE_STORE
#undef UP_GATHER
#undef UP_COMPUTE
}
template <int NQ> DI void red_tokens(size_t t0, const bf16_t* __restrict__ PART, const bf16_t* __restrict__ SELE, const float* __restrict__ SELG, const float* __restrict__ SU, const float* __restrict__ SV,
                    const float* __restrict__ SH, signed char* __restrict__ COEFQ, float* __restrict__ CS) {
    const int lane = threadIdx.x & 63;
    float s[NQ][2], g[NQ][2], su[NQ][2], sv[NQ][2], sh[NQ];
#pragma unroll
    for (int q = 0; q < NQ; ++q) { const size_t t = t0 + q; sh[q] = SH[t];
#pragma unroll
        for (int h = 0; h < 2; ++h) { const int k = lane + 64 * h; const unsigned e = SELE[t * 128 + k]; g[q][h] = SELG[t * 128 + k]; su[q][h] = SU[e]; sv[q][h] = SV[e];
            float a = 0.f;
#pragma unroll
            for (int xx = 0; xx < 4; ++xx) a += bf2f(PART[t * 512 + xx * 128 + k]);
            s[q][h] = a; } }
#pragma unroll
    for (int q = 0; q < NQ; ++q) { const size_t t = t0 + q;
        const float c0 = g[q][0] * gelu_erf(s[q][0] * su[q][0] * sh[q]) * sv[q][0], c1 = g[q][1] * gelu_erf(s[q][1] * su[q][1] * sh[q]) * sv[q][1];
        float cm = fmaxf(fabsf(c0), fabsf(c1));
        cm = wave_max(cm);
        const float inv = cm > 0.f ? 127.0f / cm : 0.f;
        signed char* cq = COEFQ + t * 128 + (lane & 7) * 16 + (lane >> 3);
        cq[0] = (signed char)(int)rintf(c0 * inv); cq[8] = (signed char)(int)rintf(c1 * inv);
        if (lane == 0) CS[t] = cm * (1.0f / 127.0f); }
}
DI unsigned bperm(unsigned hi, unsigned lo, unsigned sel) { return __builtin_amdgcn_perm(hi, lo, sel); }
DI void v_phase(LAS unsigned char* lds, int tile0, int tstep, int x, const bf16_t* SELE, const signed char* COEFQ, const float* CS, const unsigned char* V8S, bf16_t* YF) {
    int tid_o = threadIdx.x; OPAQUE(tid_o); const int tid = tid_o, lane = tid & 63, j = lane >> 3, c = lane & 7; const int wid = __builtin_amdgcn_readfirstlane(tid >> 6);
    if (tile0 >= TOK / 32) return;
    LAS unsigned char* wl = lds + wid * 4096;
    const unsigned char* Vs = V8S + (size_t)x * NEXP * 128; const unsigned c16 = 16u * c;
    u32x4 sreg, creg = {0u, 0u, 0u, 0u};
#define VP_STAGE_LOAD(TILE) do { sreg = *(const u32x4*)(SELE + (size_t)(TILE) * 32 * 128 + (wid * 64 + lane) * 8); if (lane < 32) creg = *(const u32x4*)(COEFQ + (size_t)(TILE) * 32 * 128 + (wid * 32 + lane) * 16); } while (0)
#define VP_STAGE_STORE(BUF) do { *(LAS u32x4*)(wl + (BUF) * 2048 + lane * 16) = sreg; if (lane < 32) *(LAS u32x4*)(wl + (BUF) * 2048 + 1024 + lane * 16) = creg; } while (0)
#define VP_GATHER(VR, SC, BUF, JT, TILE) do { const LAS bf16_t* se_ = (const LAS bf16_t*)(wl + (BUF) * 2048) + (JT) * 128 + j; SC = CS[(size_t)(TILE) * 32 + wid * 4 + (JT)]; \
        _Pragma("unroll") for (int g = 0; g < 16; ++g) { const unsigned e_ = se_[8 * g]; VR[g] = *(const u32x4*)(Vs + ((e_ << 7) + c16)); } } while (0)
#define VP_COMPUTE(VR, SC, BUF, JT, TILE) do { const LAS unsigned* cqp_ = (const LAS unsigned*)(wl + (BUF) * 2048 + 1024 + (JT) * 128 + j * 16); \
        int acc[16]; \
        _Pragma("unroll") for (int i = 0; i < 16; ++i) acc[i] = 0; \
        _Pragma("unroll") for (int qd = 0; qd < 4; ++qd) { const int cp = (int)cqp_[qd]; \
            _Pragma("unroll") for (int i = 0; i < 4; ++i) { const unsigned w0 = VR[4 * qd][i], w1 = VR[4 * qd + 1][i], w2 = VR[4 * qd + 2][i], w3 = VR[4 * qd + 3][i]; \
                const unsigned t0 = bperm(w1, w0, 0x05010400u), t1 = bperm(w1, w0, 0x07030602u), t2 = bperm(w3, w2, 0x05010400u), t3 = bperm(w3, w2, 0x07030602u); \
                acc[4 * i] = __builtin_amdgcn_sdot4((int)bperm(t2, t0, 0x05040100u), cp, acc[4 * i], false); \
                acc[4 * i + 1] = __builtin_amdgcn_sdot4((int)bperm(t2, t0, 0x07060302u), cp, acc[4 * i + 1], false); \
                acc[4 * i + 2] = __builtin_amdgcn_sdot4((int)bperm(t3, t1, 0x05040100u), cp, acc[4 * i + 2], false); \
                acc[4 * i + 3] = __builtin_amdgcn_sdot4((int)bperm(t3, t1, 0x07060302u), cp, acc[4 * i + 3], false); } } \
          \
        int r1[8], r2[4], r3[2]; \
        _Pragma("unroll") for (int i = 0; i < 8; ++i) { const int keep = b3 ? acc[i + 8] : acc[i], send = b3 ? acc[i] : acc[i + 8]; r1[i] = keep + dppi<0x128>(send); }                          \
        _Pragma("unroll") for (int i = 0; i < 4; ++i) { const int keep = b4 ? r1[i + 4] : r1[i], send = b4 ? r1[i] : r1[i + 4]; r2[i] = keep + __builtin_amdgcn_ds_swizzle(send, 0x401F); }     \
        _Pragma("unroll") for (int i = 0; i < 2; ++i) { const int keep = b5 ? r2[i + 2] : r2[i], send = b5 ? r2[i] : r2[i + 2]; r3[i] = keep + (int)partner32((unsigned)send, b5); }              \
        *(unsigned*)(YF + ((size_t)(TILE) * 32 + wid * 4 + (JT)) * DM + 128 * x + 16 * c + 8 * b3 + 4 * b4 + 2 * b5) = pk2((float)r3[0] * SC, (float)r3[1] * SC); } while (0)
    u32x4 vrA[16], vrB[16]; float scA, scB; const int b3 = j & 1, b4 = (j >> 1) & 1, b5 = j >> 2;
    VP_STAGE_LOAD(tile0); VP_STAGE_STORE(0);
    VP_GATHER(vrA, scA, 0, 0, tile0);
    int buf = 0;
#pragma unroll 1
    for (int tile = tile0; tile < TOK / 32; tile += tstep) {
        const int tnext = tile + tstep < TOK / 32 ? tile + tstep : tile;
        VP_STAGE_LOAD(tnext);
        VP_GATHER(vrB, scB, buf, 1, tile); VP_COMPUTE(vrA, scA, buf, 0, tile);
        VP_GATHER(vrA, scA, buf, 2, tile); VP_COMPUTE(vrB, scB, buf, 1, tile);
        VP_GATHER(vrB, scB, buf, 3, tile); VP_COMPUTE(vrA, scA, buf, 2, tile);
        VP_STAGE_STORE(buf ^ 1);
        VP_GATHER(vrA, scA, buf ^ 1, 0, tnext);
        VP_COMPUTE(vrB, scB, buf, 3, tile);
        buf ^= 1;
    }
#undef VP_STAGE_LOAD
#undef VP_STAGE_STORE
#undef VP_GATHER
#undef VP_COMPUTE
}
DI void final_rows2(size_t m0, size_t m1, const bf16_t* __restrict__ Rp, const bf16_t* __restrict__ YF, const float* __restrict__ MOD, const float* __restrict__ g1, const float* __restrict__ b1,
                    const float* __restrict__ ln_g, const float* __restrict__ ln_b, float* __restrict__ OUT) {
    const int lane = threadIdx.x & 63;
    f32x4 v[2][4], y[2][4];
#pragma unroll
    for (int r = 0; r < 2; ++r) { const size_t m = r ? m1 : m0;
        const u32x2* rr = (const u32x2*)(Rp + m * DM) + lane; const u32x2* yr = (const u32x2*)(YF + m * DM) + lane;
#pragma unroll
        for (int q = 0; q < 4; ++q) { const u32x2 rw = rr[64 * q]; v[r][q] = (f32x4){bf_lo(rw.x), bf_hi(rw.x), bf_lo(rw.y), bf_hi(rw.y)}; const u32x2 yy = yr[64 * q]; y[r][q] = (f32x4){bf_lo(yy.x), bf_hi(yy.x), bf_lo(yy.y), bf_hi(yy.y)}; } }
#pragma unroll
    for (int r = 0; r < 2; ++r) { const size_t m = r ? m1 : m0; const int b = (int)(m / SEQ); const f32x4* gt = (const f32x4*)(MOD + (size_t)b * MODW + 5 * DM) + lane; float s = 0.f;
#pragma unroll
        for (int q = 0; q < 4; ++q) s += (v[r][q].x + v[r][q].y) + (v[r][q].z + v[r][q].w);
        float mean = wave_sum(s) * (1.f / DM); float s2 = 0.f;
#pragma unroll
        for (int q = 0; q < 4; ++q) { v[r][q] = v[r][q] - mean; s2 += (v[r][q].x * v[r][q].x + v[r][q].y * v[r][q].y) + (v[r][q].z * v[r][q].z + v[r][q].w * v[r][q].w); }
        float rstd = rsqrtf(wave_sum(s2) * (1.f / DM) + LN_EPS); s = 0.f;
#pragma unroll
        for (int q = 0; q < 4; ++q) { const f32x4 x1 = v[r][q] * rstd * ((const f32x4*)g1)[lane + 64 * q] + ((const f32x4*)b1)[lane + 64 * q];
            v[r][q] = x1 * ALPHA_RES + gt[64 * q] * y[r][q]; s += (v[r][q].x + v[r][q].y) + (v[r][q].z + v[r][q].w); }
        mean = wave_sum(s) * (1.f / DM); s2 = 0.f;
#pragma unroll
        for (int q = 0; q < 4; ++q) { v[r][q] = v[r][q] - mean; s2 += (v[r][q].x * v[r][q].x + v[r][q].y * v[r][q].y) + (v[r][q].z * v[r][q].z + v[r][q].w * v[r][q].w); }
        rstd = rsqrtf(wave_sum(s2) * (1.f / DM) + LN_EPS);
        f32x4* op = (f32x4*)(OUT + m * DM) + lane;
#pragma unroll
        for (int q = 0; q < 4; ++q) op[64 * q] = v[r][q] * rstd * ((const f32x4*)ln_g)[lane + 64 * q] + ((const f32x4*)ln_b)[lane + 64 * q]; }
}
}
constexpr int NWAVES = 8;
#ifndef MK_N_LAUNCHES
#define MK_N_LAUNCHES 1
#endif
constexpr int N_PHASES = 14;
constexpr int RING_BYTES = 147456;
constexpr int MISC_OFF = RING_BYTES;
constexpr int LDS_BYTES = RING_BYTES + 4096;
static_assert(pg8::STAGE_BYTES <= RING_BYTES && datt::LDS_BYTES <= RING_BYTES && mls::LDS_BYTES <= RING_BYTES && peer::LDS_BYTES <= RING_BYTES, "LDS map");

typedef GAS unsigned gu32;
#define RLX_AGENT __ATOMIC_RELAXED, __HIP_MEMORY_SCOPE_AGENT
#define LDS_WAIT() asm volatile("s_waitcnt lgkmcnt(0)" ::: "memory")

#define XB_TMO      128
#define XB_XCNT(j)  (256  + 64 * (j))
#define XB_XSUB(j)  (1280 + 64 * (j))
#define XB_XGEN(j)  (2304 + 64 * (j))
#define XB_TOP      3328
#define XB_TOPGEN   3392
#define XCD_BAR_WORDS 3456
#define XB_SPIN_CAP (1u << 22)
DI unsigned xb_ld(unsigned* p)              { return __hip_atomic_load(p, __ATOMIC_RELAXED, __HIP_MEMORY_SCOPE_AGENT); }
DI unsigned xb_add(unsigned* p, unsigned v) { return __hip_atomic_fetch_add(p, v, __ATOMIC_RELAXED, __HIP_MEMORY_SCOPE_AGENT); }
DI unsigned xb_xcc_id() { return (unsigned)__builtin_amdgcn_s_getreg((3 << 11) | 20) & 0xFu; }
#define XB_SPIN(cond, bar) do { unsigned _sp = 0; while (cond) { __builtin_amdgcn_s_sleep(1); \
    if ((++_sp & 255u) == 0u) { if (xb_ld(&(bar)[XB_TMO])) break; if (_sp > XB_SPIN_CAP) { atomicAdd(&(bar)[XB_TMO], 1u); break; } } } } while (0)
struct XcdBarrier { unsigned* bar; unsigned x; volatile LAS unsigned* st; };
DI XcdBarrier xcd_barrier_post(unsigned* bar, volatile LAS unsigned* st) {
    XcdBarrier b; b.bar = bar; b.x = xb_xcc_id(); b.st = st;
    if (threadIdx.x == 0) st[2] = xb_add(&bar[XB_XCNT(b.x)], 1u);
    return b;
}
DI void xcd_barrier_complete(unsigned* bar, unsigned x, unsigned& nloc, unsigned& nx) {
    const unsigned G = gridDim.x * gridDim.y * gridDim.z;
    unsigned sum, cnt, mine, sp = 0u;
    for (;;) {
        sum = 0u; cnt = 0u; mine = 0u;
#pragma unroll
        for (unsigned j = 0; j < 16; ++j) { const unsigned c = xb_ld(&bar[XB_XCNT(j)]); sum += c; cnt += (c > 0u) ? 1u : 0u; mine = (j == x) ? c : mine; }
        if (sum == G) break;
        __builtin_amdgcn_s_sleep(1);
        if ((++sp & 255u) == 0u) { if (xb_ld(&bar[XB_TMO])) break; if (sp > XB_SPIN_CAP) { atomicAdd(&bar[XB_TMO], 1u); break; } }
    }
    nloc = mine > 0u ? mine : 1u; nx = cnt > 0u ? cnt : 1u;
}
DI void xcd_barrier(const XcdBarrier& b) {
    asm volatile("s_waitcnt vmcnt(0)" ::: "memory");
    __syncthreads();
    if (threadIdx.x == 0) {
        unsigned* bar = b.bar;
        __builtin_amdgcn_s_waitcnt(0);
        unsigned nloc = b.st[0], nx = b.st[1];
        if (nloc == 0u) { xcd_barrier_complete(bar, b.x, nloc, nx); b.st[0] = nloc; b.st[1] = nx; }
        const unsigned old = xb_add(&bar[XB_XSUB(b.x)], 1u);
        const unsigned gen = old / nloc;
        if (old + 1u == (gen + 1u) * nloc) {
            __builtin_amdgcn_fence(__ATOMIC_RELEASE, "agent");
            asm volatile("s_waitcnt vmcnt(0)" ::: "memory");
            const unsigned og = xb_add(&bar[XB_TOP], 1u);
            const unsigned tg = og / nx;
            if (og + 1u == (tg + 1u) * nx) xb_add(&bar[XB_TOPGEN], 1u);
            else XB_SPIN(xb_ld(&bar[XB_TOPGEN]) == tg, bar);
            xb_add(&bar[XB_XGEN(b.x)], 1u);
            __builtin_amdgcn_fence(__ATOMIC_ACQUIRE, "agent");
            asm volatile("s_waitcnt vmcnt(0)" ::: "memory");
        } else {
            XB_SPIN(xb_ld(&bar[XB_XGEN(b.x)]) == gen, bar);
            __builtin_amdgcn_fence(__ATOMIC_ACQUIRE, "agent");
            asm volatile("s_waitcnt vmcnt(0)" ::: "memory");
        }
    }
    __syncthreads();
}

#ifndef FLATBAR
#define FLATBAR 0
#endif
DI void flat_barrier(unsigned* cnt, unsigned& epoch) {
    asm volatile("s_waitcnt vmcnt(0)" ::: "memory");
    __syncthreads();
    if (threadIdx.x == 0) {
        __builtin_amdgcn_fence(__ATOMIC_RELEASE, "agent");
        asm volatile("s_waitcnt vmcnt(0)" ::: "memory");
        const unsigned target = (epoch + 1u) * gridDim.x;
        xb_add(cnt, 1u);
        unsigned sp = 0;
        while (xb_ld(cnt) < target) { __builtin_amdgcn_s_sleep(1); if (++sp > (1u << 24)) break; }
        __builtin_amdgcn_fence(__ATOMIC_ACQUIRE, "agent");
        asm volatile("s_waitcnt vmcnt(0)" ::: "memory");
    }
    ++epoch;
    __syncthreads();
}
DI void p0_transpose_item(const float* W, int ldw, int col0, bf16_t* WT, int K, int dst_row0, int kb, float scale, LAS float* scr, int lane) {
    const int k0 = 64 * kb;
#pragma unroll 8
    for (int i = 0; i < 32; ++i) { const int kk = 2 * i + (lane >> 5); scr[kk * 33 + (lane & 31)] = W[(size_t)(k0 + kk) * ldw + col0 + (lane & 31)] * scale; }
    LDS_WAIT(); asm volatile("" ::: "memory");
    const int c = lane & 7;
#pragma unroll
    for (int j = 0; j < 4; ++j) { const int n = (lane >> 3) + 8 * j; const LAS float* s = scr + (8 * c) * 33 + n;
        u32x4 o; o.x = pk2(s[0 * 33], s[1 * 33]); o.y = pk2(s[2 * 33], s[3 * 33]); o.z = pk2(s[4 * 33], s[5 * 33]); o.w = pk2(s[6 * 33], s[7 * 33]);
        *(u32x4*)(WT + (size_t)(dst_row0 + n) * K + k0 + 8 * c) = o; }
    LDS_WAIT(); asm volatile("" ::: "memory");
}


DI void p1_rows2(int m0, int m1, int lane, const float* __restrict__ xin, const float* __restrict__ MODp, bf16_t* __restrict__ H1p, float* __restrict__ GIFp, const float* __restrict__ bif, const LAS float* wif) {
    f32x4 v[2][4], scv[2][4], shv[2][4];
#pragma unroll
    for (int r = 0; r < 2; ++r) { const int m = r ? m1 : m0; const int b = m / SEQ;
        const f32x4* xr = (const f32x4*)(xin + (size_t)m * DM) + lane; const f32x4* sh = (const f32x4*)(MODp + (size_t)b * MODW) + lane; const f32x4* sc = (const f32x4*)(MODp + (size_t)b * MODW + DM) + lane;
#pragma unroll
        for (int j = 0; j < 4; ++j) { v[r][j] = xr[64 * j]; scv[r][j] = sc[64 * j]; shv[r][j] = sh[64 * j]; } }
#pragma unroll
    for (int r = 0; r < 2; ++r) { const int m = r ? m1 : m0; float s = 0.f;
#pragma unroll
        for (int j = 0; j < 4; ++j) s += (v[r][j].x + v[r][j].y) + (v[r][j].z + v[r][j].w);
        const float mean = wave_sum(s) * (1.f / DM); float s2 = 0.f;
#pragma unroll
        for (int j = 0; j < 4; ++j) { v[r][j] = v[r][j] - mean; s2 += (v[r][j].x * v[r][j].x + v[r][j].y * v[r][j].y) + (v[r][j].z * v[r][j].z + v[r][j].w * v[r][j].w); }
        const float rstd = rsqrtf(wave_sum(s2) * (1.f / DM) + LN_EPS);
        unsigned long long* o8 = (unsigned long long*)(H1p + (size_t)m * DM) + lane;
        float gp[8];
#pragma unroll
        for (int g = 0; g < 8; ++g) gp[g] = 0.f;
        const LAS float* wl = wif + 4 * lane; asm volatile("" : "+v"(wl));
#pragma unroll
        for (int j = 0; j < 4; ++j) { const f32x4 hh = v[r][j] * rstd * (scv[r][j] + 1.0f) + shv[r][j];
            o8[64 * j] = (unsigned long long)pk2(hh.x, hh.y) | ((unsigned long long)pk2(hh.z, hh.w) << 32);
#pragma unroll
            for (int g = 0; g < 8; ++g) { const f32x4 w = *(const LAS f32x4*)(wl + g * 1024 + 256 * j); gp[g] += (hh.x * w.x + hh.y * w.y) + (hh.z * w.z + hh.w * w.w); } }
#pragma unroll
        for (int g = 0; g < 8; ++g) gp[g] = wave_sum(gp[g]);
        if (lane == 0) {
#pragma unroll
            for (int g = 0; g < 8; ++g) GIFp[(size_t)m * 8 + g] = gp[g] + bif[g]; } }
}
template <int NR> DI void p7_rows(int m0, int lane, const bf16_t* __restrict__ Rp, const float* __restrict__ MODp, const float* __restrict__ g1, const float* __restrict__ b1,
                 bf16_t* __restrict__ H2p, unsigned char* __restrict__ H2Qp, float* __restrict__ SHp) {
    f32x4 v[NR][4], scv[4], shv[4];
    { const int b = m0 / SEQ; const f32x4* sh = (const f32x4*)(MODp + (size_t)b * MODW + 3 * DM) + lane; const f32x4* sc = (const f32x4*)(MODp + (size_t)b * MODW + 4 * DM) + lane;
#pragma unroll
      for (int r = 0; r < NR; ++r) { const u32x2* rr = (const u32x2*)(Rp + (size_t)(m0 + r) * DM) + lane;
#pragma unroll
        for (int j = 0; j < 4; ++j) { const u32x2 rw = rr[64 * j]; v[r][j] = (f32x4){bf_lo(rw.x), bf_hi(rw.x), bf_lo(rw.y), bf_hi(rw.y)}; } }
#pragma unroll
      for (int j = 0; j < 4; ++j) { scv[j] = sc[64 * j]; shv[j] = sh[64 * j]; } }
#pragma unroll
    for (int r = 0; r < NR; ++r) { const int m = m0 + r; float s = 0.f;
#pragma unroll
        for (int j = 0; j < 4; ++j) s += (v[r][j].x + v[r][j].y) + (v[r][j].z + v[r][j].w);
        float mean = wave_sum(s) * (1.f / DM); float s2 = 0.f;
#pragma unroll
        for (int j = 0; j < 4; ++j) { v[r][j] = v[r][j] - mean; s2 += (v[r][j].x * v[r][j].x + v[r][j].y * v[r][j].y) + (v[r][j].z * v[r][j].z + v[r][j].w * v[r][j].w); }
        float rstd = rsqrtf(wave_sum(s2) * (1.f / DM) + LN_EPS);
        s = 0.f;
#pragma unroll
        for (int j = 0; j < 4; ++j) { v[r][j] = v[r][j] * rstd * ((const f32x4*)g1)[lane + 64 * j] + ((const f32x4*)b1)[lane + 64 * j]; s += (v[r][j].x + v[r][j].y) + (v[r][j].z + v[r][j].w); }
        mean = wave_sum(s) * (1.f / DM); s2 = 0.f;
#pragma unroll
        for (int j = 0; j < 4; ++j) { v[r][j] = v[r][j] - mean; s2 += (v[r][j].x * v[r][j].x + v[r][j].y * v[r][j].y) + (v[r][j].z * v[r][j].z + v[r][j].w * v[r][j].w); }
        rstd = rsqrtf(wave_sum(s2) * (1.f / DM) + LN_EPS);
        unsigned long long* o8 = (unsigned long long*)(H2p + (size_t)m * DM) + lane;
        float amax = 0.f;
#pragma unroll
        for (int j = 0; j < 4; ++j) { const f32x4 hh = v[r][j] * rstd * (scv[j] + 1.0f) + shv[j]; o8[64 * j] = (unsigned long long)pk2(hh.x, hh.y) | ((unsigned long long)pk2(hh.z, hh.w) << 32);
            v[r][j] = hh; amax = fmaxf(amax, fmaxf(fmaxf(fabsf(hh.x), fabsf(hh.y)), fmaxf(fabsf(hh.z), fabsf(hh.w)))); }
        amax = wave_max(amax);
        const float qinv = amax > 0.f ? 119.0f / amax : 0.f;
        unsigned char* hq = H2Qp + (size_t)m * DM;
#pragma unroll
        for (int j = 0; j < 4; ++j) { const int q0 = (int)rintf(v[r][j].x * qinv), q1 = (int)rintf(v[r][j].y * qinv), q2 = (int)rintf(v[r][j].z * qinv), q3 = (int)rintf(v[r][j].w * qinv);
            const int a0 = (q0 + 8) >> 4, a1 = (q1 + 8) >> 4, a2 = (q2 + 8) >> 4, a3 = (q3 + 8) >> 4;
            const unsigned ha = (unsigned)(a0 & 15) | ((unsigned)(a1 & 15) << 4) | ((unsigned)(a2 & 15) << 8) | ((unsigned)(a3 & 15) << 12);
            const unsigned hb = (unsigned)((q0 - 16 * a0) & 15) | ((unsigned)((q1 - 16 * a1) & 15) << 4) | ((unsigned)((q2 - 16 * a2) & 15) << 8) | ((unsigned)((q3 - 16 * a3) & 15) << 12);
            const unsigned pa = (unsigned)dppi<0xB1>((int)ha), pb = (unsigned)dppi<0xB1>((int)hb);
            if (!(lane & 1)) { *(unsigned*)(hq + 128 * j + 2 * lane) = ha | (pa << 16); *(unsigned*)(hq + 512 + 128 * j + 2 * lane) = hb | (pb << 16); } }
        if (lane == 0) SHp[m] = amax * (1.0f / 119.0f); }
}


DI void prep_small_weights_item(LAS unsigned char* lds, int item, const float* w0, const float* w1, const float* w2, const float* w3, bf16_t* d0, bf16_t* d1, bf16_t* d2, bf16_t* d3) {
    int t = threadIdx.x; OPAQUE(t); const int lane = t & 63, wave = __builtin_amdgcn_readfirstlane(t >> 6);
    const int r = item * 8 + wave, wsel = r / 512, q = r % 512, kb = q / 32, nb = q % 32;
    const float* src = wsel == 0 ? w0 : wsel == 1 ? w1 : wsel == 2 ? w2 : w3; bf16_t* dst = wsel == 0 ? d0 : wsel == 1 ? d1 : wsel == 2 ? d2 : d3;
    p0_transpose_item(src, DM, 32 * nb, dst, DM, 32 * nb, kb, 1.0f, (LAS float*)(lds + wave * 16384), lane);
}
DI void prep_quant_item(int item, const float* pu, const float* pv, unsigned char* U8, unsigned char* V8, float* SU, float* SV) {
    int t = threadIdx.x; OPAQUE(t); const int lane = t & 63, wave = __builtin_amdgcn_readfirstlane(t >> 6);
#pragma unroll 1
    for (int it = 0; it < 4; ++it) { const int row0 = item * 128 + wave * 16 + it * 4;
        f32x4 a[4][4];
#pragma unroll
        for (int r = 0; r < 4; ++r) { const int row = row0 + r; const bool second = row >= NEXP; const int e = second ? row - NEXP : row;
            const float* s = (second ? pv : pu) + (size_t)e * DM + 16 * lane;
#pragma unroll
            for (int j = 0; j < 4; ++j) a[r][j] = *(const f32x4*)(s + 4 * j); }
#pragma unroll
        for (int r = 0; r < 4; ++r) { const int row = row0 + r; const bool second = row >= NEXP; const int e = second ? row - NEXP : row;
            float amax = 0.f;
#pragma unroll
            for (int j = 0; j < 4; ++j) amax = fmaxf(amax, fmaxf(fmaxf(fabsf(a[r][j].x), fabsf(a[r][j].y)), fmaxf(fabsf(a[r][j].z), fabsf(a[r][j].w))));
            amax = wave_max(amax);
            if (second) {
            const float inv = amax > 0.f ? 127.0f / amax : 0.f;
            u32x4 w;
#pragma unroll
            for (int j = 0; j < 4; ++j) { const int q0 = (int)rintf(a[r][j].x * inv), q1 = (int)rintf(a[r][j].y * inv), q2 = (int)rintf(a[r][j].z * inv), q3 = (int)rintf(a[r][j].w * inv);
                w[j] = (unsigned)(q0 & 255) | ((unsigned)(q1 & 255) << 8) | ((unsigned)(q2 & 255) << 16) | ((unsigned)(q3 & 255) << 24); }
            *(u32x4*)(V8 + (size_t)(lane >> 3) * NEXP * 128 + (size_t)e * 128 + (lane & 7) * 16) = w;
            if (lane == 0) SV[e] = amax * (1.0f / 127.0f);
            } else {
            const float inv = amax > 0.f ? 7.0f / amax : 0.f;
            u32x2 w;
#pragma unroll
            for (int j = 0; j < 4; ++j) { const unsigned n0 = (unsigned)((int)rintf(a[r][j].x * inv) & 15), n1 = (unsigned)((int)rintf(a[r][j].y * inv) & 15), n2 = (unsigned)((int)rintf(a[r][j].z * inv) & 15), n3 = (unsigned)((int)rintf(a[r][j].w * inv) & 15);
                const unsigned two = n0 | (n1 << 4) | (n2 << 8) | (n3 << 12);
                if (j & 1) w[j >> 1] |= two << 16; else w[j >> 1] = two; }
            *(u32x2*)(U8 + (size_t)(lane >> 4) * NEXP * 128 + (size_t)e * 128 + (lane & 15) * 8) = w;
            if (lane == 0) SU[e] = amax * (1.0f / 7.0f);
            } } }
}

struct Args { const float* in[22]; float* out; unsigned char* ws; int ph_lo, ph_hi; };

__global__ void __launch_bounds__(NWAVES * 64, 2) mega_fwd(Args args) {
    extern __shared__ __attribute__((aligned(16))) unsigned char lds_raw[];
    LAS unsigned char* lds = (LAS unsigned char*)lds_raw;
    volatile LAS unsigned* MISC = (volatile LAS unsigned*)(lds + MISC_OFF);
    const int tid = threadIdx.x, lane = tid & 63, wave = __builtin_amdgcn_readfirstlane(tid >> 6);
    const int G = gridDim.x; const int bx = blockIdx.x; const int vcu = (G % 8 == 0) ? (bx % 8) * (G / 8) + bx / 8 : bx;
    const int gw = vcu * NWAVES + wave, NGW = G * NWAVES;
#define ws (args.ws)
#define ctl ((unsigned*)(ws + WS_CTL))
#define x_in (args.in[0])
#define cvec (args.in[1])
#define w_ada (args.in[2])
#define b_ada (args.in[3])
#define w_in (args.in[4])
#define b_if (args.in[5])
#define conv_w (args.in[6])
#define conv_b (args.in[7])
#define da_lambda (args.in[8])
#define da_subln_g (args.in[9])
#define ml_norm_g (args.in[10])
#define w_br_attn (args.in[11])
#define w_br_mlstm (args.in[12])
#define w_out (args.in[13])
#define ln1_g (args.in[14])
#define ln1_b (args.in[15])
#define peer_wq (args.in[16])
#define peer_keys (args.in[17])
#define peer_u (args.in[18])
#define peer_v (args.in[19])
#define ln2_g (args.in[20])
#define ln2_b (args.in[21])
#define MOD ((float*)(ws + WS_MOD))
#define GIF ((float*)(ws + WS_GIF))
#define WIN ((bf16_t*)(ws + WS_WIN))
#define WA ((bf16_t*)(ws + WS_WA))
#define WM ((bf16_t*)(ws + WS_WM))
#define WOUT ((bf16_t*)(ws + WS_WOUT))
#define WQ ((bf16_t*)(ws + WS_WQ))
#define UT8 ((unsigned char*)(ws + WS_U))
#define VT8 ((unsigned char*)(ws + WS_V))
#define SUS ((float*)(ws + WS_SU))
#define SVS ((float*)(ws + WS_SV))
#define SHS ((float*)(ws + WS_SH))
#define CSS ((float*)(ws + WS_CS))
#define H2Q ((unsigned char*)(ws + WS_H2Q))
#define SELE ((bf16_t*)(ws + WS_SELE))
#define SELG ((float*)(ws + WS_SELG))
#define PART ((bf16_t*)(ws + WS_PART))
#define YFB ((bf16_t*)(ws + WS_YF))
#define COEF ((signed char*)(ws + WS_COEF))
#define H1 ((bf16_t*)(ws + WS_H1))
#define Z ((bf16_t*)(ws + WS_Z))
#define R ((bf16_t*)(ws + WS_R))
#define X1 ((float*)(ws + WS_X1))
#define H2 ((bf16_t*)(ws + WS_H2))
#define QP ((bf16_t*)(ws + WS_QP))
#define GATES ((bf16_t*)args.out)

    for (int u = tid; u < (LDS_BYTES - MISC_OFF) / 4; u += NWAVES * 64) MISC[u] = 0u;
    __syncthreads();
    XcdBarrier bar; bar.bar = ctl + CW_BAR; bar.x = 0; bar.st = nullptr;
    if (MK_N_LAUNCHES != N_PHASES) bar = xcd_barrier_post(ctl + CW_BAR, MISC + 8);
    const int lo = args.ph_lo, hi = args.ph_hi;
#ifndef PH_MASK
#define PH_MASK 0x3fff
#endif
#define IN(k) (((PH_MASK >> (k)) & 1) && lo <= (k) && (k) < hi)
    unsigned fepoch = 0; unsigned* fcnt = ctl + CW_QUEUE + 1024;
#if FLATBAR
#define GBAR() flat_barrier(fcnt, fepoch)
#else
#define GBAR() xcd_barrier(bar)
#endif
#define SEAM(k) do { if (IN(k) && IN((k) + 1)) GBAR(); } while (0)

#ifndef XBAR0
#define XBAR0 0
#endif
#if XBAR0
    if (IN(0)) for (int xb = 0; xb < XBAR0; ++xb) xcd_barrier(bar);
#endif
    if (IN(0)) {
        if (vcu * NWAVES < 96 * 8) {
            LAS float* sl = (LAS float*)lds;
            for (int i = tid; i < 32 * DM; i += NWAVES * 64) sl[i] = siluf_(cvec[i]);
            __syncthreads();
            for (int it = gw; it < 96 * 8; it += NGW) {
                const int cb = it % 96, ks = it / 96, col = 64 * cb + lane;
                float acc[32];
#pragma unroll
                for (int b = 0; b < 32; ++b) acc[b] = 0.f;
#pragma unroll 4
                for (int k = 128 * ks; k < 128 * ks + 128; ++k) { const float w = w_ada[(size_t)k * MODW + col];
#pragma unroll
                    for (int b = 0; b < 32; ++b) acc[b] += sl[b * DM + k] * w; }
                const float bias = (ks == 0) ? b_ada[col] : 0.f;
#pragma unroll
                for (int b = 0; b < 32; ++b) atomicAdd(MOD + b * MODW + col, acc[b] + bias);
            }
            __syncthreads();
        }
        LAS float* scr = (LAS float*)(lds + wave * 16384);
        const bool spare = NGW > 96 * 8 + 64; const int tw = spare ? gw - 96 * 8 : gw, ntw = spare ? NGW - 96 * 8 : NGW;
        if (tw >= 0) for (int it = tw; it < 4096; it += ntw) { const int kb = it / 256, nb = it % 256, n0 = 32 * nb; p0_transpose_item(w_in, IN_W, n0 < NZ ? n0 : n0 + 8, WIN, DM, n0, kb, n0 < 1024 ? QSCALE : 1.0f, scr, lane); }
    }
    SEAM(0);
    if (IN(1)) {
        LAS float* wif = (LAS float*)lds;
        for (int i = tid; i < 8192; i += 512) { const int k = i >> 3, j = i & 7; wif[j * 1024 + k] = w_in[(size_t)k * IN_W + NZ + j]; }
        __syncthreads();
        for (int m = gw; m < TOK; m += 2 * NGW) p1_rows2(m, m + NGW, lane, x_in, MOD, H1, GIF, b_if, wif);
    }
#if DUP1
    GBAR();
    if (IN(1)) {
        LAS float* wif = (LAS float*)lds;
        for (int i = tid; i < 8192; i += 512) { const int k = i >> 3, j = i & 7; wif[j * 1024 + k] = w_in[(size_t)k * IN_W + NZ + j]; }
        __syncthreads();
        for (int m = gw; m < TOK; m += 2 * NGW) p1_rows2(m, m + NGW, lane, x_in, MOD, H1, GIF, b_if, wif);
    }
#endif
    SEAM(1);
#ifndef DUP4
#define DUP4 0
#endif
#ifndef DUP6
#define DUP6 0
#endif
#ifndef DUP7
#define DUP7 0
#endif
#ifndef DUP8
#define DUP8 0
#endif
#ifndef DUP1
#define DUP1 0
#endif
#ifndef DUP2
#define DUP2 0
#endif
#ifndef DUP23
#define DUP23 0
#endif
#ifndef P2_STAGGER
#define P2_STAGGER 0
#endif
#define P2_BODY if (IN(2)) { if (P2_STAGGER && ((bx >> 3) & 1)) { const unsigned long long t0_ = __builtin_amdgcn_s_memrealtime(); while (__builtin_amdgcn_s_memrealtime() - t0_ < P2_STAGGER) __builtin_amdgcn_s_sleep(64); } \
        pg8::Gemm g{H1, WIN, TOK, NIN, DM, DM, DM}; pg8::StaticOrder S; S.init(TOK, NIN, G, bx); pg8::EpiZ E{Z, GATES}; \
        pg8::gemm_phase<pg8::EpiZ, pg8::StaticOrder, true, true>(lds, g, S, E); }
#define P3_BODY(QOFF) if (IN(3)) { unsigned* qhead = ctl + CW_QUEUE + (QOFF); int qx = (int)(bar.x & 7u), qtries = 0; const unsigned qlen = 16u + 256u + ((QOFF) == 0 ? 64u : 0u); \
        for (;;) { __syncthreads(); \
            if (tid == 0) { unsigned w = 0xffffffffu; while (qtries < 8) { const unsigned k = __hip_atomic_fetch_add(qhead + qx, 1u, RLX_AGENT); if (k < qlen) { w = ((unsigned)qx << 16) | k; break; } qx = (qx + 1) & 7; ++qtries; } MISC[0] = w; } \
            __syncthreads(); \
            const unsigned w = MISC[0]; if (w == 0xffffffffu) break; const int q = (int)(w >> 16), k = (int)(w & 0xffffu); \
            if (k < 16) { const int u = q * 16 + k; mls::mlstm_unit<false>(lds, Z, GIF, conv_w, conv_b, ml_norm_g, u >> 2, u & 3); } \
            else if (k < 272) { const int a = k - 16, a2 = a & 127, qb = ((a >> 7) ? 3 : 7) - (a2 & 3), bh = q * 32 + (a2 >> 2); datt::attn_unit<false>(lds, Z, da_lambda, da_subln_g, bh >> 3, bh & 7, qb); } \
            else { const int pid = q * 64 + (k - 272); \
                if (pid < 256) prep_quant_item(pid, peer_u, peer_v, UT8, VT8, SUS, SVS); \
                else prep_small_weights_item(lds, pid - 256, w_br_attn, w_br_mlstm, w_out, peer_wq, WA, WM, WOUT, WQ); } } }
#define P3A_DRY(QOFF) if (IN(3)) { unsigned* qhead = ctl + CW_QUEUE + (QOFF); \
        for (;;) { __syncthreads(); if (tid == 0) MISC[0] = __hip_atomic_fetch_add(qhead, 1u, RLX_AGENT); __syncthreads(); \
            const int id = (int)MISC[0]; if (id >= 2048) break; \
            { const int idx = id, qb = 7 - idx / 256, bh = idx % 256; datt::attn_unit<true>(lds, Z, da_lambda, da_subln_g, bh >> 3, bh & 7, qb); } } }
#define P3M_DRY(QOFF) if (IN(3)) { unsigned* qhead = ctl + CW_QUEUE + (QOFF); \
        for (;;) { __syncthreads(); if (tid == 0) MISC[0] = __hip_atomic_fetch_add(qhead, 1u, RLX_AGENT); __syncthreads(); \
            const int id = (int)MISC[0]; if (id >= 128) break; \
            mls::mlstm_unit<true, MLS_ABL>(lds, Z, GIF, conv_w, conv_b, ml_norm_g, id >> 2, id & 3); } }
#ifndef MLS_ABL
#define MLS_ABL 0
#endif
#ifndef DRY3A
#define DRY3A 0
#endif
#ifndef DRY3M
#define DRY3M 0
#endif
    P2_BODY
#if DUP2
    SEAM(2);
    P2_BODY
#endif
    SEAM(2);
#if DRY3A
    P3A_DRY(128)
    if (IN(3)) GBAR();
#endif
#if DRY3M
    P3M_DRY(192)
    if (IN(3)) GBAR();
#endif
    P3_BODY(0)
    SEAM(3);
#if DUP23
    P2_BODY
    SEAM(2);
    P3_BODY(64)
    SEAM(3);
#endif
    if (IN(4)) {
        pg8::Gemm g{Z + ZC_Q, WA, TOK, DM, DM, NZ, DM, (long)(ZC_MV - ZC_Q) * 2, (long)(WS_WM - WS_WA)}; pg8::StaticOrder2 S; S.init(TOK, DM, G, bx);
        pg8::EpiGate2 E{GATES, H1};
        pg8::gemm_phase<pg8::EpiGate2, pg8::StaticOrder2, true, true>(lds, g, S, E);
    }
    SEAM(4);
#define WG_SEAM() do { asm volatile("s_waitcnt vmcnt(0)" ::: "memory"); __syncthreads(); \
        if (tid == 0) { __builtin_amdgcn_fence(__ATOMIC_ACQUIRE, "agent"); asm volatile("s_waitcnt vmcnt(0)" ::: "memory"); } __syncthreads(); } while (0)
    if (IN(6)) {
        { pg8::Gemm g{H1, WOUT, TOK, DM, DM, DM, DM}; pg8::RowsOrder S; S.init(TOK, DM, G, bx);
          pg8::EpiR E{x_in, MOD, R};
          pg8::gemm_phase<pg8::EpiR, pg8::RowsOrder, true, true>(lds, g, S, E); }
        WG_SEAM();
        for (int pm = bx; pm < TOK / 256; pm += G)
#pragma unroll 1
            for (int k = 0; k < 8; ++k) p7_rows<4>(256 * pm + 32 * wave + 4 * k, lane, R, MOD, ln1_g, ln1_b, H2, H2Q, SHS);
        WG_SEAM();
        { pg8::Gemm g{H2, WQ, TOK, DM, DM, DM, DM}; pg8::RowsOrder S; S.init(TOK, DM, G, bx);
          pg8::EpiStore E{QP};
          pg8::gemm_phase<pg8::EpiStore, pg8::RowsOrder, true, true>(lds, g, S, E); }
        WG_SEAM();
        peer::stage_keys(lds, peer_keys);
        __syncthreads();
        for (int pm = bx; pm < TOK / 256; pm += G) peer::select_phase(lds, QP, 8 * pm, 1, 8 * pm + 8, SELE, SELG);
    }
#undef WG_SEAM
    if (IN(6) && IN(10)) GBAR();
    int sx = bx % 8, sr = bx / 8, sn = (G - sx + 7) / 8;
    if (IN(10) || IN(12)) {
        __syncthreads();
        if (tid == 0) { bool phys = (MK_N_LAUNCHES != N_PHASES) && lo == 0 && hi > 10; unsigned mine = 0;
            if (phys) { for (unsigned j = 0; j < 16; ++j) { const unsigned c = xb_ld(&bar.bar[XB_XCNT(j)]); if (j < 8) { if (c == 0u) phys = false; if (j == bar.x) mine = c; } else if (c != 0u) phys = false; } }
            MISC[16] = phys ? bar.x : (unsigned)sx; MISC[17] = phys ? MISC[10] : (unsigned)sr; MISC[18] = phys ? mine : (unsigned)sn; }
        __syncthreads();
        sx = (int)MISC[16]; sr = (int)MISC[17]; sn = (int)MISC[18];
    }
    if (IN(10)) {
        peer::u_phase(lds, 2 * sr + (sx >> 2), 2 * sn, sx & 3, SELE, H2Q, UT8, PART);
    }
    SEAM(10);
    if (IN(11)) { for (int m = 16 * gw; m < TOK; m += 16 * NGW) peer::red_tokens<16>((size_t)m, PART, SELE, SELG, SUS, SVS, SHS, COEF, CSS); }
    SEAM(11);
    if (IN(12)) {
        peer::v_phase(lds, sr, sn, sx, SELE, COEF, CSS, VT8, YFB);
    }
    SEAM(12);
    if (IN(13)) { for (int m = gw; m < TOK; m += 2 * NGW) peer::final_rows2((size_t)m, (size_t)m + NGW, R, YFB, MOD, ln1_g, ln1_b, ln2_g, ln2_b, args.out); }
#undef IN
#undef SEAM
#undef ws
#undef ctl
#undef x_in
#undef cvec
#undef w_ada
#undef b_ada
#undef w_in
#undef b_if
#undef conv_w
#undef conv_b
#undef da_lambda
#undef da_subln_g
#undef ml_norm_g
#undef w_br_attn
#undef w_br_mlstm
#undef w_out
#undef ln1_g
#undef ln1_b
#undef peer_wq
#undef peer_keys
#undef peer_u
#undef peer_v
#undef ln2_g
#undef ln2_b
#undef MOD
#undef GIF
#undef WIN
#undef WA
#undef WM
#undef WOUT
#undef WQ
#undef UT8
#undef VT8
#undef SUS
#undef SVS
#undef SHS
#undef CSS
#undef H2Q
#undef SELE
#undef SELG
#undef PART
#undef YFB
#undef COEF
#undef H1
#undef Z
#undef R
#undef X1
#undef H2
#undef QP
#undef GATES
}

extern "C" void kernel_launch(void* const* d_in, const int* in_sizes, int n_in, void* d_out, int out_size, void* d_ws, size_t ws_size, hipStream_t stream) {
    static int grid = 0;
    if (grid == 0) {
        if (n_in != 22 || in_sizes[0] != TOK * DM || out_size != TOK * DM || ws_size < WS_END) { fprintf(stderr, "kernel_launch: unexpected shapes (n_in %d, in0 %d, out %d, ws %zu; need ws >= %zu)\n", n_in, n_in > 0 ? in_sizes[0] : -1, out_size, ws_size, (size_t)WS_END); grid = -1; return; }
        int dev = 0, cus = 0, per_cu = 0;
        if (hipGetDevice(&dev) != hipSuccess || hipDeviceGetAttribute(&cus, hipDeviceAttributeMultiprocessorCount, dev) != hipSuccess) { fprintf(stderr, "kernel_launch: device query failed\n"); grid = -1; return; }
        if (hipFuncSetAttribute((const void*)mega_fwd, hipFuncAttributeMaxDynamicSharedMemorySize, LDS_BYTES) != hipSuccess) { fprintf(stderr, "kernel_launch: hipFuncSetAttribute failed\n"); grid = -1; return; }
        if (hipOccupancyMaxActiveBlocksPerMultiprocessor(&per_cu, (const void*)mega_fwd, NWAVES * 64, LDS_BYTES) != hipSuccess || per_cu < 1) fprintf(stderr, "kernel_launch: note: occupancy query reports %d workgroups per CU\n", per_cu);
        (void)hipGetLastError();
        grid = cus;
    }
    if (grid < 0) return;
    if (hipMemsetAsync((char*)d_ws + WS_CTL, 0, CTL_ZERO_BYTES, stream) != hipSuccess) { fprintf(stderr, "kernel_launch: memset failed\n"); return; }
    Args a{};
    for (int i = 0; i < 22; ++i) a.in[i] = (const float*)d_in[i];
    a.out = (float*)d_out; a.ws = (unsigned char*)d_ws;
    for (int li = 0; li < MK_N_LAUNCHES; ++li) {
        a.ph_lo = (MK_N_LAUNCHES == N_PHASES) ? li : 0; a.ph_hi = (MK_N_LAUNCHES == N_PHASES) ? li + 1 : N_PHASES;
        hipLaunchKernelGGL(mega_fwd, dim3(grid), dim3(NWAVES * 64), LDS_BYTES, stream, a);
        const hipError_t le = hipPeekAtLastError();
        if (le != hipSuccess) { fprintf(stderr, "kernel_launch: launch %d failed: %s\n", li, hipGetErrorName(le)); break; }
    }
}
```

```cpp
#include <hip/hip_runtime.h>
#include <hip/hip_bf16.h>
#include <cstdio>
#include <cstdint>
#include <cmath>

#define LAS __attribute__((address_space(3)))
#define GAS __attribute__((address_space(1)))
typedef unsigned short bf16_t;
typedef short bf16x8 __attribute__((ext_vector_type(8)));
typedef short s16x4 __attribute__((ext_vector_type(4)));
typedef float f32x2 __attribute__((ext_vector_type(2)));
typedef float f32x4 __attribute__((ext_vector_type(4)));
typedef float f32x16 __attribute__((ext_vector_type(16)));
typedef unsigned u32x2 __attribute__((ext_vector_type(2)));
typedef unsigned u32x4 __attribute__((ext_vector_type(4)));
typedef __bf16 bf16x2_t __attribute__((ext_vector_type(2)));
#define DI __device__ __forceinline__

constexpr int BATCH = 32, SEQ = 2048, DM = 1024, TOK = BATCH * SEQ;
constexpr int NZ = 6144;
constexpr int ZC_Q = 0, ZC_K = 1024, ZC_V = 2048, ZC_MQ = 3072, ZC_MK = 3584, ZC_MV = 4096, ZC_MO = 5120;
constexpr int NGATE = 2048;
constexpr int NIN = 8192;
constexpr int IN_W = 8200;
constexpr int MODW = 6 * DM;
constexpr float LN_EPS = 1e-5f;
constexpr float ALPHA_RES = 1.189207115002721f;
constexpr float LAMBDA_INIT = 0.2f;
constexpr float QSCALE = 0.125f * 1.4426950408889634f;
constexpr int NEXP = 16384;

constexpr size_t MiB = 1u << 20;
constexpr size_t WS_CTL = 0, CTL_ZERO_BYTES = 2 * MiB;
constexpr size_t WS_MOD = 1 * MiB;
constexpr size_t WS_GIF = 3 * MiB;
constexpr size_t WS_WIN = 6 * MiB;
constexpr size_t WS_WA = 22 * MiB, WS_WM = 24 * MiB, WS_WOUT = 26 * MiB, WS_WQ = 28 * MiB;
constexpr size_t WS_U = 30 * MiB, WS_V = 62 * MiB;
constexpr size_t WS_SU = 2 * MiB, WS_SV = 2 * MiB + 65536, WS_SH = 2 * MiB + 131072, WS_CS = 2 * MiB + 393216;
constexpr size_t WS_H2Q = 352 * MiB, WS_SELE = 416 * MiB, WS_SELG = 432 * MiB;
constexpr size_t WS_H1 = 96 * MiB;
constexpr size_t WS_Z = 224 * MiB;
constexpr size_t WS_R = WS_Z, WS_X1 = WS_Z + 256 * MiB, WS_H2 = WS_Z + 512 * MiB, WS_QP = WS_Z + 640 * MiB;
constexpr size_t WS_PART = WS_X1, WS_COEF = WS_H2, WS_YF = WS_QP;
constexpr size_t WS_PART_UNUSED = 0, WS_COEF_UNUSED = 0;
constexpr size_t WS_END = 992 * MiB;
constexpr int CW_BAR = 4096;
constexpr int CW_QUEUE = 16384;

DI unsigned pk2(float lo, float hi) { f32x2 v = {lo, hi}; bf16x2_t b = __builtin_convertvector(v, bf16x2_t); return __builtin_bit_cast(unsigned, b); }
DI float bf_lo(unsigned u) { return __uint_as_float(u << 16); }
DI float bf_hi(unsigned u) { return __uint_as_float(u & 0xffff0000u); }
DI float bf2f(bf16_t h) { return __uint_as_float(((unsigned)h) << 16); }
template <int CTRL> DI float dppf(float v) { return __builtin_bit_cast(float, __builtin_amdgcn_update_dpp(0, __builtin_bit_cast(int, v), CTRL, 0xF, 0xF, true)); }
DI float row_sum16(float v) { v += dppf<0xB1>(v); v += dppf<0x4E>(v); v += dppf<0x141>(v); v += dppf<0x140>(v); return v; }
DI float row_max16(float v) { v = fmaxf(v, dppf<0xB1>(v)); v = fmaxf(v, dppf<0x4E>(v)); v = fmaxf(v, dppf<0x141>(v)); v = fmaxf(v, dppf<0x140>(v)); return v; }
template <int CTRL> DI int dppi(int v) { return __builtin_amdgcn_update_dpp(0, v, CTRL, 0xF, 0xF, true); }
DI float sum32x(float v) { auto rr = __builtin_amdgcn_permlane32_swap(__builtin_bit_cast(unsigned, v), __builtin_bit_cast(unsigned, v), false, false); return __builtin_bit_cast(float, (unsigned)rr[0]) + __builtin_bit_cast(float, (unsigned)rr[1]); }
DI float max32x(float v) { auto rr = __builtin_amdgcn_permlane32_swap(__builtin_bit_cast(unsigned, v), __builtin_bit_cast(unsigned, v), false, false); return fmaxf(__builtin_bit_cast(float, (unsigned)rr[0]), __builtin_bit_cast(float, (unsigned)rr[1])); }
DI int isum32x(int v) { auto rr = __builtin_amdgcn_permlane32_swap((unsigned)v, (unsigned)v, false, false); return (int)rr[0] + (int)rr[1]; }
DI unsigned partner32(unsigned v, int hi) { auto rr = __builtin_amdgcn_permlane32_swap(v, v, false, false); return hi ? (unsigned)rr[0] : (unsigned)rr[1]; }
DI float rdlane(float v, int l) { return __builtin_bit_cast(float, __builtin_amdgcn_readlane(__builtin_bit_cast(int, v), l)); }
DI float wave_sum(float v) { v = row_sum16(v); return (rdlane(v, 0) + rdlane(v, 16)) + (rdlane(v, 32) + rdlane(v, 48)); }
DI float wave_max(float v) { v = row_max16(v); return fmaxf(fmaxf(rdlane(v, 0), rdlane(v, 16)), fmaxf(rdlane(v, 32), rdlane(v, 48))); }
DI float half_sum32(float v) { v = row_sum16(v); return v + __builtin_bit_cast(float, __builtin_amdgcn_ds_swizzle(__builtin_bit_cast(int, v), 0x401F)); }
DI float sigmoidf_(float x) { return __builtin_amdgcn_rcpf(1.0f + __builtin_amdgcn_exp2f(x * -1.4426950408889634f)); }
DI float siluf_(float x) { return x * __builtin_amdgcn_rcpf(1.0f + __builtin_amdgcn_exp2f(x * -1.4426950408889634f)); }
DI int crow(int r, int hi) { return (r & 3) + 8 * (r >> 2) + 4 * hi; }
#define MFMA32(a, b, c) __builtin_amdgcn_mfma_f32_32x32x16_bf16((a), (b), (c), 0, 0, 0)
DI bf16x8 pack_step(const f32x16& x, int s) {
    u32x4 p;
    p[0] = pk2(x[8 * s + 0], x[8 * s + 1]); p[1] = pk2(x[8 * s + 2], x[8 * s + 3]); p[2] = pk2(x[8 * s + 4], x[8 * s + 5]); p[3] = pk2(x[8 * s + 6], x[8 * s + 7]);
    return __builtin_bit_cast(bf16x8, p);
}
DI unsigned off_b(unsigned row, unsigned ch) { return 256u * row + 16u * (ch ^ (((row & 3) << 2) | ((row >> 2) & 3))); }
DI unsigned row_read_addr(unsigned lane, unsigned rt, unsigned s) { return off_b(32 * rt + (lane & 31), 2 * s + (lane >> 5)); }
DI unsigned tr_read_addr(unsigned lane, unsigned c, unsigned ks, unsigned t) {
    const unsigned h = lane >> 5, blk = (lane >> 4) & 1, q = (lane & 15) >> 2, p = lane & 3;
    return off_b(16 * ks + 8 * h + 4 * t + q, 4 * c + 2 * blk + (p >> 1)) + 8 * (p & 1);
}
DI unsigned tr_base(unsigned lane, unsigned t) { const unsigned h = lane >> 5, blk = (lane >> 4) & 1, q = (lane & 15) >> 2, p = lane & 3, cl = 2 * blk + (p >> 1);
    return 256u * (8 * h + 4 * t + q) + 16u * (cl ^ (2 * h + t)) + 8u * (p & 1); }
#define OPAQUE(x) asm volatile("" : "+v"(x))
#define OPAQUE(x) asm volatile("" : "+v"(x))
typedef short v4i16_t __attribute__((ext_vector_type(4)));
DI s16x4 tr_read(const LAS unsigned char* p) { return __builtin_bit_cast(s16x4, __builtin_amdgcn_ds_read_tr16_b64_v4i16((LAS v4i16_t*)p)); }
DI bf16x8 cat8(s16x4 lo, s16x4 hi) { return __builtin_shufflevector(lo, hi, 0, 1, 2, 3, 4, 5, 6, 7); }
namespace pg8 {
#define PG8_LAS __attribute__((address_space(3)))
typedef unsigned short bf16_t;
typedef short bf16x8 __attribute__((ext_vector_type(8)));
typedef float f32x4 __attribute__((ext_vector_type(4)));
typedef unsigned u32x4 __attribute__((ext_vector_type(4)));
constexpr int BM = 256, BK = 64, HALF = 128, HTB = HALF * BK * 2  , STAGE_BYTES = 8 * HTB, NXCD = 8, WGM = 8;

__host__ __device__ __forceinline__ int lds_byte(int r, int c) { const int st = (r >> 4) * 2 + (c >> 5), rr = r & 15, cc = c & 31, ob = rr * 64 + cc * 2; return st * 1024 + (ob ^ (((ob >> 9) & 1) << 5)); }
__host__ __device__ __forceinline__ void stage_rc(int b, int& R, int& C) { const int st = b / 1024, sb = b % 1024, swz = sb ^ (((sb >> 9) & 1) << 5); R = (st >> 1) * 16 + swz / 64; C = (st & 1) * 32 + (swz % 64) / 2; }
__host__ __device__ __forceinline__ int perm32(int rho) { const int n = rho >> 4, i = rho & 15; return 8 * (i >> 2) + 4 * n + (i & 3); }

struct Unit { int pm, pn, ph; };
struct Gemm { const bf16_t* A; const bf16_t* Bt; int M, N, K, lda, ldb; long jA, jB; };

struct StaticOrder {
    int nM, nN, nwg, G, c;
    __host__ __device__ void init(int M, int N, int G_, int c_) { nM = M / BM; nN = N / BM; nwg = nM * nN; G = G_; c = c_; }
    __host__ __device__ bool next(int i, Unit& u) const {
        const long L = (long)i * G + c; if (L >= nwg) return false;
        int wgid = (int)L; { const int q = nwg / NXCD, r = nwg % NXCD, xcd = wgid % NXCD, off = wgid / NXCD; wgid = (xcd < r ? xcd * (q + 1) : r * (q + 1) + (xcd - r) * q) + off; }
        const int nig = WGM * nN, gid = wgid / nig, fm = gid * WGM, gsz = (nM - fm) < WGM ? (nM - fm) : WGM;
        u.pm = fm + ((wgid % nig) % gsz); u.pn = (wgid % nig) / gsz; u.ph = 0; return true;
    }
    __device__ __forceinline__ void a_ready(const Unit&) const {}
    __device__ __forceinline__ void done(const Unit&) const {}
};
struct RowsOrder {
    int nM, nN, G, c;
    __host__ __device__ void init(int M, int N, int G_, int c_) { nM = M / BM; nN = N / BM; G = G_; c = c_; }
    __host__ __device__ bool next(int i, Unit& u) const { const int pm = c + (i / nN) * G; if (pm >= nM) return false; u.pm = pm; u.pn = i % nN; u.ph = 0; return true; }
    __device__ __forceinline__ void a_ready(const Unit&) const {}
    __device__ __forceinline__ void done(const Unit&) const {}
};
struct RowsOrder2 {
    RowsOrder base;
    __host__ __device__ void init(int M, int N, int G_, int c_) { base.init(M, N, G_, c_); }
    __host__ __device__ bool next(int i, Unit& u) const { if (!base.next(i >> 1, u)) return false; u.ph = i & 1; return true; }
    __device__ __forceinline__ void a_ready(const Unit&) const {}
    __device__ __forceinline__ void done(const Unit&) const {}
};
struct StaticOrder2 {
    StaticOrder base;
    __host__ __device__ void init(int M, int N, int G_, int c_) { base.init(M, N, G_, c_); }
    __host__ __device__ bool next(int i, Unit& u) const { if (!base.next(i >> 1, u)) return false; u.ph = i & 1; return true; }
    __device__ __forceinline__ void a_ready(const Unit&) const {}
    __device__ __forceinline__ void done(const Unit&) const {}
};
template <class Epi, class Sched, bool ALIGN_EPI = false, bool SP2 = false>
__device__ __forceinline__ void gemm_phase(PG8_LAS unsigned char* lds, const Gemm g, const Sched& S, const Epi& E) {
    const int tid = threadIdx.x, wid = __builtin_amdgcn_readfirstlane(tid >> 6), lane = tid & 63, wr = wid >> 2, wc = wid & 3, fr = lane & 15, fq = lane >> 4;
    const int K = g.K, nt = K / BK;
    unsigned voffA[2], voffB[2];
#pragma unroll
    for (int i = 0; i < 2; ++i) { int R, C; stage_rc(tid * 16 + i * 8192, R, C); const int Rb = Epi::PERM ? ((R & ~31) + perm32(R & 31)) : R;
        voffA[i] = (unsigned)(R * g.lda + C) * 2u; voffB[i] = (unsigned)(Rb * g.ldb + C) * 2u; }
    const size_t kstep = (size_t)(BK * 2);
    const size_t hstepA = (size_t)HALF * g.lda * 2, hstepB = (size_t)HALF * g.ldb * 2;
    const size_t tstepA = 2 * hstepA, tstepB = 2 * hstepB;
    const unsigned ldsw = (unsigned)wid * 1024u;
    const int aoff = lds_byte(wr * 64 + fr, fq * 8), boff = lds_byte(wc * 32 + fr, fq * 8);
#define PG8_SA(b, h) (((b) * 2 + (h)) * HTB)
#define PG8_SB(b, h) ((4 + (b) * 2 + (h)) * HTB)
#define PG8_STAGE(bufoff, gbase, voff) do { _Pragma("unroll") for (int _i = 0; _i < 2; ++_i) \
        __builtin_amdgcn_global_load_lds((const unsigned*)((const char*)(gbase) + (voff)[_i]), (PG8_LAS unsigned*)(lds + (bufoff) + ldsw + _i * 8192), 16, 0, 0); } while (0)
#define PG8_LDA(dst, b, h) do { _Pragma("unroll") for (int m = 0; m < 4; ++m) _Pragma("unroll") for (int k = 0; k < 2; ++k) dst[m][k] = *(const PG8_LAS bf16x8*)(lds + PG8_SA(b, h) + aoff + m * 2048 + k * 1024); } while (0)
#define PG8_LDB(dst, b, h) do { _Pragma("unroll") for (int n = 0; n < 2; ++n) _Pragma("unroll") for (int k = 0; k < 2; ++k) dst[n][k] = *(const PG8_LAS bf16x8*)(lds + PG8_SB(b, h) + boff + n * 2048 + k * 1024); } while (0)
#define PG8_MMA(ai, bj, At, Bt) do { __builtin_amdgcn_s_setprio(1); _Pragma("unroll") for (int m = 0; m < 4; ++m) _Pragma("unroll") for (int n = 0; n < 2; ++n) _Pragma("unroll") for (int k = 0; k < 2; ++k) \
        acc[ai][bj][m][n] = __builtin_amdgcn_mfma_f32_16x16x32_bf16(Bt[n][k], At[m][k], acc[ai][bj][m][n], 0, 0, 0); __builtin_amdgcn_s_setprio(0); } while (0)
#define PG8_WAIT_V(n) asm volatile("s_waitcnt vmcnt(" #n ")" ::: "memory")
#define PG8_WAIT_L(n) asm volatile("s_waitcnt lgkmcnt(" #n ")" ::: "memory")
#define PG8_BAR __builtin_amdgcn_s_barrier()
#define PG8_SCHED __builtin_amdgcn_sched_barrier(0)
    Unit cur, nxt; int ui = 0;
    if (!S.next(0, cur)) return;
    f32x4 acc[2][2][4][2];
#pragma unroll
    for (int a = 0; a < 2; ++a)
#pragma unroll
        for (int b = 0; b < 2; ++b)
#pragma unroll
            for (int m = 0; m < 4; ++m)
#pragma unroll
                for (int n = 0; n < 2; ++n) acc[a][b][m][n] = (f32x4){0.f, 0.f, 0.f, 0.f};
    bf16x8 At[4][2], B0[2][2], B1[2][2];
    const char* cA = (const char*)g.A + (size_t)cur.pm * tstepA + cur.ph * g.jA; const char* cB = (const char*)g.Bt + (size_t)cur.pn * tstepB + cur.ph * g.jB;
    S.a_ready(cur);
    if constexpr (SP2) {
        PG8_STAGE(PG8_SB(0, 0), cB, voffB); PG8_STAGE(PG8_SB(0, 1), cB + hstepB, voffB); PG8_STAGE(PG8_SA(0, 0), cA, voffA); PG8_STAGE(PG8_SA(0, 1), cA + hstepA, voffA);
        if (wr == 1) PG8_BAR;
        PG8_WAIT_V(2); PG8_BAR;
        PG8_STAGE(PG8_SB(1, 0), cB + kstep, voffB); PG8_STAGE(PG8_SA(1, 0), cA + kstep, voffA); PG8_STAGE(PG8_SB(1, 1), cB + hstepB + kstep, voffB);
        PG8_WAIT_V(6); PG8_BAR;
    } else {
        PG8_STAGE(PG8_SB(0, 0), cB, voffB); PG8_STAGE(PG8_SA(0, 0), cA, voffA); PG8_STAGE(PG8_SB(0, 1), cB + hstepB, voffB); PG8_STAGE(PG8_SA(0, 1), cA + hstepA, voffA);
        if (wr == 1) PG8_BAR;
        PG8_WAIT_V(4); PG8_BAR;
        PG8_STAGE(PG8_SB(1, 0), cB + kstep, voffB); PG8_STAGE(PG8_SA(1, 0), cA + kstep, voffA); PG8_STAGE(PG8_SB(1, 1), cB + hstepB + kstep, voffB);
        PG8_WAIT_V(6); PG8_BAR;
    }
    for (;;) {
        const bool has_next = S.next(ui + 1, nxt);
        const char* nA = has_next ? (const char*)g.A + (size_t)nxt.pm * tstepA + nxt.ph * g.jA : cA; const char* nB = has_next ? (const char*)g.Bt + (size_t)nxt.pn * tstepB + nxt.ph * g.jB : cB;
        for (int t = 0; t < nt; t += 2) {
            const bool last = (t == nt - 2);
            const char* a1 = cA + (size_t)(t + 1) * kstep;
            const char* a2 = last ? nA : cA + (size_t)(t + 2) * kstep; const char* b2 = last ? nB : cB + (size_t)(t + 2) * kstep;
            const char* a3 = a2 + kstep; const char* b3 = b2 + kstep;
            if (last && has_next) S.a_ready(nxt);
            if constexpr (SP2) {
            PG8_LDB(B0, 0, 0); PG8_LDB(B1, 0, 1); PG8_SCHED; PG8_LDA(At, 0, 0); PG8_STAGE(PG8_SA(1, 1), a1 + hstepA, voffA);
            PG8_WAIT_V(8); PG8_WAIT_L(0); PG8_BAR; PG8_MMA(0, 0, At, B0); PG8_MMA(0, 1, At, B1); PG8_BAR; PG8_SCHED;
            PG8_LDA(At, 0, 1); PG8_STAGE(PG8_SB(0, 0), b2, voffB); PG8_STAGE(PG8_SB(0, 1), b2 + hstepB, voffB); PG8_STAGE(PG8_SA(0, 0), a2, voffA);
            PG8_WAIT_V(8); PG8_WAIT_L(0); PG8_BAR; PG8_MMA(1, 0, At, B0); PG8_MMA(1, 1, At, B1); PG8_BAR; PG8_SCHED;
            PG8_LDB(B0, 1, 0); PG8_LDB(B1, 1, 1); PG8_SCHED; PG8_LDA(At, 1, 0); PG8_STAGE(PG8_SA(0, 1), a2 + hstepA, voffA);
            PG8_WAIT_V(8); PG8_WAIT_L(0); PG8_BAR; PG8_MMA(0, 0, At, B0); PG8_MMA(0, 1, At, B1); PG8_BAR; PG8_SCHED;
            PG8_LDA(At, 1, 1); PG8_STAGE(PG8_SB(1, 0), b3, voffB); PG8_STAGE(PG8_SB(1, 1), b3 + hstepB, voffB); PG8_STAGE(PG8_SA(1, 0), a3, voffA);
            PG8_WAIT_V(8); PG8_WAIT_L(0); PG8_BAR; PG8_MMA(1, 0, At, B0); PG8_MMA(1, 1, At, B1); PG8_BAR; PG8_SCHED;
            } else {
            PG8_LDB(B0, 0, 0); PG8_SCHED; PG8_LDA(At, 0, 0); PG8_STAGE(PG8_SA(1, 1), a1 + hstepA, voffA);
            PG8_WAIT_L(8); PG8_BAR; PG8_WAIT_L(0); PG8_MMA(0, 0, At, B0); PG8_BAR; PG8_SCHED;
            PG8_LDB(B1, 0, 1); PG8_STAGE(PG8_SB(0, 0), b2, voffB);
            PG8_BAR; PG8_WAIT_L(0); PG8_MMA(0, 1, At, B1); PG8_BAR;
            PG8_LDA(At, 0, 1); PG8_STAGE(PG8_SA(0, 0), a2, voffA);
            PG8_BAR; PG8_WAIT_L(0); PG8_MMA(1, 0, At, B0); PG8_BAR; PG8_SCHED;
            PG8_STAGE(PG8_SB(0, 1), b2 + hstepB, voffB);
            PG8_WAIT_V(6); PG8_BAR; PG8_MMA(1, 1, At, B1); PG8_BAR;
            PG8_LDB(B0, 1, 0); PG8_SCHED; PG8_LDA(At, 1, 0); PG8_STAGE(PG8_SA(0, 1), a2 + hstepA, voffA);
            PG8_WAIT_L(8); PG8_BAR; PG8_WAIT_L(0); PG8_MMA(0, 0, At, B0); PG8_BAR; PG8_SCHED;
            PG8_LDB(B1, 1, 1); PG8_STAGE(PG8_SB(1, 0), b3, voffB);
            PG8_BAR; PG8_WAIT_L(0); PG8_MMA(0, 1, At, B1); PG8_BAR;
            PG8_LDA(At, 1, 1); PG8_STAGE(PG8_SA(1, 0), a3, voffA);
            PG8_BAR; PG8_WAIT_L(0); PG8_MMA(1, 0, At, B0); PG8_BAR; PG8_SCHED;
            PG8_STAGE(PG8_SB(1, 1), b3 + hstepB, voffB);
            PG8_WAIT_V(6); PG8_BAR; PG8_MMA(1, 1, At, B1); PG8_BAR;
            }
        }
        if constexpr (ALIGN_EPI) { if (wr == 0) PG8_BAR; }
        bool keep_acc = false;
        if constexpr (Epi::HAS_MID) { keep_acc = (cur.ph == 0) && has_next; }
        if constexpr (!Epi::AFTER_DRAIN) { if constexpr (Epi::HAS_MID) { if (keep_acc) E.mid(acc, cur, wr, wc, fr, fq); else E(acc, cur, wr, wc, fr, fq); } else E(acc, cur, wr, wc, fr, fq); S.done(cur); }
        if (!has_next) break;
        if (!keep_acc)
#pragma unroll
        for (int a = 0; a < 2; ++a)
#pragma unroll
            for (int b = 0; b < 2; ++b)
#pragma unroll
                for (int m = 0; m < 4; ++m)
#pragma unroll
                    for (int n = 0; n < 2; ++n) acc[a][b][m][n] = (f32x4){0.f, 0.f, 0.f, 0.f};
        cur = nxt; cA = nA; cB = nB; ++ui;
        if constexpr (ALIGN_EPI) { if (wr == 1) PG8_BAR; }
    }
    PG8_WAIT_V(0);
    if constexpr (!ALIGN_EPI) { if (wr == 0) PG8_BAR; }
    PG8_BAR;
    if constexpr (Epi::AFTER_DRAIN) { E.fused(acc, cur, wr, wc, fr, fq, lds, wid, lane); S.done(cur); }
#undef PG8_SA
#undef PG8_SB
#undef PG8_STAGE
#undef PG8_LDA
#undef PG8_LDB
#undef PG8_MMA
#undef PG8_WAIT_V
#undef PG8_WAIT_L
#undef PG8_BAR
#undef PG8_SCHED
}
}
namespace pg8 {
struct EpiZ {
    static constexpr bool PERM = true, AFTER_DRAIN = false, HAS_MID = false;
    bf16_t* Z; bf16_t* G;
    __device__ __forceinline__ void operator()(const f32x4 (&acc)[2][2][4][2], const Unit& u, int wr, int wc, int fr, int fq) const {
        const int row0 = u.pm * BM + wr * 64 + fr, colt = u.pn * BM; const bool gate = colt >= NZ;
        bf16_t* base = gate ? G : Z; const int ld = gate ? NGATE : NZ; const int col0 = (gate ? colt - NZ : colt) + wc * 32 + 8 * fq;
#pragma unroll
        for (int ai = 0; ai < 2; ++ai)
#pragma unroll
            for (int m = 0; m < 4; ++m) { bf16_t* rowp = base + (size_t)(row0 + ai * HALF + m * 16) * ld + col0;
#pragma unroll
                for (int bj = 0; bj < 2; ++bj) { f32x4 v0 = acc[ai][bj][m][0], v1 = acc[ai][bj][m][1];
                    if (gate) {
#pragma unroll
                        for (int e = 0; e < 4; ++e) { v0[e] = sigmoidf_(v0[e]); v1[e] = sigmoidf_(v1[e]); } }
                    ::u32x4 w; w.x = pk2(v0[0], v0[1]); w.y = pk2(v0[2], v0[3]); w.z = pk2(v1[0], v1[1]); w.w = pk2(v1[2], v1[3]);
                    *(::u32x4*)(rowp + bj * HALF) = w; } }
    }
};
template <bool FIRST> struct EpiGate {
    static constexpr bool PERM = true, AFTER_DRAIN = false, HAS_MID = false;
    const bf16_t* G; bf16_t* Y;
    __device__ __forceinline__ void operator()(const f32x4 (&acc)[2][2][4][2], const Unit& u, int wr, int wc, int fr, int fq) const {
        const int row0 = u.pm * BM + wr * 64 + fr, col0 = u.pn * BM + wc * 32 + 8 * fq;
#pragma unroll
        for (int ai = 0; ai < 2; ++ai)
#pragma unroll
            for (int m = 0; m < 4; ++m) { const size_t row = (size_t)(row0 + ai * HALF + m * 16);
#pragma unroll
                for (int bj = 0; bj < 2; ++bj) { const f32x4 v0 = acc[ai][bj][m][0], v1 = acc[ai][bj][m][1];
                    const ::u32x4 g = *(const ::u32x4*)(G + row * NGATE + col0 + bj * HALF);
                    float o[8] = { bf_lo(g.x) * v0[0], bf_hi(g.x) * v0[1], bf_lo(g.y) * v0[2], bf_hi(g.y) * v0[3], bf_lo(g.z) * v1[0], bf_hi(g.z) * v1[1], bf_lo(g.w) * v1[2], bf_hi(g.w) * v1[3] };
                    bf16_t* yp = Y + row * DM + col0 + bj * HALF;
                    if (!FIRST) { const ::u32x4 y = *(const ::u32x4*)yp;
                        o[0] += bf_lo(y.x); o[1] += bf_hi(y.x); o[2] += bf_lo(y.y); o[3] += bf_hi(y.y); o[4] += bf_lo(y.z); o[5] += bf_hi(y.z); o[6] += bf_lo(y.w); o[7] += bf_hi(y.w); }
                    ::u32x4 w; w.x = pk2(o[0], o[1]); w.y = pk2(o[2], o[3]); w.z = pk2(o[4], o[5]); w.w = pk2(o[6], o[7]);
                    *(::u32x4*)yp = w; } }
    }
};
struct EpiR {
    static constexpr bool PERM = true, AFTER_DRAIN = false, HAS_MID = false;
    const float* X; const float* MOD; bf16_t* R;
    __device__ __forceinline__ void operator()(const f32x4 (&acc)[2][2][4][2], const Unit& u, int wr, int wc, int fr, int fq) const {
        const int row0 = u.pm * BM + wr * 64 + fr, col0 = u.pn * BM + wc * 32 + 8 * fq;
        const float* gt = MOD + (size_t)((u.pm * BM) / SEQ) * MODW + 2 * DM;
        f32x4 g[2][2];
#pragma unroll
        for (int bj = 0; bj < 2; ++bj) { g[bj][0] = *(const f32x4*)(gt + col0 + bj * HALF); g[bj][1] = *(const f32x4*)(gt + col0 + bj * HALF + 4); }
#pragma unroll
        for (int ai = 0; ai < 2; ++ai) {
            f32x4 xv[4][2][2];
#pragma unroll
            for (int m = 0; m < 4; ++m) { const size_t off = (size_t)(row0 + ai * HALF + m * 16) * DM + col0;
#pragma unroll
                for (int bj = 0; bj < 2; ++bj) { xv[m][bj][0] = *(const f32x4*)(X + off + bj * HALF); xv[m][bj][1] = *(const f32x4*)(X + off + bj * HALF + 4); } }
            __builtin_amdgcn_sched_barrier(0);
#pragma unroll
            for (int m = 0; m < 4; ++m) { const size_t off = (size_t)(row0 + ai * HALF + m * 16) * DM + col0;
#pragma unroll
                for (int bj = 0; bj < 2; ++bj) {
                    const f32x4 r0 = xv[m][bj][0] * ALPHA_RES + g[bj][0] * acc[ai][bj][m][0], r1 = xv[m][bj][1] * ALPHA_RES + g[bj][1] * acc[ai][bj][m][1];
                    ::u32x4 w; w.x = pk2(r0[0], r0[1]); w.y = pk2(r0[2], r0[3]); w.z = pk2(r1[0], r1[1]); w.w = pk2(r1[2], r1[3]);
                    *(::u32x4*)(R + off + bj * HALF) = w; } }
            __builtin_amdgcn_sched_barrier(0);
        }
    }
};
struct EpiStore {
    static constexpr bool PERM = true, AFTER_DRAIN = false, HAS_MID = false;
    bf16_t* O;
    __device__ __forceinline__ void operator()(const f32x4 (&acc)[2][2][4][2], const Unit& u, int wr, int wc, int fr, int fq) const {
        const int row0 = u.pm * BM + wr * 64 + fr, col0 = u.pn * BM + wc * 32 + 8 * fq;
#pragma unroll
        for (int ai = 0; ai < 2; ++ai)
#pragma unroll
            for (int m = 0; m < 4; ++m) { bf16_t* rowp = O + (size_t)(row0 + ai * HALF + m * 16) * DM + col0;
#pragma unroll
                for (int bj = 0; bj < 2; ++bj) { const f32x4 v0 = acc[ai][bj][m][0], v1 = acc[ai][bj][m][1];
                    ::u32x4 w; w.x = pk2(v0[0], v0[1]); w.y = pk2(v0[2], v0[3]); w.z = pk2(v1[0], v1[1]); w.w = pk2(v1[2], v1[3]);
                    *(::u32x4*)(rowp + bj * HALF) = w; } }
    }
};
struct EpiGate2 {
    static constexpr bool PERM = true, AFTER_DRAIN = false, HAS_MID = true;
    const bf16_t* G; bf16_t* Y;
    __device__ __forceinline__ void mid(f32x4 (&acc)[2][2][4][2], const Unit& u, int wr, int wc, int fr, int fq) const {
        const int row0 = u.pm * BM + wr * 64 + fr, col0 = u.pn * BM + wc * 32 + 8 * fq;
#pragma unroll
        for (int ai = 0; ai < 2; ++ai)
#pragma unroll
            for (int m = 0; m < 4; ++m) { const size_t row = (size_t)(row0 + ai * HALF + m * 16);
#pragma unroll
                for (int bj = 0; bj < 2; ++bj) {
                    const ::u32x4 ga = *(const ::u32x4*)(G + row * NGATE + col0 + bj * HALF), gm = *(const ::u32x4*)(G + row * NGATE + DM + col0 + bj * HALF);
                    f32x4& v0 = acc[ai][bj][m][0]; f32x4& v1 = acc[ai][bj][m][1];
#define PG8_RAT(a, b) ((a) * __builtin_amdgcn_rcpf(b))
                    v0[0] *= PG8_RAT(bf_lo(ga.x), bf_lo(gm.x)); v0[1] *= PG8_RAT(bf_hi(ga.x), bf_hi(gm.x)); v0[2] *= PG8_RAT(bf_lo(ga.y), bf_lo(gm.y)); v0[3] *= PG8_RAT(bf_hi(ga.y), bf_hi(gm.y));
                    v1[0] *= PG8_RAT(bf_lo(ga.z), bf_lo(gm.z)); v1[1] *= PG8_RAT(bf_hi(ga.z), bf_hi(gm.z)); v1[2] *= PG8_RAT(bf_lo(ga.w), bf_lo(gm.w)); v1[3] *= PG8_RAT(bf_hi(ga.w), bf_hi(gm.w)); }
#undef PG8_RAT
                if (m == 3) __builtin_amdgcn_sched_barrier(0); }
    }
    __device__ __forceinline__ void operator()(const f32x4 (&acc)[2][2][4][2], const Unit& u, int wr, int wc, int fr, int fq) const {
        const int row0 = u.pm * BM + wr * 64 + fr, col0 = u.pn * BM + wc * 32 + 8 * fq;
        ::u32x4 gg[2][4][2];
#pragma unroll
        for (int ai = 0; ai < 2; ++ai)
#pragma unroll
            for (int m = 0; m < 4; ++m) { const size_t row = (size_t)(row0 + ai * HALF + m * 16);
#pragma unroll
                for (int bj = 0; bj < 2; ++bj) gg[ai][m][bj] = *(const ::u32x4*)(G + row * NGATE + DM + col0 + bj * HALF); }
        __builtin_amdgcn_sched_barrier(0);
#pragma unroll
        for (int ai = 0; ai < 2; ++ai)
#pragma unroll
            for (int m = 0; m < 4; ++m) { const size_t row = (size_t)(row0 + ai * HALF + m * 16);
#pragma unroll
                for (int bj = 0; bj < 2; ++bj) { const f32x4 v0 = acc[ai][bj][m][0], v1 = acc[ai][bj][m][1]; const ::u32x4 g = gg[ai][m][bj];
                    ::u32x4 w; w.x = pk2(bf_lo(g.x) * v0[0], bf_hi(g.x) * v0[1]); w.y = pk2(bf_lo(g.y) * v0[2], bf_hi(g.y) * v0[3]); w.z = pk2(bf_lo(g.z) * v1[0], bf_hi(g.z) * v1[1]); w.w = pk2(bf_lo(g.w) * v1[2], bf_hi(g.w) * v1[3]);
                    *(::u32x4*)(Y + row * DM + col0 + bj * HALF) = w; } }
    }
};
}
namespace datt {
constexpr int KROW = 144;
constexpr int KBUF = 64 * KROW, VBUF = 64 * 256, LDS_K = 0, LDS_V = 2 * KBUF, LDS_ST = LDS_V + 2 * VBUF, STROW = 272, ST_WAVE = 32 * STROW, LDS_BYTES = LDS_ST + 8 * ST_WAVE;
DI unsigned vrow(unsigned key) { return (key & ~12u) | ((key & 4u) << 1) | ((key & 8u) >> 1); }

template <bool DRY> DI void attn_unit(LAS unsigned char* lds, bf16_t* Z, const float* lam, const float* subln_g, int b, int h, int qb) {
    int tid_o = threadIdx.x; OPAQUE(tid_o); const int tid = tid_o, lane = tid & 63, r32 = lane & 31, hi = lane >> 5; const int wid = __builtin_amdgcn_readfirstlane(tid >> 6);
    const size_t rowbase = (size_t)b * SEQ;
    const int q_first = qb * 256 + wid * 32, q_me = q_first + r32;
    float lam_val;
    { const float p1 = lam[lane] * lam[64 + lane], p2 = lam[128 + lane] * lam[192 + lane]; lam_val = __expf(wave_sum(p1)) - __expf(wave_sum(p2)) + LAMBDA_INIT; }
    const int NT = 4 * (qb + 1);
    const int k_key = tid >> 3, k_ch = tid & 7;
    const int v_key0 = tid >> 4, v_ch = tid & 15;
    const unsigned tb0 = LDS_V + tr_base(lane, 0), tb1 = LDS_V + tr_base(lane, 1); unsigned q64 = ((lane & 15) >> 2) << 6;
    const unsigned kb = LDS_K + r32 * KROW + hi * 16;
    u32x4 pk_, pv0, pv1;
#pragma unroll
    for (int m = 0; m < 2; ++m) {
        bf16x8 qf[4];
        { const bf16_t* qp = Z + (rowbase + q_me) * NZ + ZC_Q + h * 128 + m * 64 + 8 * hi;
#pragma unroll
          for (int s = 0; s < 4; ++s) qf[s] = *(const bf16x8*)(qp + 16 * s); }
        const bf16_t* ksrc = Z + (rowbase + k_key) * NZ + ZC_K + h * 128 + m * 64 + k_ch * 8;
        const bf16_t* vsrc = Z + (rowbase + v_key0) * NZ + ZC_V + h * 128 + v_ch * 8;
        f32x16 O[4];
#pragma unroll
        for (int c = 0; c < 4; ++c)
#pragma unroll
            for (int r = 0; r < 16; ++r) O[c][r] = 0.f;
        float mrun = -1e30f, lrun = 0.f;
        if (m == 0) { pk_ = *(const u32x4*)ksrc; pv0 = *(const u32x4*)vsrc; pv1 = *(const u32x4*)(vsrc + (size_t)32 * NZ); }
        __syncthreads();
        *(LAS u32x4*)(lds + LDS_K + k_key * KROW + k_ch * 16) = pk_;
        *(LAS u32x4*)(lds + LDS_V + off_b(vrow(v_key0), v_ch)) = pv0;
        *(LAS u32x4*)(lds + LDS_V + off_b(vrow(v_key0 + 32), v_ch)) = pv1;
        { const size_t o = (size_t)64 * NZ; pk_ = *(const u32x4*)(ksrc + o); pv0 = *(const u32x4*)(vsrc + o); pv1 = *(const u32x4*)(vsrc + o + (size_t)32 * NZ); }
        __syncthreads();
        for (int kt = 0; kt < NT; ++kt) {
            const int cur = kt & 1, nxt = cur ^ 1;
            if (kt * 64 <= q_first + 31) {
            f32x16 p[2];
            bf16x8 ka[8];
#pragma unroll
            for (int i = 0; i < 8; ++i) ka[i] = *(const LAS bf16x8*)(lds + kb + cur * KBUF + 32 * (i >> 2) * KROW + (i & 3) * 32);
            __builtin_amdgcn_sched_barrier(0);
#pragma unroll
            for (int hf = 0; hf < 2; ++hf) {
#pragma unroll
                for (int r = 0; r < 16; ++r) p[hf][r] = 0.f;
#pragma unroll
                for (int s = 0; s < 4; ++s) p[hf] = MFMA32(ka[4 * hf + s], qf[s], p[hf]);
            }
            OPAQUE(q64);
            const unsigned vb0 = tb0 + cur * VBUF, vb1 = tb1 + cur * VBUF;
            s16x4 vlo[2][4], vhi[2][4];
#pragma unroll
            for (int ks = 0; ks < 4; ++ks) { vlo[0][ks] = tr_read(lds + vb0 + q64 + 4096 * ks); vhi[0][ks] = tr_read(lds + vb1 + q64 + 4096 * ks); }
            __builtin_amdgcn_sched_barrier(0);
            if (kt * 64 + 63 > q_first) {
#pragma unroll
                for (int hf = 0; hf < 2; ++hf)
#pragma unroll
                    for (int r = 0; r < 16; ++r) { const int key = kt * 64 + 32 * hf + crow(r, hi); if (key > q_me) p[hf][r] = -1e30f; }
            }
            float mx = p[0][0];
#pragma unroll
            for (int r = 1; r < 16; ++r) mx = fmaxf(mx, p[0][r]);
#pragma unroll
            for (int r = 0; r < 16; ++r) mx = fmaxf(mx, p[1][r]);
            mx = max32x(mx);
            if (__builtin_amdgcn_ballot_w64(mx > mrun + 8.0f) != 0) {
                const float mnew = fmaxf(mrun, mx), alpha = __builtin_amdgcn_exp2f(mrun - mnew); mrun = mnew; lrun *= alpha;
#pragma unroll
                for (int c = 0; c < 4; ++c)
#pragma unroll
                    for (int r = 0; r < 16; ++r) O[c][r] *= alpha;
            }
            float ls = 0.f;
#pragma unroll
            for (int hf = 0; hf < 2; ++hf)
#pragma unroll
                for (int r = 0; r < 16; ++r) { const float e = __builtin_amdgcn_exp2f(p[hf][r] - mrun); p[hf][r] = e; ls += e; }
            lrun += ls;
            bf16x8 pf[4];
            pf[0] = pack_step(p[0], 0); pf[1] = pack_step(p[0], 1); pf[2] = pack_step(p[1], 0); pf[3] = pack_step(p[1], 1);
#pragma unroll
            for (int c = 0; c < 4; ++c) {
                if (c < 3) { const unsigned cx = (64u * (c + 1)) ^ q64;
#pragma unroll
                    for (int ks = 0; ks < 4; ++ks) { vlo[(c + 1) & 1][ks] = tr_read(lds + vb0 + cx + 4096 * ks); vhi[(c + 1) & 1][ks] = tr_read(lds + vb1 + cx + 4096 * ks); } }
                __builtin_amdgcn_sched_barrier(0);
#pragma unroll
                for (int ks = 0; ks < 4; ++ks) O[c] = MFMA32(cat8(vlo[c & 1][ks], vhi[c & 1][ks]), pf[ks], O[c]);
                __builtin_amdgcn_sched_barrier(0);
            }
            }
            if (kt + 1 < NT) {
                *(LAS u32x4*)(lds + LDS_K + nxt * KBUF + k_key * KROW + k_ch * 16) = pk_;
                *(LAS u32x4*)(lds + LDS_V + nxt * VBUF + off_b(vrow(v_key0), v_ch)) = pv0;
                *(LAS u32x4*)(lds + LDS_V + nxt * VBUF + off_b(vrow(v_key0 + 32), v_ch)) = pv1;
                if (kt + 2 < NT) { const size_t o = (size_t)(kt + 2) * 64 * NZ; pk_ = *(const u32x4*)(ksrc + o); pv0 = *(const u32x4*)(vsrc + o); pv1 = *(const u32x4*)(vsrc + o + (size_t)32 * NZ); }
                else if (m == 0) { pk_ = *(const u32x4*)(ksrc + 64); pv0 = *(const u32x4*)vsrc; pv1 = *(const u32x4*)(vsrc + (size_t)32 * NZ); }
            }
            __syncthreads();
        }
        const float ltot = sum32x(lrun), inv = 1.0f / ltot;
        if (m == 0) {
            LAS unsigned char* stg = lds + LDS_ST + wid * ST_WAVE;
#pragma unroll
            for (int c = 0; c < 4; ++c)
#pragma unroll
                for (int g4 = 0; g4 < 4; ++g4) { const int dv0 = 32 * c + 8 * g4 + 4 * hi;
                    u32x2 w; w.x = pk2(O[c][4 * g4] * inv, O[c][4 * g4 + 1] * inv); w.y = pk2(O[c][4 * g4 + 2] * inv, O[c][4 * g4 + 3] * inv);
                    *(LAS u32x2*)(stg + r32 * STROW + dv0 * 2) = w; }
        } else {
            const float li = lam_val * inv;
            float ss = 0.f;
            LAS unsigned char* stg = lds + LDS_ST + wid * ST_WAVE;
#pragma unroll
            for (int c = 0; c < 4; ++c)
#pragma unroll
                for (int g4 = 0; g4 < 4; ++g4) { const int dv0 = 32 * c + 8 * g4 + 4 * hi; const u32x2 k2 = *(const LAS u32x2*)(stg + r32 * STROW + dv0 * 2);
                    O[c][4 * g4] = bf_lo(k2.x) - li * O[c][4 * g4]; O[c][4 * g4 + 1] = bf_hi(k2.x) - li * O[c][4 * g4 + 1]; O[c][4 * g4 + 2] = bf_lo(k2.y) - li * O[c][4 * g4 + 2]; O[c][4 * g4 + 3] = bf_hi(k2.y) - li * O[c][4 * g4 + 3];
                    ss += (O[c][4 * g4] * O[c][4 * g4] + O[c][4 * g4 + 1] * O[c][4 * g4 + 1]) + (O[c][4 * g4 + 2] * O[c][4 * g4 + 2] + O[c][4 * g4 + 3] * O[c][4 * g4 + 3]); }
            ss = sum32x(ss);
            const float rstd = rsqrtf(ss * (1.0f / 128.0f) + LN_EPS) * (1.0f - LAMBDA_INIT);
#pragma unroll
            for (int c = 0; c < 4; ++c)
#pragma unroll
                for (int g4 = 0; g4 < 4; ++g4) { const int dv0 = 32 * c + 8 * g4 + 4 * hi; const f32x4 gg = *(const f32x4*)(subln_g + dv0);
                    u32x2 w; w.x = pk2(O[c][4 * g4] * rstd * gg[0], O[c][4 * g4 + 1] * rstd * gg[1]); w.y = pk2(O[c][4 * g4 + 2] * rstd * gg[2], O[c][4 * g4 + 3] * rstd * gg[3]);
                    *(LAS u32x2*)(stg + r32 * STROW + dv0 * 2) = w; }
        }
    }
    LAS unsigned char* stg = lds + LDS_ST + wid * ST_WAVE;
    asm volatile("s_waitcnt lgkmcnt(0)" ::: "memory");
    bf16_t* obase = Z + (rowbase + q_first) * NZ + ZC_Q + h * 128;
#pragma unroll
    for (int i = 0; i < 8; ++i) { const int idx = lane + 64 * i, row = idx >> 4, ch = idx & 15;
        const u32x4 v = *(const LAS u32x4*)(stg + row * STROW + ch * 16); if (!DRY || v.x == 0x12345678u) *(u32x4*)(obase + (size_t)row * NZ + ch * 8) = v; }
}
}
namespace mls {
constexpr int QI = 0, KI = 32768, VI = 65536, SC = 131072;
constexpr int F_IG = 0, F_LF = 128, F_A = 256, F_M = 384, F_INTER = 512, F_EMT = 640, F_W = 768, F_DEN = 896, F_N = 1024, F_MISC = 1152,
              F_NQ2P = 1280, F_NQ1P = 1792, F_NP = 2304, F_RSQ = 2816, F_END = 3840;
constexpr int LDS_BYTES = SC + F_END * 4;
static_assert(LDS_BYTES <= 147456, "mLSTM LDS");

template <int CTRL> DI float dpp_keep(float old, float v) { return __builtin_bit_cast(float, __builtin_amdgcn_update_dpp(__builtin_bit_cast(int, old), __builtin_bit_cast(int, v), CTRL, 0xF, 0xF, false)); }
DI float scan_add(float x, int lane) {
    x += dpp_keep<0x111>(0.f, x); x += dpp_keep<0x112>(0.f, x); x += dpp_keep<0x114>(0.f, x); x += dpp_keep<0x118>(0.f, x);
    const float t0 = rdlane(x, 15), t1 = rdlane(x, 31), t2 = rdlane(x, 47); const int r = lane >> 4;
    return x + ((r >= 1 ? t0 : 0.f) + (r >= 2 ? t1 : 0.f) + (r >= 3 ? t2 : 0.f));
}
DI float scan_max(float x, int lane) {
    const float ninf = -3.0e38f;
    x = fmaxf(x, dpp_keep<0x111>(ninf, x)); x = fmaxf(x, dpp_keep<0x112>(ninf, x)); x = fmaxf(x, dpp_keep<0x114>(ninf, x)); x = fmaxf(x, dpp_keep<0x118>(ninf, x));
    const float t0 = rdlane(x, 15), t1 = rdlane(x, 31), t2 = rdlane(x, 47); const int r = lane >> 4;
    return fmaxf(x, fmaxf(fmaxf(r >= 1 ? t0 : ninf, r >= 2 ? t1 : ninf), r >= 3 ? t2 : ninf));
}
DI float log_sigmoid(float x) { return fminf(x, 0.f) - __logf(1.0f + __expf(-fabsf(x))); }

template <bool DRY, int ABL = 0> DI void mlstm_unit(LAS unsigned char* lds, bf16_t* Z, const float* GIF, const float* conv_w, const float* conv_b, const float* norm_g, int b, int hd) {
    int tid_o = threadIdx.x; OPAQUE(tid_o); const int tid = tid_o, lane = tid & 63; const int wid = __builtin_amdgcn_readfirstlane(tid >> 6);
    LAS float* sc = (LAS float*)(lds + SC);
#define MLS_LV unsigned L_ = lane; OPAQUE(L_); const unsigned r32 = L_ & 31, hi = L_ >> 5, rowb = 256u * r32, f16 = (((r32 & 3) << 2) | ((r32 >> 2) & 3)) << 4, q64 = ((L_ & 15) >> 2) << 6; (void)rowb; (void)f16; (void)q64; (void)hi
    f32x16 CT[4];
#pragma unroll
    for (int i = 0; i < 4; ++i)
#pragma unroll
        for (int r = 0; r < 16; ++r) CT[i][r] = 0.f;
    float m_prev = 0.f;
    if (tid < 128) sc[F_N + tid] = 0.f;
    const int img = wid >> 2, vc = wid & 3;
    const int st_i = wid >> 1, st_j0 = 2 * (wid & 1);

    u32x4 rawn[11]; float gin = 0.f, gfn = 0.f;
#define MLS_PREFETCH(CC) do { int tp = tid; OPAQUE(tp); const int p_mat = tp >> 8, p_ch = tp & 15, p_rg = (tp >> 4) & 15; const size_t tn = (size_t)b * SEQ + (size_t)(CC) * 128; \
        const bf16_t* srcn = Z + (tn + p_rg * 8) * NZ + (p_mat ? ZC_MK : ZC_MQ) + hd * 128 + p_ch * 8; \
        _Pragma("unroll") for (int j = 0; j < 11; ++j) { const int lp = (CC) * 128 + p_rg * 8 - 3 + j; rawn[j] = (u32x4){0u, 0u, 0u, 0u}; if (lp >= 0) rawn[j] = *(const u32x4*)(srcn + (ptrdiff_t)(j - 3) * NZ); } \
        if (tp < 128) { const float* gg = GIF + (tn + tp) * 8; gin = gg[hd]; gfn = gg[4 + hd]; } } while (0)
    MLS_PREFETCH(0);
    for (int c = 0; c < 16; ++c) {
        const size_t t0 = (size_t)b * SEQ + (size_t)c * 128;
        __syncthreads();
        u32x4 vn[8];
        { int tq = tid; OPAQUE(tq);
#pragma unroll
          for (int i = 0; i < 8; ++i) { const int idx = tq + 512 * i, row = idx >> 5, ch32 = idx & 31; vn[i] = *(const u32x4*)(Z + (t0 + row) * NZ + ZC_MV + hd * 256 + ch32 * 8); } }
        {
            int tq = tid; OPAQUE(tq);
            const int c_mat = tq >> 8, c_ch = tq & 15, c_rg = (tq >> 4) & 15;
            const int chan0 = c_mat * 512 + hd * 128 + c_ch * 8;
            const float kscale = c_mat ? 0.08838834764831845f : 1.0f;
            float cw[4][8], cb[8];
            { const GAS float* cwp = (const GAS float*)(conv_w + chan0); const GAS float* cbp = (const GAS float*)(conv_b + chan0); asm volatile("" : "+v"(cwp), "+v"(cbp));
#pragma unroll
              for (int j = 0; j < 4; ++j) { const f32x4 a = *(const GAS f32x4*)(cwp + j * 1024), c4 = *(const GAS f32x4*)(cwp + j * 1024 + 4);
                cw[j][0] = a[0]; cw[j][1] = a[1]; cw[j][2] = a[2]; cw[j][3] = a[3]; cw[j][4] = c4[0]; cw[j][5] = c4[1]; cw[j][6] = c4[2]; cw[j][7] = c4[3]; }
              const f32x4 a = *(const GAS f32x4*)cbp, c4 = *(const GAS f32x4*)(cbp + 4); cb[0] = a[0]; cb[1] = a[1]; cb[2] = a[2]; cb[3] = a[3]; cb[4] = c4[0]; cb[5] = c4[1]; cb[6] = c4[2]; cb[7] = c4[3]; }
            u32x4 raw[11];
#pragma unroll
            for (int j = 0; j < 11; ++j) raw[j] = rawn[j];
#pragma unroll
            for (int i = 0; i < 8; ++i) {
                float o[8];
#pragma unroll
                for (int e = 0; e < 8; ++e) { const int q = e >> 1; const bool hi_ = e & 1;
                    const float x0 = hi_ ? bf_hi(raw[i][q]) : bf_lo(raw[i][q]), x1 = hi_ ? bf_hi(raw[i + 1][q]) : bf_lo(raw[i + 1][q]), x2 = hi_ ? bf_hi(raw[i + 2][q]) : bf_lo(raw[i + 2][q]), x3 = hi_ ? bf_hi(raw[i + 3][q]) : bf_lo(raw[i + 3][q]);
                    const float y = cb[e] + cw[0][e] * x0 + cw[1][e] * x1 + cw[2][e] * x2 + cw[3][e] * x3; o[e] = (ABL & 1) ? y : siluf_(y) * kscale; }
                u32x4 w; w.x = pk2(o[0], o[1]); w.y = pk2(o[2], o[3]); w.z = pk2(o[4], o[5]); w.w = pk2(o[6], o[7]);
                *(LAS u32x4*)(lds + (c_mat ? KI : QI) + off_b(c_rg * 8 + i, c_ch)) = w;
            }
        }
        { int tq = tid; OPAQUE(tq);
#pragma unroll
        for (int i = 0; i < 8; ++i) { const int idx = tq + 512 * i, row = idx >> 5, ch32 = idx & 31;
            *(LAS u32x4*)(lds + VI + (ch32 >> 4) * 32768 + off_b(row, ch32 & 15)) = vn[i]; } }
        if (tid < 128) { sc[F_IG + tid] = gin; sc[F_LF + tid] = log_sigmoid(gfn);
            if (c > 0) sc[F_N + tid] = sc[F_MISC + 1] * sc[F_N + tid] + (sc[F_NP + tid] + sc[F_NP + 128 + tid]) + (sc[F_NP + 256 + tid] + sc[F_NP + 384 + tid]); }
        __syncthreads();
        if (wid == 0 && !(ABL & 8)) {
            const float ig0 = sc[F_IG + 2 * lane], ig1 = sc[F_IG + 2 * lane + 1], lf0 = sc[F_LF + 2 * lane], lf1 = sc[F_LF + 2 * lane + 1];
            const float s2 = lf0 + lf1, incl = scan_add(s2, lane), excl = incl - s2;
            const float b0 = excl + lf0, b1 = incl, a0 = ig0 - b0, a1 = ig1 - b1;
            const float im = scan_max(fmaxf(a0, a1), lane); const float em = dpp_keep<0x138>(-3.0e38f, im);
            const float cm0 = fmaxf(em, a0), cm1 = im;
            const float M0 = fmaxf(m_prev, cm0), M1 = fmaxf(m_prev, cm1);
            const float ML = rdlane(M1, 63), bL = rdlane(b1, 63);
            sc[F_A + 2 * lane] = a0; sc[F_A + 2 * lane + 1] = a1; sc[F_M + 2 * lane] = M0; sc[F_M + 2 * lane + 1] = M1;
            sc[F_INTER + 2 * lane] = __expf(m_prev - M0); sc[F_INTER + 2 * lane + 1] = __expf(m_prev - M1);
            sc[F_EMT + 2 * lane] = __expf(-(b0 + M0)); sc[F_EMT + 2 * lane + 1] = __expf(-(b1 + M1));
            sc[F_W + 2 * lane] = __expf(a0 - ML); sc[F_W + 2 * lane + 1] = __expf(a1 - ML);
            if (lane == 0) sc[F_MISC + 0] = __expf(m_prev - ML);
            m_prev = bL + ML;
        }
        f32x16 sT[2];
#pragma unroll
        for (int jj = 0; jj < 2; ++jj) {
#pragma unroll
            for (int r = 0; r < 16; ++r) sT[jj][r] = 0.f;
            const int j = st_j0 + jj;
            if (j <= st_i) { MLS_LV; const unsigned fh = (16u * hi) ^ f16;
                bf16x8 af[8], qq[8];
#pragma unroll
                for (int ks = 0; ks < 8; ++ks) { const unsigned xo = rowb + ((32u * ks) ^ fh);
                    af[ks] = *(const LAS bf16x8*)(lds + KI + 8192 * j + xo); qq[ks] = *(const LAS bf16x8*)(lds + QI + 8192 * st_i + xo); }
                __builtin_amdgcn_sched_barrier(0);
#pragma unroll
                for (int ks = 0; ks < 8; ++ks) sT[jj] = MFMA32(af[ks], qq[ks], sT[jj]);
                __builtin_amdgcn_sched_barrier(0);
            }
        }
        __syncthreads();
        u32x2 pp[2][4];
        { MLS_LV; const int t = 32 * st_i + r32; const float Mt = sc[F_M + t]; const unsigned ab = SC + 4 * F_A + 128 * st_j0 + 16 * hi;
#pragma unroll
          for (int jj = 0; jj < 2; ++jj) { const int j = st_j0 + jj;
#pragma unroll
            for (int g4 = 0; g4 < 4; ++g4) { const int s0 = 32 * j + 8 * g4 + 4 * hi; float pv[4];
#pragma unroll
                for (int e = 0; e < 4; ++e) { const int s = s0 + e; pv[e] = (s <= t) ? __expf(*(const LAS float*)(lds + ab + 4 * (32 * jj + 8 * g4 + e)) - Mt) * sT[jj][4 * g4 + e] : 0.f; }
                pp[jj][g4].x = pk2(pv[0], pv[1]); pp[jj][g4].y = pk2(pv[2], pv[3]); } } }
        f32x16 acc[4];
#pragma unroll
        for (int ti = 0; ti < 4; ++ti)
#pragma unroll
            for (int r = 0; r < 16; ++r) acc[ti][r] = 0.f;
        if (c > 0) {
#pragma unroll
            for (int dt = 0; dt < 4; ++dt)
#pragma unroll
                for (int s2 = 0; s2 < 2; ++s2) { const bf16x8 bfr = pack_step(CT[dt], s2); MLS_LV;
                    const unsigned a0 = QI + rowb + 8 * hi + ((64u * dt + 32u * s2) ^ f16), a1 = QI + rowb + 8 * hi + ((64u * dt + 32u * s2 + 16u) ^ f16);
                    s16x4 lo[4], hi4[4];
#pragma unroll
                    for (int ti = 0; ti < 4; ++ti) { lo[ti] = *(const LAS s16x4*)(lds + a0 + 8192 * ti); hi4[ti] = *(const LAS s16x4*)(lds + a1 + 8192 * ti); }
                    __builtin_amdgcn_sched_barrier(0);
#pragma unroll
                    for (int ti = 0; ti < 4; ++ti) acc[ti] = MFMA32(cat8(lo[ti], hi4[ti]), bfr, acc[ti]);
                    __builtin_amdgcn_sched_barrier(0); }
        }
        { int tq = tid; OPAQUE(tq); const int t = tq & 127, part = tq >> 7; float d = 0.f;
#pragma unroll
          for (int cc = 0; cc < 4; ++cc) { const int ch = 4 * part + cc; const u32x4 raw = *(const LAS u32x4*)(lds + QI + off_b(t, ch)); const LAS float* nn = sc + F_N + 8 * ch;
              d += bf_lo(raw.x) * nn[0] + bf_hi(raw.x) * nn[1] + bf_lo(raw.y) * nn[2] + bf_hi(raw.y) * nn[3] + bf_lo(raw.z) * nn[4] + bf_hi(raw.z) * nn[5] + bf_lo(raw.w) * nn[6] + bf_hi(raw.w) * nn[7]; }
          sc[F_NQ2P + part * 128 + t] = d; }
        __syncthreads();
        { MLS_LV; const unsigned ib = SC + 4 * F_INTER + 16 * hi;
#pragma unroll
          for (int ti = 0; ti < 4; ++ti)
#pragma unroll
            for (int r = 0; r < 16; ++r) acc[ti][r] *= *(const LAS float*)(lds + ib + 4 * (32 * ti + (r & 3) + 8 * (r >> 2))); }
        { MLS_LV;
#pragma unroll
          for (int jj = 0; jj < 2; ++jj) { const int j = st_j0 + jj;
#pragma unroll
            for (int g4 = 0; g4 < 4; ++g4) *(LAS u32x2*)(lds + QI + 8192 * st_i + rowb + 8 * hi + ((64u * j + 16u * g4) ^ f16)) = pp[jj][g4]; } }
        { int tq = tid; OPAQUE(tq);
#pragma unroll
        for (int i = 0; i < 4; ++i) { const int idx = tq + 512 * i, row = idx >> 4, ch = idx & 15; LAS u32x4* p = (LAS u32x4*)(lds + KI + off_b(row, ch)); const u32x4 raw = *p; const float w = sc[F_W + row];
            u32x4 o; o.x = pk2(bf_lo(raw.x) * w, bf_hi(raw.x) * w); o.y = pk2(bf_lo(raw.y) * w, bf_hi(raw.y) * w); o.z = pk2(bf_lo(raw.z) * w, bf_hi(raw.z) * w); o.w = pk2(bf_lo(raw.w) * w, bf_hi(raw.w) * w); *p = o; } }
        __syncthreads();
        { const float decay = sc[F_MISC + 0];
#pragma unroll
          for (int dt = 0; dt < 4; ++dt)
#pragma unroll
            for (int r = 0; r < 16; ++r) CT[dt][r] *= decay; }
#pragma unroll
        for (int ks = 0; ks < 8; ++ks) {
            MLS_LV;
            const unsigned tbv0 = VI + img * 32768 + tr_base(L_, 0) + ((64u * vc) ^ q64), tbv1 = VI + img * 32768 + tr_base(L_, 1) + ((64u * vc) ^ q64);
            const unsigned tbk0 = KI + tr_base(L_, 0), tbk1 = KI + tr_base(L_, 1);
            const bf16x8 bv = cat8(tr_read(lds + tbv0 + 4096 * ks), tr_read(lds + tbv1 + 4096 * ks));
            const unsigned xo = QI + rowb + ((32u * ks) ^ ((16u * hi) ^ f16));
            bf16x8 pa[4]; s16x4 klo[4], khi[4];
#pragma unroll
            for (int ti = 0; ti < 4; ++ti) if (ks < 2 * (ti + 1)) pa[ti] = *(const LAS bf16x8*)(lds + xo + 8192 * ti);
#pragma unroll
            for (int dt = 0; dt < 4; ++dt) { const unsigned cx = (64u * dt) ^ q64; klo[dt] = tr_read(lds + tbk0 + 4096 * ks + cx); khi[dt] = tr_read(lds + tbk1 + 4096 * ks + cx); }
            __builtin_amdgcn_sched_barrier(0);
#pragma unroll
            for (int ti = 0; ti < 4; ++ti) if (ks < 2 * (ti + 1)) acc[ti] = MFMA32(pa[ti], bv, acc[ti]);
#pragma unroll
            for (int dt = 0; dt < 4; ++dt) CT[dt] = MFMA32(cat8(klo[dt], khi[dt]), bv, CT[dt]);
            __builtin_amdgcn_sched_barrier(0);
        }
        { int tq = tid; OPAQUE(tq); const int t = tq & 127, part = tq >> 7; float d = 0.f;
#pragma unroll
          for (int cc = 0; cc < 4; ++cc) { const u32x4 raw = *(const LAS u32x4*)(lds + QI + off_b(t, 4 * part + cc));
              d += (bf_lo(raw.x) + bf_hi(raw.x)) + (bf_lo(raw.y) + bf_hi(raw.y)) + (bf_lo(raw.z) + bf_hi(raw.z)) + (bf_lo(raw.w) + bf_hi(raw.w)); }
          sc[F_NQ1P + part * 128 + t] = d;
          float nn = 0.f;
          if (!(ABL & 16)) for (int s = 32 * part; s < 32 * part + 32; ++s) nn += bf2f(*(const LAS bf16_t*)(lds + KI + off_b(s, t >> 3) + (t & 7) * 2));
          sc[F_NP + part * 128 + t] = nn;
          if (tid == 0) sc[F_MISC + 1] = sc[F_MISC + 0]; }
        __syncthreads();
        if (tid < 128) { const float nq1 = (sc[F_NQ1P + tid] + sc[F_NQ1P + 128 + tid]) + (sc[F_NQ1P + 256 + tid] + sc[F_NQ1P + 384 + tid]);
            const float nq2 = (sc[F_NQ2P + tid] + sc[F_NQ2P + 128 + tid]) + (sc[F_NQ2P + 256 + tid] + sc[F_NQ2P + 384 + tid]);
            sc[F_DEN + tid] = 1.0f / fmaxf(fabsf(nq1 + sc[F_INTER + tid] * nq2), sc[F_EMT + tid]); }
        __syncthreads();
        u32x4 oraw[8];
        { int tq = tid; OPAQUE(tq);
#pragma unroll
          for (int i = 0; i < 8; ++i) { const int idx = tq + 512 * i, row = idx >> 5, ch = idx & 31; oraw[i] = *(const u32x4*)(Z + (t0 + row) * NZ + hd * 256 + ch * 8 + ZC_MO); } }
        { MLS_LV; const unsigned db = SC + 4 * F_DEN + 16 * hi, hb = VI + 2048 * hi + (32 * wid + r32) * 2;
#pragma unroll
          for (int ti = 0; ti < 4; ++ti)
#pragma unroll
            for (int r = 0; r < 16; ++r) { const int tt = 32 * ti + (r & 3) + 8 * (r >> 2); const float x = acc[ti][r] * *(const LAS float*)(lds + db + 4 * tt);
                *(LAS bf16_t*)(lds + hb + 512 * tt) = (bf16_t)(pk2(x, 0.f) & 0xffffu); } }
        __syncthreads();
        { const int cn = c + 1 < 16 ? c + 1 : 15; MLS_PREFETCH(cn); }
        if (!(ABL & 2))
        { int tq = tid; OPAQUE(tq);
          const f32x4 g0 = *(const f32x4*)(norm_g + hd * 256 + (tq & 31) * 8), g1 = *(const f32x4*)(norm_g + hd * 256 + (tq & 31) * 8 + 4);
#pragma unroll
          for (int i = 0; i < 8; ++i) { const int idx = tq + 512 * i, row = idx >> 5, ch = idx & 31;
            const u32x4 hraw = *(const LAS u32x4*)(lds + VI + row * 512 + ch * 16);
            const float h0 = bf_lo(hraw.x), h1 = bf_hi(hraw.x), h2 = bf_lo(hraw.y), h3 = bf_hi(hraw.y), h4 = bf_lo(hraw.z), h5 = bf_hi(hraw.z), h6 = bf_lo(hraw.w), h7 = bf_hi(hraw.w);
            float ssq = (h0 * h0 + h1 * h1) + (h2 * h2 + h3 * h3) + (h4 * h4 + h5 * h5) + (h6 * h6 + h7 * h7);
            ssq = half_sum32(ssq);
            const float rstd = rsqrtf(ssq * (1.0f / 256.0f) + LN_EPS);
            bf16_t* gp = Z + (t0 + row) * NZ + hd * 256 + ch * 8;
            u32x4 o;
            o.x = pk2(h0 * rstd * g0[0] * sigmoidf_(bf_lo(oraw[i].x)), h1 * rstd * g0[1] * sigmoidf_(bf_hi(oraw[i].x)));
            o.y = pk2(h2 * rstd * g0[2] * sigmoidf_(bf_lo(oraw[i].y)), h3 * rstd * g0[3] * sigmoidf_(bf_hi(oraw[i].y)));
            o.z = pk2(h4 * rstd * g1[0] * sigmoidf_(bf_lo(oraw[i].z)), h5 * rstd * g1[1] * sigmoidf_(bf_hi(oraw[i].z)));
            o.w = pk2(h6 * rstd * g1[2] * sigmoidf_(bf_lo(oraw[i].w)), h7 * rstd * g1[3] * sigmoidf_(bf_hi(oraw[i].w)));
            if (!DRY || o.x == 0x12345678u) *(u32x4*)(gp + ZC_MV) = o; } }
    }
    __syncthreads();
}
#undef MLS_LV
#undef MLS_PREFETCH
}
namespace peer {
constexpr int KROW = 144;
constexpr int L_KEYS = 0, L_IDX = 2 * 128 * KROW, LDS_BYTES = L_IDX + 512 * 32;
DI unsigned ordf(float f) { const unsigned u = __float_as_uint(f); return u ^ ((unsigned)((int)u >> 31) | 0x80000000u); }
DI float deord(unsigned k) { return __uint_as_float(k ^ ((~(unsigned)((int)k >> 31)) | 0x80000000u)); }
#define PEER_CE(a, b) do { const unsigned hi_ = (a) > (b) ? (a) : (b), lo_ = (a) > (b) ? (b) : (a); (a) = hi_; (b) = lo_; } while (0)
DI void sort16_desc(unsigned (&a)[16]) {
    PEER_CE(a[0], a[13]); PEER_CE(a[1], a[12]); PEER_CE(a[2], a[15]); PEER_CE(a[3], a[14]); PEER_CE(a[4], a[8]); PEER_CE(a[5], a[6]); PEER_CE(a[7], a[11]); PEER_CE(a[9], a[10]);
    PEER_CE(a[0], a[5]); PEER_CE(a[1], a[7]); PEER_CE(a[2], a[9]); PEER_CE(a[3], a[4]); PEER_CE(a[6], a[13]); PEER_CE(a[8], a[14]); PEER_CE(a[10], a[15]); PEER_CE(a[11], a[12]);
    PEER_CE(a[0], a[1]); PEER_CE(a[2], a[3]); PEER_CE(a[4], a[5]); PEER_CE(a[6], a[8]); PEER_CE(a[7], a[9]); PEER_CE(a[10], a[11]); PEER_CE(a[12], a[13]); PEER_CE(a[14], a[15]);
    PEER_CE(a[0], a[2]); PEER_CE(a[1], a[3]); PEER_CE(a[4], a[10]); PEER_CE(a[5], a[11]); PEER_CE(a[6], a[7]); PEER_CE(a[8], a[9]); PEER_CE(a[12], a[14]); PEER_CE(a[13], a[15]);
    PEER_CE(a[1], a[2]); PEER_CE(a[3], a[12]); PEER_CE(a[4], a[6]); PEER_CE(a[5], a[7]); PEER_CE(a[8], a[10]); PEER_CE(a[9], a[11]); PEER_CE(a[13], a[14]);
    PEER_CE(a[1], a[4]); PEER_CE(a[2], a[6]); PEER_CE(a[5], a[8]); PEER_CE(a[7], a[10]); PEER_CE(a[9], a[13]); PEER_CE(a[11], a[14]);
    PEER_CE(a[2], a[4]); PEER_CE(a[3], a[6]); PEER_CE(a[9], a[12]); PEER_CE(a[11], a[13]);
    PEER_CE(a[3], a[5]); PEER_CE(a[6], a[8]); PEER_CE(a[7], a[9]); PEER_CE(a[10], a[12]);
    PEER_CE(a[3], a[4]); PEER_CE(a[5], a[6]); PEER_CE(a[7], a[8]); PEER_CE(a[9], a[10]); PEER_CE(a[11], a[12]);
    PEER_CE(a[6], a[7]); PEER_CE(a[8], a[9]);
}
DI void merge16(unsigned (&a)[16], const unsigned (&b)[16]) {
#pragma unroll
    for (int i = 0; i < 16; ++i) a[i] = a[i] > b[15 - i] ? a[i] : b[15 - i];
#pragma unroll
    for (int j = 8; j >= 1; j >>= 1)
#pragma unroll
        for (int i = 0; i < 16; ++i) { const int l = i ^ j; if (l > i) PEER_CE(a[i], a[l]); }
}
DI float gelu_erf(float x) { return 0.5f * x * (1.0f + erff(x * 0.7071067811865476f)); }

DI void stage_keys(LAS unsigned char* lds, const float* keys) {
    for (int i = threadIdx.x; i < 2 * 128 * 8; i += 512) { const int row = i >> 3, ch = i & 7; const float* s = keys + row * 64 + ch * 8;
        const f32x4 a = *(const f32x4*)s, b = *(const f32x4*)(s + 4);
        u32x4 w; w.x = pk2(a[0], a[1]); w.y = pk2(a[2], a[3]); w.z = pk2(b[0], b[1]); w.w = pk2(b[2], b[3]);
        *(LAS u32x4*)(lds + L_KEYS + row * KROW + ch * 16) = w; }
}

DI void select_phase(LAS unsigned char* lds, const bf16_t* QP, int tile0, int tstep, int tile_end, bf16_t* SELE, float* SELG) {
    int tid_o = threadIdx.x; OPAQUE(tid_o); const int tid = tid_o, lane = tid & 63, r32 = lane & 31, hi = lane >> 5; const int wid = __builtin_amdgcn_readfirstlane(tid >> 6);
    bf16x8 qn[2][4];
#define SEL_QLOAD(TILE) do { const bf16_t* qp_ = QP + ((size_t)(TILE) * 32 + r32) * DM + wid * 128 + 8 * hi; \
        _Pragma("unroll") for (int p_ = 0; p_ < 2; ++p_) _Pragma("unroll") for (int s_ = 0; s_ < 4; ++s_) qn[p_][s_] = *(const bf16x8*)(qp_ + p_ * 64 + 16 * s_); } while (0)
    if (tile0 < tile_end) SEL_QLOAD(tile0);
    for (int tile = tile0; tile < tile_end; tile += tstep) {
    const int tok0 = tile * 32;
    unsigned LA[16], LB[16];
    bf16x8 qc[2][4];
#pragma unroll
    for (int p = 0; p < 2; ++p)
#pragma unroll
        for (int s = 0; s < 4; ++s) qc[p][s] = qn[p][s];
    { const int tn = tile + tstep < tile_end ? tile + tstep : tile; SEL_QLOAD(tn); }
#pragma unroll
    for (int p = 0; p < 2; ++p) {
        bf16x8 qf[4];
#pragma unroll
        for (int s = 0; s < 4; ++s) qf[s] = qc[p][s];
        unsigned L[16], M[16];
#pragma unroll
        for (int nt = 0; nt < 4; ++nt) {
            f32x16 acc;
#pragma unroll
            for (int r = 0; r < 16; ++r) acc[r] = 0.f;
#pragma unroll
            for (int s = 0; s < 4; ++s) { const bf16x8 a = *(const LAS bf16x8*)(lds + L_KEYS + (p * 128 + 32 * nt + r32) * KROW + (2 * s + hi) * 16); acc = MFMA32(a, qf[s], acc); }
            unsigned T[16];
#pragma unroll
            for (int r = 0; r < 16; ++r) T[r] = (ordf(acc[r]) & ~0x7Fu) | (unsigned)(32 * nt + crow(r, hi));
            sort16_desc(T);
            if (nt == 0) {
#pragma unroll
                for (int i = 0; i < 16; ++i) L[i] = T[i]; }
            else if (nt == 1) merge16(L, T);
            else if (nt == 2) {
#pragma unroll
                for (int i = 0; i < 16; ++i) M[i] = T[i]; }
            else { merge16(M, T); merge16(L, M); }
        }
        unsigned O[16];
#pragma unroll
        for (int i = 0; i < 16; ++i) O[i] = partner32(L[i], hi);
        merge16(L, O);
#pragma unroll
        for (int i = 0; i < 16; ++i) { if (p == 0) LA[i] = L[i]; else LB[i] = L[i]; }
    }
    unsigned CL[16];
    {
        float sa[16], sb[16];
#pragma unroll
        for (int i = 0; i < 16; ++i) { sa[i] = deord(LA[i] & ~0x7Fu); sb[i] = deord(LB[i] & ~0x7Fu); }
        unsigned G0[16], G1[16];
#define SEL_PUT(k, v) do { if ((k) < 16) G0[(k) & 15] = (v); else G1[(k) & 15] = (v); } while (0)
#define SEL_CAND2(k, iA, jA, iB, jB) SEL_PUT(k, (ordf((hi ? sa[iB] : sa[iA]) + (hi ? sb[jB] : sb[jA])) & ~0xFFu) | (unsigned)(hi ? (iB) * 16 + (jB) : (iA) * 16 + (jA)))
#define SEL_CAND1(k, iA, jA) SEL_PUT(k, hi ? 0u : ((ordf(sa[iA] + sb[jA]) & ~0xFFu) | (unsigned)((iA) * 16 + (jA))))
        SEL_CAND2(0, 0, 0, 3, 3);
        SEL_CAND2(1, 0, 1, 4, 0);
        SEL_CAND2(2, 0, 2, 4, 1);
        SEL_CAND2(3, 0, 3, 4, 2);
        SEL_CAND2(4, 0, 4, 5, 0);
        SEL_CAND2(5, 0, 5, 5, 1);
        SEL_CAND2(6, 0, 6, 6, 0);
        SEL_CAND2(7, 0, 7, 6, 1);
        SEL_CAND2(8, 0, 8, 7, 0);
        SEL_CAND2(9, 0, 9, 7, 1);
        SEL_CAND2(10, 0, 10, 8, 0);
        SEL_CAND2(11, 0, 11, 9, 0);
        SEL_CAND2(12, 0, 12, 10, 0);
        SEL_CAND2(13, 0, 13, 11, 0);
        SEL_CAND2(14, 0, 14, 12, 0);
        SEL_CAND2(15, 0, 15, 13, 0);
        SEL_CAND2(16, 1, 0, 14, 0);
        SEL_CAND2(17, 1, 1, 15, 0);
        SEL_CAND1(18, 1, 2);
        SEL_CAND1(19, 1, 3);
        SEL_CAND1(20, 1, 4);
        SEL_CAND1(21, 1, 5);
        SEL_CAND1(22, 1, 6);
        SEL_CAND1(23, 1, 7);
        SEL_CAND1(24, 2, 0);
        SEL_CAND1(25, 2, 1);
        SEL_CAND1(26, 2, 2);
        SEL_CAND1(27, 2, 3);
        SEL_CAND1(28, 2, 4);
        SEL_CAND1(29, 3, 0);
        SEL_CAND1(30, 3, 1);
        SEL_CAND1(31, 3, 2);
#undef SEL_PUT
#undef SEL_CAND2
#undef SEL_CAND1
        sort16_desc(G0); sort16_desc(G1); merge16(G0, G1);
        unsigned O[16];
#pragma unroll
        for (int i = 0; i < 16; ++i) O[i] = partner32(G0[i], hi);
        merge16(G0, O);
#pragma unroll
        for (int i = 0; i < 16; ++i) CL[i] = G0[i];
    }
    LAS unsigned char* itab = lds + L_IDX + tid * 32;
    { u32x4 wa, wb;
#pragma unroll
      for (int q = 0; q < 4; ++q) { wa[q] = (LA[4 * q] & 0x7Fu) | ((LA[4 * q + 1] & 0x7Fu) << 8) | ((LA[4 * q + 2] & 0x7Fu) << 16) | ((LA[4 * q + 3] & 0x7Fu) << 24);
                                    wb[q] = (LB[4 * q] & 0x7Fu) | ((LB[4 * q + 1] & 0x7Fu) << 8) | ((LB[4 * q + 2] & 0x7Fu) << 16) | ((LB[4 * q + 3] & 0x7Fu) << 24); }
      *(LAS u32x4*)itab = wa; *(LAS u32x4*)(itab + 16) = wb; }
    const float mx = deord(CL[0] & ~0xFFu);
    float ev[16], sum = 0.f;
#pragma unroll
    for (int k = 0; k < 16; ++k) { ev[k] = __expf(deord(CL[k] & ~0xFFu) - mx); sum += ev[k]; }
    const float inv = 1.0f / sum;
    bf16_t* se = SELE + (size_t)(tok0 + r32) * 128 + wid * 16;
    float* sg = SELG + (size_t)(tok0 + r32) * 128 + wid * 16;
#pragma unroll
    for (int k = 0; k < 16; ++k) if ((k >> 3) == hi) { const unsigned code = CL[k] & 0xFFu; const unsigned n1 = itab[code >> 4], n2 = itab[16 + (code & 15u)];
        se[k] = (bf16_t)(n1 * 128u + n2); sg[k] = ev[k] * inv; }
    }
#undef SEL_QLOAD
}

DI void u_phase(LAS unsigned char* lds, int tile0, int tstep, int s, const bf16_t* SELE, const unsigned char* H2Q, const unsigned char* U4S, bf16_t* PART) {
    int tid_o = threadIdx.x; OPAQUE(tid_o); const int tid = tid_o, lane = tid & 63, j = lane >> 3, c = lane & 7; const int wid = __builtin_amdgcn_readfirstlane(tid >> 6);
    if (tile0 >= TOK / 32) return;
    LAS unsigned char* wl = lds + wid * 4096;
    const unsigned char* Us = U4S + (size_t)s * NEXP * 128; const unsigned c16 = 16u * c;
    u32x4 sreg;
#define UP_STAGE_LOAD(TILE) do { sreg = *(const u32x4*)(SELE + (size_t)(TILE) * 32 * 128 + (wid * 64 + lane) * 8); } while (0)
#define UP_STAGE_STORE(BUF) do { *(LAS u32x4*)(wl + (BUF) * 2048 + lane * 16) = sreg; } while (0)
#define UP_GATHER(UR, HP, BUF, U, TILE) do { const LAS bf16_t* se_ = (const LAS bf16_t*)(wl + (BUF) * 2048) + ((U) >> 1) * 128 + 64 * ((U) & 1) + j; \
        if (((U) & 1) == 0) { const unsigned char* hrow_ = H2Q + ((size_t)(TILE) * 32 + wid * 4 + ((U) >> 1)) * DM + 128 * s; HP[0] = *(const u32x4*)(hrow_ + c16); HP[1] = *(const u32x4*)(hrow_ + 512 + c16); } \
        _Pragma("unroll") for (int g = 0; g < 8; ++g) { const unsigned e_ = se_[8 * g]; UR[g] = *(const u32x4*)(Us + ((e_ << 7) + c16)); } } while (0)
#define UP_DOTS(UR, HP, U) do { \
        _Pragma("unroll") for (int g = 0; g < 8; ++g) { int da = 0, db = 0; \
            _Pragma("unroll") for (int i = 0; i < 4; ++i) { da = __builtin_amdgcn_sdot8((int)UR[g][i], (int)HP[0][i], da, false); db = __builtin_amdgcn_sdot8((int)UR[g][i], (int)HP[1][i], db, false); } \
            d[8 * ((U) & 1) + g] = 16 * da + db; if ((g & 3) == 3) __builtin_amdgcn_sched_barrier(0); } } while (0)
#define UP_FINISH(JT, TILE) do { \
          \
        int r1[8], r2[4], r3[2]; \
        _Pragma("unroll") for (int i = 0; i < 8; ++i) { const int keep = c2 ? d[i + 8] : d[i], send = c2 ? d[i] : d[i + 8]; r1[i] = keep + dppi<0x141>(send); } \
        _Pragma("unroll") for (int i = 0; i < 4; ++i) { const int keep = c1 ? r1[i + 4] : r1[i], send = c1 ? r1[i] : r1[i + 4]; r2[i] = keep + dppi<0x4E>(send); } \
        _Pragma("unroll") for (int i = 0; i < 2; ++i) { const int keep = c0 ? r2[i + 2] : r2[i], send = c0 ? r2[i] : r2[i + 2]; r3[i] = keep + dppi<0xB1>(send); } \
        bf16_t* pp = PART + ((size_t)(TILE) * 32 + wid * 4 + (JT)) * 512 + s * 128 + 16 * c + j;            \
        pp[0] = (bf16_t)(pk2((float)r3[0], 0.f) & 0xffffu); pp[8] = (bf16_t)(pk2((float)r3[1], 0.f) & 0xffffu); } while (0)
    u32x4 urA[8], urB[8], urC[8], urD[8], h0[2], h1[2], h2[2], h3[2], hx[2]; int d[16]; const int c2 = c >> 2, c1 = (c >> 1) & 1, c0 = c & 1; (void)hx;
    UP_STAGE_LOAD(tile0); UP_STAGE_STORE(0);
    UP_GATHER(urA, h0, 0, 0, tile0); UP_GATHER(urB, hx, 0, 1, tile0); UP_GATHER(urC, h1, 0, 2, tile0);
    int buf = 0;
#pragma unroll 1
    for (int tile = tile0; tile < TOK / 32; tile += tstep) {
        const int tnext = tile + tstep < TOK / 32 ? tile + tstep : tile;
        UP_STAGE_LOAD(tnext);
        UP_GATHER(urD, hx, buf, 3, tile); UP_DOTS(urA, h0, 0);
        UP_GATHER(urA, h2, buf, 4, tile); UP_DOTS(urB, h0, 1); UP_FINISH(0, tile);
        UP_GATHER(urB, hx, buf, 5, tile); UP_DOTS(urC, h1, 2);
        UP_GATHER(urC, h3, buf, 6, tile); UP_DOTS(urD, h1, 3); UP_FINISH(1, tile);
        UP_GATHER(urD, hx, buf, 7, tile); UP_DOTS(urA, h2, 4);
        UP_STAGE_STORE(buf ^ 1);
        UP_GATHER(urA, h0, buf ^ 1, 0, tnext); UP_DOTS(urB, h2, 5); UP_FINISH(2, tile);
        UP_GATHER(urB, hx, buf ^ 1, 1, tnext); UP_DOTS(urC, h3, 6);
        UP_GATHER(urC, h1, buf ^ 1, 2, tnext); UP_DOTS(urD, h3, 7); UP_FINISH(3, tile);
        buf ^= 1;
    }
#undef UP_STAGE_LOAD
#undef UP_STAGE_STORE
#undef UP_GATHER
#undef UP_DOTS
#undef UP_FINISH
}
template <int NQ> DI void red_tokens(size_t t0, const bf16_t* __restrict__ PART, const bf16_t* __restrict__ SELE, const float* __restrict__ SELG, const float* __restrict__ SU, const float* __restrict__ SV,
                    const float* __restrict__ SH, signed char* __restrict__ COEFQ, float* __restrict__ CS) {
    const int lane = threadIdx.x & 63;
    float s[NQ][2], g[NQ][2], su[NQ][2], sv[NQ][2], sh[NQ];
#pragma unroll
    for (int q = 0; q < NQ; ++q) { const size_t t = t0 + q; sh[q] = SH[t];
#pragma unroll
        for (int h = 0; h < 2; ++h) { const int k = lane + 64 * h; const unsigned e = SELE[t * 128 + k]; g[q][h] = SELG[t * 128 + k]; su[q][h] = SU[e]; sv[q][h] = SV[e];
            float a = 0.f;
#pragma unroll
            for (int xx = 0; xx < 4; ++xx) a += bf2f(PART[t * 512 + xx * 128 + k]);
            s[q][h] = a; } }
#pragma unroll
    for (int q = 0; q < NQ; ++q) { const size_t t = t0 + q;
        const float c0 = g[q][0] * gelu_erf(s[q][0] * su[q][0] * sh[q]) * sv[q][0], c1 = g[q][1] * gelu_erf(s[q][1] * su[q][1] * sh[q]) * sv[q][1];
        float cm = fmaxf(fabsf(c0), fabsf(c1));
        cm = wave_max(cm);
        const float inv = cm > 0.f ? 127.0f / cm : 0.f;
        signed char* cq = COEFQ + t * 128 + (lane & 7) * 16 + (lane >> 3);
        cq[0] = (signed char)(int)rintf(c0 * inv); cq[8] = (signed char)(int)rintf(c1 * inv);
        if (lane == 0) CS[t] = cm * (1.0f / 127.0f); }
}
DI unsigned bperm(unsigned hi, unsigned lo, unsigned sel) { return __builtin_amdgcn_perm(hi, lo, sel); }
DI void v_phase(LAS unsigned char* lds, int tile0, int tstep, int x, const bf16_t* SELE, const signed char* COEFQ, const float* CS, const unsigned char* V8S, bf16_t* YF) {
    int tid_o = threadIdx.x; OPAQUE(tid_o); const int tid = tid_o, lane = tid & 63, j = lane >> 3, c = lane & 7; const int wid = __builtin_amdgcn_readfirstlane(tid >> 6);
    if (tile0 >= TOK / 32) return;
    LAS unsigned char* wl = lds + wid * 4096;
    const unsigned char* Vs = V8S + (size_t)x * NEXP * 128; const unsigned c16 = 16u * c;
    u32x4 sreg, creg = {0u, 0u, 0u, 0u};
#define VP_STAGE_LOAD(TILE) do { sreg = *(const u32x4*)(SELE + (size_t)(TILE) * 32 * 128 + (wid * 64 + lane) * 8); if (lane < 32) creg = *(const u32x4*)(COEFQ + (size_t)(TILE) * 32 * 128 + (wid * 32 + lane) * 16); } while (0)
#define VP_STAGE_STORE(BUF) do { *(LAS u32x4*)(wl + (BUF) * 2048 + lane * 16) = sreg; if (lane < 32) *(LAS u32x4*)(wl + (BUF) * 2048 + 1024 + lane * 16) = creg; } while (0)
#define VP_GATHER(VR, SC, BUF, JT, TILE) do { const LAS bf16_t* se_ = (const LAS bf16_t*)(wl + (BUF) * 2048) + (JT) * 128 + j; SC = CS[(size_t)(TILE) * 32 + wid * 4 + (JT)]; \
        _Pragma("unroll") for (int g = 0; g < 16; ++g) { const unsigned e_ = se_[8 * g]; VR[g] = *(const u32x4*)(Vs + ((e_ << 7) + c16)); } } while (0)
#define VP_COMPUTE(VR, SC, BUF, JT, TILE) do { const LAS unsigned* cqp_ = (const LAS unsigned*)(wl + (BUF) * 2048 + 1024 + (JT) * 128 + j * 16); \
        int acc[16]; \
        _Pragma("unroll") for (int i = 0; i < 16; ++i) acc[i] = 0; \
        _Pragma("unroll") for (int qd = 0; qd < 4; ++qd) { const int cp = (int)cqp_[qd]; \
            _Pragma("unroll") for (int i = 0; i < 4; ++i) { const unsigned w0 = VR[4 * qd][i], w1 = VR[4 * qd + 1][i], w2 = VR[4 * qd + 2][i], w3 = VR[4 * qd + 3][i]; \
                const unsigned t0 = bperm(w1, w0, 0x05010400u), t1 = bperm(w1, w0, 0x07030602u), t2 = bperm(w3, w2, 0x05010400u), t3 = bperm(w3, w2, 0x07030602u); \
                acc[4 * i] = __builtin_amdgcn_sdot4((int)bperm(t2, t0, 0x05040100u), cp, acc[4 * i], false); \
                acc[4 * i + 1] = __builtin_amdgcn_sdot4((int)bperm(t2, t0, 0x07060302u), cp, acc[4 * i + 1], false); \
                acc[4 * i + 2] = __builtin_amdgcn_sdot4((int)bperm(t3, t1, 0x05040100u), cp, acc[4 * i + 2], false); \
                acc[4 * i + 3] = __builtin_amdgcn_sdot4((int)bperm(t3, t1, 0x07060302u), cp, acc[4 * i + 3], false); } } \
          \
        int r1[8], r2[4], r3[2]; \
        _Pragma("unroll") for (int i = 0; i < 8; ++i) { const int keep = b3 ? acc[i + 8] : acc[i], send = b3 ? acc[i] : acc[i + 8]; r1[i] = keep + dppi<0x128>(send); }                          \
        _Pragma("unroll") for (int i = 0; i < 4; ++i) { const int keep = b4 ? r1[i + 4] : r1[i], send = b4 ? r1[i] : r1[i + 4]; r2[i] = keep + __builtin_amdgcn_ds_swizzle(send, 0x401F); }     \
        _Pragma("unroll") for (int i = 0; i < 2; ++i) { const int keep = b5 ? r2[i + 2] : r2[i], send = b5 ? r2[i] : r2[i + 2]; r3[i] = keep + (int)partner32((unsigned)send, b5); }              \
        *(unsigned*)(YF + ((size_t)(TILE) * 32 + wid * 4 + (JT)) * DM + 128 * x + 16 * c + 8 * b3 + 4 * b4 + 2 * b5) = pk2((float)r3[0] * SC, (float)r3[1] * SC); } while (0)
    u32x4 vrA[16], vrB[16]; float scA, scB; const int b3 = j & 1, b4 = (j >> 1) & 1, b5 = j >> 2;
    VP_STAGE_LOAD(tile0); VP_STAGE_STORE(0);
    VP_GATHER(vrA, scA, 0, 0, tile0);
    int buf = 0;
#pragma unroll 1
    for (int tile = tile0; tile < TOK / 32; tile += tstep) {
        const int tnext = tile + tstep < TOK / 32 ? tile + tstep : tile;
        VP_STAGE_LOAD(tnext);
        VP_GATHER(vrB, scB, buf, 1, tile); VP_COMPUTE(vrA, scA, buf, 0, tile);
        VP_GATHER(vrA, scA, buf, 2, tile); VP_COMPUTE(vrB, scB, buf, 1, tile);
        VP_GATHER(vrB, scB, buf, 3, tile); VP_COMPUTE(vrA, scA, buf, 2, tile);
        VP_STAGE_STORE(buf ^ 1);
        VP_GATHER(vrA, scA, buf ^ 1, 0, tnext);
        VP_COMPUTE(vrB, scB, buf, 3, tile);
        buf ^= 1;
    }
#undef VP_STAGE_LOAD
#undef VP_STAGE_STORE
#undef VP_GATHER
#undef VP_COMPUTE
}
DI void final_rows2(size_t m0, size_t m1, const bf16_t* __restrict__ Rp, const bf16_t* __restrict__ YF, const float* __restrict__ MOD, const float* __restrict__ g1, const float* __restrict__ b1,
                    const float* __restrict__ ln_g, const float* __restrict__ ln_b, float* __restrict__ OUT) {
    const int lane = threadIdx.x & 63;
    f32x4 v[2][4], y[2][4];
#pragma unroll
    for (int r = 0; r < 2; ++r) { const size_t m = r ? m1 : m0;
        const u32x2* rr = (const u32x2*)(Rp + m * DM) + lane; const u32x2* yr = (const u32x2*)(YF + m * DM) + lane;
#pragma unroll
        for (int q = 0; q < 4; ++q) { const u32x2 rw = rr[64 * q]; v[r][q] = (f32x4){bf_lo(rw.x), bf_hi(rw.x), bf_lo(rw.y), bf_hi(rw.y)}; const u32x2 yy = yr[64 * q]; y[r][q] = (f32x4){bf_lo(yy.x), bf_hi(yy.x), bf_lo(yy.y), bf_hi(yy.y)}; } }
#pragma unroll
    for (int r = 0; r < 2; ++r) { const size_t m = r ? m1 : m0; const int b = (int)(m / SEQ); const f32x4* gt = (const f32x4*)(MOD + (size_t)b * MODW + 5 * DM) + lane; float s = 0.f;
#pragma unroll
        for (int q = 0; q < 4; ++q) s += (v[r][q].x + v[r][q].y) + (v[r][q].z + v[r][q].w);
        float mean = wave_sum(s) * (1.f / DM); float s2 = 0.f;
#pragma unroll
        for (int q = 0; q < 4; ++q) { v[r][q] = v[r][q] - mean; s2 += (v[r][q].x * v[r][q].x + v[r][q].y * v[r][q].y) + (v[r][q].z * v[r][q].z + v[r][q].w * v[r][q].w); }
        float rstd = rsqrtf(wave_sum(s2) * (1.f / DM) + LN_EPS); s = 0.f;
#pragma unroll
        for (int q = 0; q < 4; ++q) { const f32x4 x1 = v[r][q] * rstd * ((const f32x4*)g1)[lane + 64 * q] + ((const f32x4*)b1)[lane + 64 * q];
            v[r][q] = x1 * ALPHA_RES + gt[64 * q] * y[r][q]; s += (v[r][q].x + v[r][q].y) + (v[r][q].z + v[r][q].w); }
        mean = wave_sum(s) * (1.f / DM); s2 = 0.f;
#pragma unroll
        for (int q = 0; q < 4; ++q) { v[r][q] = v[r][q] - mean; s2 += (v[r][q].x * v[r][q].x + v[r][q].y * v[r][q].y) + (v[r][q].z * v[r][q].z + v[r][q].w * v[r][q].w); }
        rstd = rsqrtf(wave_sum(s2) * (1.f / DM) + LN_EPS);
        f32x4* op = (f32x4*)(OUT + m * DM) + lane;
#pragma unroll
        for (int q = 0; q < 4; ++q) op[64 * q] = v[r][q] * rstd * ((const f32x4*)ln_g)[lane + 64 * q] + ((const f32x4*)ln_b)[lane + 64 * q]; }
}
}
constexpr int NWAVES = 8;
#ifndef MK_N_LAUNCHES
#define MK_N_LAUNCHES 1
#endif
constexpr int N_PHASES = 14;
constexpr int RING_BYTES = 147456;
constexpr int MISC_OFF = RING_BYTES;
constexpr int LDS_BYTES = RING_BYTES + 4096;
static_assert(pg8::STAGE_BYTES <= RING_BYTES && datt::LDS_BYTES <= RING_BYTES && mls::LDS_BYTES <= RING_BYTES && peer::LDS_BYTES <= RING_BYTES, "LDS map");

typedef GAS unsigned gu32;
#define RLX_AGENT __ATOMIC_RELAXED, __HIP_MEMORY_SCOPE_AGENT
#define LDS_WAIT() asm volatile("s_waitcnt lgkmcnt(0)" ::: "memory")

#define XB_TMO      128
#define XB_XCNT(j)  (256  + 64 * (j))
#define XB_XSUB(j)  (1280 + 64 * (j))
#define XB_XGEN(j)  (2304 + 64 * (j))
#define XB_TOP      3328
#define XB_TOPGEN   3392
#define XCD_BAR_WORDS 3456
#define XB_SPIN_CAP (1u << 22)
DI unsigned xb_ld(unsigned* p)              { return __hip_atomic_load(p, __ATOMIC_RELAXED, __HIP_MEMORY_SCOPE_AGENT); }
DI unsigned xb_add(unsigned* p, unsigned v) { return __hip_atomic_fetch_add(p, v, __ATOMIC_RELAXED, __HIP_MEMORY_SCOPE_AGENT); }
DI unsigned xb_xcc_id() { return (unsigned)__builtin_amdgcn_s_getreg((3 << 11) | 20) & 0xFu; }
#define XB_SPIN(cond, bar) do { unsigned _sp = 0; while (cond) { __builtin_amdgcn_s_sleep(1); \
    if ((++_sp & 255u) == 0u) { if (xb_ld(&(bar)[XB_TMO])) break; if (_sp > XB_SPIN_CAP) { atomicAdd(&(bar)[XB_TMO], 1u); break; } } } } while (0)
struct XcdBarrier { unsigned* bar; unsigned x; volatile LAS unsigned* st; };
DI XcdBarrier xcd_barrier_post(unsigned* bar, volatile LAS unsigned* st) {
    XcdBarrier b; b.bar = bar; b.x = xb_xcc_id(); b.st = st;
    if (threadIdx.x == 0) st[2] = xb_add(&bar[XB_XCNT(b.x)], 1u);
    return b;
}
DI void xcd_barrier_complete(unsigned* bar, unsigned x, unsigned& nloc, unsigned& nx) {
    const unsigned G = gridDim.x * gridDim.y * gridDim.z;
    unsigned sum, cnt, mine, sp = 0u;
    for (;;) {
        sum = 0u; cnt = 0u; mine = 0u;
#pragma unroll
        for (unsigned j = 0; j < 16; ++j) { const unsigned c = xb_ld(&bar[XB_XCNT(j)]); sum += c; cnt += (c > 0u) ? 1u : 0u; mine = (j == x) ? c : mine; }
        if (sum == G) break;
        __builtin_amdgcn_s_sleep(1);
        if ((++sp & 255u) == 0u) { if (xb_ld(&bar[XB_TMO])) break; if (sp > XB_SPIN_CAP) { atomicAdd(&bar[XB_TMO], 1u); break; } }
    }
    nloc = mine > 0u ? mine : 1u; nx = cnt > 0u ? cnt : 1u;
}
DI void xcd_barrier(const XcdBarrier& b) {
    asm volatile("s_waitcnt vmcnt(0)" ::: "memory");
    __syncthreads();
    if (threadIdx.x == 0) {
        unsigned* bar = b.bar;
        __builtin_amdgcn_s_waitcnt(0);
        unsigned nloc = b.st[0], nx = b.st[1];
        if (nloc == 0u) { xcd_barrier_complete(bar, b.x, nloc, nx); b.st[0] = nloc; b.st[1] = nx; }
        const unsigned old = xb_add(&bar[XB_XSUB(b.x)], 1u);
        const unsigned gen = old / nloc;
        if (old + 1u == (gen + 1u) * nloc) {
            __builtin_amdgcn_fence(__ATOMIC_RELEASE, "agent");
            asm volatile("s_waitcnt vmcnt(0)" ::: "memory");
            const unsigned og = xb_add(&bar[XB_TOP], 1u);
            const unsigned tg = og / nx;
            if (og + 1u == (tg + 1u) * nx) xb_add(&bar[XB_TOPGEN], 1u);
            else XB_SPIN(xb_ld(&bar[XB_TOPGEN]) == tg, bar);
            xb_add(&bar[XB_XGEN(b.x)], 1u);
            __builtin_amdgcn_fence(__ATOMIC_ACQUIRE, "agent");
            asm volatile("s_waitcnt vmcnt(0)" ::: "memory");
        } else {
            XB_SPIN(xb_ld(&bar[XB_XGEN(b.x)]) == gen, bar);
            __builtin_amdgcn_fence(__ATOMIC_ACQUIRE, "agent");
            asm volatile("s_waitcnt vmcnt(0)" ::: "memory");
        }
    }
    __syncthreads();
}

#ifndef FLATBAR
#define FLATBAR 0
#endif
DI void flat_barrier(unsigned* cnt, unsigned& epoch) {
    asm volatile("s_waitcnt vmcnt(0)" ::: "memory");
    __syncthreads();
    if (threadIdx.x == 0) {
        __builtin_amdgcn_fence(__ATOMIC_RELEASE, "agent");
        asm volatile("s_waitcnt vmcnt(0)" ::: "memory");
        const unsigned target = (epoch + 1u) * gridDim.x;
        xb_add(cnt, 1u);
        unsigned sp = 0;
        while (xb_ld(cnt) < target) { __builtin_amdgcn_s_sleep(1); if (++sp > (1u << 24)) break; }
        __builtin_amdgcn_fence(__ATOMIC_ACQUIRE, "agent");
        asm volatile("s_waitcnt vmcnt(0)" ::: "memory");
    }
    ++epoch;
    __syncthreads();
}
DI void p0_transpose_item(const float* W, int ldw, int col0, bf16_t* WT, int K, int dst_row0, int kb, float scale, LAS float* scr, int lane) {
    const int k0 = 64 * kb;
#pragma unroll 8
    for (int i = 0; i < 32; ++i) { const int kk = 2 * i + (lane >> 5); scr[kk * 33 + (lane & 31)] = W[(size_t)(k0 + kk) * ldw + col0 + (lane & 31)] * scale; }
    LDS_WAIT(); asm volatile("" ::: "memory");
    const int c = lane & 7;
#pragma unroll
    for (int j = 0; j < 4; ++j) { const int n = (lane >> 3) + 8 * j; const LAS float* s = scr + (8 * c) * 33 + n;
        u32x4 o; o.x = pk2(s[0 * 33], s[1 * 33]); o.y = pk2(s[2 * 33], s[3 * 33]); o.z = pk2(s[4 * 33], s[5 * 33]); o.w = pk2(s[6 * 33], s[7 * 33]);
        *(u32x4*)(WT + (size_t)(dst_row0 + n) * K + k0 + 8 * c) = o; }
    LDS_WAIT(); asm volatile("" ::: "memory");
}


DI void p1_rows2(int m0, int m1, int lane, const float* __restrict__ xin, const float* __restrict__ MODp, bf16_t* __restrict__ H1p, float* __restrict__ GIFp, const float* __restrict__ bif, const LAS float* wif) {
    f32x4 v[2][4], scv[2][4], shv[2][4];
#pragma unroll
    for (int r = 0; r < 2; ++r) { const int m = r ? m1 : m0; const int b = m / SEQ;
        const f32x4* xr = (const f32x4*)(xin + (size_t)m * DM) + lane; const f32x4* sh = (const f32x4*)(MODp + (size_t)b * MODW) + lane; const f32x4* sc = (const f32x4*)(MODp + (size_t)b * MODW + DM) + lane;
#pragma unroll
        for (int j = 0; j < 4; ++j) { v[r][j] = xr[64 * j]; scv[r][j] = sc[64 * j]; shv[r][j] = sh[64 * j]; } }
#pragma unroll
    for (int r = 0; r < 2; ++r) { const int m = r ? m1 : m0; float s = 0.f;
#pragma unroll
        for (int j = 0; j < 4; ++j) s += (v[r][j].x + v[r][j].y) + (v[r][j].z + v[r][j].w);
        const float mean = wave_sum(s) * (1.f / DM); float s2 = 0.f;
#pragma unroll
        for (int j = 0; j < 4; ++j) { v[r][j] = v[r][j] - mean; s2 += (v[r][j].x * v[r][j].x + v[r][j].y * v[r][j].y) + (v[r][j].z * v[r][j].z + v[r][j].w * v[r][j].w); }
        const float rstd = rsqrtf(wave_sum(s2) * (1.f / DM) + LN_EPS);
        unsigned long long* o8 = (unsigned long long*)(H1p + (size_t)m * DM) + lane;
        float gp[8];
#pragma unroll
        for (int g = 0; g < 8; ++g) gp[g] = 0.f;
        const LAS float* wl = wif + 4 * lane; asm volatile("" : "+v"(wl));
#pragma unroll
        for (int j = 0; j < 4; ++j) { const f32x4 hh = v[r][j] * rstd * (scv[r][j] + 1.0f) + shv[r][j];
            o8[64 * j] = (unsigned long long)pk2(hh.x, hh.y) | ((unsigned long long)pk2(hh.z, hh.w) << 32);
#pragma unroll
            for (int g = 0; g < 8; ++g) { const f32x4 w = *(const LAS f32x4*)(wl + g * 1024 + 256 * j); gp[g] += (hh.x * w.x + hh.y * w.y) + (hh.z * w.z + hh.w * w.w); } }
#pragma unroll
        for (int g = 0; g < 8; ++g) gp[g] = wave_sum(gp[g]);
        if (lane == 0) {
#pragma unroll
            for (int g = 0; g < 8; ++g) GIFp[(size_t)m * 8 + g] = gp[g] + bif[g]; } }
}
template <int NR> DI void p7_rows(int m0, int lane, const bf16_t* __restrict__ Rp, const float* __restrict__ MODp, const float* __restrict__ g1, const float* __restrict__ b1,
                 bf16_t* __restrict__ H2p, unsigned char* __restrict__ H2Qp, float* __restrict__ SHp) {
    f32x4 v[NR][4], scv[4], shv[4];
    { const int b = m0 / SEQ; const f32x4* sh = (const f32x4*)(MODp + (size_t)b * MODW + 3 * DM) + lane; const f32x4* sc = (const f32x4*)(MODp + (size_t)b * MODW + 4 * DM) + lane;
#pragma unroll
      for (int r = 0; r < NR; ++r) { const u32x2* rr = (const u32x2*)(Rp + (size_t)(m0 + r) * DM) + lane;
#pragma unroll
        for (int j = 0; j < 4; ++j) { const u32x2 rw = rr[64 * j]; v[r][j] = (f32x4){bf_lo(rw.x), bf_hi(rw.x), bf_lo(rw.y), bf_hi(rw.y)}; } }
#pragma unroll
      for (int j = 0; j < 4; ++j) { scv[j] = sc[64 * j]; shv[j] = sh[64 * j]; } }
#pragma unroll
    for (int r = 0; r < NR; ++r) { const int m = m0 + r; float s = 0.f;
#pragma unroll
        for (int j = 0; j < 4; ++j) s += (v[r][j].x + v[r][j].y) + (v[r][j].z + v[r][j].w);
        float mean = wave_sum(s) * (1.f / DM); float s2 = 0.f;
#pragma unroll
        for (int j = 0; j < 4; ++j) { v[r][j] = v[r][j] - mean; s2 += (v[r][j].x * v[r][j].x + v[r][j].y * v[r][j].y) + (v[r][j].z * v[r][j].z + v[r][j].w * v[r][j].w); }
        float rstd = rsqrtf(wave_sum(s2) * (1.f / DM) + LN_EPS);
        s = 0.f;
#pragma unroll
        for (int j = 0; j < 4; ++j) { v[r][j] = v[r][j] * rstd * ((const f32x4*)g1)[lane + 64 * j] + ((const f32x4*)b1)[lane + 64 * j]; s += (v[r][j].x + v[r][j].y) + (v[r][j].z + v[r][j].w); }
        mean = wave_sum(s) * (1.f / DM); s2 = 0.f;
#pragma unroll
        for (int j = 0; j < 4; ++j) { v[r][j] = v[r][j] - mean; s2 += (v[r][j].x * v[r][j].x + v[r][j].y * v[r][j].y) + (v[r][j].z * v[r][j].z + v[r][j].w * v[r][j].w); }
        rstd = rsqrtf(wave_sum(s2) * (1.f / DM) + LN_EPS);
        unsigned long long* o8 = (unsigned long long*)(H2p + (size_t)m * DM) + lane;
        float amax = 0.f;
#pragma unroll
        for (int j = 0; j < 4; ++j) { const f32x4 hh = v[r][j] * rstd * (scv[j] + 1.0f) + shv[j]; o8[64 * j] = (unsigned long long)pk2(hh.x, hh.y) | ((unsigned long long)pk2(hh.z, hh.w) << 32);
            v[r][j] = hh; amax = fmaxf(amax, fmaxf(fmaxf(fabsf(hh.x), fabsf(hh.y)), fmaxf(fabsf(hh.z), fabsf(hh.w)))); }
        amax = wave_max(amax);
        const float qinv = amax > 0.f ? 119.0f / amax : 0.f;
        unsigned char* hq = H2Qp + (size_t)m * DM;
#pragma unroll
        for (int j = 0; j < 4; ++j) { const int q0 = (int)rintf(v[r][j].x * qinv), q1 = (int)rintf(v[r][j].y * qinv), q2 = (int)rintf(v[r][j].z * qinv), q3 = (int)rintf(v[r][j].w * qinv);
            const int a0 = (q0 + 8) >> 4, a1 = (q1 + 8) >> 4, a2 = (q2 + 8) >> 4, a3 = (q3 + 8) >> 4;
            const unsigned ha = (unsigned)(a0 & 15) | ((unsigned)(a1 & 15) << 4) | ((unsigned)(a2 & 15) << 8) | ((unsigned)(a3 & 15) << 12);
            const unsigned hb = (unsigned)((q0 - 16 * a0) & 15) | ((unsigned)((q1 - 16 * a1) & 15) << 4) | ((unsigned)((q2 - 16 * a2) & 15) << 8) | ((unsigned)((q3 - 16 * a3) & 15) << 12);
            const unsigned pa = (unsigned)dppi<0xB1>((int)ha), pb = (unsigned)dppi<0xB1>((int)hb);
            if (!(lane & 1)) { *(unsigned*)(hq + 128 * j + 2 * lane) = ha | (pa << 16); *(unsigned*)(hq + 512 + 128 * j + 2 * lane) = hb | (pb << 16); } }
        if (lane == 0) SHp[m] = amax * (1.0f / 119.0f); }
}


DI void prep_small_weights_item(LAS unsigned char* lds, int item, const float* w0, const float* w1, const float* w2, const float* w3, bf16_t* d0, bf16_t* d1, bf16_t* d2, bf16_t* d3) {
    int t = threadIdx.x; OPAQUE(t); const int lane = t & 63, wave = __builtin_amdgcn_readfirstlane(t >> 6);
    const int r = item * 8 + wave, wsel = r / 512, q = r % 512, kb = q / 32, nb = q % 32;
    const float* src = wsel == 0 ? w0 : wsel == 1 ? w1 : wsel == 2 ? w2 : w3; bf16_t* dst = wsel == 0 ? d0 : wsel == 1 ? d1 : wsel == 2 ? d2 : d3;
    p0_transpose_item(src, DM, 32 * nb, dst, DM, 32 * nb, kb, 1.0f, (LAS float*)(lds + wave * 16384), lane);
}
DI void prep_quant_item(int item, const float* pu, const float* pv, unsigned char* U8, unsigned char* V8, float* SU, float* SV) {
    int t = threadIdx.x; OPAQUE(t); const int lane = t & 63, wave = __builtin_amdgcn_readfirstlane(t >> 6);
#pragma unroll 1
    for (int it = 0; it < 4; ++it) { const int row0 = item * 128 + wave * 16 + it * 4;
        f32x4 a[4][4];
#pragma unroll
        for (int r = 0; r < 4; ++r) { const int row = row0 + r; const bool second = row >= NEXP; const int e = second ? row - NEXP : row;
            const float* s = (second ? pv : pu) + (size_t)e * DM + 16 * lane;
#pragma unroll
            for (int j = 0; j < 4; ++j) a[r][j] = *(const f32x4*)(s + 4 * j); }
#pragma unroll
        for (int r = 0; r < 4; ++r) { const int row = row0 + r; const bool second = row >= NEXP; const int e = second ? row - NEXP : row;
            float amax = 0.f;
#pragma unroll
            for (int j = 0; j < 4; ++j) amax = fmaxf(amax, fmaxf(fmaxf(fabsf(a[r][j].x), fabsf(a[r][j].y)), fmaxf(fabsf(a[r][j].z), fabsf(a[r][j].w))));
            amax = wave_max(amax);
            if (second) {
            const float inv = amax > 0.f ? 127.0f / amax : 0.f;
            u32x4 w;
#pragma unroll
            for (int j = 0; j < 4; ++j) { const int q0 = (int)rintf(a[r][j].x * inv), q1 = (int)rintf(a[r][j].y * inv), q2 = (int)rintf(a[r][j].z * inv), q3 = (int)rintf(a[r][j].w * inv);
                w[j] = (unsigned)(q0 & 255) | ((unsigned)(q1 & 255) << 8) | ((unsigned)(q2 & 255) << 16) | ((unsigned)(q3 & 255) << 24); }
            *(u32x4*)(V8 + (size_t)(lane >> 3) * NEXP * 128 + (size_t)e * 128 + (lane & 7) * 16) = w;
            if (lane == 0) SV[e] = amax * (1.0f / 127.0f);
            } else {
            const float inv = amax > 0.f ? 7.0f / amax : 0.f;
            u32x2 w;
#pragma unroll
            for (int j = 0; j < 4; ++j) { const unsigned n0 = (unsigned)((int)rintf(a[r][j].x * inv) & 15), n1 = (unsigned)((int)rintf(a[r][j].y * inv) & 15), n2 = (unsigned)((int)rintf(a[r][j].z * inv) & 15), n3 = (unsigned)((int)rintf(a[r][j].w * inv) & 15);
                const unsigned two = n0 | (n1 << 4) | (n2 << 8) | (n3 << 12);
                if (j & 1) w[j >> 1] |= two << 16; else w[j >> 1] = two; }
            *(u32x2*)(U8 + (size_t)(lane >> 4) * NEXP * 128 + (size_t)e * 128 + (lane & 15) * 8) = w;
            if (lane == 0) SU[e] = amax * (1.0f / 7.0f);
            } } }
}

struct Args { const float* in[22]; float* out; unsigned char* ws; int ph_lo, ph_hi; };

__global__ void __launch_bounds__(NWAVES * 64, 2) mega_fwd(Args args) {
    extern __shared__ __attribute__((aligned(16))) unsigned char lds_raw[];
    LAS unsigned char* lds = (LAS unsigned char*)lds_raw;
    volatile LAS unsigned* MISC = (volatile LAS unsigned*)(lds + MISC_OFF);
    const int tid = threadIdx.x, lane = tid & 63, wave = __builtin_amdgcn_readfirstlane(tid >> 6);
    const int G = gridDim.x; const int bx = blockIdx.x; const int vcu = (G % 8 == 0) ? (bx % 8) * (G / 8) + bx / 8 : bx;
    const int gw = vcu * NWAVES + wave, NGW = G * NWAVES;
#define ws (args.ws)
#define ctl ((unsigned*)(ws + WS_CTL))
#define x_in (args.in[0])
#define cvec (args.in[1])
#define w_ada (args.in[2])
#define b_ada (args.in[3])
#define w_in (args.in[4])
#define b_if (args.in[5])
#define conv_w (args.in[6])
#define conv_b (args.in[7])
#define da_lambda (args.in[8])
#define da_subln_g (args.in[9])
#define ml_norm_g (args.in[10])
#define w_br_attn (args.in[11])
#define w_br_mlstm (args.in[12])
#define w_out (args.in[13])
#define ln1_g (args.in[14])
#define ln1_b (args.in[15])
#define peer_wq (args.in[16])
#define peer_keys (args.in[17])
#define peer_u (args.in[18])
#define peer_v (args.in[19])
#define ln2_g (args.in[20])
#define ln2_b (args.in[21])
#define MOD ((float*)(ws + WS_MOD))
#define GIF ((float*)(ws + WS_GIF))
#define WIN ((bf16_t*)(ws + WS_WIN))
#define WA ((bf16_t*)(ws + WS_WA))
#define WM ((bf16_t*)(ws + WS_WM))
#define WOUT ((bf16_t*)(ws + WS_WOUT))
#define WQ ((bf16_t*)(ws + WS_WQ))
#define UT8 ((unsigned char*)(ws + WS_U))
#define VT8 ((unsigned char*)(ws + WS_V))
#define SUS ((float*)(ws + WS_SU))
#define SVS ((float*)(ws + WS_SV))
#define SHS ((float*)(ws + WS_SH))
#define CSS ((float*)(ws + WS_CS))
#define H2Q ((unsigned char*)(ws + WS_H2Q))
#define SELE ((bf16_t*)(ws + WS_SELE))
#define SELG ((float*)(ws + WS_SELG))
#define PART ((bf16_t*)(ws + WS_PART))
#define YFB ((bf16_t*)(ws + WS_YF))
#define COEF ((signed char*)(ws + WS_COEF))
#define H1 ((bf16_t*)(ws + WS_H1))
#define Z ((bf16_t*)(ws + WS_Z))
#define R ((bf16_t*)(ws + WS_R))
#define X1 ((float*)(ws + WS_X1))
#define H2 ((bf16_t*)(ws + WS_H2))
#define QP ((bf16_t*)(ws + WS_QP))
#define GATES ((bf16_t*)args.out)

    for (int u = tid; u < (LDS_BYTES - MISC_OFF) / 4; u += NWAVES * 64) MISC[u] = 0u;
    __syncthreads();
    XcdBarrier bar; bar.bar = ctl + CW_BAR; bar.x = 0; bar.st = nullptr;
    if (MK_N_LAUNCHES != N_PHASES) bar = xcd_barrier_post(ctl + CW_BAR, MISC + 8);
    const int lo = args.ph_lo, hi = args.ph_hi;
#ifndef PH_MASK
#define PH_MASK 0x3fff
#endif
#define IN(k) (((PH_MASK >> (k)) & 1) && lo <= (k) && (k) < hi)
    unsigned fepoch = 0; unsigned* fcnt = ctl + CW_QUEUE + 1024;
#if FLATBAR
#define GBAR() flat_barrier(fcnt, fepoch)
#else
#define GBAR() xcd_barrier(bar)
#endif
#define SEAM(k) do { if (IN(k) && IN((k) + 1)) GBAR(); } while (0)

#ifndef XBAR0
#define XBAR0 0
#endif
#if XBAR0
    if (IN(0)) for (int xb = 0; xb < XBAR0; ++xb) xcd_barrier(bar);
#endif
    if (IN(0)) {
        if (vcu * NWAVES < 96 * 8) {
            LAS float* sl = (LAS float*)lds;
            for (int i = tid; i < 32 * DM; i += NWAVES * 64) sl[i] = siluf_(cvec[i]);
            __syncthreads();
            for (int it = gw; it < 96 * 8; it += NGW) {
                const int cb = it % 96, ks = it / 96, col = 64 * cb + lane;
                float acc[32];
#pragma unroll
                for (int b = 0; b < 32; ++b) acc[b] = 0.f;
#pragma unroll 4
                for (int k = 128 * ks; k < 128 * ks + 128; ++k) { const float w = w_ada[(size_t)k * MODW + col];
#pragma unroll
                    for (int b = 0; b < 32; ++b) acc[b] += sl[b * DM + k] * w; }
                const float bias = (ks == 0) ? b_ada[col] : 0.f;
#pragma unroll
                for (int b = 0; b < 32; ++b) atomicAdd(MOD + b * MODW + col, acc[b] + bias);
            }
            __syncthreads();
        }
        LAS float* scr = (LAS float*)(lds + wave * 16384);
        const bool spare = NGW > 96 * 8 + 64; const int tw = spare ? gw - 96 * 8 : gw, ntw = spare ? NGW - 96 * 8 : NGW;
        if (tw >= 0) for (int it = tw; it < 4096; it += ntw) { const int kb = it / 256, nb = it % 256, n0 = 32 * nb; p0_transpose_item(w_in, IN_W, n0 < NZ ? n0 : n0 + 8, WIN, DM, n0, kb, n0 < 1024 ? QSCALE : 1.0f, scr, lane); }
    }
    SEAM(0);
    if (IN(1)) {
        LAS float* wif = (LAS float*)lds;
        for (int i = tid; i < 8192; i += 512) { const int k = i >> 3, j = i & 7; wif[j * 1024 + k] = w_in[(size_t)k * IN_W + NZ + j]; }
        __syncthreads();
        for (int m = gw; m < TOK; m += 2 * NGW) p1_rows2(m, m + NGW, lane, x_in, MOD, H1, GIF, b_if, wif);
    }
#if DUP1
    GBAR();
    if (IN(1)) {
        LAS float* wif = (LAS float*)lds;
        for (int i = tid; i < 8192; i += 512) { const int k = i >> 3, j = i & 7; wif[j * 1024 + k] = w_in[(size_t)k * IN_W + NZ + j]; }
        __syncthreads();
        for (int m = gw; m < TOK; m += 2 * NGW) p1_rows2(m, m + NGW, lane, x_in, MOD, H1, GIF, b_if, wif);
    }
#endif
    SEAM(1);
#ifndef DUP4
#define DUP4 0
#endif
#ifndef DUP6
#define DUP6 0
#endif
#ifndef DUP7
#define DUP7 0
#endif
#ifndef DUP8
#define DUP8 0
#endif
#ifndef DUP1
#define DUP1 0
#endif
#ifndef DUP2
#define DUP2 0
#endif
#ifndef DUP23
#define DUP23 0
#endif
#ifndef P2_STAGGER
#define P2_STAGGER 0
#endif
#define P2_BODY if (IN(2)) { if (P2_STAGGER && ((bx >> 3) & 1)) { const unsigned long long t0_ = __builtin_amdgcn_s_memrealtime(); while (__builtin_amdgcn_s_memrealtime() - t0_ < P2_STAGGER) __builtin_amdgcn_s_sleep(64); } \
        pg8::Gemm g{H1, WIN, TOK, NIN, DM, DM, DM}; pg8::StaticOrder S; S.init(TOK, NIN, G, bx); pg8::EpiZ E{Z, GATES}; \
        pg8::gemm_phase<pg8::EpiZ, pg8::StaticOrder, true, true>(lds, g, S, E); }
#define P3_BODY(QOFF) if (IN(3)) { unsigned* qhead = ctl + CW_QUEUE + (QOFF); int qx = (int)(bar.x & 7u), qtries = 0; const unsigned qlen = 16u + 256u + ((QOFF) == 0 ? 64u : 0u); \
        for (;;) { __syncthreads(); \
            if (tid == 0) { unsigned w = 0xffffffffu; while (qtries < 8) { const unsigned k = __hip_atomic_fetch_add(qhead + qx, 1u, RLX_AGENT); if (k < qlen) { w = ((unsigned)qx << 16) | k; break; } qx = (qx + 1) & 7; ++qtries; } MISC[0] = w; } \
            __syncthreads(); \
            const unsigned w = MISC[0]; if (w == 0xffffffffu) break; const int q = (int)(w >> 16), k = (int)(w & 0xffffu); \
            if (k < 16) { const int u = q * 16 + k; mls::mlstm_unit<false>(lds, Z, GIF, conv_w, conv_b, ml_norm_g, u >> 2, u & 3); } \
            else if (k < 272) { const int a = k - 16, a2 = a & 127, qb = ((a >> 7) ? 3 : 7) - (a2 & 3), bh = q * 32 + (a2 >> 2); datt::attn_unit<false>(lds, Z, da_lambda, da_subln_g, bh >> 3, bh & 7, qb); } \
            else { const int pid = q * 64 + (k - 272); \
                if (pid < 256) prep_quant_item(pid, peer_u, peer_v, UT8, VT8, SUS, SVS); \
                else prep_small_weights_item(lds, pid - 256, w_br_attn, w_br_mlstm, w_out, peer_wq, WA, WM, WOUT, WQ); } } }
#define P3A_DRY(QOFF) if (IN(3)) { unsigned* qhead = ctl + CW_QUEUE + (QOFF); \
        for (;;) { __syncthreads(); if (tid == 0) MISC[0] = __hip_atomic_fetch_add(qhead, 1u, RLX_AGENT); __syncthreads(); \
            const int id = (int)MISC[0]; if (id >= 2048) break; \
            { const int idx = id, qb = 7 - idx / 256, bh = idx % 256; datt::attn_unit<true>(lds, Z, da_lambda, da_subln_g, bh >> 3, bh & 7, qb); } } }
#define P3M_DRY(QOFF) if (IN(3)) { unsigned* qhead = ctl + CW_QUEUE + (QOFF); \
        for (;;) { __syncthreads(); if (tid == 0) MISC[0] = __hip_atomic_fetch_add(qhead, 1u, RLX_AGENT); __syncthreads(); \
            const int id = (int)MISC[0]; if (id >= 128) break; \
            mls::mlstm_unit<true, MLS_ABL>(lds, Z, GIF, conv_w, conv_b, ml_norm_g, id >> 2, id & 3); } }
#ifndef MLS_ABL
#define MLS_ABL 0
#endif
#ifndef DRY3A
#define DRY3A 0
#endif
#ifndef DRY3M
#define DRY3M 0
#endif
    P2_BODY
#if DUP2
    SEAM(2);
    P2_BODY
#endif
    SEAM(2);
#if DRY3A
    P3A_DRY(128)
    if (IN(3)) GBAR();
#endif
#if DRY3M
    P3M_DRY(192)
    if (IN(3)) GBAR();
#endif
    P3_BODY(0)
    SEAM(3);
#if DUP23
    P2_BODY
    SEAM(2);
    P3_BODY(64)
    SEAM(3);
#endif
    if (IN(4)) {
        pg8::Gemm g{Z + ZC_Q, WA, TOK, DM, DM, NZ, DM, (long)(ZC_MV - ZC_Q) * 2, (long)(WS_WM - WS_WA)}; pg8::StaticOrder2 S; S.init(TOK, DM, G, bx);
        pg8::EpiGate2 E{GATES, H1};
        pg8::gemm_phase<pg8::EpiGate2, pg8::StaticOrder2, true, true>(lds, g, S, E);
    }
    SEAM(4);
#define WG_SEAM() do { asm volatile("s_waitcnt vmcnt(0)" ::: "memory"); __syncthreads(); \
        if (tid == 0) { __builtin_amdgcn_fence(__ATOMIC_ACQUIRE, "agent"); asm volatile("s_waitcnt vmcnt(0)" ::: "memory"); } __syncthreads(); } while (0)
    if (IN(6)) {
        { pg8::Gemm g{H1, WOUT, TOK, DM, DM, DM, DM}; pg8::RowsOrder S; S.init(TOK, DM, G, bx);
          pg8::EpiR E{x_in, MOD, R};
          pg8::gemm_phase<pg8::EpiR, pg8::RowsOrder, true, true>(lds, g, S, E); }
        WG_SEAM();
        for (int pm = bx; pm < TOK / 256; pm += G)
#pragma unroll 1
            for (int k = 0; k < 8; ++k) p7_rows<4>(256 * pm + 32 * wave + 4 * k, lane, R, MOD, ln1_g, ln1_b, H2, H2Q, SHS);
        WG_SEAM();
        { pg8::Gemm g{H2, WQ, TOK, DM, DM, DM, DM}; pg8::RowsOrder S; S.init(TOK, DM, G, bx);
          pg8::EpiStore E{QP};
          pg8::gemm_phase<pg8::EpiStore, pg8::RowsOrder, true, true>(lds, g, S, E); }
        WG_SEAM();
        peer::stage_keys(lds, peer_keys);
        __syncthreads();
        for (int pm = bx; pm < TOK / 256; pm += G) peer::select_phase(lds, QP, 8 * pm, 1, 8 * pm + 8, SELE, SELG);
    }
#undef WG_SEAM
    if (IN(6) && IN(10)) GBAR();
    int sx = bx % 8, sr = bx / 8, sn = (G - sx + 7) / 8;
    if (IN(10) || IN(12)) {
        __syncthreads();
        if (tid == 0) { bool phys = (MK_N_LAUNCHES != N_PHASES) && lo == 0 && hi > 10; unsigned mine = 0;
            if (phys) { for (unsigned j = 0; j < 16; ++j) { const unsigned c = xb_ld(&bar.bar[XB_XCNT(j)]); if (j < 8) { if (c == 0u) phys = false; if (j == bar.x) mine = c; } else if (c != 0u) phys = false; } }
            MISC[16] = phys ? bar.x : (unsigned)sx; MISC[17] = phys ? MISC[10] : (unsigned)sr; MISC[18] = phys ? mine : (unsigned)sn; }
        __syncthreads();
        sx = (int)MISC[16]; sr = (int)MISC[17]; sn = (int)MISC[18];
    }
    if (IN(10)) {
        peer::u_phase(lds, 2 * sr + (sx >> 2), 2 * sn, sx & 3, SELE, H2Q, UT8, PART);
    }
    SEAM(10);
    if (IN(11)) { for (int m = 16 * gw; m < TOK; m += 16 * NGW) peer::red_tokens<16>((size_t)m, PART, SELE, SELG, SUS, SVS, SHS, COEF, CSS); }
    SEAM(11);
    if (IN(12)) {
        peer::v_phase(lds, sr, sn, sx, SELE, COEF, CSS, VT8, YFB);
    }
    SEAM(12);
    if (IN(13)) { for (int m = gw; m < TOK; m += 2 * NGW) peer::final_rows2((size_t)m, (size_t)m + NGW, R, YFB, MOD, ln1_g, ln1_b, ln2_g, ln2_b, args.out); }
#undef IN
#undef SEAM
#undef ws
#undef ctl
#undef x_in
#undef cvec
#undef w_ada
#undef b_ada
#undef w_in
#undef b_if
#undef conv_w
#undef conv_b
#undef da_lambda
#undef da_subln_g
#undef ml_norm_g
#undef w_br_attn
#undef w_br_mlstm
#undef w_out
#undef ln1_g
#undef ln1_b
#undef peer_wq
#undef peer_keys
#undef peer_u
#undef peer_v
#undef ln2_g
#undef ln2_b
#undef MOD
#undef GIF
#undef WIN
#undef WA
#undef WM
#undef WOUT
#undef WQ
#undef UT8
#undef VT8
#undef SUS
#undef SVS
#undef SHS
#undef CSS
#undef H2Q
#undef SELE
#undef SELG
#undef PART
#undef YFB
#undef COEF
#undef H1
#undef Z
#undef R
#undef X1
#undef H2
#undef QP
#undef GATES
}

extern "C" void kernel_launch(void* const* d_in, const int* in_sizes, int n_in, void* d_out, int out_size, void* d_ws, size_t ws_size, hipStream_t stream) {
    static int grid = 0;
    if (grid == 0) {
        if (n_in != 22 || in_sizes[0] != TOK * DM || out_size != TOK * DM || ws_size < WS_END) { fprintf(stderr, "kernel_launch: unexpected shapes (n_in %d, in0 %d, out %d, ws %zu; need ws >= %zu)\n", n_in, n_in > 0 ? in_sizes[0] : -1, out_size, ws_size, (size_t)WS_END); grid = -1; return; }
        int dev = 0, cus = 0, per_cu = 0;
        if (hipGetDevice(&dev) != hipSuccess || hipDeviceGetAttribute(&cus, hipDeviceAttributeMultiprocessorCount, dev) != hipSuccess) { fprintf(stderr, "kernel_launch: device query failed\n"); grid = -1; return; }
        if (hipFuncSetAttribute((const void*)mega_fwd, hipFuncAttributeMaxDynamicSharedMemorySize, LDS_BYTES) != hipSuccess) { fprintf(stderr, "kernel_launch: hipFuncSetAttribute failed\n"); grid = -1; return; }
        if (hipOccupancyMaxActiveBlocksPerMultiprocessor(&per_cu, (const void*)mega_fwd, NWAVES * 64, LDS_BYTES) != hipSuccess || per_cu < 1) fprintf(stderr, "kernel_launch: note: occupancy query reports %d workgroups per CU\n", per_cu);
        (void)hipGetLastError();
        grid = cus;
    }
    if (grid < 0) return;
    if (hipMemsetAsync((char*)d_ws + WS_CTL, 0, CTL_ZERO_BYTES, stream) != hipSuccess) { fprintf(stderr, "kernel_launch: memset failed\n"); return; }
    Args a{};
    for (int i = 0; i < 22; ++i) a.in[i] = (const float*)d_in[i];
    a.out = (float*)d_out; a.ws = (unsigned char*)d_ws;
    for (int li = 0; li < MK_N_LAUNCHES; ++li) {
        a.ph_lo = (MK_N_LAUNCHES == N_PHASES) ? li : 0; a.ph_hi = (MK_N_LAUNCHES == N_PHASES) ? li + 1 : N_PHASES;
        hipLaunchKernelGGL(mega_fwd, dim3(grid), dim3(NWAVES * 64), LDS_BYTES, stream, a);
        const hipError_t le = hipPeekAtLastError();
        if (le != hipSuccess) { fprintf(stderr, "kernel_launch: launch %d failed: %s\n", li, hipGetErrorName(le)); break; }
    }
}
```

```cpp
#include <hip/hip_runtime.h>
#include <hip/hip_bf16.h>
#include <cstdio>
#include <cstdint>
#include <cmath>

#define LAS __attribute__((address_space(3)))
#define GAS __attribute__((address_space(1)))
typedef unsigned short bf16_t;
typedef short bf16x8 __attribute__((ext_vector_type(8)));
typedef short s16x4 __attribute__((ext_vector_type(4)));
typedef float f32x2 __attribute__((ext_vector_type(2)));
typedef float f32x4 __attribute__((ext_vector_type(4)));
typedef float f32x16 __attribute__((ext_vector_type(16)));
typedef unsigned u32x2 __attribute__((ext_vector_type(2)));
typedef unsigned u32x4 __attribute__((ext_vector_type(4)));
typedef __bf16 bf16x2_t __attribute__((ext_vector_type(2)));
#define DI __device__ __forceinline__

constexpr int BATCH = 32, SEQ = 2048, DM = 1024, TOK = BATCH * SEQ;
constexpr int NZ = 6144;
constexpr int ZC_Q = 0, ZC_K = 1024, ZC_V = 2048, ZC_MQ = 3072, ZC_MK = 3584, ZC_MV = 4096, ZC_MO = 5120;
constexpr int NGATE = 2048;
constexpr int NIN = 8192;
constexpr int IN_W = 8200;
constexpr int MODW = 6 * DM;
constexpr float LN_EPS = 1e-5f;
constexpr float ALPHA_RES = 1.189207115002721f;
constexpr float LAMBDA_INIT = 0.2f;
constexpr float QSCALE = 0.125f * 1.4426950408889634f;
constexpr int NEXP = 16384;

constexpr size_t MiB = 1u << 20;
constexpr size_t WS_CTL = 0, CTL_ZERO_BYTES = 2 * MiB;
constexpr size_t WS_MOD = 1 * MiB;
constexpr size_t WS_GIF = 3 * MiB;
constexpr size_t WS_WIN = 6 * MiB;
constexpr size_t WS_WA = 22 * MiB, WS_WM = 24 * MiB, WS_WOUT = 26 * MiB, WS_WQ = 28 * MiB;
constexpr size_t WS_U = 30 * MiB, WS_V = 62 * MiB;
constexpr size_t WS_SU = 2 * MiB, WS_SV = 2 * MiB + 65536, WS_SH = 2 * MiB + 131072, WS_CS = 2 * MiB + 393216;
constexpr size_t WS_H2Q = 352 * MiB, WS_SELE = 416 * MiB, WS_SELG = 432 * MiB;
constexpr size_t WS_H1 = 96 * MiB;
constexpr size_t WS_Z = 224 * MiB;
constexpr size_t WS_R = WS_Z, WS_X1 = WS_Z + 256 * MiB, WS_H2 = WS_Z + 512 * MiB, WS_QP = WS_Z + 640 * MiB;
constexpr size_t WS_PART = WS_X1, WS_COEF = WS_H2, WS_YF = WS_QP;
constexpr size_t WS_PART_UNUSED = 0, WS_COEF_UNUSED = 0;
constexpr size_t WS_END = 992 * MiB;
constexpr int CW_BAR = 4096;
constexpr int CW_QUEUE = 16384;

DI unsigned pk2(float lo, float hi) { f32x2 v = {lo, hi}; bf16x2_t b = __builtin_convertvector(v, bf16x2_t); return __builtin_bit_cast(unsigned, b); }
DI float bf_lo(unsigned u) { return __uint_as_float(u << 16); }
DI float bf_hi(unsigned u) { return __uint_as_float(u & 0xffff0000u); }
DI float bf2f(bf16_t h) { return __uint_as_float(((unsigned)h) << 16); }
template <int CTRL> DI float dppf(float v) { return __builtin_bit_cast(float, __builtin_amdgcn_update_dpp(0, __builtin_bit_cast(int, v), CTRL, 0xF, 0xF, true)); }
DI float row_sum16(float v) { v += dppf<0xB1>(v); v += dppf<0x4E>(v); v += dppf<0x141>(v); v += dppf<0x140>(v); return v; }
DI float row_max16(float v) { v = fmaxf(v, dppf<0xB1>(v)); v = fmaxf(v, dppf<0x4E>(v)); v = fmaxf(v, dppf<0x141>(v)); v = fmaxf(v, dppf<0x140>(v)); return v; }
template <int CTRL> DI int dppi(int v) { return __builtin_amdgcn_update_dpp(0, v, CTRL, 0xF, 0xF, true); }
DI float sum32x(float v) { auto rr = __builtin_amdgcn_permlane32_swap(__builtin_bit_cast(unsigned, v), __builtin_bit_cast(unsigned, v), false, false); return __builtin_bit_cast(float, (unsigned)rr[0]) + __builtin_bit_cast(float, (unsigned)rr[1]); }
DI float max32x(float v) { auto rr = __builtin_amdgcn_permlane32_swap(__builtin_bit_cast(unsigned, v), __builtin_bit_cast(unsigned, v), false, false); return fmaxf(__builtin_bit_cast(float, (unsigned)rr[0]), __builtin_bit_cast(float, (unsigned)rr[1])); }
DI int isum32x(int v) { auto rr = __builtin_amdgcn_permlane32_swap((unsigned)v, (unsigned)v, false, false); return (int)rr[0] + (int)rr[1]; }
DI unsigned partner32(unsigned v, int hi) { auto rr = __builtin_amdgcn_permlane32_swap(v, v, false, false); return hi ? (unsigned)rr[0] : (unsigned)rr[1]; }
DI float rdlane(float v, int l) { return __builtin_bit_cast(float, __builtin_amdgcn_readlane(__builtin_bit_cast(int, v), l)); }
DI float wave_sum(float v) { v = row_sum16(v); return (rdlane(v, 0) + rdlane(v, 16)) + (rdlane(v, 32) + rdlane(v, 48)); }
DI float wave_max(float v) { v = row_max16(v); return fmaxf(fmaxf(rdlane(v, 0), rdlane(v, 16)), fmaxf(rdlane(v, 32), rdlane(v, 48))); }
DI float half_sum32(float v) { v = row_sum16(v); return v + __builtin_bit_cast(float, __builtin_amdgcn_ds_swizzle(__builtin_bit_cast(int, v), 0x401F)); }
DI float sigmoidf_(float x) { return __builtin_amdgcn_rcpf(1.0f + __builtin_amdgcn_exp2f(x * -1.4426950408889634f)); }
DI float siluf_(float x) { return x * __builtin_amdgcn_rcpf(1.0f + __builtin_amdgcn_exp2f(x * -1.4426950408889634f)); }
DI int crow(int r, int hi) { return (r & 3) + 8 * (r >> 2) + 4 * hi; }
#define MFMA32(a, b, c) __builtin_amdgcn_mfma_f32_32x32x16_bf16((a), (b), (c), 0, 0, 0)
DI bf16x8 pack_step(const f32x16& x, int s) {
    u32x4 p;
    p[0] = pk2(x[8 * s + 0], x[8 * s + 1]); p[1] = pk2(x[8 * s + 2], x[8 * s + 3]); p[2] = pk2(x[8 * s + 4], x[8 * s + 5]); p[3] = pk2(x[8 * s + 6], x[8 * s + 7]);
    return __builtin_bit_cast(bf16x8, p);
}
DI unsigned off_b(unsigned row, unsigned ch) { return 256u * row + 16u * (ch ^ (((row & 3) << 2) | ((row >> 2) & 3))); }
DI unsigned row_read_addr(unsigned lane, unsigned rt, unsigned s) { return off_b(32 * rt + (lane & 31), 2 * s + (lane >> 5)); }
DI unsigned tr_read_addr(unsigned lane, unsigned c, unsigned ks, unsigned t) {
    const unsigned h = lane >> 5, blk = (lane >> 4) & 1, q = (lane & 15) >> 2, p = lane & 3;
    return off_b(16 * ks + 8 * h + 4 * t + q, 4 * c + 2 * blk + (p >> 1)) + 8 * (p & 1);
}
DI unsigned tr_base(unsigned lane, unsigned t) { const unsigned h = lane >> 5, blk = (lane >> 4) & 1, q = (lane & 15) >> 2, p = lane & 3, cl = 2 * blk + (p >> 1);
    return 256u * (8 * h + 4 * t + q) + 16u * (cl ^ (2 * h + t)) + 8u * (p & 1); }
#define OPAQUE(x) asm volatile("" : "+v"(x))
#define OPAQUE(x) asm volatile("" : "+v"(x))
typedef short v4i16_t __attribute__((ext_vector_type(4)));
DI s16x4 tr_read(const LAS unsigned char* p) { return __builtin_bit_cast(s16x4, __builtin_amdgcn_ds_read_tr16_b64_v4i16((LAS v4i16_t*)p)); }
DI bf16x8 cat8(s16x4 lo, s16x4 hi) { return __builtin_shufflevector(lo, hi, 0, 1, 2, 3, 4, 5, 6, 7); }
namespace pg8 {
#define PG8_LAS __attribute__((address_space(3)))
typedef unsigned short bf16_t;
typedef short bf16x8 __attribute__((ext_vector_type(8)));
typedef float f32x4 __attribute__((ext_vector_type(4)));
typedef unsigned u32x4 __attribute__((ext_vector_type(4)));
constexpr int BM = 256, BK = 64, HALF = 128, HTB = HALF * BK * 2  , STAGE_BYTES = 8 * HTB, NXCD = 8, WGM = 8;

__host__ __device__ __forceinline__ int lds_byte(int r, int c) { const int st = (r >> 4) * 2 + (c >> 5), rr = r & 15, cc = c & 31, ob = rr * 64 + cc * 2; return st * 1024 + (ob ^ (((ob >> 9) & 1) << 5)); }
__host__ __device__ __forceinline__ void stage_rc(int b, int& R, int& C) { const int st = b / 1024, sb = b % 1024, swz = sb ^ (((sb >> 9) & 1) << 5); R = (st >> 1) * 16 + swz / 64; C = (st & 1) * 32 + (swz % 64) / 2; }
__host__ __device__ __forceinline__ int perm32(int rho) { const int n = rho >> 4, i = rho & 15; return 8 * (i >> 2) + 4 * n + (i & 3); }

struct Unit { int pm, pn, ph; };
struct Gemm { const bf16_t* A; const bf16_t* Bt; int M, N, K, lda, ldb; long jA, jB; };

struct StaticOrder {
    int nM, nN, nwg, G, c;
    __host__ __device__ void init(int M, int N, int G_, int c_) { nM = M / BM; nN = N / BM; nwg = nM * nN; G = G_; c = c_; }
    __host__ __device__ bool next(int i, Unit& u) const {
        const long L = (long)i * G + c; if (L >= nwg) return false;
        int wgid = (int)L; { const int q = nwg / NXCD, r = nwg % NXCD, xcd = wgid % NXCD, off = wgid / NXCD; wgid = (xcd < r ? xcd * (q + 1) : r * (q + 1) + (xcd - r) * q) + off; }
        const int nig = WGM * nN, gid = wgid / nig, fm = gid * WGM, gsz = (nM - fm) < WGM ? (nM - fm) : WGM;
        u.pm = fm + ((wgid % nig) % gsz); u.pn = (wgid % nig) / gsz; u.ph = 0; return true;
    }
    __device__ __forceinline__ void a_ready(const Unit&) const {}
    __device__ __forceinline__ void done(const Unit&) const {}
};
struct RowsOrder {
    int nM, nN, G, c;
    __host__ __device__ void init(int M, int N, int G_, int c_) { nM = M / BM; nN = N / BM; G = G_; c = c_; }
    __host__ __device__ bool next(int i, Unit& u) const { const int pm = c + (i / nN) * G; if (pm >= nM) return false; u.pm = pm; u.pn = i % nN; u.ph = 0; return true; }
    __device__ __forceinline__ void a_ready(const Unit&) const {}
    __device__ __forceinline__ void done(const Unit&) const {}
};
struct RowsOrder2 {
    RowsOrder base;
    __host__ __device__ void init(int M, int N, int G_, int c_) { base.init(M, N, G_, c_); }
    __host__ __device__ bool next(int i, Unit& u) const { if (!base.next(i >> 1, u)) return false; u.ph = i & 1; return true; }
    __device__ __forceinline__ void a_ready(const Unit&) const {}
    __device__ __forceinline__ void done(const Unit&) const {}
};
struct StaticOrder2 {
    StaticOrder base;
    __host__ __device__ void init(int M, int N, int G_, int c_) { base.init(M, N, G_, c_); }
    __host__ __device__ bool next(int i, Unit& u) const { if (!base.next(i >> 1, u)) return false; u.ph = i & 1; return true; }
    __device__ __forceinline__ void a_ready(const Unit&) const {}
    __device__ __forceinline__ void done(const Unit&) const {}
};
template <class Epi, class Sched, bool ALIGN_EPI = false, bool SP2 = false>
__device__ __forceinline__ void gemm_phase(PG8_LAS unsigned char* lds, const Gemm g, const Sched& S, const Epi& E) {
    const int tid = threadIdx.x, wid = __builtin_amdgcn_readfirstlane(tid >> 6), lane = tid & 63, wr = wid >> 2, wc = wid & 3, fr = lane & 15, fq = lane >> 4;
    const int K = g.K, nt = K / BK;
    unsigned voffA[2], voffB[2];
#pragma unroll
    for (int i = 0; i < 2; ++i) { int R, C; stage_rc(tid * 16 + i * 8192, R, C); const int Rb = Epi::PERM ? ((R & ~31) + perm32(R & 31)) : R;
        voffA[i] = (unsigned)(R * g.lda + C) * 2u; voffB[i] = (unsigned)(Rb * g.ldb + C) * 2u; }
    const size_t kstep = (size_t)(BK * 2);
    const size_t hstepA = (size_t)HALF * g.lda * 2, hstepB = (size_t)HALF * g.ldb * 2;
    const size_t tstepA = 2 * hstepA, tstepB = 2 * hstepB;
    const unsigned ldsw = (unsigned)wid * 1024u;
    const int aoff = lds_byte(wr * 64 + fr, fq * 8), boff = lds_byte(wc * 32 + fr, fq * 8);
#define PG8_SA(b, h) (((b) * 2 + (h)) * HTB)
#define PG8_SB(b, h) ((4 + (b) * 2 + (h)) * HTB)
#define PG8_STAGE(bufoff, gbase, voff) do { _Pragma("unroll") for (int _i = 0; _i < 2; ++_i) \
        __builtin_amdgcn_global_load_lds((const unsigned*)((const char*)(gbase) + (voff)[_i]), (PG8_LAS unsigned*)(lds + (bufoff) + ldsw + _i * 8192), 16, 0, 0); } while (0)
#define PG8_LDA(dst, b, h) do { _Pragma("unroll") for (int m = 0; m < 4; ++m) _Pragma("unroll") for (int k = 0; k < 2; ++k) dst[m][k] = *(const PG8_LAS bf16x8*)(lds + PG8_SA(b, h) + aoff + m * 2048 + k * 1024); } while (0)
#define PG8_LDB(dst, b, h) do { _Pragma("unroll") for (int n = 0; n < 2; ++n) _Pragma("unroll") for (int k = 0; k < 2; ++k) dst[n][k] = *(const PG8_LAS bf16x8*)(lds + PG8_SB(b, h) + boff + n * 2048 + k * 1024); } while (0)
#define PG8_MMA(ai, bj, At, Bt) do { __builtin_amdgcn_s_setprio(1); _Pragma("unroll") for (int m = 0; m < 4; ++m) _Pragma("unroll") for (int n = 0; n < 2; ++n) _Pragma("unroll") for (int k = 0; k < 2; ++k) \
        acc[ai][bj][m][n] = __builtin_amdgcn_mfma_f32_16x16x32_bf16(Bt[n][k], At[m][k], acc[ai][bj][m][n], 0, 0, 0); __builtin_amdgcn_s_setprio(0); } while (0)
#define PG8_WAIT_V(n) asm volatile("s_waitcnt vmcnt(" #n ")" ::: "memory")
#define PG8_WAIT_L(n) asm volatile("s_waitcnt lgkmcnt(" #n ")" ::: "memory")
#define PG8_BAR __builtin_amdgcn_s_barrier()
#define PG8_SCHED __builtin_amdgcn_sched_barrier(0)
    Unit cur, nxt; int ui = 0;
    if (!S.next(0, cur)) return;
    f32x4 acc[2][2][4][2];
#pragma unroll
    for (int a = 0; a < 2; ++a)
#pragma unroll
        for (int b = 0; b < 2; ++b)
#pragma unroll
            for (int m = 0; m < 4; ++m)
#pragma unroll
                for (int n = 0; n < 2; ++n) acc[a][b][m][n] = (f32x4){0.f, 0.f, 0.f, 0.f};
    bf16x8 At[4][2], B0[2][2], B1[2][2];
    const char* cA = (const char*)g.A + (size_t)cur.pm * tstepA + cur.ph * g.jA; const char* cB = (const char*)g.Bt + (size_t)cur.pn * tstepB + cur.ph * g.jB;
    S.a_ready(cur);
    if constexpr (SP2) {
        PG8_STAGE(PG8_SB(0, 0), cB, voffB); PG8_STAGE(PG8_SB(0, 1), cB + hstepB, voffB); PG8_STAGE(PG8_SA(0, 0), cA, voffA); PG8_STAGE(PG8_SA(0, 1), cA + hstepA, voffA);
        if (wr == 1) PG8_BAR;
        PG8_WAIT_V(2); PG8_BAR;
        PG8_STAGE(PG8_SB(1, 0), cB + kstep, voffB); PG8_STAGE(PG8_SA(1, 0), cA + kstep, voffA); PG8_STAGE(PG8_SB(1, 1), cB + hstepB + kstep, voffB);
        PG8_WAIT_V(6); PG8_BAR;
    } else {
        PG8_STAGE(PG8_SB(0, 0), cB, voffB); PG8_STAGE(PG8_SA(0, 0), cA, voffA); PG8_STAGE(PG8_SB(0, 1), cB + hstepB, voffB); PG8_STAGE(PG8_SA(0, 1), cA + hstepA, voffA);
        if (wr == 1) PG8_BAR;
        PG8_WAIT_V(4); PG8_BAR;
        PG8_STAGE(PG8_SB(1, 0), cB + kstep, voffB); PG8_STAGE(PG8_SA(1, 0), cA + kstep, voffA); PG8_STAGE(PG8_SB(1, 1), cB + hstepB + kstep, voffB);
        PG8_WAIT_V(6); PG8_BAR;
    }
    for (;;) {
        const bool has_next = S.next(ui + 1, nxt);
        const char* nA = has_next ? (const char*)g.A + (size_t)nxt.pm * tstepA + nxt.ph * g.jA : cA; const char* nB = has_next ? (const char*)g.Bt + (size_t)nxt.pn * tstepB + nxt.ph * g.jB : cB;
        for (int t = 0; t < nt; t += 2) {
            const bool last = (t == nt - 2);
            const char* a1 = cA + (size_t)(t + 1) * kstep;
            const char* a2 = last ? nA : cA + (size_t)(t + 2) * kstep; const char* b2 = last ? nB : cB + (size_t)(t + 2) * kstep;
            const char* a3 = a2 + kstep; const char* b3 = b2 + kstep;
            if (last && has_next) S.a_ready(nxt);
            if constexpr (SP2) {
            PG8_LDB(B0, 0, 0); PG8_LDB(B1, 0, 1); PG8_SCHED; PG8_LDA(At, 0, 0); PG8_STAGE(PG8_SA(1, 1), a1 + hstepA, voffA);
            PG8_WAIT_V(8); PG8_WAIT_L(0); PG8_BAR; PG8_MMA(0, 0, At, B0); PG8_MMA(0, 1, At, B1); PG8_BAR; PG8_SCHED;
            PG8_LDA(At, 0, 1); PG8_STAGE(PG8_SB(0, 0), b2, voffB); PG8_STAGE(PG8_SB(0, 1), b2 + hstepB, voffB); PG8_STAGE(PG8_SA(0, 0), a2, voffA);
            PG8_WAIT_V(8); PG8_WAIT_L(0); PG8_BAR; PG8_MMA(1, 0, At, B0); PG8_MMA(1, 1, At, B1); PG8_BAR; PG8_SCHED;
            PG8_LDB(B0, 1, 0); PG8_LDB(B1, 1, 1); PG8_SCHED; PG8_LDA(At, 1, 0); PG8_STAGE(PG8_SA(0, 1), a2 + hstepA, voffA);
            PG8_WAIT_V(8); PG8_WAIT_L(0); PG8_BAR; PG8_MMA(0, 0, At, B0); PG8_MMA(0, 1, At, B1); PG8_BAR; PG8_SCHED;
            PG8_LDA(At, 1, 1); PG8_STAGE(PG8_SB(1, 0), b3, voffB); PG8_STAGE(PG8_SB(1, 1), b3 + hstepB, voffB); PG8_STAGE(PG8_SA(1, 0), a3, voffA);
            PG8_WAIT_V(8); PG8_WAIT_L(0); PG8_BAR; PG8_MMA(1, 0, At, B0); PG8_MMA(1, 1, At, B1); PG8_BAR; PG8_SCHED;
            } else {
            PG8_LDB(B0, 0, 0); PG8_SCHED; PG8_LDA(At, 0, 0); PG8_STAGE(PG8_SA(1, 1), a1 + hstepA, voffA);
            PG8_WAIT_L(8); PG8_BAR; PG8_WAIT_L(0); PG8_MMA(0, 0, At, B0); PG8_BAR; PG8_SCHED;
            PG8_LDB(B1, 0, 1); PG8_STAGE(PG8_SB(0, 0), b2, voffB);
            PG8_BAR; PG8_WAIT_L(0); PG8_MMA(0, 1, At, B1); PG8_BAR;
            PG8_LDA(At, 0, 1); PG8_STAGE(PG8_SA(0, 0), a2, voffA);
            PG8_BAR; PG8_WAIT_L(0); PG8_MMA(1, 0, At, B0); PG8_BAR; PG8_SCHED;
            PG8_STAGE(PG8_SB(0, 1), b2 + hstepB, voffB);
            PG8_WAIT_V(6); PG8_BAR; PG8_MMA(1, 1, At, B1); PG8_BAR;
            PG8_LDB(B0, 1, 0); PG8_SCHED; PG8_LDA(At, 1, 0); PG8_STAGE(PG8_SA(0, 1), a2 + hstepA, voffA);
            PG8_WAIT_L(8); PG8_BAR; PG8_WAIT_L(0); PG8_MMA(0, 0, At, B0); PG8_BAR; PG8_SCHED;
            PG8_LDB(B1, 1, 1); PG8_STAGE(PG8_SB(1, 0), b3, voffB);
            PG8_BAR; PG8_WAIT_L(0); PG8_MMA(0, 1, At, B1); PG8_BAR;
            PG8_LDA(At, 1, 1); PG8_STAGE(PG8_SA(1, 0), a3, voffA);
            PG8_BAR; PG8_WAIT_L(0); PG8_MMA(1, 0, At, B0); PG8_BAR; PG8_SCHED;
            PG8_STAGE(PG8_SB(1, 1), b3 + hstepB, voffB);
            PG8_WAIT_V(6); PG8_BAR; PG8_MMA(1, 1, At, B1); PG8_BAR;
            }
        }
        if constexpr (ALIGN_EPI) { if (wr == 0) PG8_BAR; }
        bool keep_acc = false;
        if constexpr (Epi::HAS_MID) { keep_acc = (cur.ph == 0) && has_next; }
        if constexpr (!Epi::AFTER_DRAIN) { if constexpr (Epi::HAS_MID) { if (keep_acc) E.mid(acc, cur, wr, wc, fr, fq); else E(acc, cur, wr, wc, fr, fq); } else E(acc, cur, wr, wc, fr, fq); S.done(cur); }
        if (!has_next) break;
        if (!keep_acc)
#pragma unroll
        for (int a = 0; a < 2; ++a)
#pragma unroll
            for (int b = 0; b < 2; ++b)
#pragma unroll
                for (int m = 0; m < 4; ++m)
#pragma unroll
                    for (int n = 0; n < 2; ++n) acc[a][b][m][n] = (f32x4){0.f, 0.f, 0.f, 0.f};
        cur = nxt; cA = nA; cB = nB; ++ui;
        if constexpr (ALIGN_EPI) { if (wr == 1) PG8_BAR; }
    }
    PG8_WAIT_V(0);
    if constexpr (!ALIGN_EPI) { if (wr == 0) PG8_BAR; }
    PG8_BAR;
    if constexpr (Epi::AFTER_DRAIN) { E.fused(acc, cur, wr, wc, fr, fq, lds, wid, lane); S.done(cur); }
#undef PG8_SA
#undef PG8_SB
#undef PG8_STAGE
#undef PG8_LDA
#undef PG8_LDB
#undef PG8_MMA
#undef PG8_WAIT_V
#undef PG8_WAIT_L
#undef PG8_BAR
#undef PG8_SCHED
}
}
namespace pg8 {
struct EpiZ {
    static constexpr bool PERM = true, AFTER_DRAIN = false, HAS_MID = false;
    bf16_t* Z; bf16_t* G;
    __device__ __forceinline__ void operator()(const f32x4 (&acc)[2][2][4][2], const Unit& u, int wr, int wc, int fr, int fq) const {
        const int row0 = u.pm * BM + wr * 64 + fr, colt = u.pn * BM; const bool gate = colt >= NZ, sig_o = colt >= ZC_MO && colt < ZC_MO + 1024;
        bf16_t* base = gate ? G : Z; const int ld = gate ? NGATE : NZ; const int col0 = (gate ? colt - NZ : colt) + wc * 32 + 8 * fq;
#pragma unroll
        for (int ai = 0; ai < 2; ++ai)
#pragma unroll
            for (int m = 0; m < 4; ++m) { bf16_t* rowp = base + (size_t)(row0 + ai * HALF + m * 16) * ld + col0;
#pragma unroll
                for (int bj = 0; bj < 2; ++bj) { f32x4 v0 = acc[ai][bj][m][0], v1 = acc[ai][bj][m][1];
                    if (gate || sig_o) {
#pragma unroll
                        for (int e = 0; e < 4; ++e) { v0[e] = sigmoidf_(v0[e]); v1[e] = sigmoidf_(v1[e]); } }
                    ::u32x4 w; w.x = pk2(v0[0], v0[1]); w.y = pk2(v0[2], v0[3]); w.z = pk2(v1[0], v1[1]); w.w = pk2(v1[2], v1[3]);
                    *(::u32x4*)(rowp + bj * HALF) = w; } }
    }
};
template <bool FIRST> struct EpiGate {
    static constexpr bool PERM = true, AFTER_DRAIN = false, HAS_MID = false;
    const bf16_t* G; bf16_t* Y;
    __device__ __forceinline__ void operator()(const f32x4 (&acc)[2][2][4][2], const Unit& u, int wr, int wc, int fr, int fq) const {
        const int row0 = u.pm * BM + wr * 64 + fr, col0 = u.pn * BM + wc * 32 + 8 * fq;
#pragma unroll
        for (int ai = 0; ai < 2; ++ai)
#pragma unroll
            for (int m = 0; m < 4; ++m) { const size_t row = (size_t)(row0 + ai * HALF + m * 16);
#pragma unroll
                for (int bj = 0; bj < 2; ++bj) { const f32x4 v0 = acc[ai][bj][m][0], v1 = acc[ai][bj][m][1];
                    const ::u32x4 g = *(const ::u32x4*)(G + row * NGATE + col0 + bj * HALF);
                    float o[8] = { bf_lo(g.x) * v0[0], bf_hi(g.x) * v0[1], bf_lo(g.y) * v0[2], bf_hi(g.y) * v0[3], bf_lo(g.z) * v1[0], bf_hi(g.z) * v1[1], bf_lo(g.w) * v1[2], bf_hi(g.w) * v1[3] };
                    bf16_t* yp = Y + row * DM + col0 + bj * HALF;
                    if (!FIRST) { const ::u32x4 y = *(const ::u32x4*)yp;
                        o[0] += bf_lo(y.x); o[1] += bf_hi(y.x); o[2] += bf_lo(y.y); o[3] += bf_hi(y.y); o[4] += bf_lo(y.z); o[5] += bf_hi(y.z); o[6] += bf_lo(y.w); o[7] += bf_hi(y.w); }
                    ::u32x4 w; w.x = pk2(o[0], o[1]); w.y = pk2(o[2], o[3]); w.z = pk2(o[4], o[5]); w.w = pk2(o[6], o[7]);
                    *(::u32x4*)yp = w; } }
    }
};
struct EpiR {
    static constexpr bool PERM = true, AFTER_DRAIN = false, HAS_MID = false;
    const float* X; const float* MOD; bf16_t* R;
    __device__ __forceinline__ void operator()(const f32x4 (&acc)[2][2][4][2], const Unit& u, int wr, int wc, int fr, int fq) const {
        const int row0 = u.pm * BM + wr * 64 + fr, col0 = u.pn * BM + wc * 32 + 8 * fq;
        const float* gt = MOD + (size_t)((u.pm * BM) / SEQ) * MODW + 2 * DM;
        f32x4 g[2][2];
#pragma unroll
        for (int bj = 0; bj < 2; ++bj) { g[bj][0] = *(const f32x4*)(gt + col0 + bj * HALF); g[bj][1] = *(const f32x4*)(gt + col0 + bj * HALF + 4); }
#pragma unroll
        for (int ai = 0; ai < 2; ++ai) {
            f32x4 xv[4][2][2];
#pragma unroll
            for (int m = 0; m < 4; ++m) { const size_t off = (size_t)(row0 + ai * HALF + m * 16) * DM + col0;
#pragma unroll
                for (int bj = 0; bj < 2; ++bj) { xv[m][bj][0] = *(const f32x4*)(X + off + bj * HALF); xv[m][bj][1] = *(const f32x4*)(X + off + bj * HALF + 4); } }
            __builtin_amdgcn_sched_barrier(0);
#pragma unroll
            for (int m = 0; m < 4; ++m) { const size_t off = (size_t)(row0 + ai * HALF + m * 16) * DM + col0;
#pragma unroll
                for (int bj = 0; bj < 2; ++bj) {
                    const f32x4 r0 = xv[m][bj][0] * ALPHA_RES + g[bj][0] * acc[ai][bj][m][0], r1 = xv[m][bj][1] * ALPHA_RES + g[bj][1] * acc[ai][bj][m][1];
                    ::u32x4 w; w.x = pk2(r0[0], r0[1]); w.y = pk2(r0[2], r0[3]); w.z = pk2(r1[0], r1[1]); w.w = pk2(r1[2], r1[3]);
                    *(::u32x4*)(R + off + bj * HALF) = w; } }
            __builtin_amdgcn_sched_barrier(0);
        }
    }
};
struct EpiStore {
    static constexpr bool PERM = true, AFTER_DRAIN = false, HAS_MID = false;
    bf16_t* O;
    __device__ __forceinline__ void operator()(const f32x4 (&acc)[2][2][4][2], const Unit& u, int wr, int wc, int fr, int fq) const {
        const int row0 = u.pm * BM + wr * 64 + fr, col0 = u.pn * BM + wc * 32 + 8 * fq;
#pragma unroll
        for (int ai = 0; ai < 2; ++ai)
#pragma unroll
            for (int m = 0; m < 4; ++m) { bf16_t* rowp = O + (size_t)(row0 + ai * HALF + m * 16) * DM + col0;
#pragma unroll
                for (int bj = 0; bj < 2; ++bj) { const f32x4 v0 = acc[ai][bj][m][0], v1 = acc[ai][bj][m][1];
                    ::u32x4 w; w.x = pk2(v0[0], v0[1]); w.y = pk2(v0[2], v0[3]); w.z = pk2(v1[0], v1[1]); w.w = pk2(v1[2], v1[3]);
                    *(::u32x4*)(rowp + bj * HALF) = w; } }
    }
};
struct EpiGate2 {
    static constexpr bool PERM = true, AFTER_DRAIN = false, HAS_MID = true;
    const bf16_t* G; bf16_t* Y;
    __device__ __forceinline__ void mid(f32x4 (&acc)[2][2][4][2], const Unit& u, int wr, int wc, int fr, int fq) const {
        const int row0 = u.pm * BM + wr * 64 + fr, col0 = u.pn * BM + wc * 32 + 8 * fq;
#pragma unroll
        for (int ai = 0; ai < 2; ++ai)
#pragma unroll
            for (int m = 0; m < 4; ++m) { const size_t row = (size_t)(row0 + ai * HALF + m * 16);
#pragma unroll
                for (int bj = 0; bj < 2; ++bj) {
                    const ::u32x4 ga = *(const ::u32x4*)(G + row * NGATE + col0 + bj * HALF), gm = *(const ::u32x4*)(G + row * NGATE + DM + col0 + bj * HALF);
                    f32x4& v0 = acc[ai][bj][m][0]; f32x4& v1 = acc[ai][bj][m][1];
#define PG8_RAT(a, b) ((a) * __builtin_amdgcn_rcpf(b))
                    v0[0] *= PG8_RAT(bf_lo(ga.x), bf_lo(gm.x)); v0[1] *= PG8_RAT(bf_hi(ga.x), bf_hi(gm.x)); v0[2] *= PG8_RAT(bf_lo(ga.y), bf_lo(gm.y)); v0[3] *= PG8_RAT(bf_hi(ga.y), bf_hi(gm.y));
                    v1[0] *= PG8_RAT(bf_lo(ga.z), bf_lo(gm.z)); v1[1] *= PG8_RAT(bf_hi(ga.z), bf_hi(gm.z)); v1[2] *= PG8_RAT(bf_lo(ga.w), bf_lo(gm.w)); v1[3] *= PG8_RAT(bf_hi(ga.w), bf_hi(gm.w)); }
#undef PG8_RAT
                if (m == 3) __builtin_amdgcn_sched_barrier(0); }
    }
    __device__ __forceinline__ void operator()(const f32x4 (&acc)[2][2][4][2], const Unit& u, int wr, int wc, int fr, int fq) const {
        const int row0 = u.pm * BM + wr * 64 + fr, col0 = u.pn * BM + wc * 32 + 8 * fq;
        ::u32x4 gg[2][4][2];
#pragma unroll
        for (int ai = 0; ai < 2; ++ai)
#pragma unroll
            for (int m = 0; m < 4; ++m) { const size_t row = (size_t)(row0 + ai * HALF + m * 16);
#pragma unroll
                for (int bj = 0; bj < 2; ++bj) gg[ai][m][bj] = *(const ::u32x4*)(G + row * NGATE + DM + col0 + bj * HALF); }
        __builtin_amdgcn_sched_barrier(0);
#pragma unroll
        for (int ai = 0; ai < 2; ++ai)
#pragma unroll
            for (int m = 0; m < 4; ++m) { const size_t row = (size_t)(row0 + ai * HALF + m * 16);
#pragma unroll
                for (int bj = 0; bj < 2; ++bj) { const f32x4 v0 = acc[ai][bj][m][0], v1 = acc[ai][bj][m][1]; const ::u32x4 g = gg[ai][m][bj];
                    ::u32x4 w; w.x = pk2(bf_lo(g.x) * v0[0], bf_hi(g.x) * v0[1]); w.y = pk2(bf_lo(g.y) * v0[2], bf_hi(g.y) * v0[3]); w.z = pk2(bf_lo(g.z) * v1[0], bf_hi(g.z) * v1[1]); w.w = pk2(bf_lo(g.w) * v1[2], bf_hi(g.w) * v1[3]);
                    *(::u32x4*)(Y + row * DM + col0 + bj * HALF) = w; } }
    }
};
}
namespace datt {
DI float attn_lambda(const float* lam) { const int lane = threadIdx.x & 63; const float p1 = lam[lane] * lam[64 + lane], p2 = lam[128 + lane] * lam[192 + lane]; return __expf(wave_sum(p1)) - __expf(wave_sum(p2)) + LAMBDA_INIT; }
constexpr int KROW = 144;
constexpr int KBUF = 64 * KROW, VBUF = 64 * 256, LDS_K = 0, LDS_V = 2 * KBUF, LDS_ST = LDS_V + 2 * VBUF, STROW = 272, ST_WAVE = 32 * STROW, LDS_BYTES = LDS_ST + 8 * ST_WAVE;
DI unsigned vrow(unsigned key) { return (key & ~12u) | ((key & 4u) << 1) | ((key & 8u) >> 1); }

template <bool DRY> DI void attn_unit(LAS unsigned char* lds, bf16_t* Z, const float lam_val, const float* subln_g, int b, int h, int qb) {
    int tid_o = threadIdx.x; OPAQUE(tid_o); const int tid = tid_o, lane = tid & 63, r32 = lane & 31, hi = lane >> 5; const int wid = __builtin_amdgcn_readfirstlane(tid >> 6);
    const size_t rowbase = (size_t)b * SEQ;
    const int q_first = qb * 256 + wid * 32, q_me = q_first + r32;
    const int NT = 4 * (qb + 1);
    const int k_key = tid >> 3, k_ch = tid & 7;
    const int v_key0 = tid >> 4, v_ch = tid & 15;
    const unsigned tb0 = LDS_V + tr_base(lane, 0), tb1 = LDS_V + tr_base(lane, 1); unsigned q64 = ((lane & 15) >> 2) << 6;
    const unsigned kb = LDS_K + r32 * KROW + hi * 16;
    u32x4 pk_, pv0, pv1;
#pragma unroll
    for (int m = 0; m < 2; ++m) {
        bf16x8 qf[4];
        { const bf16_t* qp = Z + (rowbase + q_me) * NZ + ZC_Q + h * 128 + m * 64 + 8 * hi;
#pragma unroll
          for (int s = 0; s < 4; ++s) qf[s] = *(const bf16x8*)(qp + 16 * s); }
        const bf16_t* ksrc = Z + (rowbase + k_key) * NZ + ZC_K + h * 128 + m * 64 + k_ch * 8;
        const bf16_t* vsrc = Z + (rowbase + v_key0) * NZ + ZC_V + h * 128 + v_ch * 8;
        f32x16 O[4];
#pragma unroll
        for (int c = 0; c < 4; ++c)
#pragma unroll
            for (int r = 0; r < 16; ++r) O[c][r] = 0.f;
        float mrun = -1e30f, lrun = 0.f;
        if (m == 0) { pk_ = *(const u32x4*)ksrc; pv0 = *(const u32x4*)vsrc; pv1 = *(const u32x4*)(vsrc + (size_t)32 * NZ); }
        __syncthreads();
        *(LAS u32x4*)(lds + LDS_K + k_key * KROW + k_ch * 16) = pk_;
        *(LAS u32x4*)(lds + LDS_V + off_b(vrow(v_key0), v_ch)) = pv0;
        *(LAS u32x4*)(lds + LDS_V + off_b(vrow(v_key0 + 32), v_ch)) = pv1;
        { const size_t o = (size_t)64 * NZ; pk_ = *(const u32x4*)(ksrc + o); pv0 = *(const u32x4*)(vsrc + o); pv1 = *(const u32x4*)(vsrc + o + (size_t)32 * NZ); }
        __syncthreads();
        for (int kt = 0; kt < NT; ++kt) {
            const int cur = kt & 1, nxt = cur ^ 1;
            if (kt * 64 <= q_first + 31) {
            f32x16 p[2];
            bf16x8 ka[8];
#pragma unroll
            for (int i = 0; i < 8; ++i) ka[i] = *(const LAS bf16x8*)(lds + kb + cur * KBUF + 32 * (i >> 2) * KROW + (i & 3) * 32);
            __builtin_amdgcn_sched_barrier(0);
#pragma unroll
            for (int hf = 0; hf < 2; ++hf) {
#pragma unroll
                for (int r = 0; r < 16; ++r) p[hf][r] = 0.f;
#pragma unroll
                for (int s = 0; s < 4; ++s) p[hf] = MFMA32(ka[4 * hf + s], qf[s], p[hf]);
            }
            OPAQUE(q64);
            const unsigned vb0 = tb0 + cur * VBUF, vb1 = tb1 + cur * VBUF;
            s16x4 vlo[2][4], vhi[2][4];
#pragma unroll
            for (int ks = 0; ks < 4; ++ks) { vlo[0][ks] = tr_read(lds + vb0 + q64 + 4096 * ks); vhi[0][ks] = tr_read(lds + vb1 + q64 + 4096 * ks); }
            __builtin_amdgcn_sched_barrier(0);
            if (kt * 64 + 63 > q_first) {
#pragma unroll
                for (int hf = 0; hf < 2; ++hf)
#pragma unroll
                    for (int r = 0; r < 16; ++r) { const int key = kt * 64 + 32 * hf + crow(r, hi); if (key > q_me) p[hf][r] = -1e30f; }
            }
            float mx = p[0][0];
#pragma unroll
            for (int r = 1; r < 16; ++r) mx = fmaxf(mx, p[0][r]);
#pragma unroll
            for (int r = 0; r < 16; ++r) mx = fmaxf(mx, p[1][r]);
            mx = max32x(mx);
            if (__builtin_amdgcn_ballot_w64(mx > mrun + 8.0f) != 0) {
                const float mnew = fmaxf(mrun, mx), alpha = __builtin_amdgcn_exp2f(mrun - mnew); mrun = mnew; lrun *= alpha;
#pragma unroll
                for (int c = 0; c < 4; ++c)
#pragma unroll
                    for (int r = 0; r < 16; ++r) O[c][r] *= alpha;
            }
            float ls = 0.f;
#pragma unroll
            for (int hf = 0; hf < 2; ++hf)
#pragma unroll
                for (int r = 0; r < 16; ++r) { const float e = __builtin_amdgcn_exp2f(p[hf][r] - mrun); p[hf][r] = e; ls += e; }
            lrun += ls;
            bf16x8 pf[4];
            pf[0] = pack_step(p[0], 0); pf[1] = pack_step(p[0], 1); pf[2] = pack_step(p[1], 0); pf[3] = pack_step(p[1], 1);
#pragma unroll
            for (int c = 0; c < 4; ++c) {
                if (c < 3) { const unsigned cx = (64u * (c + 1)) ^ q64;
#pragma unroll
                    for (int ks = 0; ks < 4; ++ks) { vlo[(c + 1) & 1][ks] = tr_read(lds + vb0 + cx + 4096 * ks); vhi[(c + 1) & 1][ks] = tr_read(lds + vb1 + cx + 4096 * ks); } }
                __builtin_amdgcn_sched_barrier(0);
#pragma unroll
                for (int ks = 0; ks < 4; ++ks) O[c] = MFMA32(cat8(vlo[c & 1][ks], vhi[c & 1][ks]), pf[ks], O[c]);
                __builtin_amdgcn_sched_barrier(0);
            }
            }
            if (kt + 1 < NT) {
                *(LAS u32x4*)(lds + LDS_K + nxt * KBUF + k_key * KROW + k_ch * 16) = pk_;
                *(LAS u32x4*)(lds + LDS_V + nxt * VBUF + off_b(vrow(v_key0), v_ch)) = pv0;
                *(LAS u32x4*)(lds + LDS_V + nxt * VBUF + off_b(vrow(v_key0 + 32), v_ch)) = pv1;
                if (kt + 2 < NT) { const size_t o = (size_t)(kt + 2) * 64 * NZ; pk_ = *(const u32x4*)(ksrc + o); pv0 = *(const u32x4*)(vsrc + o); pv1 = *(const u32x4*)(vsrc + o + (size_t)32 * NZ); }
                else if (m == 0) { pk_ = *(const u32x4*)(ksrc + 64); pv0 = *(const u32x4*)vsrc; pv1 = *(const u32x4*)(vsrc + (size_t)32 * NZ); }
            }
            __syncthreads();
        }
        const float ltot = sum32x(lrun), inv = 1.0f / ltot;
        if (m == 0) {
            LAS unsigned char* stg = lds + LDS_ST + wid * ST_WAVE;
#pragma unroll
            for (int c = 0; c < 4; ++c)
#pragma unroll
                for (int g4 = 0; g4 < 4; ++g4) { const int dv0 = 32 * c + 8 * g4 + 4 * hi;
                    u32x2 w; w.x = pk2(O[c][4 * g4] * inv, O[c][4 * g4 + 1] * inv); w.y = pk2(O[c][4 * g4 + 2] * inv, O[c][4 * g4 + 3] * inv);
                    *(LAS u32x2*)(stg + r32 * STROW + dv0 * 2) = w; }
        } else {
            const float li = lam_val * inv;
            float ss = 0.f;
            LAS unsigned char* stg = lds + LDS_ST + wid * ST_WAVE;
#pragma unroll
            for (int c = 0; c < 4; ++c)
#pragma unroll
                for (int g4 = 0; g4 < 4; ++g4) { const int dv0 = 32 * c + 8 * g4 + 4 * hi; const u32x2 k2 = *(const LAS u32x2*)(stg + r32 * STROW + dv0 * 2);
                    O[c][4 * g4] = bf_lo(k2.x) - li * O[c][4 * g4]; O[c][4 * g4 + 1] = bf_hi(k2.x) - li * O[c][4 * g4 + 1]; O[c][4 * g4 + 2] = bf_lo(k2.y) - li * O[c][4 * g4 + 2]; O[c][4 * g4 + 3] = bf_hi(k2.y) - li * O[c][4 * g4 + 3];
                    ss += (O[c][4 * g4] * O[c][4 * g4] + O[c][4 * g4 + 1] * O[c][4 * g4 + 1]) + (O[c][4 * g4 + 2] * O[c][4 * g4 + 2] + O[c][4 * g4 + 3] * O[c][4 * g4 + 3]); }
            ss = sum32x(ss);
            const float rstd = rsqrtf(ss * (1.0f / 128.0f) + LN_EPS) * (1.0f - LAMBDA_INIT);
#pragma unroll
            for (int c = 0; c < 4; ++c)
#pragma unroll
                for (int g4 = 0; g4 < 4; ++g4) { const int dv0 = 32 * c + 8 * g4 + 4 * hi; const f32x4 gg = *(const f32x4*)(subln_g + dv0);
                    u32x2 w; w.x = pk2(O[c][4 * g4] * rstd * gg[0], O[c][4 * g4 + 1] * rstd * gg[1]); w.y = pk2(O[c][4 * g4 + 2] * rstd * gg[2], O[c][4 * g4 + 3] * rstd * gg[3]);
                    *(LAS u32x2*)(stg + r32 * STROW + dv0 * 2) = w; }
        }
    }
    LAS unsigned char* stg = lds + LDS_ST + wid * ST_WAVE;
    asm volatile("s_waitcnt lgkmcnt(0)" ::: "memory");
    bf16_t* obase = Z + (rowbase + q_first) * NZ + ZC_Q + h * 128;
#pragma unroll
    for (int i = 0; i < 8; ++i) { const int idx = lane + 64 * i, row = idx >> 4, ch = idx & 15;
        const u32x4 v = *(const LAS u32x4*)(stg + row * STROW + ch * 16); if (!DRY || v.x == 0x12345678u) *(u32x4*)(obase + (size_t)row * NZ + ch * 8) = v; }
}
}
namespace mls {
constexpr int QI = 0, KI = 32768, VI = 65536, SC = 131072;
constexpr int F_IG = 0, F_LF = 128, F_A = 256, F_M = 384, F_INTER = 512, F_EMT = 640, F_W = 768, F_DEN = 896, F_N = 1024, F_MISC = 1152,
              F_NQ2P = 1280, F_NQ1P = 1792, F_NP = 2304, F_RSQ = 2816, F_END = 3840;
constexpr int LDS_BYTES = SC + F_END * 4;
static_assert(LDS_BYTES <= 147456, "mLSTM LDS");

template <int CTRL> DI float dpp_keep(float old, float v) { return __builtin_bit_cast(float, __builtin_amdgcn_update_dpp(__builtin_bit_cast(int, old), __builtin_bit_cast(int, v), CTRL, 0xF, 0xF, false)); }
DI float scan_add(float x, int lane) {
    x += dpp_keep<0x111>(0.f, x); x += dpp_keep<0x112>(0.f, x); x += dpp_keep<0x114>(0.f, x); x += dpp_keep<0x118>(0.f, x);
    const float t0 = rdlane(x, 15), t1 = rdlane(x, 31), t2 = rdlane(x, 47); const int r = lane >> 4;
    return x + ((r >= 1 ? t0 : 0.f) + (r >= 2 ? t1 : 0.f) + (r >= 3 ? t2 : 0.f));
}
DI float scan_max(float x, int lane) {
    const float ninf = -3.0e38f;
    x = fmaxf(x, dpp_keep<0x111>(ninf, x)); x = fmaxf(x, dpp_keep<0x112>(ninf, x)); x = fmaxf(x, dpp_keep<0x114>(ninf, x)); x = fmaxf(x, dpp_keep<0x118>(ninf, x));
    const float t0 = rdlane(x, 15), t1 = rdlane(x, 31), t2 = rdlane(x, 47); const int r = lane >> 4;
    return fmaxf(x, fmaxf(fmaxf(r >= 1 ? t0 : ninf, r >= 2 ? t1 : ninf), r >= 3 ? t2 : ninf));
}
DI float log_sigmoid(float x) { return fminf(x, 0.f) - __logf(1.0f + __expf(-fabsf(x))); }

template <bool DRY, int ABL = 0> DI void mlstm_unit(LAS unsigned char* lds, bf16_t* Z, const float* GIF, const float* conv_w, const float* conv_b, const float* norm_g, int b, int hd) {
    int tid_o = threadIdx.x; OPAQUE(tid_o); const int tid = tid_o, lane = tid & 63; const int wid = __builtin_amdgcn_readfirstlane(tid >> 6);
    LAS float* sc = (LAS float*)(lds + SC);
#define MLS_LV unsigned L_ = lane; OPAQUE(L_); const unsigned r32 = L_ & 31, hi = L_ >> 5, rowb = 256u * r32, f16 = (((r32 & 3) << 2) | ((r32 >> 2) & 3)) << 4, q64 = ((L_ & 15) >> 2) << 6; (void)rowb; (void)f16; (void)q64; (void)hi
    f32x16 CT[4];
#pragma unroll
    for (int i = 0; i < 4; ++i)
#pragma unroll
        for (int r = 0; r < 16; ++r) CT[i][r] = 0.f;
    float m_prev = 0.f;
    if (tid < 128) sc[F_N + tid] = 0.f;
    const int img = wid >> 2, vc = wid & 3;
    const int st_i = wid >> 1, st_j0 = 2 * (wid & 1);

    u32x4 rawn[11]; float gin = 0.f, gfn = 0.f;
#define MLS_PREFETCH(CC) do { int tp = tid; OPAQUE(tp); const int p_mat = tp >> 8, p_ch = tp & 15, p_rg = (tp >> 4) & 15; const size_t tn = (size_t)b * SEQ + (size_t)(CC) * 128; \
        const bf16_t* srcn = Z + (tn + p_rg * 8) * NZ + (p_mat ? ZC_MK : ZC_MQ) + hd * 128 + p_ch * 8; \
        _Pragma("unroll") for (int j = 0; j < 11; ++j) { const int lp = (CC) * 128 + p_rg * 8 - 3 + j; rawn[j] = (u32x4){0u, 0u, 0u, 0u}; if (lp >= 0) rawn[j] = *(const u32x4*)(srcn + (ptrdiff_t)(j - 3) * NZ); } \
        if (tp < 128) { const float* gg = GIF + (tn + tp) * 8; gin = gg[hd]; gfn = gg[4 + hd]; } } while (0)
    MLS_PREFETCH(0);
    for (int c = 0; c < 16; ++c) {
        const size_t t0 = (size_t)b * SEQ + (size_t)c * 128;
        __syncthreads();
        u32x4 vn[8];
        { int tq = tid; OPAQUE(tq);
#pragma unroll
          for (int i = 0; i < 8; ++i) { const int idx = tq + 512 * i, row = idx >> 5, ch32 = idx & 31; vn[i] = *(const u32x4*)(Z + (t0 + row) * NZ + ZC_MV + hd * 256 + ch32 * 8); } }
        {
            int tq = tid; OPAQUE(tq);
            const int c_mat = tq >> 8, c_ch = tq & 15, c_rg = (tq >> 4) & 15;
            const int chan0 = c_mat * 512 + hd * 128 + c_ch * 8;
            const float kscale = c_mat ? 0.08838834764831845f : 1.0f;
            float cw[4][8], cb[8];
            { const GAS float* cwp = (const GAS float*)(conv_w + chan0); const GAS float* cbp = (const GAS float*)(conv_b + chan0); asm volatile("" : "+v"(cwp), "+v"(cbp));
#pragma unroll
              for (int j = 0; j < 4; ++j) { const f32x4 a = *(const GAS f32x4*)(cwp + j * 1024), c4 = *(const GAS f32x4*)(cwp + j * 1024 + 4);
                cw[j][0] = a[0]; cw[j][1] = a[1]; cw[j][2] = a[2]; cw[j][3] = a[3]; cw[j][4] = c4[0]; cw[j][5] = c4[1]; cw[j][6] = c4[2]; cw[j][7] = c4[3]; }
              const f32x4 a = *(const GAS f32x4*)cbp, c4 = *(const GAS f32x4*)(cbp + 4); cb[0] = a[0]; cb[1] = a[1]; cb[2] = a[2]; cb[3] = a[3]; cb[4] = c4[0]; cb[5] = c4[1]; cb[6] = c4[2]; cb[7] = c4[3]; }
            u32x4 raw[11];
#pragma unroll
            for (int j = 0; j < 11; ++j) raw[j] = rawn[j];
#pragma unroll
            for (int i = 0; i < 8; ++i) {
                float o[8];
#pragma unroll
                for (int e = 0; e < 8; ++e) { const int q = e >> 1; const bool hi_ = e & 1;
                    const float x0 = hi_ ? bf_hi(raw[i][q]) : bf_lo(raw[i][q]), x1 = hi_ ? bf_hi(raw[i + 1][q]) : bf_lo(raw[i + 1][q]), x2 = hi_ ? bf_hi(raw[i + 2][q]) : bf_lo(raw[i + 2][q]), x3 = hi_ ? bf_hi(raw[i + 3][q]) : bf_lo(raw[i + 3][q]);
                    const float y = cb[e] + cw[0][e] * x0 + cw[1][e] * x1 + cw[2][e] * x2 + cw[3][e] * x3; o[e] = (ABL & 1) ? y : siluf_(y) * kscale; }
                u32x4 w; w.x = pk2(o[0], o[1]); w.y = pk2(o[2], o[3]); w.z = pk2(o[4], o[5]); w.w = pk2(o[6], o[7]);
                *(LAS u32x4*)(lds + (c_mat ? KI : QI) + off_b(c_rg * 8 + i, c_ch)) = w;
            }
        }
        { int tq = tid; OPAQUE(tq);
#pragma unroll
        for (int i = 0; i < 8; ++i) { const int idx = tq + 512 * i, row = idx >> 5, ch32 = idx & 31;
            *(LAS u32x4*)(lds + VI + (ch32 >> 4) * 32768 + off_b(row, ch32 & 15)) = vn[i]; } }
        if (tid < 128) { sc[F_IG + tid] = gin; sc[F_LF + tid] = log_sigmoid(gfn);
            if (c > 0) sc[F_N + tid] = sc[F_MISC + 1] * sc[F_N + tid] + (sc[F_NP + tid] + sc[F_NP + 128 + tid]) + (sc[F_NP + 256 + tid] + sc[F_NP + 384 + tid]); }
        __syncthreads();
        if (wid == 1 && !(ABL & 8)) {
            const float ig0 = sc[F_IG + 2 * lane], ig1 = sc[F_IG + 2 * lane + 1], lf0 = sc[F_LF + 2 * lane], lf1 = sc[F_LF + 2 * lane + 1];
            const float s2 = lf0 + lf1, incl = scan_add(s2, lane), excl = incl - s2;
            const float b0 = excl + lf0, b1 = incl, a0 = ig0 - b0, a1 = ig1 - b1;
            const float im = scan_max(fmaxf(a0, a1), lane); const float em = dpp_keep<0x138>(-3.0e38f, im);
            const float cm0 = fmaxf(em, a0), cm1 = im;
            const float M0 = fmaxf(m_prev, cm0), M1 = fmaxf(m_prev, cm1);
            const float ML = rdlane(M1, 63), bL = rdlane(b1, 63);
            sc[F_A + 2 * lane] = a0; sc[F_A + 2 * lane + 1] = a1; sc[F_M + 2 * lane] = M0; sc[F_M + 2 * lane + 1] = M1;
            sc[F_INTER + 2 * lane] = __expf(m_prev - M0); sc[F_INTER + 2 * lane + 1] = __expf(m_prev - M1);
            sc[F_EMT + 2 * lane] = __expf(-(b0 + M0)); sc[F_EMT + 2 * lane + 1] = __expf(-(b1 + M1));
            sc[F_W + 2 * lane] = __expf(a0 - ML); sc[F_W + 2 * lane + 1] = __expf(a1 - ML);
            if (lane == 0) sc[F_MISC + 0] = __expf(m_prev - ML);
            m_prev = bL + ML;
        }
        f32x16 sT[2];
#pragma unroll
        for (int jj = 0; jj < 2; ++jj) {
#pragma unroll
            for (int r = 0; r < 16; ++r) sT[jj][r] = 0.f;
            const int j = st_j0 + jj;
            if (j <= st_i) { MLS_LV; const unsigned fh = (16u * hi) ^ f16;
                bf16x8 af[8], qq[8];
#pragma unroll
                for (int ks = 0; ks < 8; ++ks) { const unsigned xo = rowb + ((32u * ks) ^ fh);
                    af[ks] = *(const LAS bf16x8*)(lds + KI + 8192 * j + xo); qq[ks] = *(const LAS bf16x8*)(lds + QI + 8192 * st_i + xo); }
                __builtin_amdgcn_sched_barrier(0);
#pragma unroll
                for (int ks = 0; ks < 8; ++ks) sT[jj] = MFMA32(af[ks], qq[ks], sT[jj]);
                __builtin_amdgcn_sched_barrier(0);
            }
        }
        __syncthreads();
        u32x2 pp[2][4];
        { MLS_LV; const int t = 32 * st_i + r32; const float Mt = sc[F_M + t]; const unsigned ab = SC + 4 * F_A + 128 * st_j0 + 16 * hi;
#pragma unroll
          for (int jj = 0; jj < 2; ++jj) { const int j = st_j0 + jj;
#pragma unroll
            for (int g4 = 0; g4 < 4; ++g4) { const int s0 = 32 * j + 8 * g4 + 4 * hi; float pv[4];
#pragma unroll
                for (int e = 0; e < 4; ++e) { const int s = s0 + e; pv[e] = (s <= t) ? __expf(*(const LAS float*)(lds + ab + 4 * (32 * jj + 8 * g4 + e)) - Mt) * sT[jj][4 * g4 + e] : 0.f; }
                pp[jj][g4].x = pk2(pv[0], pv[1]); pp[jj][g4].y = pk2(pv[2], pv[3]); } } }
        f32x16 acc[4];
#pragma unroll
        for (int ti = 0; ti < 4; ++ti)
#pragma unroll
            for (int r = 0; r < 16; ++r) acc[ti][r] = 0.f;
        if (c > 0) {
#pragma unroll
            for (int dt = 0; dt < 4; ++dt)
#pragma unroll
                for (int s2 = 0; s2 < 2; ++s2) { const bf16x8 bfr = pack_step(CT[dt], s2); MLS_LV;
                    const unsigned a0 = QI + rowb + 8 * hi + ((64u * dt + 32u * s2) ^ f16), a1 = QI + rowb + 8 * hi + ((64u * dt + 32u * s2 + 16u) ^ f16);
                    s16x4 lo[4], hi4[4];
#pragma unroll
                    for (int ti = 0; ti < 4; ++ti) { lo[ti] = *(const LAS s16x4*)(lds + a0 + 8192 * ti); hi4[ti] = *(const LAS s16x4*)(lds + a1 + 8192 * ti); }
                    __builtin_amdgcn_sched_barrier(0);
#pragma unroll
                    for (int ti = 0; ti < 4; ++ti) acc[ti] = MFMA32(cat8(lo[ti], hi4[ti]), bfr, acc[ti]);
                    __builtin_amdgcn_sched_barrier(0); }
        }
        { int tq = tid; OPAQUE(tq); const int t = tq & 127, part = tq >> 7; float d = 0.f;
#pragma unroll
          for (int cc = 0; cc < 4; ++cc) { const int ch = 4 * part + cc; const u32x4 raw = *(const LAS u32x4*)(lds + QI + off_b(t, ch)); const LAS float* nn = sc + F_N + 8 * ch;
              d += bf_lo(raw.x) * nn[0] + bf_hi(raw.x) * nn[1] + bf_lo(raw.y) * nn[2] + bf_hi(raw.y) * nn[3] + bf_lo(raw.z) * nn[4] + bf_hi(raw.z) * nn[5] + bf_lo(raw.w) * nn[6] + bf_hi(raw.w) * nn[7]; }
          sc[F_NQ2P + part * 128 + t] = d; }
        __syncthreads();
        { MLS_LV; const unsigned ib = SC + 4 * F_INTER + 16 * hi;
#pragma unroll
          for (int ti = 0; ti < 4; ++ti)
#pragma unroll
            for (int r = 0; r < 16; ++r) acc[ti][r] *= *(const LAS float*)(lds + ib + 4 * (32 * ti + (r & 3) + 8 * (r >> 2))); }
        { MLS_LV;
#pragma unroll
          for (int jj = 0; jj < 2; ++jj) { const int j = st_j0 + jj;
#pragma unroll
            for (int g4 = 0; g4 < 4; ++g4) *(LAS u32x2*)(lds + QI + 8192 * st_i + rowb + 8 * hi + ((64u * j + 16u * g4) ^ f16)) = pp[jj][g4]; } }
        { int tq = tid; OPAQUE(tq);
#pragma unroll
        for (int i = 0; i < 4; ++i) { const int idx = tq + 512 * i, row = idx >> 4, ch = idx & 15; LAS u32x4* p = (LAS u32x4*)(lds + KI + off_b(row, ch)); const u32x4 raw = *p; const float w = sc[F_W + row];
            u32x4 o; o.x = pk2(bf_lo(raw.x) * w, bf_hi(raw.x) * w); o.y = pk2(bf_lo(raw.y) * w, bf_hi(raw.y) * w); o.z = pk2(bf_lo(raw.z) * w, bf_hi(raw.z) * w); o.w = pk2(bf_lo(raw.w) * w, bf_hi(raw.w) * w); *p = o; } }
        __syncthreads();
        { const float decay = sc[F_MISC + 0];
#pragma unroll
          for (int dt = 0; dt < 4; ++dt)
#pragma unroll
            for (int r = 0; r < 16; ++r) CT[dt][r] *= decay; }
#pragma unroll
        for (int ks = 0; ks < 8; ++ks) {
            MLS_LV;
            const unsigned tbv0 = VI + img * 32768 + tr_base(L_, 0) + ((64u * vc) ^ q64), tbv1 = VI + img * 32768 + tr_base(L_, 1) + ((64u * vc) ^ q64);
            const unsigned tbk0 = KI + tr_base(L_, 0), tbk1 = KI + tr_base(L_, 1);
            const bf16x8 bv = cat8(tr_read(lds + tbv0 + 4096 * ks), tr_read(lds + tbv1 + 4096 * ks));
            const unsigned xo = QI + rowb + ((32u * ks) ^ ((16u * hi) ^ f16));
            bf16x8 pa[4]; s16x4 klo[4], khi[4];
#pragma unroll
            for (int ti = 0; ti < 4; ++ti) if (ks < 2 * (ti + 1)) pa[ti] = *(const LAS bf16x8*)(lds + xo + 8192 * ti);
#pragma unroll
            for (int dt = 0; dt < 4; ++dt) { const unsigned cx = (64u * dt) ^ q64; klo[dt] = tr_read(lds + tbk0 + 4096 * ks + cx); khi[dt] = tr_read(lds + tbk1 + 4096 * ks + cx); }
            __builtin_amdgcn_sched_barrier(0);
#pragma unroll
            for (int ti = 0; ti < 4; ++ti) if (ks < 2 * (ti + 1)) acc[ti] = MFMA32(pa[ti], bv, acc[ti]);
#pragma unroll
            for (int dt = 0; dt < 4; ++dt) CT[dt] = MFMA32(cat8(klo[dt], khi[dt]), bv, CT[dt]);
            __builtin_amdgcn_sched_barrier(0);
        }
        { int tq = tid; OPAQUE(tq); const int t = tq & 127, part = tq >> 7; float d = 0.f;
#pragma unroll
          for (int cc = 0; cc < 4; ++cc) { const u32x4 raw = *(const LAS u32x4*)(lds + QI + off_b(t, 4 * part + cc));
              d += (bf_lo(raw.x) + bf_hi(raw.x)) + (bf_lo(raw.y) + bf_hi(raw.y)) + (bf_lo(raw.z) + bf_hi(raw.z)) + (bf_lo(raw.w) + bf_hi(raw.w)); }
          sc[F_NQ1P + part * 128 + t] = d;
          float nn = 0.f;
          if (!(ABL & 16)) for (int s = 32 * part; s < 32 * part + 32; ++s) nn += bf2f(*(const LAS bf16_t*)(lds + KI + off_b(s, t >> 3) + (t & 7) * 2));
          sc[F_NP + part * 128 + t] = nn;
          if (tid == 0) sc[F_MISC + 1] = sc[F_MISC + 0]; }
        __syncthreads();
        if (tid < 128) { const float nq1 = (sc[F_NQ1P + tid] + sc[F_NQ1P + 128 + tid]) + (sc[F_NQ1P + 256 + tid] + sc[F_NQ1P + 384 + tid]);
            const float nq2 = (sc[F_NQ2P + tid] + sc[F_NQ2P + 128 + tid]) + (sc[F_NQ2P + 256 + tid] + sc[F_NQ2P + 384 + tid]);
            sc[F_DEN + tid] = 1.0f / fmaxf(fabsf(nq1 + sc[F_INTER + tid] * nq2), sc[F_EMT + tid]); }
        __syncthreads();
        u32x4 oraw[8];
        { int tq = tid; OPAQUE(tq);
#pragma unroll
          for (int i = 0; i < 8; ++i) { const int idx = tq + 512 * i, row = idx >> 5, ch = idx & 31; oraw[i] = *(const u32x4*)(Z + (t0 + row) * NZ + hd * 256 + ch * 8 + ZC_MO); } }
        { MLS_LV; const unsigned db = SC + 4 * F_DEN + 16 * hi, hb = VI + 2048 * hi + (32 * wid + r32) * 2;
#pragma unroll
          for (int ti = 0; ti < 4; ++ti)
#pragma unroll
            for (int r = 0; r < 16; ++r) { const int tt = 32 * ti + (r & 3) + 8 * (r >> 2); const float x = acc[ti][r] * *(const LAS float*)(lds + db + 4 * tt);
                *(LAS bf16_t*)(lds + hb + 512 * tt) = (bf16_t)(pk2(x, 0.f) & 0xffffu); } }
        __syncthreads();
        { const int cn = c + 1 < 16 ? c + 1 : 15; MLS_PREFETCH(cn); }
        if (!(ABL & 2))
        { int tq = tid; OPAQUE(tq);
          const f32x4 g0 = *(const f32x4*)(norm_g + hd * 256 + (tq & 31) * 8), g1 = *(const f32x4*)(norm_g + hd * 256 + (tq & 31) * 8 + 4);
#pragma unroll
          for (int i = 0; i < 8; ++i) { const int idx = tq + 512 * i, row = idx >> 5, ch = idx & 31;
            const u32x4 hraw = *(const LAS u32x4*)(lds + VI + row * 512 + ch * 16);
            const float h0 = bf_lo(hraw.x), h1 = bf_hi(hraw.x), h2 = bf_lo(hraw.y), h3 = bf_hi(hraw.y), h4 = bf_lo(hraw.z), h5 = bf_hi(hraw.z), h6 = bf_lo(hraw.w), h7 = bf_hi(hraw.w);
            float ssq = (h0 * h0 + h1 * h1) + (h2 * h2 + h3 * h3) + (h4 * h4 + h5 * h5) + (h6 * h6 + h7 * h7);
            ssq = half_sum32(ssq);
            const float rstd = rsqrtf(ssq * (1.0f / 256.0f) + LN_EPS);
            bf16_t* gp = Z + (t0 + row) * NZ + hd * 256 + ch * 8;
            u32x4 o;
            o.x = pk2(h0 * rstd * g0[0] * bf_lo(oraw[i].x), h1 * rstd * g0[1] * bf_hi(oraw[i].x));
            o.y = pk2(h2 * rstd * g0[2] * bf_lo(oraw[i].y), h3 * rstd * g0[3] * bf_hi(oraw[i].y));
            o.z = pk2(h4 * rstd * g1[0] * bf_lo(oraw[i].z), h5 * rstd * g1[1] * bf_hi(oraw[i].z));
            o.w = pk2(h6 * rstd * g1[2] * bf_lo(oraw[i].w), h7 * rstd * g1[3] * bf_hi(oraw[i].w));
            if (!DRY || o.x == 0x12345678u) *(u32x4*)(gp + ZC_MV) = o; } }
    }
    __syncthreads();
}
#undef MLS_LV
#undef MLS_PREFETCH
}
namespace peer {
constexpr int KROW = 144;
constexpr int L_KEYS = 0, L_IDX = 2 * 128 * KROW, LDS_BYTES = L_IDX + 512 * 32;
DI unsigned ordf(float f) { const unsigned u = __float_as_uint(f); return u ^ ((unsigned)((int)u >> 31) | 0x80000000u); }
DI float deord(unsigned k) { return __uint_as_float(k ^ ((~(unsigned)((int)k >> 31)) | 0x80000000u)); }
#define PEER_CE(a, b) do { const unsigned hi_ = (a) > (b) ? (a) : (b), lo_ = (a) > (b) ? (b) : (a); (a) = hi_; (b) = lo_; } while (0)
DI void sort16_desc(unsigned (&a)[16]) {
    PEER_CE(a[0], a[13]); PEER_CE(a[1], a[12]); PEER_CE(a[2], a[15]); PEER_CE(a[3], a[14]); PEER_CE(a[4], a[8]); PEER_CE(a[5], a[6]); PEER_CE(a[7], a[11]); PEER_CE(a[9], a[10]);
    PEER_CE(a[0], a[5]); PEER_CE(a[1], a[7]); PEER_CE(a[2], a[9]); PEER_CE(a[3], a[4]); PEER_CE(a[6], a[13]); PEER_CE(a[8], a[14]); PEER_CE(a[10], a[15]); PEER_CE(a[11], a[12]);
    PEER_CE(a[0], a[1]); PEER_CE(a[2], a[3]); PEER_CE(a[4], a[5]); PEER_CE(a[6], a[8]); PEER_CE(a[7], a[9]); PEER_CE(a[10], a[11]); PEER_CE(a[12], a[13]); PEER_CE(a[14], a[15]);
    PEER_CE(a[0], a[2]); PEER_CE(a[1], a[3]); PEER_CE(a[4], a[10]); PEER_CE(a[5], a[11]); PEER_CE(a[6], a[7]); PEER_CE(a[8], a[9]); PEER_CE(a[12], a[14]); PEER_CE(a[13], a[15]);
    PEER_CE(a[1], a[2]); PEER_CE(a[3], a[12]); PEER_CE(a[4], a[6]); PEER_CE(a[5], a[7]); PEER_CE(a[8], a[10]); PEER_CE(a[9], a[11]); PEER_CE(a[13], a[14]);
    PEER_CE(a[1], a[4]); PEER_CE(a[2], a[6]); PEER_CE(a[5], a[8]); PEER_CE(a[7], a[10]); PEER_CE(a[9], a[13]); PEER_CE(a[11], a[14]);
    PEER_CE(a[2], a[4]); PEER_CE(a[3], a[6]); PEER_CE(a[9], a[12]); PEER_CE(a[11], a[13]);
    PEER_CE(a[3], a[5]); PEER_CE(a[6], a[8]); PEER_CE(a[7], a[9]); PEER_CE(a[10], a[12]);
    PEER_CE(a[3], a[4]); PEER_CE(a[5], a[6]); PEER_CE(a[7], a[8]); PEER_CE(a[9], a[10]); PEER_CE(a[11], a[12]);
    PEER_CE(a[6], a[7]); PEER_CE(a[8], a[9]);
}
DI void merge16(unsigned (&a)[16], const unsigned (&b)[16]) {
#pragma unroll
    for (int i = 0; i < 16; ++i) a[i] = a[i] > b[15 - i] ? a[i] : b[15 - i];
#pragma unroll
    for (int j = 8; j >= 1; j >>= 1)
#pragma unroll
        for (int i = 0; i < 16; ++i) { const int l = i ^ j; if (l > i) PEER_CE(a[i], a[l]); }
}
DI float gelu_erf(float x) { return 0.5f * x * (1.0f + erff(x * 0.7071067811865476f)); }

DI void stage_keys(LAS unsigned char* lds, const float* keys) {
    for (int i = threadIdx.x; i < 2 * 128 * 8; i += 512) { const int row = i >> 3, ch = i & 7; const float* s = keys + row * 64 + ch * 8;
        const f32x4 a = *(const f32x4*)s, b = *(const f32x4*)(s + 4);
        u32x4 w; w.x = pk2(a[0], a[1]); w.y = pk2(a[2], a[3]); w.z = pk2(b[0], b[1]); w.w = pk2(b[2], b[3]);
        *(LAS u32x4*)(lds + L_KEYS + row * KROW + ch * 16) = w; }
}

DI void select_phase(LAS unsigned char* lds, const bf16_t* QP, int tile0, int tstep, int tile_end, bf16_t* SELE, float* SELG) {
    int tid_o = threadIdx.x; OPAQUE(tid_o); const int tid = tid_o, lane = tid & 63, r32 = lane & 31, hi = lane >> 5; const int wid = __builtin_amdgcn_readfirstlane(tid >> 6);
    bf16x8 qn[2][4];
#define SEL_QLOAD(TILE) do { const bf16_t* qp_ = QP + ((size_t)(TILE) * 32 + r32) * DM + wid * 128 + 8 * hi; \
        _Pragma("unroll") for (int p_ = 0; p_ < 2; ++p_) _Pragma("unroll") for (int s_ = 0; s_ < 4; ++s_) qn[p_][s_] = *(const bf16x8*)(qp_ + p_ * 64 + 16 * s_); } while (0)
    if (tile0 < tile_end) SEL_QLOAD(tile0);
    for (int tile = tile0; tile < tile_end; tile += tstep) {
    const int tok0 = tile * 32;
    unsigned LA[16], LB[16];
    bf16x8 qc[2][4];
#pragma unroll
    for (int p = 0; p < 2; ++p)
#pragma unroll
        for (int s = 0; s < 4; ++s) qc[p][s] = qn[p][s];
    { const int tn = tile + tstep < tile_end ? tile + tstep : tile; SEL_QLOAD(tn); }
#pragma unroll
    for (int p = 0; p < 2; ++p) {
        bf16x8 qf[4];
#pragma unroll
        for (int s = 0; s < 4; ++s) qf[s] = qc[p][s];
        unsigned L[16], M[16];
#pragma unroll
        for (int nt = 0; nt < 4; ++nt) {
            f32x16 acc;
#pragma unroll
            for (int r = 0; r < 16; ++r) acc[r] = 0.f;
#pragma unroll
            for (int s = 0; s < 4; ++s) { const bf16x8 a = *(const LAS bf16x8*)(lds + L_KEYS + (p * 128 + 32 * nt + r32) * KROW + (2 * s + hi) * 16); acc = MFMA32(a, qf[s], acc); }
            unsigned T[16];
#pragma unroll
            for (int r = 0; r < 16; ++r) T[r] = (ordf(acc[r]) & ~0x7Fu) | (unsigned)(32 * nt + crow(r, hi));
            sort16_desc(T);
            if (nt == 0) {
#pragma unroll
                for (int i = 0; i < 16; ++i) L[i] = T[i]; }
            else if (nt == 1) merge16(L, T);
            else if (nt == 2) {
#pragma unroll
                for (int i = 0; i < 16; ++i) M[i] = T[i]; }
            else { merge16(M, T); merge16(L, M); }
        }
        unsigned O[16];
#pragma unroll
        for (int i = 0; i < 16; ++i) O[i] = partner32(L[i], hi);
        merge16(L, O);
#pragma unroll
        for (int i = 0; i < 16; ++i) { if (p == 0) LA[i] = L[i]; else LB[i] = L[i]; }
    }
    unsigned CL[16];
    {
        float sa[16], sb[16];
#pragma unroll
        for (int i = 0; i < 16; ++i) { sa[i] = deord(LA[i] & ~0x7Fu); sb[i] = deord(LB[i] & ~0x7Fu); }
        unsigned G0[16], G1[16];
#define SEL_PUT(k, v) do { if ((k) < 16) G0[(k) & 15] = (v); else G1[(k) & 15] = (v); } while (0)
#define SEL_CAND2(k, iA, jA, iB, jB) SEL_PUT(k, (ordf((hi ? sa[iB] : sa[iA]) + (hi ? sb[jB] : sb[jA])) & ~0xFFu) | (unsigned)(hi ? (iB) * 16 + (jB) : (iA) * 16 + (jA)))
#define SEL_CAND1(k, iA, jA) SEL_PUT(k, hi ? 0u : ((ordf(sa[iA] + sb[jA]) & ~0xFFu) | (unsigned)((iA) * 16 + (jA))))
        SEL_CAND2(0, 0, 0, 3, 3);
        SEL_CAND2(1, 0, 1, 4, 0);
        SEL_CAND2(2, 0, 2, 4, 1);
        SEL_CAND2(3, 0, 3, 4, 2);
        SEL_CAND2(4, 0, 4, 5, 0);
        SEL_CAND2(5, 0, 5, 5, 1);
        SEL_CAND2(6, 0, 6, 6, 0);
        SEL_CAND2(7, 0, 7, 6, 1);
        SEL_CAND2(8, 0, 8, 7, 0);
        SEL_CAND2(9, 0, 9, 7, 1);
        SEL_CAND2(10, 0, 10, 8, 0);
        SEL_CAND2(11, 0, 11, 9, 0);
        SEL_CAND2(12, 0, 12, 10, 0);
        SEL_CAND2(13, 0, 13, 11, 0);
        SEL_CAND2(14, 0, 14, 12, 0);
        SEL_CAND2(15, 0, 15, 13, 0);
        SEL_CAND2(16, 1, 0, 14, 0);
        SEL_CAND2(17, 1, 1, 15, 0);
        SEL_CAND1(18, 1, 2);
        SEL_CAND1(19, 1, 3);
        SEL_CAND1(20, 1, 4);
        SEL_CAND1(21, 1, 5);
        SEL_CAND1(22, 1, 6);
        SEL_CAND1(23, 1, 7);
        SEL_CAND1(24, 2, 0);
        SEL_CAND1(25, 2, 1);
        SEL_CAND1(26, 2, 2);
        SEL_CAND1(27, 2, 3);
        SEL_CAND1(28, 2, 4);
        SEL_CAND1(29, 3, 0);
        SEL_CAND1(30, 3, 1);
        SEL_CAND1(31, 3, 2);
#undef SEL_PUT
#undef SEL_CAND2
#undef SEL_CAND1
        sort16_desc(G0); sort16_desc(G1); merge16(G0, G1);
        unsigned O[16];
#pragma unroll
        for (int i = 0; i < 16; ++i) O[i] = partner32(G0[i], hi);
        merge16(G0, O);
#pragma unroll
        for (int i = 0; i < 16; ++i) CL[i] = G0[i];
    }
    LAS unsigned char* itab = lds + L_IDX + tid * 32;
    { u32x4 wa, wb;
#pragma unroll
      for (int q = 0; q < 4; ++q) { wa[q] = (LA[4 * q] & 0x7Fu) | ((LA[4 * q + 1] & 0x7Fu) << 8) | ((LA[4 * q + 2] & 0x7Fu) << 16) | ((LA[4 * q + 3] & 0x7Fu) << 24);
                                    wb[q] = (LB[4 * q] & 0x7Fu) | ((LB[4 * q + 1] & 0x7Fu) << 8) | ((LB[4 * q + 2] & 0x7Fu) << 16) | ((LB[4 * q + 3] & 0x7Fu) << 24); }
      *(LAS u32x4*)itab = wa; *(LAS u32x4*)(itab + 16) = wb; }
    const float mx = deord(CL[0] & ~0xFFu);
    float ev[16], sum = 0.f;
#pragma unroll
    for (int k = 0; k < 16; ++k) { ev[k] = __expf(deord(CL[k] & ~0xFFu) - mx); sum += ev[k]; }
    const float inv = 1.0f / sum;
    bf16_t* se = SELE + (size_t)(tok0 + r32) * 128 + wid * 16;
    float* sg = SELG + (size_t)(tok0 + r32) * 128 + wid * 16;
#pragma unroll
    for (int k = 0; k < 16; ++k) if ((k >> 3) == hi) { const unsigned code = CL[k] & 0xFFu; const unsigned n1 = itab[code >> 4], n2 = itab[16 + (code & 15u)];
        se[k] = (bf16_t)(n1 * 128u + n2); sg[k] = ev[k] * inv; }
    }
#undef SEL_QLOAD
}

DI void u_phase(LAS unsigned char* lds, int tile0, int tstep, int s, const bf16_t* SELE, const unsigned char* H2Q, const unsigned char* U4S, bf16_t* PART) {
    int tid_o = threadIdx.x; OPAQUE(tid_o); const int tid = tid_o, lane = tid & 63, j = lane >> 3, c = lane & 7; const int wid = __builtin_amdgcn_readfirstlane(tid >> 6);
    if (tile0 >= TOK / 32) return;
    LAS unsigned char* wl = lds + wid * 4096;
    const unsigned char* Us = U4S + (size_t)s * NEXP * 128; const unsigned c16 = 16u * c;
    u32x4 sreg;
#define UP_STAGE_LOAD(TILE) do { sreg = *(const u32x4*)(SELE + (size_t)(TILE) * 32 * 128 + (wid * 64 + lane) * 8); } while (0)
#define UP_STAGE_STORE(BUF) do { *(LAS u32x4*)(wl + (BUF) * 2048 + lane * 16) = sreg; } while (0)
#define UP_GATHER(UR, H0, H1, BUF, JT, TILE) do { const LAS bf16_t* se_ = (const LAS bf16_t*)(wl + (BUF) * 2048) + (JT) * 128 + j; const size_t t_ = (size_t)(TILE) * 32 + wid * 4 + (JT); \
        { const unsigned char* hrow_ = H2Q + t_ * DM + 128 * s; H0 = *(const u32x4*)(hrow_ + c16); H1 = *(const u32x4*)(hrow_ + 512 + c16); }       \
        _Pragma("unroll") for (int g = 0; g < 16; ++g) { const unsigned e_ = se_[8 * g]; UR[g] = *(const u32x4*)(Us + ((e_ << 7) + c16)); } } while (0)
#define UP_COMPUTE(UR, H0, H1, JT, TILE) do { \
        int d[16]; \
        _Pragma("unroll") for (int g = 0; g < 16; ++g) { int da = 0, db = 0; \
            _Pragma("unroll") for (int i = 0; i < 4; ++i) { da = __builtin_amdgcn_sdot8((int)UR[g][i], (int)H0[i], da, false); db = __builtin_amdgcn_sdot8((int)UR[g][i], (int)H1[i], db, false); } \
            d[g] = 16 * da + db; if ((g & 3) == 3) __builtin_amdgcn_sched_barrier(0); } \
          \
        int r1[8], r2[4], r3[2]; \
        _Pragma("unroll") for (int i = 0; i < 8; ++i) { const int keep = c2 ? d[i + 8] : d[i], send = c2 ? d[i] : d[i + 8]; r1[i] = keep + dppi<0x141>(send); } \
        _Pragma("unroll") for (int i = 0; i < 4; ++i) { const int keep = c1 ? r1[i + 4] : r1[i], send = c1 ? r1[i] : r1[i + 4]; r2[i] = keep + dppi<0x4E>(send); } \
        _Pragma("unroll") for (int i = 0; i < 2; ++i) { const int keep = c0 ? r2[i + 2] : r2[i], send = c0 ? r2[i] : r2[i + 2]; r3[i] = keep + dppi<0xB1>(send); } \
        bf16_t* pp = PART + ((size_t)(TILE) * 32 + wid * 4 + (JT)) * 512 + s * 128 + 16 * c + j;            \
        pp[0] = (bf16_t)(pk2((float)r3[0], 0.f) & 0xffffu); pp[8] = (bf16_t)(pk2((float)r3[1], 0.f) & 0xffffu); } while (0)
    u32x4 urA[16], urB[16], hA0, hA1, hB0, hB1; const int c2 = c >> 2, c1 = (c >> 1) & 1, c0 = c & 1;
    UP_STAGE_LOAD(tile0); UP_STAGE_STORE(0);
    UP_GATHER(urA, hA0, hA1, 0, 0, tile0);
    int buf = 0;
#pragma unroll 1
    for (int tile = tile0; tile < TOK / 32; tile += tstep) {
        const int tnext = tile + tstep < TOK / 32 ? tile + tstep : tile;
        UP_STAGE_LOAD(tnext);
        UP_GATHER(urB, hB0, hB1, buf, 1, tile); UP_COMPUTE(urA, hA0, hA1, 0, tile);
        UP_GATHER(urA, hA0, hA1, buf, 2, tile); UP_COMPUTE(urB, hB0, hB1, 1, tile);
        UP_GATHER(urB, hB0, hB1, buf, 3, tile); UP_COMPUTE(urA, hA0, hA1, 2, tile);
        UP_STAGE_STORE(buf ^ 1);
        UP_GATHER(urA, hA0, hA1, buf ^ 1, 0, tnext);
        UP_COMPUTE(urB, hB0, hB1, 3, tile);
        buf ^= 1;
    }
#undef UP_STAGE_LOAD
#undef UP_STAGE_STORE
#undef UP_GATHER
#undef UP_COMPUTE
}
template <int NQ> DI void red_tokens(size_t t0, const bf16_t* __restrict__ PART, const bf16_t* __restrict__ SELE, const float* __restrict__ SELG, const float* __restrict__ SU, const float* __restrict__ SV,
                    const float* __restrict__ SH, signed char* __restrict__ COEFQ, float* __restrict__ CS) {
    const int lane = threadIdx.x & 63;
    float s[NQ][2], g[NQ][2], su[NQ][2], sv[NQ][2], sh[NQ];
#pragma unroll
    for (int q = 0; q < NQ; ++q) { const size_t t = t0 + q; sh[q] = SH[t];
#pragma unroll
        for (int h = 0; h < 2; ++h) { const int k = lane + 64 * h; const unsigned e = SELE[t * 128 + k]; g[q][h] = SELG[t * 128 + k]; su[q][h] = SU[e]; sv[q][h] = SV[e];
            float a = 0.f;
#pragma unroll
            for (int xx = 0; xx < 4; ++xx) a += bf2f(PART[t * 512 + xx * 128 + k]);
            s[q][h] = a; } }
#pragma unroll
    for (int q = 0; q < NQ; ++q) { const size_t t = t0 + q;
        const float c0 = g[q][0] * gelu_erf(s[q][0] * su[q][0] * sh[q]) * sv[q][0], c1 = g[q][1] * gelu_erf(s[q][1] * su[q][1] * sh[q]) * sv[q][1];
        float cm = fmaxf(fabsf(c0), fabsf(c1));
        cm = wave_max(cm);
        const float inv = cm > 0.f ? 127.0f / cm : 0.f;
        signed char* cq = COEFQ + t * 128 + (lane & 7) * 16 + (lane >> 3);
        cq[0] = (signed char)(int)rintf(c0 * inv); cq[8] = (signed char)(int)rintf(c1 * inv);
        if (lane == 0) CS[t] = cm * (1.0f / 127.0f); }
}
DI unsigned bperm(unsigned hi, unsigned lo, unsigned sel) { return __builtin_amdgcn_perm(hi, lo, sel); }
DI void v_phase(LAS unsigned char* lds, int tile0, int tstep, int x, const bf16_t* SELE, const signed char* COEFQ, const float* CS, const unsigned char* V8S, bf16_t* YF) {
    int tid_o = threadIdx.x; OPAQUE(tid_o); const int tid = tid_o, lane = tid & 63, j = lane >> 3, c = lane & 7; const int wid = __builtin_amdgcn_readfirstlane(tid >> 6);
    if (tile0 >= TOK / 32) return;
    LAS unsigned char* wl = lds + wid * 4096;
    const unsigned char* Vs = V8S + (size_t)x * NEXP * 128; const unsigned c16 = 16u * c;
    u32x4 sreg, creg = {0u, 0u, 0u, 0u};
#define VP_STAGE_LOAD(TILE) do { sreg = *(const u32x4*)(SELE + (size_t)(TILE) * 32 * 128 + (wid * 64 + lane) * 8); if (lane < 32) creg = *(const u32x4*)(COEFQ + (size_t)(TILE) * 32 * 128 + (wid * 32 + lane) * 16); } while (0)
#define VP_STAGE_STORE(BUF) do { *(LAS u32x4*)(wl + (BUF) * 2048 + lane * 16) = sreg; if (lane < 32) *(LAS u32x4*)(wl + (BUF) * 2048 + 1024 + lane * 16) = creg; } while (0)
#define VP_GATHER(VR, SC, BUF, JT, TILE) do { const LAS bf16_t* se_ = (const LAS bf16_t*)(wl + (BUF) * 2048) + (JT) * 128 + j; SC = CS[(size_t)(TILE) * 32 + wid * 4 + (JT)]; \
        _Pragma("unroll") for (int g = 0; g < 16; ++g) { const unsigned e_ = se_[8 * g]; VR[g] = *(const u32x4*)(Vs + ((e_ << 7) + c16)); } } while (0)
#define VP_COMPUTE(VR, SC, BUF, JT, TILE) do { const LAS unsigned* cqp_ = (const LAS unsigned*)(wl + (BUF) * 2048 + 1024 + (JT) * 128 + j * 16); \
        int acc[16]; \
        _Pragma("unroll") for (int i = 0; i < 16; ++i) acc[i] = 0; \
        _Pragma("unroll") for (int qd = 0; qd < 4; ++qd) { const int cp = (int)cqp_[qd]; \
            _Pragma("unroll") for (int i = 0; i < 4; ++i) { const unsigned w0 = VR[4 * qd][i], w1 = VR[4 * qd + 1][i], w2 = VR[4 * qd + 2][i], w3 = VR[4 * qd + 3][i]; \
                const unsigned t0 = bperm(w1, w0, 0x05010400u), t1 = bperm(w1, w0, 0x07030602u), t2 = bperm(w3, w2, 0x05010400u), t3 = bperm(w3, w2, 0x07030602u); \
                acc[4 * i] = __builtin_amdgcn_sdot4((int)bperm(t2, t0, 0x05040100u), cp, acc[4 * i], false); \
                acc[4 * i + 1] = __builtin_amdgcn_sdot4((int)bperm(t2, t0, 0x07060302u), cp, acc[4 * i + 1], false); \
                acc[4 * i + 2] = __builtin_amdgcn_sdot4((int)bperm(t3, t1, 0x05040100u), cp, acc[4 * i + 2], false); \
                acc[4 * i + 3] = __builtin_amdgcn_sdot4((int)bperm(t3, t1, 0x07060302u), cp, acc[4 * i + 3], false); } } \
          \
        int r1[8], r2[4], r3[2]; \
        _Pragma("unroll") for (int i = 0; i < 8; ++i) { const int keep = b3 ? acc[i + 8] : acc[i], send = b3 ? acc[i] : acc[i + 8]; r1[i] = keep + dppi<0x128>(send); }                          \
        _Pragma("unroll") for (int i = 0; i < 4; ++i) { const int keep = b4 ? r1[i + 4] : r1[i], send = b4 ? r1[i] : r1[i + 4]; r2[i] = keep + __builtin_amdgcn_ds_swizzle(send, 0x401F); }     \
        _Pragma("unroll") for (int i = 0; i < 2; ++i) { const int keep = b5 ? r2[i + 2] : r2[i], send = b5 ? r2[i] : r2[i + 2]; r3[i] = keep + (int)partner32((unsigned)send, b5); }              \
        *(unsigned*)(YF + ((size_t)(TILE) * 32 + wid * 4 + (JT)) * DM + 128 * x + 16 * c + 8 * b3 + 4 * b4 + 2 * b5) = pk2((float)r3[0] * SC, (float)r3[1] * SC); } while (0)
    u32x4 vrA[16], vrB[16]; float scA, scB; const int b3 = j & 1, b4 = (j >> 1) & 1, b5 = j >> 2;
    VP_STAGE_LOAD(tile0); VP_STAGE_STORE(0);
    VP_GATHER(vrA, scA, 0, 0, tile0);
    int buf = 0;
#pragma unroll 1
    for (int tile = tile0; tile < TOK / 32; tile += tstep) {
        const int tnext = tile + tstep < TOK / 32 ? tile + tstep : tile;
        VP_STAGE_LOAD(tnext);
        VP_GATHER(vrB, scB, buf, 1, tile); VP_COMPUTE(vrA, scA, buf, 0, tile);
        VP_GATHER(vrA, scA, buf, 2, tile); VP_COMPUTE(vrB, scB, buf, 1, tile);
        VP_GATHER(vrB, scB, buf, 3, tile); VP_COMPUTE(vrA, scA, buf, 2, tile);
        VP_STAGE_STORE(buf ^ 1);
        VP_GATHER(vrA, scA, buf ^ 1, 0, tnext);
        VP_COMPUTE(vrB, scB, buf, 3, tile);
        buf ^= 1;
    }
#undef VP_STAGE_LOAD
#undef VP_STAGE_STORE
#undef VP_GATHER
#undef VP_COMPUTE
}
DI void final_rows2(size_t m0, size_t m1, const bf16_t* __restrict__ Rp, const bf16_t* __restrict__ YF, const float* __restrict__ MOD, const float* __restrict__ g1, const float* __restrict__ b1,
                    const float* __restrict__ ln_g, const float* __restrict__ ln_b, float* __restrict__ OUT) {
    const int lane = threadIdx.x & 63;
    f32x4 v[2][4], y[2][4];
#pragma unroll
    for (int r = 0; r < 2; ++r) { const size_t m = r ? m1 : m0;
        const u32x2* rr = (const u32x2*)(Rp + m * DM) + lane; const u32x2* yr = (const u32x2*)(YF + m * DM) + lane;
#pragma unroll
        for (int q = 0; q < 4; ++q) { const u32x2 rw = rr[64 * q]; v[r][q] = (f32x4){bf_lo(rw.x), bf_hi(rw.x), bf_lo(rw.y), bf_hi(rw.y)}; const u32x2 yy = yr[64 * q]; y[r][q] = (f32x4){bf_lo(yy.x), bf_hi(yy.x), bf_lo(yy.y), bf_hi(yy.y)}; } }
#pragma unroll
    for (int r = 0; r < 2; ++r) { const size_t m = r ? m1 : m0; const int b = (int)(m / SEQ); const f32x4* gt = (const f32x4*)(MOD + (size_t)b * MODW + 5 * DM) + lane; float s = 0.f;
#pragma unroll
        for (int q = 0; q < 4; ++q) s += (v[r][q].x + v[r][q].y) + (v[r][q].z + v[r][q].w);
        float mean = wave_sum(s) * (1.f / DM); float s2 = 0.f;
#pragma unroll
        for (int q = 0; q < 4; ++q) { v[r][q] = v[r][q] - mean; s2 += (v[r][q].x * v[r][q].x + v[r][q].y * v[r][q].y) + (v[r][q].z * v[r][q].z + v[r][q].w * v[r][q].w); }
        float rstd = rsqrtf(wave_sum(s2) * (1.f / DM) + LN_EPS); s = 0.f;
#pragma unroll
        for (int q = 0; q < 4; ++q) { const f32x4 x1 = v[r][q] * rstd * ((const f32x4*)g1)[lane + 64 * q] + ((const f32x4*)b1)[lane + 64 * q];
            v[r][q] = x1 * ALPHA_RES + gt[64 * q] * y[r][q]; s += (v[r][q].x + v[r][q].y) + (v[r][q].z + v[r][q].w); }
        mean = wave_sum(s) * (1.f / DM); s2 = 0.f;
#pragma unroll
        for (int q = 0; q < 4; ++q) { v[r][q] = v[r][q] - mean; s2 += (v[r][q].x * v[r][q].x + v[r][q].y * v[r][q].y) + (v[r][q].z * v[r][q].z + v[r][q].w * v[r][q].w); }
        rstd = rsqrtf(wave_sum(s2) * (1.f / DM) + LN_EPS);
        f32x4* op = (f32x4*)(OUT + m * DM) + lane;
#pragma unroll
        for (int q = 0; q < 4; ++q) op[64 * q] = v[r][q] * rstd * ((const f32x4*)ln_g)[lane + 64 * q] + ((const f32x4*)ln_b)[lane + 64 * q]; }
}
}
constexpr int NWAVES = 8;
#ifndef MK_N_LAUNCHES
#define MK_N_LAUNCHES 1
#endif
constexpr int N_PHASES = 14;
constexpr int RING_BYTES = 147456;
constexpr int MISC_OFF = RING_BYTES;
constexpr int LDS_BYTES = RING_BYTES + 4096;
static_assert(pg8::STAGE_BYTES <= RING_BYTES && datt::LDS_BYTES <= RING_BYTES && mls::LDS_BYTES <= RING_BYTES && peer::LDS_BYTES <= RING_BYTES, "LDS map");

typedef GAS unsigned gu32;
#define RLX_AGENT __ATOMIC_RELAXED, __HIP_MEMORY_SCOPE_AGENT
#define LDS_WAIT() asm volatile("s_waitcnt lgkmcnt(0)" ::: "memory")

#define XB_TMO      128
#define XB_XCNT(j)  (256  + 64 * (j))
#define XB_XSUB(j)  (1280 + 64 * (j))
#define XB_XGEN(j)  (2304 + 64 * (j))
#define XB_TOP      3328
#define XB_TOPGEN   3392
#define XCD_BAR_WORDS 3456
#define XB_SPIN_CAP (1u << 22)
DI unsigned xb_ld(unsigned* p)              { return __hip_atomic_load(p, __ATOMIC_RELAXED, __HIP_MEMORY_SCOPE_AGENT); }
DI unsigned xb_add(unsigned* p, unsigned v) { return __hip_atomic_fetch_add(p, v, __ATOMIC_RELAXED, __HIP_MEMORY_SCOPE_AGENT); }
DI unsigned xb_xcc_id() { return (unsigned)__builtin_amdgcn_s_getreg((3 << 11) | 20) & 0xFu; }
#define XB_SPIN(cond, bar) do { unsigned _sp = 0; while (cond) { __builtin_amdgcn_s_sleep(1); \
    if ((++_sp & 255u) == 0u) { if (xb_ld(&(bar)[XB_TMO])) break; if (_sp > XB_SPIN_CAP) { atomicAdd(&(bar)[XB_TMO], 1u); break; } } } } while (0)
struct XcdBarrier { unsigned* bar; unsigned x; volatile LAS unsigned* st; };
DI XcdBarrier xcd_barrier_post(unsigned* bar, volatile LAS unsigned* st) {
    XcdBarrier b; b.bar = bar; b.x = xb_xcc_id(); b.st = st;
    if (threadIdx.x == 0) st[2] = xb_add(&bar[XB_XCNT(b.x)], 1u);
    return b;
}
DI void xcd_barrier_complete(unsigned* bar, unsigned x, unsigned& nloc, unsigned& nx) {
    const unsigned G = gridDim.x * gridDim.y * gridDim.z;
    unsigned sum, cnt, mine, sp = 0u;
    for (;;) {
        sum = 0u; cnt = 0u; mine = 0u;
#pragma unroll
        for (unsigned j = 0; j < 16; ++j) { const unsigned c = xb_ld(&bar[XB_XCNT(j)]); sum += c; cnt += (c > 0u) ? 1u : 0u; mine = (j == x) ? c : mine; }
        if (sum == G) break;
        __builtin_amdgcn_s_sleep(1);
        if ((++sp & 255u) == 0u) { if (xb_ld(&bar[XB_TMO])) break; if (sp > XB_SPIN_CAP) { atomicAdd(&bar[XB_TMO], 1u); break; } }
    }
    nloc = mine > 0u ? mine : 1u; nx = cnt > 0u ? cnt : 1u;
}
DI void xcd_barrier(const XcdBarrier& b) {
    asm volatile("s_waitcnt vmcnt(0)" ::: "memory");
    __syncthreads();
    if (threadIdx.x == 0) {
        unsigned* bar = b.bar;
        __builtin_amdgcn_s_waitcnt(0);
        unsigned nloc = b.st[0], nx = b.st[1];
        if (nloc == 0u) { xcd_barrier_complete(bar, b.x, nloc, nx); b.st[0] = nloc; b.st[1] = nx; }
        const unsigned old = xb_add(&bar[XB_XSUB(b.x)], 1u);
        const unsigned gen = old / nloc;
        if (old + 1u == (gen + 1u) * nloc) {
            __builtin_amdgcn_fence(__ATOMIC_RELEASE, "agent");
            asm volatile("s_waitcnt vmcnt(0)" ::: "memory");
            const unsigned og = xb_add(&bar[XB_TOP], 1u);
            const unsigned tg = og / nx;
            if (og + 1u == (tg + 1u) * nx) xb_add(&bar[XB_TOPGEN], 1u);
            else XB_SPIN(xb_ld(&bar[XB_TOPGEN]) == tg, bar);
            xb_add(&bar[XB_XGEN(b.x)], 1u);
            __builtin_amdgcn_fence(__ATOMIC_ACQUIRE, "agent");
            asm volatile("s_waitcnt vmcnt(0)" ::: "memory");
        } else {
            XB_SPIN(xb_ld(&bar[XB_XGEN(b.x)]) == gen, bar);
            __builtin_amdgcn_fence(__ATOMIC_ACQUIRE, "agent");
            asm volatile("s_waitcnt vmcnt(0)" ::: "memory");
        }
    }
    __syncthreads();
}

#ifndef FLATBAR
#define FLATBAR 0
#endif
DI void flat_barrier(unsigned* cnt, unsigned& epoch) {
    asm volatile("s_waitcnt vmcnt(0)" ::: "memory");
    __syncthreads();
    if (threadIdx.x == 0) {
        __builtin_amdgcn_fence(__ATOMIC_RELEASE, "agent");
        asm volatile("s_waitcnt vmcnt(0)" ::: "memory");
        const unsigned target = (epoch + 1u) * gridDim.x;
        xb_add(cnt, 1u);
        unsigned sp = 0;
        while (xb_ld(cnt) < target) { __builtin_amdgcn_s_sleep(1); if (++sp > (1u << 24)) break; }
        __builtin_amdgcn_fence(__ATOMIC_ACQUIRE, "agent");
        asm volatile("s_waitcnt vmcnt(0)" ::: "memory");
    }
    ++epoch;
    __syncthreads();
}
DI void p0_transpose_item(const float* W, int ldw, int col0, bf16_t* WT, int K, int dst_row0, int kb, float scale, LAS float* scr, int lane) {
    const int k0 = 64 * kb;
#pragma unroll 8
    for (int i = 0; i < 32; ++i) { const int kk = 2 * i + (lane >> 5); scr[kk * 33 + (lane & 31)] = W[(size_t)(k0 + kk) * ldw + col0 + (lane & 31)] * scale; }
    LDS_WAIT(); asm volatile("" ::: "memory");
    const int c = lane & 7;
#pragma unroll
    for (int j = 0; j < 4; ++j) { const int n = (lane >> 3) + 8 * j; const LAS float* s = scr + (8 * c) * 33 + n;
        u32x4 o; o.x = pk2(s[0 * 33], s[1 * 33]); o.y = pk2(s[2 * 33], s[3 * 33]); o.z = pk2(s[4 * 33], s[5 * 33]); o.w = pk2(s[6 * 33], s[7 * 33]);
        *(u32x4*)(WT + (size_t)(dst_row0 + n) * K + k0 + 8 * c) = o; }
    LDS_WAIT(); asm volatile("" ::: "memory");
}


DI void p1_rows2(int m0, int m1, int lane, const float* __restrict__ xin, const float* __restrict__ MODp, bf16_t* __restrict__ H1p, float* __restrict__ GIFp, const float* __restrict__ bif, const LAS float* wif) {
    f32x4 v[2][4], scv[2][4], shv[2][4];
#pragma unroll
    for (int r = 0; r < 2; ++r) { const int m = r ? m1 : m0; const int b = m / SEQ;
        const f32x4* xr = (const f32x4*)(xin + (size_t)m * DM) + lane; const f32x4* sh = (const f32x4*)(MODp + (size_t)b * MODW) + lane; const f32x4* sc = (const f32x4*)(MODp + (size_t)b * MODW + DM) + lane;
#pragma unroll
        for (int j = 0; j < 4; ++j) { v[r][j] = xr[64 * j]; scv[r][j] = sc[64 * j]; shv[r][j] = sh[64 * j]; } }
#pragma unroll
    for (int r = 0; r < 2; ++r) { const int m = r ? m1 : m0; float s = 0.f;
#pragma unroll
        for (int j = 0; j < 4; ++j) s += (v[r][j].x + v[r][j].y) + (v[r][j].z + v[r][j].w);
        const float mean = wave_sum(s) * (1.f / DM); float s2 = 0.f;
#pragma unroll
        for (int j = 0; j < 4; ++j) { v[r][j] = v[r][j] - mean; s2 += (v[r][j].x * v[r][j].x + v[r][j].y * v[r][j].y) + (v[r][j].z * v[r][j].z + v[r][j].w * v[r][j].w); }
        const float rstd = rsqrtf(wave_sum(s2) * (1.f / DM) + LN_EPS);
        unsigned long long* o8 = (unsigned long long*)(H1p + (size_t)m * DM) + lane;
        float gp[8];
#pragma unroll
        for (int g = 0; g < 8; ++g) gp[g] = 0.f;
        const LAS float* wl = wif + 4 * lane; asm volatile("" : "+v"(wl));
#pragma unroll
        for (int j = 0; j < 4; ++j) { const f32x4 hh = v[r][j] * rstd * (scv[r][j] + 1.0f) + shv[r][j];
            o8[64 * j] = (unsigned long long)pk2(hh.x, hh.y) | ((unsigned long long)pk2(hh.z, hh.w) << 32);
#pragma unroll
            for (int g = 0; g < 8; ++g) { const f32x4 w = *(const LAS f32x4*)(wl + g * 1024 + 256 * j); gp[g] += (hh.x * w.x + hh.y * w.y) + (hh.z * w.z + hh.w * w.w); } }
#pragma unroll
        for (int g = 0; g < 8; ++g) gp[g] = wave_sum(gp[g]);
        if (lane == 0) {
#pragma unroll
            for (int g = 0; g < 8; ++g) GIFp[(size_t)m * 8 + g] = gp[g] + bif[g]; } }
}
template <int NR> DI void p7_rows(int m0, int lane, const bf16_t* __restrict__ Rp, const float* __restrict__ MODp, const float* __restrict__ g1, const float* __restrict__ b1,
                 bf16_t* __restrict__ H2p, unsigned char* __restrict__ H2Qp, float* __restrict__ SHp) {
    f32x4 v[NR][4], scv[4], shv[4];
    { const int b = m0 / SEQ; const f32x4* sh = (const f32x4*)(MODp + (size_t)b * MODW + 3 * DM) + lane; const f32x4* sc = (const f32x4*)(MODp + (size_t)b * MODW + 4 * DM) + lane;
#pragma unroll
      for (int r = 0; r < NR; ++r) { const u32x2* rr = (const u32x2*)(Rp + (size_t)(m0 + r) * DM) + lane;
#pragma unroll
        for (int j = 0; j < 4; ++j) { const u32x2 rw = rr[64 * j]; v[r][j] = (f32x4){bf_lo(rw.x), bf_hi(rw.x), bf_lo(rw.y), bf_hi(rw.y)}; } }
#pragma unroll
      for (int j = 0; j < 4; ++j) { scv[j] = sc[64 * j]; shv[j] = sh[64 * j]; } }
#pragma unroll
    for (int r = 0; r < NR; ++r) { const int m = m0 + r; float s = 0.f;
#pragma unroll
        for (int j = 0; j < 4; ++j) s += (v[r][j].x + v[r][j].y) + (v[r][j].z + v[r][j].w);
        float mean = wave_sum(s) * (1.f / DM); float s2 = 0.f;
#pragma unroll
        for (int j = 0; j < 4; ++j) { v[r][j] = v[r][j] - mean; s2 += (v[r][j].x * v[r][j].x + v[r][j].y * v[r][j].y) + (v[r][j].z * v[r][j].z + v[r][j].w * v[r][j].w); }
        float rstd = rsqrtf(wave_sum(s2) * (1.f / DM) + LN_EPS);
        s = 0.f;
#pragma unroll
        for (int j = 0; j < 4; ++j) { v[r][j] = v[r][j] * rstd * ((const f32x4*)g1)[lane + 64 * j] + ((const f32x4*)b1)[lane + 64 * j]; s += (v[r][j].x + v[r][j].y) + (v[r][j].z + v[r][j].w); }
        mean = wave_sum(s) * (1.f / DM); s2 = 0.f;
#pragma unroll
        for (int j = 0; j < 4; ++j) { v[r][j] = v[r][j] - mean; s2 += (v[r][j].x * v[r][j].x + v[r][j].y * v[r][j].y) + (v[r][j].z * v[r][j].z + v[r][j].w * v[r][j].w); }
        rstd = rsqrtf(wave_sum(s2) * (1.f / DM) + LN_EPS);
        unsigned long long* o8 = (unsigned long long*)(H2p + (size_t)m * DM) + lane;
        float amax = 0.f;
#pragma unroll
        for (int j = 0; j < 4; ++j) { const f32x4 hh = v[r][j] * rstd * (scv[j] + 1.0f) + shv[j]; o8[64 * j] = (unsigned long long)pk2(hh.x, hh.y) | ((unsigned long long)pk2(hh.z, hh.w) << 32);
            v[r][j] = hh; amax = fmaxf(amax, fmaxf(fmaxf(fabsf(hh.x), fabsf(hh.y)), fmaxf(fabsf(hh.z), fabsf(hh.w)))); }
        amax = wave_max(amax);
        const float qinv = amax > 0.f ? 119.0f / amax : 0.f;
        unsigned char* hq = H2Qp + (size_t)m * DM;
#pragma unroll
        for (int j = 0; j < 4; ++j) { const int q0 = (int)rintf(v[r][j].x * qinv), q1 = (int)rintf(v[r][j].y * qinv), q2 = (int)rintf(v[r][j].z * qinv), q3 = (int)rintf(v[r][j].w * qinv);
            const int a0 = (q0 + 8) >> 4, a1 = (q1 + 8) >> 4, a2 = (q2 + 8) >> 4, a3 = (q3 + 8) >> 4;
            const unsigned ha = (unsigned)(a0 & 15) | ((unsigned)(a1 & 15) << 4) | ((unsigned)(a2 & 15) << 8) | ((unsigned)(a3 & 15) << 12);
            const unsigned hb = (unsigned)((q0 - 16 * a0) & 15) | ((unsigned)((q1 - 16 * a1) & 15) << 4) | ((unsigned)((q2 - 16 * a2) & 15) << 8) | ((unsigned)((q3 - 16 * a3) & 15) << 12);
            const unsigned pa = (unsigned)dppi<0xB1>((int)ha), pb = (unsigned)dppi<0xB1>((int)hb);
            if (!(lane & 1)) { *(unsigned*)(hq + 128 * j + 2 * lane) = ha | (pa << 16); *(unsigned*)(hq + 512 + 128 * j + 2 * lane) = hb | (pb << 16); } }
        if (lane == 0) SHp[m] = amax * (1.0f / 119.0f); }
}


DI void prep_small_weights_item(LAS unsigned char* lds, int item, const float* w0, const float* w1, const float* w2, const float* w3, bf16_t* d0, bf16_t* d1, bf16_t* d2, bf16_t* d3) {
    int t = threadIdx.x; OPAQUE(t); const int lane = t & 63, wave = __builtin_amdgcn_readfirstlane(t >> 6);
    const int r = item * 8 + wave, wsel = r / 512, q = r % 512, kb = q / 32, nb = q % 32;
    const float* src = wsel == 0 ? w0 : wsel == 1 ? w1 : wsel == 2 ? w2 : w3; bf16_t* dst = wsel == 0 ? d0 : wsel == 1 ? d1 : wsel == 2 ? d2 : d3;
    p0_transpose_item(src, DM, 32 * nb, dst, DM, 32 * nb, kb, 1.0f, (LAS float*)(lds + wave * 16384), lane);
}
DI void prep_quant_item(int item, const float* pu, const float* pv, unsigned char* U8, unsigned char* V8, float* SU, float* SV) {
    int t = threadIdx.x; OPAQUE(t); const int lane = t & 63, wave = __builtin_amdgcn_readfirstlane(t >> 6);
#pragma unroll 1
    for (int it = 0; it < 4; ++it) { const int row0 = item * 128 + wave * 16 + it * 4;
        f32x4 a[4][4];
#pragma unroll
        for (int r = 0; r < 4; ++r) { const int row = row0 + r; const bool second = row >= NEXP; const int e = second ? row - NEXP : row;
            const float* s = (second ? pv : pu) + (size_t)e * DM + 16 * lane;
#pragma unroll
            for (int j = 0; j < 4; ++j) a[r][j] = *(const f32x4*)(s + 4 * j); }
#pragma unroll
        for (int r = 0; r < 4; ++r) { const int row = row0 + r; const bool second = row >= NEXP; const int e = second ? row - NEXP : row;
            float amax = 0.f;
#pragma unroll
            for (int j = 0; j < 4; ++j) amax = fmaxf(amax, fmaxf(fmaxf(fabsf(a[r][j].x), fabsf(a[r][j].y)), fmaxf(fabsf(a[r][j].z), fabsf(a[r][j].w))));
            amax = wave_max(amax);
            if (second) {
            const float inv = amax > 0.f ? 127.0f / amax : 0.f;
            u32x4 w;
#pragma unroll
            for (int j = 0; j < 4; ++j) { const int q0 = (int)rintf(a[r][j].x * inv), q1 = (int)rintf(a[r][j].y * inv), q2 = (int)rintf(a[r][j].z * inv), q3 = (int)rintf(a[r][j].w * inv);
                w[j] = (unsigned)(q0 & 255) | ((unsigned)(q1 & 255) << 8) | ((unsigned)(q2 & 255) << 16) | ((unsigned)(q3 & 255) << 24); }
            *(u32x4*)(V8 + (size_t)(lane >> 3) * NEXP * 128 + (size_t)e * 128 + (lane & 7) * 16) = w;
            if (lane == 0) SV[e] = amax * (1.0f / 127.0f);
            } else {
            const float inv = amax > 0.f ? 7.0f / amax : 0.f;
            u32x2 w;
#pragma unroll
            for (int j = 0; j < 4; ++j) { const unsigned n0 = (unsigned)((int)rintf(a[r][j].x * inv) & 15), n1 = (unsigned)((int)rintf(a[r][j].y * inv) & 15), n2 = (unsigned)((int)rintf(a[r][j].z * inv) & 15), n3 = (unsigned)((int)rintf(a[r][j].w * inv) & 15);
                const unsigned two = n0 | (n1 << 4) | (n2 << 8) | (n3 << 12);
                if (j & 1) w[j >> 1] |= two << 16; else w[j >> 1] = two; }
            *(u32x2*)(U8 + (size_t)(lane >> 4) * NEXP * 128 + (size_t)e * 128 + (lane & 15) * 8) = w;
            if (lane == 0) SU[e] = amax * (1.0f / 7.0f);
            } } }
}

struct Args { const float* in[22]; float* out; unsigned char* ws; int ph_lo, ph_hi; };

__global__ void __launch_bounds__(NWAVES * 64, 2) mega_fwd(Args args) {
    extern __shared__ __attribute__((aligned(16))) unsigned char lds_raw[];
    LAS unsigned char* lds = (LAS unsigned char*)lds_raw;
    volatile LAS unsigned* MISC = (volatile LAS unsigned*)(lds + MISC_OFF);
    const int tid = threadIdx.x, lane = tid & 63, wave = __builtin_amdgcn_readfirstlane(tid >> 6);
    const int G = gridDim.x; const int bx = blockIdx.x; const int vcu = (G % 8 == 0) ? (bx % 8) * (G / 8) + bx / 8 : bx;
    const int gw = vcu * NWAVES + wave, NGW = G * NWAVES;
#define ws (args.ws)
#define ctl ((unsigned*)(ws + WS_CTL))
#define x_in (args.in[0])
#define cvec (args.in[1])
#define w_ada (args.in[2])
#define b_ada (args.in[3])
#define w_in (args.in[4])
#define b_if (args.in[5])
#define conv_w (args.in[6])
#define conv_b (args.in[7])
#define da_lambda (args.in[8])
#define da_subln_g (args.in[9])
#define ml_norm_g (args.in[10])
#define w_br_attn (args.in[11])
#define w_br_mlstm (args.in[12])
#define w_out (args.in[13])
#define ln1_g (args.in[14])
#define ln1_b (args.in[15])
#define peer_wq (args.in[16])
#define peer_keys (args.in[17])
#define peer_u (args.in[18])
#define peer_v (args.in[19])
#define ln2_g (args.in[20])
#define ln2_b (args.in[21])
#define MOD ((float*)(ws + WS_MOD))
#define GIF ((float*)(ws + WS_GIF))
#define WIN ((bf16_t*)(ws + WS_WIN))
#define WA ((bf16_t*)(ws + WS_WA))
#define WM ((bf16_t*)(ws + WS_WM))
#define WOUT ((bf16_t*)(ws + WS_WOUT))
#define WQ ((bf16_t*)(ws + WS_WQ))
#define UT8 ((unsigned char*)(ws + WS_U))
#define VT8 ((unsigned char*)(ws + WS_V))
#define SUS ((float*)(ws + WS_SU))
#define SVS ((float*)(ws + WS_SV))
#define SHS ((float*)(ws + WS_SH))
#define CSS ((float*)(ws + WS_CS))
#define H2Q ((unsigned char*)(ws + WS_H2Q))
#define SELE ((bf16_t*)(ws + WS_SELE))
#define SELG ((float*)(ws + WS_SELG))
#define PART ((bf16_t*)(ws + WS_PART))
#define YFB ((bf16_t*)(ws + WS_YF))
#define COEF ((signed char*)(ws + WS_COEF))
#define H1 ((bf16_t*)(ws + WS_H1))
#define Z ((bf16_t*)(ws + WS_Z))
#define R ((bf16_t*)(ws + WS_R))
#define X1 ((float*)(ws + WS_X1))
#define H2 ((bf16_t*)(ws + WS_H2))
#define QP ((bf16_t*)(ws + WS_QP))
#define GATES ((bf16_t*)args.out)

    for (int u = tid; u < (LDS_BYTES - MISC_OFF) / 4; u += NWAVES * 64) MISC[u] = 0u;
    __syncthreads();
    XcdBarrier bar; bar.bar = ctl + CW_BAR; bar.x = 0; bar.st = nullptr;
    if (MK_N_LAUNCHES != N_PHASES) bar = xcd_barrier_post(ctl + CW_BAR, MISC + 8);
    const int lo = args.ph_lo, hi = args.ph_hi;
#ifndef PH_MASK
#define PH_MASK 0x3fff
#endif
#define IN(k) (((PH_MASK >> (k)) & 1) && lo <= (k) && (k) < hi)
    unsigned fepoch = 0; unsigned* fcnt = ctl + CW_QUEUE + 1024;
#if FLATBAR
#define GBAR() flat_barrier(fcnt, fepoch)
#else
#define GBAR() xcd_barrier(bar)
#endif
#define SEAM(k) do { if (IN(k) && IN((k) + 1)) GBAR(); } while (0)

#ifndef XBAR0
#define XBAR0 0
#endif
#if XBAR0
    if (IN(0)) for (int xb = 0; xb < XBAR0; ++xb) xcd_barrier(bar);
#endif
    if (IN(0)) {
        if (vcu * NWAVES < 96 * 8) {
            LAS float* sl = (LAS float*)lds;
            for (int i = tid; i < 32 * DM; i += NWAVES * 64) sl[i] = siluf_(cvec[i]);
            __syncthreads();
            for (int it = gw; it < 96 * 8; it += NGW) {
                const int cb = it % 96, ks = it / 96, col = 64 * cb + lane;
                float acc[32];
#pragma unroll
                for (int b = 0; b < 32; ++b) acc[b] = 0.f;
#pragma unroll 4
                for (int k = 128 * ks; k < 128 * ks + 128; ++k) { const float w = w_ada[(size_t)k * MODW + col];
#pragma unroll
                    for (int b = 0; b < 32; ++b) acc[b] += sl[b * DM + k] * w; }
                const float bias = (ks == 0) ? b_ada[col] : 0.f;
#pragma unroll
                for (int b = 0; b < 32; ++b) atomicAdd(MOD + b * MODW + col, acc[b] + bias);
            }
            __syncthreads();
        }
        LAS float* scr = (LAS float*)(lds + wave * 16384);
        const bool spare = NGW > 96 * 8 + 64; const int tw = spare ? gw - 96 * 8 : gw, ntw = spare ? NGW - 96 * 8 : NGW;
        if (tw >= 0) for (int it = tw; it < 4096; it += ntw) { const int kb = it / 256, nb = it % 256, n0 = 32 * nb; p0_transpose_item(w_in, IN_W, n0 < NZ ? n0 : n0 + 8, WIN, DM, n0, kb, n0 < 1024 ? QSCALE : 1.0f, scr, lane); }
    }
    SEAM(0);
    if (IN(1)) {
        LAS float* wif = (LAS float*)lds;
        for (int i = tid; i < 8192; i += 512) { const int k = i >> 3, j = i & 7; wif[j * 1024 + k] = w_in[(size_t)k * IN_W + NZ + j]; }
        __syncthreads();
        for (int m = gw; m < TOK; m += 2 * NGW) p1_rows2(m, m + NGW, lane, x_in, MOD, H1, GIF, b_if, wif);
    }
#if DUP1
    GBAR();
    if (IN(1)) {
        LAS float* wif = (LAS float*)lds;
        for (int i = tid; i < 8192; i += 512) { const int k = i >> 3, j = i & 7; wif[j * 1024 + k] = w_in[(size_t)k * IN_W + NZ + j]; }
        __syncthreads();
        for (int m = gw; m < TOK; m += 2 * NGW) p1_rows2(m, m + NGW, lane, x_in, MOD, H1, GIF, b_if, wif);
    }
#endif
    SEAM(1);
#ifndef DUP4
#define DUP4 0
#endif
#ifndef DUP6
#define DUP6 0
#endif
#ifndef DUP7
#define DUP7 0
#endif
#ifndef DUP8
#define DUP8 0
#endif
#ifndef DUP1
#define DUP1 0
#endif
#ifndef DUP2
#define DUP2 0
#endif
#ifndef DUP23
#define DUP23 0
#endif
#ifndef P2_STAGGER
#define P2_STAGGER 0
#endif
#define P2_BODY if (IN(2)) { if (P2_STAGGER && ((bx >> 3) & 1)) { const unsigned long long t0_ = __builtin_amdgcn_s_memrealtime(); while (__builtin_amdgcn_s_memrealtime() - t0_ < P2_STAGGER) __builtin_amdgcn_s_sleep(64); } \
        pg8::Gemm g{H1, WIN, TOK, NIN, DM, DM, DM}; pg8::StaticOrder S; S.init(TOK, NIN, G, bx); pg8::EpiZ E{Z, GATES}; \
        pg8::gemm_phase<pg8::EpiZ, pg8::StaticOrder, true, true>(lds, g, S, E); }
#define P3_BODY(QOFF) if (IN(3)) { const float p3_lam = datt::attn_lambda(da_lambda); unsigned* qhead = ctl + CW_QUEUE + (QOFF); int qx = (int)(bar.x & 7u), qtries = 0; const unsigned qlen = 16u + 256u + ((QOFF) == 0 ? 64u : 0u); \
        for (;;) { __syncthreads(); \
            if (tid == 0) { unsigned w = 0xffffffffu; while (qtries < 8) { const unsigned k = __hip_atomic_fetch_add(qhead + qx, 1u, RLX_AGENT); if (k < qlen) { w = ((unsigned)qx << 16) | k; break; } qx = (qx + 1) & 7; ++qtries; } MISC[0] = w; } \
            __syncthreads(); \
            const unsigned w = MISC[0]; if (w == 0xffffffffu) break; const int q = (int)(w >> 16), k = (int)(w & 0xffffu); \
            if (k < 16) { const int u = q * 16 + k; mls::mlstm_unit<false>(lds, Z, GIF, conv_w, conv_b, ml_norm_g, u >> 2, u & 3); } \
            else if (k < 272) { const int a = k - 16, a2 = a & 127, qb = ((a >> 7) ? 3 : 7) - (a2 & 3), bh = q * 32 + (a2 >> 2); datt::attn_unit<false>(lds, Z, p3_lam, da_subln_g, bh >> 3, bh & 7, qb); } \
            else { const int pid = q * 64 + (k - 272); \
                if (pid < 256) prep_quant_item(pid, peer_u, peer_v, UT8, VT8, SUS, SVS); \
                else prep_small_weights_item(lds, pid - 256, w_br_attn, w_br_mlstm, w_out, peer_wq, WA, WM, WOUT, WQ); } } }
#define P3A_DRY(QOFF) if (IN(3)) { const float p3_lam = datt::attn_lambda(da_lambda); unsigned* qhead = ctl + CW_QUEUE + (QOFF); \
        for (;;) { __syncthreads(); if (tid == 0) MISC[0] = __hip_atomic_fetch_add(qhead, 1u, RLX_AGENT); __syncthreads(); \
            const int id = (int)MISC[0]; if (id >= 2048) break; \
            { const int idx = id, qb = 7 - idx / 256, bh = idx % 256; datt::attn_unit<true>(lds, Z, p3_lam, da_subln_g, bh >> 3, bh & 7, qb); } } }
#define P3M_DRY(QOFF) if (IN(3)) { unsigned* qhead = ctl + CW_QUEUE + (QOFF); \
        for (;;) { __syncthreads(); if (tid == 0) MISC[0] = __hip_atomic_fetch_add(qhead, 1u, RLX_AGENT); __syncthreads(); \
            const int id = (int)MISC[0]; if (id >= 128) break; \
            mls::mlstm_unit<true, MLS_ABL>(lds, Z, GIF, conv_w, conv_b, ml_norm_g, id >> 2, id & 3); } }
#ifndef MLS_ABL
#define MLS_ABL 0
#endif
#ifndef DRY3A
#define DRY3A 0
#endif
#ifndef DRY3M
#define DRY3M 0
#endif
    P2_BODY
#if DUP2
    SEAM(2);
    P2_BODY
#endif
    SEAM(2);
#if DRY3A
    P3A_DRY(128)
    if (IN(3)) GBAR();
#endif
#if DRY3M
    P3M_DRY(192)
    if (IN(3)) GBAR();
#endif
    P3_BODY(0)
    SEAM(3);
#if DUP23
    P2_BODY
    SEAM(2);
    P3_BODY(64)
    SEAM(3);
#endif
    if (IN(4)) {
        pg8::Gemm g{Z + ZC_Q, WA, TOK, DM, DM, NZ, DM, (long)(ZC_MV - ZC_Q) * 2, (long)(WS_WM - WS_WA)}; pg8::StaticOrder2 S; S.init(TOK, DM, G, bx);
        pg8::EpiGate2 E{GATES, H1};
        pg8::gemm_phase<pg8::EpiGate2, pg8::StaticOrder2, true, true>(lds, g, S, E);
    }
    SEAM(4);
#define WG_SEAM() do { asm volatile("s_waitcnt vmcnt(0)" ::: "memory"); __syncthreads(); \
        if (tid == 0) { __builtin_amdgcn_fence(__ATOMIC_ACQUIRE, "agent"); asm volatile("s_waitcnt vmcnt(0)" ::: "memory"); } __syncthreads(); } while (0)
    if (IN(6)) {
        { pg8::Gemm g{H1, WOUT, TOK, DM, DM, DM, DM}; pg8::RowsOrder S; S.init(TOK, DM, G, bx);
          pg8::EpiR E{x_in, MOD, R};
          pg8::gemm_phase<pg8::EpiR, pg8::RowsOrder, true, true>(lds, g, S, E); }
        WG_SEAM();
        for (int pm = bx; pm < TOK / 256; pm += G)
#pragma unroll 1
            for (int k = 0; k < 8; ++k) p7_rows<4>(256 * pm + 32 * wave + 4 * k, lane, R, MOD, ln1_g, ln1_b, H2, H2Q, SHS);
        WG_SEAM();
        { pg8::Gemm g{H2, WQ, TOK, DM, DM, DM, DM}; pg8::RowsOrder S; S.init(TOK, DM, G, bx);
          pg8::EpiStore E{QP};
          pg8::gemm_phase<pg8::EpiStore, pg8::RowsOrder, true, true>(lds, g, S, E); }
        WG_SEAM();
        peer::stage_keys(lds, peer_keys);
        __syncthreads();
        for (int pm = bx; pm < TOK / 256; pm += G) peer::select_phase(lds, QP, 8 * pm, 1, 8 * pm + 8, SELE, SELG);
    }
#undef WG_SEAM
    if (IN(6) && IN(10)) GBAR();
    int sx = bx % 8, sr = bx / 8, sn = (G - sx + 7) / 8;
    if (IN(10) || IN(12)) {
        __syncthreads();
        if (tid == 0) { bool phys = (MK_N_LAUNCHES != N_PHASES) && lo == 0 && hi > 10; unsigned mine = 0;
            if (phys) { for (unsigned j = 0; j < 16; ++j) { const unsigned c = xb_ld(&bar.bar[XB_XCNT(j)]); if (j < 8) { if (c == 0u) phys = false; if (j == bar.x) mine = c; } else if (c != 0u) phys = false; } }
            MISC[16] = phys ? bar.x : (unsigned)sx; MISC[17] = phys ? MISC[10] : (unsigned)sr; MISC[18] = phys ? mine : (unsigned)sn; }
        __syncthreads();
        sx = (int)MISC[16]; sr = (int)MISC[17]; sn = (int)MISC[18];
    }
    if (IN(10)) {
        peer::u_phase(lds, 2 * sr + (sx >> 2), 2 * sn, sx & 3, SELE, H2Q, UT8, PART);
    }
    SEAM(10);
    if (IN(11)) { for (int m = 16 * gw; m < TOK; m += 16 * NGW) peer::red_tokens<16>((size_t)m, PART, SELE, SELG, SUS, SVS, SHS, COEF, CSS); }
    SEAM(11);
    if (IN(12)) {
        peer::v_phase(lds, sr, sn, sx, SELE, COEF, CSS, VT8, YFB);
    }
    SEAM(12);
    if (IN(13)) { for (int m = gw; m < TOK; m += 2 * NGW) peer::final_rows2((size_t)m, (size_t)m + NGW, R, YFB, MOD, ln1_g, ln1_b, ln2_g, ln2_b, args.out); }
#undef IN
#undef SEAM
#undef ws
#undef ctl
#undef x_in
#undef cvec
#undef w_ada
#undef b_ada
#undef w_in
#undef b_if
#undef conv_w
#undef conv_b
#undef da_lambda
#undef da_subln_g
#undef ml_norm_g
#undef w_br_attn
#undef w_br_mlstm
#undef w_out
#undef ln1_g
#undef ln1_b
#undef peer_wq
#undef peer_keys
#undef peer_u
#undef peer_v
#undef ln2_g
#undef ln2_b
#undef MOD
#undef GIF
#undef WIN
#undef WA
#undef WM
#undef WOUT
#undef WQ
#undef UT8
#undef VT8
#undef SUS
#undef SVS
#undef SHS
#undef CSS
#undef H2Q
#undef SELE
#undef SELG
#undef PART
#undef YFB
#undef COEF
#undef H1
#undef Z
#undef R
#undef X1
#undef H2
#undef QP
#undef GATES
}

extern "C" void kernel_launch(void* const* d_in, const int* in_sizes, int n_in, void* d_out, int out_size, void* d_ws, size_t ws_size, hipStream_t stream) {
    static int grid = 0;
    if (grid == 0) {
        if (n_in != 22 || in_sizes[0] != TOK * DM || out_size != TOK * DM || ws_size < WS_END) { fprintf(stderr, "kernel_launch: unexpected shapes (n_in %d, in0 %d, out %d, ws %zu; need ws >= %zu)\n", n_in, n_in > 0 ? in_sizes[0] : -1, out_size, ws_size, (size_t)WS_END); grid = -1; return; }
        int dev = 0, cus = 0, per_cu = 0;
        if (hipGetDevice(&dev) != hipSuccess || hipDeviceGetAttribute(&cus, hipDeviceAttributeMultiprocessorCount, dev) != hipSuccess) { fprintf(stderr, "kernel_launch: device query failed\n"); grid = -1; return; }
        if (hipFuncSetAttribute((const void*)mega_fwd, hipFuncAttributeMaxDynamicSharedMemorySize, LDS_BYTES) != hipSuccess) { fprintf(stderr, "kernel_launch: hipFuncSetAttribute failed\n"); grid = -1; return; }
        if (hipOccupancyMaxActiveBlocksPerMultiprocessor(&per_cu, (const void*)mega_fwd, NWAVES * 64, LDS_BYTES) != hipSuccess || per_cu < 1) fprintf(stderr, "kernel_launch: note: occupancy query reports %d workgroups per CU\n", per_cu);
        (void)hipGetLastError();
        grid = cus;
    }
    if (grid < 0) return;
    if (hipMemsetAsync((char*)d_ws + WS_CTL, 0, CTL_ZERO_BYTES, stream) != hipSuccess) { fprintf(stderr, "kernel_launch: memset failed\n"); return; }
    Args a{};
    for (int i = 0; i < 22; ++i) a.in[i] = (const float*)d_in[i];
    a.out = (float*)d_out; a.ws = (unsigned char*)d_ws;
    for (int li = 0; li < MK_N_LAUNCHES; ++li) {
        a.ph_lo = (MK_N_LAUNCHES == N_PHASES) ? li : 0; a.ph_hi = (MK_N_LAUNCHES == N_PHASES) ? li + 1 : N_PHASES;
        hipLaunchKernelGGL(mega_fwd, dim3(grid), dim3(NWAVES * 64), LDS_BYTES, stream, a);
        const hipError_t le = hipPeekAtLastError();
        if (le != hipSuccess) { fprintf(stderr, "kernel_launch: launch %d failed: %s\n", li, hipGetErrorName(le)); break; }
    }
}
```

```cpp
#include <hip/hip_runtime.h>
#include <hip/hip_bf16.h>
#include <cstdio>
#include <cstdint>
#include <cmath>

#define LAS __attribute__((address_space(3)))
#define GAS __attribute__((address_space(1)))
typedef unsigned short bf16_t;
typedef short bf16x8 __attribute__((ext_vector_type(8)));
typedef short s16x4 __attribute__((ext_vector_type(4)));
typedef float f32x2 __attribute__((ext_vector_type(2)));
typedef float f32x4 __attribute__((ext_vector_type(4)));
typedef float f32x16 __attribute__((ext_vector_type(16)));
typedef unsigned u32x2 __attribute__((ext_vector_type(2)));
typedef unsigned u32x4 __attribute__((ext_vector_type(4)));
typedef __bf16 bf16x2_t __attribute__((ext_vector_type(2)));
#define DI __device__ __forceinline__

constexpr int BATCH = 32, SEQ = 2048, DM = 1024, TOK = BATCH * SEQ;
constexpr int NZ = 6144;
constexpr int ZC_Q = 0, ZC_K = 1024, ZC_V = 2048, ZC_MQ = 3072, ZC_MK = 3584, ZC_MV = 4096, ZC_MO = 5120;
constexpr int NGATE = 2048;
constexpr int NIN = 8192;
constexpr int IN_W = 8200;
constexpr int MODW = 6 * DM;
constexpr float LN_EPS = 1e-5f;
constexpr float ALPHA_RES = 1.189207115002721f;
constexpr float LAMBDA_INIT = 0.2f;
constexpr float QSCALE = 0.125f * 1.4426950408889634f;
constexpr int NEXP = 16384;

constexpr size_t MiB = 1u << 20;
constexpr size_t WS_CTL = 0, CTL_ZERO_BYTES = 2 * MiB;
constexpr size_t WS_MOD = 1 * MiB;
constexpr size_t WS_GIF = 3 * MiB;
constexpr size_t WS_WIN = 6 * MiB;
constexpr size_t WS_WA = 22 * MiB, WS_WM = 24 * MiB, WS_WOUT = 26 * MiB, WS_WQ = 28 * MiB;
constexpr size_t WS_U = 30 * MiB, WS_V = 62 * MiB;
constexpr size_t WS_SU = 2 * MiB, WS_SV = 2 * MiB + 65536, WS_SH = 2 * MiB + 131072, WS_CS = 2 * MiB + 393216;
constexpr size_t WS_H2Q = 352 * MiB, WS_SELE = 416 * MiB, WS_SELG = 432 * MiB;
constexpr size_t WS_H1 = 96 * MiB;
constexpr size_t WS_Z = 224 * MiB;
constexpr size_t WS_R = WS_Z, WS_X1 = WS_Z + 256 * MiB, WS_H2 = WS_Z + 512 * MiB, WS_QP = WS_Z + 640 * MiB;
constexpr size_t WS_PART = WS_X1, WS_COEF = WS_H2, WS_YF = WS_QP;
constexpr size_t WS_PART_UNUSED = 0, WS_COEF_UNUSED = 0;
constexpr size_t WS_END = 992 * MiB;
constexpr int CW_BAR = 4096;
constexpr int CW_QUEUE = 16384;

DI unsigned pk2(float lo, float hi) { f32x2 v = {lo, hi}; bf16x2_t b = __builtin_convertvector(v, bf16x2_t); return __builtin_bit_cast(unsigned, b); }
DI float bf_lo(unsigned u) { return __uint_as_float(u << 16); }
DI float bf_hi(unsigned u) { return __uint_as_float(u & 0xffff0000u); }
DI float bf2f(bf16_t h) { return __uint_as_float(((unsigned)h) << 16); }
template <int CTRL> DI float dppf(float v) { return __builtin_bit_cast(float, __builtin_amdgcn_update_dpp(0, __builtin_bit_cast(int, v), CTRL, 0xF, 0xF, true)); }
DI float row_sum16(float v) { v += dppf<0xB1>(v); v += dppf<0x4E>(v); v += dppf<0x141>(v); v += dppf<0x140>(v); return v; }
DI float row_max16(float v) { v = fmaxf(v, dppf<0xB1>(v)); v = fmaxf(v, dppf<0x4E>(v)); v = fmaxf(v, dppf<0x141>(v)); v = fmaxf(v, dppf<0x140>(v)); return v; }
template <int CTRL> DI int dppi(int v) { return __builtin_amdgcn_update_dpp(0, v, CTRL, 0xF, 0xF, true); }
DI float sum32x(float v) { auto rr = __builtin_amdgcn_permlane32_swap(__builtin_bit_cast(unsigned, v), __builtin_bit_cast(unsigned, v), false, false); return __builtin_bit_cast(float, (unsigned)rr[0]) + __builtin_bit_cast(float, (unsigned)rr[1]); }
DI float max32x(float v) { auto rr = __builtin_amdgcn_permlane32_swap(__builtin_bit_cast(unsigned, v), __builtin_bit_cast(unsigned, v), false, false); return fmaxf(__builtin_bit_cast(float, (unsigned)rr[0]), __builtin_bit_cast(float, (unsigned)rr[1])); }
DI int isum32x(int v) { auto rr = __builtin_amdgcn_permlane32_swap((unsigned)v, (unsigned)v, false, false); return (int)rr[0] + (int)rr[1]; }
DI unsigned partner32(unsigned v, int hi) { auto rr = __builtin_amdgcn_permlane32_swap(v, v, false, false); return hi ? (unsigned)rr[0] : (unsigned)rr[1]; }
DI float rdlane(float v, int l) { return __builtin_bit_cast(float, __builtin_amdgcn_readlane(__builtin_bit_cast(int, v), l)); }
DI float wave_sum(float v) { v = row_sum16(v); return (rdlane(v, 0) + rdlane(v, 16)) + (rdlane(v, 32) + rdlane(v, 48)); }
DI float wave_max(float v) { v = row_max16(v); return fmaxf(fmaxf(rdlane(v, 0), rdlane(v, 16)), fmaxf(rdlane(v, 32), rdlane(v, 48))); }
DI float half_sum32(float v) { v = row_sum16(v); return v + __builtin_bit_cast(float, __builtin_amdgcn_ds_swizzle(__builtin_bit_cast(int, v), 0x401F)); }
DI float sigmoidf_(float x) { return __builtin_amdgcn_rcpf(1.0f + __builtin_amdgcn_exp2f(x * -1.4426950408889634f)); }
DI float siluf_(float x) { return x * __builtin_amdgcn_rcpf(1.0f + __builtin_amdgcn_exp2f(x * -1.4426950408889634f)); }
DI int crow(int r, int hi) { return (r & 3) + 8 * (r >> 2) + 4 * hi; }
#define MFMA32(a, b, c) __builtin_amdgcn_mfma_f32_32x32x16_bf16((a), (b), (c), 0, 0, 0)
DI bf16x8 pack_step(const f32x16& x, int s) {
    u32x4 p;
    p[0] = pk2(x[8 * s + 0], x[8 * s + 1]); p[1] = pk2(x[8 * s + 2], x[8 * s + 3]); p[2] = pk2(x[8 * s + 4], x[8 * s + 5]); p[3] = pk2(x[8 * s + 6], x[8 * s + 7]);
    return __builtin_bit_cast(bf16x8, p);
}
DI unsigned off_b(unsigned row, unsigned ch) { return 256u * row + 16u * (ch ^ (((row & 3) << 2) | ((row >> 2) & 3))); }
DI unsigned row_read_addr(unsigned lane, unsigned rt, unsigned s) { return off_b(32 * rt + (lane & 31), 2 * s + (lane >> 5)); }
DI unsigned tr_read_addr(unsigned lane, unsigned c, unsigned ks, unsigned t) {
    const unsigned h = lane >> 5, blk = (lane >> 4) & 1, q = (lane & 15) >> 2, p = lane & 3;
    return off_b(16 * ks + 8 * h + 4 * t + q, 4 * c + 2 * blk + (p >> 1)) + 8 * (p & 1);
}
DI unsigned tr_base(unsigned lane, unsigned t) { const unsigned h = lane >> 5, blk = (lane >> 4) & 1, q = (lane & 15) >> 2, p = lane & 3, cl = 2 * blk + (p >> 1);
    return 256u * (8 * h + 4 * t + q) + 16u * (cl ^ (2 * h + t)) + 8u * (p & 1); }
#define OPAQUE(x) asm volatile("" : "+v"(x))
#define OPAQUE(x) asm volatile("" : "+v"(x))
typedef short v4i16_t __attribute__((ext_vector_type(4)));
DI s16x4 tr_read(const LAS unsigned char* p) { return __builtin_bit_cast(s16x4, __builtin_amdgcn_ds_read_tr16_b64_v4i16((LAS v4i16_t*)p)); }
DI bf16x8 cat8(s16x4 lo, s16x4 hi) { return __builtin_shufflevector(lo, hi, 0, 1, 2, 3, 4, 5, 6, 7); }
namespace pg8 {
#define PG8_LAS __attribute__((address_space(3)))
typedef unsigned short bf16_t;
typedef short bf16x8 __attribute__((ext_vector_type(8)));
typedef float f32x4 __attribute__((ext_vector_type(4)));
typedef unsigned u32x4 __attribute__((ext_vector_type(4)));
constexpr int BM = 256, BK = 64, HALF = 128, HTB = HALF * BK * 2  , STAGE_BYTES = 8 * HTB, NXCD = 8, WGM = 8;

__host__ __device__ __forceinline__ int lds_byte(int r, int c) { const int st = (r >> 4) * 2 + (c >> 5), rr = r & 15, cc = c & 31, ob = rr * 64 + cc * 2; return st * 1024 + (ob ^ (((ob >> 9) & 1) << 5)); }
__host__ __device__ __forceinline__ void stage_rc(int b, int& R, int& C) { const int st = b / 1024, sb = b % 1024, swz = sb ^ (((sb >> 9) & 1) << 5); R = (st >> 1) * 16 + swz / 64; C = (st & 1) * 32 + (swz % 64) / 2; }
__host__ __device__ __forceinline__ int perm32(int rho) { const int n = rho >> 4, i = rho & 15; return 8 * (i >> 2) + 4 * n + (i & 3); }

struct Unit { int pm, pn, ph; };
struct Gemm { const bf16_t* A; const bf16_t* Bt; int M, N, K, lda, ldb; long jA, jB; };

struct StaticOrder {
    int nM, nN, nwg, G, c;
    __host__ __device__ void init(int M, int N, int G_, int c_) { nM = M / BM; nN = N / BM; nwg = nM * nN; G = G_; c = c_; }
    __host__ __device__ bool next(int i, Unit& u) const {
        const long L = (long)i * G + c; if (L >= nwg) return false;
        int wgid = (int)L; { const int q = nwg / NXCD, r = nwg % NXCD, xcd = wgid % NXCD, off = wgid / NXCD; wgid = (xcd < r ? xcd * (q + 1) : r * (q + 1) + (xcd - r) * q) + off; }
        const int nig = WGM * nN, gid = wgid / nig, fm = gid * WGM, gsz = (nM - fm) < WGM ? (nM - fm) : WGM;
        u.pm = fm + ((wgid % nig) % gsz); u.pn = (wgid % nig) / gsz; u.ph = 0; return true;
    }
    __device__ __forceinline__ void a_ready(const Unit&) const {}
    __device__ __forceinline__ void done(const Unit&) const {}
};
struct RowsOrder {
    int nM, nN, G, c;
    __host__ __device__ void init(int M, int N, int G_, int c_) { nM = M / BM; nN = N / BM; G = G_; c = c_; }
    __host__ __device__ bool next(int i, Unit& u) const { const int pm = c + (i / nN) * G; if (pm >= nM) return false; u.pm = pm; u.pn = i % nN; u.ph = 0; return true; }
    __device__ __forceinline__ void a_ready(const Unit&) const {}
    __device__ __forceinline__ void done(const Unit&) const {}
};
struct RowsOrder2 {
    RowsOrder base;
    __host__ __device__ void init(int M, int N, int G_, int c_) { base.init(M, N, G_, c_); }
    __host__ __device__ bool next(int i, Unit& u) const { if (!base.next(i >> 1, u)) return false; u.ph = i & 1; return true; }
    __device__ __forceinline__ void a_ready(const Unit&) const {}
    __device__ __forceinline__ void done(const Unit&) const {}
};
struct StaticOrder2 {
    StaticOrder base;
    __host__ __device__ void init(int M, int N, int G_, int c_) { base.init(M, N, G_, c_); }
    __host__ __device__ bool next(int i, Unit& u) const { if (!base.next(i >> 1, u)) return false; u.ph = i & 1; return true; }
    __device__ __forceinline__ void a_ready(const Unit&) const {}
    __device__ __forceinline__ void done(const Unit&) const {}
};
template <class Epi, class Sched, bool ALIGN_EPI = false, bool SP2 = false>
__device__ __forceinline__ void gemm_phase(PG8_LAS unsigned char* lds, const Gemm g, const Sched& S, const Epi& E) {
    const int tid = threadIdx.x, wid = __builtin_amdgcn_readfirstlane(tid >> 6), lane = tid & 63, wr = wid >> 2, wc = wid & 3, fr = lane & 15, fq = lane >> 4;
    const int K = g.K, nt = K / BK;
    unsigned voffA[2], voffB[2];
#pragma unroll
    for (int i = 0; i < 2; ++i) { int R, C; stage_rc(tid * 16 + i * 8192, R, C); const int Rb = Epi::PERM ? ((R & ~31) + perm32(R & 31)) : R;
        voffA[i] = (unsigned)(R * g.lda + C) * 2u; voffB[i] = (unsigned)(Rb * g.ldb + C) * 2u; }
    const size_t kstep = (size_t)(BK * 2);
    const size_t hstepA = (size_t)HALF * g.lda * 2, hstepB = (size_t)HALF * g.ldb * 2;
    const size_t tstepA = 2 * hstepA, tstepB = 2 * hstepB;
    const unsigned ldsw = (unsigned)wid * 1024u;
    const int aoff = lds_byte(wr * 64 + fr, fq * 8), boff = lds_byte(wc * 32 + fr, fq * 8);
#define PG8_SA(b, h) (((b) * 2 + (h)) * HTB)
#define PG8_SB(b, h) ((4 + (b) * 2 + (h)) * HTB)
#define PG8_STAGE(bufoff, gbase, voff) do { _Pragma("unroll") for (int _i = 0; _i < 2; ++_i) \
        __builtin_amdgcn_global_load_lds((const unsigned*)((const char*)(gbase) + (voff)[_i]), (PG8_LAS unsigned*)(lds + (bufoff) + ldsw + _i * 8192), 16, 0, 0); } while (0)
#define PG8_LDA(dst, b, h) do { _Pragma("unroll") for (int m = 0; m < 4; ++m) _Pragma("unroll") for (int k = 0; k < 2; ++k) dst[m][k] = *(const PG8_LAS bf16x8*)(lds + PG8_SA(b, h) + aoff + m * 2048 + k * 1024); } while (0)
#define PG8_LDB(dst, b, h) do { _Pragma("unroll") for (int n = 0; n < 2; ++n) _Pragma("unroll") for (int k = 0; k < 2; ++k) dst[n][k] = *(const PG8_LAS bf16x8*)(lds + PG8_SB(b, h) + boff + n * 2048 + k * 1024); } while (0)
#define PG8_MMA(ai, bj, At, Bt) do { __builtin_amdgcn_s_setprio(1); _Pragma("unroll") for (int m = 0; m < 4; ++m) _Pragma("unroll") for (int n = 0; n < 2; ++n) _Pragma("unroll") for (int k = 0; k < 2; ++k) \
        acc[ai][bj][m][n] = __builtin_amdgcn_mfma_f32_16x16x32_bf16(Bt[n][k], At[m][k], acc[ai][bj][m][n], 0, 0, 0); __builtin_amdgcn_s_setprio(0); } while (0)
#define PG8_WAIT_V(n) asm volatile("s_waitcnt vmcnt(" #n ")" ::: "memory")
#define PG8_WAIT_L(n) asm volatile("s_waitcnt lgkmcnt(" #n ")" ::: "memory")
#define PG8_BAR __builtin_amdgcn_s_barrier()
#define PG8_SCHED __builtin_amdgcn_sched_barrier(0)
    Unit cur, nxt; int ui = 0;
    if (!S.next(0, cur)) return;
    f32x4 acc[2][2][4][2];
#pragma unroll
    for (int a = 0; a < 2; ++a)
#pragma unroll
        for (int b = 0; b < 2; ++b)
#pragma unroll
            for (int m = 0; m < 4; ++m)
#pragma unroll
                for (int n = 0; n < 2; ++n) acc[a][b][m][n] = (f32x4){0.f, 0.f, 0.f, 0.f};
    bf16x8 At[4][2], B0[2][2], B1[2][2];
    const char* cA = (const char*)g.A + (size_t)cur.pm * tstepA + cur.ph * g.jA; const char* cB = (const char*)g.Bt + (size_t)cur.pn * tstepB + cur.ph * g.jB;
    S.a_ready(cur);
    if constexpr (SP2) {
        PG8_STAGE(PG8_SB(0, 0), cB, voffB); PG8_STAGE(PG8_SB(0, 1), cB + hstepB, voffB); PG8_STAGE(PG8_SA(0, 0), cA, voffA); PG8_STAGE(PG8_SA(0, 1), cA + hstepA, voffA);
        if (wr == 1) PG8_BAR;
        PG8_WAIT_V(2); PG8_BAR;
        PG8_STAGE(PG8_SB(1, 0), cB + kstep, voffB); PG8_STAGE(PG8_SA(1, 0), cA + kstep, voffA); PG8_STAGE(PG8_SB(1, 1), cB + hstepB + kstep, voffB);
        PG8_WAIT_V(6); PG8_BAR;
    } else {
        PG8_STAGE(PG8_SB(0, 0), cB, voffB); PG8_STAGE(PG8_SA(0, 0), cA, voffA); PG8_STAGE(PG8_SB(0, 1), cB + hstepB, voffB); PG8_STAGE(PG8_SA(0, 1), cA + hstepA, voffA);
        if (wr == 1) PG8_BAR;
        PG8_WAIT_V(4); PG8_BAR;
        PG8_STAGE(PG8_SB(1, 0), cB + kstep, voffB); PG8_STAGE(PG8_SA(1, 0), cA + kstep, voffA); PG8_STAGE(PG8_SB(1, 1), cB + hstepB + kstep, voffB);
        PG8_WAIT_V(6); PG8_BAR;
    }
    for (;;) {
        const bool has_next = S.next(ui + 1, nxt);
        const char* nA = has_next ? (const char*)g.A + (size_t)nxt.pm * tstepA + nxt.ph * g.jA : cA; const char* nB = has_next ? (const char*)g.Bt + (size_t)nxt.pn * tstepB + nxt.ph * g.jB : cB;
        for (int t = 0; t < nt; t += 2) {
            const bool last = (t == nt - 2);
            const char* a1 = cA + (size_t)(t + 1) * kstep;
            const char* a2 = last ? nA : cA + (size_t)(t + 2) * kstep; const char* b2 = last ? nB : cB + (size_t)(t + 2) * kstep;
            const char* a3 = a2 + kstep; const char* b3 = b2 + kstep;
            if (last && has_next) S.a_ready(nxt);
            if constexpr (SP2) {
            PG8_LDB(B0, 0, 0); PG8_LDB(B1, 0, 1); PG8_SCHED; PG8_LDA(At, 0, 0); PG8_STAGE(PG8_SA(1, 1), a1 + hstepA, voffA);
            PG8_WAIT_V(8); PG8_WAIT_L(0); PG8_BAR; PG8_MMA(0, 0, At, B0); PG8_MMA(0, 1, At, B1); PG8_BAR; PG8_SCHED;
            PG8_LDA(At, 0, 1); PG8_STAGE(PG8_SB(0, 0), b2, voffB); PG8_STAGE(PG8_SB(0, 1), b2 + hstepB, voffB); PG8_STAGE(PG8_SA(0, 0), a2, voffA);
            PG8_WAIT_V(8); PG8_WAIT_L(0); PG8_BAR; PG8_MMA(1, 0, At, B0); PG8_MMA(1, 1, At, B1); PG8_BAR; PG8_SCHED;
            PG8_LDB(B0, 1, 0); PG8_LDB(B1, 1, 1); PG8_SCHED; PG8_LDA(At, 1, 0); PG8_STAGE(PG8_SA(0, 1), a2 + hstepA, voffA);
            PG8_WAIT_V(8); PG8_WAIT_L(0); PG8_BAR; PG8_MMA(0, 0, At, B0); PG8_MMA(0, 1, At, B1); PG8_BAR; PG8_SCHED;
            PG8_LDA(At, 1, 1); PG8_STAGE(PG8_SB(1, 0), b3, voffB); PG8_STAGE(PG8_SB(1, 1), b3 + hstepB, voffB); PG8_STAGE(PG8_SA(1, 0), a3, voffA);
            PG8_WAIT_V(8); PG8_WAIT_L(0); PG8_BAR; PG8_MMA(1, 0, At, B0); PG8_MMA(1, 1, At, B1); PG8_BAR; PG8_SCHED;
            } else {
            PG8_LDB(B0, 0, 0); PG8_SCHED; PG8_LDA(At, 0, 0); PG8_STAGE(PG8_SA(1, 1), a1 + hstepA, voffA);
            PG8_WAIT_L(8); PG8_BAR; PG8_WAIT_L(0); PG8_MMA(0, 0, At, B0); PG8_BAR; PG8_SCHED;
            PG8_LDB(B1, 0, 1); PG8_STAGE(PG8_SB(0, 0), b2, voffB);
            PG8_BAR; PG8_WAIT_L(0); PG8_MMA(0, 1, At, B1); PG8_BAR;
            PG8_LDA(At, 0, 1); PG8_STAGE(PG8_SA(0, 0), a2, voffA);
            PG8_BAR; PG8_WAIT_L(0); PG8_MMA(1, 0, At, B0); PG8_BAR; PG8_SCHED;
            PG8_STAGE(PG8_SB(0, 1), b2 + hstepB, voffB);
            PG8_WAIT_V(6); PG8_BAR; PG8_MMA(1, 1, At, B1); PG8_BAR;
            PG8_LDB(B0, 1, 0); PG8_SCHED; PG8_LDA(At, 1, 0); PG8_STAGE(PG8_SA(0, 1), a2 + hstepA, voffA);
            PG8_WAIT_L(8); PG8_BAR; PG8_WAIT_L(0); PG8_MMA(0, 0, At, B0); PG8_BAR; PG8_SCHED;
            PG8_LDB(B1, 1, 1); PG8_STAGE(PG8_SB(1, 0), b3, voffB);
            PG8_BAR; PG8_WAIT_L(0); PG8_MMA(0, 1, At, B1); PG8_BAR;
            PG8_LDA(At, 1, 1); PG8_STAGE(PG8_SA(1, 0), a3, voffA);
            PG8_BAR; PG8_WAIT_L(0); PG8_MMA(1, 0, At, B0); PG8_BAR; PG8_SCHED;
            PG8_STAGE(PG8_SB(1, 1), b3 + hstepB, voffB);
            PG8_WAIT_V(6); PG8_BAR; PG8_MMA(1, 1, At, B1); PG8_BAR;
            }
        }
        if constexpr (ALIGN_EPI) { if (wr == 0) PG8_BAR; }
        bool keep_acc = false;
        if constexpr (Epi::HAS_MID) { keep_acc = (cur.ph == 0) && has_next; }
        if constexpr (!Epi::AFTER_DRAIN) { if constexpr (Epi::HAS_MID) { if (keep_acc) E.mid(acc, cur, wr, wc, fr, fq); else E(acc, cur, wr, wc, fr, fq); } else E(acc, cur, wr, wc, fr, fq); S.done(cur); }
        if (!has_next) break;
        if (!keep_acc)
#pragma unroll
        for (int a = 0; a < 2; ++a)
#pragma unroll
            for (int b = 0; b < 2; ++b)
#pragma unroll
                for (int m = 0; m < 4; ++m)
#pragma unroll
                    for (int n = 0; n < 2; ++n) acc[a][b][m][n] = (f32x4){0.f, 0.f, 0.f, 0.f};
        cur = nxt; cA = nA; cB = nB; ++ui;
        if constexpr (ALIGN_EPI) { if (wr == 1) PG8_BAR; }
    }
    PG8_WAIT_V(0);
    if constexpr (!ALIGN_EPI) { if (wr == 0) PG8_BAR; }
    PG8_BAR;
    if constexpr (Epi::AFTER_DRAIN) { E.fused(acc, cur, wr, wc, fr, fq, lds, wid, lane); S.done(cur); }
#undef PG8_SA
#undef PG8_SB
#undef PG8_STAGE
#undef PG8_LDA
#undef PG8_LDB
#undef PG8_MMA
#undef PG8_WAIT_V
#undef PG8_WAIT_L
#undef PG8_BAR
#undef PG8_SCHED
}
}
namespace pg8 {
struct EpiZ {
    static constexpr bool PERM = true, AFTER_DRAIN = false, HAS_MID = false;
    bf16_t* Z; bf16_t* G;
    __device__ __forceinline__ void operator()(const f32x4 (&acc)[2][2][4][2], const Unit& u, int wr, int wc, int fr, int fq) const {
        const int row0 = u.pm * BM + wr * 64 + fr, colt = u.pn * BM; const bool gate = colt >= NZ, sig_o = colt >= ZC_MO && colt < ZC_MO + 1024;
        bf16_t* base = gate ? G : Z; const int ld = gate ? NGATE : NZ; const int col0 = (gate ? colt - NZ : colt) + wc * 32 + 8 * fq;
#pragma unroll
        for (int ai = 0; ai < 2; ++ai)
#pragma unroll
            for (int m = 0; m < 4; ++m) { bf16_t* rowp = base + (size_t)(row0 + ai * HALF + m * 16) * ld + col0;
#pragma unroll
                for (int bj = 0; bj < 2; ++bj) { f32x4 v0 = acc[ai][bj][m][0], v1 = acc[ai][bj][m][1];
                    if (gate || sig_o) {
#pragma unroll
                        for (int e = 0; e < 4; ++e) { v0[e] = sigmoidf_(v0[e]); v1[e] = sigmoidf_(v1[e]); } }
                    ::u32x4 w; w.x = pk2(v0[0], v0[1]); w.y = pk2(v0[2], v0[3]); w.z = pk2(v1[0], v1[1]); w.w = pk2(v1[2], v1[3]);
                    *(::u32x4*)(rowp + bj * HALF) = w; } }
    }
};
template <bool FIRST> struct EpiGate {
    static constexpr bool PERM = true, AFTER_DRAIN = false, HAS_MID = false;
    const bf16_t* G; bf16_t* Y;
    __device__ __forceinline__ void operator()(const f32x4 (&acc)[2][2][4][2], const Unit& u, int wr, int wc, int fr, int fq) const {
        const int row0 = u.pm * BM + wr * 64 + fr, col0 = u.pn * BM + wc * 32 + 8 * fq;
#pragma unroll
        for (int ai = 0; ai < 2; ++ai)
#pragma unroll
            for (int m = 0; m < 4; ++m) { const size_t row = (size_t)(row0 + ai * HALF + m * 16);
#pragma unroll
                for (int bj = 0; bj < 2; ++bj) { const f32x4 v0 = acc[ai][bj][m][0], v1 = acc[ai][bj][m][1];
                    const ::u32x4 g = *(const ::u32x4*)(G + row * NGATE + col0 + bj * HALF);
                    float o[8] = { bf_lo(g.x) * v0[0], bf_hi(g.x) * v0[1], bf_lo(g.y) * v0[2], bf_hi(g.y) * v0[3], bf_lo(g.z) * v1[0], bf_hi(g.z) * v1[1], bf_lo(g.w) * v1[2], bf_hi(g.w) * v1[3] };
                    bf16_t* yp = Y + row * DM + col0 + bj * HALF;
                    if (!FIRST) { const ::u32x4 y = *(const ::u32x4*)yp;
                        o[0] += bf_lo(y.x); o[1] += bf_hi(y.x); o[2] += bf_lo(y.y); o[3] += bf_hi(y.y); o[4] += bf_lo(y.z); o[5] += bf_hi(y.z); o[6] += bf_lo(y.w); o[7] += bf_hi(y.w); }
                    ::u32x4 w; w.x = pk2(o[0], o[1]); w.y = pk2(o[2], o[3]); w.z = pk2(o[4], o[5]); w.w = pk2(o[6], o[7]);
                    *(::u32x4*)yp = w; } }
    }
};
struct EpiR {
    static constexpr bool PERM = true, AFTER_DRAIN = false, HAS_MID = false;
    const float* X; const float* MOD; bf16_t* R;
    __device__ __forceinline__ void operator()(const f32x4 (&acc)[2][2][4][2], const Unit& u, int wr, int wc, int fr, int fq) const {
        const int row0 = u.pm * BM + wr * 64 + fr, col0 = u.pn * BM + wc * 32 + 8 * fq;
        const float* gt = MOD + (size_t)((u.pm * BM) / SEQ) * MODW + 2 * DM;
        f32x4 g[2][2];
#pragma unroll
        for (int bj = 0; bj < 2; ++bj) { g[bj][0] = *(const f32x4*)(gt + col0 + bj * HALF); g[bj][1] = *(const f32x4*)(gt + col0 + bj * HALF + 4); }
#pragma unroll
        for (int ai = 0; ai < 2; ++ai) {
            f32x4 xv[4][2][2];
#pragma unroll
            for (int m = 0; m < 4; ++m) { const size_t off = (size_t)(row0 + ai * HALF + m * 16) * DM + col0;
#pragma unroll
                for (int bj = 0; bj < 2; ++bj) { xv[m][bj][0] = *(const f32x4*)(X + off + bj * HALF); xv[m][bj][1] = *(const f32x4*)(X + off + bj * HALF + 4); } }
            __builtin_amdgcn_sched_barrier(0);
#pragma unroll
            for (int m = 0; m < 4; ++m) { const size_t off = (size_t)(row0 + ai * HALF + m * 16) * DM + col0;
#pragma unroll
                for (int bj = 0; bj < 2; ++bj) {
                    const f32x4 r0 = xv[m][bj][0] * ALPHA_RES + g[bj][0] * acc[ai][bj][m][0], r1 = xv[m][bj][1] * ALPHA_RES + g[bj][1] * acc[ai][bj][m][1];
                    ::u32x4 w; w.x = pk2(r0[0], r0[1]); w.y = pk2(r0[2], r0[3]); w.z = pk2(r1[0], r1[1]); w.w = pk2(r1[2], r1[3]);
                    *(::u32x4*)(R + off + bj * HALF) = w; } }
            __builtin_amdgcn_sched_barrier(0);
        }
    }
};
struct EpiStore {
    static constexpr bool PERM = true, AFTER_DRAIN = false, HAS_MID = false;
    bf16_t* O;
    __device__ __forceinline__ void operator()(const f32x4 (&acc)[2][2][4][2], const Unit& u, int wr, int wc, int fr, int fq) const {
        const int row0 = u.pm * BM + wr * 64 + fr, col0 = u.pn * BM + wc * 32 + 8 * fq;
#pragma unroll
        for (int ai = 0; ai < 2; ++ai)
#pragma unroll
            for (int m = 0; m < 4; ++m) { bf16_t* rowp = O + (size_t)(row0 + ai * HALF + m * 16) * DM + col0;
#pragma unroll
                for (int bj = 0; bj < 2; ++bj) { const f32x4 v0 = acc[ai][bj][m][0], v1 = acc[ai][bj][m][1];
                    ::u32x4 w; w.x = pk2(v0[0], v0[1]); w.y = pk2(v0[2], v0[3]); w.z = pk2(v1[0], v1[1]); w.w = pk2(v1[2], v1[3]);
                    *(::u32x4*)(rowp + bj * HALF) = w; } }
    }
};
struct EpiGate2 {
    static constexpr bool PERM = true, AFTER_DRAIN = false, HAS_MID = true;
    const bf16_t* G; bf16_t* Y;
    __device__ __forceinline__ void mid(f32x4 (&acc)[2][2][4][2], const Unit& u, int wr, int wc, int fr, int fq) const {
        const int row0 = u.pm * BM + wr * 64 + fr, col0 = u.pn * BM + wc * 32 + 8 * fq;
#pragma unroll
        for (int ai = 0; ai < 2; ++ai)
#pragma unroll
            for (int m = 0; m < 4; ++m) { const size_t row = (size_t)(row0 + ai * HALF + m * 16);
#pragma unroll
                for (int bj = 0; bj < 2; ++bj) {
                    const ::u32x4 ga = *(const ::u32x4*)(G + row * NGATE + col0 + bj * HALF), gm = *(const ::u32x4*)(G + row * NGATE + DM + col0 + bj * HALF);
                    f32x4& v0 = acc[ai][bj][m][0]; f32x4& v1 = acc[ai][bj][m][1];
#define PG8_RAT(a, b) ((a) * __builtin_amdgcn_rcpf(b))
                    v0[0] *= PG8_RAT(bf_lo(ga.x), bf_lo(gm.x)); v0[1] *= PG8_RAT(bf_hi(ga.x), bf_hi(gm.x)); v0[2] *= PG8_RAT(bf_lo(ga.y), bf_lo(gm.y)); v0[3] *= PG8_RAT(bf_hi(ga.y), bf_hi(gm.y));
                    v1[0] *= PG8_RAT(bf_lo(ga.z), bf_lo(gm.z)); v1[1] *= PG8_RAT(bf_hi(ga.z), bf_hi(gm.z)); v1[2] *= PG8_RAT(bf_lo(ga.w), bf_lo(gm.w)); v1[3] *= PG8_RAT(bf_hi(ga.w), bf_hi(gm.w)); }
#undef PG8_RAT
                if (m == 3) __builtin_amdgcn_sched_barrier(0); }
    }
    __device__ __forceinline__ void operator()(const f32x4 (&acc)[2][2][4][2], const Unit& u, int wr, int wc, int fr, int fq) const {
        const int row0 = u.pm * BM + wr * 64 + fr, col0 = u.pn * BM + wc * 32 + 8 * fq;
        ::u32x4 gg[2][4][2];
#pragma unroll
        for (int ai = 0; ai < 2; ++ai)
#pragma unroll
            for (int m = 0; m < 4; ++m) { const size_t row = (size_t)(row0 + ai * HALF + m * 16);
#pragma unroll
                for (int bj = 0; bj < 2; ++bj) gg[ai][m][bj] = *(const ::u32x4*)(G + row * NGATE + DM + col0 + bj * HALF); }
        __builtin_amdgcn_sched_barrier(0);
#pragma unroll
        for (int ai = 0; ai < 2; ++ai)
#pragma unroll
            for (int m = 0; m < 4; ++m) { const size_t row = (size_t)(row0 + ai * HALF + m * 16);
#pragma unroll
                for (int bj = 0; bj < 2; ++bj) { const f32x4 v0 = acc[ai][bj][m][0], v1 = acc[ai][bj][m][1]; const ::u32x4 g = gg[ai][m][bj];
                    ::u32x4 w; w.x = pk2(bf_lo(g.x) * v0[0], bf_hi(g.x) * v0[1]); w.y = pk2(bf_lo(g.y) * v0[2], bf_hi(g.y) * v0[3]); w.z = pk2(bf_lo(g.z) * v1[0], bf_hi(g.z) * v1[1]); w.w = pk2(bf_lo(g.w) * v1[2], bf_hi(g.w) * v1[3]);
                    *(::u32x4*)(Y + row * DM + col0 + bj * HALF) = w; } }
    }
};
}
namespace datt {
DI float attn_lambda(const float* lam) { const int lane = threadIdx.x & 63; const float p1 = lam[lane] * lam[64 + lane], p2 = lam[128 + lane] * lam[192 + lane]; return __expf(wave_sum(p1)) - __expf(wave_sum(p2)) + LAMBDA_INIT; }
constexpr int KROW = 144;
constexpr int KBUF = 64 * KROW, VBUF = 64 * 256, LDS_K = 0, LDS_V = 2 * KBUF, LDS_ST = LDS_V + 2 * VBUF, STROW = 272, ST_WAVE = 32 * STROW, LDS_BYTES = LDS_ST + 8 * ST_WAVE;
DI unsigned vrow(unsigned key) { return (key & ~12u) | ((key & 4u) << 1) | ((key & 8u) >> 1); }

template <bool DRY> DI void attn_unit(LAS unsigned char* lds, bf16_t* Z, const float lam_val, const float* subln_g, int b, int h, int qb) {
    int tid_o = threadIdx.x; OPAQUE(tid_o); const int tid = tid_o, lane = tid & 63, r32 = lane & 31, hi = lane >> 5; const int wid = __builtin_amdgcn_readfirstlane(tid >> 6);
    const size_t rowbase = (size_t)b * SEQ;
    const int q_first = qb * 256 + wid * 32, q_me = q_first + r32;
    const int NT = 4 * (qb + 1);
    const int k_key = tid >> 3, k_ch = tid & 7;
    const int v_key0 = tid >> 4, v_ch = tid & 15;
    const unsigned tb0 = LDS_V + tr_base(lane, 0), tb1 = LDS_V + tr_base(lane, 1); unsigned q64 = ((lane & 15) >> 2) << 6;
    const unsigned kb = LDS_K + r32 * KROW + hi * 16;
    u32x4 pk_, pv0, pv1;
#pragma unroll
    for (int m = 0; m < 2; ++m) {
        bf16x8 qf[4];
        { const bf16_t* qp = Z + (rowbase + q_me) * NZ + ZC_Q + h * 128 + m * 64 + 8 * hi;
#pragma unroll
          for (int s = 0; s < 4; ++s) qf[s] = *(const bf16x8*)(qp + 16 * s); }
        const bf16_t* ksrc = Z + (rowbase + k_key) * NZ + ZC_K + h * 128 + m * 64 + k_ch * 8;
        const bf16_t* vsrc = Z + (rowbase + v_key0) * NZ + ZC_V + h * 128 + v_ch * 8;
        f32x16 O[4];
#pragma unroll
        for (int c = 0; c < 4; ++c)
#pragma unroll
            for (int r = 0; r < 16; ++r) O[c][r] = 0.f;
        float mrun = -1e30f, lrun = 0.f;
        if (m == 0) { pk_ = *(const u32x4*)ksrc; pv0 = *(const u32x4*)vsrc; pv1 = *(const u32x4*)(vsrc + (size_t)32 * NZ); }
        __syncthreads();
        *(LAS u32x4*)(lds + LDS_K + k_key * KROW + k_ch * 16) = pk_;
        *(LAS u32x4*)(lds + LDS_V + off_b(vrow(v_key0), v_ch)) = pv0;
        *(LAS u32x4*)(lds + LDS_V + off_b(vrow(v_key0 + 32), v_ch)) = pv1;
        { const size_t o = (size_t)64 * NZ; pk_ = *(const u32x4*)(ksrc + o); pv0 = *(const u32x4*)(vsrc + o); pv1 = *(const u32x4*)(vsrc + o + (size_t)32 * NZ); }
        __syncthreads();
        for (int kt = 0; kt < NT; ++kt) {
            const int cur = kt & 1, nxt = cur ^ 1;
            if (kt * 64 <= q_first + 31) {
            f32x16 p[2];
            bf16x8 ka[8];
#pragma unroll
            for (int i = 0; i < 8; ++i) ka[i] = *(const LAS bf16x8*)(lds + kb + cur * KBUF + 32 * (i >> 2) * KROW + (i & 3) * 32);
            __builtin_amdgcn_sched_barrier(0);
#pragma unroll
            for (int hf = 0; hf < 2; ++hf) {
#pragma unroll
                for (int r = 0; r < 16; ++r) p[hf][r] = 0.f;
#pragma unroll
                for (int s = 0; s < 4; ++s) p[hf] = MFMA32(ka[4 * hf + s], qf[s], p[hf]);
            }
            OPAQUE(q64);
            const unsigned vb0 = tb0 + cur * VBUF, vb1 = tb1 + cur * VBUF;
            s16x4 vlo[2][4], vhi[2][4];
#pragma unroll
            for (int ks = 0; ks < 4; ++ks) { vlo[0][ks] = tr_read(lds + vb0 + q64 + 4096 * ks); vhi[0][ks] = tr_read(lds + vb1 + q64 + 4096 * ks); }
            __builtin_amdgcn_sched_barrier(0);
            if (kt * 64 + 63 > q_first) {
#pragma unroll
                for (int hf = 0; hf < 2; ++hf)
#pragma unroll
                    for (int r = 0; r < 16; ++r) { const int key = kt * 64 + 32 * hf + crow(r, hi); if (key > q_me) p[hf][r] = -1e30f; }
            }
            float mx = p[0][0];
#pragma unroll
            for (int r = 1; r < 16; ++r) mx = fmaxf(mx, p[0][r]);
#pragma unroll
            for (int r = 0; r < 16; ++r) mx = fmaxf(mx, p[1][r]);
            mx = max32x(mx);
            if (__builtin_amdgcn_ballot_w64(mx > mrun + 8.0f) != 0) {
                const float mnew = fmaxf(mrun, mx), alpha = __builtin_amdgcn_exp2f(mrun - mnew); mrun = mnew; lrun *= alpha;
#pragma unroll
                for (int c = 0; c < 4; ++c)
#pragma unroll
                    for (int r = 0; r < 16; ++r) O[c][r] *= alpha;
            }
            float ls = 0.f;
#pragma unroll
            for (int hf = 0; hf < 2; ++hf)
#pragma unroll
                for (int r = 0; r < 16; ++r) { const float e = __builtin_amdgcn_exp2f(p[hf][r] - mrun); p[hf][r] = e; ls += e; }
            lrun += ls;
            bf16x8 pf[4];
            pf[0] = pack_step(p[0], 0); pf[1] = pack_step(p[0], 1); pf[2] = pack_step(p[1], 0); pf[3] = pack_step(p[1], 1);
#pragma unroll
            for (int c = 0; c < 4; ++c) {
                if (c < 3) { const unsigned cx = (64u * (c + 1)) ^ q64;
#pragma unroll
                    for (int ks = 0; ks < 4; ++ks) { vlo[(c + 1) & 1][ks] = tr_read(lds + vb0 + cx + 4096 * ks); vhi[(c + 1) & 1][ks] = tr_read(lds + vb1 + cx + 4096 * ks); } }
                __builtin_amdgcn_sched_barrier(0);
#pragma unroll
                for (int ks = 0; ks < 4; ++ks) O[c] = MFMA32(cat8(vlo[c & 1][ks], vhi[c & 1][ks]), pf[ks], O[c]);
                __builtin_amdgcn_sched_barrier(0);
            }
            }
            if (kt + 1 < NT) {
                *(LAS u32x4*)(lds + LDS_K + nxt * KBUF + k_key * KROW + k_ch * 16) = pk_;
                *(LAS u32x4*)(lds + LDS_V + nxt * VBUF + off_b(vrow(v_key0), v_ch)) = pv0;
                *(LAS u32x4*)(lds + LDS_V + nxt * VBUF + off_b(vrow(v_key0 + 32), v_ch)) = pv1;
                if (kt + 2 < NT) { const size_t o = (size_t)(kt + 2) * 64 * NZ; pk_ = *(const u32x4*)(ksrc + o); pv0 = *(const u32x4*)(vsrc + o); pv1 = *(const u32x4*)(vsrc + o + (size_t)32 * NZ); }
                else if (m == 0) { pk_ = *(const u32x4*)(ksrc + 64); pv0 = *(const u32x4*)vsrc; pv1 = *(const u32x4*)(vsrc + (size_t)32 * NZ); }
            }
            __syncthreads();
        }
        const float ltot = sum32x(lrun), inv = 1.0f / ltot;
        if (m == 0) {
            LAS unsigned char* stg = lds + LDS_ST + wid * ST_WAVE;
#pragma unroll
            for (int c = 0; c < 4; ++c)
#pragma unroll
                for (int g4 = 0; g4 < 4; ++g4) { const int dv0 = 32 * c + 8 * g4 + 4 * hi;
                    u32x2 w; w.x = pk2(O[c][4 * g4] * inv, O[c][4 * g4 + 1] * inv); w.y = pk2(O[c][4 * g4 + 2] * inv, O[c][4 * g4 + 3] * inv);
                    *(LAS u32x2*)(stg + r32 * STROW + dv0 * 2) = w; }
        } else {
            const float li = lam_val * inv;
            float ss = 0.f;
            LAS unsigned char* stg = lds + LDS_ST + wid * ST_WAVE;
#pragma unroll
            for (int c = 0; c < 4; ++c)
#pragma unroll
                for (int g4 = 0; g4 < 4; ++g4) { const int dv0 = 32 * c + 8 * g4 + 4 * hi; const u32x2 k2 = *(const LAS u32x2*)(stg + r32 * STROW + dv0 * 2);
                    O[c][4 * g4] = bf_lo(k2.x) - li * O[c][4 * g4]; O[c][4 * g4 + 1] = bf_hi(k2.x) - li * O[c][4 * g4 + 1]; O[c][4 * g4 + 2] = bf_lo(k2.y) - li * O[c][4 * g4 + 2]; O[c][4 * g4 + 3] = bf_hi(k2.y) - li * O[c][4 * g4 + 3];
                    ss += (O[c][4 * g4] * O[c][4 * g4] + O[c][4 * g4 + 1] * O[c][4 * g4 + 1]) + (O[c][4 * g4 + 2] * O[c][4 * g4 + 2] + O[c][4 * g4 + 3] * O[c][4 * g4 + 3]); }
            ss = sum32x(ss);
            const float rstd = rsqrtf(ss * (1.0f / 128.0f) + LN_EPS) * (1.0f - LAMBDA_INIT);
#pragma unroll
            for (int c = 0; c < 4; ++c)
#pragma unroll
                for (int g4 = 0; g4 < 4; ++g4) { const int dv0 = 32 * c + 8 * g4 + 4 * hi; const f32x4 gg = *(const f32x4*)(subln_g + dv0);
                    u32x2 w; w.x = pk2(O[c][4 * g4] * rstd * gg[0], O[c][4 * g4 + 1] * rstd * gg[1]); w.y = pk2(O[c][4 * g4 + 2] * rstd * gg[2], O[c][4 * g4 + 3] * rstd * gg[3]);
                    *(LAS u32x2*)(stg + r32 * STROW + dv0 * 2) = w; }
        }
    }
    LAS unsigned char* stg = lds + LDS_ST + wid * ST_WAVE;
    asm volatile("s_waitcnt lgkmcnt(0)" ::: "memory");
    bf16_t* obase = Z + (rowbase + q_first) * NZ + ZC_Q + h * 128;
#pragma unroll
    for (int i = 0; i < 8; ++i) { const int idx = lane + 64 * i, row = idx >> 4, ch = idx & 15;
        const u32x4 v = *(const LAS u32x4*)(stg + row * STROW + ch * 16); if (!DRY || v.x == 0x12345678u) *(u32x4*)(obase + (size_t)row * NZ + ch * 8) = v; }
}
}
namespace mls {
constexpr int QI = 0, KI = 32768, VI = 65536, SC = 131072;
constexpr int F_IG = 0, F_LF = 128, F_A = 256, F_M = 384, F_INTER = 512, F_EMT = 640, F_W = 768, F_DEN = 896, F_N = 1024, F_MISC = 1152,
              F_NQ2P = 1280, F_NQ1P = 1792, F_NP = 2304, F_RSQ = 2816, F_END = 3840;
constexpr int LDS_BYTES = SC + F_END * 4;
static_assert(LDS_BYTES <= 147456, "mLSTM LDS");

template <int CTRL> DI float dpp_keep(float old, float v) { return __builtin_bit_cast(float, __builtin_amdgcn_update_dpp(__builtin_bit_cast(int, old), __builtin_bit_cast(int, v), CTRL, 0xF, 0xF, false)); }
DI float scan_add(float x, int lane) {
    x += dpp_keep<0x111>(0.f, x); x += dpp_keep<0x112>(0.f, x); x += dpp_keep<0x114>(0.f, x); x += dpp_keep<0x118>(0.f, x);
    const float t0 = rdlane(x, 15), t1 = rdlane(x, 31), t2 = rdlane(x, 47); const int r = lane >> 4;
    return x + ((r >= 1 ? t0 : 0.f) + (r >= 2 ? t1 : 0.f) + (r >= 3 ? t2 : 0.f));
}
DI float scan_max(float x, int lane) {
    const float ninf = -3.0e38f;
    x = fmaxf(x, dpp_keep<0x111>(ninf, x)); x = fmaxf(x, dpp_keep<0x112>(ninf, x)); x = fmaxf(x, dpp_keep<0x114>(ninf, x)); x = fmaxf(x, dpp_keep<0x118>(ninf, x));
    const float t0 = rdlane(x, 15), t1 = rdlane(x, 31), t2 = rdlane(x, 47); const int r = lane >> 4;
    return fmaxf(x, fmaxf(fmaxf(r >= 1 ? t0 : ninf, r >= 2 ? t1 : ninf), r >= 3 ? t2 : ninf));
}
DI float log_sigmoid(float x) { return fminf(x, 0.f) - __logf(1.0f + __expf(-fabsf(x))); }

template <bool DRY, int ABL = 0> DI void mlstm_unit(LAS unsigned char* lds, bf16_t* Z, const float* GIF, const float* conv_w, const float* conv_b, const float* norm_g, int b, int hd) {
    int tid_o = threadIdx.x; OPAQUE(tid_o); const int tid = tid_o, lane = tid & 63; const int wid = __builtin_amdgcn_readfirstlane(tid >> 6);
    LAS float* sc = (LAS float*)(lds + SC);
#define MLS_LV unsigned L_ = lane; OPAQUE(L_); const unsigned r32 = L_ & 31, hi = L_ >> 5, rowb = 256u * r32, f16 = (((r32 & 3) << 2) | ((r32 >> 2) & 3)) << 4, q64 = ((L_ & 15) >> 2) << 6; (void)rowb; (void)f16; (void)q64; (void)hi
    f32x16 CT[4];
#pragma unroll
    for (int i = 0; i < 4; ++i)
#pragma unroll
        for (int r = 0; r < 16; ++r) CT[i][r] = 0.f;
    float m_prev = 0.f;
    if (tid < 128) sc[F_N + tid] = 0.f;
    const int img = wid >> 2, vc = wid & 3;
    const int st_i = wid >> 1, st_j0 = 2 * (wid & 1);

    u32x4 rawn[11]; float gin = 0.f, gfn = 0.f;
#define MLS_PREFETCH(CC) do { int tp = tid; OPAQUE(tp); const int p_mat = tp >> 8, p_ch = tp & 15, p_rg = (tp >> 4) & 15; const size_t tn = (size_t)b * SEQ + (size_t)(CC) * 128; \
        const bf16_t* srcn = Z + (tn + p_rg * 8) * NZ + (p_mat ? ZC_MK : ZC_MQ) + hd * 128 + p_ch * 8; \
        _Pragma("unroll") for (int j = 0; j < 11; ++j) { const int lp = (CC) * 128 + p_rg * 8 - 3 + j; rawn[j] = (u32x4){0u, 0u, 0u, 0u}; if (lp >= 0) rawn[j] = *(const u32x4*)(srcn + (ptrdiff_t)(j - 3) * NZ); } \
        if (tp < 128) { const float* gg = GIF + (tn + tp) * 8; gin = gg[hd]; gfn = gg[4 + hd]; } } while (0)
    MLS_PREFETCH(0);
    for (int c = 0; c < 16; ++c) {
        const size_t t0 = (size_t)b * SEQ + (size_t)c * 128;
        __syncthreads();
        u32x4 vn[8];
        { int tq = tid; OPAQUE(tq);
#pragma unroll
          for (int i = 0; i < 8; ++i) { const int idx = tq + 512 * i, row = idx >> 5, ch32 = idx & 31; vn[i] = *(const u32x4*)(Z + (t0 + row) * NZ + ZC_MV + hd * 256 + ch32 * 8); } }
        {
            int tq = tid; OPAQUE(tq);
            const int c_mat = tq >> 8, c_ch = tq & 15, c_rg = (tq >> 4) & 15;
            const int chan0 = c_mat * 512 + hd * 128 + c_ch * 8;
            const float kscale = c_mat ? 0.08838834764831845f : 1.0f;
            float cw[4][8], cb[8];
            { const GAS float* cwp = (const GAS float*)(conv_w + chan0); const GAS float* cbp = (const GAS float*)(conv_b + chan0); asm volatile("" : "+v"(cwp), "+v"(cbp));
#pragma unroll
              for (int j = 0; j < 4; ++j) { const f32x4 a = *(const GAS f32x4*)(cwp + j * 1024), c4 = *(const GAS f32x4*)(cwp + j * 1024 + 4);
                cw[j][0] = a[0]; cw[j][1] = a[1]; cw[j][2] = a[2]; cw[j][3] = a[3]; cw[j][4] = c4[0]; cw[j][5] = c4[1]; cw[j][6] = c4[2]; cw[j][7] = c4[3]; }
              const f32x4 a = *(const GAS f32x4*)cbp, c4 = *(const GAS f32x4*)(cbp + 4); cb[0] = a[0]; cb[1] = a[1]; cb[2] = a[2]; cb[3] = a[3]; cb[4] = c4[0]; cb[5] = c4[1]; cb[6] = c4[2]; cb[7] = c4[3]; }
            u32x4 raw[11];
#pragma unroll
            for (int j = 0; j < 11; ++j) raw[j] = rawn[j];
#pragma unroll
            for (int i = 0; i < 8; ++i) {
                float o[8];
#pragma unroll
                for (int e = 0; e < 8; ++e) { const int q = e >> 1; const bool hi_ = e & 1;
                    const float x0 = hi_ ? bf_hi(raw[i][q]) : bf_lo(raw[i][q]), x1 = hi_ ? bf_hi(raw[i + 1][q]) : bf_lo(raw[i + 1][q]), x2 = hi_ ? bf_hi(raw[i + 2][q]) : bf_lo(raw[i + 2][q]), x3 = hi_ ? bf_hi(raw[i + 3][q]) : bf_lo(raw[i + 3][q]);
                    const float y = cb[e] + cw[0][e] * x0 + cw[1][e] * x1 + cw[2][e] * x2 + cw[3][e] * x3; o[e] = (ABL & 1) ? y : siluf_(y) * kscale; }
                u32x4 w; w.x = pk2(o[0], o[1]); w.y = pk2(o[2], o[3]); w.z = pk2(o[4], o[5]); w.w = pk2(o[6], o[7]);
                *(LAS u32x4*)(lds + (c_mat ? KI : QI) + off_b(c_rg * 8 + i, c_ch)) = w;
            }
        }
        { int tq = tid; OPAQUE(tq);
#pragma unroll
        for (int i = 0; i < 8; ++i) { const int idx = tq + 512 * i, row = idx >> 5, ch32 = idx & 31;
            *(LAS u32x4*)(lds + VI + (ch32 >> 4) * 32768 + off_b(row, ch32 & 15)) = vn[i]; } }
        if (tid < 128) { sc[F_IG + tid] = gin; sc[F_LF + tid] = log_sigmoid(gfn);
            if (c > 0) sc[F_N + tid] = sc[F_MISC + 1] * sc[F_N + tid] + (sc[F_NP + tid] + sc[F_NP + 128 + tid]) + (sc[F_NP + 256 + tid] + sc[F_NP + 384 + tid]); }
        __syncthreads();
        if (wid == 1 && !(ABL & 8)) {
            const float ig0 = sc[F_IG + 2 * lane], ig1 = sc[F_IG + 2 * lane + 1], lf0 = sc[F_LF + 2 * lane], lf1 = sc[F_LF + 2 * lane + 1];
            const float s2 = lf0 + lf1, incl = scan_add(s2, lane), excl = incl - s2;
            const float b0 = excl + lf0, b1 = incl, a0 = ig0 - b0, a1 = ig1 - b1;
            const float im = scan_max(fmaxf(a0, a1), lane); const float em = dpp_keep<0x138>(-3.0e38f, im);
            const float cm0 = fmaxf(em, a0), cm1 = im;
            const float M0 = fmaxf(m_prev, cm0), M1 = fmaxf(m_prev, cm1);
            const float ML = rdlane(M1, 63), bL = rdlane(b1, 63);
            sc[F_A + 2 * lane] = a0; sc[F_A + 2 * lane + 1] = a1; sc[F_M + 2 * lane] = M0; sc[F_M + 2 * lane + 1] = M1;
            sc[F_INTER + 2 * lane] = __expf(m_prev - M0); sc[F_INTER + 2 * lane + 1] = __expf(m_prev - M1);
            sc[F_EMT + 2 * lane] = __expf(-(b0 + M0)); sc[F_EMT + 2 * lane + 1] = __expf(-(b1 + M1));
            sc[F_W + 2 * lane] = __expf(a0 - ML); sc[F_W + 2 * lane + 1] = __expf(a1 - ML);
            if (lane == 0) sc[F_MISC + 0] = __expf(m_prev - ML);
            m_prev = bL + ML;
        }
        f32x16 sT[2];
#pragma unroll
        for (int jj = 0; jj < 2; ++jj) {
#pragma unroll
            for (int r = 0; r < 16; ++r) sT[jj][r] = 0.f;
            const int j = st_j0 + jj;
            if (j <= st_i) { MLS_LV; const unsigned fh = (16u * hi) ^ f16;
                bf16x8 af[8], qq[8];
#pragma unroll
                for (int ks = 0; ks < 8; ++ks) { const unsigned xo = rowb + ((32u * ks) ^ fh);
                    af[ks] = *(const LAS bf16x8*)(lds + KI + 8192 * j + xo); qq[ks] = *(const LAS bf16x8*)(lds + QI + 8192 * st_i + xo); }
                __builtin_amdgcn_sched_barrier(0);
#pragma unroll
                for (int ks = 0; ks < 8; ++ks) sT[jj] = MFMA32(af[ks], qq[ks], sT[jj]);
                __builtin_amdgcn_sched_barrier(0);
            }
        }
        __syncthreads();
        u32x2 pp[2][4];
        { MLS_LV; const int t = 32 * st_i + r32; const float Mt = sc[F_M + t]; const unsigned ab = SC + 4 * F_A + 128 * st_j0 + 16 * hi;
          f32x4 av[2][4];
#pragma unroll
          for (int jj = 0; jj < 2; ++jj)
#pragma unroll
            for (int g4 = 0; g4 < 4; ++g4) av[jj][g4] = *(const LAS f32x4*)(lds + ab + 128 * jj + 32 * g4);
          __builtin_amdgcn_sched_barrier(0);
#pragma unroll
          for (int jj = 0; jj < 2; ++jj) { const int j = st_j0 + jj;
#pragma unroll
            for (int g4 = 0; g4 < 4; ++g4) { const int s0 = 32 * j + 8 * g4 + 4 * hi; float pv[4];
#pragma unroll
                for (int e = 0; e < 4; ++e) { const int s = s0 + e; const float ex = __expf(av[jj][g4][e] - Mt) * sT[jj][4 * g4 + e]; pv[e] = (s <= t) ? ex : 0.f; }
                pp[jj][g4].x = pk2(pv[0], pv[1]); pp[jj][g4].y = pk2(pv[2], pv[3]); } } }
        f32x16 acc[4];
#pragma unroll
        for (int ti = 0; ti < 4; ++ti)
#pragma unroll
            for (int r = 0; r < 16; ++r) acc[ti][r] = 0.f;
        if (c > 0) {
#pragma unroll
            for (int dt = 0; dt < 4; ++dt)
#pragma unroll
                for (int s2 = 0; s2 < 2; ++s2) { const bf16x8 bfr = pack_step(CT[dt], s2); MLS_LV;
                    const unsigned a0 = QI + rowb + 8 * hi + ((64u * dt + 32u * s2) ^ f16), a1 = QI + rowb + 8 * hi + ((64u * dt + 32u * s2 + 16u) ^ f16);
                    s16x4 lo[4], hi4[4];
#pragma unroll
                    for (int ti = 0; ti < 4; ++ti) { lo[ti] = *(const LAS s16x4*)(lds + a0 + 8192 * ti); hi4[ti] = *(const LAS s16x4*)(lds + a1 + 8192 * ti); }
                    __builtin_amdgcn_sched_barrier(0);
#pragma unroll
                    for (int ti = 0; ti < 4; ++ti) acc[ti] = MFMA32(cat8(lo[ti], hi4[ti]), bfr, acc[ti]);
                    __builtin_amdgcn_sched_barrier(0); }
        }
        { int tq = tid; OPAQUE(tq); const int t = tq & 127, part = tq >> 7; float d = 0.f;
#pragma unroll
          for (int cc = 0; cc < 4; ++cc) { const int ch = 4 * part + cc; const u32x4 raw = *(const LAS u32x4*)(lds + QI + off_b(t, ch)); const LAS float* nn = sc + F_N + 8 * ch;
              d += bf_lo(raw.x) * nn[0] + bf_hi(raw.x) * nn[1] + bf_lo(raw.y) * nn[2] + bf_hi(raw.y) * nn[3] + bf_lo(raw.z) * nn[4] + bf_hi(raw.z) * nn[5] + bf_lo(raw.w) * nn[6] + bf_hi(raw.w) * nn[7]; }
          sc[F_NQ2P + part * 128 + t] = d; }
        __syncthreads();
        { MLS_LV; const unsigned ib = SC + 4 * F_INTER + 16 * hi;
#pragma unroll
          for (int ti = 0; ti < 4; ++ti)
#pragma unroll
            for (int r = 0; r < 16; ++r) acc[ti][r] *= *(const LAS float*)(lds + ib + 4 * (32 * ti + (r & 3) + 8 * (r >> 2))); }
        { MLS_LV;
#pragma unroll
          for (int jj = 0; jj < 2; ++jj) { const int j = st_j0 + jj;
#pragma unroll
            for (int g4 = 0; g4 < 4; ++g4) *(LAS u32x2*)(lds + QI + 8192 * st_i + rowb + 8 * hi + ((64u * j + 16u * g4) ^ f16)) = pp[jj][g4]; } }
        { int tq = tid; OPAQUE(tq);
#pragma unroll
        for (int i = 0; i < 4; ++i) { const int idx = tq + 512 * i, row = idx >> 4, ch = idx & 15; LAS u32x4* p = (LAS u32x4*)(lds + KI + off_b(row, ch)); const u32x4 raw = *p; const float w = sc[F_W + row];
            u32x4 o; o.x = pk2(bf_lo(raw.x) * w, bf_hi(raw.x) * w); o.y = pk2(bf_lo(raw.y) * w, bf_hi(raw.y) * w); o.z = pk2(bf_lo(raw.z) * w, bf_hi(raw.z) * w); o.w = pk2(bf_lo(raw.w) * w, bf_hi(raw.w) * w); *p = o; } }
        __syncthreads();
        { const float decay = sc[F_MISC + 0];
#pragma unroll
          for (int dt = 0; dt < 4; ++dt)
#pragma unroll
            for (int r = 0; r < 16; ++r) CT[dt][r] *= decay; }
#pragma unroll
        for (int ks = 0; ks < 8; ++ks) {
            MLS_LV;
            const unsigned tbv0 = VI + img * 32768 + tr_base(L_, 0) + ((64u * vc) ^ q64), tbv1 = VI + img * 32768 + tr_base(L_, 1) + ((64u * vc) ^ q64);
            const unsigned tbk0 = KI + tr_base(L_, 0), tbk1 = KI + tr_base(L_, 1);
            const bf16x8 bv = cat8(tr_read(lds + tbv0 + 4096 * ks), tr_read(lds + tbv1 + 4096 * ks));
            const unsigned xo = QI + rowb + ((32u * ks) ^ ((16u * hi) ^ f16));
            bf16x8 pa[4]; s16x4 klo[4], khi[4];
#pragma unroll
            for (int ti = 0; ti < 4; ++ti) if (ks < 2 * (ti + 1)) pa[ti] = *(const LAS bf16x8*)(lds + xo + 8192 * ti);
#pragma unroll
            for (int dt = 0; dt < 4; ++dt) { const unsigned cx = (64u * dt) ^ q64; klo[dt] = tr_read(lds + tbk0 + 4096 * ks + cx); khi[dt] = tr_read(lds + tbk1 + 4096 * ks + cx); }
            __builtin_amdgcn_sched_barrier(0);
#pragma unroll
            for (int ti = 0; ti < 4; ++ti) if (ks < 2 * (ti + 1)) acc[ti] = MFMA32(pa[ti], bv, acc[ti]);
#pragma unroll
            for (int dt = 0; dt < 4; ++dt) CT[dt] = MFMA32(cat8(klo[dt], khi[dt]), bv, CT[dt]);
            __builtin_amdgcn_sched_barrier(0);
        }
        { int tq = tid; OPAQUE(tq); const int t = tq & 127, part = tq >> 7; float d = 0.f;
#pragma unroll
          for (int cc = 0; cc < 4; ++cc) { const u32x4 raw = *(const LAS u32x4*)(lds + QI + off_b(t, 4 * part + cc));
              d += (bf_lo(raw.x) + bf_hi(raw.x)) + (bf_lo(raw.y) + bf_hi(raw.y)) + (bf_lo(raw.z) + bf_hi(raw.z)) + (bf_lo(raw.w) + bf_hi(raw.w)); }
          sc[F_NQ1P + part * 128 + t] = d;
          float nn = 0.f;
          if (!(ABL & 16)) {
#pragma unroll
              for (int g8 = 0; g8 < 4; ++g8) { bf16_t rw[8];
#pragma unroll
                  for (int i = 0; i < 8; ++i) rw[i] = *(const LAS bf16_t*)(lds + KI + off_b(32 * part + 8 * g8 + i, t >> 3) + (t & 7) * 2);
                  __builtin_amdgcn_sched_barrier(0);
#pragma unroll
                  for (int i = 0; i < 8; ++i) nn += bf2f(rw[i]);
                  __builtin_amdgcn_sched_barrier(0); } }
          sc[F_NP + part * 128 + t] = nn;
          if (tid == 0) sc[F_MISC + 1] = sc[F_MISC + 0]; }
        __syncthreads();
        if (tid < 128) { const float nq1 = (sc[F_NQ1P + tid] + sc[F_NQ1P + 128 + tid]) + (sc[F_NQ1P + 256 + tid] + sc[F_NQ1P + 384 + tid]);
            const float nq2 = (sc[F_NQ2P + tid] + sc[F_NQ2P + 128 + tid]) + (sc[F_NQ2P + 256 + tid] + sc[F_NQ2P + 384 + tid]);
            sc[F_DEN + tid] = 1.0f / fmaxf(fabsf(nq1 + sc[F_INTER + tid] * nq2), sc[F_EMT + tid]); }
        __syncthreads();
        u32x4 oraw[8];
        { int tq = tid; OPAQUE(tq);
#pragma unroll
          for (int i = 0; i < 8; ++i) { const int idx = tq + 512 * i, row = idx >> 5, ch = idx & 31; oraw[i] = *(const u32x4*)(Z + (t0 + row) * NZ + hd * 256 + ch * 8 + ZC_MO); } }
        { MLS_LV; const unsigned db = SC + 4 * F_DEN + 16 * hi, hb = VI + 2048 * hi + (32 * wid + r32) * 2;
#pragma unroll
          for (int ti = 0; ti < 4; ++ti) { f32x4 dv[4];
#pragma unroll
            for (int q = 0; q < 4; ++q) dv[q] = *(const LAS f32x4*)(lds + db + 4 * (32 * ti + 8 * q));
            __builtin_amdgcn_sched_barrier(0);
#pragma unroll
            for (int r = 0; r < 16; ++r) { const int tt = 32 * ti + (r & 3) + 8 * (r >> 2); const float x = acc[ti][r] * dv[r >> 2][r & 3];
                *(LAS bf16_t*)(lds + hb + 512 * tt) = (bf16_t)(pk2(x, 0.f) & 0xffffu); }
            __builtin_amdgcn_sched_barrier(0); } }
        __syncthreads();
        { const int cn = c + 1 < 16 ? c + 1 : 15; MLS_PREFETCH(cn); }
        if (!(ABL & 2))
        { int tq = tid; OPAQUE(tq);
          const f32x4 g0 = *(const f32x4*)(norm_g + hd * 256 + (tq & 31) * 8), g1 = *(const f32x4*)(norm_g + hd * 256 + (tq & 31) * 8 + 4);
#pragma unroll
          for (int i = 0; i < 8; ++i) { const int idx = tq + 512 * i, row = idx >> 5, ch = idx & 31;
            const u32x4 hraw = *(const LAS u32x4*)(lds + VI + row * 512 + ch * 16);
            const float h0 = bf_lo(hraw.x), h1 = bf_hi(hraw.x), h2 = bf_lo(hraw.y), h3 = bf_hi(hraw.y), h4 = bf_lo(hraw.z), h5 = bf_hi(hraw.z), h6 = bf_lo(hraw.w), h7 = bf_hi(hraw.w);
            float ssq = (h0 * h0 + h1 * h1) + (h2 * h2 + h3 * h3) + (h4 * h4 + h5 * h5) + (h6 * h6 + h7 * h7);
            ssq = half_sum32(ssq);
            const float rstd = rsqrtf(ssq * (1.0f / 256.0f) + LN_EPS);
            bf16_t* gp = Z + (t0 + row) * NZ + hd * 256 + ch * 8;
            u32x4 o;
            o.x = pk2(h0 * rstd * g0[0] * bf_lo(oraw[i].x), h1 * rstd * g0[1] * bf_hi(oraw[i].x));
            o.y = pk2(h2 * rstd * g0[2] * bf_lo(oraw[i].y), h3 * rstd * g0[3] * bf_hi(oraw[i].y));
            o.z = pk2(h4 * rstd * g1[0] * bf_lo(oraw[i].z), h5 * rstd * g1[1] * bf_hi(oraw[i].z));
            o.w = pk2(h6 * rstd * g1[2] * bf_lo(oraw[i].w), h7 * rstd * g1[3] * bf_hi(oraw[i].w));
            if (!DRY || o.x == 0x12345678u) *(u32x4*)(gp + ZC_MV) = o; } }
    }
    __syncthreads();
}
#undef MLS_LV
#undef MLS_PREFETCH
}
namespace peer {
constexpr int KROW = 144;
constexpr int L_KEYS = 0, L_IDX = 2 * 128 * KROW, LDS_BYTES = L_IDX + 512 * 32;
DI unsigned ordf(float f) { const unsigned u = __float_as_uint(f); return u ^ ((unsigned)((int)u >> 31) | 0x80000000u); }
DI float deord(unsigned k) { return __uint_as_float(k ^ ((~(unsigned)((int)k >> 31)) | 0x80000000u)); }
#define PEER_CE(a, b) do { const unsigned hi_ = (a) > (b) ? (a) : (b), lo_ = (a) > (b) ? (b) : (a); (a) = hi_; (b) = lo_; } while (0)
DI void sort16_desc(unsigned (&a)[16]) {
    PEER_CE(a[0], a[13]); PEER_CE(a[1], a[12]); PEER_CE(a[2], a[15]); PEER_CE(a[3], a[14]); PEER_CE(a[4], a[8]); PEER_CE(a[5], a[6]); PEER_CE(a[7], a[11]); PEER_CE(a[9], a[10]);
    PEER_CE(a[0], a[5]); PEER_CE(a[1], a[7]); PEER_CE(a[2], a[9]); PEER_CE(a[3], a[4]); PEER_CE(a[6], a[13]); PEER_CE(a[8], a[14]); PEER_CE(a[10], a[15]); PEER_CE(a[11], a[12]);
    PEER_CE(a[0], a[1]); PEER_CE(a[2], a[3]); PEER_CE(a[4], a[5]); PEER_CE(a[6], a[8]); PEER_CE(a[7], a[9]); PEER_CE(a[10], a[11]); PEER_CE(a[12], a[13]); PEER_CE(a[14], a[15]);
    PEER_CE(a[0], a[2]); PEER_CE(a[1], a[3]); PEER_CE(a[4], a[10]); PEER_CE(a[5], a[11]); PEER_CE(a[6], a[7]); PEER_CE(a[8], a[9]); PEER_CE(a[12], a[14]); PEER_CE(a[13], a[15]);
    PEER_CE(a[1], a[2]); PEER_CE(a[3], a[12]); PEER_CE(a[4], a[6]); PEER_CE(a[5], a[7]); PEER_CE(a[8], a[10]); PEER_CE(a[9], a[11]); PEER_CE(a[13], a[14]);
    PEER_CE(a[1], a[4]); PEER_CE(a[2], a[6]); PEER_CE(a[5], a[8]); PEER_CE(a[7], a[10]); PEER_CE(a[9], a[13]); PEER_CE(a[11], a[14]);
    PEER_CE(a[2], a[4]); PEER_CE(a[3], a[6]); PEER_CE(a[9], a[12]); PEER_CE(a[11], a[13]);
    PEER_CE(a[3], a[5]); PEER_CE(a[6], a[8]); PEER_CE(a[7], a[9]); PEER_CE(a[10], a[12]);
    PEER_CE(a[3], a[4]); PEER_CE(a[5], a[6]); PEER_CE(a[7], a[8]); PEER_CE(a[9], a[10]); PEER_CE(a[11], a[12]);
    PEER_CE(a[6], a[7]); PEER_CE(a[8], a[9]);
}
DI void merge16(unsigned (&a)[16], const unsigned (&b)[16]) {
#pragma unroll
    for (int i = 0; i < 16; ++i) a[i] = a[i] > b[15 - i] ? a[i] : b[15 - i];
#pragma unroll
    for (int j = 8; j >= 1; j >>= 1)
#pragma unroll
        for (int i = 0; i < 16; ++i) { const int l = i ^ j; if (l > i) PEER_CE(a[i], a[l]); }
}
DI float gelu_erf(float x) { return 0.5f * x * (1.0f + erff(x * 0.7071067811865476f)); }

DI void stage_keys(LAS unsigned char* lds, const float* keys) {
    f32x4 ka[4], kb[4];
#pragma unroll
    for (int n = 0; n < 4; ++n) { const int i = threadIdx.x + 512 * n, row = i >> 3, ch = i & 7; const float* s = keys + row * 64 + ch * 8; ka[n] = *(const f32x4*)s; kb[n] = *(const f32x4*)(s + 4); }
#pragma unroll
    for (int n = 0; n < 4; ++n) { const int i = threadIdx.x + 512 * n, row = i >> 3, ch = i & 7;
        u32x4 w; w.x = pk2(ka[n][0], ka[n][1]); w.y = pk2(ka[n][2], ka[n][3]); w.z = pk2(kb[n][0], kb[n][1]); w.w = pk2(kb[n][2], kb[n][3]);
        *(LAS u32x4*)(lds + L_KEYS + row * KROW + ch * 16) = w; }
}

DI void select_phase(LAS unsigned char* lds, const bf16_t* QP, int tile0, int tstep, int tile_end, bf16_t* SELE, float* SELG) {
    int tid_o = threadIdx.x; OPAQUE(tid_o); const int tid = tid_o, lane = tid & 63, r32 = lane & 31, hi = lane >> 5; const int wid = __builtin_amdgcn_readfirstlane(tid >> 6);
    bf16x8 qn[2][4];
#define SEL_QLOAD(TILE) do { const bf16_t* qp_ = QP + ((size_t)(TILE) * 32 + r32) * DM + wid * 128 + 8 * hi; \
        _Pragma("unroll") for (int p_ = 0; p_ < 2; ++p_) _Pragma("unroll") for (int s_ = 0; s_ < 4; ++s_) qn[p_][s_] = *(const bf16x8*)(qp_ + p_ * 64 + 16 * s_); } while (0)
    if (tile0 < tile_end) SEL_QLOAD(tile0);
    for (int tile = tile0; tile < tile_end; tile += tstep) {
    const int tok0 = tile * 32;
    unsigned LA[16], LB[16];
    bf16x8 qc[2][4];
#pragma unroll
    for (int p = 0; p < 2; ++p)
#pragma unroll
        for (int s = 0; s < 4; ++s) qc[p][s] = qn[p][s];
    { const int tn = tile + tstep < tile_end ? tile + tstep : tile; SEL_QLOAD(tn); }
#pragma unroll
    for (int p = 0; p < 2; ++p) {
        bf16x8 qf[4];
#pragma unroll
        for (int s = 0; s < 4; ++s) qf[s] = qc[p][s];
        unsigned L[16], M[16];
#pragma unroll
        for (int nt = 0; nt < 4; ++nt) {
            f32x16 acc;
#pragma unroll
            for (int r = 0; r < 16; ++r) acc[r] = 0.f;
#pragma unroll
            for (int s = 0; s < 4; ++s) { const bf16x8 a = *(const LAS bf16x8*)(lds + L_KEYS + (p * 128 + 32 * nt + r32) * KROW + (2 * s + hi) * 16); acc = MFMA32(a, qf[s], acc); }
            unsigned T[16];
#pragma unroll
            for (int r = 0; r < 16; ++r) T[r] = (ordf(acc[r]) & ~0x7Fu) | (unsigned)(32 * nt + crow(r, hi));
            sort16_desc(T);
            if (nt == 0) {
#pragma unroll
                for (int i = 0; i < 16; ++i) L[i] = T[i]; }
            else if (nt == 1) merge16(L, T);
            else if (nt == 2) {
#pragma unroll
                for (int i = 0; i < 16; ++i) M[i] = T[i]; }
            else { merge16(M, T); merge16(L, M); }
        }
        unsigned O[16];
#pragma unroll
        for (int i = 0; i < 16; ++i) O[i] = partner32(L[i], hi);
        merge16(L, O);
#pragma unroll
        for (int i = 0; i < 16; ++i) { if (p == 0) LA[i] = L[i]; else LB[i] = L[i]; }
    }
    unsigned CL[16];
    {
        float sa[16], sb[16];
#pragma unroll
        for (int i = 0; i < 16; ++i) { sa[i] = deord(LA[i] & ~0x7Fu); sb[i] = deord(LB[i] & ~0x7Fu); }
        unsigned G0[16], G1[16];
#define SEL_PUT(k, v) do { if ((k) < 16) G0[(k) & 15] = (v); else G1[(k) & 15] = (v); } while (0)
#define SEL_CAND2(k, iA, jA, iB, jB) SEL_PUT(k, (ordf((hi ? sa[iB] : sa[iA]) + (hi ? sb[jB] : sb[jA])) & ~0xFFu) | (unsigned)(hi ? (iB) * 16 + (jB) : (iA) * 16 + (jA)))
#define SEL_CAND1(k, iA, jA) SEL_PUT(k, hi ? 0u : ((ordf(sa[iA] + sb[jA]) & ~0xFFu) | (unsigned)((iA) * 16 + (jA))))
        SEL_CAND2(0, 0, 0, 3, 3);
        SEL_CAND2(1, 0, 1, 4, 0);
        SEL_CAND2(2, 0, 2, 4, 1);
        SEL_CAND2(3, 0, 3, 4, 2);
        SEL_CAND2(4, 0, 4, 5, 0);
        SEL_CAND2(5, 0, 5, 5, 1);
        SEL_CAND2(6, 0, 6, 6, 0);
        SEL_CAND2(7, 0, 7, 6, 1);
        SEL_CAND2(8, 0, 8, 7, 0);
        SEL_CAND2(9, 0, 9, 7, 1);
        SEL_CAND2(10, 0, 10, 8, 0);
        SEL_CAND2(11, 0, 11, 9, 0);
        SEL_CAND2(12, 0, 12, 10, 0);
        SEL_CAND2(13, 0, 13, 11, 0);
        SEL_CAND2(14, 0, 14, 12, 0);
        SEL_CAND2(15, 0, 15, 13, 0);
        SEL_CAND2(16, 1, 0, 14, 0);
        SEL_CAND2(17, 1, 1, 15, 0);
        SEL_CAND1(18, 1, 2);
        SEL_CAND1(19, 1, 3);
        SEL_CAND1(20, 1, 4);
        SEL_CAND1(21, 1, 5);
        SEL_CAND1(22, 1, 6);
        SEL_CAND1(23, 1, 7);
        SEL_CAND1(24, 2, 0);
        SEL_CAND1(25, 2, 1);
        SEL_CAND1(26, 2, 2);
        SEL_CAND1(27, 2, 3);
        SEL_CAND1(28, 2, 4);
        SEL_CAND1(29, 3, 0);
        SEL_CAND1(30, 3, 1);
        SEL_CAND1(31, 3, 2);
#undef SEL_PUT
#undef SEL_CAND2
#undef SEL_CAND1
        sort16_desc(G0); sort16_desc(G1); merge16(G0, G1);
        unsigned O[16];
#pragma unroll
        for (int i = 0; i < 16; ++i) O[i] = partner32(G0[i], hi);
        merge16(G0, O);
#pragma unroll
        for (int i = 0; i < 16; ++i) CL[i] = G0[i];
    }
    LAS unsigned char* itab = lds + L_IDX + tid * 32;
    { u32x4 wa, wb;
#pragma unroll
      for (int q = 0; q < 4; ++q) { wa[q] = (LA[4 * q] & 0x7Fu) | ((LA[4 * q + 1] & 0x7Fu) << 8) | ((LA[4 * q + 2] & 0x7Fu) << 16) | ((LA[4 * q + 3] & 0x7Fu) << 24);
                                    wb[q] = (LB[4 * q] & 0x7Fu) | ((LB[4 * q + 1] & 0x7Fu) << 8) | ((LB[4 * q + 2] & 0x7Fu) << 16) | ((LB[4 * q + 3] & 0x7Fu) << 24); }
      *(LAS u32x4*)itab = wa; *(LAS u32x4*)(itab + 16) = wb; }
    const float mx = deord(CL[0] & ~0xFFu);
    float ev[16], sum = 0.f;
#pragma unroll
    for (int k = 0; k < 16; ++k) { ev[k] = __expf(deord(CL[k] & ~0xFFu) - mx); sum += ev[k]; }
    const float inv = 1.0f / sum;
    bf16_t* se = SELE + (size_t)(tok0 + r32) * 128 + wid * 16;
    float* sg = SELG + (size_t)(tok0 + r32) * 128 + wid * 16;
#pragma unroll
    for (int k = 0; k < 16; ++k) if ((k >> 3) == hi) { const unsigned code = CL[k] & 0xFFu; const unsigned n1 = itab[code >> 4], n2 = itab[16 + (code & 15u)];
        se[k] = (bf16_t)(n1 * 128u + n2); sg[k] = ev[k] * inv; }
    }
#undef SEL_QLOAD
}

DI void u_phase(LAS unsigned char* lds, int tile0, int tstep, int s, const bf16_t* SELE, const unsigned char* H2Q, const unsigned char* U4S, bf16_t* PART) {
    int tid_o = threadIdx.x; OPAQUE(tid_o); const int tid = tid_o, lane = tid & 63, j = lane >> 3, c = lane & 7; const int wid = __builtin_amdgcn_readfirstlane(tid >> 6);
    if (tile0 >= TOK / 32) return;
    LAS unsigned char* wl = lds + wid * 4096;
    const unsigned char* Us = U4S + (size_t)s * NEXP * 128; const unsigned c16 = 16u * c;
    u32x4 sreg;
#define UP_STAGE_LOAD(TILE) do { sreg = *(const u32x4*)(SELE + (size_t)(TILE) * 32 * 128 + (wid * 64 + lane) * 8); } while (0)
#define UP_STAGE_STORE(BUF) do { *(LAS u32x4*)(wl + (BUF) * 2048 + lane * 16) = sreg; } while (0)
#define UP_GATHER(UR, H0, H1, BUF, JT, TILE) do { const LAS bf16_t* se_ = (const LAS bf16_t*)(wl + (BUF) * 2048) + (JT) * 128 + j; const size_t t_ = (size_t)(TILE) * 32 + wid * 4 + (JT); \
        { const unsigned char* hrow_ = H2Q + t_ * DM + 128 * s; H0 = *(const u32x4*)(hrow_ + c16); H1 = *(const u32x4*)(hrow_ + 512 + c16); }       \
        _Pragma("unroll") for (int g = 0; g < 16; ++g) { const unsigned e_ = se_[8 * g]; UR[g] = *(const u32x4*)(Us + ((e_ << 7) + c16)); } } while (0)
#define UP_COMPUTE(UR, H0, H1, JT, TILE) do { \
        int d[16]; \
        _Pragma("unroll") for (int g = 0; g < 16; ++g) { int da = 0, db = 0; \
            _Pragma("unroll") for (int i = 0; i < 4; ++i) { da = __builtin_amdgcn_sdot8((int)UR[g][i], (int)H0[i], da, false); db = __builtin_amdgcn_sdot8((int)UR[g][i], (int)H1[i], db, false); } \
            d[g] = 16 * da + db; if ((g & 3) == 3) __builtin_amdgcn_sched_barrier(0); } \
          \
        int r1[8], r2[4], r3[2]; \
        _Pragma("unroll") for (int i = 0; i < 8; ++i) { const int keep = c2 ? d[i + 8] : d[i], send = c2 ? d[i] : d[i + 8]; r1[i] = keep + dppi<0x141>(send); } \
        _Pragma("unroll") for (int i = 0; i < 4; ++i) { const int keep = c1 ? r1[i + 4] : r1[i], send = c1 ? r1[i] : r1[i + 4]; r2[i] = keep + dppi<0x4E>(send); } \
        _Pragma("unroll") for (int i = 0; i < 2; ++i) { const int keep = c0 ? r2[i + 2] : r2[i], send = c0 ? r2[i] : r2[i + 2]; r3[i] = keep + dppi<0xB1>(send); } \
        bf16_t* pp = PART + ((size_t)(TILE) * 32 + wid * 4 + (JT)) * 512 + s * 128 + 16 * c + j;            \
        pp[0] = (bf16_t)(pk2((float)r3[0], 0.f) & 0xffffu); pp[8] = (bf16_t)(pk2((float)r3[1], 0.f) & 0xffffu); } while (0)
    u32x4 urA[16], urB[16], hA0, hA1, hB0, hB1; const int c2 = c >> 2, c1 = (c >> 1) & 1, c0 = c & 1;
    UP_STAGE_LOAD(tile0); UP_STAGE_STORE(0);
    UP_GATHER(urA, hA0, hA1, 0, 0, tile0);
    int buf = 0;
#pragma unroll 1
    for (int tile = tile0; tile < TOK / 32; tile += tstep) {
        const int tnext = tile + tstep < TOK / 32 ? tile + tstep : tile;
        UP_STAGE_LOAD(tnext);
        UP_GATHER(urB, hB0, hB1, buf, 1, tile); UP_COMPUTE(urA, hA0, hA1, 0, tile);
        UP_GATHER(urA, hA0, hA1, buf, 2, tile); UP_COMPUTE(urB, hB0, hB1, 1, tile);
        UP_GATHER(urB, hB0, hB1, buf, 3, tile); UP_COMPUTE(urA, hA0, hA1, 2, tile);
        UP_STAGE_STORE(buf ^ 1);
        UP_GATHER(urA, hA0, hA1, buf ^ 1, 0, tnext);
        UP_COMPUTE(urB, hB0, hB1, 3, tile);
        buf ^= 1;
    }
#undef UP_STAGE_LOAD
#undef UP_STAGE_STORE
#undef UP_GATHER
#undef UP_COMPUTE
}
template <int NQ> DI void red_tokens(size_t t0, const bf16_t* __restrict__ PART, const bf16_t* __restrict__ SELE, const float* __restrict__ SELG, const float* __restrict__ SU, const float* __restrict__ SV,
                    const float* __restrict__ SH, signed char* __restrict__ COEFQ, float* __restrict__ CS) {
    const int lane = threadIdx.x & 63;
    float s[NQ][2], g[NQ][2], su[NQ][2], sv[NQ][2], sh[NQ];
#pragma unroll
    for (int q = 0; q < NQ; ++q) { const size_t t = t0 + q; sh[q] = SH[t];
#pragma unroll
        for (int h = 0; h < 2; ++h) { const int k = lane + 64 * h; const unsigned e = SELE[t * 128 + k]; g[q][h] = SELG[t * 128 + k]; su[q][h] = SU[e]; sv[q][h] = SV[e];
            float a = 0.f;
#pragma unroll
            for (int xx = 0; xx < 4; ++xx) a += bf2f(PART[t * 512 + xx * 128 + k]);
            s[q][h] = a; } }
#pragma unroll
    for (int q = 0; q < NQ; ++q) { const size_t t = t0 + q;
        const float c0 = g[q][0] * gelu_erf(s[q][0] * su[q][0] * sh[q]) * sv[q][0], c1 = g[q][1] * gelu_erf(s[q][1] * su[q][1] * sh[q]) * sv[q][1];
        float cm = fmaxf(fabsf(c0), fabsf(c1));
        cm = wave_max(cm);
        const float inv = cm > 0.f ? 127.0f / cm : 0.f;
        signed char* cq = COEFQ + t * 128 + (lane & 7) * 16 + (lane >> 3);
        cq[0] = (signed char)(int)rintf(c0 * inv); cq[8] = (signed char)(int)rintf(c1 * inv);
        if (lane == 0) CS[t] = cm * (1.0f / 127.0f); }
}
DI unsigned bperm(unsigned hi, unsigned lo, unsigned sel) { return __builtin_amdgcn_perm(hi, lo, sel); }
DI void v_phase(LAS unsigned char* lds, int tile0, int tstep, int x, const bf16_t* SELE, const signed char* COEFQ, const float* CS, const unsigned char* V8S, bf16_t* YF) {
    int tid_o = threadIdx.x; OPAQUE(tid_o); const int tid = tid_o, lane = tid & 63, j = lane >> 3, c = lane & 7; const int wid = __builtin_amdgcn_readfirstlane(tid >> 6);
    if (tile0 >= TOK / 32) return;
    LAS unsigned char* wl = lds + wid * 4096;
    const unsigned char* Vs = V8S + (size_t)x * NEXP * 128; const unsigned c16 = 16u * c;
    u32x4 sreg, creg = {0u, 0u, 0u, 0u};
#define VP_STAGE_LOAD(TILE) do { sreg = *(const u32x4*)(SELE + (size_t)(TILE) * 32 * 128 + (wid * 64 + lane) * 8); if (lane < 32) creg = *(const u32x4*)(COEFQ + (size_t)(TILE) * 32 * 128 + (wid * 32 + lane) * 16); } while (0)
#define VP_STAGE_STORE(BUF) do { *(LAS u32x4*)(wl + (BUF) * 2048 + lane * 16) = sreg; if (lane < 32) *(LAS u32x4*)(wl + (BUF) * 2048 + 1024 + lane * 16) = creg; } while (0)
#define VP_GATHER(VR, SC, BUF, JT, TILE) do { const LAS bf16_t* se_ = (const LAS bf16_t*)(wl + (BUF) * 2048) + (JT) * 128 + j; SC = CS[(size_t)(TILE) * 32 + wid * 4 + (JT)]; \
        _Pragma("unroll") for (int g = 0; g < 16; ++g) { const unsigned e_ = se_[8 * g]; VR[g] = *(const u32x4*)(Vs + ((e_ << 7) + c16)); } } while (0)
#define VP_COMPUTE(VR, SC, BUF, JT, TILE) do { const LAS unsigned* cqp_ = (const LAS unsigned*)(wl + (BUF) * 2048 + 1024 + (JT) * 128 + j * 16); \
        int acc[16]; \
        _Pragma("unroll") for (int i = 0; i < 16; ++i) acc[i] = 0; \
        _Pragma("unroll") for (int qd = 0; qd < 4; ++qd) { const int cp = (int)cqp_[qd]; \
            _Pragma("unroll") for (int i = 0; i < 4; ++i) { const unsigned w0 = VR[4 * qd][i], w1 = VR[4 * qd + 1][i], w2 = VR[4 * qd + 2][i], w3 = VR[4 * qd + 3][i]; \
                const unsigned t0 = bperm(w1, w0, 0x05010400u), t1 = bperm(w1, w0, 0x07030602u), t2 = bperm(w3, w2, 0x05010400u), t3 = bperm(w3, w2, 0x07030602u); \
                acc[4 * i] = __builtin_amdgcn_sdot4((int)bperm(t2, t0, 0x05040100u), cp, acc[4 * i], false); \
                acc[4 * i + 1] = __builtin_amdgcn_sdot4((int)bperm(t2, t0, 0x07060302u), cp, acc[4 * i + 1], false); \
                acc[4 * i + 2] = __builtin_amdgcn_sdot4((int)bperm(t3, t1, 0x05040100u), cp, acc[4 * i + 2], false); \
                acc[4 * i + 3] = __builtin_amdgcn_sdot4((int)bperm(t3, t1, 0x07060302u), cp, acc[4 * i + 3], false); } } \
          \
        int r1[8], r2[4], r3[2]; \
        _Pragma("unroll") for (int i = 0; i < 8; ++i) { const int keep = b3 ? acc[i + 8] : acc[i], send = b3 ? acc[i] : acc[i + 8]; r1[i] = keep + dppi<0x128>(send); }                          \
        _Pragma("unroll") for (int i = 0; i < 4; ++i) { const int keep = b4 ? r1[i + 4] : r1[i], send = b4 ? r1[i] : r1[i + 4]; r2[i] = keep + __builtin_amdgcn_ds_swizzle(send, 0x401F); }     \
        _Pragma("unroll") for (int i = 0; i < 2; ++i) { const int keep = b5 ? r2[i + 2] : r2[i], send = b5 ? r2[i] : r2[i + 2]; r3[i] = keep + (int)partner32((unsigned)send, b5); }              \
        *(unsigned*)(YF + ((size_t)(TILE) * 32 + wid * 4 + (JT)) * DM + 128 * x + 16 * c + 8 * b3 + 4 * b4 + 2 * b5) = pk2((float)r3[0] * SC, (float)r3[1] * SC); } while (0)
    u32x4 vrA[16], vrB[16]; float scA, scB; const int b3 = j & 1, b4 = (j >> 1) & 1, b5 = j >> 2;
    VP_STAGE_LOAD(tile0); VP_STAGE_STORE(0);
    VP_GATHER(vrA, scA, 0, 0, tile0);
    int buf = 0;
#pragma unroll 1
    for (int tile = tile0; tile < TOK / 32; tile += tstep) {
        const int tnext = tile + tstep < TOK / 32 ? tile + tstep : tile;
        VP_STAGE_LOAD(tnext);
        VP_GATHER(vrB, scB, buf, 1, tile); VP_COMPUTE(vrA, scA, buf, 0, tile);
        VP_GATHER(vrA, scA, buf, 2, tile); VP_COMPUTE(vrB, scB, buf, 1, tile);
        VP_GATHER(vrB, scB, buf, 3, tile); VP_COMPUTE(vrA, scA, buf, 2, tile);
        VP_STAGE_STORE(buf ^ 1);
        VP_GATHER(vrA, scA, buf ^ 1, 0, tnext);
        VP_COMPUTE(vrB, scB, buf, 3, tile);
        buf ^= 1;
    }
#undef VP_STAGE_LOAD
#undef VP_STAGE_STORE
#undef VP_GATHER
#undef VP_COMPUTE
}
DI void final_rows2(size_t m0, size_t m1, const bf16_t* __restrict__ Rp, const bf16_t* __restrict__ YF, const float* __restrict__ MOD, const float* __restrict__ g1, const float* __restrict__ b1,
                    const float* __restrict__ ln_g, const float* __restrict__ ln_b, float* __restrict__ OUT) {
    const int lane = threadIdx.x & 63;
    f32x4 v[2][4], y[2][4];
#pragma unroll
    for (int r = 0; r < 2; ++r) { const size_t m = r ? m1 : m0;
        const u32x2* rr = (const u32x2*)(Rp + m * DM) + lane; const u32x2* yr = (const u32x2*)(YF + m * DM) + lane;
#pragma unroll
        for (int q = 0; q < 4; ++q) { const u32x2 rw = rr[64 * q]; v[r][q] = (f32x4){bf_lo(rw.x), bf_hi(rw.x), bf_lo(rw.y), bf_hi(rw.y)}; const u32x2 yy = yr[64 * q]; y[r][q] = (f32x4){bf_lo(yy.x), bf_hi(yy.x), bf_lo(yy.y), bf_hi(yy.y)}; } }
#pragma unroll
    for (int r = 0; r < 2; ++r) { const size_t m = r ? m1 : m0; const int b = (int)(m / SEQ); const f32x4* gt = (const f32x4*)(MOD + (size_t)b * MODW + 5 * DM) + lane; float s = 0.f;
#pragma unroll
        for (int q = 0; q < 4; ++q) s += (v[r][q].x + v[r][q].y) + (v[r][q].z + v[r][q].w);
        float mean = wave_sum(s) * (1.f / DM); float s2 = 0.f;
#pragma unroll
        for (int q = 0; q < 4; ++q) { v[r][q] = v[r][q] - mean; s2 += (v[r][q].x * v[r][q].x + v[r][q].y * v[r][q].y) + (v[r][q].z * v[r][q].z + v[r][q].w * v[r][q].w); }
        float rstd = rsqrtf(wave_sum(s2) * (1.f / DM) + LN_EPS); s = 0.f;
#pragma unroll
        for (int q = 0; q < 4; ++q) { const f32x4 x1 = v[r][q] * rstd * ((const f32x4*)g1)[lane + 64 * q] + ((const f32x4*)b1)[lane + 64 * q];
            v[r][q] = x1 * ALPHA_RES + gt[64 * q] * y[r][q]; s += (v[r][q].x + v[r][q].y) + (v[r][q].z + v[r][q].w); }
        mean = wave_sum(s) * (1.f / DM); s2 = 0.f;
#pragma unroll
        for (int q = 0; q < 4; ++q) { v[r][q] = v[r][q] - mean; s2 += (v[r][q].x * v[r][q].x + v[r][q].y * v[r][q].y) + (v[r][q].z * v[r][q].z + v[r][q].w * v[r][q].w); }
        rstd = rsqrtf(wave_sum(s2) * (1.f / DM) + LN_EPS);
        f32x4* op = (f32x4*)(OUT + m * DM) + lane;
#pragma unroll
        for (int q = 0; q < 4; ++q) op[64 * q] = v[r][q] * rstd * ((const f32x4*)ln_g)[lane + 64 * q] + ((const f32x4*)ln_b)[lane + 64 * q]; }
}
}
constexpr int NWAVES = 8;
#ifndef MK_N_LAUNCHES
#define MK_N_LAUNCHES 1
#endif
constexpr int N_PHASES = 14;
constexpr int RING_BYTES = 147456;
constexpr int MISC_OFF = RING_BYTES;
constexpr int LDS_BYTES = RING_BYTES + 4096;
static_assert(pg8::STAGE_BYTES <= RING_BYTES && datt::LDS_BYTES <= RING_BYTES && mls::LDS_BYTES <= RING_BYTES && peer::LDS_BYTES <= RING_BYTES, "LDS map");

typedef GAS unsigned gu32;
#define RLX_AGENT __ATOMIC_RELAXED, __HIP_MEMORY_SCOPE_AGENT
#define LDS_WAIT() asm volatile("s_waitcnt lgkmcnt(0)" ::: "memory")

#define XB_TMO      128
#define XB_XCNT(j)  (256  + 64 * (j))
#define XB_XSUB(j)  (1280 + 64 * (j))
#define XB_XGEN(j)  (2304 + 64 * (j))
#define XB_TOP      3328
#define XB_TOPGEN   3392
#define XCD_BAR_WORDS 3456
#define XB_SPIN_CAP (1u << 22)
DI unsigned xb_ld(unsigned* p)              { return __hip_atomic_load(p, __ATOMIC_RELAXED, __HIP_MEMORY_SCOPE_AGENT); }
DI unsigned xb_add(unsigned* p, unsigned v) { return __hip_atomic_fetch_add(p, v, __ATOMIC_RELAXED, __HIP_MEMORY_SCOPE_AGENT); }
DI unsigned xb_xcc_id() { return (unsigned)__builtin_amdgcn_s_getreg((3 << 11) | 20) & 0xFu; }
#define XB_SPIN(cond, bar) do { unsigned _sp = 0; while (cond) { __builtin_amdgcn_s_sleep(1); \
    if ((++_sp & 255u) == 0u) { if (xb_ld(&(bar)[XB_TMO])) break; if (_sp > XB_SPIN_CAP) { atomicAdd(&(bar)[XB_TMO], 1u); break; } } } } while (0)
struct XcdBarrier { unsigned* bar; unsigned x; volatile LAS unsigned* st; };
DI XcdBarrier xcd_barrier_post(unsigned* bar, volatile LAS unsigned* st) {
    XcdBarrier b; b.bar = bar; b.x = xb_xcc_id(); b.st = st;
    if (threadIdx.x == 0) st[2] = xb_add(&bar[XB_XCNT(b.x)], 1u);
    return b;
}
DI void xcd_barrier_complete(unsigned* bar, unsigned x, unsigned& nloc, unsigned& nx) {
    const unsigned G = gridDim.x * gridDim.y * gridDim.z;
    unsigned sum, cnt, mine, sp = 0u;
    for (;;) {
        sum = 0u; cnt = 0u; mine = 0u;
#pragma unroll
        for (unsigned j = 0; j < 16; ++j) { const unsigned c = xb_ld(&bar[XB_XCNT(j)]); sum += c; cnt += (c > 0u) ? 1u : 0u; mine = (j == x) ? c : mine; }
        if (sum == G) break;
        __builtin_amdgcn_s_sleep(1);
        if ((++sp & 255u) == 0u) { if (xb_ld(&bar[XB_TMO])) break; if (sp > XB_SPIN_CAP) { atomicAdd(&bar[XB_TMO], 1u); break; } }
    }
    nloc = mine > 0u ? mine : 1u; nx = cnt > 0u ? cnt : 1u;
}
DI void xcd_barrier(const XcdBarrier& b) {
    asm volatile("s_waitcnt vmcnt(0)" ::: "memory");
    __syncthreads();
    if (threadIdx.x == 0) {
        unsigned* bar = b.bar;
        __builtin_amdgcn_s_waitcnt(0);
        unsigned nloc = b.st[0], nx = b.st[1];
        if (nloc == 0u) { xcd_barrier_complete(bar, b.x, nloc, nx); b.st[0] = nloc; b.st[1] = nx; }
        const unsigned old = xb_add(&bar[XB_XSUB(b.x)], 1u);
        const unsigned gen = old / nloc;
        if (old + 1u == (gen + 1u) * nloc) {
            __builtin_amdgcn_fence(__ATOMIC_RELEASE, "agent");
            asm volatile("s_waitcnt vmcnt(0)" ::: "memory");
            const unsigned og = xb_add(&bar[XB_TOP], 1u);
            const unsigned tg = og / nx;
            if (og + 1u == (tg + 1u) * nx) xb_add(&bar[XB_TOPGEN], 1u);
            else XB_SPIN(xb_ld(&bar[XB_TOPGEN]) == tg, bar);
            xb_add(&bar[XB_XGEN(b.x)], 1u);
            __builtin_amdgcn_fence(__ATOMIC_ACQUIRE, "agent");
            asm volatile("s_waitcnt vmcnt(0)" ::: "memory");
        } else {
            XB_SPIN(xb_ld(&bar[XB_XGEN(b.x)]) == gen, bar);
            __builtin_amdgcn_fence(__ATOMIC_ACQUIRE, "agent");
            asm volatile("s_waitcnt vmcnt(0)" ::: "memory");
        }
    }
    __syncthreads();
}

#ifndef FLATBAR
#define FLATBAR 0
#endif
DI void flat_barrier(unsigned* cnt, unsigned& epoch) {
    asm volatile("s_waitcnt vmcnt(0)" ::: "memory");
    __syncthreads();
    if (threadIdx.x == 0) {
        __builtin_amdgcn_fence(__ATOMIC_RELEASE, "agent");
        asm volatile("s_waitcnt vmcnt(0)" ::: "memory");
        const unsigned target = (epoch + 1u) * gridDim.x;
        xb_add(cnt, 1u);
        unsigned sp = 0;
        while (xb_ld(cnt) < target) { __builtin_amdgcn_s_sleep(1); if (++sp > (1u << 24)) break; }
        __builtin_amdgcn_fence(__ATOMIC_ACQUIRE, "agent");
        asm volatile("s_waitcnt vmcnt(0)" ::: "memory");
    }
    ++epoch;
    __syncthreads();
}
DI void p0_transpose_item(const float* W, int ldw, int col0, bf16_t* WT, int K, int dst_row0, int kb, float scale, LAS float* scr, int lane) {
    const int k0 = 64 * kb;
    float tv[32];
    { const float* wp = W + (size_t)(k0 + (lane >> 5)) * ldw + col0 + (lane & 31);
#pragma unroll
      for (int i = 0; i < 32; ++i) tv[i] = wp[(size_t)(2 * i) * ldw]; }
    __builtin_amdgcn_sched_barrier(0);
#pragma unroll
    for (int i = 0; i < 32; ++i) { const int kk = 2 * i + (lane >> 5); scr[kk * 33 + (lane & 31)] = tv[i] * scale; }
    LDS_WAIT(); asm volatile("" ::: "memory");
    const int c = lane & 7;
#pragma unroll
    for (int j = 0; j < 4; ++j) { const int n = (lane >> 3) + 8 * j; const LAS float* s = scr + (8 * c) * 33 + n;
        u32x4 o; o.x = pk2(s[0 * 33], s[1 * 33]); o.y = pk2(s[2 * 33], s[3 * 33]); o.z = pk2(s[4 * 33], s[5 * 33]); o.w = pk2(s[6 * 33], s[7 * 33]);
        *(u32x4*)(WT + (size_t)(dst_row0 + n) * K + k0 + 8 * c) = o; }
    LDS_WAIT(); asm volatile("" ::: "memory");
}


DI void p1_rows2(int m0, int m1, int lane, const float* __restrict__ xin, const float* __restrict__ MODp, bf16_t* __restrict__ H1p, float* __restrict__ GIFp, const float* __restrict__ bif, const LAS float* wif) {
    f32x4 v[2][4], scv[2][4], shv[2][4];
#pragma unroll
    for (int r = 0; r < 2; ++r) { const int m = r ? m1 : m0; const int b = m / SEQ;
        const f32x4* xr = (const f32x4*)(xin + (size_t)m * DM) + lane; const f32x4* sh = (const f32x4*)(MODp + (size_t)b * MODW) + lane; const f32x4* sc = (const f32x4*)(MODp + (size_t)b * MODW + DM) + lane;
#pragma unroll
        for (int j = 0; j < 4; ++j) { v[r][j] = xr[64 * j]; scv[r][j] = sc[64 * j]; shv[r][j] = sh[64 * j]; } }
#pragma unroll
    for (int r = 0; r < 2; ++r) { const int m = r ? m1 : m0; float s = 0.f;
#pragma unroll
        for (int j = 0; j < 4; ++j) s += (v[r][j].x + v[r][j].y) + (v[r][j].z + v[r][j].w);
        const float mean = wave_sum(s) * (1.f / DM); float s2 = 0.f;
#pragma unroll
        for (int j = 0; j < 4; ++j) { v[r][j] = v[r][j] - mean; s2 += (v[r][j].x * v[r][j].x + v[r][j].y * v[r][j].y) + (v[r][j].z * v[r][j].z + v[r][j].w * v[r][j].w); }
        const float rstd = rsqrtf(wave_sum(s2) * (1.f / DM) + LN_EPS);
        unsigned long long* o8 = (unsigned long long*)(H1p + (size_t)m * DM) + lane;
        float gp[8];
#pragma unroll
        for (int g = 0; g < 8; ++g) gp[g] = 0.f;
        const LAS float* wl = wif + 4 * lane; asm volatile("" : "+v"(wl));
#pragma unroll
        for (int j = 0; j < 4; ++j) { const f32x4 hh = v[r][j] * rstd * (scv[r][j] + 1.0f) + shv[r][j];
            o8[64 * j] = (unsigned long long)pk2(hh.x, hh.y) | ((unsigned long long)pk2(hh.z, hh.w) << 32);
#pragma unroll
            for (int g = 0; g < 8; ++g) { const f32x4 w = *(const LAS f32x4*)(wl + g * 1024 + 256 * j); gp[g] += (hh.x * w.x + hh.y * w.y) + (hh.z * w.z + hh.w * w.w); } }
#pragma unroll
        for (int g = 0; g < 8; ++g) gp[g] = wave_sum(gp[g]);
        if (lane == 0) {
#pragma unroll
            for (int g = 0; g < 8; ++g) GIFp[(size_t)m * 8 + g] = gp[g] + bif[g]; } }
}
template <int NR> DI void p7_rows(int m0, int lane, const bf16_t* __restrict__ Rp, const float* __restrict__ MODp, const float* __restrict__ g1, const float* __restrict__ b1,
                 bf16_t* __restrict__ H2p, unsigned char* __restrict__ H2Qp, float* __restrict__ SHp) {
    f32x4 v[NR][4], scv[4], shv[4];
    { const int b = m0 / SEQ; const f32x4* sh = (const f32x4*)(MODp + (size_t)b * MODW + 3 * DM) + lane; const f32x4* sc = (const f32x4*)(MODp + (size_t)b * MODW + 4 * DM) + lane;
#pragma unroll
      for (int r = 0; r < NR; ++r) { const u32x2* rr = (const u32x2*)(Rp + (size_t)(m0 + r) * DM) + lane;
#pragma unroll
        for (int j = 0; j < 4; ++j) { const u32x2 rw = rr[64 * j]; v[r][j] = (f32x4){bf_lo(rw.x), bf_hi(rw.x), bf_lo(rw.y), bf_hi(rw.y)}; } }
#pragma unroll
      for (int j = 0; j < 4; ++j) { scv[j] = sc[64 * j]; shv[j] = sh[64 * j]; } }
#pragma unroll
    for (int r = 0; r < NR; ++r) { const int m = m0 + r; float s = 0.f;
#pragma unroll
        for (int j = 0; j < 4; ++j) s += (v[r][j].x + v[r][j].y) + (v[r][j].z + v[r][j].w);
        float mean = wave_sum(s) * (1.f / DM); float s2 = 0.f;
#pragma unroll
        for (int j = 0; j < 4; ++j) { v[r][j] = v[r][j] - mean; s2 += (v[r][j].x * v[r][j].x + v[r][j].y * v[r][j].y) + (v[r][j].z * v[r][j].z + v[r][j].w * v[r][j].w); }
        float rstd = rsqrtf(wave_sum(s2) * (1.f / DM) + LN_EPS);
        s = 0.f;
#pragma unroll
        for (int j = 0; j < 4; ++j) { v[r][j] = v[r][j] * rstd * ((const f32x4*)g1)[lane + 64 * j] + ((const f32x4*)b1)[lane + 64 * j]; s += (v[r][j].x + v[r][j].y) + (v[r][j].z + v[r][j].w); }
        mean = wave_sum(s) * (1.f / DM); s2 = 0.f;
#pragma unroll
        for (int j = 0; j < 4; ++j) { v[r][j] = v[r][j] - mean; s2 += (v[r][j].x * v[r][j].x + v[r][j].y * v[r][j].y) + (v[r][j].z * v[r][j].z + v[r][j].w * v[r][j].w); }
        rstd = rsqrtf(wave_sum(s2) * (1.f / DM) + LN_EPS);
        unsigned long long* o8 = (unsigned long long*)(H2p + (size_t)m * DM) + lane;
        float amax = 0.f;
#pragma unroll
        for (int j = 0; j < 4; ++j) { const f32x4 hh = v[r][j] * rstd * (scv[j] + 1.0f) + shv[j]; o8[64 * j] = (unsigned long long)pk2(hh.x, hh.y) | ((unsigned long long)pk2(hh.z, hh.w) << 32);
            v[r][j] = hh; amax = fmaxf(amax, fmaxf(fmaxf(fabsf(hh.x), fabsf(hh.y)), fmaxf(fabsf(hh.z), fabsf(hh.w)))); }
        amax = wave_max(amax);
        const float qinv = amax > 0.f ? 119.0f / amax : 0.f;
        unsigned char* hq = H2Qp + (size_t)m * DM;
#pragma unroll
        for (int j = 0; j < 4; ++j) { const int q0 = (int)rintf(v[r][j].x * qinv), q1 = (int)rintf(v[r][j].y * qinv), q2 = (int)rintf(v[r][j].z * qinv), q3 = (int)rintf(v[r][j].w * qinv);
            const int a0 = (q0 + 8) >> 4, a1 = (q1 + 8) >> 4, a2 = (q2 + 8) >> 4, a3 = (q3 + 8) >> 4;
            const unsigned ha = (unsigned)(a0 & 15) | ((unsigned)(a1 & 15) << 4) | ((unsigned)(a2 & 15) << 8) | ((unsigned)(a3 & 15) << 12);
            const unsigned hb = (unsigned)((q0 - 16 * a0) & 15) | ((unsigned)((q1 - 16 * a1) & 15) << 4) | ((unsigned)((q2 - 16 * a2) & 15) << 8) | ((unsigned)((q3 - 16 * a3) & 15) << 12);
            const unsigned pa = (unsigned)dppi<0xB1>((int)ha), pb = (unsigned)dppi<0xB1>((int)hb);
            if (!(lane & 1)) { *(unsigned*)(hq + 128 * j + 2 * lane) = ha | (pa << 16); *(unsigned*)(hq + 512 + 128 * j + 2 * lane) = hb | (pb << 16); } }
        if (lane == 0) SHp[m] = amax * (1.0f / 119.0f); }
}


DI void prep_small_weights_item(LAS unsigned char* lds, int item, const float* w0, const float* w1, const float* w2, const float* w3, bf16_t* d0, bf16_t* d1, bf16_t* d2, bf16_t* d3) {
    int t = threadIdx.x; OPAQUE(t); const int lane = t & 63, wave = __builtin_amdgcn_readfirstlane(t >> 6);
    const int r = item * 8 + wave, wsel = r / 512, q = r % 512, kb = q / 32, nb = q % 32;
    const float* src = wsel == 0 ? w0 : wsel == 1 ? w1 : wsel == 2 ? w2 : w3; bf16_t* dst = wsel == 0 ? d0 : wsel == 1 ? d1 : wsel == 2 ? d2 : d3;
    p0_transpose_item(src, DM, 32 * nb, dst, DM, 32 * nb, kb, 1.0f, (LAS float*)(lds + wave * 16384), lane);
}
DI void prep_quant_item(int item, const float* pu, const float* pv, unsigned char* U8, unsigned char* V8, float* SU, float* SV) {
    int t = threadIdx.x; OPAQUE(t); const int lane = t & 63, wave = __builtin_amdgcn_readfirstlane(t >> 6);
#pragma unroll 1
    for (int it = 0; it < 4; ++it) { const int row0 = item * 128 + wave * 16 + it * 4;
        f32x4 a[4][4];
#pragma unroll
        for (int r = 0; r < 4; ++r) { const int row = row0 + r; const bool second = row >= NEXP; const int e = second ? row - NEXP : row;
            const float* s = (second ? pv : pu) + (size_t)e * DM + 16 * lane;
#pragma unroll
            for (int j = 0; j < 4; ++j) a[r][j] = *(const f32x4*)(s + 4 * j); }
#pragma unroll
        for (int r = 0; r < 4; ++r) { const int row = row0 + r; const bool second = row >= NEXP; const int e = second ? row - NEXP : row;
            float amax = 0.f;
#pragma unroll
            for (int j = 0; j < 4; ++j) amax = fmaxf(amax, fmaxf(fmaxf(fabsf(a[r][j].x), fabsf(a[r][j].y)), fmaxf(fabsf(a[r][j].z), fabsf(a[r][j].w))));
            amax = wave_max(amax);
            if (second) {
            const float inv = amax > 0.f ? 127.0f / amax : 0.f;
            u32x4 w;
#pragma unroll
            for (int j = 0; j < 4; ++j) { const int q0 = (int)rintf(a[r][j].x * inv), q1 = (int)rintf(a[r][j].y * inv), q2 = (int)rintf(a[r][j].z * inv), q3 = (int)rintf(a[r][j].w * inv);
                w[j] = (unsigned)(q0 & 255) | ((unsigned)(q1 & 255) << 8) | ((unsigned)(q2 & 255) << 16) | ((unsigned)(q3 & 255) << 24); }
            *(u32x4*)(V8 + (size_t)(lane >> 3) * NEXP * 128 + (size_t)e * 128 + (lane & 7) * 16) = w;
            if (lane == 0) SV[e] = amax * (1.0f / 127.0f);
            } else {
            const float inv = amax > 0.f ? 7.0f / amax : 0.f;
            u32x2 w;
#pragma unroll
            for (int j = 0; j < 4; ++j) { const unsigned n0 = (unsigned)((int)rintf(a[r][j].x * inv) & 15), n1 = (unsigned)((int)rintf(a[r][j].y * inv) & 15), n2 = (unsigned)((int)rintf(a[r][j].z * inv) & 15), n3 = (unsigned)((int)rintf(a[r][j].w * inv) & 15);
                const unsigned two = n0 | (n1 << 4) | (n2 << 8) | (n3 << 12);
                if (j & 1) w[j >> 1] |= two << 16; else w[j >> 1] = two; }
            *(u32x2*)(U8 + (size_t)(lane >> 4) * NEXP * 128 + (size_t)e * 128 + (lane & 15) * 8) = w;
            if (lane == 0) SU[e] = amax * (1.0f / 7.0f);
            } } }
}

struct Args { const float* in[22]; float* out; unsigned char* ws; int ph_lo, ph_hi; };

__global__ void __launch_bounds__(NWAVES * 64, 2) mega_fwd(Args args) {
    extern __shared__ __attribute__((aligned(16))) unsigned char lds_raw[];
    LAS unsigned char* lds = (LAS unsigned char*)lds_raw;
    volatile LAS unsigned* MISC = (volatile LAS unsigned*)(lds + MISC_OFF);
    const int tid = threadIdx.x, lane = tid & 63, wave = __builtin_amdgcn_readfirstlane(tid >> 6);
    const int G = gridDim.x; const int bx = blockIdx.x; const int vcu = (G % 8 == 0) ? (bx % 8) * (G / 8) + bx / 8 : bx;
    const int gw = vcu * NWAVES + wave, NGW = G * NWAVES;
#define ws (args.ws)
#define ctl ((unsigned*)(ws + WS_CTL))
#define x_in (args.in[0])
#define cvec (args.in[1])
#define w_ada (args.in[2])
#define b_ada (args.in[3])
#define w_in (args.in[4])
#define b_if (args.in[5])
#define conv_w (args.in[6])
#define conv_b (args.in[7])
#define da_lambda (args.in[8])
#define da_subln_g (args.in[9])
#define ml_norm_g (args.in[10])
#define w_br_attn (args.in[11])
#define w_br_mlstm (args.in[12])
#define w_out (args.in[13])
#define ln1_g (args.in[14])
#define ln1_b (args.in[15])
#define peer_wq (args.in[16])
#define peer_keys (args.in[17])
#define peer_u (args.in[18])
#define peer_v (args.in[19])
#define ln2_g (args.in[20])
#define ln2_b (args.in[21])
#define MOD ((float*)(ws + WS_MOD))
#define GIF ((float*)(ws + WS_GIF))
#define WIN ((bf16_t*)(ws + WS_WIN))
#define WA ((bf16_t*)(ws + WS_WA))
#define WM ((bf16_t*)(ws + WS_WM))
#define WOUT ((bf16_t*)(ws + WS_WOUT))
#define WQ ((bf16_t*)(ws + WS_WQ))
#define UT8 ((unsigned char*)(ws + WS_U))
#define VT8 ((unsigned char*)(ws + WS_V))
#define SUS ((float*)(ws + WS_SU))
#define SVS ((float*)(ws + WS_SV))
#define SHS ((float*)(ws + WS_SH))
#define CSS ((float*)(ws + WS_CS))
#define H2Q ((unsigned char*)(ws + WS_H2Q))
#define SELE ((bf16_t*)(ws + WS_SELE))
#define SELG ((float*)(ws + WS_SELG))
#define PART ((bf16_t*)(ws + WS_PART))
#define YFB ((bf16_t*)(ws + WS_YF))
#define COEF ((signed char*)(ws + WS_COEF))
#define H1 ((bf16_t*)(ws + WS_H1))
#define Z ((bf16_t*)(ws + WS_Z))
#define R ((bf16_t*)(ws + WS_R))
#define X1 ((float*)(ws + WS_X1))
#define H2 ((bf16_t*)(ws + WS_H2))
#define QP ((bf16_t*)(ws + WS_QP))
#define GATES ((bf16_t*)args.out)

    for (int u = tid; u < (LDS_BYTES - MISC_OFF) / 4; u += NWAVES * 64) MISC[u] = 0u;
    __syncthreads();
    XcdBarrier bar; bar.bar = ctl + CW_BAR; bar.x = 0; bar.st = nullptr;
    if (MK_N_LAUNCHES != N_PHASES) bar = xcd_barrier_post(ctl + CW_BAR, MISC + 8);
    const int lo = args.ph_lo, hi = args.ph_hi;
#ifndef PH_MASK
#define PH_MASK 0x3fff
#endif
#define IN(k) (((PH_MASK >> (k)) & 1) && lo <= (k) && (k) < hi)
    unsigned fepoch = 0; unsigned* fcnt = ctl + CW_QUEUE + 1024;
#if FLATBAR
#define GBAR() flat_barrier(fcnt, fepoch)
#else
#define GBAR() xcd_barrier(bar)
#endif
#define SEAM(k) do { if (IN(k) && IN((k) + 1)) GBAR(); } while (0)

#ifndef XBAR0
#define XBAR0 0
#endif
#if XBAR0
    if (IN(0)) for (int xb = 0; xb < XBAR0; ++xb) xcd_barrier(bar);
#endif
    if (IN(0)) {
        if (vcu * NWAVES < 96 * 8) {
            LAS float* sl = (LAS float*)lds;
#pragma unroll 1
            for (int i0 = tid; i0 < 32 * DM; i0 += 16 * NWAVES * 64) { float cv[16];
#pragma unroll
                for (int n = 0; n < 16; ++n) cv[n] = cvec[i0 + n * NWAVES * 64];
#pragma unroll
                for (int n = 0; n < 16; ++n) sl[i0 + n * NWAVES * 64] = siluf_(cv[n]); }
            __syncthreads();
            for (int it = gw; it < 96 * 8; it += NGW) {
                const int cb = it % 96, ks = it / 96, col = 64 * cb + lane;
                float acc[32];
#pragma unroll
                for (int b = 0; b < 32; ++b) acc[b] = 0.f;
#pragma unroll 1
                for (int k0 = 128 * ks; k0 < 128 * ks + 128; k0 += 16) { float wv[16];
#pragma unroll
                    for (int kk = 0; kk < 16; ++kk) wv[kk] = w_ada[(size_t)(k0 + kk) * MODW + col];
                    __builtin_amdgcn_sched_barrier(0);
#pragma unroll
                    for (int kk = 0; kk < 16; ++kk)
#pragma unroll
                        for (int b = 0; b < 32; ++b) acc[b] += sl[b * DM + k0 + kk] * wv[kk]; }
                const float bias = (ks == 0) ? b_ada[col] : 0.f;
#pragma unroll
                for (int b = 0; b < 32; ++b) atomicAdd(MOD + b * MODW + col, acc[b] + bias);
            }
            __syncthreads();
        }
        LAS float* scr = (LAS float*)(lds + wave * 16384);
        const bool spare = NGW > 96 * 8 + 64; const int tw = spare ? gw - 96 * 8 : gw, ntw = spare ? NGW - 96 * 8 : NGW;
        if (tw >= 0) for (int it = tw; it < 4096; it += ntw) { const int kb = it / 256, nb = it % 256, n0 = 32 * nb; p0_transpose_item(w_in, IN_W, n0 < NZ ? n0 : n0 + 8, WIN, DM, n0, kb, n0 < 1024 ? QSCALE : 1.0f, scr, lane); }
    }
    SEAM(0);
    if (IN(1)) {
        LAS float* wif = (LAS float*)lds;
        { float wv[16];
#pragma unroll
          for (int n = 0; n < 16; ++n) { const int i = tid + 512 * n, k = i >> 3, j = i & 7; wv[n] = w_in[(size_t)k * IN_W + NZ + j]; }
#pragma unroll
          for (int n = 0; n < 16; ++n) { const int i = tid + 512 * n, k = i >> 3, j = i & 7; wif[j * 1024 + k] = wv[n]; } }
        __syncthreads();
        for (int m = gw; m < TOK; m += 2 * NGW) p1_rows2(m, m + NGW, lane, x_in, MOD, H1, GIF, b_if, wif);
    }
#if DUP1
    GBAR();
    if (IN(1)) {
        LAS float* wif = (LAS float*)lds;
        for (int i = tid; i < 8192; i += 512) { const int k = i >> 3, j = i & 7; wif[j * 1024 + k] = w_in[(size_t)k * IN_W + NZ + j]; }
        __syncthreads();
        for (int m = gw; m < TOK; m += 2 * NGW) p1_rows2(m, m + NGW, lane, x_in, MOD, H1, GIF, b_if, wif);
    }
#endif
    SEAM(1);
#ifndef DUP4
#define DUP4 0
#endif
#ifndef DUP6
#define DUP6 0
#endif
#ifndef DUP7
#define DUP7 0
#endif
#ifndef DUP8
#define DUP8 0
#endif
#ifndef DUP1
#define DUP1 0
#endif
#ifndef DUP2
#define DUP2 0
#endif
#ifndef DUP23
#define DUP23 0
#endif
#ifndef P2_STAGGER
#define P2_STAGGER 0
#endif
#define P2_BODY if (IN(2)) { if (P2_STAGGER && ((bx >> 3) & 1)) { const unsigned long long t0_ = __builtin_amdgcn_s_memrealtime(); while (__builtin_amdgcn_s_memrealtime() - t0_ < P2_STAGGER) __builtin_amdgcn_s_sleep(64); } \
        pg8::Gemm g{H1, WIN, TOK, NIN, DM, DM, DM}; pg8::StaticOrder S; S.init(TOK, NIN, G, bx); pg8::EpiZ E{Z, GATES}; \
        pg8::gemm_phase<pg8::EpiZ, pg8::StaticOrder, true, true>(lds, g, S, E); }
#define P3_BODY(QOFF) if (IN(3)) { const float p3_lam = datt::attn_lambda(da_lambda); unsigned* qhead = ctl + CW_QUEUE + (QOFF); int qx = (int)(bar.x & 7u), qtries = 0; const unsigned qlen = 16u + 256u + ((QOFF) == 0 ? 64u : 0u); \
        for (;;) { __syncthreads(); \
            if (tid == 0) { unsigned w = 0xffffffffu; while (qtries < 8) { const unsigned k = __hip_atomic_fetch_add(qhead + qx, 1u, RLX_AGENT); if (k < qlen) { w = ((unsigned)qx << 16) | k; break; } qx = (qx + 1) & 7; ++qtries; } MISC[0] = w; } \
            __syncthreads(); \
            const unsigned w = MISC[0]; if (w == 0xffffffffu) break; const int q = (int)(w >> 16), k = (int)(w & 0xffffu); \
            if (k < 16) { const int u = q * 16 + k; mls::mlstm_unit<false>(lds, Z, GIF, conv_w, conv_b, ml_norm_g, u >> 2, u & 3); } \
            else if (k < 272) { const int a = k - 16, a2 = a & 127, qb = ((a >> 7) ? 3 : 7) - (a2 & 3), bh = q * 32 + (a2 >> 2); datt::attn_unit<false>(lds, Z, p3_lam, da_subln_g, bh >> 3, bh & 7, qb); } \
            else { const int pid = q * 64 + (k - 272); \
                if (pid < 256) prep_quant_item(pid, peer_u, peer_v, UT8, VT8, SUS, SVS); \
                else prep_small_weights_item(lds, pid - 256, w_br_attn, w_br_mlstm, w_out, peer_wq, WA, WM, WOUT, WQ); } } }
#define P3A_DRY(QOFF) if (IN(3)) { const float p3_lam = datt::attn_lambda(da_lambda); unsigned* qhead = ctl + CW_QUEUE + (QOFF); \
        for (;;) { __syncthreads(); if (tid == 0) MISC[0] = __hip_atomic_fetch_add(qhead, 1u, RLX_AGENT); __syncthreads(); \
            const int id = (int)MISC[0]; if (id >= 2048) break; \
            { const int idx = id, qb = 7 - idx / 256, bh = idx % 256; datt::attn_unit<true>(lds, Z, p3_lam, da_subln_g, bh >> 3, bh & 7, qb); } } }
#define P3M_DRY(QOFF) if (IN(3)) { unsigned* qhead = ctl + CW_QUEUE + (QOFF); \
        for (;;) { __syncthreads(); if (tid == 0) MISC[0] = __hip_atomic_fetch_add(qhead, 1u, RLX_AGENT); __syncthreads(); \
            const int id = (int)MISC[0]; if (id >= 128) break; \
            mls::mlstm_unit<true, MLS_ABL>(lds, Z, GIF, conv_w, conv_b, ml_norm_g, id >> 2, id & 3); } }
#ifndef MLS_ABL
#define MLS_ABL 0
#endif
#ifndef DRY3A
#define DRY3A 0
#endif
#ifndef DRY3M
#define DRY3M 0
#endif
    P2_BODY
#if DUP2
    SEAM(2);
    P2_BODY
#endif
    SEAM(2);
#if DRY3A
    P3A_DRY(128)
    if (IN(3)) GBAR();
#endif
#if DRY3M
    P3M_DRY(192)
    if (IN(3)) GBAR();
#endif
    P3_BODY(0)
    SEAM(3);
#if DUP23
    P2_BODY
    SEAM(2);
    P3_BODY(64)
    SEAM(3);
#endif
    if (IN(4)) {
        pg8::Gemm g{Z + ZC_Q, WA, TOK, DM, DM, NZ, DM, (long)(ZC_MV - ZC_Q) * 2, (long)(WS_WM - WS_WA)}; pg8::StaticOrder2 S; S.init(TOK, DM, G, bx);
        pg8::EpiGate2 E{GATES, H1};
        pg8::gemm_phase<pg8::EpiGate2, pg8::StaticOrder2, true, true>(lds, g, S, E);
    }
    SEAM(4);
#define WG_SEAM() do { asm volatile("s_waitcnt vmcnt(0)" ::: "memory"); __syncthreads(); \
        if (tid == 0) { __builtin_amdgcn_fence(__ATOMIC_ACQUIRE, "agent"); asm volatile("s_waitcnt vmcnt(0)" ::: "memory"); } __syncthreads(); } while (0)
    if (IN(6)) {
        { pg8::Gemm g{H1, WOUT, TOK, DM, DM, DM, DM}; pg8::RowsOrder S; S.init(TOK, DM, G, bx);
          pg8::EpiR E{x_in, MOD, R};
          pg8::gemm_phase<pg8::EpiR, pg8::RowsOrder, true, true>(lds, g, S, E); }
        WG_SEAM();
        for (int pm = bx; pm < TOK / 256; pm += G)
#pragma unroll 1
            for (int k = 0; k < 8; ++k) p7_rows<4>(256 * pm + 32 * wave + 4 * k, lane, R, MOD, ln1_g, ln1_b, H2, H2Q, SHS);
        WG_SEAM();
        { pg8::Gemm g{H2, WQ, TOK, DM, DM, DM, DM}; pg8::RowsOrder S; S.init(TOK, DM, G, bx);
          pg8::EpiStore E{QP};
          pg8::gemm_phase<pg8::EpiStore, pg8::RowsOrder, true, true>(lds, g, S, E); }
        WG_SEAM();
        peer::stage_keys(lds, peer_keys);
        __syncthreads();
        for (int pm = bx; pm < TOK / 256; pm += G) peer::select_phase(lds, QP, 8 * pm, 1, 8 * pm + 8, SELE, SELG);
    }
#undef WG_SEAM
    if (IN(6) && IN(10)) GBAR();
    int sx = bx % 8, sr = bx / 8, sn = (G - sx + 7) / 8;
    if (IN(10) || IN(12)) {
        __syncthreads();
        if (tid == 0) { bool phys = (MK_N_LAUNCHES != N_PHASES) && lo == 0 && hi > 10; unsigned mine = 0;
            if (phys) { for (unsigned j = 0; j < 16; ++j) { const unsigned c = xb_ld(&bar.bar[XB_XCNT(j)]); if (j < 8) { if (c == 0u) phys = false; if (j == bar.x) mine = c; } else if (c != 0u) phys = false; } }
            MISC[16] = phys ? bar.x : (unsigned)sx; MISC[17] = phys ? MISC[10] : (unsigned)sr; MISC[18] = phys ? mine : (unsigned)sn; }
        __syncthreads();
        sx = (int)MISC[16]; sr = (int)MISC[17]; sn = (int)MISC[18];
    }
    if (IN(10)) {
        peer::u_phase(lds, 2 * sr + (sx >> 2), 2 * sn, sx & 3, SELE, H2Q, UT8, PART);
    }
    SEAM(10);
    if (IN(11)) { for (int m = 16 * gw; m < TOK; m += 16 * NGW) peer::red_tokens<16>((size_t)m, PART, SELE, SELG, SUS, SVS, SHS, COEF, CSS); }
    SEAM(11);
    if (IN(12)) {
        peer::v_phase(lds, sr, sn, sx, SELE, COEF, CSS, VT8, YFB);
    }
    SEAM(12);
    if (IN(13)) { for (int m = gw; m < TOK; m += 2 * NGW) peer::final_rows2((size_t)m, (size_t)m + NGW, R, YFB, MOD, ln1_g, ln1_b, ln2_g, ln2_b, args.out); }
#undef IN
#undef SEAM
#undef ws
#undef ctl
#undef x_in
#undef cvec
#undef w_ada
#undef b_ada
#undef w_in
#undef b_if
#undef conv_w
#undef conv_b
#undef da_lambda
#undef da_subln_g
#undef ml_norm_g
#undef w_br_attn
#undef w_br_mlstm
#undef w_out
#undef ln1_g
#undef ln1_b
#undef peer_wq
#undef peer_keys
#undef peer_u
#undef peer_v
#undef ln2_g
#undef ln2_b
#undef MOD
#undef GIF
#undef WIN
#undef WA
#undef WM
#undef WOUT
#undef WQ
#undef UT8
#undef VT8
#undef SUS
#undef SVS
#undef SHS
#undef CSS
#undef H2Q
#undef SELE
#undef SELG
#undef PART
#undef YFB
#undef COEF
#undef H1
#undef Z
#undef R
#undef X1
#undef H2
#undef QP
#undef GATES
}

extern "C" void kernel_launch(void* const* d_in, const int* in_sizes, int n_in, void* d_out, int out_size, void* d_ws, size_t ws_size, hipStream_t stream) {
    static int grid = 0;
    if (grid == 0) {
        if (n_in != 22 || in_sizes[0] != TOK * DM || out_size != TOK * DM || ws_size < WS_END) { fprintf(stderr, "kernel_launch: unexpected shapes (n_in %d, in0 %d, out %d, ws %zu; need ws >= %zu)\n", n_in, n_in > 0 ? in_sizes[0] : -1, out_size, ws_size, (size_t)WS_END); grid = -1; return; }
        int dev = 0, cus = 0, per_cu = 0;
        if (hipGetDevice(&dev) != hipSuccess || hipDeviceGetAttribute(&cus, hipDeviceAttributeMultiprocessorCount, dev) != hipSuccess) { fprintf(stderr, "kernel_launch: device query failed\n"); grid = -1; return; }
        if (hipFuncSetAttribute((const void*)mega_fwd, hipFuncAttributeMaxDynamicSharedMemorySize, LDS_BYTES) != hipSuccess) { fprintf(stderr, "kernel_launch: hipFuncSetAttribute failed\n"); grid = -1; return; }
        if (hipOccupancyMaxActiveBlocksPerMultiprocessor(&per_cu, (const void*)mega_fwd, NWAVES * 64, LDS_BYTES) != hipSuccess || per_cu < 1) fprintf(stderr, "kernel_launch: note: occupancy query reports %d workgroups per CU\n", per_cu);
        (void)hipGetLastError();
        grid = cus;
    }
    if (grid < 0) return;
    if (hipMemsetAsync((char*)d_ws + WS_CTL, 0, CTL_ZERO_BYTES, stream) != hipSuccess) { fprintf(stderr, "kernel_launch: memset failed\n"); return; }
    Args a{};
    for (int i = 0; i < 22; ++i) a.in[i] = (const float*)d_in[i];
    a.out = (float*)d_out; a.ws = (unsigned char*)d_ws;
    for (int li = 0; li < MK_N_LAUNCHES; ++li) {
        a.ph_lo = (MK_N_LAUNCHES == N_PHASES) ? li : 0; a.ph_hi = (MK_N_LAUNCHES == N_PHASES) ? li + 1 : N_PHASES;
        hipLaunchKernelGGL(mega_fwd, dim3(grid), dim3(NWAVES * 64), LDS_BYTES, stream, a);
        const hipError_t le = hipPeekAtLastError();
        if (le != hipSuccess) { fprintf(stderr, "kernel_launch: launch %d failed: %s\n", li, hipGetErrorName(le)); break; }
    }
}
```

```cpp
#include <hip/hip_runtime.h>
#include <hip/hip_bf16.h>
#include <cstdio>
#include <cstdint>
#include <cmath>

#define LAS __attribute__((address_space(3)))
#define GAS __attribute__((address_space(1)))
typedef unsigned short bf16_t;
typedef short bf16x8 __attribute__((ext_vector_type(8)));
typedef short s16x4 __attribute__((ext_vector_type(4)));
typedef float f32x2 __attribute__((ext_vector_type(2)));
typedef float f32x4 __attribute__((ext_vector_type(4)));
typedef float f32x16 __attribute__((ext_vector_type(16)));
typedef unsigned u32x2 __attribute__((ext_vector_type(2)));
typedef unsigned u32x4 __attribute__((ext_vector_type(4)));
typedef __bf16 bf16x2_t __attribute__((ext_vector_type(2)));
#define DI __device__ __forceinline__

constexpr int BATCH = 32, SEQ = 2048, DM = 1024, TOK = BATCH * SEQ;
constexpr int NZ = 6144;
constexpr int ZC_Q = 0, ZC_K = 1024, ZC_V = 2048, ZC_MQ = 3072, ZC_MK = 3584, ZC_MV = 4096, ZC_MO = 5120;
constexpr int NGATE = 2048;
constexpr int NIN = 8192;
constexpr int IN_W = 8200;
constexpr int MODW = 6 * DM;
constexpr float LN_EPS = 1e-5f;
constexpr float ALPHA_RES = 1.189207115002721f;
constexpr float LAMBDA_INIT = 0.2f;
constexpr float QSCALE = 0.125f * 1.4426950408889634f;
constexpr int NEXP = 16384;

constexpr size_t MiB = 1u << 20;
constexpr size_t WS_CTL = 0, CTL_ZERO_BYTES = 2 * MiB;
constexpr size_t WS_MOD = 1 * MiB;
constexpr size_t WS_GIF = 3 * MiB;
constexpr size_t WS_WIN = 6 * MiB;
constexpr size_t WS_WA = 22 * MiB, WS_WM = 24 * MiB, WS_WOUT = 26 * MiB, WS_WQ = 28 * MiB;
constexpr size_t WS_U = 30 * MiB, WS_V = 62 * MiB;
constexpr size_t WS_SU = 2 * MiB, WS_SV = 2 * MiB + 65536, WS_SH = 2 * MiB + 131072, WS_CS = 2 * MiB + 393216;
constexpr size_t WS_H2Q = 352 * MiB, WS_SELE = 416 * MiB, WS_SELG = 432 * MiB;
constexpr size_t WS_H1 = 96 * MiB;
constexpr size_t WS_Z = 224 * MiB;
constexpr size_t WS_R = WS_Z, WS_X1 = WS_Z + 256 * MiB, WS_H2 = WS_Z + 512 * MiB, WS_QP = WS_Z + 640 * MiB;
constexpr size_t WS_PART = WS_X1, WS_COEF = WS_H2, WS_YF = WS_QP;
constexpr size_t WS_PART_UNUSED = 0, WS_COEF_UNUSED = 0;
constexpr size_t WS_END = 992 * MiB;
constexpr int CW_BAR = 4096;
constexpr int CW_QUEUE = 16384;

DI unsigned pk2(float lo, float hi) { f32x2 v = {lo, hi}; bf16x2_t b = __builtin_convertvector(v, bf16x2_t); return __builtin_bit_cast(unsigned, b); }
DI float bf_lo(unsigned u) { return __uint_as_float(u << 16); }
DI float bf_hi(unsigned u) { return __uint_as_float(u & 0xffff0000u); }
DI float bf2f(bf16_t h) { return __uint_as_float(((unsigned)h) << 16); }
template <int CTRL> DI float dppf(float v) { return __builtin_bit_cast(float, __builtin_amdgcn_update_dpp(0, __builtin_bit_cast(int, v), CTRL, 0xF, 0xF, true)); }
DI float row_sum16(float v) { v += dppf<0xB1>(v); v += dppf<0x4E>(v); v += dppf<0x141>(v); v += dppf<0x140>(v); return v; }
DI float row_max16(float v) { v = fmaxf(v, dppf<0xB1>(v)); v = fmaxf(v, dppf<0x4E>(v)); v = fmaxf(v, dppf<0x141>(v)); v = fmaxf(v, dppf<0x140>(v)); return v; }
template <int CTRL> DI int dppi(int v) { return __builtin_amdgcn_update_dpp(0, v, CTRL, 0xF, 0xF, true); }
DI float sum32x(float v) { auto rr = __builtin_amdgcn_permlane32_swap(__builtin_bit_cast(unsigned, v), __builtin_bit_cast(unsigned, v), false, false); return __builtin_bit_cast(float, (unsigned)rr[0]) + __builtin_bit_cast(float, (unsigned)rr[1]); }
DI float max32x(float v) { auto rr = __builtin_amdgcn_permlane32_swap(__builtin_bit_cast(unsigned, v), __builtin_bit_cast(unsigned, v), false, false); return fmaxf(__builtin_bit_cast(float, (unsigned)rr[0]), __builtin_bit_cast(float, (unsigned)rr[1])); }
DI int isum32x(int v) { auto rr = __builtin_amdgcn_permlane32_swap((unsigned)v, (unsigned)v, false, false); return (int)rr[0] + (int)rr[1]; }
DI unsigned partner32(unsigned v, int hi) { auto rr = __builtin_amdgcn_permlane32_swap(v, v, false, false); return hi ? (unsigned)rr[0] : (unsigned)rr[1]; }
DI float rdlane(float v, int l) { return __builtin_bit_cast(float, __builtin_amdgcn_readlane(__builtin_bit_cast(int, v), l)); }
DI float wave_sum(float v) { v = row_sum16(v); return (rdlane(v, 0) + rdlane(v, 16)) + (rdlane(v, 32) + rdlane(v, 48)); }
DI float wave_max(float v) { v = row_max16(v); return fmaxf(fmaxf(rdlane(v, 0), rdlane(v, 16)), fmaxf(rdlane(v, 32), rdlane(v, 48))); }
DI float half_sum32(float v) { v = row_sum16(v); return v + __builtin_bit_cast(float, __builtin_amdgcn_ds_swizzle(__builtin_bit_cast(int, v), 0x401F)); }
DI float sigmoidf_(float x) { return __builtin_amdgcn_rcpf(1.0f + __builtin_amdgcn_exp2f(x * -1.4426950408889634f)); }
DI float siluf_(float x) { return x * __builtin_amdgcn_rcpf(1.0f + __builtin_amdgcn_exp2f(x * -1.4426950408889634f)); }
DI int crow(int r, int hi) { return (r & 3) + 8 * (r >> 2) + 4 * hi; }
#define MFMA32(a, b, c) __builtin_amdgcn_mfma_f32_32x32x16_bf16((a), (b), (c), 0, 0, 0)
DI bf16x8 pack_step(const f32x16& x, int s) {
    u32x4 p;
    p[0] = pk2(x[8 * s + 0], x[8 * s + 1]); p[1] = pk2(x[8 * s + 2], x[8 * s + 3]); p[2] = pk2(x[8 * s + 4], x[8 * s + 5]); p[3] = pk2(x[8 * s + 6], x[8 * s + 7]);
    return __builtin_bit_cast(bf16x8, p);
}
DI unsigned off_b(unsigned row, unsigned ch) { return 256u * row + 16u * (ch ^ (((row & 3) << 2) | ((row >> 2) & 3))); }
DI unsigned row_read_addr(unsigned lane, unsigned rt, unsigned s) { return off_b(32 * rt + (lane & 31), 2 * s + (lane >> 5)); }
DI unsigned tr_read_addr(unsigned lane, unsigned c, unsigned ks, unsigned t) {
    const unsigned h = lane >> 5, blk = (lane >> 4) & 1, q = (lane & 15) >> 2, p = lane & 3;
    return off_b(16 * ks + 8 * h + 4 * t + q, 4 * c + 2 * blk + (p >> 1)) + 8 * (p & 1);
}
DI unsigned tr_base(unsigned lane, unsigned t) { const unsigned h = lane >> 5, blk = (lane >> 4) & 1, q = (lane & 15) >> 2, p = lane & 3, cl = 2 * blk + (p >> 1);
    return 256u * (8 * h + 4 * t + q) + 16u * (cl ^ (2 * h + t)) + 8u * (p & 1); }
#define OPAQUE(x) asm volatile("" : "+v"(x))
#define OPAQUE(x) asm volatile("" : "+v"(x))
typedef short v4i16_t __attribute__((ext_vector_type(4)));
DI s16x4 tr_read(const LAS unsigned char* p) { return __builtin_bit_cast(s16x4, __builtin_amdgcn_ds_read_tr16_b64_v4i16((LAS v4i16_t*)p)); }
DI bf16x8 cat8(s16x4 lo, s16x4 hi) { return __builtin_shufflevector(lo, hi, 0, 1, 2, 3, 4, 5, 6, 7); }
namespace pg8 {
#define PG8_LAS __attribute__((address_space(3)))
typedef unsigned short bf16_t;
typedef short bf16x8 __attribute__((ext_vector_type(8)));
typedef float f32x4 __attribute__((ext_vector_type(4)));
typedef unsigned u32x4 __attribute__((ext_vector_type(4)));
constexpr int BM = 256, BK = 64, HALF = 128, HTB = HALF * BK * 2  , STAGE_BYTES = 8 * HTB, NXCD = 8, WGM = 8;

__host__ __device__ __forceinline__ int lds_byte(int r, int c) { const int st = (r >> 4) * 2 + (c >> 5), rr = r & 15, cc = c & 31, ob = rr * 64 + cc * 2; return st * 1024 + (ob ^ (((ob >> 9) & 1) << 5)); }
__host__ __device__ __forceinline__ void stage_rc(int b, int& R, int& C) { const int st = b / 1024, sb = b % 1024, swz = sb ^ (((sb >> 9) & 1) << 5); R = (st >> 1) * 16 + swz / 64; C = (st & 1) * 32 + (swz % 64) / 2; }
__host__ __device__ __forceinline__ int perm32(int rho) { const int n = rho >> 4, i = rho & 15; return 8 * (i >> 2) + 4 * n + (i & 3); }

struct Unit { int pm, pn, ph; };
struct Gemm { const bf16_t* A; const bf16_t* Bt; int M, N, K, lda, ldb; long jA, jB; };

struct StaticOrder {
    int nM, nN, nwg, G, c;
    __host__ __device__ void init(int M, int N, int G_, int c_) { nM = M / BM; nN = N / BM; nwg = nM * nN; G = G_; c = c_; }
    __host__ __device__ bool next(int i, Unit& u) const {
        const long L = (long)i * G + c; if (L >= nwg) return false;
        int wgid = (int)L; { const int q = nwg / NXCD, r = nwg % NXCD, xcd = wgid % NXCD, off = wgid / NXCD; wgid = (xcd < r ? xcd * (q + 1) : r * (q + 1) + (xcd - r) * q) + off; }
        const int nig = WGM * nN, gid = wgid / nig, fm = gid * WGM, gsz = (nM - fm) < WGM ? (nM - fm) : WGM;
        u.pm = fm + ((wgid % nig) % gsz); u.pn = (wgid % nig) / gsz; u.ph = 0; return true;
    }
    __device__ __forceinline__ void a_ready(const Unit&) const {}
    __device__ __forceinline__ void done(const Unit&) const {}
};
struct RowsOrder {
    int nM, nN, G, c;
    __host__ __device__ void init(int M, int N, int G_, int c_) { nM = M / BM; nN = N / BM; G = G_; c = c_; }
    __host__ __device__ bool next(int i, Unit& u) const { const int pm = c + (i / nN) * G; if (pm >= nM) return false; u.pm = pm; u.pn = i % nN; u.ph = 0; return true; }
    __device__ __forceinline__ void a_ready(const Unit&) const {}
    __device__ __forceinline__ void done(const Unit&) const {}
};
struct RowsOrder2 {
    RowsOrder base;
    __host__ __device__ void init(int M, int N, int G_, int c_) { base.init(M, N, G_, c_); }
    __host__ __device__ bool next(int i, Unit& u) const { if (!base.next(i >> 1, u)) return false; u.ph = i & 1; return true; }
    __device__ __forceinline__ void a_ready(const Unit&) const {}
    __device__ __forceinline__ void done(const Unit&) const {}
};
struct StaticOrder2 {
    StaticOrder base;
    __host__ __device__ void init(int M, int N, int G_, int c_) { base.init(M, N, G_, c_); }
    __host__ __device__ bool next(int i, Unit& u) const { if (!base.next(i >> 1, u)) return false; u.ph = i & 1; return true; }
    __device__ __forceinline__ void a_ready(const Unit&) const {}
    __device__ __forceinline__ void done(const Unit&) const {}
};
template <class Epi, class Sched, bool ALIGN_EPI = false, bool SP2 = false>
__device__ __forceinline__ void gemm_phase(PG8_LAS unsigned char* lds, const Gemm g, const Sched& S, const Epi& E) {
    const int tid = threadIdx.x, wid = __builtin_amdgcn_readfirstlane(tid >> 6), lane = tid & 63, wr = wid >> 2, wc = wid & 3, fr = lane & 15, fq = lane >> 4;
    const int K = g.K, nt = K / BK;
    unsigned voffA[2], voffB[2];
#pragma unroll
    for (int i = 0; i < 2; ++i) { int R, C; stage_rc(tid * 16 + i * 8192, R, C); const int Rb = Epi::PERM ? ((R & ~31) + perm32(R & 31)) : R;
        voffA[i] = (unsigned)(R * g.lda + C) * 2u; voffB[i] = (unsigned)(Rb * g.ldb + C) * 2u; }
    const size_t kstep = (size_t)(BK * 2);
    const size_t hstepA = (size_t)HALF * g.lda * 2, hstepB = (size_t)HALF * g.ldb * 2;
    const size_t tstepA = 2 * hstepA, tstepB = 2 * hstepB;
    const unsigned ldsw = (unsigned)wid * 1024u;
    const int aoff = lds_byte(wr * 64 + fr, fq * 8), boff = lds_byte(wc * 32 + fr, fq * 8);
#define PG8_SA(b, h) (((b) * 2 + (h)) * HTB)
#define PG8_SB(b, h) ((4 + (b) * 2 + (h)) * HTB)
#define PG8_STAGE(bufoff, gbase, voff) do { _Pragma("unroll") for (int _i = 0; _i < 2; ++_i) \
        __builtin_amdgcn_global_load_lds((const unsigned*)((const char*)(gbase) + (voff)[_i]), (PG8_LAS unsigned*)(lds + (bufoff) + ldsw + _i * 8192), 16, 0, 0); } while (0)
#define PG8_LDA(dst, b, h) do { _Pragma("unroll") for (int m = 0; m < 4; ++m) _Pragma("unroll") for (int k = 0; k < 2; ++k) dst[m][k] = *(const PG8_LAS bf16x8*)(lds + PG8_SA(b, h) + aoff + m * 2048 + k * 1024); } while (0)
#define PG8_LDB(dst, b, h) do { _Pragma("unroll") for (int n = 0; n < 2; ++n) _Pragma("unroll") for (int k = 0; k < 2; ++k) dst[n][k] = *(const PG8_LAS bf16x8*)(lds + PG8_SB(b, h) + boff + n * 2048 + k * 1024); } while (0)
#define PG8_MMA(ai, bj, At, Bt) do { __builtin_amdgcn_s_setprio(1); _Pragma("unroll") for (int m = 0; m < 4; ++m) _Pragma("unroll") for (int n = 0; n < 2; ++n) _Pragma("unroll") for (int k = 0; k < 2; ++k) \
        acc[ai][bj][m][n] = __builtin_amdgcn_mfma_f32_16x16x32_bf16(Bt[n][k], At[m][k], acc[ai][bj][m][n], 0, 0, 0); __builtin_amdgcn_s_setprio(0); } while (0)
#define PG8_WAIT_V(n) asm volatile("s_waitcnt vmcnt(" #n ")" ::: "memory")
#define PG8_WAIT_L(n) asm volatile("s_waitcnt lgkmcnt(" #n ")" ::: "memory")
#define PG8_BAR __builtin_amdgcn_s_barrier()
#define PG8_SCHED __builtin_amdgcn_sched_barrier(0)
    Unit cur, nxt; int ui = 0;
    if (!S.next(0, cur)) return;
    f32x4 acc[2][2][4][2];
#pragma unroll
    for (int a = 0; a < 2; ++a)
#pragma unroll
        for (int b = 0; b < 2; ++b)
#pragma unroll
            for (int m = 0; m < 4; ++m)
#pragma unroll
                for (int n = 0; n < 2; ++n) acc[a][b][m][n] = (f32x4){0.f, 0.f, 0.f, 0.f};
    bf16x8 At[4][2], B0[2][2], B1[2][2];
    const char* cA = (const char*)g.A + (size_t)cur.pm * tstepA + cur.ph * g.jA; const char* cB = (const char*)g.Bt + (size_t)cur.pn * tstepB + cur.ph * g.jB;
    S.a_ready(cur);
    if constexpr (SP2) {
        PG8_STAGE(PG8_SB(0, 0), cB, voffB); PG8_STAGE(PG8_SB(0, 1), cB + hstepB, voffB); PG8_STAGE(PG8_SA(0, 0), cA, voffA); PG8_STAGE(PG8_SA(0, 1), cA + hstepA, voffA);
        if (wr == 1) PG8_BAR;
        PG8_WAIT_V(2); PG8_BAR;
        PG8_STAGE(PG8_SB(1, 0), cB + kstep, voffB); PG8_STAGE(PG8_SA(1, 0), cA + kstep, voffA); PG8_STAGE(PG8_SB(1, 1), cB + hstepB + kstep, voffB);
        PG8_WAIT_V(6); PG8_BAR;
    } else {
        PG8_STAGE(PG8_SB(0, 0), cB, voffB); PG8_STAGE(PG8_SA(0, 0), cA, voffA); PG8_STAGE(PG8_SB(0, 1), cB + hstepB, voffB); PG8_STAGE(PG8_SA(0, 1), cA + hstepA, voffA);
        if (wr == 1) PG8_BAR;
        PG8_WAIT_V(4); PG8_BAR;
        PG8_STAGE(PG8_SB(1, 0), cB + kstep, voffB); PG8_STAGE(PG8_SA(1, 0), cA + kstep, voffA); PG8_STAGE(PG8_SB(1, 1), cB + hstepB + kstep, voffB);
        PG8_WAIT_V(6); PG8_BAR;
    }
    for (;;) {
        const bool has_next = S.next(ui + 1, nxt);
        const char* nA = has_next ? (const char*)g.A + (size_t)nxt.pm * tstepA + nxt.ph * g.jA : cA; const char* nB = has_next ? (const char*)g.Bt + (size_t)nxt.pn * tstepB + nxt.ph * g.jB : cB;
        for (int t = 0; t < nt; t += 2) {
            const bool last = (t == nt - 2);
            const char* a1 = cA + (size_t)(t + 1) * kstep;
            const char* a2 = last ? nA : cA + (size_t)(t + 2) * kstep; const char* b2 = last ? nB : cB + (size_t)(t + 2) * kstep;
            const char* a3 = a2 + kstep; const char* b3 = b2 + kstep;
            if (last && has_next) S.a_ready(nxt);
            if constexpr (SP2) {
            PG8_LDB(B0, 0, 0); PG8_LDB(B1, 0, 1); PG8_SCHED; PG8_LDA(At, 0, 0); PG8_STAGE(PG8_SA(1, 1), a1 + hstepA, voffA);
            PG8_WAIT_V(8); PG8_WAIT_L(0); PG8_BAR; PG8_MMA(0, 0, At, B0); PG8_MMA(0, 1, At, B1); PG8_BAR; PG8_SCHED;
            PG8_LDA(At, 0, 1); PG8_STAGE(PG8_SB(0, 0), b2, voffB); PG8_STAGE(PG8_SB(0, 1), b2 + hstepB, voffB); PG8_STAGE(PG8_SA(0, 0), a2, voffA);
            PG8_WAIT_V(8); PG8_WAIT_L(0); PG8_BAR; PG8_MMA(1, 0, At, B0); PG8_MMA(1, 1, At, B1); PG8_BAR; PG8_SCHED;
            PG8_LDB(B0, 1, 0); PG8_LDB(B1, 1, 1); PG8_SCHED; PG8_LDA(At, 1, 0); PG8_STAGE(PG8_SA(0, 1), a2 + hstepA, voffA);
            PG8_WAIT_V(8); PG8_WAIT_L(0); PG8_BAR; PG8_MMA(0, 0, At, B0); PG8_MMA(0, 1, At, B1); PG8_BAR; PG8_SCHED;
            PG8_LDA(At, 1, 1); PG8_STAGE(PG8_SB(1, 0), b3, voffB); PG8_STAGE(PG8_SB(1, 1), b3 + hstepB, voffB); PG8_STAGE(PG8_SA(1, 0), a3, voffA);
            PG8_WAIT_V(8); PG8_WAIT_L(0); PG8_BAR; PG8_MMA(1, 0, At, B0); PG8_MMA(1, 1, At, B1); PG8_BAR; PG8_SCHED;
            } else {
            PG8_LDB(B0, 0, 0); PG8_SCHED; PG8_LDA(At, 0, 0); PG8_STAGE(PG8_SA(1, 1), a1 + hstepA, voffA);
            PG8_WAIT_L(8); PG8_BAR; PG8_WAIT_L(0); PG8_MMA(0, 0, At, B0); PG8_BAR; PG8_SCHED;
            PG8_LDB(B1, 0, 1); PG8_STAGE(PG8_SB(0, 0), b2, voffB);
            PG8_BAR; PG8_WAIT_L(0); PG8_MMA(0, 1, At, B1); PG8_BAR;
            PG8_LDA(At, 0, 1); PG8_STAGE(PG8_SA(0, 0), a2, voffA);
            PG8_BAR; PG8_WAIT_L(0); PG8_MMA(1, 0, At, B0); PG8_BAR; PG8_SCHED;
            PG8_STAGE(PG8_SB(0, 1), b2 + hstepB, voffB);
            PG8_WAIT_V(6); PG8_BAR; PG8_MMA(1, 1, At, B1); PG8_BAR;
            PG8_LDB(B0, 1, 0); PG8_SCHED; PG8_LDA(At, 1, 0); PG8_STAGE(PG8_SA(0, 1), a2 + hstepA, voffA);
            PG8_WAIT_L(8); PG8_BAR; PG8_WAIT_L(0); PG8_MMA(0, 0, At, B0); PG8_BAR; PG8_SCHED;
            PG8_LDB(B1, 1, 1); PG8_STAGE(PG8_SB(1, 0), b3, voffB);
            PG8_BAR; PG8_WAIT_L(0); PG8_MMA(0, 1, At, B1); PG8_BAR;
            PG8_LDA(At, 1, 1); PG8_STAGE(PG8_SA(1, 0), a3, voffA);
            PG8_BAR; PG8_WAIT_L(0); PG8_MMA(1, 0, At, B0); PG8_BAR; PG8_SCHED;
            PG8_STAGE(PG8_SB(1, 1), b3 + hstepB, voffB);
            PG8_WAIT_V(6); PG8_BAR; PG8_MMA(1, 1, At, B1); PG8_BAR;
            }
        }
        if constexpr (ALIGN_EPI) { if (wr == 0) PG8_BAR; }
        bool keep_acc = false;
        if constexpr (Epi::HAS_MID) { keep_acc = (cur.ph == 0) && has_next; }
        if constexpr (!Epi::AFTER_DRAIN) { if constexpr (Epi::HAS_MID) { if (keep_acc) E.mid(acc, cur, wr, wc, fr, fq); else E(acc, cur, wr, wc, fr, fq); } else E(acc, cur, wr, wc, fr, fq); S.done(cur); }
        if (!has_next) break;
        if (!keep_acc)
#pragma unroll
        for (int a = 0; a < 2; ++a)
#pragma unroll
            for (int b = 0; b < 2; ++b)
#pragma unroll
                for (int m = 0; m < 4; ++m)
#pragma unroll
                    for (int n = 0; n < 2; ++n) acc[a][b][m][n] = (f32x4){0.f, 0.f, 0.f, 0.f};
        cur = nxt; cA = nA; cB = nB; ++ui;
        if constexpr (ALIGN_EPI) { if (wr == 1) PG8_BAR; }
    }
    PG8_WAIT_V(0);
    if constexpr (!ALIGN_EPI) { if (wr == 0) PG8_BAR; }
    PG8_BAR;
    if constexpr (Epi::AFTER_DRAIN) { E.fused(acc, cur, wr, wc, fr, fq, lds, wid, lane); S.done(cur); }
#undef PG8_SA
#undef PG8_SB
#undef PG8_STAGE
#undef PG8_LDA
#undef PG8_LDB
#undef PG8_MMA
#undef PG8_WAIT_V
#undef PG8_WAIT_L
#undef PG8_BAR
#undef PG8_SCHED
}
}
namespace pg8 {
struct EpiZ {
    static constexpr bool PERM = true, AFTER_DRAIN = false, HAS_MID = false;
    bf16_t* Z; bf16_t* G;
    __device__ __forceinline__ void operator()(const f32x4 (&acc)[2][2][4][2], const Unit& u, int wr, int wc, int fr, int fq) const {
        const int row0 = u.pm * BM + wr * 64 + fr, colt = u.pn * BM; const bool gate = colt >= NZ, sig_o = colt >= ZC_MO && colt < ZC_MO + 1024;
        bf16_t* base = gate ? G : Z; const int ld = gate ? NGATE : NZ; const int col0 = (gate ? colt - NZ : colt) + wc * 32 + 8 * fq;
#pragma unroll
        for (int ai = 0; ai < 2; ++ai)
#pragma unroll
            for (int m = 0; m < 4; ++m) { bf16_t* rowp = base + (size_t)(row0 + ai * HALF + m * 16) * ld + col0;
#pragma unroll
                for (int bj = 0; bj < 2; ++bj) { f32x4 v0 = acc[ai][bj][m][0], v1 = acc[ai][bj][m][1];
                    if (gate || sig_o) {
#pragma unroll
                        for (int e = 0; e < 4; ++e) { v0[e] = sigmoidf_(v0[e]); v1[e] = sigmoidf_(v1[e]); } }
                    ::u32x4 w; w.x = pk2(v0[0], v0[1]); w.y = pk2(v0[2], v0[3]); w.z = pk2(v1[0], v1[1]); w.w = pk2(v1[2], v1[3]);
                    *(::u32x4*)(rowp + bj * HALF) = w; } }
    }
};
template <bool FIRST> struct EpiGate {
    static constexpr bool PERM = true, AFTER_DRAIN = false, HAS_MID = false;
    const bf16_t* G; bf16_t* Y;
    __device__ __forceinline__ void operator()(const f32x4 (&acc)[2][2][4][2], const Unit& u, int wr, int wc, int fr, int fq) const {
        const int row0 = u.pm * BM + wr * 64 + fr, col0 = u.pn * BM + wc * 32 + 8 * fq;
#pragma unroll
        for (int ai = 0; ai < 2; ++ai)
#pragma unroll
            for (int m = 0; m < 4; ++m) { const size_t row = (size_t)(row0 + ai * HALF + m * 16);
#pragma unroll
                for (int bj = 0; bj < 2; ++bj) { const f32x4 v0 = acc[ai][bj][m][0], v1 = acc[ai][bj][m][1];
                    const ::u32x4 g = *(const ::u32x4*)(G + row * NGATE + col0 + bj * HALF);
                    float o[8] = { bf_lo(g.x) * v0[0], bf_hi(g.x) * v0[1], bf_lo(g.y) * v0[2], bf_hi(g.y) * v0[3], bf_lo(g.z) * v1[0], bf_hi(g.z) * v1[1], bf_lo(g.w) * v1[2], bf_hi(g.w) * v1[3] };
                    bf16_t* yp = Y + row * DM + col0 + bj * HALF;
                    if (!FIRST) { const ::u32x4 y = *(const ::u32x4*)yp;
                        o[0] += bf_lo(y.x); o[1] += bf_hi(y.x); o[2] += bf_lo(y.y); o[3] += bf_hi(y.y); o[4] += bf_lo(y.z); o[5] += bf_hi(y.z); o[6] += bf_lo(y.w); o[7] += bf_hi(y.w); }
                    ::u32x4 w; w.x = pk2(o[0], o[1]); w.y = pk2(o[2], o[3]); w.z = pk2(o[4], o[5]); w.w = pk2(o[6], o[7]);
                    *(::u32x4*)yp = w; } }
    }
};
struct EpiR {
    static constexpr bool PERM = true, AFTER_DRAIN = false, HAS_MID = false;
    const float* X; const float* MOD; bf16_t* R;
    __device__ __forceinline__ void operator()(const f32x4 (&acc)[2][2][4][2], const Unit& u, int wr, int wc, int fr, int fq) const {
        const int row0 = u.pm * BM + wr * 64 + fr, col0 = u.pn * BM + wc * 32 + 8 * fq;
        const float* gt = MOD + (size_t)((u.pm * BM) / SEQ) * MODW + 2 * DM;
        f32x4 g[2][2];
#pragma unroll
        for (int bj = 0; bj < 2; ++bj) { g[bj][0] = *(const f32x4*)(gt + col0 + bj * HALF); g[bj][1] = *(const f32x4*)(gt + col0 + bj * HALF + 4); }
#pragma unroll
        for (int ai = 0; ai < 2; ++ai) {
            f32x4 xv[4][2][2];
#pragma unroll
            for (int m = 0; m < 4; ++m) { const size_t off = (size_t)(row0 + ai * HALF + m * 16) * DM + col0;
#pragma unroll
                for (int bj = 0; bj < 2; ++bj) { xv[m][bj][0] = *(const f32x4*)(X + off + bj * HALF); xv[m][bj][1] = *(const f32x4*)(X + off + bj * HALF + 4); } }
            __builtin_amdgcn_sched_barrier(0);
#pragma unroll
            for (int m = 0; m < 4; ++m) { const size_t off = (size_t)(row0 + ai * HALF + m * 16) * DM + col0;
#pragma unroll
                for (int bj = 0; bj < 2; ++bj) {
                    const f32x4 r0 = xv[m][bj][0] * ALPHA_RES + g[bj][0] * acc[ai][bj][m][0], r1 = xv[m][bj][1] * ALPHA_RES + g[bj][1] * acc[ai][bj][m][1];
                    ::u32x4 w; w.x = pk2(r0[0], r0[1]); w.y = pk2(r0[2], r0[3]); w.z = pk2(r1[0], r1[1]); w.w = pk2(r1[2], r1[3]);
                    *(::u32x4*)(R + off + bj * HALF) = w; } }
            __builtin_amdgcn_sched_barrier(0);
        }
    }
};
struct EpiStore {
    static constexpr bool PERM = true, AFTER_DRAIN = false, HAS_MID = false;
    bf16_t* O;
    __device__ __forceinline__ void operator()(const f32x4 (&acc)[2][2][4][2], const Unit& u, int wr, int wc, int fr, int fq) const {
        const int row0 = u.pm * BM + wr * 64 + fr, col0 = u.pn * BM + wc * 32 + 8 * fq;
#pragma unroll
        for (int ai = 0; ai < 2; ++ai)
#pragma unroll
            for (int m = 0; m < 4; ++m) { bf16_t* rowp = O + (size_t)(row0 + ai * HALF + m * 16) * DM + col0;
#pragma unroll
                for (int bj = 0; bj < 2; ++bj) { const f32x4 v0 = acc[ai][bj][m][0], v1 = acc[ai][bj][m][1];
                    ::u32x4 w; w.x = pk2(v0[0], v0[1]); w.y = pk2(v0[2], v0[3]); w.z = pk2(v1[0], v1[1]); w.w = pk2(v1[2], v1[3]);
                    *(::u32x4*)(rowp + bj * HALF) = w; } }
    }
};
struct EpiGate2 {
    static constexpr bool PERM = true, AFTER_DRAIN = false, HAS_MID = true;
    const bf16_t* G; bf16_t* Y;
    __device__ __forceinline__ void mid(f32x4 (&acc)[2][2][4][2], const Unit& u, int wr, int wc, int fr, int fq) const {
        const int row0 = u.pm * BM + wr * 64 + fr, col0 = u.pn * BM + wc * 32 + 8 * fq;
#pragma unroll
        for (int ai = 0; ai < 2; ++ai)
#pragma unroll
            for (int m = 0; m < 4; ++m) { const size_t row = (size_t)(row0 + ai * HALF + m * 16);
#pragma unroll
                for (int bj = 0; bj < 2; ++bj) {
                    const ::u32x4 ga = *(const ::u32x4*)(G + row * NGATE + col0 + bj * HALF), gm = *(const ::u32x4*)(G + row * NGATE + DM + col0 + bj * HALF);
                    f32x4& v0 = acc[ai][bj][m][0]; f32x4& v1 = acc[ai][bj][m][1];
#define PG8_RAT(a, b) ((a) * __builtin_amdgcn_rcpf(b))
                    v0[0] *= PG8_RAT(bf_lo(ga.x), bf_lo(gm.x)); v0[1] *= PG8_RAT(bf_hi(ga.x), bf_hi(gm.x)); v0[2] *= PG8_RAT(bf_lo(ga.y), bf_lo(gm.y)); v0[3] *= PG8_RAT(bf_hi(ga.y), bf_hi(gm.y));
                    v1[0] *= PG8_RAT(bf_lo(ga.z), bf_lo(gm.z)); v1[1] *= PG8_RAT(bf_hi(ga.z), bf_hi(gm.z)); v1[2] *= PG8_RAT(bf_lo(ga.w), bf_lo(gm.w)); v1[3] *= PG8_RAT(bf_hi(ga.w), bf_hi(gm.w)); }
#undef PG8_RAT
                if (m == 3) __builtin_amdgcn_sched_barrier(0); }
    }
    __device__ __forceinline__ void operator()(const f32x4 (&acc)[2][2][4][2], const Unit& u, int wr, int wc, int fr, int fq) const {
        const int row0 = u.pm * BM + wr * 64 + fr, col0 = u.pn * BM + wc * 32 + 8 * fq;
        ::u32x4 gg[2][4][2];
#pragma unroll
        for (int ai = 0; ai < 2; ++ai)
#pragma unroll
            for (int m = 0; m < 4; ++m) { const size_t row = (size_t)(row0 + ai * HALF + m * 16);
#pragma unroll
                for (int bj = 0; bj < 2; ++bj) gg[ai][m][bj] = *(const ::u32x4*)(G + row * NGATE + DM + col0 + bj * HALF); }
        __builtin_amdgcn_sched_barrier(0);
#pragma unroll
        for (int ai = 0; ai < 2; ++ai)
#pragma unroll
            for (int m = 0; m < 4; ++m) { const size_t row = (size_t)(row0 + ai * HALF + m * 16);
#pragma unroll
                for (int bj = 0; bj < 2; ++bj) { const f32x4 v0 = acc[ai][bj][m][0], v1 = acc[ai][bj][m][1]; const ::u32x4 g = gg[ai][m][bj];
                    ::u32x4 w; w.x = pk2(bf_lo(g.x) * v0[0], bf_hi(g.x) * v0[1]); w.y = pk2(bf_lo(g.y) * v0[2], bf_hi(g.y) * v0[3]); w.z = pk2(bf_lo(g.z) * v1[0], bf_hi(g.z) * v1[1]); w.w = pk2(bf_lo(g.w) * v1[2], bf_hi(g.w) * v1[3]);
                    *(::u32x4*)(Y + row * DM + col0 + bj * HALF) = w; } }
    }
};
}
namespace datt {
DI float attn_lambda(const float* lam) { const int lane = threadIdx.x & 63; const float p1 = lam[lane] * lam[64 + lane], p2 = lam[128 + lane] * lam[192 + lane]; return __expf(wave_sum(p1)) - __expf(wave_sum(p2)) + LAMBDA_INIT; }
constexpr int KROW = 144;
constexpr int KBUF = 64 * KROW, VBUF = 64 * 256, LDS_K = 0, LDS_V = 2 * KBUF, LDS_ST = LDS_V + 2 * VBUF, STROW = 272, ST_WAVE = 32 * STROW, LDS_BYTES = LDS_ST + 8 * ST_WAVE;
DI unsigned vrow(unsigned key) { return (key & ~12u) | ((key & 4u) << 1) | ((key & 8u) >> 1); }

template <bool DRY> DI void attn_unit(LAS unsigned char* lds, bf16_t* Z, const float lam_val, const float* subln_g, int b, int h, int qb) {
    int tid_o = threadIdx.x; OPAQUE(tid_o); const int tid = tid_o, lane = tid & 63, r32 = lane & 31, hi = lane >> 5; const int wid = __builtin_amdgcn_readfirstlane(tid >> 6);
    const size_t rowbase = (size_t)b * SEQ;
    const int q_first = qb * 256 + wid * 32, q_me = q_first + r32;
    const int NT = 4 * (qb + 1);
    const int k_key = tid >> 3, k_ch = tid & 7;
    const int v_key0 = tid >> 4, v_ch = tid & 15;
    const unsigned tb0 = LDS_V + tr_base(lane, 0), tb1 = LDS_V + tr_base(lane, 1); unsigned q64 = ((lane & 15) >> 2) << 6;
    const unsigned kb = LDS_K + r32 * KROW + hi * 16;
    u32x4 pk_, pv0, pv1;
#pragma unroll
    for (int m = 0; m < 2; ++m) {
        bf16x8 qf[4];
        { const bf16_t* qp = Z + (rowbase + q_me) * NZ + ZC_Q + h * 128 + m * 64 + 8 * hi;
#pragma unroll
          for (int s = 0; s < 4; ++s) qf[s] = *(const bf16x8*)(qp + 16 * s); }
        const bf16_t* ksrc = Z + (rowbase + k_key) * NZ + ZC_K + h * 128 + m * 64 + k_ch * 8;
        const bf16_t* vsrc = Z + (rowbase + v_key0) * NZ + ZC_V + h * 128 + v_ch * 8;
        f32x16 O[4];
#pragma unroll
        for (int c = 0; c < 4; ++c)
#pragma unroll
            for (int r = 0; r < 16; ++r) O[c][r] = 0.f;
        float mrun = -1e30f, lrun = 0.f;
        if (m == 0) { pk_ = *(const u32x4*)ksrc; pv0 = *(const u32x4*)vsrc; pv1 = *(const u32x4*)(vsrc + (size_t)32 * NZ); }
        __syncthreads();
        *(LAS u32x4*)(lds + LDS_K + k_key * KROW + k_ch * 16) = pk_;
        *(LAS u32x4*)(lds + LDS_V + off_b(vrow(v_key0), v_ch)) = pv0;
        *(LAS u32x4*)(lds + LDS_V + off_b(vrow(v_key0 + 32), v_ch)) = pv1;
        { const size_t o = (size_t)64 * NZ; pk_ = *(const u32x4*)(ksrc + o); pv0 = *(const u32x4*)(vsrc + o); pv1 = *(const u32x4*)(vsrc + o + (size_t)32 * NZ); }
        __syncthreads();
        for (int kt = 0; kt < NT; ++kt) {
            const int cur = kt & 1, nxt = cur ^ 1;
            if (kt * 64 <= q_first + 31) {
            f32x16 p[2];
            bf16x8 ka[8];
#pragma unroll
            for (int i = 0; i < 8; ++i) ka[i] = *(const LAS bf16x8*)(lds + kb + cur * KBUF + 32 * (i >> 2) * KROW + (i & 3) * 32);
            __builtin_amdgcn_sched_barrier(0);
#pragma unroll
            for (int hf = 0; hf < 2; ++hf) {
#pragma unroll
                for (int r = 0; r < 16; ++r) p[hf][r] = 0.f;
#pragma unroll
                for (int s = 0; s < 4; ++s) p[hf] = MFMA32(ka[4 * hf + s], qf[s], p[hf]);
            }
            OPAQUE(q64);
            const unsigned vb0 = tb0 + cur * VBUF, vb1 = tb1 + cur * VBUF;
            s16x4 vlo[2][4], vhi[2][4];
#pragma unroll
            for (int ks = 0; ks < 4; ++ks) { vlo[0][ks] = tr_read(lds + vb0 + q64 + 4096 * ks); vhi[0][ks] = tr_read(lds + vb1 + q64 + 4096 * ks); }
            __builtin_amdgcn_sched_barrier(0);
            if (kt * 64 + 63 > q_first) {
#pragma unroll
                for (int hf = 0; hf < 2; ++hf)
#pragma unroll
                    for (int r = 0; r < 16; ++r) { const int key = kt * 64 + 32 * hf + crow(r, hi); if (key > q_me) p[hf][r] = -1e30f; }
            }
            float mx = p[0][0];
#pragma unroll
            for (int r = 1; r < 16; ++r) mx = fmaxf(mx, p[0][r]);
#pragma unroll
            for (int r = 0; r < 16; ++r) mx = fmaxf(mx, p[1][r]);
            mx = max32x(mx);
            if (__builtin_amdgcn_ballot_w64(mx > mrun + 8.0f) != 0) {
                const float mnew = fmaxf(mrun, mx), alpha = __builtin_amdgcn_exp2f(mrun - mnew); mrun = mnew; lrun *= alpha;
#pragma unroll
                for (int c = 0; c < 4; ++c)
#pragma unroll
                    for (int r = 0; r < 16; ++r) O[c][r] *= alpha;
            }
            float ls = 0.f;
#pragma unroll
            for (int hf = 0; hf < 2; ++hf)
#pragma unroll
                for (int r = 0; r < 16; ++r) { const float e = __builtin_amdgcn_exp2f(p[hf][r] - mrun); p[hf][r] = e; ls += e; }
            lrun += ls;
            bf16x8 pf[4];
            pf[0] = pack_step(p[0], 0); pf[1] = pack_step(p[0], 1); pf[2] = pack_step(p[1], 0); pf[3] = pack_step(p[1], 1);
#pragma unroll
            for (int c = 0; c < 4; ++c) {
                if (c < 3) { const unsigned cx = (64u * (c + 1)) ^ q64;
#pragma unroll
                    for (int ks = 0; ks < 4; ++ks) { vlo[(c + 1) & 1][ks] = tr_read(lds + vb0 + cx + 4096 * ks); vhi[(c + 1) & 1][ks] = tr_read(lds + vb1 + cx + 4096 * ks); } }
                __builtin_amdgcn_sched_barrier(0);
#pragma unroll
                for (int ks = 0; ks < 4; ++ks) O[c] = MFMA32(cat8(vlo[c & 1][ks], vhi[c & 1][ks]), pf[ks], O[c]);
                __builtin_amdgcn_sched_barrier(0);
            }
            }
            if (kt + 1 < NT) {
                *(LAS u32x4*)(lds + LDS_K + nxt * KBUF + k_key * KROW + k_ch * 16) = pk_;
                *(LAS u32x4*)(lds + LDS_V + nxt * VBUF + off_b(vrow(v_key0), v_ch)) = pv0;
                *(LAS u32x4*)(lds + LDS_V + nxt * VBUF + off_b(vrow(v_key0 + 32), v_ch)) = pv1;
                if (kt + 2 < NT) { const size_t o = (size_t)(kt + 2) * 64 * NZ; pk_ = *(const u32x4*)(ksrc + o); pv0 = *(const u32x4*)(vsrc + o); pv1 = *(const u32x4*)(vsrc + o + (size_t)32 * NZ); }
                else if (m == 0) { pk_ = *(const u32x4*)(ksrc + 64); pv0 = *(const u32x4*)vsrc; pv1 = *(const u32x4*)(vsrc + (size_t)32 * NZ); }
            }
            __syncthreads();
        }
        const float ltot = sum32x(lrun), inv = 1.0f / ltot;
        if (m == 0) {
            LAS unsigned char* stg = lds + LDS_ST + wid * ST_WAVE;
#pragma unroll
            for (int c = 0; c < 4; ++c)
#pragma unroll
                for (int g4 = 0; g4 < 4; ++g4) { const int dv0 = 32 * c + 8 * g4 + 4 * hi;
                    u32x2 w; w.x = pk2(O[c][4 * g4] * inv, O[c][4 * g4 + 1] * inv); w.y = pk2(O[c][4 * g4 + 2] * inv, O[c][4 * g4 + 3] * inv);
                    *(LAS u32x2*)(stg + r32 * STROW + dv0 * 2) = w; }
        } else {
            const float li = lam_val * inv;
            float ss = 0.f;
            LAS unsigned char* stg = lds + LDS_ST + wid * ST_WAVE;
#pragma unroll
            for (int c = 0; c < 4; ++c)
#pragma unroll
                for (int g4 = 0; g4 < 4; ++g4) { const int dv0 = 32 * c + 8 * g4 + 4 * hi; const u32x2 k2 = *(const LAS u32x2*)(stg + r32 * STROW + dv0 * 2);
                    O[c][4 * g4] = bf_lo(k2.x) - li * O[c][4 * g4]; O[c][4 * g4 + 1] = bf_hi(k2.x) - li * O[c][4 * g4 + 1]; O[c][4 * g4 + 2] = bf_lo(k2.y) - li * O[c][4 * g4 + 2]; O[c][4 * g4 + 3] = bf_hi(k2.y) - li * O[c][4 * g4 + 3];
                    ss += (O[c][4 * g4] * O[c][4 * g4] + O[c][4 * g4 + 1] * O[c][4 * g4 + 1]) + (O[c][4 * g4 + 2] * O[c][4 * g4 + 2] + O[c][4 * g4 + 3] * O[c][4 * g4 + 3]); }
            ss = sum32x(ss);
            const float rstd = rsqrtf(ss * (1.0f / 128.0f) + LN_EPS) * (1.0f - LAMBDA_INIT);
#pragma unroll
            for (int c = 0; c < 4; ++c)
#pragma unroll
                for (int g4 = 0; g4 < 4; ++g4) { const int dv0 = 32 * c + 8 * g4 + 4 * hi; const f32x4 gg = *(const f32x4*)(subln_g + dv0);
                    u32x2 w; w.x = pk2(O[c][4 * g4] * rstd * gg[0], O[c][4 * g4 + 1] * rstd * gg[1]); w.y = pk2(O[c][4 * g4 + 2] * rstd * gg[2], O[c][4 * g4 + 3] * rstd * gg[3]);
                    *(LAS u32x2*)(stg + r32 * STROW + dv0 * 2) = w; }
        }
    }
    LAS unsigned char* stg = lds + LDS_ST + wid * ST_WAVE;
    asm volatile("s_waitcnt lgkmcnt(0)" ::: "memory");
    bf16_t* obase = Z + (rowbase + q_first) * NZ + ZC_Q + h * 128;
#pragma unroll
    for (int i = 0; i < 8; ++i) { const int idx = lane + 64 * i, row = idx >> 4, ch = idx & 15;
        const u32x4 v = *(const LAS u32x4*)(stg + row * STROW + ch * 16); if (!DRY || v.x == 0x12345678u) *(u32x4*)(obase + (size_t)row * NZ + ch * 8) = v; }
}
}
namespace mls {
constexpr int QI = 0, KI = 32768, VI = 65536, SC = 131072;
constexpr int F_IG = 0, F_LF = 128, F_A = 256, F_M = 384, F_INTER = 512, F_EMT = 640, F_W = 768, F_DEN = 896, F_N = 1024, F_MISC = 1152,
              F_NQ2P = 1280, F_NQ1P = 1792, F_NP = 2304, F_RSQ = 2816, F_END = 3840;
constexpr int LDS_BYTES = SC + F_END * 4;
static_assert(LDS_BYTES <= 147456, "mLSTM LDS");

template <int CTRL> DI float dpp_keep(float old, float v) { return __builtin_bit_cast(float, __builtin_amdgcn_update_dpp(__builtin_bit_cast(int, old), __builtin_bit_cast(int, v), CTRL, 0xF, 0xF, false)); }
DI float scan_add(float x, int lane) {
    x += dpp_keep<0x111>(0.f, x); x += dpp_keep<0x112>(0.f, x); x += dpp_keep<0x114>(0.f, x); x += dpp_keep<0x118>(0.f, x);
    const float t0 = rdlane(x, 15), t1 = rdlane(x, 31), t2 = rdlane(x, 47); const int r = lane >> 4;
    return x + ((r >= 1 ? t0 : 0.f) + (r >= 2 ? t1 : 0.f) + (r >= 3 ? t2 : 0.f));
}
DI float scan_max(float x, int lane) {
    const float ninf = -3.0e38f;
    x = fmaxf(x, dpp_keep<0x111>(ninf, x)); x = fmaxf(x, dpp_keep<0x112>(ninf, x)); x = fmaxf(x, dpp_keep<0x114>(ninf, x)); x = fmaxf(x, dpp_keep<0x118>(ninf, x));
    const float t0 = rdlane(x, 15), t1 = rdlane(x, 31), t2 = rdlane(x, 47); const int r = lane >> 4;
    return fmaxf(x, fmaxf(fmaxf(r >= 1 ? t0 : ninf, r >= 2 ? t1 : ninf), r >= 3 ? t2 : ninf));
}
DI float log_sigmoid(float x) { return fminf(x, 0.f) - __logf(1.0f + __expf(-fabsf(x))); }

template <bool DRY, int ABL = 0> DI void mlstm_unit(LAS unsigned char* lds, bf16_t* Z, const float* GIF, const float* conv_w, const float* conv_b, const float* norm_g, int b, int hd) {
    int tid_o = threadIdx.x; OPAQUE(tid_o); const int tid = tid_o, lane = tid & 63; const int wid = __builtin_amdgcn_readfirstlane(tid >> 6);
    LAS float* sc = (LAS float*)(lds + SC);
#define MLS_LV unsigned L_ = lane; OPAQUE(L_); const unsigned r32 = L_ & 31, hi = L_ >> 5, rowb = 256u * r32, f16 = (((r32 & 3) << 2) | ((r32 >> 2) & 3)) << 4, q64 = ((L_ & 15) >> 2) << 6; (void)rowb; (void)f16; (void)q64; (void)hi
    f32x16 CT[4];
#pragma unroll
    for (int i = 0; i < 4; ++i)
#pragma unroll
        for (int r = 0; r < 16; ++r) CT[i][r] = 0.f;
    float m_prev = 0.f;
    if (tid < 128) sc[F_N + tid] = 0.f;
    const int img = wid >> 2, vc = wid & 3;
    const int st_i = wid >> 1, st_j0 = 2 * (wid & 1);

    u32x4 rawn[11]; float gin = 0.f, gfn = 0.f;
#define MLS_PREFETCH(CC) do { int tp = tid; OPAQUE(tp); const int p_mat = tp >> 8, p_ch = tp & 15, p_rg = (tp >> 4) & 15; const size_t tn = (size_t)b * SEQ + (size_t)(CC) * 128; \
        const bf16_t* srcn = Z + (tn + p_rg * 8) * NZ + (p_mat ? ZC_MK : ZC_MQ) + hd * 128 + p_ch * 8; \
        _Pragma("unroll") for (int j = 0; j < 11; ++j) { const int lp = (CC) * 128 + p_rg * 8 - 3 + j; rawn[j] = (u32x4){0u, 0u, 0u, 0u}; if (lp >= 0) rawn[j] = *(const u32x4*)(srcn + (ptrdiff_t)(j - 3) * NZ); } \
        if (tp < 128) { const float* gg = GIF + (tn + tp) * 8; gin = gg[hd]; gfn = gg[4 + hd]; } } while (0)
    MLS_PREFETCH(0);
    for (int c = 0; c < 16; ++c) {
        const size_t t0 = (size_t)b * SEQ + (size_t)c * 128;
        u32x4 vn[8];
        {
            int tq = tid; OPAQUE(tq);
            const int c_mat = tq >> 8, c_ch = tq & 15, c_rg = (tq >> 4) & 15;
            const int chan0 = c_mat * 512 + hd * 128 + c_ch * 8;
            const float kscale = c_mat ? 0.08838834764831845f : 1.0f;
            float cw[4][8], cb[8];
            { const GAS float* cwp = (const GAS float*)(conv_w + chan0); const GAS float* cbp = (const GAS float*)(conv_b + chan0); asm volatile("" : "+v"(cwp), "+v"(cbp));
#pragma unroll
              for (int j = 0; j < 4; ++j) { const f32x4 a = *(const GAS f32x4*)(cwp + j * 1024), c4 = *(const GAS f32x4*)(cwp + j * 1024 + 4);
                cw[j][0] = a[0]; cw[j][1] = a[1]; cw[j][2] = a[2]; cw[j][3] = a[3]; cw[j][4] = c4[0]; cw[j][5] = c4[1]; cw[j][6] = c4[2]; cw[j][7] = c4[3]; }
              const f32x4 a = *(const GAS f32x4*)cbp, c4 = *(const GAS f32x4*)(cbp + 4); cb[0] = a[0]; cb[1] = a[1]; cb[2] = a[2]; cb[3] = a[3]; cb[4] = c4[0]; cb[5] = c4[1]; cb[6] = c4[2]; cb[7] = c4[3]; }
            __syncthreads();
            { int tv = tid; OPAQUE(tv);
#pragma unroll
              for (int i = 0; i < 8; ++i) { const int idx = tv + 512 * i, row = idx >> 5, ch32 = idx & 31; vn[i] = *(const u32x4*)(Z + (t0 + row) * NZ + ZC_MV + hd * 256 + ch32 * 8); } }
            u32x4 raw[11];
#pragma unroll
            for (int j = 0; j < 11; ++j) raw[j] = rawn[j];
#pragma unroll
            for (int i = 0; i < 8; ++i) {
                float o[8];
#pragma unroll
                for (int e = 0; e < 8; ++e) { const int q = e >> 1; const bool hi_ = e & 1;
                    const float x0 = hi_ ? bf_hi(raw[i][q]) : bf_lo(raw[i][q]), x1 = hi_ ? bf_hi(raw[i + 1][q]) : bf_lo(raw[i + 1][q]), x2 = hi_ ? bf_hi(raw[i + 2][q]) : bf_lo(raw[i + 2][q]), x3 = hi_ ? bf_hi(raw[i + 3][q]) : bf_lo(raw[i + 3][q]);
                    const float y = cb[e] + cw[0][e] * x0 + cw[1][e] * x1 + cw[2][e] * x2 + cw[3][e] * x3; o[e] = (ABL & 1) ? y : siluf_(y) * kscale; }
                u32x4 w; w.x = pk2(o[0], o[1]); w.y = pk2(o[2], o[3]); w.z = pk2(o[4], o[5]); w.w = pk2(o[6], o[7]);
                *(LAS u32x4*)(lds + (c_mat ? KI : QI) + off_b(c_rg * 8 + i, c_ch)) = w;
            }
        }
        { int tq = tid; OPAQUE(tq);
#pragma unroll
        for (int i = 0; i < 8; ++i) { const int idx = tq + 512 * i, row = idx >> 5, ch32 = idx & 31;
            *(LAS u32x4*)(lds + VI + (ch32 >> 4) * 32768 + off_b(row, ch32 & 15)) = vn[i]; } }
        if (tid < 128) { sc[F_IG + tid] = gin; sc[F_LF + tid] = log_sigmoid(gfn);
            if (c > 0) sc[F_N + tid] = sc[F_MISC + 1] * sc[F_N + tid] + (sc[F_NP + tid] + sc[F_NP + 128 + tid]) + (sc[F_NP + 256 + tid] + sc[F_NP + 384 + tid]); }
        __syncthreads();
        if (wid == 1 && !(ABL & 8)) {
            const float ig0 = sc[F_IG + 2 * lane], ig1 = sc[F_IG + 2 * lane + 1], lf0 = sc[F_LF + 2 * lane], lf1 = sc[F_LF + 2 * lane + 1];
            const float s2 = lf0 + lf1, incl = scan_add(s2, lane), excl = incl - s2;
            const float b0 = excl + lf0, b1 = incl, a0 = ig0 - b0, a1 = ig1 - b1;
            const float im = scan_max(fmaxf(a0, a1), lane); const float em = dpp_keep<0x138>(-3.0e38f, im);
            const float cm0 = fmaxf(em, a0), cm1 = im;
            const float M0 = fmaxf(m_prev, cm0), M1 = fmaxf(m_prev, cm1);
            const float ML = rdlane(M1, 63), bL = rdlane(b1, 63);
            sc[F_A + 2 * lane] = a0; sc[F_A + 2 * lane + 1] = a1; sc[F_M + 2 * lane] = M0; sc[F_M + 2 * lane + 1] = M1;
            sc[F_INTER + 2 * lane] = __expf(m_prev - M0); sc[F_INTER + 2 * lane + 1] = __expf(m_prev - M1);
            sc[F_EMT + 2 * lane] = __expf(-(b0 + M0)); sc[F_EMT + 2 * lane + 1] = __expf(-(b1 + M1));
            sc[F_W + 2 * lane] = __expf(a0 - ML); sc[F_W + 2 * lane + 1] = __expf(a1 - ML);
            if (lane == 0) sc[F_MISC + 0] = __expf(m_prev - ML);
            m_prev = bL + ML;
        }
        f32x16 sT[2];
#pragma unroll
        for (int jj = 0; jj < 2; ++jj) {
#pragma unroll
            for (int r = 0; r < 16; ++r) sT[jj][r] = 0.f;
            const int j = st_j0 + jj;
            if (j <= st_i) { MLS_LV; const unsigned fh = (16u * hi) ^ f16;
                bf16x8 af[8], qq[8];
#pragma unroll
                for (int ks = 0; ks < 8; ++ks) { const unsigned xo = rowb + ((32u * ks) ^ fh);
                    af[ks] = *(const LAS bf16x8*)(lds + KI + 8192 * j + xo); qq[ks] = *(const LAS bf16x8*)(lds + QI + 8192 * st_i + xo); }
                __builtin_amdgcn_sched_barrier(0);
#pragma unroll
                for (int ks = 0; ks < 8; ++ks) sT[jj] = MFMA32(af[ks], qq[ks], sT[jj]);
                __builtin_amdgcn_sched_barrier(0);
            }
        }
        __syncthreads();
        u32x2 pp[2][4];
        { MLS_LV; const int t = 32 * st_i + r32; const float Mt = sc[F_M + t]; const unsigned ab = SC + 4 * F_A + 128 * st_j0 + 16 * hi;
          f32x4 av[2][4];
#pragma unroll
          for (int jj = 0; jj < 2; ++jj)
#pragma unroll
            for (int g4 = 0; g4 < 4; ++g4) av[jj][g4] = *(const LAS f32x4*)(lds + ab + 128 * jj + 32 * g4);
          __builtin_amdgcn_sched_barrier(0);
#pragma unroll
          for (int jj = 0; jj < 2; ++jj) { const int j = st_j0 + jj;
#pragma unroll
            for (int g4 = 0; g4 < 4; ++g4) { const int s0 = 32 * j + 8 * g4 + 4 * hi; float pv[4];
#pragma unroll
                for (int e = 0; e < 4; ++e) { const int s = s0 + e; const float ex = __expf(av[jj][g4][e] - Mt) * sT[jj][4 * g4 + e]; pv[e] = (s <= t) ? ex : 0.f; }
                pp[jj][g4].x = pk2(pv[0], pv[1]); pp[jj][g4].y = pk2(pv[2], pv[3]); } } }
        f32x16 acc[4];
#pragma unroll
        for (int ti = 0; ti < 4; ++ti)
#pragma unroll
            for (int r = 0; r < 16; ++r) acc[ti][r] = 0.f;
        if (c > 0) {
#pragma unroll
            for (int dt = 0; dt < 4; ++dt)
#pragma unroll
                for (int s2 = 0; s2 < 2; ++s2) { const bf16x8 bfr = pack_step(CT[dt], s2); MLS_LV;
                    const unsigned a0 = QI + rowb + 8 * hi + ((64u * dt + 32u * s2) ^ f16), a1 = QI + rowb + 8 * hi + ((64u * dt + 32u * s2 + 16u) ^ f16);
                    s16x4 lo[4], hi4[4];
#pragma unroll
                    for (int ti = 0; ti < 4; ++ti) { lo[ti] = *(const LAS s16x4*)(lds + a0 + 8192 * ti); hi4[ti] = *(const LAS s16x4*)(lds + a1 + 8192 * ti); }
                    __builtin_amdgcn_sched_barrier(0);
#pragma unroll
                    for (int ti = 0; ti < 4; ++ti) acc[ti] = MFMA32(cat8(lo[ti], hi4[ti]), bfr, acc[ti]);
                    __builtin_amdgcn_sched_barrier(0); }
        }
        { int tq = tid; OPAQUE(tq); const int t = tq & 127, part = tq >> 7; float d = 0.f;
#pragma unroll
          for (int cc = 0; cc < 4; ++cc) { const int ch = 4 * part + cc; const u32x4 raw = *(const LAS u32x4*)(lds + QI + off_b(t, ch)); const LAS float* nn = sc + F_N + 8 * ch;
              d += bf_lo(raw.x) * nn[0] + bf_hi(raw.x) * nn[1] + bf_lo(raw.y) * nn[2] + bf_hi(raw.y) * nn[3] + bf_lo(raw.z) * nn[4] + bf_hi(raw.z) * nn[5] + bf_lo(raw.w) * nn[6] + bf_hi(raw.w) * nn[7]; }
          sc[F_NQ2P + part * 128 + t] = d; }
        __syncthreads();
        { MLS_LV; const unsigned ib = SC + 4 * F_INTER + 16 * hi;
#pragma unroll
          for (int ti = 0; ti < 4; ++ti)
#pragma unroll
            for (int r = 0; r < 16; ++r) acc[ti][r] *= *(const LAS float*)(lds + ib + 4 * (32 * ti + (r & 3) + 8 * (r >> 2))); }
        { MLS_LV;
#pragma unroll
          for (int jj = 0; jj < 2; ++jj) { const int j = st_j0 + jj;
#pragma unroll
            for (int g4 = 0; g4 < 4; ++g4) *(LAS u32x2*)(lds + QI + 8192 * st_i + rowb + 8 * hi + ((64u * j + 16u * g4) ^ f16)) = pp[jj][g4]; } }
        { int tq = tid; OPAQUE(tq);
#pragma unroll
        for (int i = 0; i < 4; ++i) { const int idx = tq + 512 * i, row = idx >> 4, ch = idx & 15; LAS u32x4* p = (LAS u32x4*)(lds + KI + off_b(row, ch)); const u32x4 raw = *p; const float w = sc[F_W + row];
            u32x4 o; o.x = pk2(bf_lo(raw.x) * w, bf_hi(raw.x) * w); o.y = pk2(bf_lo(raw.y) * w, bf_hi(raw.y) * w); o.z = pk2(bf_lo(raw.z) * w, bf_hi(raw.z) * w); o.w = pk2(bf_lo(raw.w) * w, bf_hi(raw.w) * w); *p = o; } }
        __syncthreads();
        { const float decay = sc[F_MISC + 0];
#pragma unroll
          for (int dt = 0; dt < 4; ++dt)
#pragma unroll
            for (int r = 0; r < 16; ++r) CT[dt][r] *= decay; }
#pragma unroll
        for (int ks = 0; ks < 8; ++ks) {
            MLS_LV;
            const unsigned tbv0 = VI + img * 32768 + tr_base(L_, 0) + ((64u * vc) ^ q64), tbv1 = VI + img * 32768 + tr_base(L_, 1) + ((64u * vc) ^ q64);
            const unsigned tbk0 = KI + tr_base(L_, 0), tbk1 = KI + tr_base(L_, 1);
            const bf16x8 bv = cat8(tr_read(lds + tbv0 + 4096 * ks), tr_read(lds + tbv1 + 4096 * ks));
            const unsigned xo = QI + rowb + ((32u * ks) ^ ((16u * hi) ^ f16));
            bf16x8 pa[4]; s16x4 klo[4], khi[4];
#pragma unroll
            for (int ti = 0; ti < 4; ++ti) if (ks < 2 * (ti + 1)) pa[ti] = *(const LAS bf16x8*)(lds + xo + 8192 * ti);
#pragma unroll
            for (int dt = 0; dt < 4; ++dt) { const unsigned cx = (64u * dt) ^ q64; klo[dt] = tr_read(lds + tbk0 + 4096 * ks + cx); khi[dt] = tr_read(lds + tbk1 + 4096 * ks + cx); }
            __builtin_amdgcn_sched_barrier(0);
#pragma unroll
            for (int ti = 0; ti < 4; ++ti) if (ks < 2 * (ti + 1)) acc[ti] = MFMA32(pa[ti], bv, acc[ti]);
#pragma unroll
            for (int dt = 0; dt < 4; ++dt) CT[dt] = MFMA32(cat8(klo[dt], khi[dt]), bv, CT[dt]);
            __builtin_amdgcn_sched_barrier(0);
        }
        { int tq = tid; OPAQUE(tq); const int t = tq & 127, part = tq >> 7; float d = 0.f;
#pragma unroll
          for (int cc = 0; cc < 4; ++cc) { const u32x4 raw = *(const LAS u32x4*)(lds + QI + off_b(t, 4 * part + cc));
              d += (bf_lo(raw.x) + bf_hi(raw.x)) + (bf_lo(raw.y) + bf_hi(raw.y)) + (bf_lo(raw.z) + bf_hi(raw.z)) + (bf_lo(raw.w) + bf_hi(raw.w)); }
          sc[F_NQ1P + part * 128 + t] = d;
          float nn = 0.f;
          if (!(ABL & 16)) {
#pragma unroll
              for (int g8 = 0; g8 < 4; ++g8) { bf16_t rw[8];
#pragma unroll
                  for (int i = 0; i < 8; ++i) rw[i] = *(const LAS bf16_t*)(lds + KI + off_b(32 * part + 8 * g8 + i, t >> 3) + (t & 7) * 2);
                  __builtin_amdgcn_sched_barrier(0);
#pragma unroll
                  for (int i = 0; i < 8; ++i) nn += bf2f(rw[i]);
                  __builtin_amdgcn_sched_barrier(0); } }
          sc[F_NP + part * 128 + t] = nn;
          if (tid == 0) sc[F_MISC + 1] = sc[F_MISC + 0]; }
        __syncthreads();
        if (tid < 128) { const float nq1 = (sc[F_NQ1P + tid] + sc[F_NQ1P + 128 + tid]) + (sc[F_NQ1P + 256 + tid] + sc[F_NQ1P + 384 + tid]);
            const float nq2 = (sc[F_NQ2P + tid] + sc[F_NQ2P + 128 + tid]) + (sc[F_NQ2P + 256 + tid] + sc[F_NQ2P + 384 + tid]);
            sc[F_DEN + tid] = 1.0f / fmaxf(fabsf(nq1 + sc[F_INTER + tid] * nq2), sc[F_EMT + tid]); }
        __syncthreads();
        u32x4 oraw[8];
        { int tq = tid; OPAQUE(tq);
#pragma unroll
          for (int i = 0; i < 8; ++i) { const int idx = tq + 512 * i, row = idx >> 5, ch = idx & 31; oraw[i] = *(const u32x4*)(Z + (t0 + row) * NZ + hd * 256 + ch * 8 + ZC_MO); } }
        { MLS_LV; const unsigned db = SC + 4 * F_DEN + 16 * hi, hb = VI + 2048 * hi + (32 * wid + r32) * 2;
#pragma unroll
          for (int ti = 0; ti < 4; ++ti) { f32x4 dv[4];
#pragma unroll
            for (int q = 0; q < 4; ++q) dv[q] = *(const LAS f32x4*)(lds + db + 4 * (32 * ti + 8 * q));
            __builtin_amdgcn_sched_barrier(0);
#pragma unroll
            for (int r = 0; r < 16; ++r) { const int tt = 32 * ti + (r & 3) + 8 * (r >> 2); const float x = acc[ti][r] * dv[r >> 2][r & 3];
                *(LAS bf16_t*)(lds + hb + 512 * tt) = (bf16_t)(pk2(x, 0.f) & 0xffffu); }
            __builtin_amdgcn_sched_barrier(0); } }
        __syncthreads();
        f32x4 g0, g1; { int tg = tid; OPAQUE(tg); g0 = *(const f32x4*)(norm_g + hd * 256 + (tg & 31) * 8); g1 = *(const f32x4*)(norm_g + hd * 256 + (tg & 31) * 8 + 4); }
        { const int cn = c + 1 < 16 ? c + 1 : 15; MLS_PREFETCH(cn); }
        if (!(ABL & 2))
        { int tq = tid; OPAQUE(tq);
#pragma unroll
          for (int i = 0; i < 8; ++i) { const int idx = tq + 512 * i, row = idx >> 5, ch = idx & 31;
            const u32x4 hraw = *(const LAS u32x4*)(lds + VI + row * 512 + ch * 16);
            const float h0 = bf_lo(hraw.x), h1 = bf_hi(hraw.x), h2 = bf_lo(hraw.y), h3 = bf_hi(hraw.y), h4 = bf_lo(hraw.z), h5 = bf_hi(hraw.z), h6 = bf_lo(hraw.w), h7 = bf_hi(hraw.w);
            float ssq = (h0 * h0 + h1 * h1) + (h2 * h2 + h3 * h3) + (h4 * h4 + h5 * h5) + (h6 * h6 + h7 * h7);
            ssq = half_sum32(ssq);
            const float rstd = rsqrtf(ssq * (1.0f / 256.0f) + LN_EPS);
            bf16_t* gp = Z + (t0 + row) * NZ + hd * 256 + ch * 8;
            u32x4 o;
            o.x = pk2(h0 * rstd * g0[0] * bf_lo(oraw[i].x), h1 * rstd * g0[1] * bf_hi(oraw[i].x));
            o.y = pk2(h2 * rstd * g0[2] * bf_lo(oraw[i].y), h3 * rstd * g0[3] * bf_hi(oraw[i].y));
            o.z = pk2(h4 * rstd * g1[0] * bf_lo(oraw[i].z), h5 * rstd * g1[1] * bf_hi(oraw[i].z));
            o.w = pk2(h6 * rstd * g1[2] * bf_lo(oraw[i].w), h7 * rstd * g1[3] * bf_hi(oraw[i].w));
            if (!DRY || o.x == 0x12345678u) *(u32x4*)(gp + ZC_MV) = o; } }
    }
    __syncthreads();
}
#undef MLS_LV
#undef MLS_PREFETCH
}
namespace peer {
constexpr int KROW = 144;
constexpr int L_KEYS = 0, L_IDX = 2 * 128 * KROW, LDS_BYTES = L_IDX + 512 * 32;
DI unsigned ordf(float f) { const unsigned u = __float_as_uint(f); return u ^ ((unsigned)((int)u >> 31) | 0x80000000u); }
DI float deord(unsigned k) { return __uint_as_float(k ^ ((~(unsigned)((int)k >> 31)) | 0x80000000u)); }
#define PEER_CE(a, b) do { const unsigned hi_ = (a) > (b) ? (a) : (b), lo_ = (a) > (b) ? (b) : (a); (a) = hi_; (b) = lo_; } while (0)
DI void sort16_desc(unsigned (&a)[16]) {
    PEER_CE(a[0], a[13]); PEER_CE(a[1], a[12]); PEER_CE(a[2], a[15]); PEER_CE(a[3], a[14]); PEER_CE(a[4], a[8]); PEER_CE(a[5], a[6]); PEER_CE(a[7], a[11]); PEER_CE(a[9], a[10]);
    PEER_CE(a[0], a[5]); PEER_CE(a[1], a[7]); PEER_CE(a[2], a[9]); PEER_CE(a[3], a[4]); PEER_CE(a[6], a[13]); PEER_CE(a[8], a[14]); PEER_CE(a[10], a[15]); PEER_CE(a[11], a[12]);
    PEER_CE(a[0], a[1]); PEER_CE(a[2], a[3]); PEER_CE(a[4], a[5]); PEER_CE(a[6], a[8]); PEER_CE(a[7], a[9]); PEER_CE(a[10], a[11]); PEER_CE(a[12], a[13]); PEER_CE(a[14], a[15]);
    PEER_CE(a[0], a[2]); PEER_CE(a[1], a[3]); PEER_CE(a[4], a[10]); PEER_CE(a[5], a[11]); PEER_CE(a[6], a[7]); PEER_CE(a[8], a[9]); PEER_CE(a[12], a[14]); PEER_CE(a[13], a[15]);
    PEER_CE(a[1], a[2]); PEER_CE(a[3], a[12]); PEER_CE(a[4], a[6]); PEER_CE(a[5], a[7]); PEER_CE(a[8], a[10]); PEER_CE(a[9], a[11]); PEER_CE(a[13], a[14]);
    PEER_CE(a[1], a[4]); PEER_CE(a[2], a[6]); PEER_CE(a[5], a[8]); PEER_CE(a[7], a[10]); PEER_CE(a[9], a[13]); PEER_CE(a[11], a[14]);
    PEER_CE(a[2], a[4]); PEER_CE(a[3], a[6]); PEER_CE(a[9], a[12]); PEER_CE(a[11], a[13]);
    PEER_CE(a[3], a[5]); PEER_CE(a[6], a[8]); PEER_CE(a[7], a[9]); PEER_CE(a[10], a[12]);
    PEER_CE(a[3], a[4]); PEER_CE(a[5], a[6]); PEER_CE(a[7], a[8]); PEER_CE(a[9], a[10]); PEER_CE(a[11], a[12]);
    PEER_CE(a[6], a[7]); PEER_CE(a[8], a[9]);
}
DI void merge16(unsigned (&a)[16], const unsigned (&b)[16]) {
#pragma unroll
    for (int i = 0; i < 16; ++i) a[i] = a[i] > b[15 - i] ? a[i] : b[15 - i];
#pragma unroll
    for (int j = 8; j >= 1; j >>= 1)
#pragma unroll
        for (int i = 0; i < 16; ++i) { const int l = i ^ j; if (l > i) PEER_CE(a[i], a[l]); }
}
DI float gelu_erf(float x) { return 0.5f * x * (1.0f + erff(x * 0.7071067811865476f)); }

DI void stage_keys(LAS unsigned char* lds, const float* keys) {
    f32x4 ka[4], kb[4];
#pragma unroll
    for (int n = 0; n < 4; ++n) { const int i = threadIdx.x + 512 * n, row = i >> 3, ch = i & 7; const float* s = keys + row * 64 + ch * 8; ka[n] = *(const f32x4*)s; kb[n] = *(const f32x4*)(s + 4); }
#pragma unroll
    for (int n = 0; n < 4; ++n) { const int i = threadIdx.x + 512 * n, row = i >> 3, ch = i & 7;
        u32x4 w; w.x = pk2(ka[n][0], ka[n][1]); w.y = pk2(ka[n][2], ka[n][3]); w.z = pk2(kb[n][0], kb[n][1]); w.w = pk2(kb[n][2], kb[n][3]);
        *(LAS u32x4*)(lds + L_KEYS + row * KROW + ch * 16) = w; }
}

DI void select_phase(LAS unsigned char* lds, const bf16_t* QP, int tile0, int tstep, int tile_end, bf16_t* SELE, float* SELG) {
    int tid_o = threadIdx.x; OPAQUE(tid_o); const int tid = tid_o, lane = tid & 63, r32 = lane & 31, hi = lane >> 5; const int wid = __builtin_amdgcn_readfirstlane(tid >> 6);
    bf16x8 qn[2][4];
#define SEL_QLOAD_P(TILE, P_) do { const bf16_t* qp_ = QP + ((size_t)(TILE) * 32 + r32) * DM + wid * 128 + 8 * hi; \
        _Pragma("unroll") for (int s_ = 0; s_ < 4; ++s_) qn[P_][s_] = *(const bf16x8*)(qp_ + (P_) * 64 + 16 * s_); } while (0)
    if (tile0 < tile_end) { SEL_QLOAD_P(tile0, 0); SEL_QLOAD_P(tile0, 1); }
    for (int tile = tile0; tile < tile_end; tile += tstep) {
    const int tok0 = tile * 32;
    unsigned LA[16], LB[16];
    bf16x8 qc[2][4];
#pragma unroll
    for (int p = 0; p < 2; ++p)
#pragma unroll
        for (int s = 0; s < 4; ++s) qc[p][s] = qn[p][s];
    const int tn = tile + tstep < tile_end ? tile + tstep : tile; SEL_QLOAD_P(tn, 0);
#pragma unroll
    for (int p = 0; p < 2; ++p) {
        bf16x8 qf[4];
#pragma unroll
        for (int s = 0; s < 4; ++s) qf[s] = qc[p][s];
        unsigned L[16], M[16];
#pragma unroll
        for (int nt = 0; nt < 4; ++nt) {
            f32x16 acc;
#pragma unroll
            for (int r = 0; r < 16; ++r) acc[r] = 0.f;
            bf16x8 ak[4];
#pragma unroll
            for (int s = 0; s < 4; ++s) ak[s] = *(const LAS bf16x8*)(lds + L_KEYS + (p * 128 + 32 * nt + r32) * KROW + (2 * s + hi) * 16);
            __builtin_amdgcn_sched_barrier(0);
#pragma unroll
            for (int s = 0; s < 4; ++s) acc = MFMA32(ak[s], qf[s], acc);
            unsigned T[16];
#pragma unroll
            for (int r = 0; r < 16; ++r) T[r] = (ordf(acc[r]) & ~0x7Fu) | (unsigned)(32 * nt + crow(r, hi));
            sort16_desc(T);
            if (nt == 0) {
#pragma unroll
                for (int i = 0; i < 16; ++i) L[i] = T[i]; }
            else if (nt == 1) merge16(L, T);
            else if (nt == 2) {
#pragma unroll
                for (int i = 0; i < 16; ++i) M[i] = T[i]; }
            else { merge16(M, T); merge16(L, M); }
        }
        unsigned O[16];
#pragma unroll
        for (int i = 0; i < 16; ++i) O[i] = partner32(L[i], hi);
        merge16(L, O);
#pragma unroll
        for (int i = 0; i < 16; ++i) { if (p == 0) LA[i] = L[i]; else LB[i] = L[i]; }
        if (p == 0) SEL_QLOAD_P(tn, 1);
    }
    unsigned CL[16];
    {
        float sa[16], sb[16];
#pragma unroll
        for (int i = 0; i < 16; ++i) { sa[i] = deord(LA[i] & ~0x7Fu); sb[i] = deord(LB[i] & ~0x7Fu); }
        unsigned G0[16], G1[16];
#define SEL_PUT(k, v) do { if ((k) < 16) G0[(k) & 15] = (v); else G1[(k) & 15] = (v); } while (0)
#define SEL_CAND2(k, iA, jA, iB, jB) SEL_PUT(k, (ordf((hi ? sa[iB] : sa[iA]) + (hi ? sb[jB] : sb[jA])) & ~0xFFu) | (unsigned)(hi ? (iB) * 16 + (jB) : (iA) * 16 + (jA)))
#define SEL_CAND1(k, iA, jA) SEL_PUT(k, hi ? 0u : ((ordf(sa[iA] + sb[jA]) & ~0xFFu) | (unsigned)((iA) * 16 + (jA))))
        SEL_CAND2(0, 0, 0, 3, 3);
        SEL_CAND2(1, 0, 1, 4, 0);
        SEL_CAND2(2, 0, 2, 4, 1);
        SEL_CAND2(3, 0, 3, 4, 2);
        SEL_CAND2(4, 0, 4, 5, 0);
        SEL_CAND2(5, 0, 5, 5, 1);
        SEL_CAND2(6, 0, 6, 6, 0);
        SEL_CAND2(7, 0, 7, 6, 1);
        SEL_CAND2(8, 0, 8, 7, 0);
        SEL_CAND2(9, 0, 9, 7, 1);
        SEL_CAND2(10, 0, 10, 8, 0);
        SEL_CAND2(11, 0, 11, 9, 0);
        SEL_CAND2(12, 0, 12, 10, 0);
        SEL_CAND2(13, 0, 13, 11, 0);
        SEL_CAND2(14, 0, 14, 12, 0);
        SEL_CAND2(15, 0, 15, 13, 0);
        SEL_CAND2(16, 1, 0, 14, 0);
        SEL_CAND2(17, 1, 1, 15, 0);
        SEL_CAND1(18, 1, 2);
        SEL_CAND1(19, 1, 3);
        SEL_CAND1(20, 1, 4);
        SEL_CAND1(21, 1, 5);
        SEL_CAND1(22, 1, 6);
        SEL_CAND1(23, 1, 7);
        SEL_CAND1(24, 2, 0);
        SEL_CAND1(25, 2, 1);
        SEL_CAND1(26, 2, 2);
        SEL_CAND1(27, 2, 3);
        SEL_CAND1(28, 2, 4);
        SEL_CAND1(29, 3, 0);
        SEL_CAND1(30, 3, 1);
        SEL_CAND1(31, 3, 2);
#undef SEL_PUT
#undef SEL_CAND2
#undef SEL_CAND1
        sort16_desc(G0); sort16_desc(G1); merge16(G0, G1);
        unsigned O[16];
#pragma unroll
        for (int i = 0; i < 16; ++i) O[i] = partner32(G0[i], hi);
        merge16(G0, O);
#pragma unroll
        for (int i = 0; i < 16; ++i) CL[i] = G0[i];
    }
    LAS unsigned char* itab = lds + L_IDX + tid * 32;
    { u32x4 wa, wb;
#pragma unroll
      for (int q = 0; q < 4; ++q) { wa[q] = (LA[4 * q] & 0x7Fu) | ((LA[4 * q + 1] & 0x7Fu) << 8) | ((LA[4 * q + 2] & 0x7Fu) << 16) | ((LA[4 * q + 3] & 0x7Fu) << 24);
                                    wb[q] = (LB[4 * q] & 0x7Fu) | ((LB[4 * q + 1] & 0x7Fu) << 8) | ((LB[4 * q + 2] & 0x7Fu) << 16) | ((LB[4 * q + 3] & 0x7Fu) << 24); }
      *(LAS u32x4*)itab = wa; *(LAS u32x4*)(itab + 16) = wb; }
    const float mx = deord(CL[0] & ~0xFFu);
    float ev[16], sum = 0.f;
#pragma unroll
    for (int k = 0; k < 16; ++k) { ev[k] = __expf(deord(CL[k] & ~0xFFu) - mx); sum += ev[k]; }
    const float inv = 1.0f / sum;
    bf16_t* se = SELE + (size_t)(tok0 + r32) * 128 + wid * 16;
    float* sg = SELG + (size_t)(tok0 + r32) * 128 + wid * 16;
#pragma unroll
    for (int k = 0; k < 16; ++k) if ((k >> 3) == hi) { const unsigned code = CL[k] & 0xFFu; const unsigned n1 = itab[code >> 4], n2 = itab[16 + (code & 15u)];
        se[k] = (bf16_t)(n1 * 128u + n2); sg[k] = ev[k] * inv; }
    }
#undef SEL_QLOAD_P
}

DI void u_phase(LAS unsigned char* lds, int tile0, int tstep, int s, const bf16_t* SELE, const unsigned char* H2Q, const unsigned char* U4S, bf16_t* PART) {
    int tid_o = threadIdx.x; OPAQUE(tid_o); const int tid = tid_o, lane = tid & 63, j = lane >> 3, c = lane & 7; const int wid = __builtin_amdgcn_readfirstlane(tid >> 6);
    if (tile0 >= TOK / 32) return;
    LAS unsigned char* wl = lds + wid * 4096;
    const unsigned char* Us = U4S + (size_t)s * NEXP * 128; const unsigned c16 = 16u * c;
    u32x4 sreg;
#define UP_STAGE_LOAD(TILE) do { sreg = *(const u32x4*)(SELE + (size_t)(TILE) * 32 * 128 + (wid * 64 + lane) * 8); } while (0)
#define UP_STAGE_STORE(BUF) do { *(LAS u32x4*)(wl + (BUF) * 2048 + lane * 16) = sreg; } while (0)
#define UP_GATHER(UR, H0, H1, BUF, JT, TILE) do { const LAS bf16_t* se_ = (const LAS bf16_t*)(wl + (BUF) * 2048) + (JT) * 128 + j; const size_t t_ = (size_t)(TILE) * 32 + wid * 4 + (JT); \
        { const unsigned char* hrow_ = H2Q + t_ * DM + 128 * s; H0 = *(const u32x4*)(hrow_ + c16); H1 = *(const u32x4*)(hrow_ + 512 + c16); }       \
        _Pragma("unroll") for (int g = 0; g < 16; ++g) { const unsigned e_ = se_[8 * g]; UR[g] = *(const u32x4*)(Us + ((e_ << 7) + c16)); } } while (0)
#define UP_COMPUTE(UR, H0, H1, JT, TILE) do { \
        int d[16]; \
        _Pragma("unroll") for (int g = 0; g < 16; ++g) { int da = 0, db = 0; \
            _Pragma("unroll") for (int i = 0; i < 4; ++i) { da = __builtin_amdgcn_sdot8((int)UR[g][i], (int)H0[i], da, false); db = __builtin_amdgcn_sdot8((int)UR[g][i], (int)H1[i], db, false); } \
            d[g] = 16 * da + db; if ((g & 3) == 3) __builtin_amdgcn_sched_barrier(0); } \
          \
        int r1[8], r2[4], r3[2]; \
        _Pragma("unroll") for (int i = 0; i < 8; ++i) { const int keep = c2 ? d[i + 8] : d[i], send = c2 ? d[i] : d[i + 8]; r1[i] = keep + dppi<0x141>(send); } \
        _Pragma("unroll") for (int i = 0; i < 4; ++i) { const int keep = c1 ? r1[i + 4] : r1[i], send = c1 ? r1[i] : r1[i + 4]; r2[i] = keep + dppi<0x4E>(send); } \
        _Pragma("unroll") for (int i = 0; i < 2; ++i) { const int keep = c0 ? r2[i + 2] : r2[i], send = c0 ? r2[i] : r2[i + 2]; r3[i] = keep + dppi<0xB1>(send); } \
        bf16_t* pp = PART + ((size_t)(TILE) * 32 + wid * 4 + (JT)) * 512 + s * 128 + 16 * c + j;            \
        pp[0] = (bf16_t)(pk2((float)r3[0], 0.f) & 0xffffu); pp[8] = (bf16_t)(pk2((float)r3[1], 0.f) & 0xffffu); } while (0)
    u32x4 urA[16], urB[16], hA0, hA1, hB0, hB1; const int c2 = c >> 2, c1 = (c >> 1) & 1, c0 = c & 1;
    UP_STAGE_LOAD(tile0); UP_STAGE_STORE(0);
    UP_GATHER(urA, hA0, hA1, 0, 0, tile0);
    int buf = 0;
#pragma unroll 1
    for (int tile = tile0; tile < TOK / 32; tile += tstep) {
        const int tnext = tile + tstep < TOK / 32 ? tile + tstep : tile;
        UP_STAGE_LOAD(tnext);
        UP_GATHER(urB, hB0, hB1, buf, 1, tile); UP_COMPUTE(urA, hA0, hA1, 0, tile);
        UP_GATHER(urA, hA0, hA1, buf, 2, tile); UP_COMPUTE(urB, hB0, hB1, 1, tile);
        UP_GATHER(urB, hB0, hB1, buf, 3, tile); UP_COMPUTE(urA, hA0, hA1, 2, tile);
        UP_STAGE_STORE(buf ^ 1);
        UP_GATHER(urA, hA0, hA1, buf ^ 1, 0, tnext);
        UP_COMPUTE(urB, hB0, hB1, 3, tile);
        buf ^= 1;
    }
#undef UP_STAGE_LOAD
#undef UP_STAGE_STORE
#undef UP_GATHER
#undef UP_COMPUTE
}
template <int NQ> DI void red_tokens(size_t t0, const bf16_t* __restrict__ PART, const bf16_t* __restrict__ SELE, const float* __restrict__ SELG, const float* __restrict__ SU, const float* __restrict__ SV,
                    const float* __restrict__ SH, signed char* __restrict__ COEFQ, float* __restrict__ CS) {
    const int lane = threadIdx.x & 63;
    float s[NQ][2], g[NQ][2], su[NQ][2], sv[NQ][2], sh[NQ];
#pragma unroll
    for (int q = 0; q < NQ; ++q) { const size_t t = t0 + q; sh[q] = SH[t];
#pragma unroll
        for (int h = 0; h < 2; ++h) { const int k = lane + 64 * h; const unsigned e = SELE[t * 128 + k]; g[q][h] = SELG[t * 128 + k]; su[q][h] = SU[e]; sv[q][h] = SV[e];
            float a = 0.f;
#pragma unroll
            for (int xx = 0; xx < 4; ++xx) a += bf2f(PART[t * 512 + xx * 128 + k]);
            s[q][h] = a; } }
#pragma unroll
    for (int q = 0; q < NQ; ++q) { const size_t t = t0 + q;
        const float c0 = g[q][0] * gelu_erf(s[q][0] * su[q][0] * sh[q]) * sv[q][0], c1 = g[q][1] * gelu_erf(s[q][1] * su[q][1] * sh[q]) * sv[q][1];
        float cm = fmaxf(fabsf(c0), fabsf(c1));
        cm = wave_max(cm);
        const float inv = cm > 0.f ? 127.0f / cm : 0.f;
        signed char* cq = COEFQ + t * 128 + (lane & 7) * 16 + (lane >> 3);
        cq[0] = (signed char)(int)rintf(c0 * inv); cq[8] = (signed char)(int)rintf(c1 * inv);
        if (lane == 0) CS[t] = cm * (1.0f / 127.0f); }
}
DI unsigned bperm(unsigned hi, unsigned lo, unsigned sel) { return __builtin_amdgcn_perm(hi, lo, sel); }
DI void v_phase(LAS unsigned char* lds, int tile0, int tstep, int x, const bf16_t* SELE, const signed char* COEFQ, const float* CS, const unsigned char* V8S, bf16_t* YF) {
    int tid_o = threadIdx.x; OPAQUE(tid_o); const int tid = tid_o, lane = tid & 63, j = lane >> 3, c = lane & 7; const int wid = __builtin_amdgcn_readfirstlane(tid >> 6);
    if (tile0 >= TOK / 32) return;
    LAS unsigned char* wl = lds + wid * 4096;
    const unsigned char* Vs = V8S + (size_t)x * NEXP * 128; const unsigned c16 = 16u * c;
    u32x4 sreg, creg = {0u, 0u, 0u, 0u};
#define VP_STAGE_LOAD(TILE) do { sreg = *(const u32x4*)(SELE + (size_t)(TILE) * 32 * 128 + (wid * 64 + lane) * 8); if (lane < 32) creg = *(const u32x4*)(COEFQ + (size_t)(TILE) * 32 * 128 + (wid * 32 + lane) * 16); } while (0)
#define VP_STAGE_STORE(BUF) do { *(LAS u32x4*)(wl + (BUF) * 2048 + lane * 16) = sreg; if (lane < 32) *(LAS u32x4*)(wl + (BUF) * 2048 + 1024 + lane * 16) = creg; } while (0)
#define VP_GATHER(VR, SC, BUF, JT, TILE) do { const LAS bf16_t* se_ = (const LAS bf16_t*)(wl + (BUF) * 2048) + (JT) * 128 + j; SC = CS[(size_t)(TILE) * 32 + wid * 4 + (JT)]; \
        _Pragma("unroll") for (int g = 0; g < 16; ++g) { const unsigned e_ = se_[8 * g]; VR[g] = *(const u32x4*)(Vs + ((e_ << 7) + c16)); } } while (0)
#define VP_COMPUTE(VR, SC, BUF, JT, TILE) do { const LAS unsigned* cqp_ = (const LAS unsigned*)(wl + (BUF) * 2048 + 1024 + (JT) * 128 + j * 16); \
        int acc[16]; \
        _Pragma("unroll") for (int i = 0; i < 16; ++i) acc[i] = 0; \
        _Pragma("unroll") for (int qd = 0; qd < 4; ++qd) { const int cp = (int)cqp_[qd]; \
            _Pragma("unroll") for (int i = 0; i < 4; ++i) { const unsigned w0 = VR[4 * qd][i], w1 = VR[4 * qd + 1][i], w2 = VR[4 * qd + 2][i], w3 = VR[4 * qd + 3][i]; \
                const unsigned t0 = bperm(w1, w0, 0x05010400u), t1 = bperm(w1, w0, 0x07030602u), t2 = bperm(w3, w2, 0x05010400u), t3 = bperm(w3, w2, 0x07030602u); \
                acc[4 * i] = __builtin_amdgcn_sdot4((int)bperm(t2, t0, 0x05040100u), cp, acc[4 * i], false); \
                acc[4 * i + 1] = __builtin_amdgcn_sdot4((int)bperm(t2, t0, 0x07060302u), cp, acc[4 * i + 1], false); \
                acc[4 * i + 2] = __builtin_amdgcn_sdot4((int)bperm(t3, t1, 0x05040100u), cp, acc[4 * i + 2], false); \
                acc[4 * i + 3] = __builtin_amdgcn_sdot4((int)bperm(t3, t1, 0x07060302u), cp, acc[4 * i + 3], false); } } \
          \
        int r1[8], r2[4], r3[2]; \
        _Pragma("unroll") for (int i = 0; i < 8; ++i) { const int keep = b3 ? acc[i + 8] : acc[i], send = b3 ? acc[i] : acc[i + 8]; r1[i] = keep + dppi<0x128>(send); }                          \
        _Pragma("unroll") for (int i = 0; i < 4; ++i) { const int keep = b4 ? r1[i + 4] : r1[i], send = b4 ? r1[i] : r1[i + 4]; r2[i] = keep + __builtin_amdgcn_ds_swizzle(send, 0x401F); }     \
        _Pragma("unroll") for (int i = 0; i < 2; ++i) { const int keep = b5 ? r2[i + 2] : r2[i], send = b5 ? r2[i] : r2[i + 2]; r3[i] = keep + (int)partner32((unsigned)send, b5); }              \
        *(unsigned*)(YF + ((size_t)(TILE) * 32 + wid * 4 + (JT)) * DM + 128 * x + 16 * c + 8 * b3 + 4 * b4 + 2 * b5) = pk2((float)r3[0] * SC, (float)r3[1] * SC); } while (0)
    u32x4 vrA[16], vrB[16]; float scA, scB; const int b3 = j & 1, b4 = (j >> 1) & 1, b5 = j >> 2;
    VP_STAGE_LOAD(tile0); VP_STAGE_STORE(0);
    VP_GATHER(vrA, scA, 0, 0, tile0);
    int buf = 0;
#pragma unroll 1
    for (int tile = tile0; tile < TOK / 32; tile += tstep) {
        const int tnext = tile + tstep < TOK / 32 ? tile + tstep : tile;
        VP_STAGE_LOAD(tnext);
        VP_GATHER(vrB, scB, buf, 1, tile); VP_COMPUTE(vrA, scA, buf, 0, tile);
        VP_GATHER(vrA, scA, buf, 2, tile); VP_COMPUTE(vrB, scB, buf, 1, tile);
        VP_GATHER(vrB, scB, buf, 3, tile); VP_COMPUTE(vrA, scA, buf, 2, tile);
        VP_STAGE_STORE(buf ^ 1);
        VP_GATHER(vrA, scA, buf ^ 1, 0, tnext);
        VP_COMPUTE(vrB, scB, buf, 3, tile);
        buf ^= 1;
    }
#undef VP_STAGE_LOAD
#undef VP_STAGE_STORE
#undef VP_GATHER
#undef VP_COMPUTE
}
DI void final_rows2(size_t m0, size_t m1, const bf16_t* __restrict__ Rp, const bf16_t* __restrict__ YF, const float* __restrict__ MOD, const float* __restrict__ g1, const float* __restrict__ b1,
                    const float* __restrict__ ln_g, const float* __restrict__ ln_b, float* __restrict__ OUT) {
    const int lane = threadIdx.x & 63;
    f32x4 v[2][4], y[2][4];
#pragma unroll
    for (int r = 0; r < 2; ++r) { const size_t m = r ? m1 : m0;
        const u32x2* rr = (const u32x2*)(Rp + m * DM) + lane; const u32x2* yr = (const u32x2*)(YF + m * DM) + lane;
#pragma unroll
        for (int q = 0; q < 4; ++q) { const u32x2 rw = rr[64 * q]; v[r][q] = (f32x4){bf_lo(rw.x), bf_hi(rw.x), bf_lo(rw.y), bf_hi(rw.y)}; const u32x2 yy = yr[64 * q]; y[r][q] = (f32x4){bf_lo(yy.x), bf_hi(yy.x), bf_lo(yy.y), bf_hi(yy.y)}; } }
#pragma unroll
    for (int r = 0; r < 2; ++r) { const size_t m = r ? m1 : m0; const int b = (int)(m / SEQ); const f32x4* gt = (const f32x4*)(MOD + (size_t)b * MODW + 5 * DM) + lane; float s = 0.f;
#pragma unroll
        for (int q = 0; q < 4; ++q) s += (v[r][q].x + v[r][q].y) + (v[r][q].z + v[r][q].w);
        float mean = wave_sum(s) * (1.f / DM); float s2 = 0.f;
#pragma unroll
        for (int q = 0; q < 4; ++q) { v[r][q] = v[r][q] - mean; s2 += (v[r][q].x * v[r][q].x + v[r][q].y * v[r][q].y) + (v[r][q].z * v[r][q].z + v[r][q].w * v[r][q].w); }
        float rstd = rsqrtf(wave_sum(s2) * (1.f / DM) + LN_EPS); s = 0.f;
#pragma unroll
        for (int q = 0; q < 4; ++q) { const f32x4 x1 = v[r][q] * rstd * ((const f32x4*)g1)[lane + 64 * q] + ((const f32x4*)b1)[lane + 64 * q];
            v[r][q] = x1 * ALPHA_RES + gt[64 * q] * y[r][q]; s += (v[r][q].x + v[r][q].y) + (v[r][q].z + v[r][q].w); }
        mean = wave_sum(s) * (1.f / DM); s2 = 0.f;
#pragma unroll
        for (int q = 0; q < 4; ++q) { v[r][q] = v[r][q] - mean; s2 += (v[r][q].x * v[r][q].x + v[r][q].y * v[r][q].y) + (v[r][q].z * v[r][q].z + v[r][q].w * v[r][q].w); }
        rstd = rsqrtf(wave_sum(s2) * (1.f / DM) + LN_EPS);
        f32x4* op = (f32x4*)(OUT + m * DM) + lane;
#pragma unroll
        for (int q = 0; q < 4; ++q) op[64 * q] = v[r][q] * rstd * ((const f32x4*)ln_g)[lane + 64 * q] + ((const f32x4*)ln_b)[lane + 64 * q]; }
}
}
constexpr int NWAVES = 8;
#ifndef MK_N_LAUNCHES
#define MK_N_LAUNCHES 1
#endif
constexpr int N_PHASES = 14;
constexpr int RING_BYTES = 147456;
constexpr int MISC_OFF = RING_BYTES;
constexpr int LDS_BYTES = RING_BYTES + 4096;
static_assert(pg8::STAGE_BYTES <= RING_BYTES && datt::LDS_BYTES <= RING_BYTES && mls::LDS_BYTES <= RING_BYTES && peer::LDS_BYTES <= RING_BYTES, "LDS map");

typedef GAS unsigned gu32;
#define RLX_AGENT __ATOMIC_RELAXED, __HIP_MEMORY_SCOPE_AGENT
#define LDS_WAIT() asm volatile("s_waitcnt lgkmcnt(0)" ::: "memory")

#define XB_TMO      128
#define XB_XCNT(j)  (256  + 64 * (j))
#define XB_XSUB(j)  (1280 + 64 * (j))
#define XB_XGEN(j)  (2304 + 64 * (j))
#define XB_TOP      3328
#define XB_TOPGEN   3392
#define XCD_BAR_WORDS 3456
#define XB_SPIN_CAP (1u << 22)
DI unsigned xb_ld(unsigned* p)              { return __hip_atomic_load(p, __ATOMIC_RELAXED, __HIP_MEMORY_SCOPE_AGENT); }
DI unsigned xb_add(unsigned* p, unsigned v) { return __hip_atomic_fetch_add(p, v, __ATOMIC_RELAXED, __HIP_MEMORY_SCOPE_AGENT); }
DI unsigned xb_xcc_id() { return (unsigned)__builtin_amdgcn_s_getreg((3 << 11) | 20) & 0xFu; }
#define XB_SPIN(cond, bar) do { unsigned _sp = 0; while (cond) { __builtin_amdgcn_s_sleep(1); \
    if ((++_sp & 255u) == 0u) { if (xb_ld(&(bar)[XB_TMO])) break; if (_sp > XB_SPIN_CAP) { atomicAdd(&(bar)[XB_TMO], 1u); break; } } } } while (0)
struct XcdBarrier { unsigned* bar; unsigned x; volatile LAS unsigned* st; };
DI XcdBarrier xcd_barrier_post(unsigned* bar, volatile LAS unsigned* st) {
    XcdBarrier b; b.bar = bar; b.x = xb_xcc_id(); b.st = st;
    if (threadIdx.x == 0) st[2] = xb_add(&bar[XB_XCNT(b.x)], 1u);
    return b;
}
DI void xcd_barrier_complete(unsigned* bar, unsigned x, unsigned& nloc, unsigned& nx) {
    const unsigned G = gridDim.x * gridDim.y * gridDim.z;
    unsigned sum, cnt, mine, sp = 0u;
    for (;;) {
        sum = 0u; cnt = 0u; mine = 0u;
#pragma unroll
        for (unsigned j = 0; j < 16; ++j) { const unsigned c = xb_ld(&bar[XB_XCNT(j)]); sum += c; cnt += (c > 0u) ? 1u : 0u; mine = (j == x) ? c : mine; }
        if (sum == G) break;
        __builtin_amdgcn_s_sleep(1);
        if ((++sp & 255u) == 0u) { if (xb_ld(&bar[XB_TMO])) break; if (sp > XB_SPIN_CAP) { atomicAdd(&bar[XB_TMO], 1u); break; } }
    }
    nloc = mine > 0u ? mine : 1u; nx = cnt > 0u ? cnt : 1u;
}
DI void xcd_barrier(const XcdBarrier& b) {
    asm volatile("s_waitcnt vmcnt(0)" ::: "memory");
    __syncthreads();
    if (threadIdx.x == 0) {
        unsigned* bar = b.bar;
        __builtin_amdgcn_s_waitcnt(0);
        unsigned nloc = b.st[0], nx = b.st[1];
        if (nloc == 0u) { xcd_barrier_complete(bar, b.x, nloc, nx); b.st[0] = nloc; b.st[1] = nx; }
        const unsigned old = xb_add(&bar[XB_XSUB(b.x)], 1u);
        const unsigned gen = old / nloc;
        if (old + 1u == (gen + 1u) * nloc) {
            __builtin_amdgcn_fence(__ATOMIC_RELEASE, "agent");
            asm volatile("s_waitcnt vmcnt(0)" ::: "memory");
            const unsigned og = xb_add(&bar[XB_TOP], 1u);
            const unsigned tg = og / nx;
            if (og + 1u == (tg + 1u) * nx) xb_add(&bar[XB_TOPGEN], 1u);
            else XB_SPIN(xb_ld(&bar[XB_TOPGEN]) == tg, bar);
            xb_add(&bar[XB_XGEN(b.x)], 1u);
            __builtin_amdgcn_fence(__ATOMIC_ACQUIRE, "agent");
            asm volatile("s_waitcnt vmcnt(0)" ::: "memory");
        } else {
            XB_SPIN(xb_ld(&bar[XB_XGEN(b.x)]) == gen, bar);
            __builtin_amdgcn_fence(__ATOMIC_ACQUIRE, "agent");
            asm volatile("s_waitcnt vmcnt(0)" ::: "memory");
        }
    }
    __syncthreads();
}

#ifndef FLATBAR
#define FLATBAR 0
#endif
DI void flat_barrier(unsigned* cnt, unsigned& epoch) {
    asm volatile("s_waitcnt vmcnt(0)" ::: "memory");
    __syncthreads();
    if (threadIdx.x == 0) {
        __builtin_amdgcn_fence(__ATOMIC_RELEASE, "agent");
        asm volatile("s_waitcnt vmcnt(0)" ::: "memory");
        const unsigned target = (epoch + 1u) * gridDim.x;
        xb_add(cnt, 1u);
        unsigned sp = 0;
        while (xb_ld(cnt) < target) { __builtin_amdgcn_s_sleep(1); if (++sp > (1u << 24)) break; }
        __builtin_amdgcn_fence(__ATOMIC_ACQUIRE, "agent");
        asm volatile("s_waitcnt vmcnt(0)" ::: "memory");
    }
    ++epoch;
    __syncthreads();
}
DI void p0_transpose_item(const float* W, int ldw, int col0, bf16_t* WT, int K, int dst_row0, int kb, float scale, LAS float* scr, int lane) {
    const int k0 = 64 * kb;
    float tv[32];
    { const float* wp = W + (size_t)(k0 + (lane >> 5)) * ldw + col0 + (lane & 31);
#pragma unroll
      for (int i = 0; i < 32; ++i) tv[i] = wp[(size_t)(2 * i) * ldw]; }
    __builtin_amdgcn_sched_barrier(0);
#pragma unroll
    for (int i = 0; i < 32; ++i) { const int kk = 2 * i + (lane >> 5); scr[kk * 33 + (lane & 31)] = tv[i] * scale; }
    LDS_WAIT(); asm volatile("" ::: "memory");
    const int c = lane & 7;
#pragma unroll
    for (int j = 0; j < 4; ++j) { const int n = (lane >> 3) + 8 * j; const LAS float* s = scr + (8 * c) * 33 + n;
        u32x4 o; o.x = pk2(s[0 * 33], s[1 * 33]); o.y = pk2(s[2 * 33], s[3 * 33]); o.z = pk2(s[4 * 33], s[5 * 33]); o.w = pk2(s[6 * 33], s[7 * 33]);
        *(u32x4*)(WT + (size_t)(dst_row0 + n) * K + k0 + 8 * c) = o; }
    LDS_WAIT(); asm volatile("" ::: "memory");
}


DI void p1_rows2(int m0, int m1, int lane, const float* __restrict__ xin, const float* __restrict__ MODp, bf16_t* __restrict__ H1p, float* __restrict__ GIFp, const float* __restrict__ bif, const LAS float* wif) {
    f32x4 v[2][4], scv[2][4], shv[2][4];
#pragma unroll
    for (int r = 0; r < 2; ++r) { const int m = r ? m1 : m0; const int b = m / SEQ;
        const f32x4* xr = (const f32x4*)(xin + (size_t)m * DM) + lane; const f32x4* sh = (const f32x4*)(MODp + (size_t)b * MODW) + lane; const f32x4* sc = (const f32x4*)(MODp + (size_t)b * MODW + DM) + lane;
#pragma unroll
        for (int j = 0; j < 4; ++j) { v[r][j] = xr[64 * j]; scv[r][j] = sc[64 * j]; shv[r][j] = sh[64 * j]; } }
#pragma unroll
    for (int r = 0; r < 2; ++r) { const int m = r ? m1 : m0; float s = 0.f;
#pragma unroll
        for (int j = 0; j < 4; ++j) s += (v[r][j].x + v[r][j].y) + (v[r][j].z + v[r][j].w);
        const float mean = wave_sum(s) * (1.f / DM); float s2 = 0.f;
#pragma unroll
        for (int j = 0; j < 4; ++j) { v[r][j] = v[r][j] - mean; s2 += (v[r][j].x * v[r][j].x + v[r][j].y * v[r][j].y) + (v[r][j].z * v[r][j].z + v[r][j].w * v[r][j].w); }
        const float rstd = rsqrtf(wave_sum(s2) * (1.f / DM) + LN_EPS);
        unsigned long long* o8 = (unsigned long long*)(H1p + (size_t)m * DM) + lane;
        float gp[8];
#pragma unroll
        for (int g = 0; g < 8; ++g) gp[g] = 0.f;
        const LAS float* wl = wif + 4 * lane; asm volatile("" : "+v"(wl));
#pragma unroll
        for (int j = 0; j < 4; ++j) { const f32x4 hh = v[r][j] * rstd * (scv[r][j] + 1.0f) + shv[r][j];
            o8[64 * j] = (unsigned long long)pk2(hh.x, hh.y) | ((unsigned long long)pk2(hh.z, hh.w) << 32);
#pragma unroll
            for (int g = 0; g < 8; ++g) { const f32x4 w = *(const LAS f32x4*)(wl + g * 1024 + 256 * j); gp[g] += (hh.x * w.x + hh.y * w.y) + (hh.z * w.z + hh.w * w.w); } }
#pragma unroll
        for (int g = 0; g < 8; ++g) gp[g] = wave_sum(gp[g]);
        if (lane == 0) {
#pragma unroll
            for (int g = 0; g < 8; ++g) GIFp[(size_t)m * 8 + g] = gp[g] + bif[g]; } }
}
template <int NR> DI void p7_rows(int m0, int lane, const bf16_t* __restrict__ Rp, const float* __restrict__ MODp, const float* __restrict__ g1, const float* __restrict__ b1,
                 bf16_t* __restrict__ H2p, unsigned char* __restrict__ H2Qp, float* __restrict__ SHp) {
    f32x4 v[NR][4], scv[4], shv[4];
    { const int b = m0 / SEQ; const f32x4* sh = (const f32x4*)(MODp + (size_t)b * MODW + 3 * DM) + lane; const f32x4* sc = (const f32x4*)(MODp + (size_t)b * MODW + 4 * DM) + lane;
#pragma unroll
      for (int r = 0; r < NR; ++r) { const u32x2* rr = (const u32x2*)(Rp + (size_t)(m0 + r) * DM) + lane;
#pragma unroll
        for (int j = 0; j < 4; ++j) { const u32x2 rw = rr[64 * j]; v[r][j] = (f32x4){bf_lo(rw.x), bf_hi(rw.x), bf_lo(rw.y), bf_hi(rw.y)}; } }
#pragma unroll
      for (int j = 0; j < 4; ++j) { scv[j] = sc[64 * j]; shv[j] = sh[64 * j]; } }
#pragma unroll
    for (int r = 0; r < NR; ++r) { const int m = m0 + r; float s = 0.f;
#pragma unroll
        for (int j = 0; j < 4; ++j) s += (v[r][j].x + v[r][j].y) + (v[r][j].z + v[r][j].w);
        float mean = wave_sum(s) * (1.f / DM); float s2 = 0.f;
#pragma unroll
        for (int j = 0; j < 4; ++j) { v[r][j] = v[r][j] - mean; s2 += (v[r][j].x * v[r][j].x + v[r][j].y * v[r][j].y) + (v[r][j].z * v[r][j].z + v[r][j].w * v[r][j].w); }
        float rstd = rsqrtf(wave_sum(s2) * (1.f / DM) + LN_EPS);
        s = 0.f;
#pragma unroll
        for (int j = 0; j < 4; ++j) { v[r][j] = v[r][j] * rstd * ((const f32x4*)g1)[lane + 64 * j] + ((const f32x4*)b1)[lane + 64 * j]; s += (v[r][j].x + v[r][j].y) + (v[r][j].z + v[r][j].w); }
        mean = wave_sum(s) * (1.f / DM); s2 = 0.f;
#pragma unroll
        for (int j = 0; j < 4; ++j) { v[r][j] = v[r][j] - mean; s2 += (v[r][j].x * v[r][j].x + v[r][j].y * v[r][j].y) + (v[r][j].z * v[r][j].z + v[r][j].w * v[r][j].w); }
        rstd = rsqrtf(wave_sum(s2) * (1.f / DM) + LN_EPS);
        unsigned long long* o8 = (unsigned long long*)(H2p + (size_t)m * DM) + lane;
        float amax = 0.f;
#pragma unroll
        for (int j = 0; j < 4; ++j) { const f32x4 hh = v[r][j] * rstd * (scv[j] + 1.0f) + shv[j]; o8[64 * j] = (unsigned long long)pk2(hh.x, hh.y) | ((unsigned long long)pk2(hh.z, hh.w) << 32);
            v[r][j] = hh; amax = fmaxf(amax, fmaxf(fmaxf(fabsf(hh.x), fabsf(hh.y)), fmaxf(fabsf(hh.z), fabsf(hh.w)))); }
        amax = wave_max(amax);
        const float qinv = amax > 0.f ? 119.0f / amax : 0.f;
        unsigned char* hq = H2Qp + (size_t)m * DM;
#pragma unroll
        for (int j = 0; j < 4; ++j) { const int q0 = (int)rintf(v[r][j].x * qinv), q1 = (int)rintf(v[r][j].y * qinv), q2 = (int)rintf(v[r][j].z * qinv), q3 = (int)rintf(v[r][j].w * qinv);
            const int a0 = (q0 + 8) >> 4, a1 = (q1 + 8) >> 4, a2 = (q2 + 8) >> 4, a3 = (q3 + 8) >> 4;
            const unsigned ha = (unsigned)(a0 & 15) | ((unsigned)(a1 & 15) << 4) | ((unsigned)(a2 & 15) << 8) | ((unsigned)(a3 & 15) << 12);
            const unsigned hb = (unsigned)((q0 - 16 * a0) & 15) | ((unsigned)((q1 - 16 * a1) & 15) << 4) | ((unsigned)((q2 - 16 * a2) & 15) << 8) | ((unsigned)((q3 - 16 * a3) & 15) << 12);
            const unsigned pa = (unsigned)dppi<0xB1>((int)ha), pb = (unsigned)dppi<0xB1>((int)hb);
            if (!(lane & 1)) { *(unsigned*)(hq + 128 * j + 2 * lane) = ha | (pa << 16); *(unsigned*)(hq + 512 + 128 * j + 2 * lane) = hb | (pb << 16); } }
        if (lane == 0) SHp[m] = amax * (1.0f / 119.0f); }
}


DI void prep_small_weights_item(LAS unsigned char* lds, int item, const float* w0, const float* w1, const float* w2, const float* w3, bf16_t* d0, bf16_t* d1, bf16_t* d2, bf16_t* d3) {
    int t = threadIdx.x; OPAQUE(t); const int lane = t & 63, wave = __builtin_amdgcn_readfirstlane(t >> 6);
    const int r = item * 8 + wave, wsel = r / 512, q = r % 512, kb = q / 32, nb = q % 32;
    const float* src = wsel == 0 ? w0 : wsel == 1 ? w1 : wsel == 2 ? w2 : w3; bf16_t* dst = wsel == 0 ? d0 : wsel == 1 ? d1 : wsel == 2 ? d2 : d3;
    p0_transpose_item(src, DM, 32 * nb, dst, DM, 32 * nb, kb, 1.0f, (LAS float*)(lds + wave * 16384), lane);
}
DI void prep_quant_item(int item, const float* pu, const float* pv, unsigned char* U8, unsigned char* V8, float* SU, float* SV) {
    int t = threadIdx.x; OPAQUE(t); const int lane = t & 63, wave = __builtin_amdgcn_readfirstlane(t >> 6);
#pragma unroll 1
    for (int it = 0; it < 4; ++it) { const int row0 = item * 128 + wave * 16 + it * 4;
        f32x4 a[4][4];
#pragma unroll
        for (int r = 0; r < 4; ++r) { const int row = row0 + r; const bool second = row >= NEXP; const int e = second ? row - NEXP : row;
            const float* s = (second ? pv : pu) + (size_t)e * DM + 16 * lane;
#pragma unroll
            for (int j = 0; j < 4; ++j) a[r][j] = *(const f32x4*)(s + 4 * j); }
#pragma unroll
        for (int r = 0; r < 4; ++r) { const int row = row0 + r; const bool second = row >= NEXP; const int e = second ? row - NEXP : row;
            float amax = 0.f;
#pragma unroll
            for (int j = 0; j < 4; ++j) amax = fmaxf(amax, fmaxf(fmaxf(fabsf(a[r][j].x), fabsf(a[r][j].y)), fmaxf(fabsf(a[r][j].z), fabsf(a[r][j].w))));
            amax = wave_max(amax);
            if (second) {
            const float inv = amax > 0.f ? 127.0f / amax : 0.f;
            u32x4 w;
#pragma unroll
            for (int j = 0; j < 4; ++j) { const int q0 = (int)rintf(a[r][j].x * inv), q1 = (int)rintf(a[r][j].y * inv), q2 = (int)rintf(a[r][j].z * inv), q3 = (int)rintf(a[r][j].w * inv);
                w[j] = (unsigned)(q0 & 255) | ((unsigned)(q1 & 255) << 8) | ((unsigned)(q2 & 255) << 16) | ((unsigned)(q3 & 255) << 24); }
            *(u32x4*)(V8 + (size_t)(lane >> 3) * NEXP * 128 + (size_t)e * 128 + (lane & 7) * 16) = w;
            if (lane == 0) SV[e] = amax * (1.0f / 127.0f);
            } else {
            const float inv = amax > 0.f ? 7.0f / amax : 0.f;
            u32x2 w;
#pragma unroll
            for (int j = 0; j < 4; ++j) { const unsigned n0 = (unsigned)((int)rintf(a[r][j].x * inv) & 15), n1 = (unsigned)((int)rintf(a[r][j].y * inv) & 15), n2 = (unsigned)((int)rintf(a[r][j].z * inv) & 15), n3 = (unsigned)((int)rintf(a[r][j].w * inv) & 15);
                const unsigned two = n0 | (n1 << 4) | (n2 << 8) | (n3 << 12);
                if (j & 1) w[j >> 1] |= two << 16; else w[j >> 1] = two; }
            *(u32x2*)(U8 + (size_t)(lane >> 4) * NEXP * 128 + (size_t)e * 128 + (lane & 15) * 8) = w;
            if (lane == 0) SU[e] = amax * (1.0f / 7.0f);
            } } }
}

struct Args { const float* in[22]; float* out; unsigned char* ws; int ph_lo, ph_hi; };

__global__ void __launch_bounds__(NWAVES * 64, 2) mega_fwd(Args args) {
    extern __shared__ __attribute__((aligned(16))) unsigned char lds_raw[];
    LAS unsigned char* lds = (LAS unsigned char*)lds_raw;
    volatile LAS unsigned* MISC = (volatile LAS unsigned*)(lds + MISC_OFF);
    const int tid = threadIdx.x, lane = tid & 63, wave = __builtin_amdgcn_readfirstlane(tid >> 6);
    const int G = gridDim.x; const int bx = blockIdx.x; const int vcu = (G % 8 == 0) ? (bx % 8) * (G / 8) + bx / 8 : bx;
    const int gw = vcu * NWAVES + wave, NGW = G * NWAVES;
#define ws (args.ws)
#define ctl ((unsigned*)(ws + WS_CTL))
#define x_in (args.in[0])
#define cvec (args.in[1])
#define w_ada (args.in[2])
#define b_ada (args.in[3])
#define w_in (args.in[4])
#define b_if (args.in[5])
#define conv_w (args.in[6])
#define conv_b (args.in[7])
#define da_lambda (args.in[8])
#define da_subln_g (args.in[9])
#define ml_norm_g (args.in[10])
#define w_br_attn (args.in[11])
#define w_br_mlstm (args.in[12])
#define w_out (args.in[13])
#define ln1_g (args.in[14])
#define ln1_b (args.in[15])
#define peer_wq (args.in[16])
#define peer_keys (args.in[17])
#define peer_u (args.in[18])
#define peer_v (args.in[19])
#define ln2_g (args.in[20])
#define ln2_b (args.in[21])
#define MOD ((float*)(ws + WS_MOD))
#define GIF ((float*)(ws + WS_GIF))
#define WIN ((bf16_t*)(ws + WS_WIN))
#define WA ((bf16_t*)(ws + WS_WA))
#define WM ((bf16_t*)(ws + WS_WM))
#define WOUT ((bf16_t*)(ws + WS_WOUT))
#define WQ ((bf16_t*)(ws + WS_WQ))
#define UT8 ((unsigned char*)(ws + WS_U))
#define VT8 ((unsigned char*)(ws + WS_V))
#define SUS ((float*)(ws + WS_SU))
#define SVS ((float*)(ws + WS_SV))
#define SHS ((float*)(ws + WS_SH))
#define CSS ((float*)(ws + WS_CS))
#define H2Q ((unsigned char*)(ws + WS_H2Q))
#define SELE ((bf16_t*)(ws + WS_SELE))
#define SELG ((float*)(ws + WS_SELG))
#define PART ((bf16_t*)(ws + WS_PART))
#define YFB ((bf16_t*)(ws + WS_YF))
#define COEF ((signed char*)(ws + WS_COEF))
#define H1 ((bf16_t*)(ws + WS_H1))
#define Z ((bf16_t*)(ws + WS_Z))
#define R ((bf16_t*)(ws + WS_R))
#define X1 ((float*)(ws + WS_X1))
#define H2 ((bf16_t*)(ws + WS_H2))
#define QP ((bf16_t*)(ws + WS_QP))
#define GATES ((bf16_t*)args.out)

    for (int u = tid; u < (LDS_BYTES - MISC_OFF) / 4; u += NWAVES * 64) MISC[u] = 0u;
    __syncthreads();
    XcdBarrier bar; bar.bar = ctl + CW_BAR; bar.x = 0; bar.st = nullptr;
    if (MK_N_LAUNCHES != N_PHASES) bar = xcd_barrier_post(ctl + CW_BAR, MISC + 8);
    const int lo = args.ph_lo, hi = args.ph_hi;
#ifndef PH_MASK
#define PH_MASK 0x3fff
#endif
#define IN(k) (((PH_MASK >> (k)) & 1) && lo <= (k) && (k) < hi)
    unsigned fepoch = 0; unsigned* fcnt = ctl + CW_QUEUE + 1024;
#if FLATBAR
#define GBAR() flat_barrier(fcnt, fepoch)
#else
#define GBAR() xcd_barrier(bar)
#endif
#define SEAM(k) do { if (IN(k) && IN((k) + 1)) GBAR(); } while (0)

#ifndef XBAR0
#define XBAR0 0
#endif
#if XBAR0
    if (IN(0)) for (int xb = 0; xb < XBAR0; ++xb) xcd_barrier(bar);
#endif
    if (IN(0)) {
        if (vcu * NWAVES < 96 * 8) {
            LAS float* sl = (LAS float*)lds;
#pragma unroll 1
            for (int i0 = tid; i0 < 32 * DM; i0 += 16 * NWAVES * 64) { float cv[16];
#pragma unroll
                for (int n = 0; n < 16; ++n) cv[n] = cvec[i0 + n * NWAVES * 64];
#pragma unroll
                for (int n = 0; n < 16; ++n) sl[i0 + n * NWAVES * 64] = siluf_(cv[n]); }
            __syncthreads();
            for (int it = gw; it < 96 * 8; it += NGW) {
                const int cb = it % 96, ks = it / 96, col = 64 * cb + lane;
                float acc[32];
#pragma unroll
                for (int b = 0; b < 32; ++b) acc[b] = 0.f;
#pragma unroll 1
                for (int k0 = 128 * ks; k0 < 128 * ks + 128; k0 += 8) { float wv[8];
#pragma unroll
                    for (int kk = 0; kk < 8; ++kk) wv[kk] = w_ada[(size_t)(k0 + kk) * MODW + col];
                    __builtin_amdgcn_sched_barrier(0);
#pragma unroll
                    for (int kk = 0; kk < 8; ++kk)
#pragma unroll
                        for (int b = 0; b < 32; ++b) acc[b] += sl[b * DM + k0 + kk] * wv[kk]; }
                const float bias = (ks == 0) ? b_ada[col] : 0.f;
#pragma unroll
                for (int b = 0; b < 32; ++b) atomicAdd(MOD + b * MODW + col, acc[b] + bias);
            }
            __syncthreads();
        }
        LAS float* scr = (LAS float*)(lds + wave * 16384);
        const bool spare = NGW > 96 * 8 + 64; const int tw = spare ? gw - 96 * 8 : gw, ntw = spare ? NGW - 96 * 8 : NGW;
        if (tw >= 0) for (int it = tw; it < 4096; it += ntw) { const int kb = it / 256, nb = it % 256, n0 = 32 * nb; p0_transpose_item(w_in, IN_W, n0 < NZ ? n0 : n0 + 8, WIN, DM, n0, kb, n0 < 1024 ? QSCALE : 1.0f, scr, lane); }
    }
    SEAM(0);
    if (IN(1)) {
        LAS float* wif = (LAS float*)lds;
        { float wv[16];
#pragma unroll
          for (int n = 0; n < 16; ++n) { const int i = tid + 512 * n, k = i >> 3, j = i & 7; wv[n] = w_in[(size_t)k * IN_W + NZ + j]; }
#pragma unroll
          for (int n = 0; n < 16; ++n) { const int i = tid + 512 * n, k = i >> 3, j = i & 7; wif[j * 1024 + k] = wv[n]; } }
        __syncthreads();
        for (int m = gw; m < TOK; m += 2 * NGW) p1_rows2(m, m + NGW, lane, x_in, MOD, H1, GIF, b_if, wif);
    }
#if DUP1
    GBAR();
    if (IN(1)) {
        LAS float* wif = (LAS float*)lds;
        for (int i = tid; i < 8192; i += 512) { const int k = i >> 3, j = i & 7; wif[j * 1024 + k] = w_in[(size_t)k * IN_W + NZ + j]; }
        __syncthreads();
        for (int m = gw; m < TOK; m += 2 * NGW) p1_rows2(m, m + NGW, lane, x_in, MOD, H1, GIF, b_if, wif);
    }
#endif
    SEAM(1);
#ifndef DUP4
#define DUP4 0
#endif
#ifndef DUP6
#define DUP6 0
#endif
#ifndef DUP7
#define DUP7 0
#endif
#ifndef DUP8
#define DUP8 0
#endif
#ifndef DUP1
#define DUP1 0
#endif
#ifndef DUP2
#define DUP2 0
#endif
#ifndef DUP23
#define DUP23 0
#endif
#ifndef P2_STAGGER
#define P2_STAGGER 0
#endif
#define P2_BODY if (IN(2)) { if (P2_STAGGER && ((bx >> 3) & 1)) { const unsigned long long t0_ = __builtin_amdgcn_s_memrealtime(); while (__builtin_amdgcn_s_memrealtime() - t0_ < P2_STAGGER) __builtin_amdgcn_s_sleep(64); } \
        pg8::Gemm g{H1, WIN, TOK, NIN, DM, DM, DM}; pg8::StaticOrder S; S.init(TOK, NIN, G, bx); pg8::EpiZ E{Z, GATES}; \
        pg8::gemm_phase<pg8::EpiZ, pg8::StaticOrder, true, true>(lds, g, S, E); }
#define P3_BODY(QOFF) if (IN(3)) { const float p3_lam = datt::attn_lambda(da_lambda); unsigned* qhead = ctl + CW_QUEUE + (QOFF); int qx = (int)(bar.x & 7u), qtries = 0; const unsigned qlen = 16u + 256u + ((QOFF) == 0 ? 64u : 0u); \
        for (;;) { __syncthreads(); \
            if (tid == 0) { unsigned w = 0xffffffffu; while (qtries < 8) { const unsigned k = __hip_atomic_fetch_add(qhead + qx, 1u, RLX_AGENT); if (k < qlen) { w = ((unsigned)qx << 16) | k; break; } qx = (qx + 1) & 7; ++qtries; } MISC[0] = w; } \
            __syncthreads(); \
            const unsigned w = MISC[0]; if (w == 0xffffffffu) break; const int q = (int)(w >> 16), k = (int)(w & 0xffffu); \
            if (k < 16) { const int u = q * 16 + k; mls::mlstm_unit<false>(lds, Z, GIF, conv_w, conv_b, ml_norm_g, u >> 2, u & 3); } \
            else if (k < 272) { const int a = k - 16, a2 = a & 127, qb = ((a >> 7) ? 3 : 7) - (a2 & 3), bh = q * 32 + (a2 >> 2); datt::attn_unit<false>(lds, Z, p3_lam, da_subln_g, bh >> 3, bh & 7, qb); } \
            else { const int pid = q * 64 + (k - 272); \
                if (pid < 256) prep_quant_item(pid, peer_u, peer_v, UT8, VT8, SUS, SVS); \
                else prep_small_weights_item(lds, pid - 256, w_br_attn, w_br_mlstm, w_out, peer_wq, WA, WM, WOUT, WQ); } } }
#define P3A_DRY(QOFF) if (IN(3)) { const float p3_lam = datt::attn_lambda(da_lambda); unsigned* qhead = ctl + CW_QUEUE + (QOFF); \
        for (;;) { __syncthreads(); if (tid == 0) MISC[0] = __hip_atomic_fetch_add(qhead, 1u, RLX_AGENT); __syncthreads(); \
            const int id = (int)MISC[0]; if (id >= 2048) break; \
            { const int idx = id, qb = 7 - idx / 256, bh = idx % 256; datt::attn_unit<true>(lds, Z, p3_lam, da_subln_g, bh >> 3, bh & 7, qb); } } }
#define P3M_DRY(QOFF) if (IN(3)) { unsigned* qhead = ctl + CW_QUEUE + (QOFF); \
        for (;;) { __syncthreads(); if (tid == 0) MISC[0] = __hip_atomic_fetch_add(qhead, 1u, RLX_AGENT); __syncthreads(); \
            const int id = (int)MISC[0]; if (id >= 128) break; \
            mls::mlstm_unit<true, MLS_ABL>(lds, Z, GIF, conv_w, conv_b, ml_norm_g, id >> 2, id & 3); } }
#ifndef MLS_ABL
#define MLS_ABL 0
#endif
#ifndef DRY3A
#define DRY3A 0
#endif
#ifndef DRY3M
#define DRY3M 0
#endif
    P2_BODY
#if DUP2
    SEAM(2);
    P2_BODY
#endif
    SEAM(2);
#if DRY3A
    P3A_DRY(128)
    if (IN(3)) GBAR();
#endif
#if DRY3M
    P3M_DRY(192)
    if (IN(3)) GBAR();
#endif
    P3_BODY(0)
    SEAM(3);
#if DUP23
    P2_BODY
    SEAM(2);
    P3_BODY(64)
    SEAM(3);
#endif
    if (IN(4)) {
        pg8::Gemm g{Z + ZC_Q, WA, TOK, DM, DM, NZ, DM, (long)(ZC_MV - ZC_Q) * 2, (long)(WS_WM - WS_WA)}; pg8::StaticOrder2 S; S.init(TOK, DM, G, bx);
        pg8::EpiGate2 E{GATES, H1};
        pg8::gemm_phase<pg8::EpiGate2, pg8::StaticOrder2, true, true>(lds, g, S, E);
    }
    SEAM(4);
#define WG_SEAM() do { asm volatile("s_waitcnt vmcnt(0)" ::: "memory"); __syncthreads(); \
        if (tid == 0) { __builtin_amdgcn_fence(__ATOMIC_ACQUIRE, "agent"); asm volatile("s_waitcnt vmcnt(0)" ::: "memory"); } __syncthreads(); } while (0)
    if (IN(6)) {
        { pg8::Gemm g{H1, WOUT, TOK, DM, DM, DM, DM}; pg8::RowsOrder S; S.init(TOK, DM, G, bx);
          pg8::EpiR E{x_in, MOD, R};
          pg8::gemm_phase<pg8::EpiR, pg8::RowsOrder, true, true>(lds, g, S, E); }
        WG_SEAM();
        for (int pm = bx; pm < TOK / 256; pm += G)
#pragma unroll 1
            for (int k = 0; k < 8; ++k) p7_rows<4>(256 * pm + 32 * wave + 4 * k, lane, R, MOD, ln1_g, ln1_b, H2, H2Q, SHS);
        WG_SEAM();
        { pg8::Gemm g{H2, WQ, TOK, DM, DM, DM, DM}; pg8::RowsOrder S; S.init(TOK, DM, G, bx);
          pg8::EpiStore E{QP};
          pg8::gemm_phase<pg8::EpiStore, pg8::RowsOrder, true, true>(lds, g, S, E); }
        WG_SEAM();
        peer::stage_keys(lds, peer_keys);
        __syncthreads();
        for (int pm = bx; pm < TOK / 256; pm += G) peer::select_phase(lds, QP, 8 * pm, 1, 8 * pm + 8, SELE, SELG);
    }
#undef WG_SEAM
    if (IN(6) && IN(10)) GBAR();
    int sx = bx % 8, sr = bx / 8, sn = (G - sx + 7) / 8;
    if (IN(10) || IN(12)) {
        __syncthreads();
        if (tid == 0) { bool phys = (MK_N_LAUNCHES != N_PHASES) && lo == 0 && hi > 10; unsigned mine = 0;
            if (phys) { for (unsigned j = 0; j < 16; ++j) { const unsigned c = xb_ld(&bar.bar[XB_XCNT(j)]); if (j < 8) { if (c == 0u) phys = false; if (j == bar.x) mine = c; } else if (c != 0u) phys = false; } }
            MISC[16] = phys ? bar.x : (unsigned)sx; MISC[17] = phys ? MISC[10] : (unsigned)sr; MISC[18] = phys ? mine : (unsigned)sn; }
        __syncthreads();
        sx = (int)MISC[16]; sr = (int)MISC[17]; sn = (int)MISC[18];
    }
    if (IN(10)) {
        peer::u_phase(lds, 2 * sr + (sx >> 2), 2 * sn, sx & 3, SELE, H2Q, UT8, PART);
    }
    SEAM(10);
    if (IN(11)) { for (int m = 16 * gw; m < TOK; m += 16 * NGW) peer::red_tokens<16>((size_t)m, PART, SELE, SELG, SUS, SVS, SHS, COEF, CSS); }
    SEAM(11);
    if (IN(12)) {
        peer::v_phase(lds, sr, sn, sx, SELE, COEF, CSS, VT8, YFB);
    }
    SEAM(12);
    if (IN(13)) { for (int m = gw; m < TOK; m += 2 * NGW) peer::final_rows2((size_t)m, (size_t)m + NGW, R, YFB, MOD, ln1_g, ln1_b, ln2_g, ln2_b, args.out); }
#undef IN
#undef SEAM
#undef ws
#undef ctl
#undef x_in
#undef cvec
#undef w_ada
#undef b_ada
#undef w_in
#undef b_if
#undef conv_w
#undef conv_b
#undef da_lambda
#undef da_subln_g
#undef ml_norm_g
#undef w_br_attn
#undef w_br_mlstm
#undef w_out
#undef ln1_g
#undef ln1_b
#undef peer_wq
#undef peer_keys
#undef peer_u
#undef peer_v
#undef ln2_g
#undef ln2_b
#undef MOD
#undef GIF
#undef WIN
#undef WA
#undef WM
#undef WOUT
#undef WQ
#undef UT8
#undef VT8
#undef SUS
#undef SVS
#undef SHS
#undef CSS
#undef H2Q
#undef SELE
#undef SELG
#undef PART
#undef YFB
#undef COEF
#undef H1
#undef Z
#undef R
#undef X1
#undef H2
#undef QP
#undef GATES
}

extern "C" void kernel_launch(void* const* d_in, const int* in_sizes, int n_in, void* d_out, int out_size, void* d_ws, size_t ws_size, hipStream_t stream) {
    static int grid = 0;
    if (grid == 0) {
        if (n_in != 22 || in_sizes[0] != TOK * DM || out_size != TOK * DM || ws_size < WS_END) { fprintf(stderr, "kernel_launch: unexpected shapes (n_in %d, in0 %d, out %d, ws %zu; need ws >= %zu)\n", n_in, n_in > 0 ? in_sizes[0] : -1, out_size, ws_size, (size_t)WS_END); grid = -1; return; }
        int dev = 0, cus = 0, per_cu = 0;
        if (hipGetDevice(&dev) != hipSuccess || hipDeviceGetAttribute(&cus, hipDeviceAttributeMultiprocessorCount, dev) != hipSuccess) { fprintf(stderr, "kernel_launch: device query failed\n"); grid = -1; return; }
        if (hipFuncSetAttribute((const void*)mega_fwd, hipFuncAttributeMaxDynamicSharedMemorySize, LDS_BYTES) != hipSuccess) { fprintf(stderr, "kernel_launch: hipFuncSetAttribute failed\n"); grid = -1; return; }
        if (hipOccupancyMaxActiveBlocksPerMultiprocessor(&per_cu, (const void*)mega_fwd, NWAVES * 64, LDS_BYTES) != hipSuccess || per_cu < 1) fprintf(stderr, "kernel_launch: note: occupancy query reports %d workgroups per CU\n", per_cu);
        (void)hipGetLastError();
        grid = cus;
    }
    if (grid < 0) return;
    if (hipMemsetAsync((char*)d_ws + WS_CTL, 0, CTL_ZERO_BYTES, stream) != hipSuccess) { fprintf(stderr, "kernel_launch: memset failed\n"); return; }
    Args a{};
    for (int i = 0; i < 22; ++i) a.in[i] = (const float*)d_in[i];
    a.out = (float*)d_out; a.ws = (unsigned char*)d_ws;
    for (int li = 0; li < MK_N_LAUNCHES; ++li) {
        a.ph_lo = (MK_N_LAUNCHES == N_PHASES) ? li : 0; a.ph_hi = (MK_N_LAUNCHES == N_PHASES) ? li + 1 : N_PHASES;
        hipLaunchKernelGGL(mega_fwd, dim3(grid), dim3(NWAVES * 64), LDS_BYTES, stream, a);
        const hipError_t le = hipPeekAtLastError();
        if (le != hipSuccess) { fprintf(stderr, "kernel_launch: launch %d failed: %s\n", li, hipGetErrorName(le)); break; }
    }
}
```
